# Optimizing an MI355X kernel written in HIP

```python
import math
import jax, jax.numpy as jnp
from jax import lax
import numpy as np

D_MODEL = 1024
BATCH = 2
SEQ = 8192
DEPTH = 2

A_GROUPS = 4
A_GROUP_DIM = 128
A_WIDTH = A_GROUPS * A_GROUP_DIM
A_CHUNK = 128
B_HEADS = 4
B_KDIM = 128
B_VDIM = 128
B_QK_WIDTH = B_HEADS * B_KDIM
B_WIDTH = B_HEADS * B_VDIM
B_CHUNK = 64
C_HEADS = 16
C_HEAD_DIM = D_MODEL // C_HEADS
C_WIDTH = C_HEADS * C_HEAD_DIM
DILATED_PATTERNS = ((128, 1), (512, 4), (2048, 16))
REL_BUCKETS = 32
REL_MAX_DISTANCE = 1024
N_EXPERTS = 16
EXPERT_D_FF = 1024
CAPACITY_FACTOR = 2
EPS = 1e-6
NEG_INF = -1e30

kernel_name = 'hybrid_gmlp_hgrn2_dilated_ec_moe'


def rmsnorm(x, g):
    xf = x.astype(jnp.float32)
    y = xf * lax.rsqrt(jnp.mean(xf * xf, axis=-1, keepdims=True) + EPS)
    return (y * g.astype(jnp.float32)).astype(x.dtype)


def layernorm(x, g, b):
    xf = x.astype(jnp.float32)
    mu = jnp.mean(xf, axis=-1, keepdims=True)
    xc = xf - mu
    y = xc * lax.rsqrt(jnp.mean(xc * xc, axis=-1, keepdims=True) + EPS)
    return (y * g.astype(jnp.float32) + b.astype(jnp.float32)).astype(x.dtype)


def chunked_spatial_gating(u, v, w_s, b_s, ln_g, ln_b):
    B, S, _ = v.shape
    v = layernorm(v, ln_g, ln_b)
    vc = v.reshape(B, S // A_CHUNK, A_CHUNK, A_GROUPS, A_GROUP_DIM)
    mixed = jnp.einsum('gts,bnsgc->bntgc', w_s, vc) + b_s.T[:, :, None]
    return u * mixed.reshape(B, S, A_WIDTH)


def gla_chunk_scan(q, k, log_f, v):
    B, S, H, K = q.shape
    V = v.shape[-1]
    n = S // B_CHUNK

    def chunks(t):
        return t.reshape(B, n, B_CHUNK, H, t.shape[-1]).transpose(1, 0, 3, 2, 4)

    lower = jnp.tril(jnp.ones((B_CHUNK, B_CHUNK), dtype=bool))[:, :, None]

    def step(state, inp):
        qc, kc, fc, vc = inp
        b = jnp.cumsum(fc, axis=2)
        diff = b[:, :, :, None, :] - b[:, :, None, :, :]
        decay = jnp.exp(jnp.where(lower, diff, -jnp.inf))
        scores = jnp.einsum('bhtsk,bhsk->bhts', qc[:, :, :, None, :] * decay, kc)
        o = (jnp.einsum('bhts,bhsv->bhtv', scores, vc)
             + jnp.einsum('bhtk,bhkv->bhtv', qc * jnp.exp(b), state))
        b_end = b[:, :, -1]
        state = (state * jnp.exp(b_end)[..., None]
                 + jnp.einsum('bhsk,bhsv->bhkv', kc * jnp.exp(b_end[:, :, None] - b), vc))
        return state, o

    state0 = jnp.zeros((B, H, K, V), jnp.float32)
    _, o = lax.scan(step, state0, (chunks(q), chunks(k), chunks(log_f), chunks(v)))
    return o.transpose(1, 0, 3, 2, 4).reshape(B, S, H, V)


def hgrn2_bidirectional(q_raw, f_fwd_raw, f_bwd_raw, i_raw, gate, lb_fwd, lb_bwd, norm_g):
    B, S, _ = q_raw.shape

    def heads(t, d):
        return t.reshape(B, S, B_HEADS, d).astype(jnp.float32)

    q = heads(jax.nn.silu(q_raw), B_KDIM)
    v = heads(i_raw, B_VDIM)

    def direction(f_raw, lb, rev):
        f = lb + (1.0 - lb) * jax.nn.sigmoid(f_raw.astype(jnp.float32))
        args = (q, heads(1.0 - f, B_KDIM), heads(jnp.log(f), B_KDIM), v)
        if rev:
            return gla_chunk_scan(*[a[:, ::-1] for a in args])[:, ::-1]
        return gla_chunk_scan(*args)

    o = direction(f_fwd_raw, lb_fwd, False) + direction(f_bwd_raw, lb_bwd, True)
    o = o * lax.rsqrt(jnp.mean(o * o, axis=-1, keepdims=True) + EPS)
    o = o.reshape(B, S, B_WIDTH) * norm_g.astype(jnp.float32)
    o = o * jax.nn.sigmoid(gate.astype(jnp.float32))
    return o.astype(q_raw.dtype)


def t5_bucket(rel):
    half_buckets = REL_BUCKETS // 2
    max_exact = half_buckets // 2
    n = jnp.abs(rel)
    scaled = (jnp.log(jnp.maximum(n, 1).astype(jnp.float32) / max_exact)
              / math.log(REL_MAX_DISTANCE / max_exact))
    large = jnp.minimum(max_exact + (scaled * (half_buckets - max_exact)).astype(jnp.int32),
                        half_buckets - 1)
    return jnp.where(rel > 0, half_buckets, 0) + jnp.where(n < max_exact, n, large)


def dilated_branch(q, k, v, rel_table, dilation, half):
    B, S, H, Dh = q.shape
    n = S // dilation
    nb = -(-n // half)
    pad = nb * half - n

    def strided(t, front, back):
        t = t.reshape(B, n, dilation, H, Dh).transpose(0, 2, 1, 3, 4)
        return jnp.pad(t, ((0, 0), (0, 0), (front, back), (0, 0), (0, 0)))

    qb = strided(q, 0, pad).reshape(B, dilation, nb, half, H, Dh)

    def band(t):
        tb = strided(t, half, half + pad).reshape(B, dilation, nb + 2, half, H, Dh)
        return jnp.concatenate([tb[:, :, :-2], tb[:, :, 1:-1], tb[:, :, 2:]], axis=3)

    kb, vb = band(k), band(v)
    qi = jnp.arange(half)
    kc = jnp.arange(3 * half)
    rel = kc[None, :] - half - qi[:, None]
    bias = rel_table[t5_bucket(rel * dilation)].transpose(2, 0, 1).astype(jnp.float32)
    k_sub = (jnp.arange(nb)[:, None] - 1) * half + kc[None, :]
    valid = (jnp.abs(rel) <= half)[None] & ((k_sub >= 0) & (k_sub < n))[:, None, :]
    logits = jnp.einsum('brnqhc,brnkhc->brnhqk', qb, kb).astype(jnp.float32) + bias
    logits = jnp.where(valid[None, None, :, None], logits, NEG_INF)
    m = jnp.max(logits, axis=-1, keepdims=True)
    p = jnp.exp(logits - m)
    den = jnp.sum(p, axis=-1, keepdims=True)
    o = jnp.einsum('brnhqk,brnkhc->brnqhc', (p / den).astype(v.dtype), vb).astype(jnp.float32)
    lse = (m + jnp.log(den))[..., 0]

    def unstride(t):
        t = t[:, :, :n]
        return jnp.swapaxes(t, 1, 2).reshape((B, S) + t.shape[3:])

    o = unstride(o.reshape(B, dilation, nb * half, H, Dh))
    lse = unstride(lse.transpose(0, 1, 2, 4, 3).reshape(B, dilation, nb * half, H))
    return o, lse


def dilated_mixture(q, k, v, rel_table):
    outs, lses = [], []
    for window, dilation in DILATED_PATTERNS:
        o, lse = dilated_branch(q, k, v, rel_table, dilation, window // (2 * dilation))
        outs.append(o)
        lses.append(lse)
    w = jax.nn.softmax(jnp.stack(lses), axis=0)
    return jnp.einsum('pbsh,pbshc->bshc', w, jnp.stack(outs)).astype(q.dtype)


def expert_choice_moe(x, w_router, w_gate, w_up, w_down):
    B, S, D = x.shape
    cap = max(1, CAPACITY_FACTOR * S // N_EXPERTS)
    logits = jnp.einsum('bsd,de->bse', x, w_router).astype(jnp.float32)
    affinity = jax.nn.softmax(logits, axis=-1)
    g, idx = lax.top_k(jnp.swapaxes(affinity, 1, 2), cap)
    bidx = jnp.arange(B)[:, None, None]
    xe = x[bidx, idx]
    h = (jax.nn.silu(jnp.einsum('becd,edf->becf', xe, w_gate))
         * jnp.einsum('becd,edf->becf', xe, w_up))
    y = jnp.einsum('becf,efd->becd', h, w_down) * g[..., None].astype(x.dtype)
    return jnp.zeros_like(x).at[bidx, idx].add(y)


def setup_inputs(seed: int = 0) -> dict:
    key = jax.random.key(seed)
    ks = jax.random.split(key, 19)
    n_even, n_odd = (DEPTH + 1) // 2, DEPTH // 2
    even_in = 2 * A_WIDTH + 3 * B_QK_WIDTH + 2 * B_WIDTH
    even_out = A_WIDTH + B_WIDTH

    def nrm(k, shape, scale):
        return jax.random.normal(k, shape, jnp.float32) * scale

    return {
        'x': nrm(ks[0], (BATCH, SEQ, D_MODEL), 1.0),
        'mix_norm': 1.0 + nrm(ks[1], (DEPTH, D_MODEL), 0.05),
        'ffn_norm': 1.0 + nrm(ks[2], (DEPTH, D_MODEL), 0.05),
        'final_norm': 1.0 + nrm(ks[3], (D_MODEL,), 0.05),
        'w_in_even': nrm(ks[4], (n_even, D_MODEL, even_in), D_MODEL ** -0.5),
        'w_out_even': nrm(ks[5], (n_even, even_out, D_MODEL), even_out ** -0.5),
        'a_ln_g': 1.0 + nrm(ks[6], (n_even, A_WIDTH), 0.05),
        'a_ln_b': nrm(ks[7], (n_even, A_WIDTH), 0.02),
        'a_w_s': nrm(ks[8], (n_even, A_GROUPS, A_CHUNK, A_CHUNK), A_CHUNK ** -0.5),
        'a_b_s': 1.0 + nrm(ks[9], (n_even, A_GROUPS, A_CHUNK), 0.1),
        'b_lb_table': nrm(ks[10], (2, DEPTH + 1, B_QK_WIDTH), 0.1),
        'b_norm_g': 1.0 + nrm(ks[11], (n_even, B_WIDTH), 0.05),
        'w_qkv_odd': nrm(ks[12], (n_odd, D_MODEL, 3 * C_WIDTH), D_MODEL ** -0.5),
        'w_o_odd': nrm(ks[13], (n_odd, C_WIDTH, D_MODEL), C_WIDTH ** -0.5),
        'rel_bias': nrm(ks[14], (REL_BUCKETS, C_HEADS), 0.5),
        'w_router': nrm(ks[15], (DEPTH, D_MODEL, N_EXPERTS), D_MODEL ** -0.5),
        'w_gate': nrm(ks[16], (DEPTH, N_EXPERTS, D_MODEL, EXPERT_D_FF), D_MODEL ** -0.5),
        'w_up': nrm(ks[17], (DEPTH, N_EXPERTS, D_MODEL, EXPERT_D_FF), D_MODEL ** -0.5),
        'w_down': nrm(ks[18], (DEPTH, N_EXPERTS, EXPERT_D_FF, D_MODEL), EXPERT_D_FF ** -0.5),
    }


def reference(x, mix_norm, ffn_norm, final_norm, w_in_even, w_out_even, a_ln_g, a_ln_b,
              a_w_s, a_b_s, b_lb_table, b_norm_g, w_qkv_odd, w_o_odd, rel_bias,
              w_router, w_gate, w_up, w_down):
    B, S, _ = x.shape
    sizes = (A_WIDTH, A_WIDTH, B_QK_WIDTH, B_QK_WIDTH, B_QK_WIDTH, B_WIDTH, B_WIDTH)
    cuts = [sum(sizes[:j]) for j in range(1, len(sizes))]
    lower_bounds = jnp.cumsum(jax.nn.softmax(b_lb_table.astype(jnp.float32), axis=1), axis=1)
    for layer in range(DEPTH):
        h = rmsnorm(x, mix_norm[layer])
        if layer % 2 == 0:
            e = layer // 2
            proj = jnp.einsum('bsd,dn->bsn', h, w_in_even[e])
            u, v, q_b, f_fwd, f_bwd, i_b, g_b = jnp.split(proj, cuts, axis=-1)
            a_out = chunked_spatial_gating(jax.nn.gelu(u), jax.nn.gelu(v), a_w_s[e], a_b_s[e],
                                           a_ln_g[e], a_ln_b[e])
            b_out = hgrn2_bidirectional(q_b, f_fwd, f_bwd, i_b, g_b, lower_bounds[0, layer],
                                        lower_bounds[1, layer], b_norm_g[e])
            mixed = jnp.einsum('bsn,nd->bsd', jnp.concatenate([a_out, b_out], axis=-1), w_out_even[e])
        else:
            o = layer // 2
            qkv = jnp.einsum('bsd,dn->bsn', h, w_qkv_odd[o]).reshape(B, S, 3, C_HEADS, C_HEAD_DIM)
            q = qkv[:, :, 0] * (C_HEAD_DIM ** -0.5)
            attn = dilated_mixture(q, qkv[:, :, 1], qkv[:, :, 2], rel_bias)
            mixed = jnp.einsum('bsn,nd->bsd', attn.reshape(B, S, C_WIDTH), w_o_odd[o])
        x = x + mixed
        x = x + expert_choice_moe(rmsnorm(x, ffn_norm[layer]), w_router[layer], w_gate[layer],
                                  w_up[layer], w_down[layer])
    return rmsnorm(x, final_norm)
```

```cpp
#include <hip/hip_runtime.h>
#include <cstdio>
#include <cstdint>
namespace pg8 {
#define PG8_LAS __attribute__((address_space(3)))
typedef unsigned short bf16_t;
typedef short bf16x8 __attribute__((ext_vector_type(8)));
typedef float f32x4 __attribute__((ext_vector_type(4)));
typedef unsigned u32x4 __attribute__((ext_vector_type(4)));
constexpr int BM = 256, BK = 64, HALF = 128, HTB = HALF * BK * 2  , STAGE_BYTES = 8 * HTB, NXCD = 8, WGM = 8;

__host__ __device__ __forceinline__ int lds_byte(int r, int c) { const int st = (r >> 4) * 2 + (c >> 5), rr = r & 15, cc = c & 31, ob = rr * 64 + cc * 2; return st * 1024 + (ob ^ (((ob >> 9) & 1) << 5)); }
__host__ __device__ __forceinline__ void stage_rc(int b, int& R, int& C) { const int st = b / 1024, sb = b % 1024, swz = sb ^ (((sb >> 9) & 1) << 5); R = (st >> 1) * 16 + swz / 64; C = (st & 1) * 32 + (swz % 64) / 2; }
__host__ __device__ __forceinline__ int perm32(int rho) { const int n = rho >> 4, i = rho & 15; return 8 * (i >> 2) + 4 * n + (i & 3); }

struct Unit { int pm, pn; };
struct Gemm { const bf16_t* A; const bf16_t* Bt; int M, N, K; };

struct StaticOrder {
    int nM, nN, nwg, G, c;
    __host__ __device__ void init(int M, int N, int G_, int c_) { nM = M / BM; nN = N / BM; nwg = nM * nN; G = G_; c = c_; }
    __host__ __device__ bool next(int i, Unit& u) const {
        const long L = (long)i * G + c; if (L >= nwg) return false;
        int wgid = (int)L; { const int q = nwg / NXCD, r = nwg % NXCD, xcd = wgid % NXCD, off = wgid / NXCD; wgid = (xcd < r ? xcd * (q + 1) : r * (q + 1) + (xcd - r) * q) + off; }
        const int nig = WGM * nN, gid = wgid / nig, fm = gid * WGM, gsz = (nM - fm) < WGM ? (nM - fm) : WGM;
        u.pm = fm + ((wgid % nig) % gsz); u.pn = (wgid % nig) / gsz; return true;
    }
    __device__ __forceinline__ void a_ready(const Unit&) const {}
    __device__ __forceinline__ void done(const Unit&) const {}
};

__device__ __forceinline__ unsigned cvt_pk_bf16(float lo, float hi) { unsigned r; asm volatile("v_cvt_pk_bf16_f32 %0, %1, %2" : "=v"(r) : "v"(lo), "v"(hi)); return r; }
typedef float f32x2 __attribute__((ext_vector_type(2)));
__device__ __forceinline__ f32x2 gelu_pk(f32x2 v) {
    const f32x2 av = __builtin_elementwise_abs(v), d = av * 0.2316418882f + 1.0f;
    f32x2 t; t.x = __builtin_amdgcn_rcpf(d.x); t.y = __builtin_amdgcn_rcpf(d.y);
    f32x2 q = t * 0.5307027145f + (-0.7265760135f); q = q * t + 0.7107068705f; q = q * t + (-0.142248368f); q = q * t + 0.127414796f; q = q * t;
    const f32x2 s = (v * v) * (-0.72134752044f);
    f32x2 e; e.x = __builtin_amdgcn_exp2f(s.x); e.y = __builtin_amdgcn_exp2f(s.y);
    const f32x2 m = v * (q * e), r = v - m;
    f32x2 o; o.x = v.x < 0.f ? m.x : r.x; o.y = v.y < 0.f ? m.y : r.y; return o;
}

template <int ACT  > struct EpiBf16 {
    static constexpr bool PERM = true, AFTER_DRAIN = false; static_assert(ACT == 0 || ACT == 1, "EpiBf16: ACT is 0 (none) or 1 (gelu_pk)");
    bf16_t* O; int ldc; const float* bias; int split_cols; size_t split_stride; float scale0;
    __device__ __forceinline__ void operator()(const f32x4 (&acc)[2][2][4][2], const Unit& u, int wr, int wc, int fr, int fq) const {
        const int row0 = u.pm * BM + wr * 64 + fr; int colt = u.pn * BM; bf16_t* base = O;
        float sc = 1.f; if (split_cols) { const int t = colt / split_cols; base += (size_t)t * split_stride; colt -= t * split_cols; if (t == 0) sc = scale0; }
        const int col0 = colt + wc * 32 + 8 * fq, bcol0 = u.pn * BM + wc * 32 + 8 * fq;
        f32x4 bv[2][2];
#pragma unroll
        for (int bj = 0; bj < 2; ++bj)
#pragma unroll
            for (int n = 0; n < 2; ++n) bv[bj][n] = bias ? *(const f32x4*)(bias + bcol0 + bj * HALF + 4 * n) : (f32x4){0.f, 0.f, 0.f, 0.f};
#pragma unroll
        for (int ai = 0; ai < 2; ++ai)
#pragma unroll
            for (int m = 0; m < 4; ++m) { bf16_t* rowp = base + (size_t)(row0 + ai * HALF + m * 16) * ldc + col0;
#pragma unroll
                for (int bj = 0; bj < 2; ++bj) { f32x4 v0 = acc[ai][bj][m][0] + bv[bj][0], v1 = acc[ai][bj][m][1] + bv[bj][1];
                    if (ACT == 1) { f32x2 a = gelu_pk((f32x2){v0[0], v0[1]}), b = gelu_pk((f32x2){v0[2], v0[3]}), c = gelu_pk((f32x2){v1[0], v1[1]}), d = gelu_pk((f32x2){v1[2], v1[3]});
                        v0 = (f32x4){a.x, a.y, b.x, b.y}; v1 = (f32x4){c.x, c.y, d.x, d.y}; }
                    v0 = v0 * sc; v1 = v1 * sc; u32x4 w; w.x = cvt_pk_bf16(v0[0], v0[1]); w.y = cvt_pk_bf16(v0[2], v0[3]); w.z = cvt_pk_bf16(v1[0], v1[1]); w.w = cvt_pk_bf16(v1[2], v1[3]);
                    *(u32x4*)(rowp + bj * HALF) = w; } }
    }
};
template <class Epi, class Sched, bool ALIGN_EPI = false, bool SP2 = false>
__device__ __forceinline__ void gemm_phase(PG8_LAS unsigned char* lds, const Gemm g, const Sched& S, const Epi& E) {
    const int tid = threadIdx.x, wid = __builtin_amdgcn_readfirstlane(tid >> 6), lane = tid & 63, wr = wid >> 2, wc = wid & 3, fr = lane & 15, fq = lane >> 4;
    const int K = g.K, nt = K / BK;
    unsigned voffA[2], voffB[2];
#pragma unroll
    for (int i = 0; i < 2; ++i) { int R, C; stage_rc(tid * 16 + i * 8192, R, C); const int Rb = Epi::PERM ? ((R & ~31) + perm32(R & 31)) : R;
        voffA[i] = (unsigned)(R * K + C) * 2u; voffB[i] = (unsigned)(Rb * K + C) * 2u; }
    const size_t kstep = (size_t)(BK * 2);
    const size_t hstep = (size_t)HALF * K * 2;
    const size_t tstep = 2 * hstep;
    const unsigned ldsw = (unsigned)wid * 1024u;
    const int aoff = lds_byte(wr * 64 + fr, fq * 8), boff = lds_byte(wc * 32 + fr, fq * 8);
#define PG8_SA(b, h) (((b) * 2 + (h)) * HTB)
#define PG8_SB(b, h) ((4 + (b) * 2 + (h)) * HTB)
#define PG8_STAGE(bufoff, gbase, voff) do { _Pragma("unroll") for (int _i = 0; _i < 2; ++_i) \
        __builtin_amdgcn_global_load_lds((const unsigned*)((const char*)(gbase) + (voff)[_i]), (PG8_LAS unsigned*)(lds + (bufoff) + ldsw + _i * 8192), 16, 0, 0); } while (0)
#define PG8_LDA(dst, b, h) do { _Pragma("unroll") for (int m = 0; m < 4; ++m) _Pragma("unroll") for (int k = 0; k < 2; ++k) dst[m][k] = *(const PG8_LAS bf16x8*)(lds + PG8_SA(b, h) + aoff + m * 2048 + k * 1024); } while (0)
#define PG8_LDB(dst, b, h) do { _Pragma("unroll") for (int n = 0; n < 2; ++n) _Pragma("unroll") for (int k = 0; k < 2; ++k) dst[n][k] = *(const PG8_LAS bf16x8*)(lds + PG8_SB(b, h) + boff + n * 2048 + k * 1024); } while (0)
#define PG8_MMA(ai, bj, At, Bt) do { __builtin_amdgcn_s_setprio(1); _Pragma("unroll") for (int m = 0; m < 4; ++m) _Pragma("unroll") for (int n = 0; n < 2; ++n) _Pragma("unroll") for (int k = 0; k < 2; ++k) \
        acc[ai][bj][m][n] = __builtin_amdgcn_mfma_f32_16x16x32_bf16(Bt[n][k], At[m][k], acc[ai][bj][m][n], 0, 0, 0); __builtin_amdgcn_s_setprio(0); } while (0)
#define PG8_WAIT_V(n) asm volatile("s_waitcnt vmcnt(" #n ")" ::: "memory")
#define PG8_WAIT_L(n) asm volatile("s_waitcnt lgkmcnt(" #n ")" ::: "memory")
#define PG8_BAR __builtin_amdgcn_s_barrier()
#define PG8_SCHED __builtin_amdgcn_sched_barrier(0)
    Unit cur, nxt; int ui = 0;
    if (!S.next(0, cur)) return;
    f32x4 acc[2][2][4][2];
#pragma unroll
    for (int a = 0; a < 2; ++a)
#pragma unroll
        for (int b = 0; b < 2; ++b)
#pragma unroll
            for (int m = 0; m < 4; ++m)
#pragma unroll
                for (int n = 0; n < 2; ++n) acc[a][b][m][n] = (f32x4){0.f, 0.f, 0.f, 0.f};
    bf16x8 At[4][2], B0[2][2], B1[2][2];
    const char* cA = (const char*)g.A + (size_t)cur.pm * tstep; const char* cB = (const char*)g.Bt + (size_t)cur.pn * tstep;
    S.a_ready(cur);
    if constexpr (SP2) {
        PG8_STAGE(PG8_SB(0, 0), cB, voffB); PG8_STAGE(PG8_SB(0, 1), cB + hstep, voffB); PG8_STAGE(PG8_SA(0, 0), cA, voffA); PG8_STAGE(PG8_SA(0, 1), cA + hstep, voffA);
        if (wr == 1) PG8_BAR;
        PG8_WAIT_V(2); PG8_BAR;
        PG8_STAGE(PG8_SB(1, 0), cB + kstep, voffB); PG8_STAGE(PG8_SA(1, 0), cA + kstep, voffA); PG8_STAGE(PG8_SB(1, 1), cB + hstep + kstep, voffB);
        PG8_WAIT_V(6); PG8_BAR;
    } else {
        PG8_STAGE(PG8_SB(0, 0), cB, voffB); PG8_STAGE(PG8_SA(0, 0), cA, voffA); PG8_STAGE(PG8_SB(0, 1), cB + hstep, voffB); PG8_STAGE(PG8_SA(0, 1), cA + hstep, voffA);
        if (wr == 1) PG8_BAR;
        PG8_WAIT_V(4); PG8_BAR;
        PG8_STAGE(PG8_SB(1, 0), cB + kstep, voffB); PG8_STAGE(PG8_SA(1, 0), cA + kstep, voffA); PG8_STAGE(PG8_SB(1, 1), cB + hstep + kstep, voffB);
        PG8_WAIT_V(6); PG8_BAR;
    }
    for (;;) {
        const bool has_next = S.next(ui + 1, nxt);
        const char* nA = has_next ? (const char*)g.A + (size_t)nxt.pm * tstep : cA; const char* nB = has_next ? (const char*)g.Bt + (size_t)nxt.pn * tstep : cB;
        for (int t = 0; t < nt; t += 2) {
            const bool last = (t == nt - 2);
            const char* a1 = cA + (size_t)(t + 1) * kstep;
            const char* a2 = last ? nA : cA + (size_t)(t + 2) * kstep; const char* b2 = last ? nB : cB + (size_t)(t + 2) * kstep;
            const char* a3 = a2 + kstep; const char* b3 = b2 + kstep;
            if (last && has_next) S.a_ready(nxt);
            if constexpr (SP2) {
            PG8_LDB(B0, 0, 0); PG8_LDB(B1, 0, 1); PG8_SCHED; PG8_LDA(At, 0, 0); PG8_STAGE(PG8_SA(1, 1), a1 + hstep, voffA);
            PG8_WAIT_V(8); PG8_WAIT_L(0); PG8_BAR; PG8_MMA(0, 0, At, B0); PG8_MMA(0, 1, At, B1); PG8_BAR; PG8_SCHED;
            PG8_LDA(At, 0, 1); PG8_STAGE(PG8_SB(0, 0), b2, voffB); PG8_STAGE(PG8_SB(0, 1), b2 + hstep, voffB); PG8_STAGE(PG8_SA(0, 0), a2, voffA);
            PG8_WAIT_V(8); PG8_WAIT_L(0); PG8_BAR; PG8_MMA(1, 0, At, B0); PG8_MMA(1, 1, At, B1); PG8_BAR; PG8_SCHED;
            PG8_LDB(B0, 1, 0); PG8_LDB(B1, 1, 1); PG8_SCHED; PG8_LDA(At, 1, 0); PG8_STAGE(PG8_SA(0, 1), a2 + hstep, voffA);
            PG8_WAIT_V(8); PG8_WAIT_L(0); PG8_BAR; PG8_MMA(0, 0, At, B0); PG8_MMA(0, 1, At, B1); PG8_BAR; PG8_SCHED;
            PG8_LDA(At, 1, 1); PG8_STAGE(PG8_SB(1, 0), b3, voffB); PG8_STAGE(PG8_SB(1, 1), b3 + hstep, voffB); PG8_STAGE(PG8_SA(1, 0), a3, voffA);
            PG8_WAIT_V(8); PG8_WAIT_L(0); PG8_BAR; PG8_MMA(1, 0, At, B0); PG8_MMA(1, 1, At, B1); PG8_BAR; PG8_SCHED;
            } else {
            PG8_LDB(B0, 0, 0); PG8_SCHED; PG8_LDA(At, 0, 0); PG8_STAGE(PG8_SA(1, 1), a1 + hstep, voffA);
            PG8_WAIT_L(8); PG8_BAR; PG8_WAIT_L(0); PG8_MMA(0, 0, At, B0); PG8_BAR; PG8_SCHED;
            PG8_LDB(B1, 0, 1); PG8_STAGE(PG8_SB(0, 0), b2, voffB);
            PG8_BAR; PG8_WAIT_L(0); PG8_MMA(0, 1, At, B1); PG8_BAR;
            PG8_LDA(At, 0, 1); PG8_STAGE(PG8_SA(0, 0), a2, voffA);
            PG8_BAR; PG8_WAIT_L(0); PG8_MMA(1, 0, At, B0); PG8_BAR; PG8_SCHED;
            PG8_STAGE(PG8_SB(0, 1), b2 + hstep, voffB);
            PG8_WAIT_V(6); PG8_BAR; PG8_MMA(1, 1, At, B1); PG8_BAR;
            PG8_LDB(B0, 1, 0); PG8_SCHED; PG8_LDA(At, 1, 0); PG8_STAGE(PG8_SA(0, 1), a2 + hstep, voffA);
            PG8_WAIT_L(8); PG8_BAR; PG8_WAIT_L(0); PG8_MMA(0, 0, At, B0); PG8_BAR; PG8_SCHED;
            PG8_LDB(B1, 1, 1); PG8_STAGE(PG8_SB(1, 0), b3, voffB);
            PG8_BAR; PG8_WAIT_L(0); PG8_MMA(0, 1, At, B1); PG8_BAR;
            PG8_LDA(At, 1, 1); PG8_STAGE(PG8_SA(1, 0), a3, voffA);
            PG8_BAR; PG8_WAIT_L(0); PG8_MMA(1, 0, At, B0); PG8_BAR; PG8_SCHED;
            PG8_STAGE(PG8_SB(1, 1), b3 + hstep, voffB);
            PG8_WAIT_V(6); PG8_BAR; PG8_MMA(1, 1, At, B1); PG8_BAR;
            }
        }
        if constexpr (ALIGN_EPI) { if (wr == 0) PG8_BAR; }
        if constexpr (!Epi::AFTER_DRAIN) { E(acc, cur, wr, wc, fr, fq); S.done(cur); }
        if (!has_next) break;
#pragma unroll
        for (int a = 0; a < 2; ++a)
#pragma unroll
            for (int b = 0; b < 2; ++b)
#pragma unroll
                for (int m = 0; m < 4; ++m)
#pragma unroll
                    for (int n = 0; n < 2; ++n) acc[a][b][m][n] = (f32x4){0.f, 0.f, 0.f, 0.f};
        cur = nxt; cA = nA; cB = nB; ++ui;
        if constexpr (ALIGN_EPI) { if (wr == 1) PG8_BAR; }
    }
    PG8_WAIT_V(0);
    if constexpr (!ALIGN_EPI) { if (wr == 0) PG8_BAR; }
    PG8_BAR;
    if constexpr (Epi::AFTER_DRAIN) { E.fused(acc, cur, wr, wc, fr, fq, lds, wid, lane); S.done(cur); }
#undef PG8_SA
#undef PG8_SB
#undef PG8_STAGE
#undef PG8_LDA
#undef PG8_LDB
#undef PG8_MMA
#undef PG8_WAIT_V
#undef PG8_WAIT_L
#undef PG8_BAR
#undef PG8_SCHED
}
}
#define LAS __attribute__((address_space(3)))
#define DI __device__ __forceinline__
typedef unsigned short bf16;
typedef unsigned v4u __attribute__((ext_vector_type(4)));
typedef unsigned v2u __attribute__((ext_vector_type(2)));
typedef float f32x4 __attribute__((ext_vector_type(4)));
typedef short bf16x8 __attribute__((ext_vector_type(8)));
#define LDS_WAIT() asm volatile("s_waitcnt lgkmcnt(0)" ::: "memory")
#define VM_WAIT() asm volatile("s_waitcnt vmcnt(0)" ::: "memory")
DI unsigned f2bf(float f) { unsigned u = __builtin_bit_cast(unsigned, f); return (u + 0x7fffu + ((u >> 16) & 1u)) >> 16; }
DI unsigned pk2(float lo, float hi) { return f2bf(lo) | (f2bf(hi) << 16); }
DI float bf2f(unsigned b) { return __builtin_bit_cast(float, b << 16); }
DI float bflo(unsigned w) { return __builtin_bit_cast(float, w << 16); }
DI float bfhi(unsigned w) { return __builtin_bit_cast(float, w & 0xffff0000u); }
DI float fexp(float x) { return __builtin_amdgcn_exp2f(x * 1.4426950408889634f); }
DI float flog(float x) { return __builtin_amdgcn_logf(x) * 0.6931471805599453f; }
DI float frcp(float x) { return __builtin_amdgcn_rcpf(x); }
DI float sigmoidf_(float x) { return frcp(1.f + fexp(-x)); }
DI float siluf_(float x) { return x * sigmoidf_(x); }
DI float gelu_tanh(float x) { const float u = 0.7978845608028654f * (x + 0.044715f * x * x * x); return x * sigmoidf_(2.f * u); }
DI float wave_sum(float v) {
#pragma unroll
    for (int o = 1; o < 64; o <<= 1) v += __shfl_xor(v, o);
    return v;
}
DI float wave_max(float v) {
#pragma unroll
    for (int o = 1; o < 64; o <<= 1) v = fmaxf(v, __shfl_xor(v, o));
    return v;
}
DI int red16_idx(int lane) { return 8 * ((lane >> 5) & 1) + 4 * ((lane >> 4) & 1) + 2 * ((lane >> 3) & 1) + ((lane >> 2) & 1); }
DI float red16(const float (&o)[16], int lane) {
    const bool b32 = lane & 32, b16 = lane & 16, b8 = lane & 8, b4 = lane & 4;
    float a8[8], a4[4], a2[2], a1;
#pragma unroll
    for (int j = 0; j < 8; ++j) { const float send = b32 ? o[j] : o[j + 8], keep = b32 ? o[j + 8] : o[j]; a8[j] = keep + __shfl_xor(send, 32); }
#pragma unroll
    for (int j = 0; j < 4; ++j) { const float send = b16 ? a8[j] : a8[j + 4], keep = b16 ? a8[j + 4] : a8[j]; a4[j] = keep + __shfl_xor(send, 16); }
#pragma unroll
    for (int j = 0; j < 2; ++j) { const float send = b8 ? a4[j] : a4[j + 2], keep = b8 ? a4[j + 2] : a4[j]; a2[j] = keep + __shfl_xor(send, 8); }
    { const float send = b4 ? a2[0] : a2[1], keep = b4 ? a2[1] : a2[0]; a1 = keep + __shfl_xor(send, 4); }
    a1 += __shfl_xor(a1, 2); a1 += __shfl_xor(a1, 1);
    return a1;
}
#define XB_TMO      128
#define XB_XCNT(j)  (256  + 64 * (j))
#define XB_XSUB(j)  (1280 + 64 * (j))
#define XB_XGEN(j)  (2304 + 64 * (j))
#define XB_TOP      3328
#define XB_TOPGEN   3392
#define XCD_BAR_WORDS 3456
#define XB_SPIN_CAP (1u << 18)

__device__ __forceinline__ unsigned xb_ld(unsigned* p)              { return __hip_atomic_load(p, __ATOMIC_RELAXED, __HIP_MEMORY_SCOPE_AGENT); }
__device__ __forceinline__ unsigned xb_add(unsigned* p, unsigned v) { return __hip_atomic_fetch_add(p, v, __ATOMIC_RELAXED, __HIP_MEMORY_SCOPE_AGENT); }
__device__ __forceinline__ unsigned xb_xcc_id() { return (unsigned)__builtin_amdgcn_s_getreg((3 << 11) | 20) & 0xFu; }
#define XB_SPIN(cond, bar) do { unsigned _sp = 0; while (cond) { __builtin_amdgcn_s_sleep(1); \
    if ((++_sp & 255u) == 0u) { if (xb_ld(&(bar)[XB_TMO])) break; if (_sp > XB_SPIN_CAP) { atomicAdd(&(bar)[XB_TMO], 1u); break; } } } } while (0)

struct XcdBarrier {
    unsigned* bar; unsigned x;
    volatile LAS unsigned* st;
};

__device__ __forceinline__ XcdBarrier xcd_barrier_post(unsigned* bar, volatile LAS unsigned* st) {
    XcdBarrier b; b.bar = bar; b.x = xb_xcc_id(); b.st = st;
    if (threadIdx.x == 0) (void)xb_add(&bar[XB_XCNT(b.x)], 1u);
    return b;
}
__device__ __forceinline__ void xcd_barrier_complete(unsigned* bar, unsigned x, unsigned& nloc, unsigned& nx) {
    const unsigned G = gridDim.x * gridDim.y * gridDim.z;
    unsigned sum, cnt, mine, sp = 0u;
    for (;;) {
        sum = 0u; cnt = 0u; mine = 0u;
#pragma unroll
        for (unsigned j = 0; j < 16; ++j) { const unsigned c = xb_ld(&bar[XB_XCNT(j)]); sum += c; cnt += (c > 0u) ? 1u : 0u; mine = (j == x) ? c : mine; }
        if (sum == G) break;
        __builtin_amdgcn_s_sleep(1);
        if ((++sp & 255u) == 0u) { if (xb_ld(&bar[XB_TMO])) break; if (sp > XB_SPIN_CAP) { atomicAdd(&bar[XB_TMO], 1u); break; } }
    }
    nloc = mine > 0u ? mine : 1u; nx = cnt > 0u ? cnt : 1u;
}

__device__ __forceinline__ void xcd_barrier(const XcdBarrier& b) {
    asm volatile("s_waitcnt vmcnt(0)" ::: "memory");
    __syncthreads();
    if (threadIdx.x == 0) {
        unsigned* bar = b.bar;
        __builtin_amdgcn_s_waitcnt(0);
        unsigned nloc = b.st[0], nx = b.st[1];
        if (nloc == 0u) { xcd_barrier_complete(bar, b.x, nloc, nx); b.st[0] = nloc; b.st[1] = nx; }
        const unsigned old = xb_add(&bar[XB_XSUB(b.x)], 1u);
        const unsigned gen = old / nloc;
        if (old + 1u == (gen + 1u) * nloc) {
            __builtin_amdgcn_fence(__ATOMIC_RELEASE, "agent");
            asm volatile("s_waitcnt vmcnt(0)" ::: "memory");
            const unsigned og = xb_add(&bar[XB_TOP], 1u);
            const unsigned tg = og / nx;
            if (og + 1u == (tg + 1u) * nx) xb_add(&bar[XB_TOPGEN], 1u);
            else XB_SPIN(xb_ld(&bar[XB_TOPGEN]) == tg, bar);
            __builtin_amdgcn_fence(__ATOMIC_ACQUIRE, "agent");
            xb_add(&bar[XB_XGEN(b.x)], 1u);
            asm volatile("s_waitcnt vmcnt(0)" ::: "memory");
        } else {
            XB_SPIN(xb_ld(&bar[XB_XGEN(b.x)]) == gen, bar);
            __builtin_amdgcn_fence(__ATOMIC_ACQUIRE, "agent");
            asm volatile("s_waitcnt vmcnt(0)" ::: "memory");
        }
    }
    __syncthreads();
}
constexpr int NWAVES = 8, NTHR = 512;
constexpr int BATCH = 2, SEQ = 8192, DM = 1024, MTOK = BATCH * SEQ;
constexpr int NIN = 3584;
constexpr int AW = 512;
constexpr int NEXP = 16, DFF = 1024, CAP = 1024, NROWS = BATCH * NEXP * CAP;
constexpr int NSC = 32, SCLEN = 256;
constexpr int NHEAD = 16, HD = 64, NQKV = 3072;
constexpr float EPS = 1e-6f;
constexpr int NPHASE = 22;

constexpr size_t MiB = 1u << 20;
constexpr size_t WS_CTL = 0, CTL_ZERO_BYTES = 1 * MiB;
constexpr size_t WS_AFF = 1 * MiB;
constexpr size_t WS_POS = 2 * MiB;
constexpr size_t WS_IDX = 3 * MiB;
constexpr size_t WS_GATE = 3 * MiB + 256 * 1024;
constexpr size_t WS_DEC = 3 * MiB + 512 * 1024;
constexpr size_t WS_LB = 4 * MiB;
constexpr size_t WS_BT = 4 * MiB + 64 * 1024;
constexpr size_t WS_WIN = 8 * MiB;
constexpr size_t WS_WOUT = 15 * MiB;
constexpr size_t WS_WQKV = 17 * MiB;
constexpr size_t WS_WO = 23 * MiB;
constexpr size_t WS_WGU = 32 * MiB;
constexpr size_t WS_WDN = 96 * MiB;
constexpr size_t WS_H = 128 * MiB;
constexpr size_t WS_R1 = 160 * MiB;
constexpr size_t WS_U = WS_R1, WS_GV = WS_R1 + 16 * MiB, WS_Q = WS_R1 + 32 * MiB, WS_V = WS_R1 + 48 * MiB, WS_G = WS_R1 + 64 * MiB;
constexpr size_t WS_LFF = WS_R1 + 80 * MiB, WS_LFB = WS_R1 + 112 * MiB;
constexpr size_t WS_CAT = WS_R1 + 144 * MiB;
constexpr size_t WS_ST = WS_R1 + 176 * MiB;
constexpr size_t WS_ODIR = WS_R1 + 208 * MiB;
constexpr size_t WS_XE = WS_R1, WS_Y = WS_R1;
constexpr size_t WS_HMID = WS_R1 + 64 * MiB;
constexpr size_t WS_QKV = WS_R1;
constexpr size_t WS_ATT = WS_R1 + 96 * MiB;
constexpr size_t WS_END = WS_R1 + 272 * MiB;
constexpr int CW_BAR = 4096;
constexpr int MAX_BAR_REGIONS = 24;

constexpr int RING_BYTES = 131072;
constexpr int LDSCTL_OFF = RING_BYTES, MISC_OFF = LDSCTL_OFF + 320;
constexpr int LDS_BYTES = 147456;

struct Args { const float* in[19]; float* out; unsigned char* ws; int ph_lo, ph_hi, li, pad; };

struct Frame {
    LAS unsigned char* lds;
    volatile LAS unsigned* MISC;
    int tid, lane, wave, G, bid, gw, NGW;
    unsigned char* ws;
};

template <int NPN_> struct GroupedOrder {
    int G, c;
    DI bool next(int i, pg8::Unit& u) const {
        const int L = i * G + c; if (L >= 16 * 8 * NPN_) return false;
        const int e = L / (8 * NPN_), w = L % (8 * NPN_);
        u.pm = e * 8 + (w & 7); u.pn = e * NPN_ + (w >> 3); return true;
    }
    DI void a_ready(const pg8::Unit&) const {}
    DI void done(const pg8::Unit&) const {}
};

struct EpiInProj {
    static constexpr bool PERM = true, AFTER_DRAIN = false;
    bf16 *U, *GV, *Q, *V, *G; float *LFf, *LFb; const float* LB;
    DI void operator()(const pg8::f32x4 (&acc)[2][2][4][2], const pg8::Unit& u, int wr, int wc, int fr, int fq) const {
        const int seg = u.pn >> 1;
        const int row0 = u.pm * 256 + wr * 64 + fr, lc0 = (u.pn & 1) * 256 + wc * 32 + 8 * fq;
#pragma unroll
        for (int bj = 0; bj < 2; ++bj) {
            const int lc = lc0 + bj * 128;
            float lb[8];
            if (seg == 3 || seg == 4) {
#pragma unroll
                for (int j = 0; j < 8; ++j) lb[j] = LB[(seg - 3) * 512 + lc + j];
            }
#pragma unroll
            for (int ai = 0; ai < 2; ++ai)
#pragma unroll
                for (int m = 0; m < 4; ++m) {
                    const size_t off = (size_t)(row0 + ai * 128 + m * 16) * 512 + lc;
                    float v[8];
#pragma unroll
                    for (int j = 0; j < 8; ++j) v[j] = acc[ai][bj][m][j >> 2][j & 3];
                    if (seg == 3 || seg == 4) {
#pragma unroll
                        for (int j = 0; j < 8; ++j) v[j] = flog(lb[j] + (1.f - lb[j]) * sigmoidf_(v[j]));
                        float* o = (seg == 3 ? LFf : LFb) + off;
                        *(f32x4*)o = (f32x4){v[0], v[1], v[2], v[3]}; *(f32x4*)(o + 4) = (f32x4){v[4], v[5], v[6], v[7]};
                    } else {
                        bf16* o;
                        if (seg == 0) { o = U;
#pragma unroll
                            for (int j = 0; j < 8; ++j) v[j] = gelu_tanh(v[j]);
                        } else if (seg == 1) { o = GV;
#pragma unroll
                            for (int j = 0; j < 8; ++j) v[j] = gelu_tanh(v[j]);
                        } else if (seg == 2) { o = Q;
#pragma unroll
                            for (int j = 0; j < 8; ++j) v[j] = siluf_(v[j]);
                        } else if (seg == 5) { o = V;
                        } else { o = G;
#pragma unroll
                            for (int j = 0; j < 8; ++j) v[j] = sigmoidf_(v[j]);
                        }
                        v4u w; w.x = pk2(v[0], v[1]); w.y = pk2(v[2], v[3]); w.z = pk2(v[4], v[5]); w.w = pk2(v[6], v[7]);
                        *(v4u*)(o + off) = w;
                    }
                }
        }
    }
};
struct EpiResid {
    static constexpr bool PERM = false, AFTER_DRAIN = false;
    const float* base; float* out;
    DI void operator()(const pg8::f32x4 (&acc)[2][2][4][2], const pg8::Unit& u, int wr, int wc, int fr, int fq) const {
        const int row0 = u.pm * 256 + wr * 64 + fr, col0 = u.pn * 256 + wc * 32 + 4 * fq;
#pragma unroll
        for (int ai = 0; ai < 2; ++ai)
#pragma unroll
            for (int m = 0; m < 4; ++m) { const size_t ro = (size_t)(row0 + ai * 128 + m * 16) * DM + col0;
#pragma unroll
                for (int bj = 0; bj < 2; ++bj)
#pragma unroll
                    for (int n = 0; n < 2; ++n) { const size_t o = ro + bj * 128 + n * 16; *(f32x4*)(out + o) = *(const f32x4*)(base + o) + acc[ai][bj][m][n]; } }
    }
};
struct EpiGateUp {
    static constexpr bool PERM = true, AFTER_DRAIN = false;
    bf16* H;
    DI void operator()(const pg8::f32x4 (&acc)[2][2][4][2], const pg8::Unit& u, int wr, int wc, int fr, int fq) const {
        const int pnl = u.pn & 7;
        const int row0 = u.pm * 256 + wr * 64 + fr, col0 = pnl * 128 + wc * 32 + 8 * fq;
#pragma unroll
        for (int ai = 0; ai < 2; ++ai)
#pragma unroll
            for (int m = 0; m < 4; ++m) {
                float v[8];
#pragma unroll
                for (int j = 0; j < 8; ++j) v[j] = siluf_(acc[ai][0][m][j >> 2][j & 3]) * acc[ai][1][m][j >> 2][j & 3];
                v4u w; w.x = pk2(v[0], v[1]); w.y = pk2(v[2], v[3]); w.z = pk2(v[4], v[5]); w.w = pk2(v[6], v[7]);
                *(v4u*)(H + (size_t)(row0 + ai * 128 + m * 16) * DFF + col0) = w;
            }
    }
};
struct EpiDown {
    static constexpr bool PERM = true, AFTER_DRAIN = false;
    bf16* Y; const float* gate;
    DI void operator()(const pg8::f32x4 (&acc)[2][2][4][2], const pg8::Unit& u, int wr, int wc, int fr, int fq) const {
        const int pnl = u.pn & 3;
        const int row0 = u.pm * 256 + wr * 64 + fr, col0 = pnl * 256 + wc * 32 + 8 * fq;
#pragma unroll
        for (int ai = 0; ai < 2; ++ai)
#pragma unroll
            for (int m = 0; m < 4; ++m) { const int row = row0 + ai * 128 + m * 16; const float g = gate[row];
#pragma unroll
                for (int bj = 0; bj < 2; ++bj) {
                    float v[8];
#pragma unroll
                    for (int j = 0; j < 8; ++j) v[j] = acc[ai][bj][m][j >> 2][j & 3] * g;
                    v4u w; w.x = pk2(v[0], v[1]); w.y = pk2(v[2], v[3]); w.z = pk2(v[4], v[5]); w.w = pk2(v[6], v[7]);
                    *(v4u*)(Y + (size_t)row * DM + col0 + bj * 128) = w; } }
    }
};
struct EpiQKV {
    static constexpr bool PERM = true, AFTER_DRAIN = false;
    bf16* O;
    DI void operator()(const pg8::f32x4 (&acc)[2][2][4][2], const pg8::Unit& u, int wr, int wc, int fr, int fq) const {
        const float sc = (u.pn < 4) ? 0.125f : 1.f;
        const int row0 = u.pm * 256 + wr * 64 + fr, col0 = u.pn * 256 + wc * 32 + 8 * fq;
#pragma unroll
        for (int ai = 0; ai < 2; ++ai)
#pragma unroll
            for (int m = 0; m < 4; ++m)
#pragma unroll
                for (int bj = 0; bj < 2; ++bj) {
                    float v[8];
#pragma unroll
                    for (int j = 0; j < 8; ++j) v[j] = acc[ai][bj][m][j >> 2][j & 3] * sc;
                    v4u w; w.x = pk2(v[0], v[1]); w.y = pk2(v[2], v[3]); w.z = pk2(v[4], v[5]); w.w = pk2(v[6], v[7]);
                    *(v4u*)(O + (size_t)(row0 + ai * 128 + m * 16) * NQKV + col0 + bj * 128) = w; }
    }
};

DI void transpose_item(const float* W, int K, int N, bf16* WT, LAS float* scr, int k0, int n0, int drow0, int lane) {
#pragma unroll 8
    for (int i = 0; i < 32; ++i) { const int kk = 2 * i + (lane >> 5); scr[kk * 33 + (lane & 31)] = W[(size_t)(k0 + kk) * N + n0 + (lane & 31)]; }
    LDS_WAIT(); asm volatile("" ::: "memory");
    const int c = lane & 7;
#pragma unroll
    for (int j = 0; j < 4; ++j) { const int n = (lane >> 3) + 8 * j; const LAS float* s = scr + (8 * c) * 33 + n;
        v4u o; o.x = pk2(s[0 * 33], s[1 * 33]); o.y = pk2(s[2 * 33], s[3 * 33]); o.z = pk2(s[4 * 33], s[5 * 33]); o.w = pk2(s[6 * 33], s[7 * 33]);
        *(v4u*)(WT + (size_t)(drow0 + n) * K + k0 + 8 * c) = o; }
    LDS_WAIT(); asm volatile("" ::: "memory");
}
DI void transpose_matrix(Frame& F, const float* W, int K, int N, bf16* WT) {
    LAS float* scr = (LAS float*)(F.lds + F.wave * 16384);
    const int nblk = N / 32, nitems = (K / 64) * nblk;
    for (int it = F.gw; it < nitems; it += F.NGW) { const int kb = it / nblk, nb = it % nblk; transpose_item(W, K, N, WT, scr, 64 * kb, 32 * nb, 32 * nb, F.lane); }
}
DI void convert_moe_weights(Frame& F, const float* wg, const float* wu, const float* wd, int layer) {
    LAS float* scr = (LAS float*)(F.lds + F.wave * 16384);
    bf16* WGU = (bf16*)(F.ws + WS_WGU); bf16* WDN = (bf16*)(F.ws + WS_WDN);
    for (int it = F.gw; it < 3 * 16 * 512; it += F.NGW) {
        const int mat = it / 8192, rem = it % 8192, e = rem / 512, r = rem % 512, kb = r / 32, nb = r % 32, n0 = 32 * nb;
        const size_t so = ((size_t)layer * 16 + e) * 1024 * 1024;
        if (mat == 0) transpose_item(wg + so, 1024, 1024, WGU + (size_t)e * 2048 * 1024, scr, 64 * kb, n0, (n0 >> 7) * 256 + (n0 & 127), F.lane);
        else if (mat == 1) transpose_item(wu + so, 1024, 1024, WGU + (size_t)e * 2048 * 1024, scr, 64 * kb, n0, (n0 >> 7) * 256 + 128 + (n0 & 127), F.lane);
        else transpose_item(wd + so, 1024, 1024, WDN + (size_t)e * 1024 * 1024, scr, 64 * kb, n0, n0, F.lane);
    }
}
DI void rms_row(const float* xrow, const float* g, f32x4 (&v)[4], int lane) {
    const f32x4* xr = (const f32x4*)xrow + lane; float s = 0.f;
#pragma unroll
    for (int j = 0; j < 4; ++j) { v[j] = xr[64 * j]; s += (v[j].x * v[j].x + v[j].y * v[j].y) + (v[j].z * v[j].z + v[j].w * v[j].w); }
    const float rstd = 1.f / sqrtf(wave_sum(s) * (1.f / DM) + EPS);
    const f32x4* gr = (const f32x4*)g + lane;
#pragma unroll
    for (int j = 0; j < 4; ++j) v[j] = v[j] * rstd * gr[64 * j];
}
DI void store_row_bf16(bf16* orow, const f32x4 (&v)[4], int lane) {
    v2u* o8 = (v2u*)orow + lane;
#pragma unroll
    for (int j = 0; j < 4; ++j) { v2u w; w.x = pk2(v[j].x, v[j].y); w.y = pk2(v[j].z, v[j].w); o8[64 * j] = w; }
}
DI int t5_bucket(int rel) {
    const int n = rel < 0 ? -rel : rel;
    int val;
    if (n < 8) val = n;
    else { const float sc = logf((float)n / 8.f) / 4.852030263919617f; int lg = 8 + (int)(sc * 8.f); val = lg < 15 ? lg : 15; }
    return (rel > 0 ? 16 : 0) + val;
}

DI void phase_prologue(Frame& F, const Args& a) {
    unsigned char* ws = F.ws;
    transpose_matrix(F, a.in[4], 1024, NIN, (bf16*)(ws + WS_WIN));
    transpose_matrix(F, a.in[5], 1024, 1024, (bf16*)(ws + WS_WOUT));
    transpose_matrix(F, a.in[12], 1024, NQKV, (bf16*)(ws + WS_WQKV));
    transpose_matrix(F, a.in[13], 1024, 1024, (bf16*)(ws + WS_WO));
    convert_moe_weights(F, a.in[16], a.in[17], a.in[18], 0);
    { float* LB = (float*)(ws + WS_LB); const float* t = a.in[10];
      for (int i = F.bid * NTHR + F.tid; i < 2 * 512; i += F.G * NTHR) { const int d = i / 512, k = i % 512;
          const float a0 = t[(d * 3 + 0) * 512 + k], a1 = t[(d * 3 + 1) * 512 + k], a2 = t[(d * 3 + 2) * 512 + k];
          const float mx = fmaxf(a0, fmaxf(a1, a2)); const float e0 = expf(a0 - mx), e1 = expf(a1 - mx), e2 = expf(a2 - mx);
          LB[i] = e0 / (e0 + e1 + e2); } }
    { float* BT = (float*)(ws + WS_BT); const float* rb = a.in[14];
      for (int i = F.bid * NTHR + F.tid; i < 3 * 16 * 129; i += F.G * NTHR) { const int p = i / (16 * 129), h = (i / 129) % 16, j = i % 129;
          const int dil = (p == 0) ? 1 : (p == 1 ? 4 : 16);
          BT[i] = rb[t5_bucket((j - 64) * dil) * 16 + h]; } }
    { bf16* H = (bf16*)(ws + WS_H); const float* x = a.in[0];
      for (int m = F.gw; m < MTOK; m += F.NGW) { f32x4 v[4]; rms_row(x + (size_t)m * DM, a.in[1], v, F.lane); store_row_bf16(H + (size_t)m * DM, v, F.lane); } }
}

DI void phase_a_ln(Frame& F, const Args& a) {
    bf16* GV = (bf16*)(F.ws + WS_GV); const float* lg = a.in[6]; const float* lbv = a.in[7];
    for (int m = F.gw; m < MTOK; m += F.NGW) {
        v4u w = *((const v4u*)(GV + (size_t)m * AW) + F.lane);
        float v[8] = {bflo(w.x), bfhi(w.x), bflo(w.y), bfhi(w.y), bflo(w.z), bfhi(w.z), bflo(w.w), bfhi(w.w)};
        float s = 0.f;
#pragma unroll
        for (int j = 0; j < 8; ++j) s += v[j];
        const float mu = wave_sum(s) * (1.f / AW); float s2 = 0.f;
#pragma unroll
        for (int j = 0; j < 8; ++j) { v[j] -= mu; s2 += v[j] * v[j]; }
        const float rstd = 1.f / sqrtf(wave_sum(s2) * (1.f / AW) + EPS);
#pragma unroll
        for (int j = 0; j < 8; ++j) v[j] = v[j] * rstd * lg[8 * F.lane + j] + lbv[8 * F.lane + j];
        v4u o; o.x = pk2(v[0], v[1]); o.y = pk2(v[2], v[3]); o.z = pk2(v[4], v[5]); o.w = pk2(v[6], v[7]);
        *((v4u*)(GV + (size_t)m * AW) + F.lane) = o;
    }
}
DI void phase_a_mix_naive(Frame& F, const Args& a) {
    const bf16* VN = (const bf16*)(F.ws + WS_GV); const bf16* U = (const bf16*)(F.ws + WS_U); bf16* CAT = (bf16*)(F.ws + WS_CAT);
    LAS float* wl = (LAS float*)F.lds; LAS float* vl = (LAS float*)(F.lds + 65536);
    for (int u = F.bid; u < 512; u += F.G) {
        const int g = u & 3, ch = u >> 2; const int row0 = ch * 128;
        __syncthreads();
        for (int i = F.tid; i < 128 * 128; i += NTHR) { wl[i] = a.in[8][g * 16384 + i]; const int s = i >> 7, c = i & 127; vl[i] = bf2f(VN[(size_t)(row0 + s) * AW + g * 128 + c]); }
        __syncthreads();
        const int c = F.tid & 127, tq = F.tid >> 7;
        for (int tt = 0; tt < 32; ++tt) { const int t = tq * 32 + tt; float acc = 0.f;
            for (int s = 0; s < 128; ++s) acc += wl[t * 128 + s] * vl[s * 128 + c];
            const float uu = bf2f(U[(size_t)(row0 + t) * AW + g * 128 + c]);
            CAT[(size_t)(row0 + t) * DM + g * 128 + c] = (bf16)f2bf(uu * (acc + a.in[9][g * 128 + t])); }
    }
}

DI void gla_naive_unit(Frame& F, int u, bool with_out) {
    const int sc = u & 31, dir = (u >> 5) & 1, h = (u >> 6) & 3, b = u >> 8;
    const bf16* Q = (const bf16*)(F.ws + WS_Q); const bf16* V = (const bf16*)(F.ws + WS_V);
    const float* LF = (const float*)(F.ws + (dir ? WS_LFB : WS_LFF));
    float* ST = (float*)(F.ws + WS_ST) + (size_t)u * 16384; float* DEC = (float*)(F.ws + WS_DEC) + u * 128;
    float* OD = (float*)(F.ws + WS_ODIR) + (size_t)dir * MTOK * AW;
    LAS bf16* qs = (LAS bf16*)F.lds; LAS bf16* vs = (LAS bf16*)(F.lds + 16384); LAS float* lfs = (LAS float*)(F.lds + 32768);
    const int lane = F.lane, w = F.wave;
    float S[2][16]; float lsum[2] = {0.f, 0.f};
#pragma unroll
    for (int aa = 0; aa < 2; ++aa)
#pragma unroll
        for (int j = 0; j < 16; ++j) S[aa][j] = with_out ? ST[(lane + 64 * aa) * 128 + 16 * w + j] : 0.f;
    for (int sub = 0; sub < 4; ++sub) {
        __syncthreads();
        for (int idx = F.tid; idx < 1024; idx += NTHR) { const int i = idx >> 4, c8 = (idx & 15) * 8; const int ii = sc * 256 + sub * 64 + i; const int tok = dir ? (SEQ - 1 - ii) : ii;
            const size_t go = (size_t)(b * SEQ + tok) * AW + h * 128 + c8;
            *(LAS v4u*)(qs + i * 128 + c8) = *(const v4u*)(Q + go); *(LAS v4u*)(vs + i * 128 + c8) = *(const v4u*)(V + go); }
        for (int idx = F.tid; idx < 2048; idx += NTHR) { const int i = idx >> 5, c4 = (idx & 31) * 4; const int ii = sc * 256 + sub * 64 + i; const int tok = dir ? (SEQ - 1 - ii) : ii;
            *(LAS f32x4*)(lfs + i * 128 + c4) = *(const f32x4*)(LF + (size_t)(b * SEQ + tok) * AW + h * 128 + c4); }
        __syncthreads();
        for (int i = 0; i < 64; ++i) {
            const float l0 = lfs[i * 128 + lane], l1 = lfs[i * 128 + lane + 64];
            const float f0 = fexp(l0), f1 = fexp(l1), k0 = 1.f - f0, k1 = 1.f - f1;
            lsum[0] += l0; lsum[1] += l1;
            float vv[16];
            { const v4u a0 = *(const LAS v4u*)(vs + i * 128 + 16 * w), a1 = *(const LAS v4u*)(vs + i * 128 + 16 * w + 8);
              vv[0] = bflo(a0.x); vv[1] = bfhi(a0.x); vv[2] = bflo(a0.y); vv[3] = bfhi(a0.y); vv[4] = bflo(a0.z); vv[5] = bfhi(a0.z); vv[6] = bflo(a0.w); vv[7] = bfhi(a0.w);
              vv[8] = bflo(a1.x); vv[9] = bfhi(a1.x); vv[10] = bflo(a1.y); vv[11] = bfhi(a1.y); vv[12] = bflo(a1.z); vv[13] = bfhi(a1.z); vv[14] = bflo(a1.w); vv[15] = bfhi(a1.w); }
#pragma unroll
            for (int j = 0; j < 16; ++j) { S[0][j] = f0 * S[0][j] + k0 * vv[j]; S[1][j] = f1 * S[1][j] + k1 * vv[j]; }
            if (with_out) {
                const float q0 = bf2f(qs[i * 128 + lane]), q1 = bf2f(qs[i * 128 + lane + 64]);
                float o[16];
#pragma unroll
                for (int j = 0; j < 16; ++j) o[j] = S[0][j] * q0 + S[1][j] * q1;
                const float tot = red16(o, lane);
                if ((lane & 3) == 0) { const int ii = sc * 256 + sub * 64 + i; const int tok = dir ? (SEQ - 1 - ii) : ii;
                    OD[(size_t)(b * SEQ + tok) * AW + h * 128 + 16 * w + red16_idx(lane)] = tot; }
            }
        }
    }
    if (!with_out) {
#pragma unroll
        for (int aa = 0; aa < 2; ++aa)
#pragma unroll
            for (int j = 0; j < 16; ++j) ST[(lane + 64 * aa) * 128 + 16 * w + j] = S[aa][j];
        if (w == 0) { DEC[lane] = fexp(lsum[0]); DEC[lane + 64] = fexp(lsum[1]); }
    }
}
DI void phase_gla_scan(Frame& F) {
    float* ST = (float*)(F.ws + WS_ST); const float* DEC = (const float*)(F.ws + WS_DEC);
    for (int idx = F.bid * NTHR + F.tid; idx < 16 * 16384; idx += F.G * NTHR) {
        const int chain = idx >> 14, kv = idx & 16383, k = kv >> 7; float S = 0.f;
        for (int sc = 0; sc < NSC; ++sc) { const int u = chain * NSC + sc; const size_t o = (size_t)u * 16384 + kv; const float d = ST[o]; ST[o] = S; S = S * DEC[u * 128 + k] + d; }
    }
}
DI void phase_b_combine(Frame& F, const Args& a) {
    const float* OD = (const float*)(F.ws + WS_ODIR); const bf16* G = (const bf16*)(F.ws + WS_G); bf16* CAT = (bf16*)(F.ws + WS_CAT); const float* ng = a.in[11];
    for (int t = F.gw; t < MTOK * 4; t += F.NGW) { const int row = t >> 2, h = t & 3; const size_t o = (size_t)row * AW + h * 128 + 2 * F.lane;
        const float o0 = OD[o] + OD[(size_t)MTOK * AW + o], o1 = OD[o + 1] + OD[(size_t)MTOK * AW + o + 1];
        const float rstd = 1.f / sqrtf(wave_sum(o0 * o0 + o1 * o1) * (1.f / 128.f) + EPS);
        const unsigned gw2 = *(const unsigned*)(G + o);
        const float r0 = o0 * rstd * ng[h * 128 + 2 * F.lane] * bflo(gw2), r1 = o1 * rstd * ng[h * 128 + 2 * F.lane + 1] * bfhi(gw2);
        *(unsigned*)(CAT + (size_t)row * DM + 512 + h * 128 + 2 * F.lane) = pk2(r0, r1); }
}

DI void phase_router(Frame& F, const float* XR, const float* gn, const float* wr) {
    LAS float* wl = (LAS float*)F.lds;
    __syncthreads();
    for (int i = F.tid; i < 1024 * 16 / 4; i += NTHR) *(LAS f32x4*)(wl + 4 * i) = *(const f32x4*)(wr + 4 * i);
    __syncthreads();
    bf16* H = (bf16*)(F.ws + WS_H); float* AFF = (float*)(F.ws + WS_AFF);
    for (int m = F.gw; m < MTOK; m += F.NGW) {
        asm volatile("" ::: "memory");
        f32x4 v[4]; rms_row(XR + (size_t)m * DM, gn, v, F.lane); store_row_bf16(H + (size_t)m * DM, v, F.lane);
        float p[16];
#pragma unroll
        for (int e = 0; e < 16; ++e) p[e] = 0.f;
#pragma unroll
        for (int j = 0; j < 4; ++j)
#pragma unroll
            for (int q = 0; q < 4; ++q) { const int d = 4 * F.lane + 256 * j + q; const float xv = v[j][q];
#pragma unroll
                for (int e4 = 0; e4 < 4; ++e4) { const f32x4 w4 = *(const LAS f32x4*)(wl + d * 16 + 4 * e4); p[4 * e4] += xv * w4.x; p[4 * e4 + 1] += xv * w4.y; p[4 * e4 + 2] += xv * w4.z; p[4 * e4 + 3] += xv * w4.w; } }
        const float lg = red16(p, F.lane);
        const float mx = wave_max(lg); const float ex = expf(lg - mx); const float sm = wave_sum(ex) * 0.25f;
        if ((F.lane & 3) == 0) { const int b = m / SEQ, s = m % SEQ; AFF[(size_t)(b * 16 + red16_idx(F.lane)) * SEQ + s] = ex / sm; }
    }
}

DI int block_excl_scan(int v, LAS int* scratch, int tid, int lane, int wave, int* tot) {
    int inc = v;
#pragma unroll
    for (int o = 1; o < 64; o <<= 1) { const int t = __shfl_up(inc, o); if (lane >= o) inc += t; }
    __syncthreads();
    if (lane == 63) scratch[wave] = inc;
    __syncthreads();
    int base = 0, total = 0;
#pragma unroll
    for (int w = 0; w < NWAVES; ++w) { const int s = scratch[w]; if (w < wave) base += s; total += s; }
    *tot = total;
    return base + inc - v;
}
DI void phase_topk(Frame& F) {
    const float* AFF = (const float*)(F.ws + WS_AFF); int* IDX = (int*)(F.ws + WS_IDX); float* GATE = (float*)(F.ws + WS_GATE); int* POS = (int*)(F.ws + WS_POS);
    LAS unsigned* hist = (LAS unsigned*)F.lds; LAS int* sc = (LAS int*)(F.lds + 2048); LAS unsigned* shv = (LAS unsigned*)(F.lds + 2048 + 256);
    for (int u = F.bid; u < BATCH * NEXP; u += F.G) {
        const int b = u / NEXP, e = u % NEXP;
        unsigned vals[16];
        { const v4u* src = (const v4u*)(AFF + (size_t)u * SEQ + 16 * F.tid);
#pragma unroll
          for (int j = 0; j < 4; ++j) { const v4u t = src[j]; vals[4 * j] = t.x; vals[4 * j + 1] = t.y; vals[4 * j + 2] = t.z; vals[4 * j + 3] = t.w; } }
        unsigned prefix = 0; int krem = CAP;
        for (int pass = 0; pass < 4; ++pass) { const int shift = 24 - 8 * pass;
            __syncthreads();
            if (F.tid < 256) hist[F.tid] = 0u;
            __syncthreads();
#pragma unroll
            for (int j = 0; j < 16; ++j) { const unsigned v = vals[j]; if (pass == 0 || (v >> (shift + 8)) == prefix) __hip_atomic_fetch_add(&hist[(v >> shift) & 255u], 1u, __ATOMIC_RELAXED, __HIP_MEMORY_SCOPE_WORKGROUP); }
            __syncthreads();
            if (F.tid == 0) { int cum = 0, sel = 0; for (int bin = 255; bin >= 0; --bin) { const int c = (int)hist[bin]; if (cum + c >= krem) { sel = bin; break; } cum += c; }
                shv[0] = (prefix << 8) | (unsigned)sel; shv[1] = (unsigned)(krem - cum); }
            __syncthreads();
            prefix = shv[0]; krem = (int)shv[1];
        }
        const unsigned T = prefix;
        int ce = 0;
#pragma unroll
        for (int j = 0; j < 16; ++j) ce += (vals[j] == T) ? 1 : 0;
        int tot; int pe = block_excl_scan(ce, sc, F.tid, F.lane, F.wave, &tot);
        unsigned selmask = 0; int cs = 0;
#pragma unroll
        for (int j = 0; j < 16; ++j) { bool s = vals[j] > T; if (vals[j] == T) { s = pe < krem; ++pe; } if (s) { selmask |= 1u << j; ++cs; } }
        int slot = block_excl_scan(cs, sc, F.tid, F.lane, F.wave, &tot);
#pragma unroll
        for (int j = 0; j < 16; ++j) { const int s = 16 * F.tid + j; const int tokrow = b * SEQ + s;
            if (selmask & (1u << j)) { const int row = (e * 2 + b) * CAP + slot; ++slot; IDX[row] = tokrow; GATE[row] = __builtin_bit_cast(float, vals[j]); POS[tokrow * 16 + e] = row; }
            else POS[tokrow * 16 + e] = -1; }
    }
}
DI void phase_gather(Frame& F) {
    const bf16* H = (const bf16*)(F.ws + WS_H); bf16* XE = (bf16*)(F.ws + WS_XE); const int* IDX = (const int*)(F.ws + WS_IDX);
    for (int r = F.gw; r < NROWS; r += F.NGW) { const int src = IDX[r];
        const v4u* s = (const v4u*)(H + (size_t)src * DM) + F.lane; v4u* d = (v4u*)(XE + (size_t)r * DM) + F.lane;
        d[0] = s[0]; d[64] = s[64]; }
}
DI void phase_moe_combine(Frame& F, float* XR, const float* gnext, bool final_out) {
    const bf16* Y = (const bf16*)(F.ws + WS_Y); const int* POS = (const int*)(F.ws + WS_POS); bf16* H = (bf16*)(F.ws + WS_H);
    for (int m = F.gw; m < MTOK; m += F.NGW) {
        f32x4* xr = (f32x4*)(XR + (size_t)m * DM) + F.lane;
        f32x4 v[4];
#pragma unroll
        for (int j = 0; j < 4; ++j) v[j] = xr[64 * j];
        const int pmine = POS[m * 16 + (F.lane & 15)];
        for (int e = 0; e < 16; ++e) { const int p = __shfl(pmine, e);
            if (p >= 0) { const v2u* yr = (const v2u*)(Y + (size_t)p * DM) + F.lane;
#pragma unroll
                for (int j = 0; j < 4; ++j) { const v2u w = yr[64 * j]; v[j].x += bflo(w.x); v[j].y += bfhi(w.x); v[j].z += bflo(w.y); v[j].w += bfhi(w.y); } } }
        float s = 0.f;
#pragma unroll
        for (int j = 0; j < 4; ++j) s += (v[j].x * v[j].x + v[j].y * v[j].y) + (v[j].z * v[j].z + v[j].w * v[j].w);
        const float rstd = 1.f / sqrtf(wave_sum(s) * (1.f / DM) + EPS);
        const f32x4* gr = (const f32x4*)gnext + F.lane;
        if (final_out) {
#pragma unroll
            for (int j = 0; j < 4; ++j) xr[64 * j] = v[j] * rstd * gr[64 * j];
        } else {
#pragma unroll
            for (int j = 0; j < 4; ++j) xr[64 * j] = v[j];
            f32x4 nv[4];
#pragma unroll
            for (int j = 0; j < 4; ++j) nv[j] = v[j] * rstd * gr[64 * j];
            store_row_bf16(H + (size_t)m * DM, nv, F.lane);
        }
    }
}

DI void phase_attn_naive(Frame& F) {
    const bf16* QKV = (const bf16*)(F.ws + WS_QKV); bf16* ATT = (bf16*)(F.ws + WS_ATT); const float* BT = (const float*)(F.ws + WS_BT);
    LAS float* ql = (LAS float*)(F.lds + F.wave * 4096);
    LAS float* pl = ql + 64; LAS int* posl = (LAS int*)(ql + 512);
    const int lane = F.lane;
    for (int t = F.gw; t < MTOK * NHEAD; t += F.NGW) {
        const int row = t >> 4, h = t & 15, b = row / SEQ, tq = row % SEQ;
        ql[lane] = bf2f(QKV[(size_t)row * NQKV + h * 64 + lane]);
        LDS_WAIT();
        float s[7]; int pos[7];
#pragma unroll
        for (int i = 0; i < 7; ++i) {
            const int slot = lane + 64 * i; const int p = slot / 129, j = slot % 129;
            const int dil = (p == 0) ? 1 : (p == 1 ? 4 : 16);
            const int mq = tq / dil, r = tq % dil, mk = mq - 64 + j;
            const bool valid = (slot < 387) && (mk >= 0) && (mk < SEQ / dil);
            pos[i] = valid ? (b * SEQ + r + dil * mk) : -1;
            float d = -1e30f;
            if (valid) { const v4u* kr = (const v4u*)(QKV + (size_t)pos[i] * NQKV + 1024 + h * 64); float acc = 0.f;
#pragma unroll
                for (int c = 0; c < 8; ++c) { const v4u w = kr[c];
                    acc += ql[8 * c] * bflo(w.x) + ql[8 * c + 1] * bfhi(w.x) + ql[8 * c + 2] * bflo(w.y) + ql[8 * c + 3] * bfhi(w.y) + ql[8 * c + 4] * bflo(w.z) + ql[8 * c + 5] * bfhi(w.z) + ql[8 * c + 6] * bflo(w.w) + ql[8 * c + 7] * bfhi(w.w); }
                d = acc + BT[(p * 16 + h) * 129 + j]; }
            s[i] = d;
        }
        float mx = s[0];
#pragma unroll
        for (int i = 1; i < 7; ++i) mx = fmaxf(mx, s[i]);
        mx = wave_max(mx);
        float sum = 0.f;
#pragma unroll
        for (int i = 0; i < 7; ++i) { const float pv = (pos[i] >= 0) ? expf(s[i] - mx) : 0.f; sum += pv; pl[lane + 64 * i] = pv; posl[lane + 64 * i] = pos[i]; }
        sum = wave_sum(sum);
        LDS_WAIT();
        float o = 0.f;
        for (int k = 0; k < 387; ++k) { const int pp = posl[k]; if (pp >= 0) o += pl[k] * bf2f(QKV[(size_t)pp * NQKV + 2048 + h * 64 + lane]); }
        ATT[(size_t)row * DM + h * 64 + lane] = (bf16)f2bf(o / sum);
        LDS_WAIT();
    }
}

__global__ void __launch_bounds__(NTHR, 2) fwd_kernel(Args args) {
    extern __shared__ __attribute__((aligned(16))) unsigned char lds[];
    Frame F;
    F.lds = (LAS unsigned char*)lds;
    F.MISC = (volatile LAS unsigned*)(F.lds + MISC_OFF);
    F.tid = threadIdx.x; F.lane = F.tid & 63; F.wave = __builtin_amdgcn_readfirstlane(F.tid >> 6);
    F.G = gridDim.x; F.bid = blockIdx.x; F.gw = F.bid * NWAVES + F.wave; F.NGW = F.G * NWAVES;
    F.ws = args.ws;
    unsigned* ctl = (unsigned*)(args.ws + WS_CTL);
    for (int u = F.tid; u < (LDS_BYTES - LDSCTL_OFF) / 4; u += NTHR) ((LAS unsigned*)(F.lds + LDSCTL_OFF))[u] = 0u;
    __syncthreads();
    const int lo = args.ph_lo, hi = args.ph_hi;
    XcdBarrier bar; bar.bar = ctl + CW_BAR + args.li * XCD_BAR_WORDS; bar.x = 0; bar.st = nullptr;
    if (hi - lo > 1) bar = xcd_barrier_post(ctl + CW_BAR + args.li * XCD_BAR_WORDS, F.MISC + 8);
#define IN(k) (lo <= (k) && (k) < hi)
#define SEAM(k) do { if (IN(k) && IN((k) + 1)) xcd_barrier(bar); } while (0)
    unsigned char* ws = args.ws;
    float* XR = args.out;

    if (IN(0)) { phase_prologue(F, args); } SEAM(0);
    if (IN(1)) {
        pg8::Gemm g{(const bf16*)(ws + WS_H), (const bf16*)(ws + WS_WIN), MTOK, NIN, DM}; pg8::StaticOrder S; S.init(MTOK, NIN, F.G, F.bid);
        EpiInProj E{(bf16*)(ws + WS_U), (bf16*)(ws + WS_GV), (bf16*)(ws + WS_Q), (bf16*)(ws + WS_V), (bf16*)(ws + WS_G), (float*)(ws + WS_LFF), (float*)(ws + WS_LFB), (const float*)(ws + WS_LB)};
        pg8::gemm_phase<EpiInProj, pg8::StaticOrder, true, true>(F.lds, g, S, E);
    } SEAM(1);
    if (IN(2)) { phase_a_ln(F, args); for (int u = F.bid; u < 512; u += F.G) gla_naive_unit(F, u, false); } SEAM(2);
    if (IN(3)) { phase_gla_scan(F); phase_a_mix_naive(F, args); } SEAM(3);
    if (IN(4)) { for (int u = F.bid; u < 512; u += F.G) gla_naive_unit(F, u, true); } SEAM(4);
    if (IN(5)) { phase_b_combine(F, args); } SEAM(5);
    if (IN(6)) {
        pg8::Gemm g{(const bf16*)(ws + WS_CAT), (const bf16*)(ws + WS_WOUT), MTOK, DM, DM}; pg8::StaticOrder S; S.init(MTOK, DM, F.G, F.bid);
        EpiResid E{args.in[0], XR};
        pg8::gemm_phase<EpiResid, pg8::StaticOrder, false, true>(F.lds, g, S, E);
    } SEAM(6);
#define MOE_BLOCK(L, pb) do { \
        if (IN(pb)) { phase_router(F, XR, args.in[2] + (L) * DM, args.in[15] + (L) * DM * NEXP); } SEAM(pb); \
        if (IN((pb) + 1)) { phase_topk(F); } SEAM((pb) + 1); \
        if (IN((pb) + 2)) { phase_gather(F); } SEAM((pb) + 2); \
        if (IN((pb) + 3)) { \
            pg8::Gemm g{(const bf16*)(ws + WS_XE), (const bf16*)(ws + WS_WGU), NROWS, 16 * 2048, DM}; GroupedOrder<8> S{F.G, F.bid}; \
            EpiGateUp E{(bf16*)(ws + WS_HMID)}; \
            pg8::gemm_phase<EpiGateUp, GroupedOrder<8>, true, true>(F.lds, g, S, E); \
        } SEAM((pb) + 3); \
        if (IN((pb) + 4)) { \
            pg8::Gemm g{(const bf16*)(ws + WS_HMID), (const bf16*)(ws + WS_WDN), NROWS, 16 * 1024, DFF}; GroupedOrder<4> S{F.G, F.bid}; \
            EpiDown E{(bf16*)(ws + WS_Y), (const float*)(ws + WS_GATE)}; \
            pg8::gemm_phase<EpiDown, GroupedOrder<4>, true, true>(F.lds, g, S, E); \
        } SEAM((pb) + 4); \
    } while (0)

    MOE_BLOCK(0, 7);
    if (IN(12)) { phase_moe_combine(F, XR, args.in[1] + DM, false); convert_moe_weights(F, args.in[16], args.in[17], args.in[18], 1); } SEAM(12);
    if (IN(13)) {
        pg8::Gemm g{(const bf16*)(ws + WS_H), (const bf16*)(ws + WS_WQKV), MTOK, NQKV, DM}; pg8::StaticOrder S; S.init(MTOK, NQKV, F.G, F.bid);
        EpiQKV E{(bf16*)(ws + WS_QKV)};
        pg8::gemm_phase<EpiQKV, pg8::StaticOrder, true, true>(F.lds, g, S, E);
    } SEAM(13);
    if (IN(14)) { phase_attn_naive(F); } SEAM(14);
    if (IN(15)) {
        pg8::Gemm g{(const bf16*)(ws + WS_ATT), (const bf16*)(ws + WS_WO), MTOK, DM, DM}; pg8::StaticOrder S; S.init(MTOK, DM, F.G, F.bid);
        EpiResid E{XR, XR};
        pg8::gemm_phase<EpiResid, pg8::StaticOrder, false, true>(F.lds, g, S, E);
    } SEAM(15);
    MOE_BLOCK(1, 16);
    if (IN(21)) { phase_moe_combine(F, XR, args.in[3], true); }
#undef MOE_BLOCK
#undef IN
#undef SEAM
}

#ifndef MK_N_LAUNCHES
#define MK_N_LAUNCHES 22
#endif
extern "C" void kernel_launch(void* const* d_in, const int* in_sizes, int n_in, void* d_out, int out_size, void* d_ws, size_t ws_size, hipStream_t stream) {
    static int grid = 0;
    if (grid == 0) {
        if (n_in != 19 || in_sizes[0] != MTOK * DM || out_size != MTOK * DM || ws_size < WS_END) { fprintf(stderr, "kernel_launch: unexpected shapes (n_in %d, in0 %d, out %d, ws %zu < %zu); nothing launched\n", n_in, n_in > 0 ? in_sizes[0] : -1, out_size, ws_size, (size_t)WS_END); grid = -1; return; }
        int dev = 0, cus = 0, per_cu = 0;
        if (hipGetDevice(&dev) != hipSuccess || hipDeviceGetAttribute(&cus, hipDeviceAttributeMultiprocessorCount, dev) != hipSuccess) { grid = -1; return; }
        if (hipFuncSetAttribute((const void*)fwd_kernel, hipFuncAttributeMaxDynamicSharedMemorySize, LDS_BYTES) != hipSuccess) { fprintf(stderr, "kernel_launch: hipFuncSetAttribute failed\n"); grid = -1; return; }
        if (hipOccupancyMaxActiveBlocksPerMultiprocessor(&per_cu, (const void*)fwd_kernel, NTHR, LDS_BYTES) != hipSuccess || per_cu < 1) { fprintf(stderr, "kernel_launch: occupancy query reports %d workgroups per CU\n", per_cu); }
        (void)hipGetLastError();
        grid = cus;
    }
    if (grid < 0) return;
    if (hipMemsetAsync((char*)d_ws + WS_CTL, 0, CTL_ZERO_BYTES, stream) != hipSuccess) return;
    Args a{};
    for (int i = 0; i < 19; ++i) a.in[i] = (const float*)d_in[i];
    a.out = (float*)d_out; a.ws = (unsigned char*)d_ws; a.pad = 0;
    static_assert(CW_BAR + MAX_BAR_REGIONS * XCD_BAR_WORDS <= (int)(CTL_ZERO_BYTES / 4), "barrier regions inside the memset region");
    const int nl = MK_N_LAUNCHES;
    for (int li = 0; li < nl; ++li) {
        a.ph_lo = (int)((long)NPHASE * li / nl); a.ph_hi = (int)((long)NPHASE * (li + 1) / nl); a.li = li;
        hipLaunchKernelGGL(fwd_kernel, dim3(grid), dim3(NTHR), LDS_BYTES, stream, a);
        const hipError_t le = hipPeekAtLastError();
        if (le != hipSuccess) { fprintf(stderr, "kernel_launch: launch %d failed: %s\n", li, hipGetErrorName(le)); break; }
    }
}
```

```cpp
#include <hip/hip_runtime.h>
#include <cstdio>
#include <cstdint>
namespace pg8 {
#define PG8_LAS __attribute__((address_space(3)))
typedef unsigned short bf16_t;
typedef short bf16x8 __attribute__((ext_vector_type(8)));
typedef float f32x4 __attribute__((ext_vector_type(4)));
typedef unsigned u32x4 __attribute__((ext_vector_type(4)));
constexpr int BM = 256, BK = 64, HALF = 128, HTB = HALF * BK * 2  , STAGE_BYTES = 8 * HTB, NXCD = 8, WGM = 8;

__host__ __device__ __forceinline__ int lds_byte(int r, int c) { const int st = (r >> 4) * 2 + (c >> 5), rr = r & 15, cc = c & 31, ob = rr * 64 + cc * 2; return st * 1024 + (ob ^ (((ob >> 9) & 1) << 5)); }
__host__ __device__ __forceinline__ void stage_rc(int b, int& R, int& C) { const int st = b / 1024, sb = b % 1024, swz = sb ^ (((sb >> 9) & 1) << 5); R = (st >> 1) * 16 + swz / 64; C = (st & 1) * 32 + (swz % 64) / 2; }
__host__ __device__ __forceinline__ int perm32(int rho) { const int n = rho >> 4, i = rho & 15; return 8 * (i >> 2) + 4 * n + (i & 3); }

struct Unit { int pm, pn; };
struct Gemm { const bf16_t* A; const bf16_t* Bt; int M, N, K; };

struct StaticOrder {
    int nM, nN, nwg, G, c;
    __host__ __device__ void init(int M, int N, int G_, int c_) { nM = M / BM; nN = N / BM; nwg = nM * nN; G = G_; c = c_; }
    __host__ __device__ bool next(int i, Unit& u) const {
        const long L = (long)i * G + c; if (L >= nwg) return false;
        int wgid = (int)L; { const int q = nwg / NXCD, r = nwg % NXCD, xcd = wgid % NXCD, off = wgid / NXCD; wgid = (xcd < r ? xcd * (q + 1) : r * (q + 1) + (xcd - r) * q) + off; }
        const int nig = WGM * nN, gid = wgid / nig, fm = gid * WGM, gsz = (nM - fm) < WGM ? (nM - fm) : WGM;
        u.pm = fm + ((wgid % nig) % gsz); u.pn = (wgid % nig) / gsz; return true;
    }
    __device__ __forceinline__ void a_ready(const Unit&) const {}
    __device__ __forceinline__ void done(const Unit&) const {}
};

__device__ __forceinline__ unsigned cvt_pk_bf16(float lo, float hi) { unsigned r; asm volatile("v_cvt_pk_bf16_f32 %0, %1, %2" : "=v"(r) : "v"(lo), "v"(hi)); return r; }
typedef float f32x2 __attribute__((ext_vector_type(2)));
__device__ __forceinline__ f32x2 gelu_pk(f32x2 v) {
    const f32x2 av = __builtin_elementwise_abs(v), d = av * 0.2316418882f + 1.0f;
    f32x2 t; t.x = __builtin_amdgcn_rcpf(d.x); t.y = __builtin_amdgcn_rcpf(d.y);
    f32x2 q = t * 0.5307027145f + (-0.7265760135f); q = q * t + 0.7107068705f; q = q * t + (-0.142248368f); q = q * t + 0.127414796f; q = q * t;
    const f32x2 s = (v * v) * (-0.72134752044f);
    f32x2 e; e.x = __builtin_amdgcn_exp2f(s.x); e.y = __builtin_amdgcn_exp2f(s.y);
    const f32x2 m = v * (q * e), r = v - m;
    f32x2 o; o.x = v.x < 0.f ? m.x : r.x; o.y = v.y < 0.f ? m.y : r.y; return o;
}

template <int ACT  > struct EpiBf16 {
    static constexpr bool PERM = true, AFTER_DRAIN = false; static_assert(ACT == 0 || ACT == 1, "EpiBf16: ACT is 0 (none) or 1 (gelu_pk)");
    bf16_t* O; int ldc; const float* bias; int split_cols; size_t split_stride; float scale0;
    __device__ __forceinline__ void operator()(const f32x4 (&acc)[2][2][4][2], const Unit& u, int wr, int wc, int fr, int fq) const {
        const int row0 = u.pm * BM + wr * 64 + fr; int colt = u.pn * BM; bf16_t* base = O;
        float sc = 1.f; if (split_cols) { const int t = colt / split_cols; base += (size_t)t * split_stride; colt -= t * split_cols; if (t == 0) sc = scale0; }
        const int col0 = colt + wc * 32 + 8 * fq, bcol0 = u.pn * BM + wc * 32 + 8 * fq;
        f32x4 bv[2][2];
#pragma unroll
        for (int bj = 0; bj < 2; ++bj)
#pragma unroll
            for (int n = 0; n < 2; ++n) bv[bj][n] = bias ? *(const f32x4*)(bias + bcol0 + bj * HALF + 4 * n) : (f32x4){0.f, 0.f, 0.f, 0.f};
#pragma unroll
        for (int ai = 0; ai < 2; ++ai)
#pragma unroll
            for (int m = 0; m < 4; ++m) { bf16_t* rowp = base + (size_t)(row0 + ai * HALF + m * 16) * ldc + col0;
#pragma unroll
                for (int bj = 0; bj < 2; ++bj) { f32x4 v0 = acc[ai][bj][m][0] + bv[bj][0], v1 = acc[ai][bj][m][1] + bv[bj][1];
                    if (ACT == 1) { f32x2 a = gelu_pk((f32x2){v0[0], v0[1]}), b = gelu_pk((f32x2){v0[2], v0[3]}), c = gelu_pk((f32x2){v1[0], v1[1]}), d = gelu_pk((f32x2){v1[2], v1[3]});
                        v0 = (f32x4){a.x, a.y, b.x, b.y}; v1 = (f32x4){c.x, c.y, d.x, d.y}; }
                    v0 = v0 * sc; v1 = v1 * sc; u32x4 w; w.x = cvt_pk_bf16(v0[0], v0[1]); w.y = cvt_pk_bf16(v0[2], v0[3]); w.z = cvt_pk_bf16(v1[0], v1[1]); w.w = cvt_pk_bf16(v1[2], v1[3]);
                    *(u32x4*)(rowp + bj * HALF) = w; } }
    }
};
template <class Epi, class Sched, bool ALIGN_EPI = false, bool SP2 = false>
__device__ __forceinline__ void gemm_phase(PG8_LAS unsigned char* lds, const Gemm g, const Sched& S, const Epi& E) {
    const int tid = threadIdx.x, wid = __builtin_amdgcn_readfirstlane(tid >> 6), lane = tid & 63, wr = wid >> 2, wc = wid & 3, fr = lane & 15, fq = lane >> 4;
    const int K = g.K, nt = K / BK;
    unsigned voffA[2], voffB[2];
#pragma unroll
    for (int i = 0; i < 2; ++i) { int R, C; stage_rc(tid * 16 + i * 8192, R, C); const int Rb = Epi::PERM ? ((R & ~31) + perm32(R & 31)) : R;
        voffA[i] = (unsigned)(R * K + C) * 2u; voffB[i] = (unsigned)(Rb * K + C) * 2u; }
    const size_t kstep = (size_t)(BK * 2);
    const size_t hstep = (size_t)HALF * K * 2;
    const size_t tstep = 2 * hstep;
    const unsigned ldsw = (unsigned)wid * 1024u;
    const int aoff = lds_byte(wr * 64 + fr, fq * 8), boff = lds_byte(wc * 32 + fr, fq * 8);
#define PG8_SA(b, h) (((b) * 2 + (h)) * HTB)
#define PG8_SB(b, h) ((4 + (b) * 2 + (h)) * HTB)
#define PG8_STAGE(bufoff, gbase, voff) do { _Pragma("unroll") for (int _i = 0; _i < 2; ++_i) \
        __builtin_amdgcn_global_load_lds((const unsigned*)((const char*)(gbase) + (voff)[_i]), (PG8_LAS unsigned*)(lds + (bufoff) + ldsw + _i * 8192), 16, 0, 0); } while (0)
#define PG8_LDA(dst, b, h) do { _Pragma("unroll") for (int m = 0; m < 4; ++m) _Pragma("unroll") for (int k = 0; k < 2; ++k) dst[m][k] = *(const PG8_LAS bf16x8*)(lds + PG8_SA(b, h) + aoff + m * 2048 + k * 1024); } while (0)
#define PG8_LDB(dst, b, h) do { _Pragma("unroll") for (int n = 0; n < 2; ++n) _Pragma("unroll") for (int k = 0; k < 2; ++k) dst[n][k] = *(const PG8_LAS bf16x8*)(lds + PG8_SB(b, h) + boff + n * 2048 + k * 1024); } while (0)
#define PG8_MMA(ai, bj, At, Bt) do { __builtin_amdgcn_s_setprio(1); _Pragma("unroll") for (int m = 0; m < 4; ++m) _Pragma("unroll") for (int n = 0; n < 2; ++n) _Pragma("unroll") for (int k = 0; k < 2; ++k) \
        acc[ai][bj][m][n] = __builtin_amdgcn_mfma_f32_16x16x32_bf16(Bt[n][k], At[m][k], acc[ai][bj][m][n], 0, 0, 0); __builtin_amdgcn_s_setprio(0); } while (0)
#define PG8_WAIT_V(n) asm volatile("s_waitcnt vmcnt(" #n ")" ::: "memory")
#define PG8_WAIT_L(n) asm volatile("s_waitcnt lgkmcnt(" #n ")" ::: "memory")
#define PG8_BAR __builtin_amdgcn_s_barrier()
#define PG8_SCHED __builtin_amdgcn_sched_barrier(0)
    Unit cur, nxt; int ui = 0;
    if (!S.next(0, cur)) return;
    f32x4 acc[2][2][4][2];
#pragma unroll
    for (int a = 0; a < 2; ++a)
#pragma unroll
        for (int b = 0; b < 2; ++b)
#pragma unroll
            for (int m = 0; m < 4; ++m)
#pragma unroll
                for (int n = 0; n < 2; ++n) acc[a][b][m][n] = (f32x4){0.f, 0.f, 0.f, 0.f};
    bf16x8 At[4][2], B0[2][2], B1[2][2];
    const char* cA = (const char*)g.A + (size_t)cur.pm * tstep; const char* cB = (const char*)g.Bt + (size_t)cur.pn * tstep;
    S.a_ready(cur);
    if constexpr (SP2) {
        PG8_STAGE(PG8_SB(0, 0), cB, voffB); PG8_STAGE(PG8_SB(0, 1), cB + hstep, voffB); PG8_STAGE(PG8_SA(0, 0), cA, voffA); PG8_STAGE(PG8_SA(0, 1), cA + hstep, voffA);
        if (wr == 1) PG8_BAR;
        PG8_WAIT_V(2); PG8_BAR;
        PG8_STAGE(PG8_SB(1, 0), cB + kstep, voffB); PG8_STAGE(PG8_SA(1, 0), cA + kstep, voffA); PG8_STAGE(PG8_SB(1, 1), cB + hstep + kstep, voffB);
        PG8_WAIT_V(6); PG8_BAR;
    } else {
        PG8_STAGE(PG8_SB(0, 0), cB, voffB); PG8_STAGE(PG8_SA(0, 0), cA, voffA); PG8_STAGE(PG8_SB(0, 1), cB + hstep, voffB); PG8_STAGE(PG8_SA(0, 1), cA + hstep, voffA);
        if (wr == 1) PG8_BAR;
        PG8_WAIT_V(4); PG8_BAR;
        PG8_STAGE(PG8_SB(1, 0), cB + kstep, voffB); PG8_STAGE(PG8_SA(1, 0), cA + kstep, voffA); PG8_STAGE(PG8_SB(1, 1), cB + hstep + kstep, voffB);
        PG8_WAIT_V(6); PG8_BAR;
    }
    for (;;) {
        const bool has_next = S.next(ui + 1, nxt);
        const char* nA = has_next ? (const char*)g.A + (size_t)nxt.pm * tstep : cA; const char* nB = has_next ? (const char*)g.Bt + (size_t)nxt.pn * tstep : cB;
        for (int t = 0; t < nt; t += 2) {
            const bool last = (t == nt - 2);
            const char* a1 = cA + (size_t)(t + 1) * kstep;
            const char* a2 = last ? nA : cA + (size_t)(t + 2) * kstep; const char* b2 = last ? nB : cB + (size_t)(t + 2) * kstep;
            const char* a3 = a2 + kstep; const char* b3 = b2 + kstep;
            if (last && has_next) S.a_ready(nxt);
            if constexpr (SP2) {
            PG8_LDB(B0, 0, 0); PG8_LDB(B1, 0, 1); PG8_SCHED; PG8_LDA(At, 0, 0); PG8_STAGE(PG8_SA(1, 1), a1 + hstep, voffA);
            PG8_WAIT_V(8); PG8_WAIT_L(0); PG8_BAR; PG8_MMA(0, 0, At, B0); PG8_MMA(0, 1, At, B1); PG8_BAR; PG8_SCHED;
            PG8_LDA(At, 0, 1); PG8_STAGE(PG8_SB(0, 0), b2, voffB); PG8_STAGE(PG8_SB(0, 1), b2 + hstep, voffB); PG8_STAGE(PG8_SA(0, 0), a2, voffA);
            PG8_WAIT_V(8); PG8_WAIT_L(0); PG8_BAR; PG8_MMA(1, 0, At, B0); PG8_MMA(1, 1, At, B1); PG8_BAR; PG8_SCHED;
            PG8_LDB(B0, 1, 0); PG8_LDB(B1, 1, 1); PG8_SCHED; PG8_LDA(At, 1, 0); PG8_STAGE(PG8_SA(0, 1), a2 + hstep, voffA);
            PG8_WAIT_V(8); PG8_WAIT_L(0); PG8_BAR; PG8_MMA(0, 0, At, B0); PG8_MMA(0, 1, At, B1); PG8_BAR; PG8_SCHED;
            PG8_LDA(At, 1, 1); PG8_STAGE(PG8_SB(1, 0), b3, voffB); PG8_STAGE(PG8_SB(1, 1), b3 + hstep, voffB); PG8_STAGE(PG8_SA(1, 0), a3, voffA);
            PG8_WAIT_V(8); PG8_WAIT_L(0); PG8_BAR; PG8_MMA(1, 0, At, B0); PG8_MMA(1, 1, At, B1); PG8_BAR; PG8_SCHED;
            } else {
            PG8_LDB(B0, 0, 0); PG8_SCHED; PG8_LDA(At, 0, 0); PG8_STAGE(PG8_SA(1, 1), a1 + hstep, voffA);
            PG8_WAIT_L(8); PG8_BAR; PG8_WAIT_L(0); PG8_MMA(0, 0, At, B0); PG8_BAR; PG8_SCHED;
            PG8_LDB(B1, 0, 1); PG8_STAGE(PG8_SB(0, 0), b2, voffB);
            PG8_BAR; PG8_WAIT_L(0); PG8_MMA(0, 1, At, B1); PG8_BAR;
            PG8_LDA(At, 0, 1); PG8_STAGE(PG8_SA(0, 0), a2, voffA);
            PG8_BAR; PG8_WAIT_L(0); PG8_MMA(1, 0, At, B0); PG8_BAR; PG8_SCHED;
            PG8_STAGE(PG8_SB(0, 1), b2 + hstep, voffB);
            PG8_WAIT_V(6); PG8_BAR; PG8_MMA(1, 1, At, B1); PG8_BAR;
            PG8_LDB(B0, 1, 0); PG8_SCHED; PG8_LDA(At, 1, 0); PG8_STAGE(PG8_SA(0, 1), a2 + hstep, voffA);
            PG8_WAIT_L(8); PG8_BAR; PG8_WAIT_L(0); PG8_MMA(0, 0, At, B0); PG8_BAR; PG8_SCHED;
            PG8_LDB(B1, 1, 1); PG8_STAGE(PG8_SB(1, 0), b3, voffB);
            PG8_BAR; PG8_WAIT_L(0); PG8_MMA(0, 1, At, B1); PG8_BAR;
            PG8_LDA(At, 1, 1); PG8_STAGE(PG8_SA(1, 0), a3, voffA);
            PG8_BAR; PG8_WAIT_L(0); PG8_MMA(1, 0, At, B0); PG8_BAR; PG8_SCHED;
            PG8_STAGE(PG8_SB(1, 1), b3 + hstep, voffB);
            PG8_WAIT_V(6); PG8_BAR; PG8_MMA(1, 1, At, B1); PG8_BAR;
            }
        }
        if constexpr (ALIGN_EPI) { if (wr == 0) PG8_BAR; }
        if constexpr (!Epi::AFTER_DRAIN) { E(acc, cur, wr, wc, fr, fq); S.done(cur); }
        if (!has_next) break;
#pragma unroll
        for (int a = 0; a < 2; ++a)
#pragma unroll
            for (int b = 0; b < 2; ++b)
#pragma unroll
                for (int m = 0; m < 4; ++m)
#pragma unroll
                    for (int n = 0; n < 2; ++n) acc[a][b][m][n] = (f32x4){0.f, 0.f, 0.f, 0.f};
        cur = nxt; cA = nA; cB = nB; ++ui;
        if constexpr (ALIGN_EPI) { if (wr == 1) PG8_BAR; }
    }
    PG8_WAIT_V(0);
    if constexpr (!ALIGN_EPI) { if (wr == 0) PG8_BAR; }
    PG8_BAR;
    if constexpr (Epi::AFTER_DRAIN) { E.fused(acc, cur, wr, wc, fr, fq, lds, wid, lane); S.done(cur); }
#undef PG8_SA
#undef PG8_SB
#undef PG8_STAGE
#undef PG8_LDA
#undef PG8_LDB
#undef PG8_MMA
#undef PG8_WAIT_V
#undef PG8_WAIT_L
#undef PG8_BAR
#undef PG8_SCHED
}
}
#define LAS __attribute__((address_space(3)))
#define DI __device__ __forceinline__
typedef unsigned short bf16;
typedef unsigned v4u __attribute__((ext_vector_type(4)));
typedef unsigned v2u __attribute__((ext_vector_type(2)));
typedef float f32x4 __attribute__((ext_vector_type(4)));
typedef short bf16x8 __attribute__((ext_vector_type(8)));
#define LDS_WAIT() asm volatile("s_waitcnt lgkmcnt(0)" ::: "memory")
#define VM_WAIT() asm volatile("s_waitcnt vmcnt(0)" ::: "memory")
DI unsigned f2bf(float f) { unsigned u = __builtin_bit_cast(unsigned, f); return (u + 0x7fffu + ((u >> 16) & 1u)) >> 16; }
DI unsigned pk2(float lo, float hi) { return f2bf(lo) | (f2bf(hi) << 16); }
DI float bf2f(unsigned b) { return __builtin_bit_cast(float, b << 16); }
DI float bflo(unsigned w) { return __builtin_bit_cast(float, w << 16); }
DI float bfhi(unsigned w) { return __builtin_bit_cast(float, w & 0xffff0000u); }
DI float fexp(float x) { return __builtin_amdgcn_exp2f(x * 1.4426950408889634f); }
DI float flog(float x) { return __builtin_amdgcn_logf(x) * 0.6931471805599453f; }
DI float frcp(float x) { return __builtin_amdgcn_rcpf(x); }
DI float sigmoidf_(float x) { return frcp(1.f + fexp(-x)); }
DI float siluf_(float x) { return x * sigmoidf_(x); }
DI float gelu_tanh(float x) { const float u = 0.7978845608028654f * (x + 0.044715f * x * x * x); return x * sigmoidf_(2.f * u); }
DI float wave_sum(float v) {
#pragma unroll
    for (int o = 1; o < 64; o <<= 1) v += __shfl_xor(v, o);
    return v;
}
DI float wave_max(float v) {
#pragma unroll
    for (int o = 1; o < 64; o <<= 1) v = fmaxf(v, __shfl_xor(v, o));
    return v;
}
DI int red16_idx(int lane) { return 8 * ((lane >> 5) & 1) + 4 * ((lane >> 4) & 1) + 2 * ((lane >> 3) & 1) + ((lane >> 2) & 1); }
DI float red16(const float (&o)[16], int lane) {
    const bool b32 = lane & 32, b16 = lane & 16, b8 = lane & 8, b4 = lane & 4;
    float a8[8], a4[4], a2[2], a1;
#pragma unroll
    for (int j = 0; j < 8; ++j) { const float send = b32 ? o[j] : o[j + 8], keep = b32 ? o[j + 8] : o[j]; a8[j] = keep + __shfl_xor(send, 32); }
#pragma unroll
    for (int j = 0; j < 4; ++j) { const float send = b16 ? a8[j] : a8[j + 4], keep = b16 ? a8[j + 4] : a8[j]; a4[j] = keep + __shfl_xor(send, 16); }
#pragma unroll
    for (int j = 0; j < 2; ++j) { const float send = b8 ? a4[j] : a4[j + 2], keep = b8 ? a4[j + 2] : a4[j]; a2[j] = keep + __shfl_xor(send, 8); }
    { const float send = b4 ? a2[0] : a2[1], keep = b4 ? a2[1] : a2[0]; a1 = keep + __shfl_xor(send, 4); }
    a1 += __shfl_xor(a1, 2); a1 += __shfl_xor(a1, 1);
    return a1;
}
#define XB_TMO      128
#define XB_XCNT(j)  (256  + 64 * (j))
#define XB_XSUB(j)  (1280 + 64 * (j))
#define XB_XGEN(j)  (2304 + 64 * (j))
#define XB_TOP      3328
#define XB_TOPGEN   3392
#define XCD_BAR_WORDS 3456
#define XB_SPIN_CAP (1u << 18)

__device__ __forceinline__ unsigned xb_ld(unsigned* p)              { return __hip_atomic_load(p, __ATOMIC_RELAXED, __HIP_MEMORY_SCOPE_AGENT); }
__device__ __forceinline__ unsigned xb_add(unsigned* p, unsigned v) { return __hip_atomic_fetch_add(p, v, __ATOMIC_RELAXED, __HIP_MEMORY_SCOPE_AGENT); }
__device__ __forceinline__ unsigned xb_xcc_id() { return (unsigned)__builtin_amdgcn_s_getreg((3 << 11) | 20) & 0xFu; }
#define XB_SPIN(cond, bar) do { unsigned _sp = 0; while (cond) { __builtin_amdgcn_s_sleep(1); \
    if ((++_sp & 255u) == 0u) { if (xb_ld(&(bar)[XB_TMO])) break; if (_sp > XB_SPIN_CAP) { atomicAdd(&(bar)[XB_TMO], 1u); break; } } } } while (0)

struct XcdBarrier {
    unsigned* bar; unsigned x;
    volatile LAS unsigned* st;
};

__device__ __forceinline__ XcdBarrier xcd_barrier_post(unsigned* bar, volatile LAS unsigned* st) {
    XcdBarrier b; b.bar = bar; b.x = xb_xcc_id(); b.st = st;
    if (threadIdx.x == 0) (void)xb_add(&bar[XB_XCNT(b.x)], 1u);
    return b;
}
__device__ __forceinline__ void xcd_barrier_complete(unsigned* bar, unsigned x, unsigned& nloc, unsigned& nx) {
    const unsigned G = gridDim.x * gridDim.y * gridDim.z;
    unsigned sum, cnt, mine, sp = 0u;
    for (;;) {
        sum = 0u; cnt = 0u; mine = 0u;
#pragma unroll
        for (unsigned j = 0; j < 16; ++j) { const unsigned c = xb_ld(&bar[XB_XCNT(j)]); sum += c; cnt += (c > 0u) ? 1u : 0u; mine = (j == x) ? c : mine; }
        if (sum == G) break;
        __builtin_amdgcn_s_sleep(1);
        if ((++sp & 255u) == 0u) { if (xb_ld(&bar[XB_TMO])) break; if (sp > XB_SPIN_CAP) { atomicAdd(&bar[XB_TMO], 1u); break; } }
    }
    nloc = mine > 0u ? mine : 1u; nx = cnt > 0u ? cnt : 1u;
}

__device__ __forceinline__ void xcd_barrier(const XcdBarrier& b) {
    asm volatile("s_waitcnt vmcnt(0)" ::: "memory");
    __syncthreads();
    if (threadIdx.x == 0) {
        unsigned* bar = b.bar;
        __builtin_amdgcn_s_waitcnt(0);
        unsigned nloc = b.st[0], nx = b.st[1];
        if (nloc == 0u) { xcd_barrier_complete(bar, b.x, nloc, nx); b.st[0] = nloc; b.st[1] = nx; }
        const unsigned old = xb_add(&bar[XB_XSUB(b.x)], 1u);
        const unsigned gen = old / nloc;
        if (old + 1u == (gen + 1u) * nloc) {
            __builtin_amdgcn_fence(__ATOMIC_RELEASE, "agent");
            asm volatile("s_waitcnt vmcnt(0)" ::: "memory");
            const unsigned og = xb_add(&bar[XB_TOP], 1u);
            const unsigned tg = og / nx;
            if (og + 1u == (tg + 1u) * nx) xb_add(&bar[XB_TOPGEN], 1u);
            else XB_SPIN(xb_ld(&bar[XB_TOPGEN]) == tg, bar);
            __builtin_amdgcn_fence(__ATOMIC_ACQUIRE, "agent");
            xb_add(&bar[XB_XGEN(b.x)], 1u);
            asm volatile("s_waitcnt vmcnt(0)" ::: "memory");
        } else {
            XB_SPIN(xb_ld(&bar[XB_XGEN(b.x)]) == gen, bar);
            __builtin_amdgcn_fence(__ATOMIC_ACQUIRE, "agent");
            asm volatile("s_waitcnt vmcnt(0)" ::: "memory");
        }
    }
    __syncthreads();
}
constexpr int NWAVES = 8, NTHR = 512;
constexpr int BATCH = 2, SEQ = 8192, DM = 1024, MTOK = BATCH * SEQ;
constexpr int NIN = 3584;
constexpr int AW = 512;
constexpr int NEXP = 16, DFF = 1024, CAP = 1024, NROWS = BATCH * NEXP * CAP;
constexpr int NSC = 32, SCLEN = 256;
constexpr int NHEAD = 16, HD = 64, NQKV = 3072;
constexpr float EPS = 1e-6f;
constexpr int NPHASE = 22;

constexpr size_t MiB = 1u << 20;
constexpr size_t WS_CTL = 0, CTL_ZERO_BYTES = 1 * MiB;
constexpr size_t WS_AFF = 1 * MiB;
constexpr size_t WS_POS = 2 * MiB;
constexpr size_t WS_IDX = 3 * MiB;
constexpr size_t WS_GATE = 3 * MiB + 256 * 1024;
constexpr size_t WS_DEC = 3 * MiB + 512 * 1024;
constexpr size_t WS_LB = 4 * MiB;
constexpr size_t WS_BT = 4 * MiB + 64 * 1024;
constexpr size_t WS_WIN = 8 * MiB;
constexpr size_t WS_WOUT = 15 * MiB;
constexpr size_t WS_WQKV = 17 * MiB;
constexpr size_t WS_WO = 23 * MiB;
constexpr size_t WS_WGU = 32 * MiB;
constexpr size_t WS_WDN = 96 * MiB;
constexpr size_t WS_H = 128 * MiB;
constexpr size_t WS_R1 = 160 * MiB;
constexpr size_t WS_U = WS_R1, WS_GV = WS_R1 + 16 * MiB, WS_Q = WS_R1 + 32 * MiB, WS_V = WS_R1 + 48 * MiB, WS_G = WS_R1 + 64 * MiB;
constexpr size_t WS_LFF = WS_R1 + 80 * MiB, WS_LFB = WS_R1 + 112 * MiB;
constexpr size_t WS_CAT = WS_R1 + 144 * MiB;
constexpr size_t WS_ST = WS_R1 + 176 * MiB;
constexpr size_t WS_ODIR = WS_R1 + 208 * MiB;
constexpr size_t WS_XE = WS_R1, WS_Y = WS_R1;
constexpr size_t WS_HMID = WS_R1 + 64 * MiB;
constexpr size_t WS_QKV = WS_R1;
constexpr size_t WS_ATT = WS_R1 + 96 * MiB;
constexpr size_t WS_END = WS_R1 + 272 * MiB;
constexpr int CW_BAR = 4096;
constexpr int MAX_BAR_REGIONS = 24;

constexpr int RING_BYTES = 131072;
constexpr int LDSCTL_OFF = RING_BYTES, MISC_OFF = LDSCTL_OFF + 320;
constexpr int LDS_BYTES = 147456;

struct Args { const float* in[19]; float* out; unsigned char* ws; int ph_lo, ph_hi, li, pad; };

struct Frame {
    LAS unsigned char* lds;
    volatile LAS unsigned* MISC;
    int tid, lane, wave, G, bid, gw, NGW;
    unsigned char* ws;
};

template <int NPN_> struct GroupedOrder {
    int G, c;
    DI bool next(int i, pg8::Unit& u) const {
        const int L = i * G + c; if (L >= 16 * 8 * NPN_) return false;
        const int e = L / (8 * NPN_), w = L % (8 * NPN_);
        u.pm = e * 8 + (w & 7); u.pn = e * NPN_ + (w >> 3); return true;
    }
    DI void a_ready(const pg8::Unit&) const {}
    DI void done(const pg8::Unit&) const {}
};

struct EpiInProj {
    static constexpr bool PERM = true, AFTER_DRAIN = false;
    bf16 *U, *GV, *Q, *V, *G; float *LFf, *LFb; const float* LB;
    DI void operator()(const pg8::f32x4 (&acc)[2][2][4][2], const pg8::Unit& u, int wr, int wc, int fr, int fq) const {
        const int seg = u.pn >> 1;
        const int row0 = u.pm * 256 + wr * 64 + fr, lc0 = (u.pn & 1) * 256 + wc * 32 + 8 * fq;
#pragma unroll
        for (int bj = 0; bj < 2; ++bj) {
            const int lc = lc0 + bj * 128;
            float lb[8];
            if (seg == 3 || seg == 4) {
#pragma unroll
                for (int j = 0; j < 8; ++j) lb[j] = LB[(seg - 3) * 512 + lc + j];
            }
#pragma unroll
            for (int ai = 0; ai < 2; ++ai)
#pragma unroll
                for (int m = 0; m < 4; ++m) {
                    const size_t off = (size_t)(row0 + ai * 128 + m * 16) * 512 + lc;
                    float v[8];
#pragma unroll
                    for (int j = 0; j < 8; ++j) v[j] = acc[ai][bj][m][j >> 2][j & 3];
                    if (seg == 3 || seg == 4) {
#pragma unroll
                        for (int j = 0; j < 8; ++j) v[j] = flog(lb[j] + (1.f - lb[j]) * sigmoidf_(v[j]));
                        float* o = (seg == 3 ? LFf : LFb) + off;
                        *(f32x4*)o = (f32x4){v[0], v[1], v[2], v[3]}; *(f32x4*)(o + 4) = (f32x4){v[4], v[5], v[6], v[7]};
                    } else {
                        bf16* o;
                        if (seg == 0) { o = U;
#pragma unroll
                            for (int j = 0; j < 8; ++j) v[j] = gelu_tanh(v[j]);
                        } else if (seg == 1) { o = GV;
#pragma unroll
                            for (int j = 0; j < 8; ++j) v[j] = gelu_tanh(v[j]);
                        } else if (seg == 2) { o = Q;
#pragma unroll
                            for (int j = 0; j < 8; ++j) v[j] = siluf_(v[j]);
                        } else if (seg == 5) { o = V;
                        } else { o = G;
#pragma unroll
                            for (int j = 0; j < 8; ++j) v[j] = sigmoidf_(v[j]);
                        }
                        v4u w; w.x = pk2(v[0], v[1]); w.y = pk2(v[2], v[3]); w.z = pk2(v[4], v[5]); w.w = pk2(v[6], v[7]);
                        *(v4u*)(o + off) = w;
                    }
                }
        }
    }
};
struct EpiResid {
    static constexpr bool PERM = false, AFTER_DRAIN = false;
    const float* base; float* out;
    DI void operator()(const pg8::f32x4 (&acc)[2][2][4][2], const pg8::Unit& u, int wr, int wc, int fr, int fq) const {
        const int row0 = u.pm * 256 + wr * 64 + fr, col0 = u.pn * 256 + wc * 32 + 4 * fq;
#pragma unroll
        for (int ai = 0; ai < 2; ++ai)
#pragma unroll
            for (int m = 0; m < 4; ++m) { const size_t ro = (size_t)(row0 + ai * 128 + m * 16) * DM + col0;
#pragma unroll
                for (int bj = 0; bj < 2; ++bj)
#pragma unroll
                    for (int n = 0; n < 2; ++n) { const size_t o = ro + bj * 128 + n * 16; *(f32x4*)(out + o) = *(const f32x4*)(base + o) + acc[ai][bj][m][n]; } }
    }
};
struct EpiGateUp {
    static constexpr bool PERM = true, AFTER_DRAIN = false;
    bf16* H;
    DI void operator()(const pg8::f32x4 (&acc)[2][2][4][2], const pg8::Unit& u, int wr, int wc, int fr, int fq) const {
        const int pnl = u.pn & 7;
        const int row0 = u.pm * 256 + wr * 64 + fr, col0 = pnl * 128 + wc * 32 + 8 * fq;
#pragma unroll
        for (int ai = 0; ai < 2; ++ai)
#pragma unroll
            for (int m = 0; m < 4; ++m) {
                float v[8];
#pragma unroll
                for (int j = 0; j < 8; ++j) v[j] = siluf_(acc[ai][0][m][j >> 2][j & 3]) * acc[ai][1][m][j >> 2][j & 3];
                v4u w; w.x = pk2(v[0], v[1]); w.y = pk2(v[2], v[3]); w.z = pk2(v[4], v[5]); w.w = pk2(v[6], v[7]);
                *(v4u*)(H + (size_t)(row0 + ai * 128 + m * 16) * DFF + col0) = w;
            }
    }
};
struct EpiDown {
    static constexpr bool PERM = true, AFTER_DRAIN = false;
    bf16* Y; const float* gate;
    DI void operator()(const pg8::f32x4 (&acc)[2][2][4][2], const pg8::Unit& u, int wr, int wc, int fr, int fq) const {
        const int pnl = u.pn & 3;
        const int row0 = u.pm * 256 + wr * 64 + fr, col0 = pnl * 256 + wc * 32 + 8 * fq;
#pragma unroll
        for (int ai = 0; ai < 2; ++ai)
#pragma unroll
            for (int m = 0; m < 4; ++m) { const int row = row0 + ai * 128 + m * 16; const float g = gate[row];
#pragma unroll
                for (int bj = 0; bj < 2; ++bj) {
                    float v[8];
#pragma unroll
                    for (int j = 0; j < 8; ++j) v[j] = acc[ai][bj][m][j >> 2][j & 3] * g;
                    v4u w; w.x = pk2(v[0], v[1]); w.y = pk2(v[2], v[3]); w.z = pk2(v[4], v[5]); w.w = pk2(v[6], v[7]);
                    *(v4u*)(Y + (size_t)row * DM + col0 + bj * 128) = w; } }
    }
};
struct EpiQKV {
    static constexpr bool PERM = true, AFTER_DRAIN = false;
    bf16* O;
    DI void operator()(const pg8::f32x4 (&acc)[2][2][4][2], const pg8::Unit& u, int wr, int wc, int fr, int fq) const {
        const float sc = (u.pn < 4) ? 0.125f : 1.f;
        const int row0 = u.pm * 256 + wr * 64 + fr, col0 = u.pn * 256 + wc * 32 + 8 * fq;
#pragma unroll
        for (int ai = 0; ai < 2; ++ai)
#pragma unroll
            for (int m = 0; m < 4; ++m)
#pragma unroll
                for (int bj = 0; bj < 2; ++bj) {
                    float v[8];
#pragma unroll
                    for (int j = 0; j < 8; ++j) v[j] = acc[ai][bj][m][j >> 2][j & 3] * sc;
                    v4u w; w.x = pk2(v[0], v[1]); w.y = pk2(v[2], v[3]); w.z = pk2(v[4], v[5]); w.w = pk2(v[6], v[7]);
                    *(v4u*)(O + (size_t)(row0 + ai * 128 + m * 16) * NQKV + col0 + bj * 128) = w; }
    }
};

DI void transpose_item(const float* W, int K, int N, bf16* WT, LAS float* scr, int k0, int n0, int drow0, int lane) {
#pragma unroll 8
    for (int i = 0; i < 32; ++i) { const int kk = 2 * i + (lane >> 5); scr[kk * 33 + (lane & 31)] = W[(size_t)(k0 + kk) * N + n0 + (lane & 31)]; }
    LDS_WAIT(); asm volatile("" ::: "memory");
    const int c = lane & 7;
#pragma unroll
    for (int j = 0; j < 4; ++j) { const int n = (lane >> 3) + 8 * j; const LAS float* s = scr + (8 * c) * 33 + n;
        v4u o; o.x = pk2(s[0 * 33], s[1 * 33]); o.y = pk2(s[2 * 33], s[3 * 33]); o.z = pk2(s[4 * 33], s[5 * 33]); o.w = pk2(s[6 * 33], s[7 * 33]);
        *(v4u*)(WT + (size_t)(drow0 + n) * K + k0 + 8 * c) = o; }
    LDS_WAIT(); asm volatile("" ::: "memory");
}
DI void transpose_matrix(Frame& F, const float* W, int K, int N, bf16* WT) {
    LAS float* scr = (LAS float*)(F.lds + F.wave * 16384);
    const int nblk = N / 32, nitems = (K / 64) * nblk;
    for (int it = F.gw; it < nitems; it += F.NGW) { const int kb = it / nblk, nb = it % nblk; transpose_item(W, K, N, WT, scr, 64 * kb, 32 * nb, 32 * nb, F.lane); }
}
DI void convert_moe_weights(Frame& F, const float* wg, const float* wu, const float* wd, int layer) {
    LAS float* scr = (LAS float*)(F.lds + F.wave * 16384);
    bf16* WGU = (bf16*)(F.ws + WS_WGU); bf16* WDN = (bf16*)(F.ws + WS_WDN);
    for (int it = F.gw; it < 3 * 16 * 512; it += F.NGW) {
        const int mat = it / 8192, rem = it % 8192, e = rem / 512, r = rem % 512, kb = r / 32, nb = r % 32, n0 = 32 * nb;
        const size_t so = ((size_t)layer * 16 + e) * 1024 * 1024;
        if (mat == 0) transpose_item(wg + so, 1024, 1024, WGU + (size_t)e * 2048 * 1024, scr, 64 * kb, n0, (n0 >> 7) * 256 + (n0 & 127), F.lane);
        else if (mat == 1) transpose_item(wu + so, 1024, 1024, WGU + (size_t)e * 2048 * 1024, scr, 64 * kb, n0, (n0 >> 7) * 256 + 128 + (n0 & 127), F.lane);
        else transpose_item(wd + so, 1024, 1024, WDN + (size_t)e * 1024 * 1024, scr, 64 * kb, n0, n0, F.lane);
    }
}
DI void rms_row(const float* xrow, const float* g, f32x4 (&v)[4], int lane) {
    const f32x4* xr = (const f32x4*)xrow + lane; float s = 0.f;
#pragma unroll
    for (int j = 0; j < 4; ++j) { v[j] = xr[64 * j]; s += (v[j].x * v[j].x + v[j].y * v[j].y) + (v[j].z * v[j].z + v[j].w * v[j].w); }
    const float rstd = 1.f / sqrtf(wave_sum(s) * (1.f / DM) + EPS);
    const f32x4* gr = (const f32x4*)g + lane;
#pragma unroll
    for (int j = 0; j < 4; ++j) v[j] = v[j] * rstd * gr[64 * j];
}
DI void store_row_bf16(bf16* orow, const f32x4 (&v)[4], int lane) {
    v2u* o8 = (v2u*)orow + lane;
#pragma unroll
    for (int j = 0; j < 4; ++j) { v2u w; w.x = pk2(v[j].x, v[j].y); w.y = pk2(v[j].z, v[j].w); o8[64 * j] = w; }
}
DI int t5_bucket(int rel) {
    const int n = rel < 0 ? -rel : rel;
    int val;
    if (n < 8) val = n;
    else { const float sc = logf((float)n / 8.f) / 4.852030263919617f; int lg = 8 + (int)(sc * 8.f); val = lg < 15 ? lg : 15; }
    return (rel > 0 ? 16 : 0) + val;
}

DI void phase_prologue(Frame& F, const Args& a) {
    unsigned char* ws = F.ws;
    transpose_matrix(F, a.in[4], 1024, NIN, (bf16*)(ws + WS_WIN));
    transpose_matrix(F, a.in[5], 1024, 1024, (bf16*)(ws + WS_WOUT));
    transpose_matrix(F, a.in[12], 1024, NQKV, (bf16*)(ws + WS_WQKV));
    transpose_matrix(F, a.in[13], 1024, 1024, (bf16*)(ws + WS_WO));
    convert_moe_weights(F, a.in[16], a.in[17], a.in[18], 0);
    { float* LB = (float*)(ws + WS_LB); const float* t = a.in[10];
      for (int i = F.bid * NTHR + F.tid; i < 2 * 512; i += F.G * NTHR) { const int d = i / 512, k = i % 512;
          const float a0 = t[(d * 3 + 0) * 512 + k], a1 = t[(d * 3 + 1) * 512 + k], a2 = t[(d * 3 + 2) * 512 + k];
          const float mx = fmaxf(a0, fmaxf(a1, a2)); const float e0 = expf(a0 - mx), e1 = expf(a1 - mx), e2 = expf(a2 - mx);
          LB[i] = e0 / (e0 + e1 + e2); } }
    { float* BT = (float*)(ws + WS_BT); const float* rb = a.in[14];
      for (int i = F.bid * NTHR + F.tid; i < 3 * 16 * 129; i += F.G * NTHR) { const int p = i / (16 * 129), h = (i / 129) % 16, j = i % 129;
          const int dil = (p == 0) ? 1 : (p == 1 ? 4 : 16);
          BT[i] = rb[t5_bucket((j - 64) * dil) * 16 + h]; } }
    { bf16* H = (bf16*)(ws + WS_H); const float* x = a.in[0];
      for (int m = F.gw; m < MTOK; m += F.NGW) { f32x4 v[4]; rms_row(x + (size_t)m * DM, a.in[1], v, F.lane); store_row_bf16(H + (size_t)m * DM, v, F.lane); } }
}

DI void phase_a_ln(Frame& F, const Args& a) {
    bf16* GV = (bf16*)(F.ws + WS_GV); const float* lg = a.in[6]; const float* lbv = a.in[7];
    for (int m = F.gw; m < MTOK; m += F.NGW) {
        v4u w = *((const v4u*)(GV + (size_t)m * AW) + F.lane);
        float v[8] = {bflo(w.x), bfhi(w.x), bflo(w.y), bfhi(w.y), bflo(w.z), bfhi(w.z), bflo(w.w), bfhi(w.w)};
        float s = 0.f;
#pragma unroll
        for (int j = 0; j < 8; ++j) s += v[j];
        const float mu = wave_sum(s) * (1.f / AW); float s2 = 0.f;
#pragma unroll
        for (int j = 0; j < 8; ++j) { v[j] -= mu; s2 += v[j] * v[j]; }
        const float rstd = 1.f / sqrtf(wave_sum(s2) * (1.f / AW) + EPS);
#pragma unroll
        for (int j = 0; j < 8; ++j) v[j] = v[j] * rstd * lg[8 * F.lane + j] + lbv[8 * F.lane + j];
        v4u o; o.x = pk2(v[0], v[1]); o.y = pk2(v[2], v[3]); o.z = pk2(v[4], v[5]); o.w = pk2(v[6], v[7]);
        *((v4u*)(GV + (size_t)m * AW) + F.lane) = o;
    }
}
DI void phase_a_mix_naive(Frame& F, const Args& a) {
    const bf16* VN = (const bf16*)(F.ws + WS_GV); const bf16* U = (const bf16*)(F.ws + WS_U); bf16* CAT = (bf16*)(F.ws + WS_CAT);
    LAS float* wl = (LAS float*)F.lds; LAS float* vl = (LAS float*)(F.lds + 65536);
    for (int u = F.bid; u < 512; u += F.G) {
        const int g = u & 3, ch = u >> 2; const int row0 = ch * 128;
        __syncthreads();
        for (int i = F.tid; i < 128 * 128; i += NTHR) { wl[i] = a.in[8][g * 16384 + i]; const int s = i >> 7, c = i & 127; vl[i] = bf2f(VN[(size_t)(row0 + s) * AW + g * 128 + c]); }
        __syncthreads();
        const int c = F.tid & 127, tq = F.tid >> 7;
        for (int tt = 0; tt < 32; ++tt) { const int t = tq * 32 + tt; float acc = 0.f;
            for (int s = 0; s < 128; ++s) acc += wl[t * 128 + s] * vl[s * 128 + c];
            const float uu = bf2f(U[(size_t)(row0 + t) * AW + g * 128 + c]);
            CAT[(size_t)(row0 + t) * DM + g * 128 + c] = (bf16)f2bf(uu * (acc + a.in[9][g * 128 + t])); }
    }
}

DI void gla_naive_unit(Frame& F, int u, bool with_out) {
    const int sc = u & 31, dir = (u >> 5) & 1, h = (u >> 6) & 3, b = u >> 8;
    const bf16* Q = (const bf16*)(F.ws + WS_Q); const bf16* V = (const bf16*)(F.ws + WS_V);
    const float* LF = (const float*)(F.ws + (dir ? WS_LFB : WS_LFF));
    float* ST = (float*)(F.ws + WS_ST) + (size_t)u * 16384; float* DEC = (float*)(F.ws + WS_DEC) + u * 128;
    float* OD = (float*)(F.ws + WS_ODIR) + (size_t)dir * MTOK * AW;
    LAS bf16* qs = (LAS bf16*)F.lds; LAS bf16* vs = (LAS bf16*)(F.lds + 16384); LAS float* lfs = (LAS float*)(F.lds + 32768);
    const int lane = F.lane, w = F.wave;
    float S[2][16]; float lsum[2] = {0.f, 0.f};
#pragma unroll
    for (int aa = 0; aa < 2; ++aa)
#pragma unroll
        for (int j = 0; j < 16; ++j) S[aa][j] = with_out ? ST[(lane + 64 * aa) * 128 + 16 * w + j] : 0.f;
    for (int sub = 0; sub < 4; ++sub) {
        __syncthreads();
        for (int idx = F.tid; idx < 1024; idx += NTHR) { const int i = idx >> 4, c8 = (idx & 15) * 8; const int ii = sc * 256 + sub * 64 + i; const int tok = dir ? (SEQ - 1 - ii) : ii;
            const size_t go = (size_t)(b * SEQ + tok) * AW + h * 128 + c8;
            *(LAS v4u*)(qs + i * 128 + c8) = *(const v4u*)(Q + go); *(LAS v4u*)(vs + i * 128 + c8) = *(const v4u*)(V + go); }
        for (int idx = F.tid; idx < 2048; idx += NTHR) { const int i = idx >> 5, c4 = (idx & 31) * 4; const int ii = sc * 256 + sub * 64 + i; const int tok = dir ? (SEQ - 1 - ii) : ii;
            *(LAS f32x4*)(lfs + i * 128 + c4) = *(const f32x4*)(LF + (size_t)(b * SEQ + tok) * AW + h * 128 + c4); }
        __syncthreads();
        for (int i = 0; i < 64; ++i) {
            const float l0 = lfs[i * 128 + lane], l1 = lfs[i * 128 + lane + 64];
            const float f0 = fexp(l0), f1 = fexp(l1), k0 = 1.f - f0, k1 = 1.f - f1;
            lsum[0] += l0; lsum[1] += l1;
            float vv[16];
            { const v4u a0 = *(const LAS v4u*)(vs + i * 128 + 16 * w), a1 = *(const LAS v4u*)(vs + i * 128 + 16 * w + 8);
              vv[0] = bflo(a0.x); vv[1] = bfhi(a0.x); vv[2] = bflo(a0.y); vv[3] = bfhi(a0.y); vv[4] = bflo(a0.z); vv[5] = bfhi(a0.z); vv[6] = bflo(a0.w); vv[7] = bfhi(a0.w);
              vv[8] = bflo(a1.x); vv[9] = bfhi(a1.x); vv[10] = bflo(a1.y); vv[11] = bfhi(a1.y); vv[12] = bflo(a1.z); vv[13] = bfhi(a1.z); vv[14] = bflo(a1.w); vv[15] = bfhi(a1.w); }
#pragma unroll
            for (int j = 0; j < 16; ++j) { S[0][j] = f0 * S[0][j] + k0 * vv[j]; S[1][j] = f1 * S[1][j] + k1 * vv[j]; }
            if (with_out) {
                const float q0 = bf2f(qs[i * 128 + lane]), q1 = bf2f(qs[i * 128 + lane + 64]);
                float o[16];
#pragma unroll
                for (int j = 0; j < 16; ++j) o[j] = S[0][j] * q0 + S[1][j] * q1;
                const float tot = red16(o, lane);
                if ((lane & 3) == 0) { const int ii = sc * 256 + sub * 64 + i; const int tok = dir ? (SEQ - 1 - ii) : ii;
                    OD[(size_t)(b * SEQ + tok) * AW + h * 128 + 16 * w + red16_idx(lane)] = tot; }
            }
        }
    }
    if (!with_out) {
#pragma unroll
        for (int aa = 0; aa < 2; ++aa)
#pragma unroll
            for (int j = 0; j < 16; ++j) ST[(lane + 64 * aa) * 128 + 16 * w + j] = S[aa][j];
        if (w == 0) { DEC[lane] = fexp(lsum[0]); DEC[lane + 64] = fexp(lsum[1]); }
    }
}
DI void phase_gla_scan(Frame& F) {
    float* ST = (float*)(F.ws + WS_ST); const float* DEC = (const float*)(F.ws + WS_DEC);
    for (int idx = F.bid * NTHR + F.tid; idx < 16 * 16384; idx += F.G * NTHR) {
        const int chain = idx >> 14, kv = idx & 16383, k = kv >> 7; float S = 0.f;
        for (int sc = 0; sc < NSC; ++sc) { const int u = chain * NSC + sc; const size_t o = (size_t)u * 16384 + kv; const float d = ST[o]; ST[o] = S; S = S * DEC[u * 128 + k] + d; }
    }
}
DI void phase_b_combine(Frame& F, const Args& a) {
    const float* OD = (const float*)(F.ws + WS_ODIR); const bf16* G = (const bf16*)(F.ws + WS_G); bf16* CAT = (bf16*)(F.ws + WS_CAT); const float* ng = a.in[11];
    for (int t = F.gw; t < MTOK * 4; t += F.NGW) { const int row = t >> 2, h = t & 3; const size_t o = (size_t)row * AW + h * 128 + 2 * F.lane;
        const float o0 = OD[o] + OD[(size_t)MTOK * AW + o], o1 = OD[o + 1] + OD[(size_t)MTOK * AW + o + 1];
        const float rstd = 1.f / sqrtf(wave_sum(o0 * o0 + o1 * o1) * (1.f / 128.f) + EPS);
        const unsigned gw2 = *(const unsigned*)(G + o);
        const float r0 = o0 * rstd * ng[h * 128 + 2 * F.lane] * bflo(gw2), r1 = o1 * rstd * ng[h * 128 + 2 * F.lane + 1] * bfhi(gw2);
        *(unsigned*)(CAT + (size_t)row * DM + 512 + h * 128 + 2 * F.lane) = pk2(r0, r1); }
}

DI void phase_router(Frame& F, const float* XR, const float* gn, const float* wr) {
    LAS float* wl = (LAS float*)F.lds;
    __syncthreads();
    for (int i = F.tid; i < 1024 * 16 / 4; i += NTHR) *(LAS f32x4*)(wl + 4 * i) = *(const f32x4*)(wr + 4 * i);
    __syncthreads();
    bf16* H = (bf16*)(F.ws + WS_H); float* AFF = (float*)(F.ws + WS_AFF);
    for (int m = F.gw; m < MTOK; m += F.NGW) {
        asm volatile("" ::: "memory");
        f32x4 v[4]; rms_row(XR + (size_t)m * DM, gn, v, F.lane); store_row_bf16(H + (size_t)m * DM, v, F.lane);
        float p[16];
#pragma unroll
        for (int e = 0; e < 16; ++e) p[e] = 0.f;
#pragma unroll
        for (int j = 0; j < 4; ++j)
#pragma unroll
            for (int q = 0; q < 4; ++q) { const int d = 4 * F.lane + 256 * j + q; const float xv = v[j][q];
#pragma unroll
                for (int e4 = 0; e4 < 4; ++e4) { const f32x4 w4 = *(const LAS f32x4*)(wl + d * 16 + 4 * e4); p[4 * e4] += xv * w4.x; p[4 * e4 + 1] += xv * w4.y; p[4 * e4 + 2] += xv * w4.z; p[4 * e4 + 3] += xv * w4.w; } }
        const float lg = red16(p, F.lane);
        const float mx = wave_max(lg); const float ex = expf(lg - mx); const float sm = wave_sum(ex) * 0.25f;
        if ((F.lane & 3) == 0) { const int b = m / SEQ, s = m % SEQ; AFF[(size_t)(b * 16 + red16_idx(F.lane)) * SEQ + s] = ex / sm; }
    }
}

DI int block_excl_scan(int v, LAS int* scratch, int tid, int lane, int wave, int* tot) {
    int inc = v;
#pragma unroll
    for (int o = 1; o < 64; o <<= 1) { const int t = __shfl_up(inc, o); if (lane >= o) inc += t; }
    __syncthreads();
    if (lane == 63) scratch[wave] = inc;
    __syncthreads();
    int base = 0, total = 0;
#pragma unroll
    for (int w = 0; w < NWAVES; ++w) { const int s = scratch[w]; if (w < wave) base += s; total += s; }
    *tot = total;
    return base + inc - v;
}
DI void phase_topk(Frame& F) {
    const float* AFF = (const float*)(F.ws + WS_AFF); int* IDX = (int*)(F.ws + WS_IDX); float* GATE = (float*)(F.ws + WS_GATE); int* POS = (int*)(F.ws + WS_POS);
    LAS unsigned* hist = (LAS unsigned*)F.lds; LAS int* sc = (LAS int*)(F.lds + 2048); LAS unsigned* shv = (LAS unsigned*)(F.lds + 2048 + 256);
    for (int u = F.bid; u < BATCH * NEXP; u += F.G) {
        const int b = u / NEXP, e = u % NEXP;
        unsigned vals[16];
        { const v4u* src = (const v4u*)(AFF + (size_t)u * SEQ + 16 * F.tid);
#pragma unroll
          for (int j = 0; j < 4; ++j) { const v4u t = src[j]; vals[4 * j] = t.x; vals[4 * j + 1] = t.y; vals[4 * j + 2] = t.z; vals[4 * j + 3] = t.w; } }
        unsigned prefix = 0; int krem = CAP;
        for (int pass = 0; pass < 4; ++pass) { const int shift = 24 - 8 * pass;
            __syncthreads();
            if (F.tid < 256) hist[F.tid] = 0u;
            __syncthreads();
#pragma unroll
            for (int j = 0; j < 16; ++j) { const unsigned v = vals[j]; if (pass == 0 || (v >> (shift + 8)) == prefix) __hip_atomic_fetch_add(&hist[(v >> shift) & 255u], 1u, __ATOMIC_RELAXED, __HIP_MEMORY_SCOPE_WORKGROUP); }
            __syncthreads();
            if (F.tid == 0) { int cum = 0, sel = 0; for (int bin = 255; bin >= 0; --bin) { const int c = (int)hist[bin]; if (cum + c >= krem) { sel = bin; break; } cum += c; }
                shv[0] = (prefix << 8) | (unsigned)sel; shv[1] = (unsigned)(krem - cum); }
            __syncthreads();
            prefix = shv[0]; krem = (int)shv[1];
        }
        const unsigned T = prefix;
        int ce = 0;
#pragma unroll
        for (int j = 0; j < 16; ++j) ce += (vals[j] == T) ? 1 : 0;
        int tot; int pe = block_excl_scan(ce, sc, F.tid, F.lane, F.wave, &tot);
        unsigned selmask = 0; int cs = 0;
#pragma unroll
        for (int j = 0; j < 16; ++j) { bool s = vals[j] > T; if (vals[j] == T) { s = pe < krem; ++pe; } if (s) { selmask |= 1u << j; ++cs; } }
        int slot = block_excl_scan(cs, sc, F.tid, F.lane, F.wave, &tot);
#pragma unroll
        for (int j = 0; j < 16; ++j) { const int s = 16 * F.tid + j; const int tokrow = b * SEQ + s;
            if (selmask & (1u << j)) { const int row = (e * 2 + b) * CAP + slot; ++slot; IDX[row] = tokrow; GATE[row] = __builtin_bit_cast(float, vals[j]); POS[tokrow * 16 + e] = row; }
            else POS[tokrow * 16 + e] = -1; }
    }
}
DI void phase_gather(Frame& F) {
    const bf16* H = (const bf16*)(F.ws + WS_H); bf16* XE = (bf16*)(F.ws + WS_XE); const int* IDX = (const int*)(F.ws + WS_IDX);
    for (int r = F.gw; r < NROWS; r += F.NGW) { const int src = IDX[r];
        const v4u* s = (const v4u*)(H + (size_t)src * DM) + F.lane; v4u* d = (v4u*)(XE + (size_t)r * DM) + F.lane;
        d[0] = s[0]; d[64] = s[64]; }
}
DI void phase_moe_combine(Frame& F, float* XR, const float* gnext, bool final_out) {
    const bf16* Y = (const bf16*)(F.ws + WS_Y); const int* POS = (const int*)(F.ws + WS_POS); bf16* H = (bf16*)(F.ws + WS_H);
    for (int m = F.gw; m < MTOK; m += F.NGW) {
        f32x4* xr = (f32x4*)(XR + (size_t)m * DM) + F.lane;
        f32x4 v[4];
#pragma unroll
        for (int j = 0; j < 4; ++j) v[j] = xr[64 * j];
        const int pmine = POS[m * 16 + (F.lane & 15)];
        for (int e = 0; e < 16; ++e) { const int p = __shfl(pmine, e);
            if (p >= 0) { const v2u* yr = (const v2u*)(Y + (size_t)p * DM) + F.lane;
#pragma unroll
                for (int j = 0; j < 4; ++j) { const v2u w = yr[64 * j]; v[j].x += bflo(w.x); v[j].y += bfhi(w.x); v[j].z += bflo(w.y); v[j].w += bfhi(w.y); } } }
        float s = 0.f;
#pragma unroll
        for (int j = 0; j < 4; ++j) s += (v[j].x * v[j].x + v[j].y * v[j].y) + (v[j].z * v[j].z + v[j].w * v[j].w);
        const float rstd = 1.f / sqrtf(wave_sum(s) * (1.f / DM) + EPS);
        const f32x4* gr = (const f32x4*)gnext + F.lane;
        if (final_out) {
#pragma unroll
            for (int j = 0; j < 4; ++j) xr[64 * j] = v[j] * rstd * gr[64 * j];
        } else {
#pragma unroll
            for (int j = 0; j < 4; ++j) xr[64 * j] = v[j];
            f32x4 nv[4];
#pragma unroll
            for (int j = 0; j < 4; ++j) nv[j] = v[j] * rstd * gr[64 * j];
            store_row_bf16(H + (size_t)m * DM, nv, F.lane);
        }
    }
}

DI void phase_attn_naive(Frame& F) {
    const bf16* QKV = (const bf16*)(F.ws + WS_QKV); bf16* ATT = (bf16*)(F.ws + WS_ATT); const float* BT = (const float*)(F.ws + WS_BT);
    LAS float* ql = (LAS float*)(F.lds + F.wave * 4096);
    LAS float* pl = ql + 64; LAS int* posl = (LAS int*)(ql + 512);
    const int lane = F.lane;
    for (int t = F.gw; t < MTOK * NHEAD; t += F.NGW) {
        const int row = t >> 4, h = t & 15, b = row / SEQ, tq = row % SEQ;
        ql[lane] = bf2f(QKV[(size_t)row * NQKV + h * 64 + lane]);
        LDS_WAIT();
        float s[7]; int pos[7];
#pragma unroll
        for (int i = 0; i < 7; ++i) {
            const int slot = lane + 64 * i; const int p = slot / 129, j = slot % 129;
            const int dil = (p == 0) ? 1 : (p == 1 ? 4 : 16);
            const int mq = tq / dil, r = tq % dil, mk = mq - 64 + j;
            const bool valid = (slot < 387) && (mk >= 0) && (mk < SEQ / dil);
            pos[i] = valid ? (b * SEQ + r + dil * mk) : -1;
            float d = -1e30f;
            if (valid) { const v4u* kr = (const v4u*)(QKV + (size_t)pos[i] * NQKV + 1024 + h * 64); float acc = 0.f;
#pragma unroll
                for (int c = 0; c < 8; ++c) { const v4u w = kr[c];
                    acc += ql[8 * c] * bflo(w.x) + ql[8 * c + 1] * bfhi(w.x) + ql[8 * c + 2] * bflo(w.y) + ql[8 * c + 3] * bfhi(w.y) + ql[8 * c + 4] * bflo(w.z) + ql[8 * c + 5] * bfhi(w.z) + ql[8 * c + 6] * bflo(w.w) + ql[8 * c + 7] * bfhi(w.w); }
                d = acc + BT[(p * 16 + h) * 129 + j]; }
            s[i] = d;
        }
        float mx = s[0];
#pragma unroll
        for (int i = 1; i < 7; ++i) mx = fmaxf(mx, s[i]);
        mx = wave_max(mx);
        float sum = 0.f;
#pragma unroll
        for (int i = 0; i < 7; ++i) { const float pv = (pos[i] >= 0) ? expf(s[i] - mx) : 0.f; sum += pv; pl[lane + 64 * i] = pv; posl[lane + 64 * i] = pos[i]; }
        sum = wave_sum(sum);
        LDS_WAIT();
        float o = 0.f;
        for (int k = 0; k < 387; ++k) { const int pp = posl[k]; if (pp >= 0) o += pl[k] * bf2f(QKV[(size_t)pp * NQKV + 2048 + h * 64 + lane]); }
        ATT[(size_t)row * DM + h * 64 + lane] = (bf16)f2bf(o / sum);
        LDS_WAIT();
    }
}

__global__ void __launch_bounds__(NTHR, 2) fwd_kernel(Args args) {
    extern __shared__ __attribute__((aligned(16))) unsigned char lds[];
    Frame F;
    F.lds = (LAS unsigned char*)lds;
    F.MISC = (volatile LAS unsigned*)(F.lds + MISC_OFF);
    F.tid = threadIdx.x; F.lane = F.tid & 63; F.wave = __builtin_amdgcn_readfirstlane(F.tid >> 6);
    F.G = gridDim.x; F.bid = blockIdx.x; F.gw = F.bid * NWAVES + F.wave; F.NGW = F.G * NWAVES;
    F.ws = args.ws;
    unsigned* ctl = (unsigned*)(args.ws + WS_CTL);
    for (int u = F.tid; u < (LDS_BYTES - LDSCTL_OFF) / 4; u += NTHR) ((LAS unsigned*)(F.lds + LDSCTL_OFF))[u] = 0u;
    __syncthreads();
    const int lo = args.ph_lo, hi = args.ph_hi;
    XcdBarrier bar; bar.bar = ctl + CW_BAR + args.li * XCD_BAR_WORDS; bar.x = 0; bar.st = nullptr;
    if (hi - lo > 1) bar = xcd_barrier_post(ctl + CW_BAR + args.li * XCD_BAR_WORDS, F.MISC + 8);
#define IN(k) (lo <= (k) && (k) < hi)
#define SEAM(k) do { if (IN(k) && IN((k) + 1)) xcd_barrier(bar); } while (0)
    unsigned char* ws = args.ws;
    float* XR = args.out;

    if (IN(0)) { phase_prologue(F, args); } SEAM(0);
    if (IN(1)) {
        pg8::Gemm g{(const bf16*)(ws + WS_H), (const bf16*)(ws + WS_WIN), MTOK, NIN, DM}; pg8::StaticOrder S; S.init(MTOK, NIN, F.G, F.bid);
        EpiInProj E{(bf16*)(ws + WS_U), (bf16*)(ws + WS_GV), (bf16*)(ws + WS_Q), (bf16*)(ws + WS_V), (bf16*)(ws + WS_G), (float*)(ws + WS_LFF), (float*)(ws + WS_LFB), (const float*)(ws + WS_LB)};
        pg8::gemm_phase<EpiInProj, pg8::StaticOrder, true, true>(F.lds, g, S, E);
    } SEAM(1);
    if (IN(2)) { phase_a_ln(F, args); for (int u = F.bid; u < 512; u += F.G) gla_naive_unit(F, u, false); } SEAM(2);
    if (IN(3)) { phase_gla_scan(F); phase_a_mix_naive(F, args); } SEAM(3);
    if (IN(4)) { for (int u = F.bid; u < 512; u += F.G) gla_naive_unit(F, u, true); } SEAM(4);
    if (IN(5)) { phase_b_combine(F, args); } SEAM(5);
    if (IN(6)) {
        pg8::Gemm g{(const bf16*)(ws + WS_CAT), (const bf16*)(ws + WS_WOUT), MTOK, DM, DM}; pg8::StaticOrder S; S.init(MTOK, DM, F.G, F.bid);
        EpiResid E{args.in[0], XR};
        pg8::gemm_phase<EpiResid, pg8::StaticOrder, false, true>(F.lds, g, S, E);
    } SEAM(6);
#define MOE_BLOCK(L, pb) do { \
        if (IN(pb)) { phase_router(F, XR, args.in[2] + (L) * DM, args.in[15] + (L) * DM * NEXP); } SEAM(pb); \
        if (IN((pb) + 1)) { phase_topk(F); } SEAM((pb) + 1); \
        if (IN((pb) + 2)) { phase_gather(F); } SEAM((pb) + 2); \
        if (IN((pb) + 3)) { \
            pg8::Gemm g{(const bf16*)(ws + WS_XE), (const bf16*)(ws + WS_WGU), NROWS, 16 * 2048, DM}; GroupedOrder<8> S{F.G, F.bid}; \
            EpiGateUp E{(bf16*)(ws + WS_HMID)}; \
            pg8::gemm_phase<EpiGateUp, GroupedOrder<8>, true, true>(F.lds, g, S, E); \
        } SEAM((pb) + 3); \
        if (IN((pb) + 4)) { \
            pg8::Gemm g{(const bf16*)(ws + WS_HMID), (const bf16*)(ws + WS_WDN), NROWS, 16 * 1024, DFF}; GroupedOrder<4> S{F.G, F.bid}; \
            EpiDown E{(bf16*)(ws + WS_Y), (const float*)(ws + WS_GATE)}; \
            pg8::gemm_phase<EpiDown, GroupedOrder<4>, true, true>(F.lds, g, S, E); \
        } SEAM((pb) + 4); \
    } while (0)

    MOE_BLOCK(0, 7);
    if (IN(12)) { phase_moe_combine(F, XR, args.in[1] + DM, false); convert_moe_weights(F, args.in[16], args.in[17], args.in[18], 1); } SEAM(12);
    if (IN(13)) {
        pg8::Gemm g{(const bf16*)(ws + WS_H), (const bf16*)(ws + WS_WQKV), MTOK, NQKV, DM}; pg8::StaticOrder S; S.init(MTOK, NQKV, F.G, F.bid);
        EpiQKV E{(bf16*)(ws + WS_QKV)};
        pg8::gemm_phase<EpiQKV, pg8::StaticOrder, true, true>(F.lds, g, S, E);
    } SEAM(13);
    if (IN(14)) { phase_attn_naive(F); } SEAM(14);
    if (IN(15)) {
        pg8::Gemm g{(const bf16*)(ws + WS_ATT), (const bf16*)(ws + WS_WO), MTOK, DM, DM}; pg8::StaticOrder S; S.init(MTOK, DM, F.G, F.bid);
        EpiResid E{XR, XR};
        pg8::gemm_phase<EpiResid, pg8::StaticOrder, false, true>(F.lds, g, S, E);
    } SEAM(15);
    MOE_BLOCK(1, 16);
    if (IN(21)) { phase_moe_combine(F, XR, args.in[3], true); }
#undef MOE_BLOCK
#undef IN
#undef SEAM
}

#ifndef MK_N_LAUNCHES
#define MK_N_LAUNCHES 1
#endif
extern "C" void kernel_launch(void* const* d_in, const int* in_sizes, int n_in, void* d_out, int out_size, void* d_ws, size_t ws_size, hipStream_t stream) {
    static int grid = 0;
    if (grid == 0) {
        if (n_in != 19 || in_sizes[0] != MTOK * DM || out_size != MTOK * DM || ws_size < WS_END) { fprintf(stderr, "kernel_launch: unexpected shapes (n_in %d, in0 %d, out %d, ws %zu < %zu); nothing launched\n", n_in, n_in > 0 ? in_sizes[0] : -1, out_size, ws_size, (size_t)WS_END); grid = -1; return; }
        int dev = 0, cus = 0, per_cu = 0;
        if (hipGetDevice(&dev) != hipSuccess || hipDeviceGetAttribute(&cus, hipDeviceAttributeMultiprocessorCount, dev) != hipSuccess) { grid = -1; return; }
        if (hipFuncSetAttribute((const void*)fwd_kernel, hipFuncAttributeMaxDynamicSharedMemorySize, LDS_BYTES) != hipSuccess) { fprintf(stderr, "kernel_launch: hipFuncSetAttribute failed\n"); grid = -1; return; }
        if (hipOccupancyMaxActiveBlocksPerMultiprocessor(&per_cu, (const void*)fwd_kernel, NTHR, LDS_BYTES) != hipSuccess || per_cu < 1) { fprintf(stderr, "kernel_launch: occupancy query reports %d workgroups per CU\n", per_cu); }
        (void)hipGetLastError();
        grid = cus;
    }
    if (grid < 0) return;
    if (hipMemsetAsync((char*)d_ws + WS_CTL, 0, CTL_ZERO_BYTES, stream) != hipSuccess) return;
    Args a{};
    for (int i = 0; i < 19; ++i) a.in[i] = (const float*)d_in[i];
    a.out = (float*)d_out; a.ws = (unsigned char*)d_ws; a.pad = 0;
    static_assert(CW_BAR + MAX_BAR_REGIONS * XCD_BAR_WORDS <= (int)(CTL_ZERO_BYTES / 4), "barrier regions inside the memset region");
    const int nl = MK_N_LAUNCHES;
    for (int li = 0; li < nl; ++li) {
        a.ph_lo = (int)((long)NPHASE * li / nl); a.ph_hi = (int)((long)NPHASE * (li + 1) / nl); a.li = li;
        hipLaunchKernelGGL(fwd_kernel, dim3(grid), dim3(NTHR), LDS_BYTES, stream, a);
        const hipError_t le = hipPeekAtLastError();
        if (le != hipSuccess) { fprintf(stderr, "kernel_launch: launch %d failed: %s\n", li, hipGetErrorName(le)); break; }
    }
}
```

```cpp
#include <hip/hip_runtime.h>
#include <cstdio>
#include <cstdint>
namespace pg8 {
#define PG8_LAS __attribute__((address_space(3)))
typedef unsigned short bf16_t;
typedef short bf16x8 __attribute__((ext_vector_type(8)));
typedef float f32x4 __attribute__((ext_vector_type(4)));
typedef unsigned u32x4 __attribute__((ext_vector_type(4)));
constexpr int BM = 256, BK = 64, HALF = 128, HTB = HALF * BK * 2  , STAGE_BYTES = 8 * HTB, NXCD = 8, WGM = 8;

__host__ __device__ __forceinline__ int lds_byte(int r, int c) { const int st = (r >> 4) * 2 + (c >> 5), rr = r & 15, cc = c & 31, ob = rr * 64 + cc * 2; return st * 1024 + (ob ^ (((ob >> 9) & 1) << 5)); }
__host__ __device__ __forceinline__ void stage_rc(int b, int& R, int& C) { const int st = b / 1024, sb = b % 1024, swz = sb ^ (((sb >> 9) & 1) << 5); R = (st >> 1) * 16 + swz / 64; C = (st & 1) * 32 + (swz % 64) / 2; }
__host__ __device__ __forceinline__ int perm32(int rho) { const int n = rho >> 4, i = rho & 15; return 8 * (i >> 2) + 4 * n + (i & 3); }

struct Unit { int pm, pn; };
struct Gemm { const bf16_t* A; const bf16_t* Bt; int M, N, K; };

struct StaticOrder {
    int nM, nN, nwg, G, c;
    __host__ __device__ void init(int M, int N, int G_, int c_) { nM = M / BM; nN = N / BM; nwg = nM * nN; G = G_; c = c_; }
    __host__ __device__ bool next(int i, Unit& u) const {
        const long L = (long)i * G + c; if (L >= nwg) return false;
        int wgid = (int)L; { const int q = nwg / NXCD, r = nwg % NXCD, xcd = wgid % NXCD, off = wgid / NXCD; wgid = (xcd < r ? xcd * (q + 1) : r * (q + 1) + (xcd - r) * q) + off; }
        const int nig = WGM * nN, gid = wgid / nig, fm = gid * WGM, gsz = (nM - fm) < WGM ? (nM - fm) : WGM;
        u.pm = fm + ((wgid % nig) % gsz); u.pn = (wgid % nig) / gsz; return true;
    }
    __device__ __forceinline__ void a_ready(const Unit&) const {}
    __device__ __forceinline__ void done(const Unit&) const {}
};

__device__ __forceinline__ unsigned cvt_pk_bf16(float lo, float hi) { unsigned r; asm volatile("v_cvt_pk_bf16_f32 %0, %1, %2" : "=v"(r) : "v"(lo), "v"(hi)); return r; }
typedef float f32x2 __attribute__((ext_vector_type(2)));
__device__ __forceinline__ f32x2 gelu_pk(f32x2 v) {
    const f32x2 av = __builtin_elementwise_abs(v), d = av * 0.2316418882f + 1.0f;
    f32x2 t; t.x = __builtin_amdgcn_rcpf(d.x); t.y = __builtin_amdgcn_rcpf(d.y);
    f32x2 q = t * 0.5307027145f + (-0.7265760135f); q = q * t + 0.7107068705f; q = q * t + (-0.142248368f); q = q * t + 0.127414796f; q = q * t;
    const f32x2 s = (v * v) * (-0.72134752044f);
    f32x2 e; e.x = __builtin_amdgcn_exp2f(s.x); e.y = __builtin_amdgcn_exp2f(s.y);
    const f32x2 m = v * (q * e), r = v - m;
    f32x2 o; o.x = v.x < 0.f ? m.x : r.x; o.y = v.y < 0.f ? m.y : r.y; return o;
}

template <int ACT  > struct EpiBf16 {
    static constexpr bool PERM = true, AFTER_DRAIN = false; static_assert(ACT == 0 || ACT == 1, "EpiBf16: ACT is 0 (none) or 1 (gelu_pk)");
    bf16_t* O; int ldc; const float* bias; int split_cols; size_t split_stride; float scale0;
    __device__ __forceinline__ void operator()(const f32x4 (&acc)[2][2][4][2], const Unit& u, int wr, int wc, int fr, int fq) const {
        const int row0 = u.pm * BM + wr * 64 + fr; int colt = u.pn * BM; bf16_t* base = O;
        float sc = 1.f; if (split_cols) { const int t = colt / split_cols; base += (size_t)t * split_stride; colt -= t * split_cols; if (t == 0) sc = scale0; }
        const int col0 = colt + wc * 32 + 8 * fq, bcol0 = u.pn * BM + wc * 32 + 8 * fq;
        f32x4 bv[2][2];
#pragma unroll
        for (int bj = 0; bj < 2; ++bj)
#pragma unroll
            for (int n = 0; n < 2; ++n) bv[bj][n] = bias ? *(const f32x4*)(bias + bcol0 + bj * HALF + 4 * n) : (f32x4){0.f, 0.f, 0.f, 0.f};
#pragma unroll
        for (int ai = 0; ai < 2; ++ai)
#pragma unroll
            for (int m = 0; m < 4; ++m) { bf16_t* rowp = base + (size_t)(row0 + ai * HALF + m * 16) * ldc + col0;
#pragma unroll
                for (int bj = 0; bj < 2; ++bj) { f32x4 v0 = acc[ai][bj][m][0] + bv[bj][0], v1 = acc[ai][bj][m][1] + bv[bj][1];
                    if (ACT == 1) { f32x2 a = gelu_pk((f32x2){v0[0], v0[1]}), b = gelu_pk((f32x2){v0[2], v0[3]}), c = gelu_pk((f32x2){v1[0], v1[1]}), d = gelu_pk((f32x2){v1[2], v1[3]});
                        v0 = (f32x4){a.x, a.y, b.x, b.y}; v1 = (f32x4){c.x, c.y, d.x, d.y}; }
                    v0 = v0 * sc; v1 = v1 * sc; u32x4 w; w.x = cvt_pk_bf16(v0[0], v0[1]); w.y = cvt_pk_bf16(v0[2], v0[3]); w.z = cvt_pk_bf16(v1[0], v1[1]); w.w = cvt_pk_bf16(v1[2], v1[3]);
                    *(u32x4*)(rowp + bj * HALF) = w; } }
    }
};
template <class Epi, class Sched, bool ALIGN_EPI = false, bool SP2 = false>
__device__ __forceinline__ void gemm_phase(PG8_LAS unsigned char* lds, const Gemm g, const Sched& S, const Epi& E) {
    const int tid = threadIdx.x, wid = __builtin_amdgcn_readfirstlane(tid >> 6), lane = tid & 63, wr = wid >> 2, wc = wid & 3, fr = lane & 15, fq = lane >> 4;
    const int K = g.K, nt = K / BK;
    unsigned voffA[2], voffB[2];
#pragma unroll
    for (int i = 0; i < 2; ++i) { int R, C; stage_rc(tid * 16 + i * 8192, R, C); const int Rb = Epi::PERM ? ((R & ~31) + perm32(R & 31)) : R;
        voffA[i] = (unsigned)(R * K + C) * 2u; voffB[i] = (unsigned)(Rb * K + C) * 2u; }
    const size_t kstep = (size_t)(BK * 2);
    const size_t hstep = (size_t)HALF * K * 2;
    const size_t tstep = 2 * hstep;
    const unsigned ldsw = (unsigned)wid * 1024u;
    const int aoff = lds_byte(wr * 64 + fr, fq * 8), boff = lds_byte(wc * 32 + fr, fq * 8);
#define PG8_SA(b, h) (((b) * 2 + (h)) * HTB)
#define PG8_SB(b, h) ((4 + (b) * 2 + (h)) * HTB)
#define PG8_STAGE(bufoff, gbase, voff) do { _Pragma("unroll") for (int _i = 0; _i < 2; ++_i) \
        __builtin_amdgcn_global_load_lds((const unsigned*)((const char*)(gbase) + (voff)[_i]), (PG8_LAS unsigned*)(lds + (bufoff) + ldsw + _i * 8192), 16, 0, 0); } while (0)
#define PG8_LDA(dst, b, h) do { _Pragma("unroll") for (int m = 0; m < 4; ++m) _Pragma("unroll") for (int k = 0; k < 2; ++k) dst[m][k] = *(const PG8_LAS bf16x8*)(lds + PG8_SA(b, h) + aoff + m * 2048 + k * 1024); } while (0)
#define PG8_LDB(dst, b, h) do { _Pragma("unroll") for (int n = 0; n < 2; ++n) _Pragma("unroll") for (int k = 0; k < 2; ++k) dst[n][k] = *(const PG8_LAS bf16x8*)(lds + PG8_SB(b, h) + boff + n * 2048 + k * 1024); } while (0)
#define PG8_MMA(ai, bj, At, Bt) do { __builtin_amdgcn_s_setprio(1); _Pragma("unroll") for (int m = 0; m < 4; ++m) _Pragma("unroll") for (int n = 0; n < 2; ++n) _Pragma("unroll") for (int k = 0; k < 2; ++k) \
        acc[ai][bj][m][n] = __builtin_amdgcn_mfma_f32_16x16x32_bf16(Bt[n][k], At[m][k], acc[ai][bj][m][n], 0, 0, 0); __builtin_amdgcn_s_setprio(0); } while (0)
#define PG8_WAIT_V(n) asm volatile("s_waitcnt vmcnt(" #n ")" ::: "memory")
#define PG8_WAIT_L(n) asm volatile("s_waitcnt lgkmcnt(" #n ")" ::: "memory")
#define PG8_BAR __builtin_amdgcn_s_barrier()
#define PG8_SCHED __builtin_amdgcn_sched_barrier(0)
    Unit cur, nxt; int ui = 0;
    if (!S.next(0, cur)) return;
    f32x4 acc[2][2][4][2];
#pragma unroll
    for (int a = 0; a < 2; ++a)
#pragma unroll
        for (int b = 0; b < 2; ++b)
#pragma unroll
            for (int m = 0; m < 4; ++m)
#pragma unroll
                for (int n = 0; n < 2; ++n) acc[a][b][m][n] = (f32x4){0.f, 0.f, 0.f, 0.f};
    bf16x8 At[4][2], B0[2][2], B1[2][2];
    const char* cA = (const char*)g.A + (size_t)cur.pm * tstep; const char* cB = (const char*)g.Bt + (size_t)cur.pn * tstep;
    S.a_ready(cur);
    if constexpr (SP2) {
        PG8_STAGE(PG8_SB(0, 0), cB, voffB); PG8_STAGE(PG8_SB(0, 1), cB + hstep, voffB); PG8_STAGE(PG8_SA(0, 0), cA, voffA); PG8_STAGE(PG8_SA(0, 1), cA + hstep, voffA);
        if (wr == 1) PG8_BAR;
        PG8_WAIT_V(2); PG8_BAR;
        PG8_STAGE(PG8_SB(1, 0), cB + kstep, voffB); PG8_STAGE(PG8_SA(1, 0), cA + kstep, voffA); PG8_STAGE(PG8_SB(1, 1), cB + hstep + kstep, voffB);
        PG8_WAIT_V(6); PG8_BAR;
    } else {
        PG8_STAGE(PG8_SB(0, 0), cB, voffB); PG8_STAGE(PG8_SA(0, 0), cA, voffA); PG8_STAGE(PG8_SB(0, 1), cB + hstep, voffB); PG8_STAGE(PG8_SA(0, 1), cA + hstep, voffA);
        if (wr == 1) PG8_BAR;
        PG8_WAIT_V(4); PG8_BAR;
        PG8_STAGE(PG8_SB(1, 0), cB + kstep, voffB); PG8_STAGE(PG8_SA(1, 0), cA + kstep, voffA); PG8_STAGE(PG8_SB(1, 1), cB + hstep + kstep, voffB);
        PG8_WAIT_V(6); PG8_BAR;
    }
    for (;;) {
        const bool has_next = S.next(ui + 1, nxt);
        const char* nA = has_next ? (const char*)g.A + (size_t)nxt.pm * tstep : cA; const char* nB = has_next ? (const char*)g.Bt + (size_t)nxt.pn * tstep : cB;
        for (int t = 0; t < nt; t += 2) {
            const bool last = (t == nt - 2);
            const char* a1 = cA + (size_t)(t + 1) * kstep;
            const char* a2 = last ? nA : cA + (size_t)(t + 2) * kstep; const char* b2 = last ? nB : cB + (size_t)(t + 2) * kstep;
            const char* a3 = a2 + kstep; const char* b3 = b2 + kstep;
            if (last && has_next) S.a_ready(nxt);
            if constexpr (SP2) {
            PG8_LDB(B0, 0, 0); PG8_LDB(B1, 0, 1); PG8_SCHED; PG8_LDA(At, 0, 0); PG8_STAGE(PG8_SA(1, 1), a1 + hstep, voffA);
            PG8_WAIT_V(8); PG8_WAIT_L(0); PG8_BAR; PG8_MMA(0, 0, At, B0); PG8_MMA(0, 1, At, B1); PG8_BAR; PG8_SCHED;
            PG8_LDA(At, 0, 1); PG8_STAGE(PG8_SB(0, 0), b2, voffB); PG8_STAGE(PG8_SB(0, 1), b2 + hstep, voffB); PG8_STAGE(PG8_SA(0, 0), a2, voffA);
            PG8_WAIT_V(8); PG8_WAIT_L(0); PG8_BAR; PG8_MMA(1, 0, At, B0); PG8_MMA(1, 1, At, B1); PG8_BAR; PG8_SCHED;
            PG8_LDB(B0, 1, 0); PG8_LDB(B1, 1, 1); PG8_SCHED; PG8_LDA(At, 1, 0); PG8_STAGE(PG8_SA(0, 1), a2 + hstep, voffA);
            PG8_WAIT_V(8); PG8_WAIT_L(0); PG8_BAR; PG8_MMA(0, 0, At, B0); PG8_MMA(0, 1, At, B1); PG8_BAR; PG8_SCHED;
            PG8_LDA(At, 1, 1); PG8_STAGE(PG8_SB(1, 0), b3, voffB); PG8_STAGE(PG8_SB(1, 1), b3 + hstep, voffB); PG8_STAGE(PG8_SA(1, 0), a3, voffA);
            PG8_WAIT_V(8); PG8_WAIT_L(0); PG8_BAR; PG8_MMA(1, 0, At, B0); PG8_MMA(1, 1, At, B1); PG8_BAR; PG8_SCHED;
            } else {
            PG8_LDB(B0, 0, 0); PG8_SCHED; PG8_LDA(At, 0, 0); PG8_STAGE(PG8_SA(1, 1), a1 + hstep, voffA);
            PG8_WAIT_L(8); PG8_BAR; PG8_WAIT_L(0); PG8_MMA(0, 0, At, B0); PG8_BAR; PG8_SCHED;
            PG8_LDB(B1, 0, 1); PG8_STAGE(PG8_SB(0, 0), b2, voffB);
            PG8_BAR; PG8_WAIT_L(0); PG8_MMA(0, 1, At, B1); PG8_BAR;
            PG8_LDA(At, 0, 1); PG8_STAGE(PG8_SA(0, 0), a2, voffA);
            PG8_BAR; PG8_WAIT_L(0); PG8_MMA(1, 0, At, B0); PG8_BAR; PG8_SCHED;
            PG8_STAGE(PG8_SB(0, 1), b2 + hstep, voffB);
            PG8_WAIT_V(6); PG8_BAR; PG8_MMA(1, 1, At, B1); PG8_BAR;
            PG8_LDB(B0, 1, 0); PG8_SCHED; PG8_LDA(At, 1, 0); PG8_STAGE(PG8_SA(0, 1), a2 + hstep, voffA);
            PG8_WAIT_L(8); PG8_BAR; PG8_WAIT_L(0); PG8_MMA(0, 0, At, B0); PG8_BAR; PG8_SCHED;
            PG8_LDB(B1, 1, 1); PG8_STAGE(PG8_SB(1, 0), b3, voffB);
            PG8_BAR; PG8_WAIT_L(0); PG8_MMA(0, 1, At, B1); PG8_BAR;
            PG8_LDA(At, 1, 1); PG8_STAGE(PG8_SA(1, 0), a3, voffA);
            PG8_BAR; PG8_WAIT_L(0); PG8_MMA(1, 0, At, B0); PG8_BAR; PG8_SCHED;
            PG8_STAGE(PG8_SB(1, 1), b3 + hstep, voffB);
            PG8_WAIT_V(6); PG8_BAR; PG8_MMA(1, 1, At, B1); PG8_BAR;
            }
        }
        if constexpr (ALIGN_EPI) { if (wr == 0) PG8_BAR; }
        if constexpr (!Epi::AFTER_DRAIN) { E(acc, cur, wr, wc, fr, fq); S.done(cur); }
        if (!has_next) break;
#pragma unroll
        for (int a = 0; a < 2; ++a)
#pragma unroll
            for (int b = 0; b < 2; ++b)
#pragma unroll
                for (int m = 0; m < 4; ++m)
#pragma unroll
                    for (int n = 0; n < 2; ++n) acc[a][b][m][n] = (f32x4){0.f, 0.f, 0.f, 0.f};
        cur = nxt; cA = nA; cB = nB; ++ui;
        if constexpr (ALIGN_EPI) { if (wr == 1) PG8_BAR; }
    }
    PG8_WAIT_V(0);
    if constexpr (!ALIGN_EPI) { if (wr == 0) PG8_BAR; }
    PG8_BAR;
    if constexpr (Epi::AFTER_DRAIN) { E.fused(acc, cur, wr, wc, fr, fq, lds, wid, lane); S.done(cur); }
#undef PG8_SA
#undef PG8_SB
#undef PG8_STAGE
#undef PG8_LDA
#undef PG8_LDB
#undef PG8_MMA
#undef PG8_WAIT_V
#undef PG8_WAIT_L
#undef PG8_BAR
#undef PG8_SCHED
}
}
#define LAS __attribute__((address_space(3)))
#define DI __device__ __forceinline__
typedef unsigned short bf16;
typedef unsigned v4u __attribute__((ext_vector_type(4)));
typedef unsigned v2u __attribute__((ext_vector_type(2)));
typedef float f32x4 __attribute__((ext_vector_type(4)));
typedef short bf16x8 __attribute__((ext_vector_type(8)));
#define LDS_WAIT() asm volatile("s_waitcnt lgkmcnt(0)" ::: "memory")
#define VM_WAIT() asm volatile("s_waitcnt vmcnt(0)" ::: "memory")
DI unsigned f2bf(float f) { unsigned u = __builtin_bit_cast(unsigned, f); return (u + 0x7fffu + ((u >> 16) & 1u)) >> 16; }
DI unsigned pk2(float lo, float hi) { return f2bf(lo) | (f2bf(hi) << 16); }
DI float bf2f(unsigned b) { return __builtin_bit_cast(float, b << 16); }
DI float bflo(unsigned w) { return __builtin_bit_cast(float, w << 16); }
DI float bfhi(unsigned w) { return __builtin_bit_cast(float, w & 0xffff0000u); }
DI float fexp(float x) { return __builtin_amdgcn_exp2f(x * 1.4426950408889634f); }
DI float flog(float x) { return __builtin_amdgcn_logf(x) * 0.6931471805599453f; }
DI float frcp(float x) { return __builtin_amdgcn_rcpf(x); }
DI float sigmoidf_(float x) { return frcp(1.f + fexp(-x)); }
DI float siluf_(float x) { return x * sigmoidf_(x); }
DI float gelu_tanh(float x) { const float u = 0.7978845608028654f * (x + 0.044715f * x * x * x); return x * sigmoidf_(2.f * u); }
DI float wave_sum(float v) {
#pragma unroll
    for (int o = 1; o < 64; o <<= 1) v += __shfl_xor(v, o);
    return v;
}
DI float wave_max(float v) {
#pragma unroll
    for (int o = 1; o < 64; o <<= 1) v = fmaxf(v, __shfl_xor(v, o));
    return v;
}
DI int red16_idx(int lane) { return 8 * ((lane >> 5) & 1) + 4 * ((lane >> 4) & 1) + 2 * ((lane >> 3) & 1) + ((lane >> 2) & 1); }
DI float red16(const float (&o)[16], int lane) {
    const bool b32 = lane & 32, b16 = lane & 16, b8 = lane & 8, b4 = lane & 4;
    float a8[8], a4[4], a2[2], a1;
#pragma unroll
    for (int j = 0; j < 8; ++j) { const float send = b32 ? o[j] : o[j + 8], keep = b32 ? o[j + 8] : o[j]; a8[j] = keep + __shfl_xor(send, 32); }
#pragma unroll
    for (int j = 0; j < 4; ++j) { const float send = b16 ? a8[j] : a8[j + 4], keep = b16 ? a8[j + 4] : a8[j]; a4[j] = keep + __shfl_xor(send, 16); }
#pragma unroll
    for (int j = 0; j < 2; ++j) { const float send = b8 ? a4[j] : a4[j + 2], keep = b8 ? a4[j + 2] : a4[j]; a2[j] = keep + __shfl_xor(send, 8); }
    { const float send = b4 ? a2[0] : a2[1], keep = b4 ? a2[1] : a2[0]; a1 = keep + __shfl_xor(send, 4); }
    a1 += __shfl_xor(a1, 2); a1 += __shfl_xor(a1, 1);
    return a1;
}
#define XB_TMO      128
#define XB_XCNT(j)  (256  + 64 * (j))
#define XB_XSUB(j)  (1280 + 64 * (j))
#define XB_XGEN(j)  (2304 + 64 * (j))
#define XB_TOP      3328
#define XB_TOPGEN   3392
#define XCD_BAR_WORDS 3456
#define XB_SPIN_CAP (1u << 18)

__device__ __forceinline__ unsigned xb_ld(unsigned* p)              { return __hip_atomic_load(p, __ATOMIC_RELAXED, __HIP_MEMORY_SCOPE_AGENT); }
__device__ __forceinline__ unsigned xb_add(unsigned* p, unsigned v) { return __hip_atomic_fetch_add(p, v, __ATOMIC_RELAXED, __HIP_MEMORY_SCOPE_AGENT); }
__device__ __forceinline__ unsigned xb_xcc_id() { return (unsigned)__builtin_amdgcn_s_getreg((3 << 11) | 20) & 0xFu; }
#define XB_SPIN(cond, bar) do { unsigned _sp = 0; while (cond) { __builtin_amdgcn_s_sleep(1); \
    if ((++_sp & 255u) == 0u) { if (xb_ld(&(bar)[XB_TMO])) break; if (_sp > XB_SPIN_CAP) { atomicAdd(&(bar)[XB_TMO], 1u); break; } } } } while (0)

struct XcdBarrier {
    unsigned* bar; unsigned x;
    volatile LAS unsigned* st;
};

__device__ __forceinline__ XcdBarrier xcd_barrier_post(unsigned* bar, volatile LAS unsigned* st) {
    XcdBarrier b; b.bar = bar; b.x = xb_xcc_id(); b.st = st;
    if (threadIdx.x == 0) (void)xb_add(&bar[XB_XCNT(b.x)], 1u);
    return b;
}
__device__ __forceinline__ void xcd_barrier_complete(unsigned* bar, unsigned x, unsigned& nloc, unsigned& nx) {
    const unsigned G = gridDim.x * gridDim.y * gridDim.z;
    unsigned sum, cnt, mine, sp = 0u;
    for (;;) {
        sum = 0u; cnt = 0u; mine = 0u;
#pragma unroll
        for (unsigned j = 0; j < 16; ++j) { const unsigned c = xb_ld(&bar[XB_XCNT(j)]); sum += c; cnt += (c > 0u) ? 1u : 0u; mine = (j == x) ? c : mine; }
        if (sum == G) break;
        __builtin_amdgcn_s_sleep(1);
        if ((++sp & 255u) == 0u) { if (xb_ld(&bar[XB_TMO])) break; if (sp > XB_SPIN_CAP) { atomicAdd(&bar[XB_TMO], 1u); break; } }
    }
    nloc = mine > 0u ? mine : 1u; nx = cnt > 0u ? cnt : 1u;
}

__device__ __forceinline__ void xcd_barrier(const XcdBarrier& b) {
    asm volatile("s_waitcnt vmcnt(0)" ::: "memory");
    __syncthreads();
    if (threadIdx.x == 0) {
        unsigned* bar = b.bar;
        __builtin_amdgcn_s_waitcnt(0);
        unsigned nloc = b.st[0], nx = b.st[1];
        if (nloc == 0u) { xcd_barrier_complete(bar, b.x, nloc, nx); b.st[0] = nloc; b.st[1] = nx; }
        const unsigned old = xb_add(&bar[XB_XSUB(b.x)], 1u);
        const unsigned gen = old / nloc;
        if (old + 1u == (gen + 1u) * nloc) {
            __builtin_amdgcn_fence(__ATOMIC_RELEASE, "agent");
            asm volatile("s_waitcnt vmcnt(0)" ::: "memory");
            const unsigned og = xb_add(&bar[XB_TOP], 1u);
            const unsigned tg = og / nx;
            if (og + 1u == (tg + 1u) * nx) xb_add(&bar[XB_TOPGEN], 1u);
            else XB_SPIN(xb_ld(&bar[XB_TOPGEN]) == tg, bar);
            __builtin_amdgcn_fence(__ATOMIC_ACQUIRE, "agent");
            xb_add(&bar[XB_XGEN(b.x)], 1u);
            asm volatile("s_waitcnt vmcnt(0)" ::: "memory");
        } else {
            XB_SPIN(xb_ld(&bar[XB_XGEN(b.x)]) == gen, bar);
            __builtin_amdgcn_fence(__ATOMIC_ACQUIRE, "agent");
            asm volatile("s_waitcnt vmcnt(0)" ::: "memory");
        }
    }
    __syncthreads();
}
constexpr int NWAVES = 8, NTHR = 512;
constexpr int BATCH = 2, SEQ = 8192, DM = 1024, MTOK = BATCH * SEQ;
constexpr int NIN = 3584;
constexpr int AW = 512;
constexpr int NEXP = 16, DFF = 1024, CAP = 1024, NROWS = BATCH * NEXP * CAP;
constexpr int NSC = 32, SCLEN = 256;
constexpr int NHEAD = 16, HD = 64, NQKV = 3072;
constexpr float EPS = 1e-6f;
constexpr int NPHASE = 23;

constexpr size_t MiB = 1u << 20;
constexpr size_t WS_CTL = 0, CTL_ZERO_BYTES = 1 * MiB;
constexpr size_t WS_AFF = 1 * MiB;
constexpr size_t WS_POS = 2 * MiB;
constexpr size_t WS_IDX = 3 * MiB;
constexpr size_t WS_GATE = 3 * MiB + 256 * 1024;
constexpr size_t WS_DEC = 3 * MiB + 512 * 1024;
constexpr size_t WS_LB = 4 * MiB;
constexpr size_t WS_BT = 4 * MiB + 64 * 1024;
constexpr size_t WS_WIN = 8 * MiB;
constexpr size_t WS_WOUT = 15 * MiB;
constexpr size_t WS_WQKV = 17 * MiB;
constexpr size_t WS_WO = 23 * MiB;
constexpr size_t WS_WGU = 32 * MiB;
constexpr size_t WS_WDN = 96 * MiB;
constexpr size_t WS_H = 128 * MiB;
constexpr size_t WS_R1 = 160 * MiB;
constexpr size_t WS_U = WS_R1, WS_GV = WS_R1 + 16 * MiB, WS_Q = WS_R1 + 32 * MiB, WS_V = WS_R1 + 48 * MiB, WS_G = WS_R1 + 64 * MiB;
constexpr size_t WS_LFF = WS_R1 + 80 * MiB, WS_LFB = WS_R1 + 112 * MiB;
constexpr size_t WS_CAT = WS_R1 + 144 * MiB;
constexpr size_t WS_ST = WS_R1 + 176 * MiB;
constexpr size_t WS_ODIR = WS_R1 + 208 * MiB;
constexpr size_t WS_XE = WS_R1, WS_Y = WS_R1;
constexpr size_t WS_HMID = WS_R1 + 64 * MiB;
constexpr size_t WS_QKV = WS_R1;
constexpr size_t WS_ATT = WS_R1 + 96 * MiB;
constexpr size_t WS_VT = WS_R1 + 128 * MiB;
constexpr size_t WS_END = WS_R1 + 272 * MiB;
constexpr int CW_BAR = 4096;
constexpr int MAX_BAR_REGIONS = 24;

constexpr int RING_BYTES = 131072;
constexpr int LDS_BYTES = 147456;
constexpr int LDSCTL_OFF = LDS_BYTES - 512, MISC_OFF = LDSCTL_OFF + 320;

struct Args { const float* in[19]; float* out; unsigned char* ws; int ph_lo, ph_hi, li, pad; };

struct Frame {
    LAS unsigned char* lds;
    volatile LAS unsigned* MISC;
    int tid, lane, wave, G, bid, gw, NGW;
    unsigned char* ws;
};

template <int NPN_> struct GroupedOrder {
    int G, c;
    DI bool next(int i, pg8::Unit& u) const {
        const int L = i * G + c; if (L >= 16 * 8 * NPN_) return false;
        const int e = L / (8 * NPN_), w = L % (8 * NPN_);
        u.pm = e * 8 + (w & 7); u.pn = e * NPN_ + (w >> 3); return true;
    }
    DI void a_ready(const pg8::Unit&) const {}
    DI void done(const pg8::Unit&) const {}
};

struct EpiInProj {
    static constexpr bool PERM = true, AFTER_DRAIN = false;
    bf16 *U, *GV, *Q, *V, *G; float *LFf, *LFb; const float* LB;
    DI void operator()(const pg8::f32x4 (&acc)[2][2][4][2], const pg8::Unit& u, int wr, int wc, int fr, int fq) const {
        const int seg = u.pn >> 1;
        const int row0 = u.pm * 256 + wr * 64 + fr, lc0 = (u.pn & 1) * 256 + wc * 32 + 8 * fq;
#pragma unroll
        for (int bj = 0; bj < 2; ++bj) {
            const int lc = lc0 + bj * 128;
            float lb[8];
            if (seg == 3 || seg == 4) {
#pragma unroll
                for (int j = 0; j < 8; ++j) lb[j] = LB[(seg - 3) * 512 + lc + j];
            }
#pragma unroll
            for (int ai = 0; ai < 2; ++ai)
#pragma unroll
                for (int m = 0; m < 4; ++m) {
                    const size_t off = (size_t)(row0 + ai * 128 + m * 16) * 512 + lc;
                    float v[8];
#pragma unroll
                    for (int j = 0; j < 8; ++j) v[j] = acc[ai][bj][m][j >> 2][j & 3];
                    if (seg == 3 || seg == 4) {
#pragma unroll
                        for (int j = 0; j < 8; ++j) v[j] = flog(lb[j] + (1.f - lb[j]) * sigmoidf_(v[j]));
                        float* o = (seg == 3 ? LFf : LFb) + off;
                        *(f32x4*)o = (f32x4){v[0], v[1], v[2], v[3]}; *(f32x4*)(o + 4) = (f32x4){v[4], v[5], v[6], v[7]};
                    } else {
                        bf16* o;
                        if (seg == 0) { o = U;
#pragma unroll
                            for (int j = 0; j < 8; ++j) v[j] = gelu_tanh(v[j]);
                        } else if (seg == 1) { o = GV;
#pragma unroll
                            for (int j = 0; j < 8; ++j) v[j] = gelu_tanh(v[j]);
                        } else if (seg == 2) { o = Q;
#pragma unroll
                            for (int j = 0; j < 8; ++j) v[j] = siluf_(v[j]);
                        } else if (seg == 5) { o = V;
                        } else { o = G;
#pragma unroll
                            for (int j = 0; j < 8; ++j) v[j] = sigmoidf_(v[j]);
                        }
                        v4u w; w.x = pk2(v[0], v[1]); w.y = pk2(v[2], v[3]); w.z = pk2(v[4], v[5]); w.w = pk2(v[6], v[7]);
                        *(v4u*)(o + off) = w;
                    }
                }
        }
    }
};
struct EpiResid {
    static constexpr bool PERM = false, AFTER_DRAIN = false;
    const float* base; float* out;
    DI void operator()(const pg8::f32x4 (&acc)[2][2][4][2], const pg8::Unit& u, int wr, int wc, int fr, int fq) const {
        const int row0 = u.pm * 256 + wr * 64 + fr, col0 = u.pn * 256 + wc * 32 + 4 * fq;
#pragma unroll
        for (int ai = 0; ai < 2; ++ai)
#pragma unroll
            for (int m = 0; m < 4; ++m) { const size_t ro = (size_t)(row0 + ai * 128 + m * 16) * DM + col0;
#pragma unroll
                for (int bj = 0; bj < 2; ++bj)
#pragma unroll
                    for (int n = 0; n < 2; ++n) { const size_t o = ro + bj * 128 + n * 16; *(f32x4*)(out + o) = *(const f32x4*)(base + o) + acc[ai][bj][m][n]; } }
    }
};
struct EpiGateUp {
    static constexpr bool PERM = true, AFTER_DRAIN = false;
    bf16* H;
    DI void operator()(const pg8::f32x4 (&acc)[2][2][4][2], const pg8::Unit& u, int wr, int wc, int fr, int fq) const {
        const int pnl = u.pn & 7;
        const int row0 = u.pm * 256 + wr * 64 + fr, col0 = pnl * 128 + wc * 32 + 8 * fq;
#pragma unroll
        for (int ai = 0; ai < 2; ++ai)
#pragma unroll
            for (int m = 0; m < 4; ++m) {
                float v[8];
#pragma unroll
                for (int j = 0; j < 8; ++j) v[j] = siluf_(acc[ai][0][m][j >> 2][j & 3]) * acc[ai][1][m][j >> 2][j & 3];
                v4u w; w.x = pk2(v[0], v[1]); w.y = pk2(v[2], v[3]); w.z = pk2(v[4], v[5]); w.w = pk2(v[6], v[7]);
                *(v4u*)(H + (size_t)(row0 + ai * 128 + m * 16) * DFF + col0) = w;
            }
    }
};
struct EpiDown {
    static constexpr bool PERM = true, AFTER_DRAIN = false;
    bf16* Y; const float* gate;
    DI void operator()(const pg8::f32x4 (&acc)[2][2][4][2], const pg8::Unit& u, int wr, int wc, int fr, int fq) const {
        const int pnl = u.pn & 3;
        const int row0 = u.pm * 256 + wr * 64 + fr, col0 = pnl * 256 + wc * 32 + 8 * fq;
#pragma unroll
        for (int ai = 0; ai < 2; ++ai)
#pragma unroll
            for (int m = 0; m < 4; ++m) { const int row = row0 + ai * 128 + m * 16; const float g = gate[row];
#pragma unroll
                for (int bj = 0; bj < 2; ++bj) {
                    float v[8];
#pragma unroll
                    for (int j = 0; j < 8; ++j) v[j] = acc[ai][bj][m][j >> 2][j & 3] * g;
                    v4u w; w.x = pk2(v[0], v[1]); w.y = pk2(v[2], v[3]); w.z = pk2(v[4], v[5]); w.w = pk2(v[6], v[7]);
                    *(v4u*)(Y + (size_t)row * DM + col0 + bj * 128) = w; } }
    }
};
struct EpiQKV {
    static constexpr bool PERM = true, AFTER_DRAIN = false;
    bf16* O;
    DI void operator()(const pg8::f32x4 (&acc)[2][2][4][2], const pg8::Unit& u, int wr, int wc, int fr, int fq) const {
        const float sc = (u.pn < 4) ? 0.125f : 1.f;
        const int row0 = u.pm * 256 + wr * 64 + fr, col0 = u.pn * 256 + wc * 32 + 8 * fq;
#pragma unroll
        for (int ai = 0; ai < 2; ++ai)
#pragma unroll
            for (int m = 0; m < 4; ++m)
#pragma unroll
                for (int bj = 0; bj < 2; ++bj) {
                    float v[8];
#pragma unroll
                    for (int j = 0; j < 8; ++j) v[j] = acc[ai][bj][m][j >> 2][j & 3] * sc;
                    v4u w; w.x = pk2(v[0], v[1]); w.y = pk2(v[2], v[3]); w.z = pk2(v[4], v[5]); w.w = pk2(v[6], v[7]);
                    *(v4u*)(O + (size_t)(row0 + ai * 128 + m * 16) * NQKV + col0 + bj * 128) = w; }
    }
};

DI void transpose_item(const float* W, int K, int N, bf16* WT, LAS float* scr, int k0, int n0, int drow0, int lane) {
#pragma unroll 8
    for (int i = 0; i < 32; ++i) { const int kk = 2 * i + (lane >> 5); scr[kk * 33 + (lane & 31)] = W[(size_t)(k0 + kk) * N + n0 + (lane & 31)]; }
    LDS_WAIT(); asm volatile("" ::: "memory");
    const int c = lane & 7;
#pragma unroll
    for (int j = 0; j < 4; ++j) { const int n = (lane >> 3) + 8 * j; const LAS float* s = scr + (8 * c) * 33 + n;
        v4u o; o.x = pk2(s[0 * 33], s[1 * 33]); o.y = pk2(s[2 * 33], s[3 * 33]); o.z = pk2(s[4 * 33], s[5 * 33]); o.w = pk2(s[6 * 33], s[7 * 33]);
        *(v4u*)(WT + (size_t)(drow0 + n) * K + k0 + 8 * c) = o; }
    LDS_WAIT(); asm volatile("" ::: "memory");
}
DI void transpose_matrix(Frame& F, const float* W, int K, int N, bf16* WT) {
    LAS float* scr = (LAS float*)(F.lds + F.wave * 16384);
    const int nblk = N / 32, nitems = (K / 64) * nblk;
    for (int it = F.gw; it < nitems; it += F.NGW) { const int kb = it / nblk, nb = it % nblk; transpose_item(W, K, N, WT, scr, 64 * kb, 32 * nb, 32 * nb, F.lane); }
}
DI void convert_moe_weights(Frame& F, const float* wg, const float* wu, const float* wd, int layer) {
    LAS float* scr = (LAS float*)(F.lds + F.wave * 16384);
    bf16* WGU = (bf16*)(F.ws + WS_WGU); bf16* WDN = (bf16*)(F.ws + WS_WDN);
    for (int it = F.gw; it < 3 * 16 * 512; it += F.NGW) {
        const int mat = it / 8192, rem = it % 8192, e = rem / 512, r = rem % 512, kb = r / 32, nb = r % 32, n0 = 32 * nb;
        const size_t so = ((size_t)layer * 16 + e) * 1024 * 1024;
        if (mat == 0) transpose_item(wg + so, 1024, 1024, WGU + (size_t)e * 2048 * 1024, scr, 64 * kb, n0, (n0 >> 7) * 256 + (n0 & 127), F.lane);
        else if (mat == 1) transpose_item(wu + so, 1024, 1024, WGU + (size_t)e * 2048 * 1024, scr, 64 * kb, n0, (n0 >> 7) * 256 + 128 + (n0 & 127), F.lane);
        else transpose_item(wd + so, 1024, 1024, WDN + (size_t)e * 1024 * 1024, scr, 64 * kb, n0, n0, F.lane);
    }
}
DI void rms_row(const float* xrow, const float* g, f32x4 (&v)[4], int lane) {
    const f32x4* xr = (const f32x4*)xrow + lane; float s = 0.f;
#pragma unroll
    for (int j = 0; j < 4; ++j) { v[j] = xr[64 * j]; s += (v[j].x * v[j].x + v[j].y * v[j].y) + (v[j].z * v[j].z + v[j].w * v[j].w); }
    const float rstd = 1.f / sqrtf(wave_sum(s) * (1.f / DM) + EPS);
    const f32x4* gr = (const f32x4*)g + lane;
#pragma unroll
    for (int j = 0; j < 4; ++j) v[j] = v[j] * rstd * gr[64 * j];
}
DI void store_row_bf16(bf16* orow, const f32x4 (&v)[4], int lane) {
    v2u* o8 = (v2u*)orow + lane;
#pragma unroll
    for (int j = 0; j < 4; ++j) { v2u w; w.x = pk2(v[j].x, v[j].y); w.y = pk2(v[j].z, v[j].w); o8[64 * j] = w; }
}
DI int t5_bucket(int rel) {
    const int n = rel < 0 ? -rel : rel;
    int val;
    if (n < 8) val = n;
    else { const float sc = logf((float)n / 8.f) / 4.852030263919617f; int lg = 8 + (int)(sc * 8.f); val = lg < 15 ? lg : 15; }
    return (rel > 0 ? 16 : 0) + val;
}

DI void phase_prologue(Frame& F, const Args& a) {
    unsigned char* ws = F.ws;
    transpose_matrix(F, a.in[4], 1024, NIN, (bf16*)(ws + WS_WIN));
    transpose_matrix(F, a.in[5], 1024, 1024, (bf16*)(ws + WS_WOUT));
    transpose_matrix(F, a.in[12], 1024, NQKV, (bf16*)(ws + WS_WQKV));
    transpose_matrix(F, a.in[13], 1024, 1024, (bf16*)(ws + WS_WO));
    convert_moe_weights(F, a.in[16], a.in[17], a.in[18], 0);
    { float* LB = (float*)(ws + WS_LB); const float* t = a.in[10];
      for (int i = F.bid * NTHR + F.tid; i < 2 * 512; i += F.G * NTHR) { const int d = i / 512, k = i % 512;
          const float a0 = t[(d * 3 + 0) * 512 + k], a1 = t[(d * 3 + 1) * 512 + k], a2 = t[(d * 3 + 2) * 512 + k];
          const float mx = fmaxf(a0, fmaxf(a1, a2)); const float e0 = expf(a0 - mx), e1 = expf(a1 - mx), e2 = expf(a2 - mx);
          LB[i] = e0 / (e0 + e1 + e2); } }
    { float* BT = (float*)(ws + WS_BT); const float* rb = a.in[14];
      for (int i = F.bid * NTHR + F.tid; i < 3 * 16 * 129; i += F.G * NTHR) { const int p = i / (16 * 129), h = (i / 129) % 16, j = i % 129;
          const int dil = (p == 0) ? 1 : (p == 1 ? 4 : 16);
          BT[i] = rb[t5_bucket((j - 64) * dil) * 16 + h]; } }
    { bf16* H = (bf16*)(ws + WS_H); const float* x = a.in[0];
      for (int m = F.gw; m < MTOK; m += F.NGW) { f32x4 v[4]; rms_row(x + (size_t)m * DM, a.in[1], v, F.lane); store_row_bf16(H + (size_t)m * DM, v, F.lane); } }
}

DI void phase_a_ln(Frame& F, const Args& a) {
    bf16* GV = (bf16*)(F.ws + WS_GV); const float* lg = a.in[6]; const float* lbv = a.in[7];
    for (int m = F.gw; m < MTOK; m += F.NGW) {
        v4u w = *((const v4u*)(GV + (size_t)m * AW) + F.lane);
        float v[8] = {bflo(w.x), bfhi(w.x), bflo(w.y), bfhi(w.y), bflo(w.z), bfhi(w.z), bflo(w.w), bfhi(w.w)};
        float s = 0.f;
#pragma unroll
        for (int j = 0; j < 8; ++j) s += v[j];
        const float mu = wave_sum(s) * (1.f / AW); float s2 = 0.f;
#pragma unroll
        for (int j = 0; j < 8; ++j) { v[j] -= mu; s2 += v[j] * v[j]; }
        const float rstd = 1.f / sqrtf(wave_sum(s2) * (1.f / AW) + EPS);
#pragma unroll
        for (int j = 0; j < 8; ++j) v[j] = v[j] * rstd * lg[8 * F.lane + j] + lbv[8 * F.lane + j];
        v4u o; o.x = pk2(v[0], v[1]); o.y = pk2(v[2], v[3]); o.z = pk2(v[4], v[5]); o.w = pk2(v[6], v[7]);
        *((v4u*)(GV + (size_t)m * AW) + F.lane) = o;
    }
}
DI void phase_a_mix_naive(Frame& F, const Args& a) {
    const bf16* VN = (const bf16*)(F.ws + WS_GV); const bf16* U = (const bf16*)(F.ws + WS_U); bf16* CAT = (bf16*)(F.ws + WS_CAT);
    LAS float* wl = (LAS float*)F.lds; LAS float* vl = (LAS float*)(F.lds + 65536);
    for (int u = F.bid; u < 512; u += F.G) {
        const int g = u & 3, ch = u >> 2; const int row0 = ch * 128;
        __syncthreads();
        for (int i = F.tid; i < 128 * 128; i += NTHR) { wl[i] = a.in[8][g * 16384 + i]; const int s = i >> 7, c = i & 127; vl[i] = bf2f(VN[(size_t)(row0 + s) * AW + g * 128 + c]); }
        __syncthreads();
        const int c = F.tid & 127, tq = F.tid >> 7;
        for (int tt = 0; tt < 32; ++tt) { const int t = tq * 32 + tt; float acc = 0.f;
            for (int s = 0; s < 128; ++s) acc += wl[t * 128 + s] * vl[s * 128 + c];
            const float uu = bf2f(U[(size_t)(row0 + t) * AW + g * 128 + c]);
            CAT[(size_t)(row0 + t) * DM + g * 128 + c] = (bf16)f2bf(uu * (acc + a.in[9][g * 128 + t])); }
    }
}

DI void gla_naive_unit(Frame& F, int u, bool with_out) {
    const int sc = u & 31, dir = (u >> 5) & 1, h = (u >> 6) & 3, b = u >> 8;
    const bf16* Q = (const bf16*)(F.ws + WS_Q); const bf16* V = (const bf16*)(F.ws + WS_V);
    const float* LF = (const float*)(F.ws + (dir ? WS_LFB : WS_LFF));
    float* ST = (float*)(F.ws + WS_ST) + (size_t)u * 16384; float* DEC = (float*)(F.ws + WS_DEC) + u * 128;
    float* OD = (float*)(F.ws + WS_ODIR) + (size_t)dir * MTOK * AW;
    LAS bf16* qs = (LAS bf16*)F.lds; LAS bf16* vs = (LAS bf16*)(F.lds + 16384); LAS float* lfs = (LAS float*)(F.lds + 32768);
    const int lane = F.lane, w = F.wave;
    float S[2][16]; float lsum[2] = {0.f, 0.f};
#pragma unroll
    for (int aa = 0; aa < 2; ++aa)
#pragma unroll
        for (int j = 0; j < 16; ++j) S[aa][j] = with_out ? ST[(lane + 64 * aa) * 128 + 16 * w + j] : 0.f;
    for (int sub = 0; sub < 4; ++sub) {
        __syncthreads();
        for (int idx = F.tid; idx < 1024; idx += NTHR) { const int i = idx >> 4, c8 = (idx & 15) * 8; const int ii = sc * 256 + sub * 64 + i; const int tok = dir ? (SEQ - 1 - ii) : ii;
            const size_t go = (size_t)(b * SEQ + tok) * AW + h * 128 + c8;
            *(LAS v4u*)(qs + i * 128 + c8) = *(const v4u*)(Q + go); *(LAS v4u*)(vs + i * 128 + c8) = *(const v4u*)(V + go); }
        for (int idx = F.tid; idx < 2048; idx += NTHR) { const int i = idx >> 5, c4 = (idx & 31) * 4; const int ii = sc * 256 + sub * 64 + i; const int tok = dir ? (SEQ - 1 - ii) : ii;
            *(LAS f32x4*)(lfs + i * 128 + c4) = *(const f32x4*)(LF + (size_t)(b * SEQ + tok) * AW + h * 128 + c4); }
        __syncthreads();
        for (int i = 0; i < 64; ++i) {
            const float l0 = lfs[i * 128 + lane], l1 = lfs[i * 128 + lane + 64];
            const float f0 = fexp(l0), f1 = fexp(l1), k0 = 1.f - f0, k1 = 1.f - f1;
            lsum[0] += l0; lsum[1] += l1;
            float vv[16];
            { const v4u a0 = *(const LAS v4u*)(vs + i * 128 + 16 * w), a1 = *(const LAS v4u*)(vs + i * 128 + 16 * w + 8);
              vv[0] = bflo(a0.x); vv[1] = bfhi(a0.x); vv[2] = bflo(a0.y); vv[3] = bfhi(a0.y); vv[4] = bflo(a0.z); vv[5] = bfhi(a0.z); vv[6] = bflo(a0.w); vv[7] = bfhi(a0.w);
              vv[8] = bflo(a1.x); vv[9] = bfhi(a1.x); vv[10] = bflo(a1.y); vv[11] = bfhi(a1.y); vv[12] = bflo(a1.z); vv[13] = bfhi(a1.z); vv[14] = bflo(a1.w); vv[15] = bfhi(a1.w); }
#pragma unroll
            for (int j = 0; j < 16; ++j) { S[0][j] = f0 * S[0][j] + k0 * vv[j]; S[1][j] = f1 * S[1][j] + k1 * vv[j]; }
            if (with_out) {
                const float q0 = bf2f(qs[i * 128 + lane]), q1 = bf2f(qs[i * 128 + lane + 64]);
                float o[16];
#pragma unroll
                for (int j = 0; j < 16; ++j) o[j] = S[0][j] * q0 + S[1][j] * q1;
                const float tot = red16(o, lane);
                if ((lane & 3) == 0) { const int ii = sc * 256 + sub * 64 + i; const int tok = dir ? (SEQ - 1 - ii) : ii;
                    OD[(size_t)(b * SEQ + tok) * AW + h * 128 + 16 * w + red16_idx(lane)] = tot; }
            }
        }
    }
    if (!with_out) {
#pragma unroll
        for (int aa = 0; aa < 2; ++aa)
#pragma unroll
            for (int j = 0; j < 16; ++j) ST[(lane + 64 * aa) * 128 + 16 * w + j] = S[aa][j];
        if (w == 0) { DEC[lane] = fexp(lsum[0]); DEC[lane + 64] = fexp(lsum[1]); }
    }
}
DI void phase_gla_scan(Frame& F) {
    float* ST = (float*)(F.ws + WS_ST); const float* DEC = (const float*)(F.ws + WS_DEC);
    for (int idx = F.bid * NTHR + F.tid; idx < 16 * 16384; idx += F.G * NTHR) {
        const int chain = idx >> 14, kv = idx & 16383, k = kv >> 7; float S = 0.f;
        for (int sc = 0; sc < NSC; ++sc) { const int u = chain * NSC + sc; const size_t o = (size_t)u * 16384 + kv; const float d = ST[o]; ST[o] = S; S = S * DEC[u * 128 + k] + d; }
    }
}
DI void phase_b_combine(Frame& F, const Args& a) {
    const float* OD = (const float*)(F.ws + WS_ODIR); const bf16* G = (const bf16*)(F.ws + WS_G); bf16* CAT = (bf16*)(F.ws + WS_CAT); const float* ng = a.in[11];
    for (int t = F.gw; t < MTOK * 4; t += F.NGW) { const int row = t >> 2, h = t & 3; const size_t o = (size_t)row * AW + h * 128 + 2 * F.lane;
        const float o0 = OD[o] + OD[(size_t)MTOK * AW + o], o1 = OD[o + 1] + OD[(size_t)MTOK * AW + o + 1];
        const float rstd = 1.f / sqrtf(wave_sum(o0 * o0 + o1 * o1) * (1.f / 128.f) + EPS);
        const unsigned gw2 = *(const unsigned*)(G + o);
        const float r0 = o0 * rstd * ng[h * 128 + 2 * F.lane] * bflo(gw2), r1 = o1 * rstd * ng[h * 128 + 2 * F.lane + 1] * bfhi(gw2);
        *(unsigned*)(CAT + (size_t)row * DM + 512 + h * 128 + 2 * F.lane) = pk2(r0, r1); }
}

DI void phase_router(Frame& F, const float* XR, const float* gn, const float* wr) {
    LAS float* wl = (LAS float*)F.lds;
    __syncthreads();
    for (int i = F.tid; i < 1024 * 16 / 4; i += NTHR) *(LAS f32x4*)(wl + 4 * i) = *(const f32x4*)(wr + 4 * i);
    __syncthreads();
    bf16* H = (bf16*)(F.ws + WS_H); float* AFF = (float*)(F.ws + WS_AFF);
    for (int m = F.gw; m < MTOK; m += F.NGW) {
        asm volatile("" ::: "memory");
        f32x4 v[4]; rms_row(XR + (size_t)m * DM, gn, v, F.lane); store_row_bf16(H + (size_t)m * DM, v, F.lane);
        float p[16];
#pragma unroll
        for (int e = 0; e < 16; ++e) p[e] = 0.f;
#pragma unroll
        for (int j = 0; j < 4; ++j)
#pragma unroll
            for (int q = 0; q < 4; ++q) { const int d = 4 * F.lane + 256 * j + q; const float xv = v[j][q];
#pragma unroll
                for (int e4 = 0; e4 < 4; ++e4) { const f32x4 w4 = *(const LAS f32x4*)(wl + d * 16 + 4 * e4); p[4 * e4] += xv * w4.x; p[4 * e4 + 1] += xv * w4.y; p[4 * e4 + 2] += xv * w4.z; p[4 * e4 + 3] += xv * w4.w; } }
        const float lg = red16(p, F.lane);
        const float mx = wave_max(lg); const float ex = expf(lg - mx); const float sm = wave_sum(ex) * 0.25f;
        if ((F.lane & 3) == 0) { const int b = m / SEQ, s = m % SEQ; AFF[(size_t)(b * 16 + red16_idx(F.lane)) * SEQ + s] = ex / sm; }
    }
}

DI int block_excl_scan(int v, LAS int* scratch, int tid, int lane, int wave, int* tot) {
    int inc = v;
#pragma unroll
    for (int o = 1; o < 64; o <<= 1) { const int t = __shfl_up(inc, o); if (lane >= o) inc += t; }
    __syncthreads();
    if (lane == 63) scratch[wave] = inc;
    __syncthreads();
    int base = 0, total = 0;
#pragma unroll
    for (int w = 0; w < NWAVES; ++w) { const int s = scratch[w]; if (w < wave) base += s; total += s; }
    *tot = total;
    return base + inc - v;
}
DI void phase_topk(Frame& F) {
    const float* AFF = (const float*)(F.ws + WS_AFF); int* IDX = (int*)(F.ws + WS_IDX); float* GATE = (float*)(F.ws + WS_GATE); int* POS = (int*)(F.ws + WS_POS);
    LAS unsigned* hist = (LAS unsigned*)F.lds; LAS int* sc = (LAS int*)(F.lds + 2048); LAS unsigned* shv = (LAS unsigned*)(F.lds + 2048 + 256);
    for (int u = F.bid; u < BATCH * NEXP; u += F.G) {
        const int b = u / NEXP, e = u % NEXP;
        unsigned vals[16];
        { const v4u* src = (const v4u*)(AFF + (size_t)u * SEQ + 16 * F.tid);
#pragma unroll
          for (int j = 0; j < 4; ++j) { const v4u t = src[j]; vals[4 * j] = t.x; vals[4 * j + 1] = t.y; vals[4 * j + 2] = t.z; vals[4 * j + 3] = t.w; } }
        unsigned prefix = 0; int krem = CAP;
        for (int pass = 0; pass < 4; ++pass) { const int shift = 24 - 8 * pass;
            __syncthreads();
            if (F.tid < 256) hist[F.tid] = 0u;
            __syncthreads();
#pragma unroll
            for (int j = 0; j < 16; ++j) { const unsigned v = vals[j]; if (pass == 0 || (v >> (shift + 8)) == prefix) __hip_atomic_fetch_add(&hist[(v >> shift) & 255u], 1u, __ATOMIC_RELAXED, __HIP_MEMORY_SCOPE_WORKGROUP); }
            __syncthreads();
            if (F.tid == 0) { int cum = 0, sel = 0; for (int bin = 255; bin >= 0; --bin) { const int c = (int)hist[bin]; if (cum + c >= krem) { sel = bin; break; } cum += c; }
                shv[0] = (prefix << 8) | (unsigned)sel; shv[1] = (unsigned)(krem - cum); }
            __syncthreads();
            prefix = shv[0]; krem = (int)shv[1];
        }
        const unsigned T = prefix;
        int ce = 0;
#pragma unroll
        for (int j = 0; j < 16; ++j) ce += (vals[j] == T) ? 1 : 0;
        int tot; int pe = block_excl_scan(ce, sc, F.tid, F.lane, F.wave, &tot);
        unsigned selmask = 0; int cs = 0;
#pragma unroll
        for (int j = 0; j < 16; ++j) { bool s = vals[j] > T; if (vals[j] == T) { s = pe < krem; ++pe; } if (s) { selmask |= 1u << j; ++cs; } }
        int slot = block_excl_scan(cs, sc, F.tid, F.lane, F.wave, &tot);
#pragma unroll
        for (int j = 0; j < 16; ++j) { const int s = 16 * F.tid + j; const int tokrow = b * SEQ + s;
            if (selmask & (1u << j)) { const int row = (e * 2 + b) * CAP + slot; ++slot; IDX[row] = tokrow; GATE[row] = __builtin_bit_cast(float, vals[j]); POS[tokrow * 16 + e] = row; }
            else POS[tokrow * 16 + e] = -1; }
    }
}
DI void phase_gather(Frame& F) {
    const bf16* H = (const bf16*)(F.ws + WS_H); bf16* XE = (bf16*)(F.ws + WS_XE); const int* IDX = (const int*)(F.ws + WS_IDX);
    for (int r = F.gw; r < NROWS; r += F.NGW) { const int src = IDX[r];
        const v4u* s = (const v4u*)(H + (size_t)src * DM) + F.lane; v4u* d = (v4u*)(XE + (size_t)r * DM) + F.lane;
        d[0] = s[0]; d[64] = s[64]; }
}
DI void phase_moe_combine(Frame& F, float* XR, const float* gnext, bool final_out) {
    const bf16* Y = (const bf16*)(F.ws + WS_Y); const int* POS = (const int*)(F.ws + WS_POS); bf16* H = (bf16*)(F.ws + WS_H);
    for (int m = F.gw; m < MTOK; m += F.NGW) {
        f32x4* xr = (f32x4*)(XR + (size_t)m * DM) + F.lane;
        f32x4 v[4];
#pragma unroll
        for (int j = 0; j < 4; ++j) v[j] = xr[64 * j];
        const int pmine = POS[m * 16 + (F.lane & 15)];
        for (int e = 0; e < 16; ++e) { const int p = __shfl(pmine, e);
            if (p >= 0) { const v2u* yr = (const v2u*)(Y + (size_t)p * DM) + F.lane;
#pragma unroll
                for (int j = 0; j < 4; ++j) { const v2u w = yr[64 * j]; v[j].x += bflo(w.x); v[j].y += bfhi(w.x); v[j].z += bflo(w.y); v[j].w += bfhi(w.y); } } }
        float s = 0.f;
#pragma unroll
        for (int j = 0; j < 4; ++j) s += (v[j].x * v[j].x + v[j].y * v[j].y) + (v[j].z * v[j].z + v[j].w * v[j].w);
        const float rstd = 1.f / sqrtf(wave_sum(s) * (1.f / DM) + EPS);
        const f32x4* gr = (const f32x4*)gnext + F.lane;
        if (final_out) {
#pragma unroll
            for (int j = 0; j < 4; ++j) xr[64 * j] = v[j] * rstd * gr[64 * j];
        } else {
#pragma unroll
            for (int j = 0; j < 4; ++j) xr[64 * j] = v[j];
            f32x4 nv[4];
#pragma unroll
            for (int j = 0; j < 4; ++j) nv[j] = v[j] * rstd * gr[64 * j];
            store_row_bf16(H + (size_t)m * DM, nv, F.lane);
        }
    }
}

DI void phase_attn_naive(Frame& F) {
    const bf16* QKV = (const bf16*)(F.ws + WS_QKV); bf16* ATT = (bf16*)(F.ws + WS_ATT); const float* BT = (const float*)(F.ws + WS_BT);
    LAS float* ql = (LAS float*)(F.lds + F.wave * 4096);
    LAS float* pl = ql + 64; LAS int* posl = (LAS int*)(ql + 512);
    const int lane = F.lane;
    for (int t = F.gw; t < MTOK * NHEAD; t += F.NGW) {
        const int row = t >> 4, h = t & 15, b = row / SEQ, tq = row % SEQ;
        ql[lane] = bf2f(QKV[(size_t)row * NQKV + h * 64 + lane]);
        LDS_WAIT();
        float s[7]; int pos[7];
#pragma unroll
        for (int i = 0; i < 7; ++i) {
            const int slot = lane + 64 * i; const int p = slot / 129, j = slot % 129;
            const int dil = (p == 0) ? 1 : (p == 1 ? 4 : 16);
            const int mq = tq / dil, r = tq % dil, mk = mq - 64 + j;
            const bool valid = (slot < 387) && (mk >= 0) && (mk < SEQ / dil);
            pos[i] = valid ? (b * SEQ + r + dil * mk) : -1;
            float d = -1e30f;
            if (valid) { const v4u* kr = (const v4u*)(QKV + (size_t)pos[i] * NQKV + 1024 + h * 64); float acc = 0.f;
#pragma unroll
                for (int c = 0; c < 8; ++c) { const v4u w = kr[c];
                    acc += ql[8 * c] * bflo(w.x) + ql[8 * c + 1] * bfhi(w.x) + ql[8 * c + 2] * bflo(w.y) + ql[8 * c + 3] * bfhi(w.y) + ql[8 * c + 4] * bflo(w.z) + ql[8 * c + 5] * bfhi(w.z) + ql[8 * c + 6] * bflo(w.w) + ql[8 * c + 7] * bfhi(w.w); }
                d = acc + BT[(p * 16 + h) * 129 + j]; }
            s[i] = d;
        }
        float mx = s[0];
#pragma unroll
        for (int i = 1; i < 7; ++i) mx = fmaxf(mx, s[i]);
        mx = wave_max(mx);
        float sum = 0.f;
#pragma unroll
        for (int i = 0; i < 7; ++i) { const float pv = (pos[i] >= 0) ? expf(s[i] - mx) : 0.f; sum += pv; pl[lane + 64 * i] = pv; posl[lane + 64 * i] = pos[i]; }
        sum = wave_sum(sum);
        LDS_WAIT();
        float o = 0.f;
        for (int k = 0; k < 387; ++k) { const int pp = posl[k]; if (pp >= 0) o += pl[k] * bf2f(QKV[(size_t)pp * NQKV + 2048 + h * 64 + lane]); }
        ATT[(size_t)row * DM + h * 64 + lane] = (bf16)f2bf(o / sum);
        LDS_WAIT();
    }
}

DI void phase_vt(Frame& F) {
    const bf16* QKV = (const bf16*)(F.ws + WS_QKV); bf16* VT = (bf16*)(F.ws + WS_VT);
    LAS unsigned char* tl = F.lds;
    for (int u = F.bid; u < 512; u += F.G) {
        const int c = u & 15, h = (u >> 4) & 15, b = u >> 8, t0 = c * 512;
        __syncthreads();
        { const v4u* src = (const v4u*)(QKV + (size_t)(b * SEQ + t0 + F.tid) * NQKV + 2048 + h * 64);
#pragma unroll
          for (int j = 0; j < 8; ++j) { const v4u w = src[j]; LAS v2u* d = (LAS v2u*)(tl + F.tid * 136 + 16 * j); d[0] = (v2u){w.x, w.y}; d[1] = (v2u){w.z, w.w}; } }
        __syncthreads();
#pragma unroll
        for (int p = 0; p < 3; ++p) {
            const int dl = (p == 0) ? 1 : (p == 1 ? 4 : 16), ns = SEQ / dl, per = 512 / dl;
            bf16* dst = VT + (size_t)p * MTOK * DM;
            for (int q = F.tid; q < 4096; q += NTHR) {
                const int dim = q >> 6, pp = (q & 63) * 8, r = pp / per, ml = pp % per;
                unsigned short e[8];
#pragma unroll
                for (int k = 0; k < 8; ++k) e[k] = *(const LAS unsigned short*)(tl + (dl * (ml + k) + r) * 136 + dim * 2);
                v4u o; o.x = e[0] | ((unsigned)e[1] << 16); o.y = e[2] | ((unsigned)e[3] << 16); o.z = e[4] | ((unsigned)e[5] << 16); o.w = e[6] | ((unsigned)e[7] << 16);
                *(v4u*)(dst + ((size_t)((b * 16 + h) * 64 + dim)) * SEQ + r * ns + t0 / dl + ml) = o;
            }
        }
    }
}

typedef float f32x16 __attribute__((ext_vector_type(16)));
#define MFMA32(a, b, c) __builtin_amdgcn_mfma_f32_32x32x16_bf16((a), (b), (c), 0, 0, 0)
DI int kperm(int r) { return (r & ~12) | ((r & 4) << 1) | ((r & 8) >> 1); }
DI int osw(int tok, int chunk) { return tok * 256 + (((chunk ^ tok ^ (tok >> 4)) & 15) << 4); }
struct AttnKV { bf16x8 k[4]; bf16x8 v[2][2]; };
DI void attn_load(AttnKV& t, const bf16* kb, const bf16* vb, int mk0, int kp, int DL) {
    const bf16* kr = kb + (size_t)(DL * (mk0 + kp)) * NQKV;
#pragma unroll
    for (int s = 0; s < 4; ++s) t.k[s] = *(const bf16x8*)(kr + 8 * s);
#pragma unroll
    for (int dt = 0; dt < 2; ++dt)
#pragma unroll
        for (int s = 0; s < 2; ++s) t.v[dt][s] = *(const bf16x8*)(vb + mk0 + (size_t)dt * 32 * SEQ + 16 * s);
}
DI void attn_step(const AttnKV& t, const bf16x8 (&qf)[4], f32x16& o0, f32x16& o1, float& m, float& l, const LAS float* bl, int rel0, int hh) {
    f32x16 sa;
#pragma unroll
    for (int i = 0; i < 16; ++i) sa[i] = 0.f;
#pragma unroll
    for (int s = 0; s < 4; ++s) sa = MFMA32(t.k[s], qf[s], sa);
    float sc[16]; float tmax = -1e30f;
#pragma unroll
    for (int i = 0; i < 16; ++i) { const int rel = rel0 + 16 * (i >> 3) + (i & 7);
        const bool valid = (rel >= -64) && (rel <= 64); const int idx = valid ? rel + 64 : 0;
        const float v = sa[i] + bl[idx]; sc[i] = valid ? v : -1e30f; tmax = fmaxf(tmax, sc[i]); }
    tmax = fmaxf(tmax, __shfl_xor(tmax, 32));
    const float mnew = fmaxf(m, tmax), alpha = fexp(m - mnew);
    float ps = 0.f; float p[16];
#pragma unroll
    for (int i = 0; i < 16; ++i) { p[i] = (sc[i] > -1e29f) ? fexp(sc[i] - mnew) : 0.f; ps += p[i]; }
    l = l * alpha + ps; m = mnew;
#pragma unroll
    for (int i = 0; i < 16; ++i) { o0[i] *= alpha; o1[i] *= alpha; }
#pragma unroll
    for (int s = 0; s < 2; ++s) {
        v4u w; w.x = pk2(p[8 * s], p[8 * s + 1]); w.y = pk2(p[8 * s + 2], p[8 * s + 3]); w.z = pk2(p[8 * s + 4], p[8 * s + 5]); w.w = pk2(p[8 * s + 6], p[8 * s + 7]);
        const bf16x8 pf = __builtin_bit_cast(bf16x8, w);
        o0 = MFMA32(t.v[0][s], pf, o0); o1 = MFMA32(t.v[1][s], pf, o1);
    }
}
template <int P> DI void attn_stage(Frame& F, int b, int h, int t0) {
    constexpr int DL = (P == 0) ? 1 : (P == 1 ? 4 : 16), NS = SEQ / DL;
    const bf16* QKV = (const bf16*)(F.ws + WS_QKV); const bf16* VT = (const bf16*)(F.ws + WS_VT) + (size_t)P * MTOK * DM; bf16* ATT = (bf16*)(F.ws + WS_ATT);
    LAS unsigned char* ol = F.lds; LAS float* ml = (LAS float*)(F.lds + 131072); LAS float* ll = ml + 512; const LAS float* bl = (const LAS float*)(F.lds + 135168) + P * 132;
    const int lane = F.lane, r32 = lane & 31, hh = lane >> 5, w = F.wave, kp = kperm(r32);
#pragma unroll 1
    for (int task = 0; task < 2; ++task) {
        asm volatile("" ::: "memory");
        int r, i0;
        if (P == 0) { r = 0; i0 = 64 * w + 32 * task; } else if (P == 1) { r = w & 3; i0 = 64 * (w >> 2) + 32 * task; } else { r = 2 * w + task; i0 = 0; }
        const int mq0 = t0 / DL + i0, tql = r + DL * (i0 + r32);
        bf16x8 qf[4];
        { const bf16* qp = QKV + (size_t)(b * SEQ + t0 + tql) * NQKV + h * 64 + 32 * hh;
#pragma unroll
          for (int s = 0; s < 4; ++s) qf[s] = *(const bf16x8*)(qp + 8 * s); }
        f32x16 o0, o1; float m, l;
        if (P == 0) {
#pragma unroll
            for (int i = 0; i < 16; ++i) { o0[i] = 0.f; o1[i] = 0.f; }
            m = -1e30f; l = 0.f;
        } else {
#pragma unroll
            for (int g = 0; g < 4; ++g) { const f32x4 a = *(const LAS f32x4*)(ol + osw(tql, 2 * g + hh)), c = *(const LAS f32x4*)(ol + osw(tql, 8 + 2 * g + hh));
                o0[4 * g] = a.x; o0[4 * g + 1] = a.y; o0[4 * g + 2] = a.z; o0[4 * g + 3] = a.w; o1[4 * g] = c.x; o1[4 * g + 1] = c.y; o1[4 * g + 2] = c.z; o1[4 * g + 3] = c.w; }
            m = ml[tql]; l = hh ? 0.f : ll[tql];
        }
        const bf16* kb = QKV + (size_t)(b * SEQ + r) * NQKV + 1024 + h * 64 + 32 * hh;
        const bf16* vb = VT + ((size_t)((b * 16 + h) * 64 + r32)) * SEQ + r * NS + 8 * hh;
        int relb = 8 * hh - 64 - r32;
        asm volatile("" : "+v"(relb));
        AttnKV ta, tb;
#define ATT_OK(kt) ((mq0 - 64 + 32 * (kt)) >= 0 && (mq0 - 64 + 32 * (kt)) < NS)
        if (ATT_OK(0)) attn_load(ta, kb, vb, mq0 - 64, kp, DL);
        if (ATT_OK(1)) attn_load(tb, kb, vb, mq0 - 32, kp, DL);
        if (ATT_OK(0)) attn_step(ta, qf, o0, o1, m, l, bl, relb, hh);
        if (ATT_OK(2)) attn_load(ta, kb, vb, mq0, kp, DL);
        if (ATT_OK(1)) attn_step(tb, qf, o0, o1, m, l, bl, relb + 32, hh);
        if (ATT_OK(3)) attn_load(tb, kb, vb, mq0 + 32, kp, DL);
        if (ATT_OK(2)) attn_step(ta, qf, o0, o1, m, l, bl, relb + 64, hh);
        if (ATT_OK(4)) attn_load(ta, kb, vb, mq0 + 64, kp, DL);
        if (ATT_OK(3)) attn_step(tb, qf, o0, o1, m, l, bl, relb + 96, hh);
        if (ATT_OK(4)) attn_step(ta, qf, o0, o1, m, l, bl, relb + 128, hh);
#undef ATT_OK
        const float lt = l + __shfl_xor(l, 32);
        if (P < 2) {
#pragma unroll
            for (int g = 0; g < 4; ++g) { *(LAS f32x4*)(ol + osw(tql, 2 * g + hh)) = (f32x4){o0[4 * g], o0[4 * g + 1], o0[4 * g + 2], o0[4 * g + 3]};
                *(LAS f32x4*)(ol + osw(tql, 8 + 2 * g + hh)) = (f32x4){o1[4 * g], o1[4 * g + 1], o1[4 * g + 2], o1[4 * g + 3]}; }
            if (hh == 0) { ml[tql] = m; ll[tql] = lt; }
        } else {
            const float inv = 1.f / lt;
            bf16* op = ATT + (size_t)(b * SEQ + t0 + tql) * DM + h * 64 + 4 * hh;
#pragma unroll
            for (int g = 0; g < 4; ++g) { v2u a, c; a.x = pk2(o0[4 * g] * inv, o0[4 * g + 1] * inv); a.y = pk2(o0[4 * g + 2] * inv, o0[4 * g + 3] * inv);
                c.x = pk2(o1[4 * g] * inv, o1[4 * g + 1] * inv); c.y = pk2(o1[4 * g + 2] * inv, o1[4 * g + 3] * inv);
                *(v2u*)(op + 8 * g) = a; *(v2u*)(op + 32 + 8 * g) = c; }
        }
    }
}
DI void phase_attn(Frame& F) {
    const float* BT = (const float*)(F.ws + WS_BT);
    LAS float* bl = (LAS float*)(F.lds + 135168);
    for (int u = F.bid; u < 512; u += F.G) {
        const int c = u & 15, h = (u >> 4) & 15, b = u >> 8, t0 = c * 512;
        __syncthreads();
        for (int i = F.tid; i < 3 * 129; i += NTHR) bl[(i / 129) * 132 + i % 129] = BT[((i / 129) * 16 + h) * 129 + i % 129];
        __syncthreads();
        attn_stage<0>(F, b, h, t0);
        __syncthreads();
        attn_stage<1>(F, b, h, t0);
        __syncthreads();
        attn_stage<2>(F, b, h, t0);
    }
}

__global__ void __launch_bounds__(NTHR, 2) fwd_kernel(Args args) {
    extern __shared__ __attribute__((aligned(16))) unsigned char lds[];
    Frame F;
    F.lds = (LAS unsigned char*)lds;
    F.MISC = (volatile LAS unsigned*)(F.lds + MISC_OFF);
    F.tid = threadIdx.x; F.lane = F.tid & 63; F.wave = __builtin_amdgcn_readfirstlane(F.tid >> 6);
    F.G = gridDim.x; F.bid = blockIdx.x; F.gw = F.bid * NWAVES + F.wave; F.NGW = F.G * NWAVES;
    F.ws = args.ws;
    unsigned* ctl = (unsigned*)(args.ws + WS_CTL);
    for (int u = F.tid; u < (LDS_BYTES - LDSCTL_OFF) / 4; u += NTHR) ((LAS unsigned*)(F.lds + LDSCTL_OFF))[u] = 0u;
    __syncthreads();
    const int lo = args.ph_lo, hi = args.ph_hi;
    XcdBarrier bar; bar.bar = ctl + CW_BAR + args.li * XCD_BAR_WORDS; bar.x = 0; bar.st = nullptr;
    if (hi - lo > 1) bar = xcd_barrier_post(ctl + CW_BAR + args.li * XCD_BAR_WORDS, F.MISC + 8);
#define IN(k) (lo <= (k) && (k) < hi)
#define SEAM(k) do { if (IN(k) && IN((k) + 1)) xcd_barrier(bar); } while (0)
    unsigned char* ws = args.ws;
    float* XR = args.out;

    if (IN(0)) { phase_prologue(F, args); } SEAM(0);
    if (IN(1)) {
        pg8::Gemm g{(const bf16*)(ws + WS_H), (const bf16*)(ws + WS_WIN), MTOK, NIN, DM}; pg8::StaticOrder S; S.init(MTOK, NIN, F.G, F.bid);
        EpiInProj E{(bf16*)(ws + WS_U), (bf16*)(ws + WS_GV), (bf16*)(ws + WS_Q), (bf16*)(ws + WS_V), (bf16*)(ws + WS_G), (float*)(ws + WS_LFF), (float*)(ws + WS_LFB), (const float*)(ws + WS_LB)};
        pg8::gemm_phase<EpiInProj, pg8::StaticOrder, true, true>(F.lds, g, S, E);
    } SEAM(1);
    if (IN(2)) { phase_a_ln(F, args); for (int u = F.bid; u < 512; u += F.G) gla_naive_unit(F, u, false); } SEAM(2);
    if (IN(3)) { phase_gla_scan(F); phase_a_mix_naive(F, args); } SEAM(3);
    if (IN(4)) { for (int u = F.bid; u < 512; u += F.G) gla_naive_unit(F, u, true); } SEAM(4);
    if (IN(5)) { phase_b_combine(F, args); } SEAM(5);
    if (IN(6)) {
        pg8::Gemm g{(const bf16*)(ws + WS_CAT), (const bf16*)(ws + WS_WOUT), MTOK, DM, DM}; pg8::StaticOrder S; S.init(MTOK, DM, F.G, F.bid);
        EpiResid E{args.in[0], XR};
        pg8::gemm_phase<EpiResid, pg8::StaticOrder, false, true>(F.lds, g, S, E);
    } SEAM(6);
#define MOE_BLOCK(L, pb) do { \
        if (IN(pb)) { phase_router(F, XR, args.in[2] + (L) * DM, args.in[15] + (L) * DM * NEXP); } SEAM(pb); \
        if (IN((pb) + 1)) { phase_topk(F); } SEAM((pb) + 1); \
        if (IN((pb) + 2)) { phase_gather(F); } SEAM((pb) + 2); \
        if (IN((pb) + 3)) { \
            pg8::Gemm g{(const bf16*)(ws + WS_XE), (const bf16*)(ws + WS_WGU), NROWS, 16 * 2048, DM}; GroupedOrder<8> S{F.G, F.bid}; \
            EpiGateUp E{(bf16*)(ws + WS_HMID)}; \
            pg8::gemm_phase<EpiGateUp, GroupedOrder<8>, true, true>(F.lds, g, S, E); \
        } SEAM((pb) + 3); \
        if (IN((pb) + 4)) { \
            pg8::Gemm g{(const bf16*)(ws + WS_HMID), (const bf16*)(ws + WS_WDN), NROWS, 16 * 1024, DFF}; GroupedOrder<4> S{F.G, F.bid}; \
            EpiDown E{(bf16*)(ws + WS_Y), (const float*)(ws + WS_GATE)}; \
            pg8::gemm_phase<EpiDown, GroupedOrder<4>, true, true>(F.lds, g, S, E); \
        } SEAM((pb) + 4); \
    } while (0)

    MOE_BLOCK(0, 7);
    if (IN(12)) { phase_moe_combine(F, XR, args.in[1] + DM, false); convert_moe_weights(F, args.in[16], args.in[17], args.in[18], 1); } SEAM(12);
    if (IN(13)) {
        pg8::Gemm g{(const bf16*)(ws + WS_H), (const bf16*)(ws + WS_WQKV), MTOK, NQKV, DM}; pg8::StaticOrder S; S.init(MTOK, NQKV, F.G, F.bid);
        EpiQKV E{(bf16*)(ws + WS_QKV)};
        pg8::gemm_phase<EpiQKV, pg8::StaticOrder, true, true>(F.lds, g, S, E);
    } SEAM(13);
    if (IN(14)) { phase_vt(F); } SEAM(14);
    if (IN(15)) { phase_attn(F); } SEAM(15);
    if (IN(16)) {
        pg8::Gemm g{(const bf16*)(ws + WS_ATT), (const bf16*)(ws + WS_WO), MTOK, DM, DM}; pg8::StaticOrder S; S.init(MTOK, DM, F.G, F.bid);
        EpiResid E{XR, XR};
        pg8::gemm_phase<EpiResid, pg8::StaticOrder, false, true>(F.lds, g, S, E);
    } SEAM(16);
    MOE_BLOCK(1, 17);
    if (IN(22)) { phase_moe_combine(F, XR, args.in[3], true); }
#undef MOE_BLOCK
#undef IN
#undef SEAM
}

#ifndef MK_N_LAUNCHES
#define MK_N_LAUNCHES 1
#endif
extern "C" void kernel_launch(void* const* d_in, const int* in_sizes, int n_in, void* d_out, int out_size, void* d_ws, size_t ws_size, hipStream_t stream) {
    static int grid = 0;
    if (grid == 0) {
        if (n_in != 19 || in_sizes[0] != MTOK * DM || out_size != MTOK * DM || ws_size < WS_END) { fprintf(stderr, "kernel_launch: unexpected shapes (n_in %d, in0 %d, out %d, ws %zu < %zu); nothing launched\n", n_in, n_in > 0 ? in_sizes[0] : -1, out_size, ws_size, (size_t)WS_END); grid = -1; return; }
        int dev = 0, cus = 0, per_cu = 0;
        if (hipGetDevice(&dev) != hipSuccess || hipDeviceGetAttribute(&cus, hipDeviceAttributeMultiprocessorCount, dev) != hipSuccess) { grid = -1; return; }
        if (hipFuncSetAttribute((const void*)fwd_kernel, hipFuncAttributeMaxDynamicSharedMemorySize, LDS_BYTES) != hipSuccess) { fprintf(stderr, "kernel_launch: hipFuncSetAttribute failed\n"); grid = -1; return; }
        if (hipOccupancyMaxActiveBlocksPerMultiprocessor(&per_cu, (const void*)fwd_kernel, NTHR, LDS_BYTES) != hipSuccess || per_cu < 1) { fprintf(stderr, "kernel_launch: occupancy query reports %d workgroups per CU\n", per_cu); }
        (void)hipGetLastError();
        grid = cus;
    }
    if (grid < 0) return;
    if (hipMemsetAsync((char*)d_ws + WS_CTL, 0, CTL_ZERO_BYTES, stream) != hipSuccess) return;
    Args a{};
    for (int i = 0; i < 19; ++i) a.in[i] = (const float*)d_in[i];
    a.out = (float*)d_out; a.ws = (unsigned char*)d_ws; a.pad = 0;
    static_assert(CW_BAR + MAX_BAR_REGIONS * XCD_BAR_WORDS <= (int)(CTL_ZERO_BYTES / 4), "barrier regions inside the memset region");
    const int nl = MK_N_LAUNCHES;
    for (int li = 0; li < nl; ++li) {
        a.ph_lo = (int)((long)NPHASE * li / nl); a.ph_hi = (int)((long)NPHASE * (li + 1) / nl); a.li = li;
        hipLaunchKernelGGL(fwd_kernel, dim3(grid), dim3(NTHR), LDS_BYTES, stream, a);
        const hipError_t le = hipPeekAtLastError();
        if (le != hipSuccess) { fprintf(stderr, "kernel_launch: launch %d failed: %s\n", li, hipGetErrorName(le)); break; }
    }
}
```

```cpp
#include <hip/hip_runtime.h>
#include <cstdio>
#include <cstdint>
namespace pg8 {
#define PG8_LAS __attribute__((address_space(3)))
typedef unsigned short bf16_t;
typedef short bf16x8 __attribute__((ext_vector_type(8)));
typedef float f32x4 __attribute__((ext_vector_type(4)));
typedef unsigned u32x4 __attribute__((ext_vector_type(4)));
constexpr int BM = 256, BK = 64, HALF = 128, HTB = HALF * BK * 2  , STAGE_BYTES = 8 * HTB, NXCD = 8, WGM = 8;

__host__ __device__ __forceinline__ int lds_byte(int r, int c) { const int st = (r >> 4) * 2 + (c >> 5), rr = r & 15, cc = c & 31, ob = rr * 64 + cc * 2; return st * 1024 + (ob ^ (((ob >> 9) & 1) << 5)); }
__host__ __device__ __forceinline__ void stage_rc(int b, int& R, int& C) { const int st = b / 1024, sb = b % 1024, swz = sb ^ (((sb >> 9) & 1) << 5); R = (st >> 1) * 16 + swz / 64; C = (st & 1) * 32 + (swz % 64) / 2; }
__host__ __device__ __forceinline__ int perm32(int rho) { const int n = rho >> 4, i = rho & 15; return 8 * (i >> 2) + 4 * n + (i & 3); }

struct Unit { int pm, pn; };
struct Gemm { const bf16_t* A; const bf16_t* Bt; int M, N, K; };

struct StaticOrder {
    int nM, nN, nwg, G, c;
    __host__ __device__ void init(int M, int N, int G_, int c_) { nM = M / BM; nN = N / BM; nwg = nM * nN; G = G_; c = c_; }
    __host__ __device__ bool next(int i, Unit& u) const {
        const long L = (long)i * G + c; if (L >= nwg) return false;
        int wgid = (int)L; { const int q = nwg / NXCD, r = nwg % NXCD, xcd = wgid % NXCD, off = wgid / NXCD; wgid = (xcd < r ? xcd * (q + 1) : r * (q + 1) + (xcd - r) * q) + off; }
        const int nig = WGM * nN, gid = wgid / nig, fm = gid * WGM, gsz = (nM - fm) < WGM ? (nM - fm) : WGM;
        u.pm = fm + ((wgid % nig) % gsz); u.pn = (wgid % nig) / gsz; return true;
    }
    __device__ __forceinline__ void a_ready(const Unit&) const {}
    __device__ __forceinline__ void done(const Unit&) const {}
};

__device__ __forceinline__ unsigned cvt_pk_bf16(float lo, float hi) { unsigned r; asm volatile("v_cvt_pk_bf16_f32 %0, %1, %2" : "=v"(r) : "v"(lo), "v"(hi)); return r; }
typedef float f32x2 __attribute__((ext_vector_type(2)));
__device__ __forceinline__ f32x2 gelu_pk(f32x2 v) {
    const f32x2 av = __builtin_elementwise_abs(v), d = av * 0.2316418882f + 1.0f;
    f32x2 t; t.x = __builtin_amdgcn_rcpf(d.x); t.y = __builtin_amdgcn_rcpf(d.y);
    f32x2 q = t * 0.5307027145f + (-0.7265760135f); q = q * t + 0.7107068705f; q = q * t + (-0.142248368f); q = q * t + 0.127414796f; q = q * t;
    const f32x2 s = (v * v) * (-0.72134752044f);
    f32x2 e; e.x = __builtin_amdgcn_exp2f(s.x); e.y = __builtin_amdgcn_exp2f(s.y);
    const f32x2 m = v * (q * e), r = v - m;
    f32x2 o; o.x = v.x < 0.f ? m.x : r.x; o.y = v.y < 0.f ? m.y : r.y; return o;
}

template <int ACT  > struct EpiBf16 {
    static constexpr bool PERM = true, AFTER_DRAIN = false; static_assert(ACT == 0 || ACT == 1, "EpiBf16: ACT is 0 (none) or 1 (gelu_pk)");
    bf16_t* O; int ldc; const float* bias; int split_cols; size_t split_stride; float scale0;
    __device__ __forceinline__ void operator()(const f32x4 (&acc)[2][2][4][2], const Unit& u, int wr, int wc, int fr, int fq) const {
        const int row0 = u.pm * BM + wr * 64 + fr; int colt = u.pn * BM; bf16_t* base = O;
        float sc = 1.f; if (split_cols) { const int t = colt / split_cols; base += (size_t)t * split_stride; colt -= t * split_cols; if (t == 0) sc = scale0; }
        const int col0 = colt + wc * 32 + 8 * fq, bcol0 = u.pn * BM + wc * 32 + 8 * fq;
        f32x4 bv[2][2];
#pragma unroll
        for (int bj = 0; bj < 2; ++bj)
#pragma unroll
            for (int n = 0; n < 2; ++n) bv[bj][n] = bias ? *(const f32x4*)(bias + bcol0 + bj * HALF + 4 * n) : (f32x4){0.f, 0.f, 0.f, 0.f};
#pragma unroll
        for (int ai = 0; ai < 2; ++ai)
#pragma unroll
            for (int m = 0; m < 4; ++m) { bf16_t* rowp = base + (size_t)(row0 + ai * HALF + m * 16) * ldc + col0;
#pragma unroll
                for (int bj = 0; bj < 2; ++bj) { f32x4 v0 = acc[ai][bj][m][0] + bv[bj][0], v1 = acc[ai][bj][m][1] + bv[bj][1];
                    if (ACT == 1) { f32x2 a = gelu_pk((f32x2){v0[0], v0[1]}), b = gelu_pk((f32x2){v0[2], v0[3]}), c = gelu_pk((f32x2){v1[0], v1[1]}), d = gelu_pk((f32x2){v1[2], v1[3]});
                        v0 = (f32x4){a.x, a.y, b.x, b.y}; v1 = (f32x4){c.x, c.y, d.x, d.y}; }
                    v0 = v0 * sc; v1 = v1 * sc; u32x4 w; w.x = cvt_pk_bf16(v0[0], v0[1]); w.y = cvt_pk_bf16(v0[2], v0[3]); w.z = cvt_pk_bf16(v1[0], v1[1]); w.w = cvt_pk_bf16(v1[2], v1[3]);
                    *(u32x4*)(rowp + bj * HALF) = w; } }
    }
};
template <class Epi, class Sched, bool ALIGN_EPI = false, bool SP2 = false>
__device__ __forceinline__ void gemm_phase(PG8_LAS unsigned char* lds, const Gemm g, const Sched& S, const Epi& E) {
    const int tid = threadIdx.x, wid = __builtin_amdgcn_readfirstlane(tid >> 6), lane = tid & 63, wr = wid >> 2, wc = wid & 3, fr = lane & 15, fq = lane >> 4;
    const int K = g.K, nt = K / BK;
    unsigned voffA[2], voffB[2];
#pragma unroll
    for (int i = 0; i < 2; ++i) { int R, C; stage_rc(tid * 16 + i * 8192, R, C); const int Rb = Epi::PERM ? ((R & ~31) + perm32(R & 31)) : R;
        voffA[i] = (unsigned)(R * K + C) * 2u; voffB[i] = (unsigned)(Rb * K + C) * 2u; }
    const size_t kstep = (size_t)(BK * 2);
    const size_t hstep = (size_t)HALF * K * 2;
    const size_t tstep = 2 * hstep;
    const unsigned ldsw = (unsigned)wid * 1024u;
    const int aoff = lds_byte(wr * 64 + fr, fq * 8), boff = lds_byte(wc * 32 + fr, fq * 8);
#define PG8_SA(b, h) (((b) * 2 + (h)) * HTB)
#define PG8_SB(b, h) ((4 + (b) * 2 + (h)) * HTB)
#define PG8_STAGE(bufoff, gbase, voff) do { _Pragma("unroll") for (int _i = 0; _i < 2; ++_i) \
        __builtin_amdgcn_global_load_lds((const unsigned*)((const char*)(gbase) + (voff)[_i]), (PG8_LAS unsigned*)(lds + (bufoff) + ldsw + _i * 8192), 16, 0, 0); } while (0)
#define PG8_LDA(dst, b, h) do { _Pragma("unroll") for (int m = 0; m < 4; ++m) _Pragma("unroll") for (int k = 0; k < 2; ++k) dst[m][k] = *(const PG8_LAS bf16x8*)(lds + PG8_SA(b, h) + aoff + m * 2048 + k * 1024); } while (0)
#define PG8_LDB(dst, b, h) do { _Pragma("unroll") for (int n = 0; n < 2; ++n) _Pragma("unroll") for (int k = 0; k < 2; ++k) dst[n][k] = *(const PG8_LAS bf16x8*)(lds + PG8_SB(b, h) + boff + n * 2048 + k * 1024); } while (0)
#define PG8_MMA(ai, bj, At, Bt) do { __builtin_amdgcn_s_setprio(1); _Pragma("unroll") for (int m = 0; m < 4; ++m) _Pragma("unroll") for (int n = 0; n < 2; ++n) _Pragma("unroll") for (int k = 0; k < 2; ++k) \
        acc[ai][bj][m][n] = __builtin_amdgcn_mfma_f32_16x16x32_bf16(Bt[n][k], At[m][k], acc[ai][bj][m][n], 0, 0, 0); __builtin_amdgcn_s_setprio(0); } while (0)
#define PG8_WAIT_V(n) asm volatile("s_waitcnt vmcnt(" #n ")" ::: "memory")
#define PG8_WAIT_L(n) asm volatile("s_waitcnt lgkmcnt(" #n ")" ::: "memory")
#define PG8_BAR __builtin_amdgcn_s_barrier()
#define PG8_SCHED __builtin_amdgcn_sched_barrier(0)
    Unit cur, nxt; int ui = 0;
    if (!S.next(0, cur)) return;
    f32x4 acc[2][2][4][2];
#pragma unroll
    for (int a = 0; a < 2; ++a)
#pragma unroll
        for (int b = 0; b < 2; ++b)
#pragma unroll
            for (int m = 0; m < 4; ++m)
#pragma unroll
                for (int n = 0; n < 2; ++n) acc[a][b][m][n] = (f32x4){0.f, 0.f, 0.f, 0.f};
    bf16x8 At[4][2], B0[2][2], B1[2][2];
    const char* cA = (const char*)g.A + (size_t)cur.pm * tstep; const char* cB = (const char*)g.Bt + (size_t)cur.pn * tstep;
    S.a_ready(cur);
    if constexpr (SP2) {
        PG8_STAGE(PG8_SB(0, 0), cB, voffB); PG8_STAGE(PG8_SB(0, 1), cB + hstep, voffB); PG8_STAGE(PG8_SA(0, 0), cA, voffA); PG8_STAGE(PG8_SA(0, 1), cA + hstep, voffA);
        if (wr == 1) PG8_BAR;
        PG8_WAIT_V(2); PG8_BAR;
        PG8_STAGE(PG8_SB(1, 0), cB + kstep, voffB); PG8_STAGE(PG8_SA(1, 0), cA + kstep, voffA); PG8_STAGE(PG8_SB(1, 1), cB + hstep + kstep, voffB);
        PG8_WAIT_V(6); PG8_BAR;
    } else {
        PG8_STAGE(PG8_SB(0, 0), cB, voffB); PG8_STAGE(PG8_SA(0, 0), cA, voffA); PG8_STAGE(PG8_SB(0, 1), cB + hstep, voffB); PG8_STAGE(PG8_SA(0, 1), cA + hstep, voffA);
        if (wr == 1) PG8_BAR;
        PG8_WAIT_V(4); PG8_BAR;
        PG8_STAGE(PG8_SB(1, 0), cB + kstep, voffB); PG8_STAGE(PG8_SA(1, 0), cA + kstep, voffA); PG8_STAGE(PG8_SB(1, 1), cB + hstep + kstep, voffB);
        PG8_WAIT_V(6); PG8_BAR;
    }
    for (;;) {
        const bool has_next = S.next(ui + 1, nxt);
        const char* nA = has_next ? (const char*)g.A + (size_t)nxt.pm * tstep : cA; const char* nB = has_next ? (const char*)g.Bt + (size_t)nxt.pn * tstep : cB;
        for (int t = 0; t < nt; t += 2) {
            const bool last = (t == nt - 2);
            const char* a1 = cA + (size_t)(t + 1) * kstep;
            const char* a2 = last ? nA : cA + (size_t)(t + 2) * kstep; const char* b2 = last ? nB : cB + (size_t)(t + 2) * kstep;
            const char* a3 = a2 + kstep; const char* b3 = b2 + kstep;
            if (last && has_next) S.a_ready(nxt);
            if constexpr (SP2) {
            PG8_LDB(B0, 0, 0); PG8_LDB(B1, 0, 1); PG8_SCHED; PG8_LDA(At, 0, 0); PG8_STAGE(PG8_SA(1, 1), a1 + hstep, voffA);
            PG8_WAIT_V(8); PG8_WAIT_L(0); PG8_BAR; PG8_MMA(0, 0, At, B0); PG8_MMA(0, 1, At, B1); PG8_BAR; PG8_SCHED;
            PG8_LDA(At, 0, 1); PG8_STAGE(PG8_SB(0, 0), b2, voffB); PG8_STAGE(PG8_SB(0, 1), b2 + hstep, voffB); PG8_STAGE(PG8_SA(0, 0), a2, voffA);
            PG8_WAIT_V(8); PG8_WAIT_L(0); PG8_BAR; PG8_MMA(1, 0, At, B0); PG8_MMA(1, 1, At, B1); PG8_BAR; PG8_SCHED;
            PG8_LDB(B0, 1, 0); PG8_LDB(B1, 1, 1); PG8_SCHED; PG8_LDA(At, 1, 0); PG8_STAGE(PG8_SA(0, 1), a2 + hstep, voffA);
            PG8_WAIT_V(8); PG8_WAIT_L(0); PG8_BAR; PG8_MMA(0, 0, At, B0); PG8_MMA(0, 1, At, B1); PG8_BAR; PG8_SCHED;
            PG8_LDA(At, 1, 1); PG8_STAGE(PG8_SB(1, 0), b3, voffB); PG8_STAGE(PG8_SB(1, 1), b3 + hstep, voffB); PG8_STAGE(PG8_SA(1, 0), a3, voffA);
            PG8_WAIT_V(8); PG8_WAIT_L(0); PG8_BAR; PG8_MMA(1, 0, At, B0); PG8_MMA(1, 1, At, B1); PG8_BAR; PG8_SCHED;
            } else {
            PG8_LDB(B0, 0, 0); PG8_SCHED; PG8_LDA(At, 0, 0); PG8_STAGE(PG8_SA(1, 1), a1 + hstep, voffA);
            PG8_WAIT_L(8); PG8_BAR; PG8_WAIT_L(0); PG8_MMA(0, 0, At, B0); PG8_BAR; PG8_SCHED;
            PG8_LDB(B1, 0, 1); PG8_STAGE(PG8_SB(0, 0), b2, voffB);
            PG8_BAR; PG8_WAIT_L(0); PG8_MMA(0, 1, At, B1); PG8_BAR;
            PG8_LDA(At, 0, 1); PG8_STAGE(PG8_SA(0, 0), a2, voffA);
            PG8_BAR; PG8_WAIT_L(0); PG8_MMA(1, 0, At, B0); PG8_BAR; PG8_SCHED;
            PG8_STAGE(PG8_SB(0, 1), b2 + hstep, voffB);
            PG8_WAIT_V(6); PG8_BAR; PG8_MMA(1, 1, At, B1); PG8_BAR;
            PG8_LDB(B0, 1, 0); PG8_SCHED; PG8_LDA(At, 1, 0); PG8_STAGE(PG8_SA(0, 1), a2 + hstep, voffA);
            PG8_WAIT_L(8); PG8_BAR; PG8_WAIT_L(0); PG8_MMA(0, 0, At, B0); PG8_BAR; PG8_SCHED;
            PG8_LDB(B1, 1, 1); PG8_STAGE(PG8_SB(1, 0), b3, voffB);
            PG8_BAR; PG8_WAIT_L(0); PG8_MMA(0, 1, At, B1); PG8_BAR;
            PG8_LDA(At, 1, 1); PG8_STAGE(PG8_SA(1, 0), a3, voffA);
            PG8_BAR; PG8_WAIT_L(0); PG8_MMA(1, 0, At, B0); PG8_BAR; PG8_SCHED;
            PG8_STAGE(PG8_SB(1, 1), b3 + hstep, voffB);
            PG8_WAIT_V(6); PG8_BAR; PG8_MMA(1, 1, At, B1); PG8_BAR;
            }
        }
        if constexpr (ALIGN_EPI) { if (wr == 0) PG8_BAR; }
        if constexpr (!Epi::AFTER_DRAIN) { E(acc, cur, wr, wc, fr, fq); S.done(cur); }
        if (!has_next) break;
#pragma unroll
        for (int a = 0; a < 2; ++a)
#pragma unroll
            for (int b = 0; b < 2; ++b)
#pragma unroll
                for (int m = 0; m < 4; ++m)
#pragma unroll
                    for (int n = 0; n < 2; ++n) acc[a][b][m][n] = (f32x4){0.f, 0.f, 0.f, 0.f};
        cur = nxt; cA = nA; cB = nB; ++ui;
        if constexpr (ALIGN_EPI) { if (wr == 1) PG8_BAR; }
    }
    PG8_WAIT_V(0);
    if constexpr (!ALIGN_EPI) { if (wr == 0) PG8_BAR; }
    PG8_BAR;
    if constexpr (Epi::AFTER_DRAIN) { E.fused(acc, cur, wr, wc, fr, fq, lds, wid, lane); S.done(cur); }
#undef PG8_SA
#undef PG8_SB
#undef PG8_STAGE
#undef PG8_LDA
#undef PG8_LDB
#undef PG8_MMA
#undef PG8_WAIT_V
#undef PG8_WAIT_L
#undef PG8_BAR
#undef PG8_SCHED
}
}
#define LAS __attribute__((address_space(3)))
#define DI __device__ __forceinline__
typedef unsigned short bf16;
typedef unsigned v4u __attribute__((ext_vector_type(4)));
typedef unsigned v2u __attribute__((ext_vector_type(2)));
typedef float f32x4 __attribute__((ext_vector_type(4)));
typedef short bf16x8 __attribute__((ext_vector_type(8)));
#define LDS_WAIT() asm volatile("s_waitcnt lgkmcnt(0)" ::: "memory")
#define VM_WAIT() asm volatile("s_waitcnt vmcnt(0)" ::: "memory")
DI unsigned f2bf(float f) { unsigned u = __builtin_bit_cast(unsigned, f); return (u + 0x7fffu + ((u >> 16) & 1u)) >> 16; }
typedef float f32x2_t __attribute__((ext_vector_type(2))); typedef __bf16 bf16x2_t __attribute__((ext_vector_type(2)));
DI unsigned pk2(float lo, float hi) { f32x2_t v = {lo, hi}; bf16x2_t b = __builtin_convertvector(v, bf16x2_t); return __builtin_bit_cast(unsigned, b); }
DI float bf2f(unsigned b) { return __builtin_bit_cast(float, b << 16); }
DI float bflo(unsigned w) { return __builtin_bit_cast(float, w << 16); }
DI float bfhi(unsigned w) { return __builtin_bit_cast(float, w & 0xffff0000u); }
DI float fexp(float x) { return __builtin_amdgcn_exp2f(x * 1.4426950408889634f); }
DI float flog(float x) { return __builtin_amdgcn_logf(x) * 0.6931471805599453f; }
DI float frcp(float x) { return __builtin_amdgcn_rcpf(x); }
DI float sigmoidf_(float x) { return frcp(1.f + fexp(-x)); }
DI float siluf_(float x) { return x * sigmoidf_(x); }
DI float gelu_tanh(float x) { const float u = 0.7978845608028654f * (x + 0.044715f * x * x * x); return x * sigmoidf_(2.f * u); }
DI float wave_sum(float v) {
#pragma unroll
    for (int o = 1; o < 64; o <<= 1) v += __shfl_xor(v, o);
    return v;
}
DI float wave_max(float v) {
#pragma unroll
    for (int o = 1; o < 64; o <<= 1) v = fmaxf(v, __shfl_xor(v, o));
    return v;
}
DI int red16_idx(int lane) { return 8 * ((lane >> 5) & 1) + 4 * ((lane >> 4) & 1) + 2 * ((lane >> 3) & 1) + ((lane >> 2) & 1); }
DI float red16(const float (&o)[16], int lane) {
    const bool b32 = lane & 32, b16 = lane & 16, b8 = lane & 8, b4 = lane & 4;
    float a8[8], a4[4], a2[2], a1;
#pragma unroll
    for (int j = 0; j < 8; ++j) { const float send = b32 ? o[j] : o[j + 8], keep = b32 ? o[j + 8] : o[j]; a8[j] = keep + __shfl_xor(send, 32); }
#pragma unroll
    for (int j = 0; j < 4; ++j) { const float send = b16 ? a8[j] : a8[j + 4], keep = b16 ? a8[j + 4] : a8[j]; a4[j] = keep + __shfl_xor(send, 16); }
#pragma unroll
    for (int j = 0; j < 2; ++j) { const float send = b8 ? a4[j] : a4[j + 2], keep = b8 ? a4[j + 2] : a4[j]; a2[j] = keep + __shfl_xor(send, 8); }
    { const float send = b4 ? a2[0] : a2[1], keep = b4 ? a2[1] : a2[0]; a1 = keep + __shfl_xor(send, 4); }
    a1 += __shfl_xor(a1, 2); a1 += __shfl_xor(a1, 1);
    return a1;
}
#define XB_TMO      128
#define XB_XCNT(j)  (256  + 64 * (j))
#define XB_XSUB(j)  (1280 + 64 * (j))
#define XB_XGEN(j)  (2304 + 64 * (j))
#define XB_TOP      3328
#define XB_TOPGEN   3392
#define XCD_BAR_WORDS 3456
#define XB_SPIN_CAP (1u << 18)

__device__ __forceinline__ unsigned xb_ld(unsigned* p)              { return __hip_atomic_load(p, __ATOMIC_RELAXED, __HIP_MEMORY_SCOPE_AGENT); }
__device__ __forceinline__ unsigned xb_add(unsigned* p, unsigned v) { return __hip_atomic_fetch_add(p, v, __ATOMIC_RELAXED, __HIP_MEMORY_SCOPE_AGENT); }
__device__ __forceinline__ unsigned xb_xcc_id() { return (unsigned)__builtin_amdgcn_s_getreg((3 << 11) | 20) & 0xFu; }
#define XB_SPIN(cond, bar) do { unsigned _sp = 0; while (cond) { __builtin_amdgcn_s_sleep(1); \
    if ((++_sp & 255u) == 0u) { if (xb_ld(&(bar)[XB_TMO])) break; if (_sp > XB_SPIN_CAP) { atomicAdd(&(bar)[XB_TMO], 1u); break; } } } } while (0)

struct XcdBarrier {
    unsigned* bar; unsigned x;
    volatile LAS unsigned* st;
};

__device__ __forceinline__ XcdBarrier xcd_barrier_post(unsigned* bar, volatile LAS unsigned* st) {
    XcdBarrier b; b.bar = bar; b.x = xb_xcc_id(); b.st = st;
    if (threadIdx.x == 0) (void)xb_add(&bar[XB_XCNT(b.x)], 1u);
    return b;
}
__device__ __forceinline__ void xcd_barrier_complete(unsigned* bar, unsigned x, unsigned& nloc, unsigned& nx) {
    const unsigned G = gridDim.x * gridDim.y * gridDim.z;
    unsigned sum, cnt, mine, sp = 0u;
    for (;;) {
        sum = 0u; cnt = 0u; mine = 0u;
#pragma unroll
        for (unsigned j = 0; j < 16; ++j) { const unsigned c = xb_ld(&bar[XB_XCNT(j)]); sum += c; cnt += (c > 0u) ? 1u : 0u; mine = (j == x) ? c : mine; }
        if (sum == G) break;
        __builtin_amdgcn_s_sleep(1);
        if ((++sp & 255u) == 0u) { if (xb_ld(&bar[XB_TMO])) break; if (sp > XB_SPIN_CAP) { atomicAdd(&bar[XB_TMO], 1u); break; } }
    }
    nloc = mine > 0u ? mine : 1u; nx = cnt > 0u ? cnt : 1u;
}

__device__ __forceinline__ void xcd_barrier(const XcdBarrier& b) {
    asm volatile("s_waitcnt vmcnt(0)" ::: "memory");
    __syncthreads();
    if (threadIdx.x == 0) {
        unsigned* bar = b.bar;
        __builtin_amdgcn_s_waitcnt(0);
        unsigned nloc = b.st[0], nx = b.st[1];
        if (nloc == 0u) { xcd_barrier_complete(bar, b.x, nloc, nx); b.st[0] = nloc; b.st[1] = nx; }
        const unsigned old = xb_add(&bar[XB_XSUB(b.x)], 1u);
        const unsigned gen = old / nloc;
        if (old + 1u == (gen + 1u) * nloc) {
            __builtin_amdgcn_fence(__ATOMIC_RELEASE, "agent");
            asm volatile("s_waitcnt vmcnt(0)" ::: "memory");
            const unsigned og = xb_add(&bar[XB_TOP], 1u);
            const unsigned tg = og / nx;
            if (og + 1u == (tg + 1u) * nx) xb_add(&bar[XB_TOPGEN], 1u);
            else XB_SPIN(xb_ld(&bar[XB_TOPGEN]) == tg, bar);
            __builtin_amdgcn_fence(__ATOMIC_ACQUIRE, "agent");
            xb_add(&bar[XB_XGEN(b.x)], 1u);
            asm volatile("s_waitcnt vmcnt(0)" ::: "memory");
        } else {
            XB_SPIN(xb_ld(&bar[XB_XGEN(b.x)]) == gen, bar);
            __builtin_amdgcn_fence(__ATOMIC_ACQUIRE, "agent");
            asm volatile("s_waitcnt vmcnt(0)" ::: "memory");
        }
    }
    __syncthreads();
}
constexpr int NWAVES = 8, NTHR = 512;
constexpr int BATCH = 2, SEQ = 8192, DM = 1024, MTOK = BATCH * SEQ;
constexpr int NIN = 3584;
constexpr int AW = 512;
constexpr int NEXP = 16, DFF = 1024, CAP = 1024, NROWS = BATCH * NEXP * CAP;
constexpr int NSC = 32, SCLEN = 256;
constexpr int NHEAD = 16, HD = 64, NQKV = 3072;
constexpr float EPS = 1e-6f;
constexpr int NPHASE = 23;

constexpr size_t MiB = 1u << 20;
constexpr size_t WS_CTL = 0, CTL_ZERO_BYTES = 1 * MiB;
constexpr size_t WS_AFF = 1 * MiB;
constexpr size_t WS_POS = 2 * MiB;
constexpr size_t WS_IDX = 3 * MiB;
constexpr size_t WS_GATE = 3 * MiB + 256 * 1024;
constexpr size_t WS_DEC = 3 * MiB + 512 * 1024;
constexpr size_t WS_LB = 4 * MiB;
constexpr size_t WS_BT = 4 * MiB + 64 * 1024;
constexpr size_t WS_WIN = 8 * MiB;
constexpr size_t WS_WOUT = 15 * MiB;
constexpr size_t WS_WQKV = 17 * MiB;
constexpr size_t WS_WO = 23 * MiB;
constexpr size_t WS_WGU = 32 * MiB;
constexpr size_t WS_WDN = 96 * MiB;
constexpr size_t WS_H = 128 * MiB;
constexpr size_t WS_R1 = 160 * MiB;
constexpr size_t WS_U = WS_R1, WS_GV = WS_R1 + 16 * MiB, WS_Q = WS_R1 + 32 * MiB, WS_V = WS_R1 + 48 * MiB, WS_G = WS_R1 + 64 * MiB;
constexpr size_t WS_LFF = WS_R1 + 80 * MiB, WS_LFB = WS_R1 + 112 * MiB;
constexpr size_t WS_CAT = WS_R1 + 144 * MiB;
constexpr size_t WS_ST = WS_R1 + 176 * MiB;
constexpr size_t WS_ODIR = WS_R1 + 208 * MiB;
constexpr size_t WS_XE = WS_R1, WS_Y = WS_R1;
constexpr size_t WS_HMID = WS_R1 + 64 * MiB;
constexpr size_t WS_QKV = WS_R1;
constexpr size_t WS_ATT = WS_R1 + 96 * MiB;
constexpr size_t WS_VT = WS_R1 + 128 * MiB;
constexpr size_t WS_END = WS_R1 + 272 * MiB;
constexpr int CW_BAR = 4096;
constexpr int MAX_BAR_REGIONS = 24;

constexpr int RING_BYTES = 131072;
constexpr int LDS_BYTES = 147456;
constexpr int LDSCTL_OFF = LDS_BYTES - 512, MISC_OFF = LDSCTL_OFF + 320;

struct Args { const float* in[19]; float* out; unsigned char* ws; int ph_lo, ph_hi, li, pad; };

struct Frame {
    LAS unsigned char* lds;
    volatile LAS unsigned* MISC;
    int tid, lane, wave, G, bid, gw, NGW;
    unsigned char* ws;
};

template <int NPN_> struct GroupedOrder {
    int G, c;
    DI bool next(int i, pg8::Unit& u) const {
        const int L = i * G + c; if (L >= 16 * 8 * NPN_) return false;
        const int e = L / (8 * NPN_), w = L % (8 * NPN_);
        u.pm = e * 8 + (w & 7); u.pn = e * NPN_ + (w >> 3); return true;
    }
    DI void a_ready(const pg8::Unit&) const {}
    DI void done(const pg8::Unit&) const {}
};

struct EpiInProj {
    static constexpr bool PERM = true, AFTER_DRAIN = false;
    bf16 *U, *GV, *Q, *V, *G; float *LFf, *LFb; const float* LB;
    DI void operator()(const pg8::f32x4 (&acc)[2][2][4][2], const pg8::Unit& u, int wr, int wc, int fr, int fq) const {
        const int seg = u.pn >> 1;
        const int row0 = u.pm * 256 + wr * 64 + fr, lc0 = (u.pn & 1) * 256 + wc * 32 + 8 * fq;
#pragma unroll
        for (int bj = 0; bj < 2; ++bj) {
            const int lc = lc0 + bj * 128;
            float lb[8];
            if (seg == 3 || seg == 4) {
#pragma unroll
                for (int j = 0; j < 8; ++j) lb[j] = LB[(seg - 3) * 512 + lc + j];
            }
#pragma unroll
            for (int ai = 0; ai < 2; ++ai)
#pragma unroll
                for (int m = 0; m < 4; ++m) {
                    const size_t off = (size_t)(row0 + ai * 128 + m * 16) * 512 + lc;
                    float v[8];
#pragma unroll
                    for (int j = 0; j < 8; ++j) v[j] = acc[ai][bj][m][j >> 2][j & 3];
                    if (seg == 3 || seg == 4) {
#pragma unroll
                        for (int j = 0; j < 8; ++j) v[j] = flog(lb[j] + (1.f - lb[j]) * sigmoidf_(v[j]));
                        float* o = (seg == 3 ? LFf : LFb) + off;
                        *(f32x4*)o = (f32x4){v[0], v[1], v[2], v[3]}; *(f32x4*)(o + 4) = (f32x4){v[4], v[5], v[6], v[7]};
                    } else {
                        bf16* o;
                        if (seg == 0) { o = U;
#pragma unroll
                            for (int j = 0; j < 8; ++j) v[j] = gelu_tanh(v[j]);
                        } else if (seg == 1) { o = GV;
#pragma unroll
                            for (int j = 0; j < 8; ++j) v[j] = gelu_tanh(v[j]);
                        } else if (seg == 2) { o = Q;
#pragma unroll
                            for (int j = 0; j < 8; ++j) v[j] = siluf_(v[j]);
                        } else if (seg == 5) { o = V;
                        } else { o = G;
#pragma unroll
                            for (int j = 0; j < 8; ++j) v[j] = sigmoidf_(v[j]);
                        }
                        v4u w; w.x = pk2(v[0], v[1]); w.y = pk2(v[2], v[3]); w.z = pk2(v[4], v[5]); w.w = pk2(v[6], v[7]);
                        *(v4u*)(o + off) = w;
                    }
                }
        }
    }
};
struct EpiResid {
    static constexpr bool PERM = false, AFTER_DRAIN = false;
    const float* base; float* out;
    DI void operator()(const pg8::f32x4 (&acc)[2][2][4][2], const pg8::Unit& u, int wr, int wc, int fr, int fq) const {
        const int row0 = u.pm * 256 + wr * 64 + fr, col0 = u.pn * 256 + wc * 32 + 4 * fq;
#pragma unroll
        for (int ai = 0; ai < 2; ++ai)
#pragma unroll
            for (int m = 0; m < 4; ++m) { const size_t ro = (size_t)(row0 + ai * 128 + m * 16) * DM + col0;
#pragma unroll
                for (int bj = 0; bj < 2; ++bj)
#pragma unroll
                    for (int n = 0; n < 2; ++n) { const size_t o = ro + bj * 128 + n * 16; *(f32x4*)(out + o) = *(const f32x4*)(base + o) + acc[ai][bj][m][n]; } }
    }
};
struct EpiGateUp {
    static constexpr bool PERM = true, AFTER_DRAIN = false;
    bf16* H;
    DI void operator()(const pg8::f32x4 (&acc)[2][2][4][2], const pg8::Unit& u, int wr, int wc, int fr, int fq) const {
        const int pnl = u.pn & 7;
        const int row0 = u.pm * 256 + wr * 64 + fr, col0 = pnl * 128 + wc * 32 + 8 * fq;
#pragma unroll
        for (int ai = 0; ai < 2; ++ai)
#pragma unroll
            for (int m = 0; m < 4; ++m) {
                float v[8];
#pragma unroll
                for (int j = 0; j < 8; ++j) v[j] = siluf_(acc[ai][0][m][j >> 2][j & 3]) * acc[ai][1][m][j >> 2][j & 3];
                v4u w; w.x = pk2(v[0], v[1]); w.y = pk2(v[2], v[3]); w.z = pk2(v[4], v[5]); w.w = pk2(v[6], v[7]);
                *(v4u*)(H + (size_t)(row0 + ai * 128 + m * 16) * DFF + col0) = w;
            }
    }
};
struct EpiDown {
    static constexpr bool PERM = true, AFTER_DRAIN = false;
    bf16* Y; const float* gate;
    DI void operator()(const pg8::f32x4 (&acc)[2][2][4][2], const pg8::Unit& u, int wr, int wc, int fr, int fq) const {
        const int pnl = u.pn & 3;
        const int row0 = u.pm * 256 + wr * 64 + fr, col0 = pnl * 256 + wc * 32 + 8 * fq;
#pragma unroll
        for (int ai = 0; ai < 2; ++ai)
#pragma unroll
            for (int m = 0; m < 4; ++m) { const int row = row0 + ai * 128 + m * 16; const float g = gate[row];
#pragma unroll
                for (int bj = 0; bj < 2; ++bj) {
                    float v[8];
#pragma unroll
                    for (int j = 0; j < 8; ++j) v[j] = acc[ai][bj][m][j >> 2][j & 3] * g;
                    v4u w; w.x = pk2(v[0], v[1]); w.y = pk2(v[2], v[3]); w.z = pk2(v[4], v[5]); w.w = pk2(v[6], v[7]);
                    *(v4u*)(Y + (size_t)row * DM + col0 + bj * 128) = w; } }
    }
};
struct EpiQKV {
    static constexpr bool PERM = true, AFTER_DRAIN = false;
    bf16* O;
    DI void operator()(const pg8::f32x4 (&acc)[2][2][4][2], const pg8::Unit& u, int wr, int wc, int fr, int fq) const {
        const float sc = (u.pn < 4) ? 0.125f : 1.f;
        const int row0 = u.pm * 256 + wr * 64 + fr, col0 = u.pn * 256 + wc * 32 + 8 * fq;
#pragma unroll
        for (int ai = 0; ai < 2; ++ai)
#pragma unroll
            for (int m = 0; m < 4; ++m)
#pragma unroll
                for (int bj = 0; bj < 2; ++bj) {
                    float v[8];
#pragma unroll
                    for (int j = 0; j < 8; ++j) v[j] = acc[ai][bj][m][j >> 2][j & 3] * sc;
                    v4u w; w.x = pk2(v[0], v[1]); w.y = pk2(v[2], v[3]); w.z = pk2(v[4], v[5]); w.w = pk2(v[6], v[7]);
                    *(v4u*)(O + (size_t)(row0 + ai * 128 + m * 16) * NQKV + col0 + bj * 128) = w; }
    }
};

DI void transpose_item(const float* W, int K, int N, bf16* WT, LAS float* scr, int k0, int n0, int drow0, int lane) {
#pragma unroll 8
    for (int i = 0; i < 32; ++i) { const int kk = 2 * i + (lane >> 5); scr[kk * 33 + (lane & 31)] = W[(size_t)(k0 + kk) * N + n0 + (lane & 31)]; }
    LDS_WAIT(); asm volatile("" ::: "memory");
    const int c = lane & 7;
#pragma unroll
    for (int j = 0; j < 4; ++j) { const int n = (lane >> 3) + 8 * j; const LAS float* s = scr + (8 * c) * 33 + n;
        v4u o; o.x = pk2(s[0 * 33], s[1 * 33]); o.y = pk2(s[2 * 33], s[3 * 33]); o.z = pk2(s[4 * 33], s[5 * 33]); o.w = pk2(s[6 * 33], s[7 * 33]);
        *(v4u*)(WT + (size_t)(drow0 + n) * K + k0 + 8 * c) = o; }
    LDS_WAIT(); asm volatile("" ::: "memory");
}
DI void transpose_matrix(Frame& F, const float* W, int K, int N, bf16* WT) {
    LAS float* scr = (LAS float*)(F.lds + F.wave * 16384);
    const int nblk = N / 32, nitems = (K / 64) * nblk;
    for (int it = F.gw; it < nitems; it += F.NGW) { const int kb = it / nblk, nb = it % nblk; transpose_item(W, K, N, WT, scr, 64 * kb, 32 * nb, 32 * nb, F.lane); }
}
DI void convert_moe_weights(Frame& F, const float* wg, const float* wu, const float* wd, int layer) {
    LAS float* scr = (LAS float*)(F.lds + F.wave * 16384);
    bf16* WGU = (bf16*)(F.ws + WS_WGU); bf16* WDN = (bf16*)(F.ws + WS_WDN);
    for (int it = F.gw; it < 3 * 16 * 512; it += F.NGW) {
        const int mat = it / 8192, rem = it % 8192, e = rem / 512, r = rem % 512, kb = r / 32, nb = r % 32, n0 = 32 * nb;
        const size_t so = ((size_t)layer * 16 + e) * 1024 * 1024;
        if (mat == 0) transpose_item(wg + so, 1024, 1024, WGU + (size_t)e * 2048 * 1024, scr, 64 * kb, n0, (n0 >> 7) * 256 + (n0 & 127), F.lane);
        else if (mat == 1) transpose_item(wu + so, 1024, 1024, WGU + (size_t)e * 2048 * 1024, scr, 64 * kb, n0, (n0 >> 7) * 256 + 128 + (n0 & 127), F.lane);
        else transpose_item(wd + so, 1024, 1024, WDN + (size_t)e * 1024 * 1024, scr, 64 * kb, n0, n0, F.lane);
    }
}
DI void rms_row(const float* xrow, const float* g, f32x4 (&v)[4], int lane) {
    const f32x4* xr = (const f32x4*)xrow + lane; float s = 0.f;
#pragma unroll
    for (int j = 0; j < 4; ++j) { v[j] = xr[64 * j]; s += (v[j].x * v[j].x + v[j].y * v[j].y) + (v[j].z * v[j].z + v[j].w * v[j].w); }
    const float rstd = 1.f / sqrtf(wave_sum(s) * (1.f / DM) + EPS);
    const f32x4* gr = (const f32x4*)g + lane;
#pragma unroll
    for (int j = 0; j < 4; ++j) v[j] = v[j] * rstd * gr[64 * j];
}
DI void store_row_bf16(bf16* orow, const f32x4 (&v)[4], int lane) {
    v2u* o8 = (v2u*)orow + lane;
#pragma unroll
    for (int j = 0; j < 4; ++j) { v2u w; w.x = pk2(v[j].x, v[j].y); w.y = pk2(v[j].z, v[j].w); o8[64 * j] = w; }
}
DI int t5_bucket(int rel) {
    const int n = rel < 0 ? -rel : rel;
    int val;
    if (n < 8) val = n;
    else { const float sc = logf((float)n / 8.f) / 4.852030263919617f; int lg = 8 + (int)(sc * 8.f); val = lg < 15 ? lg : 15; }
    return (rel > 0 ? 16 : 0) + val;
}

DI void phase_prologue(Frame& F, const Args& a) {
    unsigned char* ws = F.ws;
    transpose_matrix(F, a.in[4], 1024, NIN, (bf16*)(ws + WS_WIN));
    transpose_matrix(F, a.in[5], 1024, 1024, (bf16*)(ws + WS_WOUT));
    transpose_matrix(F, a.in[12], 1024, NQKV, (bf16*)(ws + WS_WQKV));
    transpose_matrix(F, a.in[13], 1024, 1024, (bf16*)(ws + WS_WO));
    convert_moe_weights(F, a.in[16], a.in[17], a.in[18], 0);
    { float* LB = (float*)(ws + WS_LB); const float* t = a.in[10];
      for (int i = F.bid * NTHR + F.tid; i < 2 * 512; i += F.G * NTHR) { const int d = i / 512, k = i % 512;
          const float a0 = t[(d * 3 + 0) * 512 + k], a1 = t[(d * 3 + 1) * 512 + k], a2 = t[(d * 3 + 2) * 512 + k];
          const float mx = fmaxf(a0, fmaxf(a1, a2)); const float e0 = expf(a0 - mx), e1 = expf(a1 - mx), e2 = expf(a2 - mx);
          LB[i] = e0 / (e0 + e1 + e2); } }
    { float* BT = (float*)(ws + WS_BT); const float* rb = a.in[14];
      for (int i = F.bid * NTHR + F.tid; i < 3 * 16 * 129; i += F.G * NTHR) { const int p = i / (16 * 129), h = (i / 129) % 16, j = i % 129;
          const int dil = (p == 0) ? 1 : (p == 1 ? 4 : 16);
          BT[i] = rb[t5_bucket((j - 64) * dil) * 16 + h]; } }
    { bf16* H = (bf16*)(ws + WS_H); const float* x = a.in[0];
      for (int m = F.gw; m < MTOK; m += F.NGW) { f32x4 v[4]; rms_row(x + (size_t)m * DM, a.in[1], v, F.lane); store_row_bf16(H + (size_t)m * DM, v, F.lane); } }
}

DI void phase_a_ln(Frame& F, const Args& a) {
    bf16* GV = (bf16*)(F.ws + WS_GV); const float* lg = a.in[6]; const float* lbv = a.in[7];
    for (int m = F.gw; m < MTOK; m += F.NGW) {
        v4u w = *((const v4u*)(GV + (size_t)m * AW) + F.lane);
        float v[8] = {bflo(w.x), bfhi(w.x), bflo(w.y), bfhi(w.y), bflo(w.z), bfhi(w.z), bflo(w.w), bfhi(w.w)};
        float s = 0.f;
#pragma unroll
        for (int j = 0; j < 8; ++j) s += v[j];
        const float mu = wave_sum(s) * (1.f / AW); float s2 = 0.f;
#pragma unroll
        for (int j = 0; j < 8; ++j) { v[j] -= mu; s2 += v[j] * v[j]; }
        const float rstd = 1.f / sqrtf(wave_sum(s2) * (1.f / AW) + EPS);
#pragma unroll
        for (int j = 0; j < 8; ++j) v[j] = v[j] * rstd * lg[8 * F.lane + j] + lbv[8 * F.lane + j];
        v4u o; o.x = pk2(v[0], v[1]); o.y = pk2(v[2], v[3]); o.z = pk2(v[4], v[5]); o.w = pk2(v[6], v[7]);
        *((v4u*)(GV + (size_t)m * AW) + F.lane) = o;
    }
}
DI void phase_a_mix_naive(Frame& F, const Args& a) {
    const bf16* VN = (const bf16*)(F.ws + WS_GV); const bf16* U = (const bf16*)(F.ws + WS_U); bf16* CAT = (bf16*)(F.ws + WS_CAT);
    LAS float* wl = (LAS float*)F.lds; LAS float* vl = (LAS float*)(F.lds + 65536);
    for (int u = F.bid; u < 512; u += F.G) {
        const int g = u & 3, ch = u >> 2; const int row0 = ch * 128;
        __syncthreads();
        for (int i = F.tid; i < 128 * 128; i += NTHR) { wl[i] = a.in[8][g * 16384 + i]; const int s = i >> 7, c = i & 127; vl[i] = bf2f(VN[(size_t)(row0 + s) * AW + g * 128 + c]); }
        __syncthreads();
        const int c = F.tid & 127, tq = F.tid >> 7;
        for (int tt = 0; tt < 32; ++tt) { const int t = tq * 32 + tt; float acc = 0.f;
            for (int s = 0; s < 128; ++s) acc += wl[t * 128 + s] * vl[s * 128 + c];
            const float uu = bf2f(U[(size_t)(row0 + t) * AW + g * 128 + c]);
            CAT[(size_t)(row0 + t) * DM + g * 128 + c] = (bf16)f2bf(uu * (acc + a.in[9][g * 128 + t])); }
    }
}

DI void gla_naive_unit(Frame& F, int u, bool with_out) {
    const int sc = u & 31, dir = (u >> 5) & 1, h = (u >> 6) & 3, b = u >> 8;
    const bf16* Q = (const bf16*)(F.ws + WS_Q); const bf16* V = (const bf16*)(F.ws + WS_V);
    const float* LF = (const float*)(F.ws + (dir ? WS_LFB : WS_LFF));
    float* ST = (float*)(F.ws + WS_ST) + (size_t)u * 16384; float* DEC = (float*)(F.ws + WS_DEC) + u * 128;
    float* OD = (float*)(F.ws + WS_ODIR) + (size_t)dir * MTOK * AW;
    LAS bf16* qs = (LAS bf16*)F.lds; LAS bf16* vs = (LAS bf16*)(F.lds + 16384); LAS float* lfs = (LAS float*)(F.lds + 32768);
    const int lane = F.lane, w = F.wave;
    float S[2][16]; float lsum[2] = {0.f, 0.f};
#pragma unroll
    for (int aa = 0; aa < 2; ++aa)
#pragma unroll
        for (int j = 0; j < 16; ++j) S[aa][j] = with_out ? ST[(lane + 64 * aa) * 128 + 16 * w + j] : 0.f;
    for (int sub = 0; sub < 4; ++sub) {
        __syncthreads();
        for (int idx = F.tid; idx < 1024; idx += NTHR) { const int i = idx >> 4, c8 = (idx & 15) * 8; const int ii = sc * 256 + sub * 64 + i; const int tok = dir ? (SEQ - 1 - ii) : ii;
            const size_t go = (size_t)(b * SEQ + tok) * AW + h * 128 + c8;
            *(LAS v4u*)(qs + i * 128 + c8) = *(const v4u*)(Q + go); *(LAS v4u*)(vs + i * 128 + c8) = *(const v4u*)(V + go); }
        for (int idx = F.tid; idx < 2048; idx += NTHR) { const int i = idx >> 5, c4 = (idx & 31) * 4; const int ii = sc * 256 + sub * 64 + i; const int tok = dir ? (SEQ - 1 - ii) : ii;
            *(LAS f32x4*)(lfs + i * 128 + c4) = *(const f32x4*)(LF + (size_t)(b * SEQ + tok) * AW + h * 128 + c4); }
        __syncthreads();
        for (int i = 0; i < 64; ++i) {
            const float l0 = lfs[i * 128 + lane], l1 = lfs[i * 128 + lane + 64];
            const float f0 = fexp(l0), f1 = fexp(l1), k0 = 1.f - f0, k1 = 1.f - f1;
            lsum[0] += l0; lsum[1] += l1;
            float vv[16];
            { const v4u a0 = *(const LAS v4u*)(vs + i * 128 + 16 * w), a1 = *(const LAS v4u*)(vs + i * 128 + 16 * w + 8);
              vv[0] = bflo(a0.x); vv[1] = bfhi(a0.x); vv[2] = bflo(a0.y); vv[3] = bfhi(a0.y); vv[4] = bflo(a0.z); vv[5] = bfhi(a0.z); vv[6] = bflo(a0.w); vv[7] = bfhi(a0.w);
              vv[8] = bflo(a1.x); vv[9] = bfhi(a1.x); vv[10] = bflo(a1.y); vv[11] = bfhi(a1.y); vv[12] = bflo(a1.z); vv[13] = bfhi(a1.z); vv[14] = bflo(a1.w); vv[15] = bfhi(a1.w); }
#pragma unroll
            for (int j = 0; j < 16; ++j) { S[0][j] = f0 * S[0][j] + k0 * vv[j]; S[1][j] = f1 * S[1][j] + k1 * vv[j]; }
            if (with_out) {
                const float q0 = bf2f(qs[i * 128 + lane]), q1 = bf2f(qs[i * 128 + lane + 64]);
                float o[16];
#pragma unroll
                for (int j = 0; j < 16; ++j) o[j] = S[0][j] * q0 + S[1][j] * q1;
                const float tot = red16(o, lane);
                if ((lane & 3) == 0) { const int ii = sc * 256 + sub * 64 + i; const int tok = dir ? (SEQ - 1 - ii) : ii;
                    OD[(size_t)(b * SEQ + tok) * AW + h * 128 + 16 * w + red16_idx(lane)] = tot; }
            }
        }
    }
    if (!with_out) {
#pragma unroll
        for (int aa = 0; aa < 2; ++aa)
#pragma unroll
            for (int j = 0; j < 16; ++j) ST[(lane + 64 * aa) * 128 + 16 * w + j] = S[aa][j];
        if (w == 0) { DEC[lane] = fexp(lsum[0]); DEC[lane + 64] = fexp(lsum[1]); }
    }
}
DI void phase_gla_scan(Frame& F) {
    float* ST = (float*)(F.ws + WS_ST); const float* DEC = (const float*)(F.ws + WS_DEC);
    for (int idx = F.bid * NTHR + F.tid; idx < 16 * 16384; idx += F.G * NTHR) {
        const int chain = idx >> 14, kv = idx & 16383, k = kv >> 7; float S = 0.f;
        for (int sc = 0; sc < NSC; ++sc) { const int u = chain * NSC + sc; const size_t o = (size_t)u * 16384 + kv; const float d = ST[o]; ST[o] = S; S = S * DEC[u * 128 + k] + d; }
    }
}
DI void phase_b_combine(Frame& F, const Args& a) {
    const float* OD = (const float*)(F.ws + WS_ODIR); const bf16* G = (const bf16*)(F.ws + WS_G); bf16* CAT = (bf16*)(F.ws + WS_CAT); const float* ng = a.in[11];
    for (int t = F.gw; t < MTOK * 4; t += F.NGW) { const int row = t >> 2, h = t & 3; const size_t o = (size_t)row * AW + h * 128 + 2 * F.lane;
        const float o0 = OD[o] + OD[(size_t)MTOK * AW + o], o1 = OD[o + 1] + OD[(size_t)MTOK * AW + o + 1];
        const float rstd = 1.f / sqrtf(wave_sum(o0 * o0 + o1 * o1) * (1.f / 128.f) + EPS);
        const unsigned gw2 = *(const unsigned*)(G + o);
        const float r0 = o0 * rstd * ng[h * 128 + 2 * F.lane] * bflo(gw2), r1 = o1 * rstd * ng[h * 128 + 2 * F.lane + 1] * bfhi(gw2);
        *(unsigned*)(CAT + (size_t)row * DM + 512 + h * 128 + 2 * F.lane) = pk2(r0, r1); }
}

DI void phase_router(Frame& F, const float* XR, const float* gn, const float* wr) {
    LAS float* wl = (LAS float*)F.lds;
    __syncthreads();
    for (int i = F.tid; i < 1024 * 16 / 4; i += NTHR) *(LAS f32x4*)(wl + 4 * i) = *(const f32x4*)(wr + 4 * i);
    __syncthreads();
    bf16* H = (bf16*)(F.ws + WS_H); float* AFF = (float*)(F.ws + WS_AFF);
    for (int m = F.gw; m < MTOK; m += F.NGW) {
        asm volatile("" ::: "memory");
        f32x4 v[4]; rms_row(XR + (size_t)m * DM, gn, v, F.lane); store_row_bf16(H + (size_t)m * DM, v, F.lane);
        float p[16];
#pragma unroll
        for (int e = 0; e < 16; ++e) p[e] = 0.f;
#pragma unroll
        for (int j = 0; j < 4; ++j)
#pragma unroll
            for (int q = 0; q < 4; ++q) { const int d = 4 * F.lane + 256 * j + q; const float xv = v[j][q];
#pragma unroll
                for (int e4 = 0; e4 < 4; ++e4) { const f32x4 w4 = *(const LAS f32x4*)(wl + d * 16 + 4 * e4); p[4 * e4] += xv * w4.x; p[4 * e4 + 1] += xv * w4.y; p[4 * e4 + 2] += xv * w4.z; p[4 * e4 + 3] += xv * w4.w; } }
        const float lg = red16(p, F.lane);
        const float mx = wave_max(lg); const float ex = expf(lg - mx); const float sm = wave_sum(ex) * 0.25f;
        if ((F.lane & 3) == 0) { const int b = m / SEQ, s = m % SEQ; AFF[(size_t)(b * 16 + red16_idx(F.lane)) * SEQ + s] = ex / sm; }
    }
}

DI int block_excl_scan(int v, LAS int* scratch, int tid, int lane, int wave, int* tot) {
    int inc = v;
#pragma unroll
    for (int o = 1; o < 64; o <<= 1) { const int t = __shfl_up(inc, o); if (lane >= o) inc += t; }
    __syncthreads();
    if (lane == 63) scratch[wave] = inc;
    __syncthreads();
    int base = 0, total = 0;
#pragma unroll
    for (int w = 0; w < NWAVES; ++w) { const int s = scratch[w]; if (w < wave) base += s; total += s; }
    *tot = total;
    return base + inc - v;
}
DI void phase_topk(Frame& F) {
    const float* AFF = (const float*)(F.ws + WS_AFF); int* IDX = (int*)(F.ws + WS_IDX); float* GATE = (float*)(F.ws + WS_GATE); int* POS = (int*)(F.ws + WS_POS);
    LAS unsigned* hist = (LAS unsigned*)F.lds; LAS int* sc = (LAS int*)(F.lds + 2048); LAS unsigned* shv = (LAS unsigned*)(F.lds + 2048 + 256);
    for (int u = F.bid; u < BATCH * NEXP; u += F.G) {
        const int b = u / NEXP, e = u % NEXP;
        unsigned vals[16];
        { const v4u* src = (const v4u*)(AFF + (size_t)u * SEQ + 16 * F.tid);
#pragma unroll
          for (int j = 0; j < 4; ++j) { const v4u t = src[j]; vals[4 * j] = t.x; vals[4 * j + 1] = t.y; vals[4 * j + 2] = t.z; vals[4 * j + 3] = t.w; } }
        unsigned prefix = 0; int krem = CAP;
        for (int pass = 0; pass < 4; ++pass) { const int shift = 24 - 8 * pass;
            __syncthreads();
            if (F.tid < 256) hist[F.tid] = 0u;
            __syncthreads();
#pragma unroll
            for (int j = 0; j < 16; ++j) { const unsigned v = vals[j]; if (pass == 0 || (v >> (shift + 8)) == prefix) __hip_atomic_fetch_add(&hist[(v >> shift) & 255u], 1u, __ATOMIC_RELAXED, __HIP_MEMORY_SCOPE_WORKGROUP); }
            __syncthreads();
            if (F.tid == 0) { int cum = 0, sel = 0; for (int bin = 255; bin >= 0; --bin) { const int c = (int)hist[bin]; if (cum + c >= krem) { sel = bin; break; } cum += c; }
                shv[0] = (prefix << 8) | (unsigned)sel; shv[1] = (unsigned)(krem - cum); }
            __syncthreads();
            prefix = shv[0]; krem = (int)shv[1];
        }
        const unsigned T = prefix;
        int ce = 0;
#pragma unroll
        for (int j = 0; j < 16; ++j) ce += (vals[j] == T) ? 1 : 0;
        int tot; int pe = block_excl_scan(ce, sc, F.tid, F.lane, F.wave, &tot);
        unsigned selmask = 0; int cs = 0;
#pragma unroll
        for (int j = 0; j < 16; ++j) { bool s = vals[j] > T; if (vals[j] == T) { s = pe < krem; ++pe; } if (s) { selmask |= 1u << j; ++cs; } }
        int slot = block_excl_scan(cs, sc, F.tid, F.lane, F.wave, &tot);
#pragma unroll
        for (int j = 0; j < 16; ++j) { const int s = 16 * F.tid + j; const int tokrow = b * SEQ + s;
            if (selmask & (1u << j)) { const int row = (e * 2 + b) * CAP + slot; ++slot; IDX[row] = tokrow; GATE[row] = __builtin_bit_cast(float, vals[j]); POS[tokrow * 16 + e] = row; }
            else POS[tokrow * 16 + e] = -1; }
    }
}
DI void phase_gather(Frame& F) {
    const bf16* H = (const bf16*)(F.ws + WS_H); bf16* XE = (bf16*)(F.ws + WS_XE); const int* IDX = (const int*)(F.ws + WS_IDX);
    for (int r = F.gw; r < NROWS; r += F.NGW) { const int src = IDX[r];
        const v4u* s = (const v4u*)(H + (size_t)src * DM) + F.lane; v4u* d = (v4u*)(XE + (size_t)r * DM) + F.lane;
        d[0] = s[0]; d[64] = s[64]; }
}
DI void phase_moe_combine(Frame& F, float* XR, const float* gnext, bool final_out) {
    const bf16* Y = (const bf16*)(F.ws + WS_Y); const int* POS = (const int*)(F.ws + WS_POS); bf16* H = (bf16*)(F.ws + WS_H);
    for (int m = F.gw; m < MTOK; m += F.NGW) {
        f32x4* xr = (f32x4*)(XR + (size_t)m * DM) + F.lane;
        f32x4 v[4];
#pragma unroll
        for (int j = 0; j < 4; ++j) v[j] = xr[64 * j];
        const int pmine = POS[m * 16 + (F.lane & 15)];
        for (int e = 0; e < 16; ++e) { const int p = __shfl(pmine, e);
            if (p >= 0) { const v2u* yr = (const v2u*)(Y + (size_t)p * DM) + F.lane;
#pragma unroll
                for (int j = 0; j < 4; ++j) { const v2u w = yr[64 * j]; v[j].x += bflo(w.x); v[j].y += bfhi(w.x); v[j].z += bflo(w.y); v[j].w += bfhi(w.y); } } }
        float s = 0.f;
#pragma unroll
        for (int j = 0; j < 4; ++j) s += (v[j].x * v[j].x + v[j].y * v[j].y) + (v[j].z * v[j].z + v[j].w * v[j].w);
        const float rstd = 1.f / sqrtf(wave_sum(s) * (1.f / DM) + EPS);
        const f32x4* gr = (const f32x4*)gnext + F.lane;
        if (final_out) {
#pragma unroll
            for (int j = 0; j < 4; ++j) xr[64 * j] = v[j] * rstd * gr[64 * j];
        } else {
#pragma unroll
            for (int j = 0; j < 4; ++j) xr[64 * j] = v[j];
            f32x4 nv[4];
#pragma unroll
            for (int j = 0; j < 4; ++j) nv[j] = v[j] * rstd * gr[64 * j];
            store_row_bf16(H + (size_t)m * DM, nv, F.lane);
        }
    }
}

DI void phase_attn_naive(Frame& F) {
    const bf16* QKV = (const bf16*)(F.ws + WS_QKV); bf16* ATT = (bf16*)(F.ws + WS_ATT); const float* BT = (const float*)(F.ws + WS_BT);
    LAS float* ql = (LAS float*)(F.lds + F.wave * 4096);
    LAS float* pl = ql + 64; LAS int* posl = (LAS int*)(ql + 512);
    const int lane = F.lane;
    for (int t = F.gw; t < MTOK * NHEAD; t += F.NGW) {
        const int row = t >> 4, h = t & 15, b = row / SEQ, tq = row % SEQ;
        ql[lane] = bf2f(QKV[(size_t)row * NQKV + h * 64 + lane]);
        LDS_WAIT();
        float s[7]; int pos[7];
#pragma unroll
        for (int i = 0; i < 7; ++i) {
            const int slot = lane + 64 * i; const int p = slot / 129, j = slot % 129;
            const int dil = (p == 0) ? 1 : (p == 1 ? 4 : 16);
            const int mq = tq / dil, r = tq % dil, mk = mq - 64 + j;
            const bool valid = (slot < 387) && (mk >= 0) && (mk < SEQ / dil);
            pos[i] = valid ? (b * SEQ + r + dil * mk) : -1;
            float d = -1e30f;
            if (valid) { const v4u* kr = (const v4u*)(QKV + (size_t)pos[i] * NQKV + 1024 + h * 64); float acc = 0.f;
#pragma unroll
                for (int c = 0; c < 8; ++c) { const v4u w = kr[c];
                    acc += ql[8 * c] * bflo(w.x) + ql[8 * c + 1] * bfhi(w.x) + ql[8 * c + 2] * bflo(w.y) + ql[8 * c + 3] * bfhi(w.y) + ql[8 * c + 4] * bflo(w.z) + ql[8 * c + 5] * bfhi(w.z) + ql[8 * c + 6] * bflo(w.w) + ql[8 * c + 7] * bfhi(w.w); }
                d = acc + BT[(p * 16 + h) * 129 + j]; }
            s[i] = d;
        }
        float mx = s[0];
#pragma unroll
        for (int i = 1; i < 7; ++i) mx = fmaxf(mx, s[i]);
        mx = wave_max(mx);
        float sum = 0.f;
#pragma unroll
        for (int i = 0; i < 7; ++i) { const float pv = (pos[i] >= 0) ? expf(s[i] - mx) : 0.f; sum += pv; pl[lane + 64 * i] = pv; posl[lane + 64 * i] = pos[i]; }
        sum = wave_sum(sum);
        LDS_WAIT();
        float o = 0.f;
        for (int k = 0; k < 387; ++k) { const int pp = posl[k]; if (pp >= 0) o += pl[k] * bf2f(QKV[(size_t)pp * NQKV + 2048 + h * 64 + lane]); }
        ATT[(size_t)row * DM + h * 64 + lane] = (bf16)f2bf(o / sum);
        LDS_WAIT();
    }
}

DI void phase_vt(Frame& F) {
    const bf16* QKV = (const bf16*)(F.ws + WS_QKV); bf16* VT = (bf16*)(F.ws + WS_VT);
    LAS unsigned char* tl = F.lds;
    for (int u = F.bid; u < 512; u += F.G) {
        const int c = u & 15, h = (u >> 4) & 15, b = u >> 8, t0 = c * 512;
        __syncthreads();
        { const v4u* src = (const v4u*)(QKV + (size_t)(b * SEQ + t0 + F.tid) * NQKV + 2048 + h * 64);
#pragma unroll
          for (int j = 0; j < 8; ++j) { const v4u w = src[j]; LAS v2u* d = (LAS v2u*)(tl + F.tid * 136 + 16 * j); d[0] = (v2u){w.x, w.y}; d[1] = (v2u){w.z, w.w}; } }
        __syncthreads();
#pragma unroll
        for (int p = 0; p < 3; ++p) {
            const int dl = (p == 0) ? 1 : (p == 1 ? 4 : 16), ns = SEQ / dl, per = 512 / dl;
            bf16* dst = VT + (size_t)p * MTOK * DM;
            for (int q = F.tid; q < 4096; q += NTHR) {
                const int dim = q >> 6, pp = (q & 63) * 8, r = pp / per, ml = pp % per;
                unsigned short e[8];
#pragma unroll
                for (int k = 0; k < 8; ++k) e[k] = *(const LAS unsigned short*)(tl + (dl * (ml + k) + r) * 136 + dim * 2);
                v4u o; o.x = e[0] | ((unsigned)e[1] << 16); o.y = e[2] | ((unsigned)e[3] << 16); o.z = e[4] | ((unsigned)e[5] << 16); o.w = e[6] | ((unsigned)e[7] << 16);
                *(v4u*)(dst + ((size_t)((b * 16 + h) * 64 + dim)) * SEQ + r * ns + t0 / dl + ml) = o;
            }
        }
    }
}

typedef float f32x16 __attribute__((ext_vector_type(16)));
#define MFMA32(a, b, c) __builtin_amdgcn_mfma_f32_32x32x16_bf16((a), (b), (c), 0, 0, 0)
DI int kperm(int r) { return (r & ~12) | ((r & 4) << 1) | ((r & 8) >> 1); }
DI int osw(int tok, int chunk) { return tok * 256 + (((chunk ^ tok ^ (tok >> 4)) & 15) << 4); }
struct AttnKV { bf16x8 k[4]; bf16x8 v[2][2]; };
DI void attn_load(AttnKV& t, const bf16* kb, const bf16* vb, int mk0, int kp, int DL) {
    const bf16* kr = kb + (size_t)(DL * (mk0 + kp)) * NQKV;
#pragma unroll
    for (int s = 0; s < 4; ++s) t.k[s] = *(const bf16x8*)(kr + 8 * s);
#pragma unroll
    for (int dt = 0; dt < 2; ++dt)
#pragma unroll
        for (int s = 0; s < 2; ++s) t.v[dt][s] = *(const bf16x8*)(vb + mk0 + (size_t)dt * 32 * SEQ + 16 * s);
}
DI void attn_step(const AttnKV& t, const bf16x8 (&qf)[4], f32x16& o0, f32x16& o1, float& m, float& l, const LAS float* bl, int rel0, int hh) {
    f32x16 sa;
#pragma unroll
    for (int i = 0; i < 16; ++i) sa[i] = 0.f;
#pragma unroll
    for (int s = 0; s < 4; ++s) sa = MFMA32(t.k[s], qf[s], sa);
    float sc[16]; float tmax = -1e30f;
#pragma unroll
    for (int i = 0; i < 16; ++i) { const int rel = rel0 + 16 * (i >> 3) + (i & 7);
        const bool valid = (rel >= -64) && (rel <= 64); const int idx = valid ? rel + 64 : 0;
        const float v = sa[i] + bl[idx]; sc[i] = valid ? v : -1e30f; tmax = fmaxf(tmax, sc[i]); }
    tmax = fmaxf(tmax, __shfl_xor(tmax, 32));
    const float mnew = fmaxf(m, tmax), alpha = fexp(m - mnew);
    float ps = 0.f; float p[16];
#pragma unroll
    for (int i = 0; i < 16; ++i) { p[i] = (sc[i] > -1e29f) ? fexp(sc[i] - mnew) : 0.f; ps += p[i]; }
    l = l * alpha + ps; m = mnew;
#pragma unroll
    for (int i = 0; i < 16; ++i) { o0[i] *= alpha; o1[i] *= alpha; }
#pragma unroll
    for (int s = 0; s < 2; ++s) {
        v4u w; w.x = pk2(p[8 * s], p[8 * s + 1]); w.y = pk2(p[8 * s + 2], p[8 * s + 3]); w.z = pk2(p[8 * s + 4], p[8 * s + 5]); w.w = pk2(p[8 * s + 6], p[8 * s + 7]);
        const bf16x8 pf = __builtin_bit_cast(bf16x8, w);
        o0 = MFMA32(t.v[0][s], pf, o0); o1 = MFMA32(t.v[1][s], pf, o1);
    }
}
template <int P> DI void attn_stage(Frame& F, int b, int h, int t0) {
    constexpr int DL = (P == 0) ? 1 : (P == 1 ? 4 : 16), NS = SEQ / DL;
    const bf16* QKV = (const bf16*)(F.ws + WS_QKV); const bf16* VT = (const bf16*)(F.ws + WS_VT) + (size_t)P * MTOK * DM; bf16* ATT = (bf16*)(F.ws + WS_ATT);
    LAS unsigned char* ol = F.lds; LAS float* ml = (LAS float*)(F.lds + 131072); LAS float* ll = ml + 512; const LAS float* bl = (const LAS float*)(F.lds + 135168) + P * 132;
    const int lane = F.lane, r32 = lane & 31, hh = lane >> 5, w = F.wave, kp = kperm(r32);
#pragma unroll 1
    for (int task = 0; task < 2; ++task) {
        asm volatile("" ::: "memory");
        int r, i0;
        if (P == 0) { r = 0; i0 = 64 * w + 32 * task; } else if (P == 1) { r = w & 3; i0 = 64 * (w >> 2) + 32 * task; } else { r = 2 * w + task; i0 = 0; }
        const int mq0 = t0 / DL + i0, tql = r + DL * (i0 + r32);
        bf16x8 qf[4];
        { const bf16* qp = QKV + (size_t)(b * SEQ + t0 + tql) * NQKV + h * 64 + 32 * hh;
#pragma unroll
          for (int s = 0; s < 4; ++s) qf[s] = *(const bf16x8*)(qp + 8 * s); }
        f32x16 o0, o1; float m, l;
        if (P == 0) {
#pragma unroll
            for (int i = 0; i < 16; ++i) { o0[i] = 0.f; o1[i] = 0.f; }
            m = -1e30f; l = 0.f;
        } else {
#pragma unroll
            for (int g = 0; g < 4; ++g) { const f32x4 a = *(const LAS f32x4*)(ol + osw(tql, 2 * g + hh)), c = *(const LAS f32x4*)(ol + osw(tql, 8 + 2 * g + hh));
                o0[4 * g] = a.x; o0[4 * g + 1] = a.y; o0[4 * g + 2] = a.z; o0[4 * g + 3] = a.w; o1[4 * g] = c.x; o1[4 * g + 1] = c.y; o1[4 * g + 2] = c.z; o1[4 * g + 3] = c.w; }
            m = ml[tql]; l = hh ? 0.f : ll[tql];
        }
        const bf16* kb = QKV + (size_t)(b * SEQ + r) * NQKV + 1024 + h * 64 + 32 * hh;
        const bf16* vb = VT + ((size_t)((b * 16 + h) * 64 + r32)) * SEQ + r * NS + 8 * hh;
        int relb = 8 * hh - 64 - r32;
        asm volatile("" : "+v"(relb));
        AttnKV ta, tb;
#define ATT_OK(kt) ((mq0 - 64 + 32 * (kt)) >= 0 && (mq0 - 64 + 32 * (kt)) < NS)
        if (ATT_OK(0)) attn_load(ta, kb, vb, mq0 - 64, kp, DL);
        if (ATT_OK(1)) attn_load(tb, kb, vb, mq0 - 32, kp, DL);
        if (ATT_OK(0)) attn_step(ta, qf, o0, o1, m, l, bl, relb, hh);
        if (ATT_OK(2)) attn_load(ta, kb, vb, mq0, kp, DL);
        if (ATT_OK(1)) attn_step(tb, qf, o0, o1, m, l, bl, relb + 32, hh);
        if (ATT_OK(3)) attn_load(tb, kb, vb, mq0 + 32, kp, DL);
        if (ATT_OK(2)) attn_step(ta, qf, o0, o1, m, l, bl, relb + 64, hh);
        if (ATT_OK(4)) attn_load(ta, kb, vb, mq0 + 64, kp, DL);
        if (ATT_OK(3)) attn_step(tb, qf, o0, o1, m, l, bl, relb + 96, hh);
        if (ATT_OK(4)) attn_step(ta, qf, o0, o1, m, l, bl, relb + 128, hh);
#undef ATT_OK
        const float lt = l + __shfl_xor(l, 32);
        if (P < 2) {
#pragma unroll
            for (int g = 0; g < 4; ++g) { *(LAS f32x4*)(ol + osw(tql, 2 * g + hh)) = (f32x4){o0[4 * g], o0[4 * g + 1], o0[4 * g + 2], o0[4 * g + 3]};
                *(LAS f32x4*)(ol + osw(tql, 8 + 2 * g + hh)) = (f32x4){o1[4 * g], o1[4 * g + 1], o1[4 * g + 2], o1[4 * g + 3]}; }
            if (hh == 0) { ml[tql] = m; ll[tql] = lt; }
        } else {
            const float inv = 1.f / lt;
            bf16* op = ATT + (size_t)(b * SEQ + t0 + tql) * DM + h * 64 + 4 * hh;
#pragma unroll
            for (int g = 0; g < 4; ++g) { v2u a, c; a.x = pk2(o0[4 * g] * inv, o0[4 * g + 1] * inv); a.y = pk2(o0[4 * g + 2] * inv, o0[4 * g + 3] * inv);
                c.x = pk2(o1[4 * g] * inv, o1[4 * g + 1] * inv); c.y = pk2(o1[4 * g + 2] * inv, o1[4 * g + 3] * inv);
                *(v2u*)(op + 8 * g) = a; *(v2u*)(op + 32 + 8 * g) = c; }
        }
    }
}
DI void phase_attn(Frame& F) {
    const float* BT = (const float*)(F.ws + WS_BT);
    LAS float* bl = (LAS float*)(F.lds + 135168);
    for (int u = F.bid; u < 512; u += F.G) {
        const int c = u & 15, h = (u >> 4) & 15, b = u >> 8, t0 = c * 512;
        __syncthreads();
        for (int i = F.tid; i < 3 * 129; i += NTHR) bl[(i / 129) * 132 + i % 129] = BT[((i / 129) * 16 + h) * 129 + i % 129];
        __syncthreads();
        attn_stage<0>(F, b, h, t0);
        __syncthreads();
        attn_stage<1>(F, b, h, t0);
        __syncthreads();
        attn_stage<2>(F, b, h, t0);
    }
}

constexpr int GL_QT = 0, GL_KT = 17408, GL_QB = 34816, GL_KHT = 52224, GL_VT = 70656, GL_P = 89088, GL_ST = 98304, GL_DEC = 133120, GL_TOT = 133632;
struct GlaRaw { float lf[16]; unsigned short q[16]; unsigned short v[16]; };
DI int crow32(int j, int hh) { return (j & 3) + 8 * (j >> 2) + 4 * hh; }
template <bool FULL> DI void gla_load_raw(GlaRaw& R, const float* LF, const bf16* Q, const bf16* V, int b, int h, int dir, int pos0, int ch) {
#pragma unroll
    for (int i = 0; i < 16; ++i) { const int ii = pos0 + i; const int tok = dir ? (SEQ - 1 - ii) : ii; const size_t off = (size_t)(b * SEQ + tok) * AW + h * 128 + ch;
        R.lf[i] = LF[off]; R.v[i] = V[off]; if (FULL) R.q[i] = Q[off]; }
}
template <bool FULL> DI float gla_prep(Frame& F, const GlaRaw& R) {
    LAS unsigned char* L = F.lds; LAS float* tot = (LAS float*)(L + GL_TOT);
    const int ch = F.tid & 127, qtr = F.tid >> 7;
    float c[16]; float run = 0.f;
#pragma unroll
    for (int i = 0; i < 16; ++i) { run += R.lf[i]; c[i] = run; }
    tot[qtr * 128 + ch] = run;
    __syncthreads();
    const float t0 = tot[ch], t1 = tot[128 + ch], t2 = tot[256 + ch], t3 = tot[384 + ch];
    const float off = (qtr > 0 ? t0 : 0.f) + (qtr > 1 ? t1 : 0.f) + (qtr > 2 ? t2 : 0.f), rr = t0 + t1, bend = (t0 + t1) + (t2 + t3);
    unsigned kh[8], vv[8];
#pragma unroll
    for (int i = 0; i < 16; i += 2) {
        const float b0 = off + c[i], b1 = off + c[i + 1];
        const float k0 = 1.f - fexp(R.lf[i]), k1 = 1.f - fexp(R.lf[i + 1]);
        kh[i >> 1] = pk2(k0 * fexp(bend - b0), k1 * fexp(bend - b1));
        vv[i >> 1] = (unsigned)R.v[i] | ((unsigned)R.v[i + 1] << 16);
        if (FULL) {
            const float q0 = bf2f(R.q[i]), q1 = bf2f(R.q[i + 1]);
            const int ta = 16 * qtr + i;
            *(LAS unsigned short*)(L + GL_QT + ta * 272 + 2 * ch) = (unsigned short)f2bf(q0 * fexp(b0 - rr));
            *(LAS unsigned short*)(L + GL_QT + (ta + 1) * 272 + 2 * ch) = (unsigned short)f2bf(q1 * fexp(b1 - rr));
            *(LAS unsigned short*)(L + GL_KT + ta * 272 + 2 * ch) = (unsigned short)f2bf(k0 * fexp(rr - b0));
            *(LAS unsigned short*)(L + GL_KT + (ta + 1) * 272 + 2 * ch) = (unsigned short)f2bf(k1 * fexp(rr - b1));
            *(LAS unsigned short*)(L + GL_QB + ta * 272 + 2 * ch) = (unsigned short)f2bf(q0 * fexp(b0));
            *(LAS unsigned short*)(L + GL_QB + (ta + 1) * 272 + 2 * ch) = (unsigned short)f2bf(q1 * fexp(b1));
        }
    }
    *(LAS v4u*)(L + GL_KHT + ch * 144 + 32 * qtr) = (v4u){kh[0], kh[1], kh[2], kh[3]}; *(LAS v4u*)(L + GL_KHT + ch * 144 + 32 * qtr + 16) = (v4u){kh[4], kh[5], kh[6], kh[7]};
    *(LAS v4u*)(L + GL_VT + ch * 144 + 32 * qtr) = (v4u){vv[0], vv[1], vv[2], vv[3]}; *(LAS v4u*)(L + GL_VT + ch * 144 + 32 * qtr + 16) = (v4u){vv[4], vv[5], vv[6], vv[7]};
    if (qtr == 0) *(LAS float*)(L + GL_DEC + 4 * ch) = fexp(bend);
    return bend;
}
DI bf16x8 gfrag(const LAS unsigned char* base, int row, int stride, int kel) { return *(const LAS bf16x8*)(base + row * stride + kel * 2); }
DI void gla_state_update(Frame& F, f32x16 (&S)[2]) {
    const LAS unsigned char* L = F.lds; const int r32 = F.lane & 31, hh = F.lane >> 5, vi = F.wave & 3, ki0 = 2 * (F.wave >> 2);
    bf16x8 a[4];
#pragma unroll
    for (int s = 0; s < 4; ++s) a[s] = gfrag(L + GL_VT, 32 * vi + r32, 144, 16 * s + 8 * hh);
#pragma unroll
    for (int q = 0; q < 2; ++q) { const int kr = 32 * (ki0 + q) + r32; const float d = *(const LAS float*)(L + GL_DEC + 4 * kr);
#pragma unroll
        for (int j = 0; j < 16; ++j) S[q][j] *= d;
#pragma unroll
        for (int s = 0; s < 4; ++s) S[q] = MFMA32(a[s], gfrag(L + GL_KHT, kr, 144, 16 * s + 8 * hh), S[q]); }
}
DI void gla_state_to_lds(Frame& F, const f32x16 (&S)[2]) {
    LAS unsigned char* L = F.lds; const int r32 = F.lane & 31, hh = F.lane >> 5, vi = F.wave & 3, ki0 = 2 * (F.wave >> 2);
#pragma unroll
    for (int q = 0; q < 2; ++q)
#pragma unroll
        for (int j = 0; j < 16; ++j) *(LAS unsigned short*)(L + GL_ST + (32 * vi + crow32(j, hh)) * 272 + 2 * (32 * (ki0 + q) + r32)) = (unsigned short)f2bf(S[q][j]);
}
DI void gla_unit_state(Frame& F, int u) {
    const int sc = u & 31, dir = (u >> 5) & 1, h = (u >> 6) & 3, b = u >> 8;
    const bf16* Q = (const bf16*)(F.ws + WS_Q); const bf16* V = (const bf16*)(F.ws + WS_V); const float* LF = (const float*)(F.ws + (dir ? WS_LFB : WS_LFF));
    float* ST = (float*)(F.ws + WS_ST) + (size_t)u * 16384; float* DEC = (float*)(F.ws + WS_DEC) + u * 128;
    const int ch = F.tid & 127, qtr = F.tid >> 7, r32 = F.lane & 31, hh = F.lane >> 5, vi = F.wave & 3, ki0 = 2 * (F.wave >> 2);
    f32x16 S[2];
#pragma unroll
    for (int j = 0; j < 16; ++j) { S[0][j] = 0.f; S[1][j] = 0.f; }
    float lsum = 0.f;
    GlaRaw cur, nxt;
    gla_load_raw<false>(cur, LF, Q, V, b, h, dir, sc * 256 + 16 * qtr, ch);
#pragma unroll 1
    for (int c = 0; c < 4; ++c) {
        __syncthreads();
        lsum += gla_prep<false>(F, cur);
        if (c < 3) gla_load_raw<false>(nxt, LF, Q, V, b, h, dir, sc * 256 + (c + 1) * 64 + 16 * qtr, ch);
        __syncthreads();
        gla_state_update(F, S);
        cur = nxt;
    }
#pragma unroll
    for (int q = 0; q < 2; ++q)
#pragma unroll
        for (int g = 0; g < 4; ++g) *(f32x4*)(ST + (size_t)(32 * (ki0 + q) + r32) * 128 + 32 * vi + 8 * g + 4 * hh) = (f32x4){S[q][4 * g], S[q][4 * g + 1], S[q][4 * g + 2], S[q][4 * g + 3]};
    if (qtr == 0) DEC[ch] = fexp(lsum);
}
DI void gla_unit_out(Frame& F, int u) {
    const int sc = u & 31, dir = (u >> 5) & 1, h = (u >> 6) & 3, b = u >> 8;
    const bf16* Q = (const bf16*)(F.ws + WS_Q); const bf16* V = (const bf16*)(F.ws + WS_V); const float* LF = (const float*)(F.ws + (dir ? WS_LFB : WS_LFF));
    const float* ST = (const float*)(F.ws + WS_ST) + (size_t)u * 16384; float* OD = (float*)(F.ws + WS_ODIR) + (size_t)dir * MTOK * AW;
    const LAS unsigned char* L = F.lds;
    const int ch = F.tid & 127, qtr = F.tid >> 7, r32 = F.lane & 31, hh = F.lane >> 5, w = F.wave, vi = w & 3, ki0 = 2 * (w >> 2), ti = w >> 2;
    f32x16 S[2];
#pragma unroll
    for (int q = 0; q < 2; ++q)
#pragma unroll
        for (int g = 0; g < 4; ++g) { const f32x4 t = *(const f32x4*)(ST + (size_t)(32 * (ki0 + q) + r32) * 128 + 32 * vi + 8 * g + 4 * hh); S[q][4 * g] = t.x; S[q][4 * g + 1] = t.y; S[q][4 * g + 2] = t.z; S[q][4 * g + 3] = t.w; }
    GlaRaw cur, nxt;
    gla_load_raw<true>(cur, LF, Q, V, b, h, dir, sc * 256 + 16 * qtr, ch);
    __syncthreads();
    gla_state_to_lds(F, S);
#pragma unroll 1
    for (int c = 0; c < 4; ++c) {
        (void)gla_prep<true>(F, cur);
        if (c < 3) gla_load_raw<true>(nxt, LF, Q, V, b, h, dir, sc * 256 + (c + 1) * 64 + 16 * qtr, ch);
        __syncthreads();
        f32x16 o;
#pragma unroll
        for (int j = 0; j < 16; ++j) o[j] = 0.f;
#pragma unroll
        for (int s = 0; s < 8; ++s) o = MFMA32(gfrag(L + GL_QB, 32 * ti + r32, 272, 16 * s + 8 * hh), gfrag(L + GL_ST, 32 * vi + r32, 272, 16 * s + 8 * hh), o);
        if (w < 3) {
            const int tp = (w + 1) >> 1, sp = (w == 2) ? 1 : 0;
            f32x16 p;
#pragma unroll
            for (int j = 0; j < 16; ++j) p[j] = 0.f;
#pragma unroll
            for (int s = 0; s < 8; ++s) p = MFMA32(gfrag(L + GL_QT, 32 * tp + r32, 272, 16 * s + 8 * hh), gfrag(L + GL_KT, 32 * sp + r32, 272, 16 * s + 8 * hh), p);
#pragma unroll
            for (int j = 0; j < 16; ++j) { const int t = 32 * tp + crow32(j, hh), s = 32 * sp + r32;
                *(LAS unsigned short*)(F.lds + GL_P + t * 144 + 2 * s) = (s <= t) ? (unsigned short)f2bf(p[j]) : (unsigned short)0; }
        }
        __syncthreads();
        { const int ns = ti ? 4 : 2;
#pragma unroll
          for (int s = 0; s < 4; ++s) if (s < ns) o = MFMA32(gfrag(L + GL_P, 32 * ti + r32, 144, 16 * s + 8 * hh), gfrag(L + GL_VT, 32 * vi + r32, 144, 16 * s + 8 * hh), o); }
#pragma unroll
        for (int j = 0; j < 16; ++j) { const int ii = sc * 256 + c * 64 + 32 * ti + crow32(j, hh); const int tok = dir ? (SEQ - 1 - ii) : ii;
            OD[(size_t)(b * SEQ + tok) * AW + h * 128 + 32 * vi + r32] = o[j]; }
        if (c < 3) { gla_state_update(F, S); gla_state_to_lds(F, S); }
        cur = nxt;
        __syncthreads();
    }
}

__global__ void __launch_bounds__(NTHR, 2) fwd_kernel(Args args) {
    extern __shared__ __attribute__((aligned(16))) unsigned char lds[];
    Frame F;
    F.lds = (LAS unsigned char*)lds;
    F.MISC = (volatile LAS unsigned*)(F.lds + MISC_OFF);
    F.tid = threadIdx.x; F.lane = F.tid & 63; F.wave = __builtin_amdgcn_readfirstlane(F.tid >> 6);
    F.G = gridDim.x; F.bid = blockIdx.x; F.gw = F.bid * NWAVES + F.wave; F.NGW = F.G * NWAVES;
    F.ws = args.ws;
    unsigned* ctl = (unsigned*)(args.ws + WS_CTL);
    for (int u = F.tid; u < (LDS_BYTES - LDSCTL_OFF) / 4; u += NTHR) ((LAS unsigned*)(F.lds + LDSCTL_OFF))[u] = 0u;
    __syncthreads();
    const int lo = args.ph_lo, hi = args.ph_hi;
    XcdBarrier bar; bar.bar = ctl + CW_BAR + args.li * XCD_BAR_WORDS; bar.x = 0; bar.st = nullptr;
    if (hi - lo > 1) bar = xcd_barrier_post(ctl + CW_BAR + args.li * XCD_BAR_WORDS, F.MISC + 8);
#define IN(k) (lo <= (k) && (k) < hi)
#define SEAM(k) do { if (IN(k) && IN((k) + 1)) xcd_barrier(bar); } while (0)
    unsigned char* ws = args.ws;
    float* XR = args.out;

    if (IN(0)) { phase_prologue(F, args); } SEAM(0);
    if (IN(1)) {
        pg8::Gemm g{(const bf16*)(ws + WS_H), (const bf16*)(ws + WS_WIN), MTOK, NIN, DM}; pg8::StaticOrder S; S.init(MTOK, NIN, F.G, F.bid);
        EpiInProj E{(bf16*)(ws + WS_U), (bf16*)(ws + WS_GV), (bf16*)(ws + WS_Q), (bf16*)(ws + WS_V), (bf16*)(ws + WS_G), (float*)(ws + WS_LFF), (float*)(ws + WS_LFB), (const float*)(ws + WS_LB)};
        pg8::gemm_phase<EpiInProj, pg8::StaticOrder, true, true>(F.lds, g, S, E);
    } SEAM(1);
    if (IN(2)) { phase_a_ln(F, args); for (int u = F.bid; u < 512; u += F.G) gla_unit_state(F, u); } SEAM(2);
    if (IN(3)) { phase_gla_scan(F); phase_a_mix_naive(F, args); } SEAM(3);
    if (IN(4)) { for (int u = F.bid; u < 512; u += F.G) gla_unit_out(F, u); } SEAM(4);
    if (IN(5)) { phase_b_combine(F, args); } SEAM(5);
    if (IN(6)) {
        pg8::Gemm g{(const bf16*)(ws + WS_CAT), (const bf16*)(ws + WS_WOUT), MTOK, DM, DM}; pg8::StaticOrder S; S.init(MTOK, DM, F.G, F.bid);
        EpiResid E{args.in[0], XR};
        pg8::gemm_phase<EpiResid, pg8::StaticOrder, false, true>(F.lds, g, S, E);
    } SEAM(6);
#define MOE_BLOCK(L, pb) do { \
        if (IN(pb)) { phase_router(F, XR, args.in[2] + (L) * DM, args.in[15] + (L) * DM * NEXP); } SEAM(pb); \
        if (IN((pb) + 1)) { phase_topk(F); } SEAM((pb) + 1); \
        if (IN((pb) + 2)) { phase_gather(F); } SEAM((pb) + 2); \
        if (IN((pb) + 3)) { \
            pg8::Gemm g{(const bf16*)(ws + WS_XE), (const bf16*)(ws + WS_WGU), NROWS, 16 * 2048, DM}; GroupedOrder<8> S{F.G, F.bid}; \
            EpiGateUp E{(bf16*)(ws + WS_HMID)}; \
            pg8::gemm_phase<EpiGateUp, GroupedOrder<8>, true, true>(F.lds, g, S, E); \
        } SEAM((pb) + 3); \
        if (IN((pb) + 4)) { \
            pg8::Gemm g{(const bf16*)(ws + WS_HMID), (const bf16*)(ws + WS_WDN), NROWS, 16 * 1024, DFF}; GroupedOrder<4> S{F.G, F.bid}; \
            EpiDown E{(bf16*)(ws + WS_Y), (const float*)(ws + WS_GATE)}; \
            pg8::gemm_phase<EpiDown, GroupedOrder<4>, true, true>(F.lds, g, S, E); \
        } SEAM((pb) + 4); \
    } while (0)

    MOE_BLOCK(0, 7);
    if (IN(12)) { phase_moe_combine(F, XR, args.in[1] + DM, false); convert_moe_weights(F, args.in[16], args.in[17], args.in[18], 1); } SEAM(12);
    if (IN(13)) {
        pg8::Gemm g{(const bf16*)(ws + WS_H), (const bf16*)(ws + WS_WQKV), MTOK, NQKV, DM}; pg8::StaticOrder S; S.init(MTOK, NQKV, F.G, F.bid);
        EpiQKV E{(bf16*)(ws + WS_QKV)};
        pg8::gemm_phase<EpiQKV, pg8::StaticOrder, true, true>(F.lds, g, S, E);
    } SEAM(13);
    if (IN(14)) { phase_vt(F); } SEAM(14);
    if (IN(15)) { phase_attn(F); } SEAM(15);
    if (IN(16)) {
        pg8::Gemm g{(const bf16*)(ws + WS_ATT), (const bf16*)(ws + WS_WO), MTOK, DM, DM}; pg8::StaticOrder S; S.init(MTOK, DM, F.G, F.bid);
        EpiResid E{XR, XR};
        pg8::gemm_phase<EpiResid, pg8::StaticOrder, false, true>(F.lds, g, S, E);
    } SEAM(16);
    MOE_BLOCK(1, 17);
    if (IN(22)) { phase_moe_combine(F, XR, args.in[3], true); }
#undef MOE_BLOCK
#undef IN
#undef SEAM
}

#ifndef MK_N_LAUNCHES
#define MK_N_LAUNCHES 1
#endif
extern "C" void kernel_launch(void* const* d_in, const int* in_sizes, int n_in, void* d_out, int out_size, void* d_ws, size_t ws_size, hipStream_t stream) {
    static int grid = 0;
    if (grid == 0) {
        if (n_in != 19 || in_sizes[0] != MTOK * DM || out_size != MTOK * DM || ws_size < WS_END) { fprintf(stderr, "kernel_launch: unexpected shapes (n_in %d, in0 %d, out %d, ws %zu < %zu); nothing launched\n", n_in, n_in > 0 ? in_sizes[0] : -1, out_size, ws_size, (size_t)WS_END); grid = -1; return; }
        int dev = 0, cus = 0, per_cu = 0;
        if (hipGetDevice(&dev) != hipSuccess || hipDeviceGetAttribute(&cus, hipDeviceAttributeMultiprocessorCount, dev) != hipSuccess) { grid = -1; return; }
        if (hipFuncSetAttribute((const void*)fwd_kernel, hipFuncAttributeMaxDynamicSharedMemorySize, LDS_BYTES) != hipSuccess) { fprintf(stderr, "kernel_launch: hipFuncSetAttribute failed\n"); grid = -1; return; }
        if (hipOccupancyMaxActiveBlocksPerMultiprocessor(&per_cu, (const void*)fwd_kernel, NTHR, LDS_BYTES) != hipSuccess || per_cu < 1) { fprintf(stderr, "kernel_launch: occupancy query reports %d workgroups per CU\n", per_cu); }
        (void)hipGetLastError();
        grid = cus;
    }
    if (grid < 0) return;
    if (hipMemsetAsync((char*)d_ws + WS_CTL, 0, CTL_ZERO_BYTES, stream) != hipSuccess) return;
    Args a{};
    for (int i = 0; i < 19; ++i) a.in[i] = (const float*)d_in[i];
    a.out = (float*)d_out; a.ws = (unsigned char*)d_ws; a.pad = 0;
    static_assert(CW_BAR + MAX_BAR_REGIONS * XCD_BAR_WORDS <= (int)(CTL_ZERO_BYTES / 4), "barrier regions inside the memset region");
    const int nl = MK_N_LAUNCHES;
    for (int li = 0; li < nl; ++li) {
        a.ph_lo = (int)((long)NPHASE * li / nl); a.ph_hi = (int)((long)NPHASE * (li + 1) / nl); a.li = li;
        hipLaunchKernelGGL(fwd_kernel, dim3(grid), dim3(NTHR), LDS_BYTES, stream, a);
        const hipError_t le = hipPeekAtLastError();
        if (le != hipSuccess) { fprintf(stderr, "kernel_launch: launch %d failed: %s\n", li, hipGetErrorName(le)); break; }
    }
}
```

```cpp
#include <hip/hip_runtime.h>
#include <cstdio>
#include <cstdint>
namespace pg8 {
#define PG8_LAS __attribute__((address_space(3)))
typedef unsigned short bf16_t;
typedef short bf16x8 __attribute__((ext_vector_type(8)));
typedef float f32x4 __attribute__((ext_vector_type(4)));
typedef unsigned u32x4 __attribute__((ext_vector_type(4)));
constexpr int BM = 256, BK = 64, HALF = 128, HTB = HALF * BK * 2  , STAGE_BYTES = 8 * HTB, NXCD = 8, WGM = 8;

__host__ __device__ __forceinline__ int lds_byte(int r, int c) { const int st = (r >> 4) * 2 + (c >> 5), rr = r & 15, cc = c & 31, ob = rr * 64 + cc * 2; return st * 1024 + (ob ^ (((ob >> 9) & 1) << 5)); }
__host__ __device__ __forceinline__ void stage_rc(int b, int& R, int& C) { const int st = b / 1024, sb = b % 1024, swz = sb ^ (((sb >> 9) & 1) << 5); R = (st >> 1) * 16 + swz / 64; C = (st & 1) * 32 + (swz % 64) / 2; }
__host__ __device__ __forceinline__ int perm32(int rho) { const int n = rho >> 4, i = rho & 15; return 8 * (i >> 2) + 4 * n + (i & 3); }

struct Unit { int pm, pn; };
struct Gemm { const bf16_t* A; const bf16_t* Bt; int M, N, K; };

struct StaticOrder {
    int nM, nN, nwg, G, c;
    __host__ __device__ void init(int M, int N, int G_, int c_) { nM = M / BM; nN = N / BM; nwg = nM * nN; G = G_; c = c_; }
    __host__ __device__ bool next(int i, Unit& u) const {
        const long L = (long)i * G + c; if (L >= nwg) return false;
        int wgid = (int)L; { const int q = nwg / NXCD, r = nwg % NXCD, xcd = wgid % NXCD, off = wgid / NXCD; wgid = (xcd < r ? xcd * (q + 1) : r * (q + 1) + (xcd - r) * q) + off; }
        const int nig = WGM * nN, gid = wgid / nig, fm = gid * WGM, gsz = (nM - fm) < WGM ? (nM - fm) : WGM;
        u.pm = fm + ((wgid % nig) % gsz); u.pn = (wgid % nig) / gsz; return true;
    }
    __device__ __forceinline__ void a_ready(const Unit&) const {}
    __device__ __forceinline__ void done(const Unit&) const {}
};

__device__ __forceinline__ unsigned cvt_pk_bf16(float lo, float hi) { unsigned r; asm volatile("v_cvt_pk_bf16_f32 %0, %1, %2" : "=v"(r) : "v"(lo), "v"(hi)); return r; }
typedef float f32x2 __attribute__((ext_vector_type(2)));
__device__ __forceinline__ f32x2 gelu_pk(f32x2 v) {
    const f32x2 av = __builtin_elementwise_abs(v), d = av * 0.2316418882f + 1.0f;
    f32x2 t; t.x = __builtin_amdgcn_rcpf(d.x); t.y = __builtin_amdgcn_rcpf(d.y);
    f32x2 q = t * 0.5307027145f + (-0.7265760135f); q = q * t + 0.7107068705f; q = q * t + (-0.142248368f); q = q * t + 0.127414796f; q = q * t;
    const f32x2 s = (v * v) * (-0.72134752044f);
    f32x2 e; e.x = __builtin_amdgcn_exp2f(s.x); e.y = __builtin_amdgcn_exp2f(s.y);
    const f32x2 m = v * (q * e), r = v - m;
    f32x2 o; o.x = v.x < 0.f ? m.x : r.x; o.y = v.y < 0.f ? m.y : r.y; return o;
}

template <int ACT  > struct EpiBf16 {
    static constexpr bool PERM = true, AFTER_DRAIN = false; static_assert(ACT == 0 || ACT == 1, "EpiBf16: ACT is 0 (none) or 1 (gelu_pk)");
    bf16_t* O; int ldc; const float* bias; int split_cols; size_t split_stride; float scale0;
    __device__ __forceinline__ void operator()(const f32x4 (&acc)[2][2][4][2], const Unit& u, int wr, int wc, int fr, int fq) const {
        const int row0 = u.pm * BM + wr * 64 + fr; int colt = u.pn * BM; bf16_t* base = O;
        float sc = 1.f; if (split_cols) { const int t = colt / split_cols; base += (size_t)t * split_stride; colt -= t * split_cols; if (t == 0) sc = scale0; }
        const int col0 = colt + wc * 32 + 8 * fq, bcol0 = u.pn * BM + wc * 32 + 8 * fq;
        f32x4 bv[2][2];
#pragma unroll
        for (int bj = 0; bj < 2; ++bj)
#pragma unroll
            for (int n = 0; n < 2; ++n) bv[bj][n] = bias ? *(const f32x4*)(bias + bcol0 + bj * HALF + 4 * n) : (f32x4){0.f, 0.f, 0.f, 0.f};
#pragma unroll
        for (int ai = 0; ai < 2; ++ai)
#pragma unroll
            for (int m = 0; m < 4; ++m) { bf16_t* rowp = base + (size_t)(row0 + ai * HALF + m * 16) * ldc + col0;
#pragma unroll
                for (int bj = 0; bj < 2; ++bj) { f32x4 v0 = acc[ai][bj][m][0] + bv[bj][0], v1 = acc[ai][bj][m][1] + bv[bj][1];
                    if (ACT == 1) { f32x2 a = gelu_pk((f32x2){v0[0], v0[1]}), b = gelu_pk((f32x2){v0[2], v0[3]}), c = gelu_pk((f32x2){v1[0], v1[1]}), d = gelu_pk((f32x2){v1[2], v1[3]});
                        v0 = (f32x4){a.x, a.y, b.x, b.y}; v1 = (f32x4){c.x, c.y, d.x, d.y}; }
                    v0 = v0 * sc; v1 = v1 * sc; u32x4 w; w.x = cvt_pk_bf16(v0[0], v0[1]); w.y = cvt_pk_bf16(v0[2], v0[3]); w.z = cvt_pk_bf16(v1[0], v1[1]); w.w = cvt_pk_bf16(v1[2], v1[3]);
                    *(u32x4*)(rowp + bj * HALF) = w; } }
    }
};
template <class Epi, class Sched, bool ALIGN_EPI = false, bool SP2 = false>
__device__ __forceinline__ void gemm_phase(PG8_LAS unsigned char* lds, const Gemm g, const Sched& S, const Epi& E) {
    const int tid = threadIdx.x, wid = __builtin_amdgcn_readfirstlane(tid >> 6), lane = tid & 63, wr = wid >> 2, wc = wid & 3, fr = lane & 15, fq = lane >> 4;
    const int K = g.K, nt = K / BK;
    unsigned voffA[2], voffB[2];
#pragma unroll
    for (int i = 0; i < 2; ++i) { int R, C; stage_rc(tid * 16 + i * 8192, R, C); const int Rb = Epi::PERM ? ((R & ~31) + perm32(R & 31)) : R;
        voffA[i] = (unsigned)(R * K + C) * 2u; voffB[i] = (unsigned)(Rb * K + C) * 2u; }
    const size_t kstep = (size_t)(BK * 2);
    const size_t hstep = (size_t)HALF * K * 2;
    const size_t tstep = 2 * hstep;
    const unsigned ldsw = (unsigned)wid * 1024u;
    const int aoff = lds_byte(wr * 64 + fr, fq * 8), boff = lds_byte(wc * 32 + fr, fq * 8);
#define PG8_SA(b, h) (((b) * 2 + (h)) * HTB)
#define PG8_SB(b, h) ((4 + (b) * 2 + (h)) * HTB)
#define PG8_STAGE(bufoff, gbase, voff) do { _Pragma("unroll") for (int _i = 0; _i < 2; ++_i) \
        __builtin_amdgcn_global_load_lds((const unsigned*)((const char*)(gbase) + (voff)[_i]), (PG8_LAS unsigned*)(lds + (bufoff) + ldsw + _i * 8192), 16, 0, 0); } while (0)
#define PG8_LDA(dst, b, h) do { _Pragma("unroll") for (int m = 0; m < 4; ++m) _Pragma("unroll") for (int k = 0; k < 2; ++k) dst[m][k] = *(const PG8_LAS bf16x8*)(lds + PG8_SA(b, h) + aoff + m * 2048 + k * 1024); } while (0)
#define PG8_LDB(dst, b, h) do { _Pragma("unroll") for (int n = 0; n < 2; ++n) _Pragma("unroll") for (int k = 0; k < 2; ++k) dst[n][k] = *(const PG8_LAS bf16x8*)(lds + PG8_SB(b, h) + boff + n * 2048 + k * 1024); } while (0)
#define PG8_MMA(ai, bj, At, Bt) do { __builtin_amdgcn_s_setprio(1); _Pragma("unroll") for (int m = 0; m < 4; ++m) _Pragma("unroll") for (int n = 0; n < 2; ++n) _Pragma("unroll") for (int k = 0; k < 2; ++k) \
        acc[ai][bj][m][n] = __builtin_amdgcn_mfma_f32_16x16x32_bf16(Bt[n][k], At[m][k], acc[ai][bj][m][n], 0, 0, 0); __builtin_amdgcn_s_setprio(0); } while (0)
#define PG8_WAIT_V(n) asm volatile("s_waitcnt vmcnt(" #n ")" ::: "memory")
#define PG8_WAIT_L(n) asm volatile("s_waitcnt lgkmcnt(" #n ")" ::: "memory")
#define PG8_BAR __builtin_amdgcn_s_barrier()
#define PG8_SCHED __builtin_amdgcn_sched_barrier(0)
    Unit cur, nxt; int ui = 0;
    if (!S.next(0, cur)) return;
    f32x4 acc[2][2][4][2];
#pragma unroll
    for (int a = 0; a < 2; ++a)
#pragma unroll
        for (int b = 0; b < 2; ++b)
#pragma unroll
            for (int m = 0; m < 4; ++m)
#pragma unroll
                for (int n = 0; n < 2; ++n) acc[a][b][m][n] = (f32x4){0.f, 0.f, 0.f, 0.f};
    bf16x8 At[4][2], B0[2][2], B1[2][2];
    const char* cA = (const char*)g.A + (size_t)cur.pm * tstep; const char* cB = (const char*)g.Bt + (size_t)cur.pn * tstep;
    S.a_ready(cur);
    if constexpr (SP2) {
        PG8_STAGE(PG8_SB(0, 0), cB, voffB); PG8_STAGE(PG8_SB(0, 1), cB + hstep, voffB); PG8_STAGE(PG8_SA(0, 0), cA, voffA); PG8_STAGE(PG8_SA(0, 1), cA + hstep, voffA);
        if (wr == 1) PG8_BAR;
        PG8_WAIT_V(2); PG8_BAR;
        PG8_STAGE(PG8_SB(1, 0), cB + kstep, voffB); PG8_STAGE(PG8_SA(1, 0), cA + kstep, voffA); PG8_STAGE(PG8_SB(1, 1), cB + hstep + kstep, voffB);
        PG8_WAIT_V(6); PG8_BAR;
    } else {
        PG8_STAGE(PG8_SB(0, 0), cB, voffB); PG8_STAGE(PG8_SA(0, 0), cA, voffA); PG8_STAGE(PG8_SB(0, 1), cB + hstep, voffB); PG8_STAGE(PG8_SA(0, 1), cA + hstep, voffA);
        if (wr == 1) PG8_BAR;
        PG8_WAIT_V(4); PG8_BAR;
        PG8_STAGE(PG8_SB(1, 0), cB + kstep, voffB); PG8_STAGE(PG8_SA(1, 0), cA + kstep, voffA); PG8_STAGE(PG8_SB(1, 1), cB + hstep + kstep, voffB);
        PG8_WAIT_V(6); PG8_BAR;
    }
    for (;;) {
        const bool has_next = S.next(ui + 1, nxt);
        const char* nA = has_next ? (const char*)g.A + (size_t)nxt.pm * tstep : cA; const char* nB = has_next ? (const char*)g.Bt + (size_t)nxt.pn * tstep : cB;
        for (int t = 0; t < nt; t += 2) {
            const bool last = (t == nt - 2);
            const char* a1 = cA + (size_t)(t + 1) * kstep;
            const char* a2 = last ? nA : cA + (size_t)(t + 2) * kstep; const char* b2 = last ? nB : cB + (size_t)(t + 2) * kstep;
            const char* a3 = a2 + kstep; const char* b3 = b2 + kstep;
            if (last && has_next) S.a_ready(nxt);
            if constexpr (SP2) {
            PG8_LDB(B0, 0, 0); PG8_LDB(B1, 0, 1); PG8_SCHED; PG8_LDA(At, 0, 0); PG8_STAGE(PG8_SA(1, 1), a1 + hstep, voffA);
            PG8_WAIT_V(8); PG8_WAIT_L(0); PG8_BAR; PG8_MMA(0, 0, At, B0); PG8_MMA(0, 1, At, B1); PG8_BAR; PG8_SCHED;
            PG8_LDA(At, 0, 1); PG8_STAGE(PG8_SB(0, 0), b2, voffB); PG8_STAGE(PG8_SB(0, 1), b2 + hstep, voffB); PG8_STAGE(PG8_SA(0, 0), a2, voffA);
            PG8_WAIT_V(8); PG8_WAIT_L(0); PG8_BAR; PG8_MMA(1, 0, At, B0); PG8_MMA(1, 1, At, B1); PG8_BAR; PG8_SCHED;
            PG8_LDB(B0, 1, 0); PG8_LDB(B1, 1, 1); PG8_SCHED; PG8_LDA(At, 1, 0); PG8_STAGE(PG8_SA(0, 1), a2 + hstep, voffA);
            PG8_WAIT_V(8); PG8_WAIT_L(0); PG8_BAR; PG8_MMA(0, 0, At, B0); PG8_MMA(0, 1, At, B1); PG8_BAR; PG8_SCHED;
            PG8_LDA(At, 1, 1); PG8_STAGE(PG8_SB(1, 0), b3, voffB); PG8_STAGE(PG8_SB(1, 1), b3 + hstep, voffB); PG8_STAGE(PG8_SA(1, 0), a3, voffA);
            PG8_WAIT_V(8); PG8_WAIT_L(0); PG8_BAR; PG8_MMA(1, 0, At, B0); PG8_MMA(1, 1, At, B1); PG8_BAR; PG8_SCHED;
            } else {
            PG8_LDB(B0, 0, 0); PG8_SCHED; PG8_LDA(At, 0, 0); PG8_STAGE(PG8_SA(1, 1), a1 + hstep, voffA);
            PG8_WAIT_L(8); PG8_BAR; PG8_WAIT_L(0); PG8_MMA(0, 0, At, B0); PG8_BAR; PG8_SCHED;
            PG8_LDB(B1, 0, 1); PG8_STAGE(PG8_SB(0, 0), b2, voffB);
            PG8_BAR; PG8_WAIT_L(0); PG8_MMA(0, 1, At, B1); PG8_BAR;
            PG8_LDA(At, 0, 1); PG8_STAGE(PG8_SA(0, 0), a2, voffA);
            PG8_BAR; PG8_WAIT_L(0); PG8_MMA(1, 0, At, B0); PG8_BAR; PG8_SCHED;
            PG8_STAGE(PG8_SB(0, 1), b2 + hstep, voffB);
            PG8_WAIT_V(6); PG8_BAR; PG8_MMA(1, 1, At, B1); PG8_BAR;
            PG8_LDB(B0, 1, 0); PG8_SCHED; PG8_LDA(At, 1, 0); PG8_STAGE(PG8_SA(0, 1), a2 + hstep, voffA);
            PG8_WAIT_L(8); PG8_BAR; PG8_WAIT_L(0); PG8_MMA(0, 0, At, B0); PG8_BAR; PG8_SCHED;
            PG8_LDB(B1, 1, 1); PG8_STAGE(PG8_SB(1, 0), b3, voffB);
            PG8_BAR; PG8_WAIT_L(0); PG8_MMA(0, 1, At, B1); PG8_BAR;
            PG8_LDA(At, 1, 1); PG8_STAGE(PG8_SA(1, 0), a3, voffA);
            PG8_BAR; PG8_WAIT_L(0); PG8_MMA(1, 0, At, B0); PG8_BAR; PG8_SCHED;
            PG8_STAGE(PG8_SB(1, 1), b3 + hstep, voffB);
            PG8_WAIT_V(6); PG8_BAR; PG8_MMA(1, 1, At, B1); PG8_BAR;
            }
        }
        if constexpr (ALIGN_EPI) { if (wr == 0) PG8_BAR; }
        if constexpr (!Epi::AFTER_DRAIN) { E(acc, cur, wr, wc, fr, fq); S.done(cur); }
        if (!has_next) break;
#pragma unroll
        for (int a = 0; a < 2; ++a)
#pragma unroll
            for (int b = 0; b < 2; ++b)
#pragma unroll
                for (int m = 0; m < 4; ++m)
#pragma unroll
                    for (int n = 0; n < 2; ++n) acc[a][b][m][n] = (f32x4){0.f, 0.f, 0.f, 0.f};
        cur = nxt; cA = nA; cB = nB; ++ui;
        if constexpr (ALIGN_EPI) { if (wr == 1) PG8_BAR; }
    }
    PG8_WAIT_V(0);
    if constexpr (!ALIGN_EPI) { if (wr == 0) PG8_BAR; }
    PG8_BAR;
    if constexpr (Epi::AFTER_DRAIN) { E.fused(acc, cur, wr, wc, fr, fq, lds, wid, lane); S.done(cur); }
#undef PG8_SA
#undef PG8_SB
#undef PG8_STAGE
#undef PG8_LDA
#undef PG8_LDB
#undef PG8_MMA
#undef PG8_WAIT_V
#undef PG8_WAIT_L
#undef PG8_BAR
#undef PG8_SCHED
}
}
#define LAS __attribute__((address_space(3)))
#define DI __device__ __forceinline__
typedef unsigned short bf16;
typedef unsigned v4u __attribute__((ext_vector_type(4)));
typedef unsigned v2u __attribute__((ext_vector_type(2)));
typedef float f32x4 __attribute__((ext_vector_type(4)));
typedef short bf16x8 __attribute__((ext_vector_type(8)));
#define LDS_WAIT() asm volatile("s_waitcnt lgkmcnt(0)" ::: "memory")
#define VM_WAIT() asm volatile("s_waitcnt vmcnt(0)" ::: "memory")
DI unsigned f2bf(float f) { unsigned u = __builtin_bit_cast(unsigned, f); return (u + 0x7fffu + ((u >> 16) & 1u)) >> 16; }
typedef float f32x2_t __attribute__((ext_vector_type(2))); typedef __bf16 bf16x2_t __attribute__((ext_vector_type(2)));
DI unsigned pk2(float lo, float hi) { f32x2_t v = {lo, hi}; bf16x2_t b = __builtin_convertvector(v, bf16x2_t); return __builtin_bit_cast(unsigned, b); }
DI float bf2f(unsigned b) { return __builtin_bit_cast(float, b << 16); }
DI float bflo(unsigned w) { return __builtin_bit_cast(float, w << 16); }
DI float bfhi(unsigned w) { return __builtin_bit_cast(float, w & 0xffff0000u); }
DI float fexp(float x) { return __builtin_amdgcn_exp2f(x * 1.4426950408889634f); }
DI float flog(float x) { return __builtin_amdgcn_logf(x) * 0.6931471805599453f; }
DI float frcp(float x) { return __builtin_amdgcn_rcpf(x); }
DI float sigmoidf_(float x) { return frcp(1.f + fexp(-x)); }
DI float siluf_(float x) { return x * sigmoidf_(x); }
DI float gelu_tanh(float x) { const float u = 0.7978845608028654f * (x + 0.044715f * x * x * x); return x * sigmoidf_(2.f * u); }
DI float wave_sum(float v) {
#pragma unroll
    for (int o = 1; o < 64; o <<= 1) v += __shfl_xor(v, o);
    return v;
}
DI float wave_max(float v) {
#pragma unroll
    for (int o = 1; o < 64; o <<= 1) v = fmaxf(v, __shfl_xor(v, o));
    return v;
}
DI int red16_idx(int lane) { return 8 * ((lane >> 5) & 1) + 4 * ((lane >> 4) & 1) + 2 * ((lane >> 3) & 1) + ((lane >> 2) & 1); }
DI float red16(const float (&o)[16], int lane) {
    const bool b32 = lane & 32, b16 = lane & 16, b8 = lane & 8, b4 = lane & 4;
    float a8[8], a4[4], a2[2], a1;
#pragma unroll
    for (int j = 0; j < 8; ++j) { const float send = b32 ? o[j] : o[j + 8], keep = b32 ? o[j + 8] : o[j]; a8[j] = keep + __shfl_xor(send, 32); }
#pragma unroll
    for (int j = 0; j < 4; ++j) { const float send = b16 ? a8[j] : a8[j + 4], keep = b16 ? a8[j + 4] : a8[j]; a4[j] = keep + __shfl_xor(send, 16); }
#pragma unroll
    for (int j = 0; j < 2; ++j) { const float send = b8 ? a4[j] : a4[j + 2], keep = b8 ? a4[j + 2] : a4[j]; a2[j] = keep + __shfl_xor(send, 8); }
    { const float send = b4 ? a2[0] : a2[1], keep = b4 ? a2[1] : a2[0]; a1 = keep + __shfl_xor(send, 4); }
    a1 += __shfl_xor(a1, 2); a1 += __shfl_xor(a1, 1);
    return a1;
}
#define XB_TMO      128
#define XB_XCNT(j)  (256  + 64 * (j))
#define XB_XSUB(j)  (1280 + 64 * (j))
#define XB_XGEN(j)  (2304 + 64 * (j))
#define XB_TOP      3328
#define XB_TOPGEN   3392
#define XCD_BAR_WORDS 3456
#define XB_SPIN_CAP (1u << 18)

__device__ __forceinline__ unsigned xb_ld(unsigned* p)              { return __hip_atomic_load(p, __ATOMIC_RELAXED, __HIP_MEMORY_SCOPE_AGENT); }
__device__ __forceinline__ unsigned xb_add(unsigned* p, unsigned v) { return __hip_atomic_fetch_add(p, v, __ATOMIC_RELAXED, __HIP_MEMORY_SCOPE_AGENT); }
__device__ __forceinline__ unsigned xb_xcc_id() { return (unsigned)__builtin_amdgcn_s_getreg((3 << 11) | 20) & 0xFu; }
#define XB_SPIN(cond, bar) do { unsigned _sp = 0; while (cond) { __builtin_amdgcn_s_sleep(1); \
    if ((++_sp & 255u) == 0u) { if (xb_ld(&(bar)[XB_TMO])) break; if (_sp > XB_SPIN_CAP) { atomicAdd(&(bar)[XB_TMO], 1u); break; } } } } while (0)

struct XcdBarrier {
    unsigned* bar; unsigned x;
    volatile LAS unsigned* st;
};

__device__ __forceinline__ XcdBarrier xcd_barrier_post(unsigned* bar, volatile LAS unsigned* st) {
    XcdBarrier b; b.bar = bar; b.x = xb_xcc_id(); b.st = st;
    if (threadIdx.x == 0) (void)xb_add(&bar[XB_XCNT(b.x)], 1u);
    return b;
}
__device__ __forceinline__ void xcd_barrier_complete(unsigned* bar, unsigned x, unsigned& nloc, unsigned& nx) {
    const unsigned G = gridDim.x * gridDim.y * gridDim.z;
    unsigned sum, cnt, mine, sp = 0u;
    for (;;) {
        sum = 0u; cnt = 0u; mine = 0u;
#pragma unroll
        for (unsigned j = 0; j < 16; ++j) { const unsigned c = xb_ld(&bar[XB_XCNT(j)]); sum += c; cnt += (c > 0u) ? 1u : 0u; mine = (j == x) ? c : mine; }
        if (sum == G) break;
        __builtin_amdgcn_s_sleep(1);
        if ((++sp & 255u) == 0u) { if (xb_ld(&bar[XB_TMO])) break; if (sp > XB_SPIN_CAP) { atomicAdd(&bar[XB_TMO], 1u); break; } }
    }
    nloc = mine > 0u ? mine : 1u; nx = cnt > 0u ? cnt : 1u;
}

__device__ __forceinline__ void xcd_barrier(const XcdBarrier& b) {
    asm volatile("s_waitcnt vmcnt(0)" ::: "memory");
    __syncthreads();
    if (threadIdx.x == 0) {
        unsigned* bar = b.bar;
        __builtin_amdgcn_s_waitcnt(0);
        unsigned nloc = b.st[0], nx = b.st[1];
        if (nloc == 0u) { xcd_barrier_complete(bar, b.x, nloc, nx); b.st[0] = nloc; b.st[1] = nx; }
        const unsigned old = xb_add(&bar[XB_XSUB(b.x)], 1u);
        const unsigned gen = old / nloc;
        if (old + 1u == (gen + 1u) * nloc) {
            __builtin_amdgcn_fence(__ATOMIC_RELEASE, "agent");
            asm volatile("s_waitcnt vmcnt(0)" ::: "memory");
            const unsigned og = xb_add(&bar[XB_TOP], 1u);
            const unsigned tg = og / nx;
            if (og + 1u == (tg + 1u) * nx) xb_add(&bar[XB_TOPGEN], 1u);
            else XB_SPIN(xb_ld(&bar[XB_TOPGEN]) == tg, bar);
            __builtin_amdgcn_fence(__ATOMIC_ACQUIRE, "agent");
            xb_add(&bar[XB_XGEN(b.x)], 1u);
            asm volatile("s_waitcnt vmcnt(0)" ::: "memory");
        } else {
            XB_SPIN(xb_ld(&bar[XB_XGEN(b.x)]) == gen, bar);
            __builtin_amdgcn_fence(__ATOMIC_ACQUIRE, "agent");
            asm volatile("s_waitcnt vmcnt(0)" ::: "memory");
        }
    }
    __syncthreads();
}
constexpr int NWAVES = 8, NTHR = 512;
constexpr int BATCH = 2, SEQ = 8192, DM = 1024, MTOK = BATCH * SEQ;
constexpr int NIN = 3584;
constexpr int AW = 512;
constexpr int NEXP = 16, DFF = 1024, CAP = 1024, NROWS = BATCH * NEXP * CAP;
constexpr int NSC = 32, SCLEN = 256;
constexpr int NHEAD = 16, HD = 64, NQKV = 3072;
constexpr float EPS = 1e-6f;
constexpr int NPHASE = 23;

constexpr size_t MiB = 1u << 20;
constexpr size_t WS_CTL = 0, CTL_ZERO_BYTES = 1 * MiB;
constexpr size_t WS_AFF = 1 * MiB;
constexpr size_t WS_POS = 2 * MiB;
constexpr size_t WS_IDX = 3 * MiB;
constexpr size_t WS_GATE = 3 * MiB + 256 * 1024;
constexpr size_t WS_DEC = 3 * MiB + 512 * 1024;
constexpr size_t WS_LB = 4 * MiB;
constexpr size_t WS_BT = 4 * MiB + 64 * 1024;
constexpr size_t WS_WIN = 8 * MiB;
constexpr size_t WS_WOUT = 15 * MiB;
constexpr size_t WS_WQKV = 17 * MiB;
constexpr size_t WS_WO = 23 * MiB;
constexpr size_t WS_WSB = 25 * MiB;
constexpr size_t WS_WGU = 32 * MiB;
constexpr size_t WS_WDN = 96 * MiB;
constexpr size_t WS_H = 128 * MiB;
constexpr size_t WS_R1 = 160 * MiB;
constexpr size_t WS_U = WS_R1, WS_GV = WS_R1 + 16 * MiB, WS_Q = WS_R1 + 32 * MiB, WS_V = WS_R1 + 48 * MiB, WS_G = WS_R1 + 64 * MiB;
constexpr size_t WS_LFF = WS_R1 + 80 * MiB, WS_LFB = WS_R1 + 112 * MiB;
constexpr size_t WS_CAT = WS_R1 + 144 * MiB;
constexpr size_t WS_ST = WS_R1 + 176 * MiB;
constexpr size_t WS_ODIR = WS_R1 + 208 * MiB;
constexpr size_t WS_XE = WS_R1, WS_Y = WS_R1;
constexpr size_t WS_HMID = WS_R1 + 64 * MiB;
constexpr size_t WS_QKV = WS_R1;
constexpr size_t WS_ATT = WS_R1 + 96 * MiB;
constexpr size_t WS_VT = WS_R1 + 128 * MiB;
constexpr size_t WS_END = WS_R1 + 272 * MiB;
constexpr int CW_BAR = 4096;
constexpr int MAX_BAR_REGIONS = 24;

constexpr int RING_BYTES = 131072;
constexpr int LDS_BYTES = 147456;
constexpr int LDSCTL_OFF = LDS_BYTES - 512, MISC_OFF = LDSCTL_OFF + 320;

struct Args { const float* in[19]; float* out; unsigned char* ws; int ph_lo, ph_hi, li, pad; };

struct Frame {
    LAS unsigned char* lds;
    volatile LAS unsigned* MISC;
    int tid, lane, wave, G, bid, gw, NGW;
    unsigned char* ws;
};

template <int NPN_> struct GroupedOrder {
    int G, c;
    DI bool next(int i, pg8::Unit& u) const {
        const int L = i * G + c; if (L >= 16 * 8 * NPN_) return false;
        const int e = L / (8 * NPN_), w = L % (8 * NPN_);
        u.pm = e * 8 + (w & 7); u.pn = e * NPN_ + (w >> 3); return true;
    }
    DI void a_ready(const pg8::Unit&) const {}
    DI void done(const pg8::Unit&) const {}
};

struct EpiInProj {
    static constexpr bool PERM = true, AFTER_DRAIN = false;
    bf16 *U, *GV, *Q, *V, *G; float *LFf, *LFb; const float* LB;
    DI void operator()(const pg8::f32x4 (&acc)[2][2][4][2], const pg8::Unit& u, int wr, int wc, int fr, int fq) const {
        const int seg = u.pn >> 1;
        const int row0 = u.pm * 256 + wr * 64 + fr, lc0 = (u.pn & 1) * 256 + wc * 32 + 8 * fq;
#pragma unroll
        for (int bj = 0; bj < 2; ++bj) {
            const int lc = lc0 + bj * 128;
            float lb[8];
            if (seg == 3 || seg == 4) {
#pragma unroll
                for (int j = 0; j < 8; ++j) lb[j] = LB[(seg - 3) * 512 + lc + j];
            }
#pragma unroll
            for (int ai = 0; ai < 2; ++ai)
#pragma unroll
                for (int m = 0; m < 4; ++m) {
                    const size_t off = (size_t)(row0 + ai * 128 + m * 16) * 512 + lc;
                    float v[8];
#pragma unroll
                    for (int j = 0; j < 8; ++j) v[j] = acc[ai][bj][m][j >> 2][j & 3];
                    if (seg == 3 || seg == 4) {
#pragma unroll
                        for (int j = 0; j < 8; ++j) v[j] = flog(lb[j] + (1.f - lb[j]) * sigmoidf_(v[j]));
                        float* o = (seg == 3 ? LFf : LFb) + off;
                        *(f32x4*)o = (f32x4){v[0], v[1], v[2], v[3]}; *(f32x4*)(o + 4) = (f32x4){v[4], v[5], v[6], v[7]};
                    } else {
                        bf16* o;
                        if (seg == 0) { o = U;
#pragma unroll
                            for (int j = 0; j < 8; ++j) v[j] = gelu_tanh(v[j]);
                        } else if (seg == 1) { o = GV;
#pragma unroll
                            for (int j = 0; j < 8; ++j) v[j] = gelu_tanh(v[j]);
                        } else if (seg == 2) { o = Q;
#pragma unroll
                            for (int j = 0; j < 8; ++j) v[j] = siluf_(v[j]);
                        } else if (seg == 5) { o = V;
                        } else { o = G;
#pragma unroll
                            for (int j = 0; j < 8; ++j) v[j] = sigmoidf_(v[j]);
                        }
                        v4u w; w.x = pk2(v[0], v[1]); w.y = pk2(v[2], v[3]); w.z = pk2(v[4], v[5]); w.w = pk2(v[6], v[7]);
                        *(v4u*)(o + off) = w;
                    }
                }
        }
    }
};
struct EpiResid {
    static constexpr bool PERM = false, AFTER_DRAIN = false;
    const float* base; float* out;
    DI void operator()(const pg8::f32x4 (&acc)[2][2][4][2], const pg8::Unit& u, int wr, int wc, int fr, int fq) const {
        const int row0 = u.pm * 256 + wr * 64 + fr, col0 = u.pn * 256 + wc * 32 + 4 * fq;
#pragma unroll
        for (int ai = 0; ai < 2; ++ai)
#pragma unroll
            for (int m = 0; m < 4; ++m) { const size_t ro = (size_t)(row0 + ai * 128 + m * 16) * DM + col0;
#pragma unroll
                for (int bj = 0; bj < 2; ++bj)
#pragma unroll
                    for (int n = 0; n < 2; ++n) { const size_t o = ro + bj * 128 + n * 16; *(f32x4*)(out + o) = *(const f32x4*)(base + o) + acc[ai][bj][m][n]; } }
    }
};
struct EpiGateUp {
    static constexpr bool PERM = true, AFTER_DRAIN = false;
    bf16* H;
    DI void operator()(const pg8::f32x4 (&acc)[2][2][4][2], const pg8::Unit& u, int wr, int wc, int fr, int fq) const {
        const int pnl = u.pn & 7;
        const int row0 = u.pm * 256 + wr * 64 + fr, col0 = pnl * 128 + wc * 32 + 8 * fq;
#pragma unroll
        for (int ai = 0; ai < 2; ++ai)
#pragma unroll
            for (int m = 0; m < 4; ++m) {
                float v[8];
#pragma unroll
                for (int j = 0; j < 8; ++j) v[j] = siluf_(acc[ai][0][m][j >> 2][j & 3]) * acc[ai][1][m][j >> 2][j & 3];
                v4u w; w.x = pk2(v[0], v[1]); w.y = pk2(v[2], v[3]); w.z = pk2(v[4], v[5]); w.w = pk2(v[6], v[7]);
                *(v4u*)(H + (size_t)(row0 + ai * 128 + m * 16) * DFF + col0) = w;
            }
    }
};
struct EpiDown {
    static constexpr bool PERM = true, AFTER_DRAIN = false;
    bf16* Y; const float* gate;
    DI void operator()(const pg8::f32x4 (&acc)[2][2][4][2], const pg8::Unit& u, int wr, int wc, int fr, int fq) const {
        const int pnl = u.pn & 3;
        const int row0 = u.pm * 256 + wr * 64 + fr, col0 = pnl * 256 + wc * 32 + 8 * fq;
#pragma unroll
        for (int ai = 0; ai < 2; ++ai)
#pragma unroll
            for (int m = 0; m < 4; ++m) { const int row = row0 + ai * 128 + m * 16; const float g = gate[row];
#pragma unroll
                for (int bj = 0; bj < 2; ++bj) {
                    float v[8];
#pragma unroll
                    for (int j = 0; j < 8; ++j) v[j] = acc[ai][bj][m][j >> 2][j & 3] * g;
                    v4u w; w.x = pk2(v[0], v[1]); w.y = pk2(v[2], v[3]); w.z = pk2(v[4], v[5]); w.w = pk2(v[6], v[7]);
                    *(v4u*)(Y + (size_t)row * DM + col0 + bj * 128) = w; } }
    }
};
struct EpiQKV {
    static constexpr bool PERM = true, AFTER_DRAIN = false;
    bf16* O;
    DI void operator()(const pg8::f32x4 (&acc)[2][2][4][2], const pg8::Unit& u, int wr, int wc, int fr, int fq) const {
        const float sc = (u.pn < 4) ? 0.125f : 1.f;
        const int row0 = u.pm * 256 + wr * 64 + fr, col0 = u.pn * 256 + wc * 32 + 8 * fq;
#pragma unroll
        for (int ai = 0; ai < 2; ++ai)
#pragma unroll
            for (int m = 0; m < 4; ++m)
#pragma unroll
                for (int bj = 0; bj < 2; ++bj) {
                    float v[8];
#pragma unroll
                    for (int j = 0; j < 8; ++j) v[j] = acc[ai][bj][m][j >> 2][j & 3] * sc;
                    v4u w; w.x = pk2(v[0], v[1]); w.y = pk2(v[2], v[3]); w.z = pk2(v[4], v[5]); w.w = pk2(v[6], v[7]);
                    *(v4u*)(O + (size_t)(row0 + ai * 128 + m * 16) * NQKV + col0 + bj * 128) = w; }
    }
};

DI void transpose_item(const float* W, int K, int N, bf16* WT, LAS float* scr, int k0, int n0, int drow0, int lane) {
#pragma unroll 8
    for (int i = 0; i < 32; ++i) { const int kk = 2 * i + (lane >> 5); scr[kk * 33 + (lane & 31)] = W[(size_t)(k0 + kk) * N + n0 + (lane & 31)]; }
    LDS_WAIT(); asm volatile("" ::: "memory");
    const int c = lane & 7;
#pragma unroll
    for (int j = 0; j < 4; ++j) { const int n = (lane >> 3) + 8 * j; const LAS float* s = scr + (8 * c) * 33 + n;
        v4u o; o.x = pk2(s[0 * 33], s[1 * 33]); o.y = pk2(s[2 * 33], s[3 * 33]); o.z = pk2(s[4 * 33], s[5 * 33]); o.w = pk2(s[6 * 33], s[7 * 33]);
        *(v4u*)(WT + (size_t)(drow0 + n) * K + k0 + 8 * c) = o; }
    LDS_WAIT(); asm volatile("" ::: "memory");
}
DI void transpose_matrix(Frame& F, const float* W, int K, int N, bf16* WT) {
    LAS float* scr = (LAS float*)(F.lds + F.wave * 16384);
    const int nblk = N / 32, nitems = (K / 64) * nblk;
    for (int it = F.gw; it < nitems; it += F.NGW) { const int kb = it / nblk, nb = it % nblk; transpose_item(W, K, N, WT, scr, 64 * kb, 32 * nb, 32 * nb, F.lane); }
}
DI void convert_moe_weights(Frame& F, const float* wg, const float* wu, const float* wd, int layer) {
    LAS float* scr = (LAS float*)(F.lds + F.wave * 16384);
    bf16* WGU = (bf16*)(F.ws + WS_WGU); bf16* WDN = (bf16*)(F.ws + WS_WDN);
    for (int it = F.gw; it < 3 * 16 * 512; it += F.NGW) {
        const int mat = it / 8192, rem = it % 8192, e = rem / 512, r = rem % 512, kb = r / 32, nb = r % 32, n0 = 32 * nb;
        const size_t so = ((size_t)layer * 16 + e) * 1024 * 1024;
        if (mat == 0) transpose_item(wg + so, 1024, 1024, WGU + (size_t)e * 2048 * 1024, scr, 64 * kb, n0, (n0 >> 7) * 256 + (n0 & 127), F.lane);
        else if (mat == 1) transpose_item(wu + so, 1024, 1024, WGU + (size_t)e * 2048 * 1024, scr, 64 * kb, n0, (n0 >> 7) * 256 + 128 + (n0 & 127), F.lane);
        else transpose_item(wd + so, 1024, 1024, WDN + (size_t)e * 1024 * 1024, scr, 64 * kb, n0, n0, F.lane);
    }
}
DI void rms_row(const float* xrow, const float* g, f32x4 (&v)[4], int lane) {
    const f32x4* xr = (const f32x4*)xrow + lane; float s = 0.f;
#pragma unroll
    for (int j = 0; j < 4; ++j) { v[j] = xr[64 * j]; s += (v[j].x * v[j].x + v[j].y * v[j].y) + (v[j].z * v[j].z + v[j].w * v[j].w); }
    const float rstd = 1.f / sqrtf(wave_sum(s) * (1.f / DM) + EPS);
    const f32x4* gr = (const f32x4*)g + lane;
#pragma unroll
    for (int j = 0; j < 4; ++j) v[j] = v[j] * rstd * gr[64 * j];
}
DI void store_row_bf16(bf16* orow, const f32x4 (&v)[4], int lane) {
    v2u* o8 = (v2u*)orow + lane;
#pragma unroll
    for (int j = 0; j < 4; ++j) { v2u w; w.x = pk2(v[j].x, v[j].y); w.y = pk2(v[j].z, v[j].w); o8[64 * j] = w; }
}
DI int t5_bucket(int rel) {
    const int n = rel < 0 ? -rel : rel;
    int val;
    if (n < 8) val = n;
    else { const float sc = logf((float)n / 8.f) / 4.852030263919617f; int lg = 8 + (int)(sc * 8.f); val = lg < 15 ? lg : 15; }
    return (rel > 0 ? 16 : 0) + val;
}

typedef float f32x16 __attribute__((ext_vector_type(16)));
#define MFMA32(a, b, c) __builtin_amdgcn_mfma_f32_32x32x16_bf16((a), (b), (c), 0, 0, 0)
DI int crow32(int j, int hh) { return (j & 3) + 8 * (j >> 2) + 4 * hh; }
DI void phase_prologue(Frame& F, const Args& a) {
    unsigned char* ws = F.ws;
    transpose_matrix(F, a.in[4], 1024, NIN, (bf16*)(ws + WS_WIN));
    transpose_matrix(F, a.in[5], 1024, 1024, (bf16*)(ws + WS_WOUT));
    transpose_matrix(F, a.in[12], 1024, NQKV, (bf16*)(ws + WS_WQKV));
    transpose_matrix(F, a.in[13], 1024, 1024, (bf16*)(ws + WS_WO));
    convert_moe_weights(F, a.in[16], a.in[17], a.in[18], 0);
    { bf16* WSB = (bf16*)(ws + WS_WSB); for (int i = F.bid * NTHR + F.tid; i < 4 * 128 * 128; i += F.G * NTHR) WSB[i] = (bf16)f2bf(a.in[8][i]); }
    { float* LB = (float*)(ws + WS_LB); const float* t = a.in[10];
      for (int i = F.bid * NTHR + F.tid; i < 2 * 512; i += F.G * NTHR) { const int d = i / 512, k = i % 512;
          const float a0 = t[(d * 3 + 0) * 512 + k], a1 = t[(d * 3 + 1) * 512 + k], a2 = t[(d * 3 + 2) * 512 + k];
          const float mx = fmaxf(a0, fmaxf(a1, a2)); const float e0 = expf(a0 - mx), e1 = expf(a1 - mx), e2 = expf(a2 - mx);
          LB[i] = e0 / (e0 + e1 + e2); } }
    { float* BT = (float*)(ws + WS_BT); const float* rb = a.in[14];
      for (int i = F.bid * NTHR + F.tid; i < 3 * 16 * 129; i += F.G * NTHR) { const int p = i / (16 * 129), h = (i / 129) % 16, j = i % 129;
          const int dil = (p == 0) ? 1 : (p == 1 ? 4 : 16);
          BT[i] = rb[t5_bucket((j - 64) * dil) * 16 + h]; } }
    { bf16* H = (bf16*)(ws + WS_H); const float* x = a.in[0];
      for (int m = F.gw; m < MTOK; m += F.NGW) { f32x4 v[4]; rms_row(x + (size_t)m * DM, a.in[1], v, F.lane); store_row_bf16(H + (size_t)m * DM, v, F.lane); } }
}

DI void phase_a_ln(Frame& F, const Args& a) {
    bf16* GV = (bf16*)(F.ws + WS_GV); const float* lg = a.in[6]; const float* lbv = a.in[7];
    for (int m = F.gw; m < MTOK; m += F.NGW) {
        v4u w = *((const v4u*)(GV + (size_t)m * AW) + F.lane);
        float v[8] = {bflo(w.x), bfhi(w.x), bflo(w.y), bfhi(w.y), bflo(w.z), bfhi(w.z), bflo(w.w), bfhi(w.w)};
        float s = 0.f;
#pragma unroll
        for (int j = 0; j < 8; ++j) s += v[j];
        const float mu = wave_sum(s) * (1.f / AW); float s2 = 0.f;
#pragma unroll
        for (int j = 0; j < 8; ++j) { v[j] -= mu; s2 += v[j] * v[j]; }
        const float rstd = 1.f / sqrtf(wave_sum(s2) * (1.f / AW) + EPS);
#pragma unroll
        for (int j = 0; j < 8; ++j) v[j] = v[j] * rstd * lg[8 * F.lane + j] + lbv[8 * F.lane + j];
        v4u o; o.x = pk2(v[0], v[1]); o.y = pk2(v[2], v[3]); o.z = pk2(v[4], v[5]); o.w = pk2(v[6], v[7]);
        *((v4u*)(GV + (size_t)m * AW) + F.lane) = o;
    }
}
DI void phase_a_mix_naive(Frame& F, const Args& a) {
    const bf16* VN = (const bf16*)(F.ws + WS_GV); const bf16* U = (const bf16*)(F.ws + WS_U); bf16* CAT = (bf16*)(F.ws + WS_CAT);
    LAS float* wl = (LAS float*)F.lds; LAS float* vl = (LAS float*)(F.lds + 65536);
    for (int u = F.bid; u < 512; u += F.G) {
        const int g = u & 3, ch = u >> 2; const int row0 = ch * 128;
        __syncthreads();
        for (int i = F.tid; i < 128 * 128; i += NTHR) { wl[i] = a.in[8][g * 16384 + i]; const int s = i >> 7, c = i & 127; vl[i] = bf2f(VN[(size_t)(row0 + s) * AW + g * 128 + c]); }
        __syncthreads();
        const int c = F.tid & 127, tq = F.tid >> 7;
        for (int tt = 0; tt < 32; ++tt) { const int t = tq * 32 + tt; float acc = 0.f;
            for (int s = 0; s < 128; ++s) acc += wl[t * 128 + s] * vl[s * 128 + c];
            const float uu = bf2f(U[(size_t)(row0 + t) * AW + g * 128 + c]);
            CAT[(size_t)(row0 + t) * DM + g * 128 + c] = (bf16)f2bf(uu * (acc + a.in[9][g * 128 + t])); }
    }
}

DI void phase_a_mix(Frame& F, const Args& a) {
    const bf16* VN = (const bf16*)(F.ws + WS_GV); const bf16* U = (const bf16*)(F.ws + WS_U); bf16* CAT = (bf16*)(F.ws + WS_CAT); const bf16* WSB = (const bf16*)(F.ws + WS_WSB);
    const int r32 = F.lane & 31, hh = F.lane >> 5, ci = F.wave & 3, tp = F.wave >> 2;
    for (int u = F.bid; u < 512; u += F.G) {
        const int g = u & 3, ch = u >> 2; const int row0 = ch * 128;
        f32x16 acc[2];
#pragma unroll
        for (int j = 0; j < 16; ++j) { acc[0][j] = 0.f; acc[1][j] = 0.f; }
        const bf16* vcol = VN + (size_t)row0 * AW + g * 128 + 32 * ci + r32;
        const bf16* w0 = WSB + (size_t)g * 16384 + (size_t)(64 * tp + r32) * 128 + 8 * hh;
#pragma unroll
        for (int s = 0; s < 8; ++s) {
            unsigned short e[8];
#pragma unroll
            for (int j = 0; j < 8; ++j) e[j] = vcol[(size_t)(16 * s + 8 * hh + j) * AW];
            v4u bw; bw.x = e[0] | ((unsigned)e[1] << 16); bw.y = e[2] | ((unsigned)e[3] << 16); bw.z = e[4] | ((unsigned)e[5] << 16); bw.w = e[6] | ((unsigned)e[7] << 16);
            const bf16x8 bt = __builtin_bit_cast(bf16x8, bw);
            acc[0] = MFMA32(*(const bf16x8*)(w0 + 16 * s), bt, acc[0]);
            acc[1] = MFMA32(*(const bf16x8*)(w0 + 32 * 128 + 16 * s), bt, acc[1]);
        }
#pragma unroll
        for (int q = 0; q < 2; ++q)
#pragma unroll
            for (int j = 0; j < 16; ++j) { const int t = 64 * tp + 32 * q + crow32(j, hh), c = g * 128 + 32 * ci + r32;
                const float uu = bf2f(U[(size_t)(row0 + t) * AW + c]);
                CAT[(size_t)(row0 + t) * DM + c] = (bf16)f2bf(uu * (acc[q][j] + a.in[9][g * 128 + t])); }
    }
}

DI void gla_naive_unit(Frame& F, int u, bool with_out) {
    const int sc = u & 31, dir = (u >> 5) & 1, h = (u >> 6) & 3, b = u >> 8;
    const bf16* Q = (const bf16*)(F.ws + WS_Q); const bf16* V = (const bf16*)(F.ws + WS_V);
    const float* LF = (const float*)(F.ws + (dir ? WS_LFB : WS_LFF));
    float* ST = (float*)(F.ws + WS_ST) + (size_t)u * 16384; float* DEC = (float*)(F.ws + WS_DEC) + u * 128;
    float* OD = (float*)(F.ws + WS_ODIR) + (size_t)dir * MTOK * AW;
    LAS bf16* qs = (LAS bf16*)F.lds; LAS bf16* vs = (LAS bf16*)(F.lds + 16384); LAS float* lfs = (LAS float*)(F.lds + 32768);
    const int lane = F.lane, w = F.wave;
    float S[2][16]; float lsum[2] = {0.f, 0.f};
#pragma unroll
    for (int aa = 0; aa < 2; ++aa)
#pragma unroll
        for (int j = 0; j < 16; ++j) S[aa][j] = with_out ? ST[(lane + 64 * aa) * 128 + 16 * w + j] : 0.f;
    for (int sub = 0; sub < 4; ++sub) {
        __syncthreads();
        for (int idx = F.tid; idx < 1024; idx += NTHR) { const int i = idx >> 4, c8 = (idx & 15) * 8; const int ii = sc * 256 + sub * 64 + i; const int tok = dir ? (SEQ - 1 - ii) : ii;
            const size_t go = (size_t)(b * SEQ + tok) * AW + h * 128 + c8;
            *(LAS v4u*)(qs + i * 128 + c8) = *(const v4u*)(Q + go); *(LAS v4u*)(vs + i * 128 + c8) = *(const v4u*)(V + go); }
        for (int idx = F.tid; idx < 2048; idx += NTHR) { const int i = idx >> 5, c4 = (idx & 31) * 4; const int ii = sc * 256 + sub * 64 + i; const int tok = dir ? (SEQ - 1 - ii) : ii;
            *(LAS f32x4*)(lfs + i * 128 + c4) = *(const f32x4*)(LF + (size_t)(b * SEQ + tok) * AW + h * 128 + c4); }
        __syncthreads();
        for (int i = 0; i < 64; ++i) {
            const float l0 = lfs[i * 128 + lane], l1 = lfs[i * 128 + lane + 64];
            const float f0 = fexp(l0), f1 = fexp(l1), k0 = 1.f - f0, k1 = 1.f - f1;
            lsum[0] += l0; lsum[1] += l1;
            float vv[16];
            { const v4u a0 = *(const LAS v4u*)(vs + i * 128 + 16 * w), a1 = *(const LAS v4u*)(vs + i * 128 + 16 * w + 8);
              vv[0] = bflo(a0.x); vv[1] = bfhi(a0.x); vv[2] = bflo(a0.y); vv[3] = bfhi(a0.y); vv[4] = bflo(a0.z); vv[5] = bfhi(a0.z); vv[6] = bflo(a0.w); vv[7] = bfhi(a0.w);
              vv[8] = bflo(a1.x); vv[9] = bfhi(a1.x); vv[10] = bflo(a1.y); vv[11] = bfhi(a1.y); vv[12] = bflo(a1.z); vv[13] = bfhi(a1.z); vv[14] = bflo(a1.w); vv[15] = bfhi(a1.w); }
#pragma unroll
            for (int j = 0; j < 16; ++j) { S[0][j] = f0 * S[0][j] + k0 * vv[j]; S[1][j] = f1 * S[1][j] + k1 * vv[j]; }
            if (with_out) {
                const float q0 = bf2f(qs[i * 128 + lane]), q1 = bf2f(qs[i * 128 + lane + 64]);
                float o[16];
#pragma unroll
                for (int j = 0; j < 16; ++j) o[j] = S[0][j] * q0 + S[1][j] * q1;
                const float tot = red16(o, lane);
                if ((lane & 3) == 0) { const int ii = sc * 256 + sub * 64 + i; const int tok = dir ? (SEQ - 1 - ii) : ii;
                    OD[(size_t)(b * SEQ + tok) * AW + h * 128 + 16 * w + red16_idx(lane)] = tot; }
            }
        }
    }
    if (!with_out) {
#pragma unroll
        for (int aa = 0; aa < 2; ++aa)
#pragma unroll
            for (int j = 0; j < 16; ++j) ST[(lane + 64 * aa) * 128 + 16 * w + j] = S[aa][j];
        if (w == 0) { DEC[lane] = fexp(lsum[0]); DEC[lane + 64] = fexp(lsum[1]); }
    }
}
DI void phase_gla_scan(Frame& F) {
    float* ST = (float*)(F.ws + WS_ST); const float* DEC = (const float*)(F.ws + WS_DEC);
    for (int idx = F.bid * NTHR + F.tid; idx < 16 * 16384; idx += F.G * NTHR) {
        const int chain = idx >> 14, kv = idx & 16383, k = kv >> 7; float S = 0.f;
        for (int sc = 0; sc < NSC; ++sc) { const int u = chain * NSC + sc; const size_t o = (size_t)u * 16384 + kv; const float d = ST[o]; ST[o] = S; S = S * DEC[u * 128 + k] + d; }
    }
}
DI void phase_b_combine(Frame& F, const Args& a) {
    const float* OD = (const float*)(F.ws + WS_ODIR); const bf16* G = (const bf16*)(F.ws + WS_G); bf16* CAT = (bf16*)(F.ws + WS_CAT); const float* ng = a.in[11];
    for (int t = F.gw; t < MTOK * 4; t += F.NGW) { const int row = t >> 2, h = t & 3; const size_t o = (size_t)row * AW + h * 128 + 2 * F.lane;
        const float o0 = OD[o] + OD[(size_t)MTOK * AW + o], o1 = OD[o + 1] + OD[(size_t)MTOK * AW + o + 1];
        const float rstd = 1.f / sqrtf(wave_sum(o0 * o0 + o1 * o1) * (1.f / 128.f) + EPS);
        const unsigned gw2 = *(const unsigned*)(G + o);
        const float r0 = o0 * rstd * ng[h * 128 + 2 * F.lane] * bflo(gw2), r1 = o1 * rstd * ng[h * 128 + 2 * F.lane + 1] * bfhi(gw2);
        *(unsigned*)(CAT + (size_t)row * DM + 512 + h * 128 + 2 * F.lane) = pk2(r0, r1); }
}

DI void phase_router(Frame& F, const float* XR, const float* gn, const float* wr) {
    LAS float* wl = (LAS float*)F.lds;
    __syncthreads();
    for (int i = F.tid; i < 1024 * 16 / 4; i += NTHR) { const f32x4 w4 = *(const f32x4*)(wr + 4 * i); const int d = i >> 2, e0 = 4 * (i & 3);
        wl[(e0 + 0) * 1024 + d] = w4.x; wl[(e0 + 1) * 1024 + d] = w4.y; wl[(e0 + 2) * 1024 + d] = w4.z; wl[(e0 + 3) * 1024 + d] = w4.w; }
    __syncthreads();
    bf16* H = (bf16*)(F.ws + WS_H); float* AFF = (float*)(F.ws + WS_AFF);
    for (int m = F.gw; m < MTOK; m += F.NGW) {
        asm volatile("" ::: "memory");
        f32x4 v[4]; rms_row(XR + (size_t)m * DM, gn, v, F.lane); store_row_bf16(H + (size_t)m * DM, v, F.lane);
        float p[16];
#pragma unroll
        for (int e = 0; e < 16; ++e) { float a = 0.f;
#pragma unroll
            for (int j = 0; j < 4; ++j) { const f32x4 w4 = *(const LAS f32x4*)(wl + e * 1024 + 4 * F.lane + 256 * j); a += (v[j].x * w4.x + v[j].y * w4.y) + (v[j].z * w4.z + v[j].w * w4.w); }
            p[e] = a; }
        const float lg = red16(p, F.lane);
        const float mx = wave_max(lg); const float ex = expf(lg - mx); const float sm = wave_sum(ex) * 0.25f;
        if ((F.lane & 3) == 0) { const int b = m / SEQ, s = m % SEQ; AFF[(size_t)(b * 16 + red16_idx(F.lane)) * SEQ + s] = ex / sm; }
    }
}

DI int block_excl_scan(int v, LAS int* scratch, int tid, int lane, int wave, int* tot) {
    int inc = v;
#pragma unroll
    for (int o = 1; o < 64; o <<= 1) { const int t = __shfl_up(inc, o); if (lane >= o) inc += t; }
    __syncthreads();
    if (lane == 63) scratch[wave] = inc;
    __syncthreads();
    int base = 0, total = 0;
#pragma unroll
    for (int w = 0; w < NWAVES; ++w) { const int s = scratch[w]; if (w < wave) base += s; total += s; }
    *tot = total;
    return base + inc - v;
}
DI void phase_topk(Frame& F) {
    const float* AFF = (const float*)(F.ws + WS_AFF); int* IDX = (int*)(F.ws + WS_IDX); float* GATE = (float*)(F.ws + WS_GATE); int* POS = (int*)(F.ws + WS_POS);
    LAS unsigned* hist = (LAS unsigned*)F.lds; LAS int* sc = (LAS int*)(F.lds + 16384); LAS unsigned* shv = (LAS unsigned*)(F.lds + 16384 + 256);
    for (int u = F.bid; u < BATCH * NEXP; u += F.G) {
        const int b = u / NEXP, e = u % NEXP;
        unsigned vals[16];
        { const v4u* src = (const v4u*)(AFF + (size_t)u * SEQ + 16 * F.tid);
#pragma unroll
          for (int j = 0; j < 4; ++j) { const v4u t = src[j]; vals[4 * j] = t.x; vals[4 * j + 1] = t.y; vals[4 * j + 2] = t.z; vals[4 * j + 3] = t.w; } }
        unsigned prefix = 0; int krem = CAP;
#pragma unroll
        for (int pass = 0; pass < 3; ++pass) {
            const int shift = (pass == 0) ? 20 : (pass == 1 ? 8 : 0); const unsigned mask = (pass == 2) ? 255u : 4095u; const int pshift = (pass == 2) ? 8 : 20;
            __syncthreads();
#pragma unroll
            for (int j = 0; j < 8; ++j) hist[F.tid + 512 * j] = 0u;
            __syncthreads();
#pragma unroll
            for (int j = 0; j < 16; ++j) { const unsigned v = vals[j]; if (pass == 0 || (v >> pshift) == prefix) __hip_atomic_fetch_add(&hist[(v >> shift) & mask], 1u, __ATOMIC_RELAXED, __HIP_MEMORY_SCOPE_WORKGROUP); }
            __syncthreads();
            const int hi = 4095 - 8 * F.tid; int ls = 0; unsigned hb[8];
#pragma unroll
            for (int j = 0; j < 8; ++j) { hb[j] = hist[hi - j]; ls += (int)hb[j]; }
            int tot; const int above = block_excl_scan(ls, sc, F.tid, F.lane, F.wave, &tot);
            if (above < krem && krem <= above + ls) { int cum = above, sel = hi, found = 0;
#pragma unroll
                for (int j = 0; j < 8; ++j) { if (!found) { if (cum + (int)hb[j] >= krem) { sel = hi - j; found = 1; } else cum += (int)hb[j]; } }
                shv[0] = (unsigned)sel; shv[1] = (unsigned)(krem - cum); }
            __syncthreads();
            prefix = (pass == 2) ? ((prefix << 8) | shv[0]) : ((prefix << 12) | shv[0]); krem = (int)shv[1];
        }
        const unsigned T = prefix;
        int ce = 0;
#pragma unroll
        for (int j = 0; j < 16; ++j) ce += (vals[j] == T) ? 1 : 0;
        int tot; int pe = block_excl_scan(ce, sc, F.tid, F.lane, F.wave, &tot);
        unsigned selmask = 0; int cs = 0;
#pragma unroll
        for (int j = 0; j < 16; ++j) { bool s = vals[j] > T; if (vals[j] == T) { s = pe < krem; ++pe; } if (s) { selmask |= 1u << j; ++cs; } }
        int slot = block_excl_scan(cs, sc, F.tid, F.lane, F.wave, &tot);
#pragma unroll
        for (int j = 0; j < 16; ++j) { const int s = 16 * F.tid + j; const int tokrow = b * SEQ + s;
            if (selmask & (1u << j)) { const int row = (e * 2 + b) * CAP + slot; ++slot; IDX[row] = tokrow; GATE[row] = __builtin_bit_cast(float, vals[j]); POS[tokrow * 16 + e] = row; }
            else POS[tokrow * 16 + e] = -1; }
    }
}
DI void phase_gather(Frame& F) {
    const bf16* H = (const bf16*)(F.ws + WS_H); bf16* XE = (bf16*)(F.ws + WS_XE); const int* IDX = (const int*)(F.ws + WS_IDX);
    for (int r = F.gw; r < NROWS; r += F.NGW) { const int src = IDX[r];
        const v4u* s = (const v4u*)(H + (size_t)src * DM) + F.lane; v4u* d = (v4u*)(XE + (size_t)r * DM) + F.lane;
        d[0] = s[0]; d[64] = s[64]; }
}
DI void phase_moe_combine(Frame& F, float* XR, const float* gnext, bool final_out) {
    const bf16* Y = (const bf16*)(F.ws + WS_Y); const int* POS = (const int*)(F.ws + WS_POS); bf16* H = (bf16*)(F.ws + WS_H);
    for (int m = F.gw; m < MTOK; m += F.NGW) {
        f32x4* xr = (f32x4*)(XR + (size_t)m * DM) + F.lane;
        f32x4 v[4];
#pragma unroll
        for (int j = 0; j < 4; ++j) v[j] = xr[64 * j];
        const int pmine = POS[m * 16 + (F.lane & 15)];
        for (int e = 0; e < 16; ++e) { const int p = __shfl(pmine, e);
            if (p >= 0) { const v2u* yr = (const v2u*)(Y + (size_t)p * DM) + F.lane;
#pragma unroll
                for (int j = 0; j < 4; ++j) { const v2u w = yr[64 * j]; v[j].x += bflo(w.x); v[j].y += bfhi(w.x); v[j].z += bflo(w.y); v[j].w += bfhi(w.y); } } }
        float s = 0.f;
#pragma unroll
        for (int j = 0; j < 4; ++j) s += (v[j].x * v[j].x + v[j].y * v[j].y) + (v[j].z * v[j].z + v[j].w * v[j].w);
        const float rstd = 1.f / sqrtf(wave_sum(s) * (1.f / DM) + EPS);
        const f32x4* gr = (const f32x4*)gnext + F.lane;
        if (final_out) {
#pragma unroll
            for (int j = 0; j < 4; ++j) xr[64 * j] = v[j] * rstd * gr[64 * j];
        } else {
#pragma unroll
            for (int j = 0; j < 4; ++j) xr[64 * j] = v[j];
            f32x4 nv[4];
#pragma unroll
            for (int j = 0; j < 4; ++j) nv[j] = v[j] * rstd * gr[64 * j];
            store_row_bf16(H + (size_t)m * DM, nv, F.lane);
        }
    }
}

DI void phase_attn_naive(Frame& F) {
    const bf16* QKV = (const bf16*)(F.ws + WS_QKV); bf16* ATT = (bf16*)(F.ws + WS_ATT); const float* BT = (const float*)(F.ws + WS_BT);
    LAS float* ql = (LAS float*)(F.lds + F.wave * 4096);
    LAS float* pl = ql + 64; LAS int* posl = (LAS int*)(ql + 512);
    const int lane = F.lane;
    for (int t = F.gw; t < MTOK * NHEAD; t += F.NGW) {
        const int row = t >> 4, h = t & 15, b = row / SEQ, tq = row % SEQ;
        ql[lane] = bf2f(QKV[(size_t)row * NQKV + h * 64 + lane]);
        LDS_WAIT();
        float s[7]; int pos[7];
#pragma unroll
        for (int i = 0; i < 7; ++i) {
            const int slot = lane + 64 * i; const int p = slot / 129, j = slot % 129;
            const int dil = (p == 0) ? 1 : (p == 1 ? 4 : 16);
            const int mq = tq / dil, r = tq % dil, mk = mq - 64 + j;
            const bool valid = (slot < 387) && (mk >= 0) && (mk < SEQ / dil);
            pos[i] = valid ? (b * SEQ + r + dil * mk) : -1;
            float d = -1e30f;
            if (valid) { const v4u* kr = (const v4u*)(QKV + (size_t)pos[i] * NQKV + 1024 + h * 64); float acc = 0.f;
#pragma unroll
                for (int c = 0; c < 8; ++c) { const v4u w = kr[c];
                    acc += ql[8 * c] * bflo(w.x) + ql[8 * c + 1] * bfhi(w.x) + ql[8 * c + 2] * bflo(w.y) + ql[8 * c + 3] * bfhi(w.y) + ql[8 * c + 4] * bflo(w.z) + ql[8 * c + 5] * bfhi(w.z) + ql[8 * c + 6] * bflo(w.w) + ql[8 * c + 7] * bfhi(w.w); }
                d = acc + BT[(p * 16 + h) * 129 + j]; }
            s[i] = d;
        }
        float mx = s[0];
#pragma unroll
        for (int i = 1; i < 7; ++i) mx = fmaxf(mx, s[i]);
        mx = wave_max(mx);
        float sum = 0.f;
#pragma unroll
        for (int i = 0; i < 7; ++i) { const float pv = (pos[i] >= 0) ? expf(s[i] - mx) : 0.f; sum += pv; pl[lane + 64 * i] = pv; posl[lane + 64 * i] = pos[i]; }
        sum = wave_sum(sum);
        LDS_WAIT();
        float o = 0.f;
        for (int k = 0; k < 387; ++k) { const int pp = posl[k]; if (pp >= 0) o += pl[k] * bf2f(QKV[(size_t)pp * NQKV + 2048 + h * 64 + lane]); }
        ATT[(size_t)row * DM + h * 64 + lane] = (bf16)f2bf(o / sum);
        LDS_WAIT();
    }
}

DI void phase_vt(Frame& F) {
    const bf16* QKV = (const bf16*)(F.ws + WS_QKV); bf16* VT = (bf16*)(F.ws + WS_VT);
    LAS unsigned char* tl = F.lds;
    for (int u = F.bid; u < 512; u += F.G) {
        const int c = u & 15, h = (u >> 4) & 15, b = u >> 8, t0 = c * 512;
        __syncthreads();
        { const v4u* src = (const v4u*)(QKV + (size_t)(b * SEQ + t0 + F.tid) * NQKV + 2048 + h * 64);
#pragma unroll
          for (int j = 0; j < 8; ++j) { const v4u w = src[j]; LAS v2u* d = (LAS v2u*)(tl + F.tid * 136 + 16 * j); d[0] = (v2u){w.x, w.y}; d[1] = (v2u){w.z, w.w}; } }
        __syncthreads();
#pragma unroll
        for (int p = 0; p < 3; ++p) {
            const int dl = (p == 0) ? 1 : (p == 1 ? 4 : 16), ns = SEQ / dl, per = 512 / dl;
            bf16* dst = VT + (size_t)p * MTOK * DM;
            for (int q = F.tid; q < 4096; q += NTHR) {
                const int dim = q >> 6, pp = (q & 63) * 8, r = pp / per, ml = pp % per;
                unsigned short e[8];
#pragma unroll
                for (int k = 0; k < 8; ++k) e[k] = *(const LAS unsigned short*)(tl + (dl * (ml + k) + r) * 136 + dim * 2);
                v4u o; o.x = e[0] | ((unsigned)e[1] << 16); o.y = e[2] | ((unsigned)e[3] << 16); o.z = e[4] | ((unsigned)e[5] << 16); o.w = e[6] | ((unsigned)e[7] << 16);
                *(v4u*)(dst + ((size_t)((b * 16 + h) * 64 + dim)) * SEQ + r * ns + t0 / dl + ml) = o;
            }
        }
    }
}

DI int kperm(int r) { return (r & ~12) | ((r & 4) << 1) | ((r & 8) >> 1); }
DI int osw(int tok, int chunk) { return tok * 256 + (((chunk ^ tok ^ (tok >> 4)) & 15) << 4); }
struct AttnKV { bf16x8 k[4]; bf16x8 v[2][2]; };
DI void attn_load(AttnKV& t, const bf16* kb, const bf16* vb, int mk0, int kp, int DL) {
    const bf16* kr = kb + (size_t)(DL * (mk0 + kp)) * NQKV;
#pragma unroll
    for (int s = 0; s < 4; ++s) t.k[s] = *(const bf16x8*)(kr + 8 * s);
#pragma unroll
    for (int dt = 0; dt < 2; ++dt)
#pragma unroll
        for (int s = 0; s < 2; ++s) t.v[dt][s] = *(const bf16x8*)(vb + mk0 + (size_t)dt * 32 * SEQ + 16 * s);
}
DI void attn_step(const AttnKV& t, const bf16x8 (&qf)[4], f32x16& o0, f32x16& o1, float& m, float& l, const LAS float* bl, int rel0, int hh) {
    f32x16 sa;
#pragma unroll
    for (int i = 0; i < 16; ++i) sa[i] = 0.f;
#pragma unroll
    for (int s = 0; s < 4; ++s) sa = MFMA32(t.k[s], qf[s], sa);
    float sc[16]; float tmax = -1e30f;
#pragma unroll
    for (int i = 0; i < 16; ++i) { const int rel = rel0 + 16 * (i >> 3) + (i & 7);
        const bool valid = (rel >= -64) && (rel <= 64); const int idx = valid ? rel + 64 : 0;
        const float v = sa[i] + bl[idx]; sc[i] = valid ? v : -1e30f; tmax = fmaxf(tmax, sc[i]); }
    tmax = fmaxf(tmax, __shfl_xor(tmax, 32));
    const float mnew = fmaxf(m, tmax), alpha = fexp(m - mnew);
    float ps = 0.f; float p[16];
#pragma unroll
    for (int i = 0; i < 16; ++i) { p[i] = (sc[i] > -1e29f) ? fexp(sc[i] - mnew) : 0.f; ps += p[i]; }
    l = l * alpha + ps; m = mnew;
#pragma unroll
    for (int i = 0; i < 16; ++i) { o0[i] *= alpha; o1[i] *= alpha; }
#pragma unroll
    for (int s = 0; s < 2; ++s) {
        v4u w; w.x = pk2(p[8 * s], p[8 * s + 1]); w.y = pk2(p[8 * s + 2], p[8 * s + 3]); w.z = pk2(p[8 * s + 4], p[8 * s + 5]); w.w = pk2(p[8 * s + 6], p[8 * s + 7]);
        const bf16x8 pf = __builtin_bit_cast(bf16x8, w);
        o0 = MFMA32(t.v[0][s], pf, o0); o1 = MFMA32(t.v[1][s], pf, o1);
    }
}
template <int P> DI void attn_stage(Frame& F, int b, int h, int t0) {
    constexpr int DL = (P == 0) ? 1 : (P == 1 ? 4 : 16), NS = SEQ / DL;
    const bf16* QKV = (const bf16*)(F.ws + WS_QKV); const bf16* VT = (const bf16*)(F.ws + WS_VT) + (size_t)P * MTOK * DM; bf16* ATT = (bf16*)(F.ws + WS_ATT);
    LAS unsigned char* ol = F.lds; LAS float* ml = (LAS float*)(F.lds + 131072); LAS float* ll = ml + 512; const LAS float* bl = (const LAS float*)(F.lds + 135168) + P * 132;
    const int lane = F.lane, r32 = lane & 31, hh = lane >> 5, w = F.wave, kp = kperm(r32);
#pragma unroll 1
    for (int task = 0; task < 2; ++task) {
        asm volatile("" ::: "memory");
        int r, i0;
        if (P == 0) { r = 0; i0 = 64 * w + 32 * task; } else if (P == 1) { r = w & 3; i0 = 64 * (w >> 2) + 32 * task; } else { r = 2 * w + task; i0 = 0; }
        const int mq0 = t0 / DL + i0, tql = r + DL * (i0 + r32);
        bf16x8 qf[4];
        { const bf16* qp = QKV + (size_t)(b * SEQ + t0 + tql) * NQKV + h * 64 + 32 * hh;
#pragma unroll
          for (int s = 0; s < 4; ++s) qf[s] = *(const bf16x8*)(qp + 8 * s); }
        f32x16 o0, o1; float m, l;
        if (P == 0) {
#pragma unroll
            for (int i = 0; i < 16; ++i) { o0[i] = 0.f; o1[i] = 0.f; }
            m = -1e30f; l = 0.f;
        } else {
#pragma unroll
            for (int g = 0; g < 4; ++g) { const f32x4 a = *(const LAS f32x4*)(ol + osw(tql, 2 * g + hh)), c = *(const LAS f32x4*)(ol + osw(tql, 8 + 2 * g + hh));
                o0[4 * g] = a.x; o0[4 * g + 1] = a.y; o0[4 * g + 2] = a.z; o0[4 * g + 3] = a.w; o1[4 * g] = c.x; o1[4 * g + 1] = c.y; o1[4 * g + 2] = c.z; o1[4 * g + 3] = c.w; }
            m = ml[tql]; l = hh ? 0.f : ll[tql];
        }
        const bf16* kb = QKV + (size_t)(b * SEQ + r) * NQKV + 1024 + h * 64 + 32 * hh;
        const bf16* vb = VT + ((size_t)((b * 16 + h) * 64 + r32)) * SEQ + r * NS + 8 * hh;
        int relb = 8 * hh - 64 - r32;
        asm volatile("" : "+v"(relb));
        AttnKV ta, tb;
#define ATT_OK(kt) ((mq0 - 64 + 32 * (kt)) >= 0 && (mq0 - 64 + 32 * (kt)) < NS)
        if (ATT_OK(0)) attn_load(ta, kb, vb, mq0 - 64, kp, DL);
        if (ATT_OK(1)) attn_load(tb, kb, vb, mq0 - 32, kp, DL);
        if (ATT_OK(0)) attn_step(ta, qf, o0, o1, m, l, bl, relb, hh);
        if (ATT_OK(2)) attn_load(ta, kb, vb, mq0, kp, DL);
        if (ATT_OK(1)) attn_step(tb, qf, o0, o1, m, l, bl, relb + 32, hh);
        if (ATT_OK(3)) attn_load(tb, kb, vb, mq0 + 32, kp, DL);
        if (ATT_OK(2)) attn_step(ta, qf, o0, o1, m, l, bl, relb + 64, hh);
        if (ATT_OK(4)) attn_load(ta, kb, vb, mq0 + 64, kp, DL);
        if (ATT_OK(3)) attn_step(tb, qf, o0, o1, m, l, bl, relb + 96, hh);
        if (ATT_OK(4)) attn_step(ta, qf, o0, o1, m, l, bl, relb + 128, hh);
#undef ATT_OK
        const float lt = l + __shfl_xor(l, 32);
        if (P < 2) {
#pragma unroll
            for (int g = 0; g < 4; ++g) { *(LAS f32x4*)(ol + osw(tql, 2 * g + hh)) = (f32x4){o0[4 * g], o0[4 * g + 1], o0[4 * g + 2], o0[4 * g + 3]};
                *(LAS f32x4*)(ol + osw(tql, 8 + 2 * g + hh)) = (f32x4){o1[4 * g], o1[4 * g + 1], o1[4 * g + 2], o1[4 * g + 3]}; }
            if (hh == 0) { ml[tql] = m; ll[tql] = lt; }
        } else {
            const float inv = 1.f / lt;
            bf16* op = ATT + (size_t)(b * SEQ + t0 + tql) * DM + h * 64 + 4 * hh;
#pragma unroll
            for (int g = 0; g < 4; ++g) { v2u a, c; a.x = pk2(o0[4 * g] * inv, o0[4 * g + 1] * inv); a.y = pk2(o0[4 * g + 2] * inv, o0[4 * g + 3] * inv);
                c.x = pk2(o1[4 * g] * inv, o1[4 * g + 1] * inv); c.y = pk2(o1[4 * g + 2] * inv, o1[4 * g + 3] * inv);
                *(v2u*)(op + 8 * g) = a; *(v2u*)(op + 32 + 8 * g) = c; }
        }
    }
}
DI void phase_attn(Frame& F) {
    const float* BT = (const float*)(F.ws + WS_BT);
    LAS float* bl = (LAS float*)(F.lds + 135168);
    for (int u = F.bid; u < 512; u += F.G) {
        const int c = u & 15, h = (u >> 4) & 15, b = u >> 8, t0 = c * 512;
        __syncthreads();
        for (int i = F.tid; i < 3 * 129; i += NTHR) bl[(i / 129) * 132 + i % 129] = BT[((i / 129) * 16 + h) * 129 + i % 129];
        __syncthreads();
        attn_stage<0>(F, b, h, t0);
        __syncthreads();
        attn_stage<1>(F, b, h, t0);
        __syncthreads();
        attn_stage<2>(F, b, h, t0);
    }
}

constexpr int GL_QT = 0, GL_KT = 17408, GL_QB = 34816, GL_KHT = 52224, GL_VT = 70656, GL_P = 89088, GL_ST = 98304, GL_DEC = 133120, GL_TOT = 133632;
struct GlaRaw { float lf[16]; unsigned short q[16]; unsigned short v[16]; };
template <bool FULL> DI void gla_load_raw(GlaRaw& R, const float* LF, const bf16* Q, const bf16* V, int b, int h, int dir, int pos0, int ch) {
#pragma unroll
    for (int i = 0; i < 16; ++i) { const int ii = pos0 + i; const int tok = dir ? (SEQ - 1 - ii) : ii; const size_t off = (size_t)(b * SEQ + tok) * AW + h * 128 + ch;
        R.lf[i] = LF[off]; R.v[i] = V[off]; if (FULL) R.q[i] = Q[off]; }
}
template <bool FULL> DI float gla_prep(Frame& F, const GlaRaw& R) {
    LAS unsigned char* L = F.lds; LAS float* tot = (LAS float*)(L + GL_TOT);
    const int ch = F.tid & 127, qtr = F.tid >> 7;
    float c[16]; float run = 0.f;
#pragma unroll
    for (int i = 0; i < 16; ++i) { run += R.lf[i]; c[i] = run; }
    tot[qtr * 128 + ch] = run;
    __syncthreads();
    const float t0 = tot[ch], t1 = tot[128 + ch], t2 = tot[256 + ch], t3 = tot[384 + ch];
    const float off = (qtr > 0 ? t0 : 0.f) + (qtr > 1 ? t1 : 0.f) + (qtr > 2 ? t2 : 0.f), rr = t0 + t1, bend = (t0 + t1) + (t2 + t3);
    unsigned kh[8], vv[8];
#pragma unroll
    for (int i = 0; i < 16; i += 2) {
        const float b0 = off + c[i], b1 = off + c[i + 1];
        const float k0 = 1.f - fexp(R.lf[i]), k1 = 1.f - fexp(R.lf[i + 1]);
        kh[i >> 1] = pk2(k0 * fexp(bend - b0), k1 * fexp(bend - b1));
        vv[i >> 1] = (unsigned)R.v[i] | ((unsigned)R.v[i + 1] << 16);
        if (FULL) {
            const float q0 = bf2f(R.q[i]), q1 = bf2f(R.q[i + 1]);
            const int ta = 16 * qtr + i;
            *(LAS unsigned short*)(L + GL_QT + ta * 272 + 2 * ch) = (unsigned short)f2bf(q0 * fexp(b0 - rr));
            *(LAS unsigned short*)(L + GL_QT + (ta + 1) * 272 + 2 * ch) = (unsigned short)f2bf(q1 * fexp(b1 - rr));
            *(LAS unsigned short*)(L + GL_KT + ta * 272 + 2 * ch) = (unsigned short)f2bf(k0 * fexp(rr - b0));
            *(LAS unsigned short*)(L + GL_KT + (ta + 1) * 272 + 2 * ch) = (unsigned short)f2bf(k1 * fexp(rr - b1));
            *(LAS unsigned short*)(L + GL_QB + ta * 272 + 2 * ch) = (unsigned short)f2bf(q0 * fexp(b0));
            *(LAS unsigned short*)(L + GL_QB + (ta + 1) * 272 + 2 * ch) = (unsigned short)f2bf(q1 * fexp(b1));
        }
    }
    *(LAS v4u*)(L + GL_KHT + ch * 144 + 32 * qtr) = (v4u){kh[0], kh[1], kh[2], kh[3]}; *(LAS v4u*)(L + GL_KHT + ch * 144 + 32 * qtr + 16) = (v4u){kh[4], kh[5], kh[6], kh[7]};
    *(LAS v4u*)(L + GL_VT + ch * 144 + 32 * qtr) = (v4u){vv[0], vv[1], vv[2], vv[3]}; *(LAS v4u*)(L + GL_VT + ch * 144 + 32 * qtr + 16) = (v4u){vv[4], vv[5], vv[6], vv[7]};
    if (qtr == 0) *(LAS float*)(L + GL_DEC + 4 * ch) = fexp(bend);
    return bend;
}
DI bf16x8 gfrag(const LAS unsigned char* base, int row, int stride, int kel) { return *(const LAS bf16x8*)(base + row * stride + kel * 2); }
DI void gla_state_update(Frame& F, f32x16 (&S)[2]) {
    const LAS unsigned char* L = F.lds; const int r32 = F.lane & 31, hh = F.lane >> 5, vi = F.wave & 3, ki0 = 2 * (F.wave >> 2);
    bf16x8 a[4];
#pragma unroll
    for (int s = 0; s < 4; ++s) a[s] = gfrag(L + GL_VT, 32 * vi + r32, 144, 16 * s + 8 * hh);
#pragma unroll
    for (int q = 0; q < 2; ++q) { const int kr = 32 * (ki0 + q) + r32; const float d = *(const LAS float*)(L + GL_DEC + 4 * kr);
#pragma unroll
        for (int j = 0; j < 16; ++j) S[q][j] *= d;
#pragma unroll
        for (int s = 0; s < 4; ++s) S[q] = MFMA32(a[s], gfrag(L + GL_KHT, kr, 144, 16 * s + 8 * hh), S[q]); }
}
DI void gla_state_to_lds(Frame& F, const f32x16 (&S)[2]) {
    LAS unsigned char* L = F.lds; const int r32 = F.lane & 31, hh = F.lane >> 5, vi = F.wave & 3, ki0 = 2 * (F.wave >> 2);
#pragma unroll
    for (int q = 0; q < 2; ++q)
#pragma unroll
        for (int j = 0; j < 16; ++j) *(LAS unsigned short*)(L + GL_ST + (32 * vi + crow32(j, hh)) * 272 + 2 * (32 * (ki0 + q) + r32)) = (unsigned short)f2bf(S[q][j]);
}
DI void gla_unit_state(Frame& F, int u) {
    const int sc = u & 31, dir = (u >> 5) & 1, h = (u >> 6) & 3, b = u >> 8;
    const bf16* Q = (const bf16*)(F.ws + WS_Q); const bf16* V = (const bf16*)(F.ws + WS_V); const float* LF = (const float*)(F.ws + (dir ? WS_LFB : WS_LFF));
    float* ST = (float*)(F.ws + WS_ST) + (size_t)u * 16384; float* DEC = (float*)(F.ws + WS_DEC) + u * 128;
    const int ch = F.tid & 127, qtr = F.tid >> 7, r32 = F.lane & 31, hh = F.lane >> 5, vi = F.wave & 3, ki0 = 2 * (F.wave >> 2);
    f32x16 S[2];
#pragma unroll
    for (int j = 0; j < 16; ++j) { S[0][j] = 0.f; S[1][j] = 0.f; }
    float lsum = 0.f;
    GlaRaw cur, nxt;
    gla_load_raw<false>(cur, LF, Q, V, b, h, dir, sc * 256 + 16 * qtr, ch);
#pragma unroll 1
    for (int c = 0; c < 4; ++c) {
        __syncthreads();
        lsum += gla_prep<false>(F, cur);
        if (c < 3) gla_load_raw<false>(nxt, LF, Q, V, b, h, dir, sc * 256 + (c + 1) * 64 + 16 * qtr, ch);
        __syncthreads();
        gla_state_update(F, S);
        cur = nxt;
    }
#pragma unroll
    for (int q = 0; q < 2; ++q)
#pragma unroll
        for (int g = 0; g < 4; ++g) *(f32x4*)(ST + (size_t)(32 * (ki0 + q) + r32) * 128 + 32 * vi + 8 * g + 4 * hh) = (f32x4){S[q][4 * g], S[q][4 * g + 1], S[q][4 * g + 2], S[q][4 * g + 3]};
    if (qtr == 0) DEC[ch] = fexp(lsum);
}
DI void gla_unit_out(Frame& F, int u) {
    const int sc = u & 31, dir = (u >> 5) & 1, h = (u >> 6) & 3, b = u >> 8;
    const bf16* Q = (const bf16*)(F.ws + WS_Q); const bf16* V = (const bf16*)(F.ws + WS_V); const float* LF = (const float*)(F.ws + (dir ? WS_LFB : WS_LFF));
    const float* ST = (const float*)(F.ws + WS_ST) + (size_t)u * 16384; float* OD = (float*)(F.ws + WS_ODIR) + (size_t)dir * MTOK * AW;
    const LAS unsigned char* L = F.lds;
    const int ch = F.tid & 127, qtr = F.tid >> 7, r32 = F.lane & 31, hh = F.lane >> 5, w = F.wave, vi = w & 3, ki0 = 2 * (w >> 2), ti = w >> 2;
    f32x16 S[2];
#pragma unroll
    for (int q = 0; q < 2; ++q)
#pragma unroll
        for (int g = 0; g < 4; ++g) { const f32x4 t = *(const f32x4*)(ST + (size_t)(32 * (ki0 + q) + r32) * 128 + 32 * vi + 8 * g + 4 * hh); S[q][4 * g] = t.x; S[q][4 * g + 1] = t.y; S[q][4 * g + 2] = t.z; S[q][4 * g + 3] = t.w; }
    GlaRaw cur, nxt;
    gla_load_raw<true>(cur, LF, Q, V, b, h, dir, sc * 256 + 16 * qtr, ch);
    __syncthreads();
    gla_state_to_lds(F, S);
#pragma unroll 1
    for (int c = 0; c < 4; ++c) {
        (void)gla_prep<true>(F, cur);
        if (c < 3) gla_load_raw<true>(nxt, LF, Q, V, b, h, dir, sc * 256 + (c + 1) * 64 + 16 * qtr, ch);
        __syncthreads();
        f32x16 o;
#pragma unroll
        for (int j = 0; j < 16; ++j) o[j] = 0.f;
#pragma unroll
        for (int s = 0; s < 8; ++s) o = MFMA32(gfrag(L + GL_QB, 32 * ti + r32, 272, 16 * s + 8 * hh), gfrag(L + GL_ST, 32 * vi + r32, 272, 16 * s + 8 * hh), o);
        if (w < 3) {
            const int tp = (w + 1) >> 1, sp = (w == 2) ? 1 : 0;
            f32x16 p;
#pragma unroll
            for (int j = 0; j < 16; ++j) p[j] = 0.f;
#pragma unroll
            for (int s = 0; s < 8; ++s) p = MFMA32(gfrag(L + GL_QT, 32 * tp + r32, 272, 16 * s + 8 * hh), gfrag(L + GL_KT, 32 * sp + r32, 272, 16 * s + 8 * hh), p);
#pragma unroll
            for (int j = 0; j < 16; ++j) { const int t = 32 * tp + crow32(j, hh), s = 32 * sp + r32;
                *(LAS unsigned short*)(F.lds + GL_P + t * 144 + 2 * s) = (s <= t) ? (unsigned short)f2bf(p[j]) : (unsigned short)0; }
        }
        __syncthreads();
        { const int ns = ti ? 4 : 2;
#pragma unroll
          for (int s = 0; s < 4; ++s) if (s < ns) o = MFMA32(gfrag(L + GL_P, 32 * ti + r32, 144, 16 * s + 8 * hh), gfrag(L + GL_VT, 32 * vi + r32, 144, 16 * s + 8 * hh), o); }
#pragma unroll
        for (int j = 0; j < 16; ++j) { const int ii = sc * 256 + c * 64 + 32 * ti + crow32(j, hh); const int tok = dir ? (SEQ - 1 - ii) : ii;
            OD[(size_t)(b * SEQ + tok) * AW + h * 128 + 32 * vi + r32] = o[j]; }
        if (c < 3) { gla_state_update(F, S); gla_state_to_lds(F, S); }
        cur = nxt;
        __syncthreads();
    }
}

__global__ void __launch_bounds__(NTHR, 2) fwd_kernel(Args args) {
    extern __shared__ __attribute__((aligned(16))) unsigned char lds[];
    Frame F;
    F.lds = (LAS unsigned char*)lds;
    F.MISC = (volatile LAS unsigned*)(F.lds + MISC_OFF);
    F.tid = threadIdx.x; F.lane = F.tid & 63; F.wave = __builtin_amdgcn_readfirstlane(F.tid >> 6);
    F.G = gridDim.x; F.bid = blockIdx.x; F.gw = F.bid * NWAVES + F.wave; F.NGW = F.G * NWAVES;
    F.ws = args.ws;
    unsigned* ctl = (unsigned*)(args.ws + WS_CTL);
    for (int u = F.tid; u < (LDS_BYTES - LDSCTL_OFF) / 4; u += NTHR) ((LAS unsigned*)(F.lds + LDSCTL_OFF))[u] = 0u;
    __syncthreads();
    const int lo = args.ph_lo, hi = args.ph_hi;
    XcdBarrier bar; bar.bar = ctl + CW_BAR + args.li * XCD_BAR_WORDS; bar.x = 0; bar.st = nullptr;
    if (hi - lo > 1) bar = xcd_barrier_post(ctl + CW_BAR + args.li * XCD_BAR_WORDS, F.MISC + 8);
#define IN(k) (lo <= (k) && (k) < hi)
#ifndef PROBE_DUP
#define PROBE_DUP (-1)
#endif
#define REP(k) for (int rep_ = 0; rep_ < (((PROBE_DUP) == (k)) ? 2 : 1); ++rep_)
#define SEAM(k) do { if (IN(k) && IN((k) + 1)) xcd_barrier(bar); } while (0)
    unsigned char* ws = args.ws;
    float* XR = args.out;

    if (IN(0)) REP(0) { phase_prologue(F, args); } SEAM(0);
    if (IN(1)) REP(1) {
        pg8::Gemm g{(const bf16*)(ws + WS_H), (const bf16*)(ws + WS_WIN), MTOK, NIN, DM}; pg8::StaticOrder S; S.init(MTOK, NIN, F.G, F.bid);
        EpiInProj E{(bf16*)(ws + WS_U), (bf16*)(ws + WS_GV), (bf16*)(ws + WS_Q), (bf16*)(ws + WS_V), (bf16*)(ws + WS_G), (float*)(ws + WS_LFF), (float*)(ws + WS_LFB), (const float*)(ws + WS_LB)};
        pg8::gemm_phase<EpiInProj, pg8::StaticOrder, true, true>(F.lds, g, S, E);
    } SEAM(1);
    if (IN(2)) { phase_a_ln(F, args); REP(2) for (int u = F.bid; u < 512; u += F.G) gla_unit_state(F, u); } SEAM(2);
    if (IN(3)) { phase_gla_scan(F); REP(3) phase_a_mix(F, args); } SEAM(3);
    if (IN(4)) REP(4) { for (int u = F.bid; u < 512; u += F.G) gla_unit_out(F, u); } SEAM(4);
    if (IN(5)) REP(5) { phase_b_combine(F, args); } SEAM(5);
    if (IN(6)) REP(6) {
        pg8::Gemm g{(const bf16*)(ws + WS_CAT), (const bf16*)(ws + WS_WOUT), MTOK, DM, DM}; pg8::StaticOrder S; S.init(MTOK, DM, F.G, F.bid);
        EpiResid E{args.in[0], XR};
        pg8::gemm_phase<EpiResid, pg8::StaticOrder, false, true>(F.lds, g, S, E);
    } SEAM(6);
#define MOE_BLOCK(L, pb) do { \
        if (IN(pb)) REP(pb) { phase_router(F, XR, args.in[2] + (L) * DM, args.in[15] + (L) * DM * NEXP); } SEAM(pb); \
        if (IN((pb) + 1)) REP((pb) + 1) { phase_topk(F); } SEAM((pb) + 1); \
        if (IN((pb) + 2)) REP((pb) + 2) { phase_gather(F); } SEAM((pb) + 2); \
        if (IN((pb) + 3)) REP((pb) + 3) { \
            pg8::Gemm g{(const bf16*)(ws + WS_XE), (const bf16*)(ws + WS_WGU), NROWS, 16 * 2048, DM}; GroupedOrder<8> S{F.G, F.bid}; \
            EpiGateUp E{(bf16*)(ws + WS_HMID)}; \
            pg8::gemm_phase<EpiGateUp, GroupedOrder<8>, true, true>(F.lds, g, S, E); \
        } SEAM((pb) + 3); \
        if (IN((pb) + 4)) REP((pb) + 4) { \
            pg8::Gemm g{(const bf16*)(ws + WS_HMID), (const bf16*)(ws + WS_WDN), NROWS, 16 * 1024, DFF}; GroupedOrder<4> S{F.G, F.bid}; \
            EpiDown E{(bf16*)(ws + WS_Y), (const float*)(ws + WS_GATE)}; \
            pg8::gemm_phase<EpiDown, GroupedOrder<4>, true, true>(F.lds, g, S, E); \
        } SEAM((pb) + 4); \
    } while (0)

    MOE_BLOCK(0, 7);
    if (IN(12)) { phase_moe_combine(F, XR, args.in[1] + DM, false); REP(12) convert_moe_weights(F, args.in[16], args.in[17], args.in[18], 1); } SEAM(12);
    if (IN(13)) REP(13) {
        pg8::Gemm g{(const bf16*)(ws + WS_H), (const bf16*)(ws + WS_WQKV), MTOK, NQKV, DM}; pg8::StaticOrder S; S.init(MTOK, NQKV, F.G, F.bid);
        EpiQKV E{(bf16*)(ws + WS_QKV)};
        pg8::gemm_phase<EpiQKV, pg8::StaticOrder, true, true>(F.lds, g, S, E);
    } SEAM(13);
    if (IN(14)) REP(14) { phase_vt(F); } SEAM(14);
    if (IN(15)) REP(15) { phase_attn(F); } SEAM(15);
    if (IN(16)) {
        pg8::Gemm g{(const bf16*)(ws + WS_ATT), (const bf16*)(ws + WS_WO), MTOK, DM, DM}; pg8::StaticOrder S; S.init(MTOK, DM, F.G, F.bid);
        EpiResid E{XR, XR};
        pg8::gemm_phase<EpiResid, pg8::StaticOrder, false, true>(F.lds, g, S, E);
    } SEAM(16);
    MOE_BLOCK(1, 17);
    if (IN(22)) { phase_moe_combine(F, XR, args.in[3], true); }
#undef MOE_BLOCK
#undef IN
#undef SEAM
}

#ifndef MK_N_LAUNCHES
#define MK_N_LAUNCHES 1
#endif
extern "C" void kernel_launch(void* const* d_in, const int* in_sizes, int n_in, void* d_out, int out_size, void* d_ws, size_t ws_size, hipStream_t stream) {
    static int grid = 0;
    if (grid == 0) {
        if (n_in != 19 || in_sizes[0] != MTOK * DM || out_size != MTOK * DM || ws_size < WS_END) { fprintf(stderr, "kernel_launch: unexpected shapes (n_in %d, in0 %d, out %d, ws %zu < %zu); nothing launched\n", n_in, n_in > 0 ? in_sizes[0] : -1, out_size, ws_size, (size_t)WS_END); grid = -1; return; }
        int dev = 0, cus = 0, per_cu = 0;
        if (hipGetDevice(&dev) != hipSuccess || hipDeviceGetAttribute(&cus, hipDeviceAttributeMultiprocessorCount, dev) != hipSuccess) { grid = -1; return; }
        if (hipFuncSetAttribute((const void*)fwd_kernel, hipFuncAttributeMaxDynamicSharedMemorySize, LDS_BYTES) != hipSuccess) { fprintf(stderr, "kernel_launch: hipFuncSetAttribute failed\n"); grid = -1; return; }
        if (hipOccupancyMaxActiveBlocksPerMultiprocessor(&per_cu, (const void*)fwd_kernel, NTHR, LDS_BYTES) != hipSuccess || per_cu < 1) { fprintf(stderr, "kernel_launch: occupancy query reports %d workgroups per CU\n", per_cu); }
        (void)hipGetLastError();
        grid = cus;
    }
    if (grid < 0) return;
    if (hipMemsetAsync((char*)d_ws + WS_CTL, 0, CTL_ZERO_BYTES, stream) != hipSuccess) return;
    Args a{};
    for (int i = 0; i < 19; ++i) a.in[i] = (const float*)d_in[i];
    a.out = (float*)d_out; a.ws = (unsigned char*)d_ws; a.pad = 0;
    static_assert(CW_BAR + MAX_BAR_REGIONS * XCD_BAR_WORDS <= (int)(CTL_ZERO_BYTES / 4), "barrier regions inside the memset region");
    const int nl = MK_N_LAUNCHES;
    for (int li = 0; li < nl; ++li) {
        a.ph_lo = (int)((long)NPHASE * li / nl); a.ph_hi = (int)((long)NPHASE * (li + 1) / nl); a.li = li;
        hipLaunchKernelGGL(fwd_kernel, dim3(grid), dim3(NTHR), LDS_BYTES, stream, a);
        const hipError_t le = hipPeekAtLastError();
        if (le != hipSuccess) { fprintf(stderr, "kernel_launch: launch %d failed: %s\n", li, hipGetErrorName(le)); break; }
    }
}
```

```cpp
#include <hip/hip_runtime.h>
#include <cstdio>
#include <cstdint>
namespace pg8 {
#define PG8_LAS __attribute__((address_space(3)))
typedef unsigned short bf16_t;
typedef short bf16x8 __attribute__((ext_vector_type(8)));
typedef float f32x4 __attribute__((ext_vector_type(4)));
typedef unsigned u32x4 __attribute__((ext_vector_type(4)));
constexpr int BM = 256, BK = 64, HALF = 128, HTB = HALF * BK * 2  , STAGE_BYTES = 8 * HTB, NXCD = 8, WGM = 8;

__host__ __device__ __forceinline__ int lds_byte(int r, int c) { const int st = (r >> 4) * 2 + (c >> 5), rr = r & 15, cc = c & 31, ob = rr * 64 + cc * 2; return st * 1024 + (ob ^ (((ob >> 9) & 1) << 5)); }
__host__ __device__ __forceinline__ void stage_rc(int b, int& R, int& C) { const int st = b / 1024, sb = b % 1024, swz = sb ^ (((sb >> 9) & 1) << 5); R = (st >> 1) * 16 + swz / 64; C = (st & 1) * 32 + (swz % 64) / 2; }
__host__ __device__ __forceinline__ int perm32(int rho) { const int n = rho >> 4, i = rho & 15; return 8 * (i >> 2) + 4 * n + (i & 3); }

struct Unit { int pm, pn; };
struct Gemm { const bf16_t* A; const bf16_t* Bt; int M, N, K; };

struct StaticOrder {
    int nM, nN, nwg, G, c;
    __host__ __device__ void init(int M, int N, int G_, int c_) { nM = M / BM; nN = N / BM; nwg = nM * nN; G = G_; c = c_; }
    __host__ __device__ bool next(int i, Unit& u) const {
        const long L = (long)i * G + c; if (L >= nwg) return false;
        int wgid = (int)L; { const int q = nwg / NXCD, r = nwg % NXCD, xcd = wgid % NXCD, off = wgid / NXCD; wgid = (xcd < r ? xcd * (q + 1) : r * (q + 1) + (xcd - r) * q) + off; }
        const int nig = WGM * nN, gid = wgid / nig, fm = gid * WGM, gsz = (nM - fm) < WGM ? (nM - fm) : WGM;
        u.pm = fm + ((wgid % nig) % gsz); u.pn = (wgid % nig) / gsz; return true;
    }
    __device__ __forceinline__ void a_ready(const Unit&) const {}
    __device__ __forceinline__ void done(const Unit&) const {}
};

__device__ __forceinline__ unsigned cvt_pk_bf16(float lo, float hi) { unsigned r; asm volatile("v_cvt_pk_bf16_f32 %0, %1, %2" : "=v"(r) : "v"(lo), "v"(hi)); return r; }
typedef float f32x2 __attribute__((ext_vector_type(2)));
__device__ __forceinline__ f32x2 gelu_pk(f32x2 v) {
    const f32x2 av = __builtin_elementwise_abs(v), d = av * 0.2316418882f + 1.0f;
    f32x2 t; t.x = __builtin_amdgcn_rcpf(d.x); t.y = __builtin_amdgcn_rcpf(d.y);
    f32x2 q = t * 0.5307027145f + (-0.7265760135f); q = q * t + 0.7107068705f; q = q * t + (-0.142248368f); q = q * t + 0.127414796f; q = q * t;
    const f32x2 s = (v * v) * (-0.72134752044f);
    f32x2 e; e.x = __builtin_amdgcn_exp2f(s.x); e.y = __builtin_amdgcn_exp2f(s.y);
    const f32x2 m = v * (q * e), r = v - m;
    f32x2 o; o.x = v.x < 0.f ? m.x : r.x; o.y = v.y < 0.f ? m.y : r.y; return o;
}

template <int ACT  > struct EpiBf16 {
    static constexpr bool PERM = true, AFTER_DRAIN = false; static_assert(ACT == 0 || ACT == 1, "EpiBf16: ACT is 0 (none) or 1 (gelu_pk)");
    bf16_t* O; int ldc; const float* bias; int split_cols; size_t split_stride; float scale0;
    __device__ __forceinline__ void operator()(const f32x4 (&acc)[2][2][4][2], const Unit& u, int wr, int wc, int fr, int fq) const {
        const int row0 = u.pm * BM + wr * 64 + fr; int colt = u.pn * BM; bf16_t* base = O;
        float sc = 1.f; if (split_cols) { const int t = colt / split_cols; base += (size_t)t * split_stride; colt -= t * split_cols; if (t == 0) sc = scale0; }
        const int col0 = colt + wc * 32 + 8 * fq, bcol0 = u.pn * BM + wc * 32 + 8 * fq;
        f32x4 bv[2][2];
#pragma unroll
        for (int bj = 0; bj < 2; ++bj)
#pragma unroll
            for (int n = 0; n < 2; ++n) bv[bj][n] = bias ? *(const f32x4*)(bias + bcol0 + bj * HALF + 4 * n) : (f32x4){0.f, 0.f, 0.f, 0.f};
#pragma unroll
        for (int ai = 0; ai < 2; ++ai)
#pragma unroll
            for (int m = 0; m < 4; ++m) { bf16_t* rowp = base + (size_t)(row0 + ai * HALF + m * 16) * ldc + col0;
#pragma unroll
                for (int bj = 0; bj < 2; ++bj) { f32x4 v0 = acc[ai][bj][m][0] + bv[bj][0], v1 = acc[ai][bj][m][1] + bv[bj][1];
                    if (ACT == 1) { f32x2 a = gelu_pk((f32x2){v0[0], v0[1]}), b = gelu_pk((f32x2){v0[2], v0[3]}), c = gelu_pk((f32x2){v1[0], v1[1]}), d = gelu_pk((f32x2){v1[2], v1[3]});
                        v0 = (f32x4){a.x, a.y, b.x, b.y}; v1 = (f32x4){c.x, c.y, d.x, d.y}; }
                    v0 = v0 * sc; v1 = v1 * sc; u32x4 w; w.x = cvt_pk_bf16(v0[0], v0[1]); w.y = cvt_pk_bf16(v0[2], v0[3]); w.z = cvt_pk_bf16(v1[0], v1[1]); w.w = cvt_pk_bf16(v1[2], v1[3]);
                    *(u32x4*)(rowp + bj * HALF) = w; } }
    }
};
template <class Epi, class Sched, bool ALIGN_EPI = false, bool SP2 = false, bool GATHER = false>
__device__ __forceinline__ void gemm_phase(PG8_LAS unsigned char* lds, const Gemm g, const Sched& S, const Epi& E, const PG8_LAS int* rowtab = nullptr) {
    const int tid = threadIdx.x, wid = __builtin_amdgcn_readfirstlane(tid >> 6), lane = tid & 63, wr = wid >> 2, wc = wid & 3, fr = lane & 15, fq = lane >> 4;
    const int K = g.K, nt = K / BK;
    unsigned voffA[2], voffB[2]; int gR[2], gC[2];
#pragma unroll
    for (int i = 0; i < 2; ++i) { int R, C; stage_rc(tid * 16 + i * 8192, R, C); const int Rb = Epi::PERM ? ((R & ~31) + perm32(R & 31)) : R;
        voffA[i] = (unsigned)(R * K + C) * 2u; voffB[i] = (unsigned)(Rb * K + C) * 2u; gR[i] = R; gC[i] = C; }
    unsigned vC[2][2] = {{0u, 0u}, {0u, 0u}}, vN[2][2] = {{0u, 0u}, {0u, 0u}};
#define PG8_ROWS(dst, ui_) do { _Pragma("unroll") for (int _h = 0; _h < 2; ++_h) _Pragma("unroll") for (int _i = 0; _i < 2; ++_i) \
        dst[_h][_i] = (unsigned)(rowtab[(ui_) * 256 + _h * 128 + gR[_i]] * K + gC[_i]) * 2u; } while (0)
    const size_t kstep = (size_t)(BK * 2);
    const size_t hstep = (size_t)HALF * K * 2;
    const size_t tstep = 2 * hstep;
    const unsigned ldsw = (unsigned)wid * 1024u;
    const int aoff = lds_byte(wr * 64 + fr, fq * 8), boff = lds_byte(wc * 32 + fr, fq * 8);
#define PG8_SA(b, h) (((b) * 2 + (h)) * HTB)
#define PG8_SB(b, h) ((4 + (b) * 2 + (h)) * HTB)
#define PG8_STAGE(bufoff, gbase, voff) do { _Pragma("unroll") for (int _i = 0; _i < 2; ++_i) \
        __builtin_amdgcn_global_load_lds((const unsigned*)((const char*)(gbase) + (voff)[_i]), (PG8_LAS unsigned*)(lds + (bufoff) + ldsw + _i * 8192), 16, 0, 0); } while (0)
#define PG8_STGA(bufoff, abase, half, V) do { _Pragma("unroll") for (int _i = 0; _i < 2; ++_i) \
        __builtin_amdgcn_global_load_lds((const unsigned*)((const char*)(abase) + (GATHER ? (size_t)V[half][_i] : (size_t)((half) ? hstep : 0) + voffA[_i])), (PG8_LAS unsigned*)(lds + (bufoff) + ldsw + _i * 8192), 16, 0, 0); } while (0)
#define PG8_LDA(dst, b, h) do { _Pragma("unroll") for (int m = 0; m < 4; ++m) _Pragma("unroll") for (int k = 0; k < 2; ++k) dst[m][k] = *(const PG8_LAS bf16x8*)(lds + PG8_SA(b, h) + aoff + m * 2048 + k * 1024); } while (0)
#define PG8_LDB(dst, b, h) do { _Pragma("unroll") for (int n = 0; n < 2; ++n) _Pragma("unroll") for (int k = 0; k < 2; ++k) dst[n][k] = *(const PG8_LAS bf16x8*)(lds + PG8_SB(b, h) + boff + n * 2048 + k * 1024); } while (0)
#define PG8_MMA(ai, bj, At, Bt) do { __builtin_amdgcn_s_setprio(1); _Pragma("unroll") for (int m = 0; m < 4; ++m) _Pragma("unroll") for (int n = 0; n < 2; ++n) _Pragma("unroll") for (int k = 0; k < 2; ++k) \
        acc[ai][bj][m][n] = __builtin_amdgcn_mfma_f32_16x16x32_bf16(Bt[n][k], At[m][k], acc[ai][bj][m][n], 0, 0, 0); __builtin_amdgcn_s_setprio(0); } while (0)
#define PG8_WAIT_V(n) asm volatile("s_waitcnt vmcnt(" #n ")" ::: "memory")
#define PG8_WAIT_L(n) asm volatile("s_waitcnt lgkmcnt(" #n ")" ::: "memory")
#define PG8_BAR __builtin_amdgcn_s_barrier()
#define PG8_SCHED __builtin_amdgcn_sched_barrier(0)
    Unit cur, nxt; int ui = 0;
    if (!S.next(0, cur)) return;
    f32x4 acc[2][2][4][2];
#pragma unroll
    for (int a = 0; a < 2; ++a)
#pragma unroll
        for (int b = 0; b < 2; ++b)
#pragma unroll
            for (int m = 0; m < 4; ++m)
#pragma unroll
                for (int n = 0; n < 2; ++n) acc[a][b][m][n] = (f32x4){0.f, 0.f, 0.f, 0.f};
    bf16x8 At[4][2], B0[2][2], B1[2][2];
    const char* cA = (const char*)g.A + (GATHER ? (size_t)0 : (size_t)cur.pm * tstep); if constexpr (GATHER) PG8_ROWS(vC, 0);
    const char* cB = (const char*)g.Bt + (size_t)cur.pn * tstep;
    S.a_ready(cur);
    if constexpr (SP2) {
        PG8_STAGE(PG8_SB(0, 0), cB, voffB); PG8_STAGE(PG8_SB(0, 1), cB + hstep, voffB); PG8_STGA(PG8_SA(0, 0), cA, 0, vC); PG8_STGA(PG8_SA(0, 1), cA, 1, vC);
        if (wr == 1) PG8_BAR;
        PG8_WAIT_V(2); PG8_BAR;
        PG8_STAGE(PG8_SB(1, 0), cB + kstep, voffB); PG8_STGA(PG8_SA(1, 0), cA + kstep, 0, vC); PG8_STAGE(PG8_SB(1, 1), cB + hstep + kstep, voffB);
        PG8_WAIT_V(6); PG8_BAR;
    } else {
        PG8_STAGE(PG8_SB(0, 0), cB, voffB); PG8_STGA(PG8_SA(0, 0), cA, 0, vC); PG8_STAGE(PG8_SB(0, 1), cB + hstep, voffB); PG8_STGA(PG8_SA(0, 1), cA, 1, vC);
        if (wr == 1) PG8_BAR;
        PG8_WAIT_V(4); PG8_BAR;
        PG8_STAGE(PG8_SB(1, 0), cB + kstep, voffB); PG8_STGA(PG8_SA(1, 0), cA + kstep, 0, vC); PG8_STAGE(PG8_SB(1, 1), cB + hstep + kstep, voffB);
        PG8_WAIT_V(6); PG8_BAR;
    }
    for (;;) {
        const bool has_next = S.next(ui + 1, nxt);
        const char* nA = (has_next && !GATHER) ? (const char*)g.A + (size_t)nxt.pm * tstep : cA;
        if constexpr (GATHER) { if (has_next) PG8_ROWS(vN, ui + 1); else { _Pragma("unroll") for (int _h = 0; _h < 2; ++_h) _Pragma("unroll") for (int _i = 0; _i < 2; ++_i) vN[_h][_i] = vC[_h][_i]; } }
        const char* nB = has_next ? (const char*)g.Bt + (size_t)nxt.pn * tstep : cB;
        for (int t = 0; t < nt; t += 2) {
            const bool last = (t == nt - 2);
            unsigned vX[2][2];
            _Pragma("unroll") for (int _h = 0; _h < 2; ++_h) _Pragma("unroll") for (int _i = 0; _i < 2; ++_i) vX[_h][_i] = last ? vN[_h][_i] : vC[_h][_i];
            const char* a1 = cA + (size_t)(t + 1) * kstep;
            const char* a2 = last ? nA : cA + (size_t)(t + 2) * kstep; const char* b2 = last ? nB : cB + (size_t)(t + 2) * kstep;
            const char* a3 = a2 + kstep; const char* b3 = b2 + kstep;
            if (last && has_next) S.a_ready(nxt);
            if constexpr (SP2) {
            PG8_LDB(B0, 0, 0); PG8_LDB(B1, 0, 1); PG8_SCHED; PG8_LDA(At, 0, 0); PG8_STGA(PG8_SA(1, 1), a1, 1, vC);
            PG8_WAIT_V(8); PG8_WAIT_L(0); PG8_BAR; PG8_MMA(0, 0, At, B0); PG8_MMA(0, 1, At, B1); PG8_BAR; PG8_SCHED;
            PG8_LDA(At, 0, 1); PG8_STAGE(PG8_SB(0, 0), b2, voffB); PG8_STAGE(PG8_SB(0, 1), b2 + hstep, voffB); PG8_STGA(PG8_SA(0, 0), a2, 0, vX);
            PG8_WAIT_V(8); PG8_WAIT_L(0); PG8_BAR; PG8_MMA(1, 0, At, B0); PG8_MMA(1, 1, At, B1); PG8_BAR; PG8_SCHED;
            PG8_LDB(B0, 1, 0); PG8_LDB(B1, 1, 1); PG8_SCHED; PG8_LDA(At, 1, 0); PG8_STGA(PG8_SA(0, 1), a2, 1, vX);
            PG8_WAIT_V(8); PG8_WAIT_L(0); PG8_BAR; PG8_MMA(0, 0, At, B0); PG8_MMA(0, 1, At, B1); PG8_BAR; PG8_SCHED;
            PG8_LDA(At, 1, 1); PG8_STAGE(PG8_SB(1, 0), b3, voffB); PG8_STAGE(PG8_SB(1, 1), b3 + hstep, voffB); PG8_STGA(PG8_SA(1, 0), a3, 0, vX);
            PG8_WAIT_V(8); PG8_WAIT_L(0); PG8_BAR; PG8_MMA(1, 0, At, B0); PG8_MMA(1, 1, At, B1); PG8_BAR; PG8_SCHED;
            } else {
            PG8_LDB(B0, 0, 0); PG8_SCHED; PG8_LDA(At, 0, 0); PG8_STGA(PG8_SA(1, 1), a1, 1, vC);
            PG8_WAIT_L(8); PG8_BAR; PG8_WAIT_L(0); PG8_MMA(0, 0, At, B0); PG8_BAR; PG8_SCHED;
            PG8_LDB(B1, 0, 1); PG8_STAGE(PG8_SB(0, 0), b2, voffB);
            PG8_BAR; PG8_WAIT_L(0); PG8_MMA(0, 1, At, B1); PG8_BAR;
            PG8_LDA(At, 0, 1); PG8_STGA(PG8_SA(0, 0), a2, 0, vX);
            PG8_BAR; PG8_WAIT_L(0); PG8_MMA(1, 0, At, B0); PG8_BAR; PG8_SCHED;
            PG8_STAGE(PG8_SB(0, 1), b2 + hstep, voffB);
            PG8_WAIT_V(6); PG8_BAR; PG8_MMA(1, 1, At, B1); PG8_BAR;
            PG8_LDB(B0, 1, 0); PG8_SCHED; PG8_LDA(At, 1, 0); PG8_STGA(PG8_SA(0, 1), a2, 1, vX);
            PG8_WAIT_L(8); PG8_BAR; PG8_WAIT_L(0); PG8_MMA(0, 0, At, B0); PG8_BAR; PG8_SCHED;
            PG8_LDB(B1, 1, 1); PG8_STAGE(PG8_SB(1, 0), b3, voffB);
            PG8_BAR; PG8_WAIT_L(0); PG8_MMA(0, 1, At, B1); PG8_BAR;
            PG8_LDA(At, 1, 1); PG8_STGA(PG8_SA(1, 0), a3, 0, vX);
            PG8_BAR; PG8_WAIT_L(0); PG8_MMA(1, 0, At, B0); PG8_BAR; PG8_SCHED;
            PG8_STAGE(PG8_SB(1, 1), b3 + hstep, voffB);
            PG8_WAIT_V(6); PG8_BAR; PG8_MMA(1, 1, At, B1); PG8_BAR;
            }
        }
        if constexpr (ALIGN_EPI) { if (wr == 0) PG8_BAR; }
        if constexpr (!Epi::AFTER_DRAIN) { E(acc, cur, wr, wc, fr, fq); S.done(cur); }
        if (!has_next) break;
#pragma unroll
        for (int a = 0; a < 2; ++a)
#pragma unroll
            for (int b = 0; b < 2; ++b)
#pragma unroll
                for (int m = 0; m < 4; ++m)
#pragma unroll
                    for (int n = 0; n < 2; ++n) acc[a][b][m][n] = (f32x4){0.f, 0.f, 0.f, 0.f};
        cur = nxt; cA = nA; cB = nB; ++ui;
        if constexpr (GATHER) { _Pragma("unroll") for (int _h = 0; _h < 2; ++_h) _Pragma("unroll") for (int _i = 0; _i < 2; ++_i) vC[_h][_i] = vN[_h][_i]; }
        if constexpr (ALIGN_EPI) { if (wr == 1) PG8_BAR; }
    }
    PG8_WAIT_V(0);
    if constexpr (!ALIGN_EPI) { if (wr == 0) PG8_BAR; }
    PG8_BAR;
    if constexpr (Epi::AFTER_DRAIN) { E.fused(acc, cur, wr, wc, fr, fq, lds, wid, lane); S.done(cur); }
#undef PG8_SA
#undef PG8_SB
#undef PG8_STAGE
#undef PG8_STGA
#undef PG8_ROWS
#undef PG8_LDA
#undef PG8_LDB
#undef PG8_MMA
#undef PG8_WAIT_V
#undef PG8_WAIT_L
#undef PG8_BAR
#undef PG8_SCHED
}
}
#define LAS __attribute__((address_space(3)))
#define DI __device__ __forceinline__
typedef unsigned short bf16;
typedef unsigned v4u __attribute__((ext_vector_type(4)));
typedef unsigned v2u __attribute__((ext_vector_type(2)));
typedef float f32x4 __attribute__((ext_vector_type(4)));
typedef short bf16x8 __attribute__((ext_vector_type(8)));
#define LDS_WAIT() asm volatile("s_waitcnt lgkmcnt(0)" ::: "memory")
#define VM_WAIT() asm volatile("s_waitcnt vmcnt(0)" ::: "memory")
DI unsigned f2bf(float f) { unsigned u = __builtin_bit_cast(unsigned, f); return (u + 0x7fffu + ((u >> 16) & 1u)) >> 16; }
typedef float f32x2_t __attribute__((ext_vector_type(2))); typedef __bf16 bf16x2_t __attribute__((ext_vector_type(2)));
DI unsigned pk2(float lo, float hi) { f32x2_t v = {lo, hi}; bf16x2_t b = __builtin_convertvector(v, bf16x2_t); return __builtin_bit_cast(unsigned, b); }
DI float bf2f(unsigned b) { return __builtin_bit_cast(float, b << 16); }
DI float bflo(unsigned w) { return __builtin_bit_cast(float, w << 16); }
DI float bfhi(unsigned w) { return __builtin_bit_cast(float, w & 0xffff0000u); }
DI float fexp(float x) { return __builtin_amdgcn_exp2f(x * 1.4426950408889634f); }
DI float flog(float x) { return __builtin_amdgcn_logf(x) * 0.6931471805599453f; }
DI float frcp(float x) { return __builtin_amdgcn_rcpf(x); }
DI float sigmoidf_(float x) { return frcp(1.f + fexp(-x)); }
DI float siluf_(float x) { return x * sigmoidf_(x); }
DI float gelu_tanh(float x) { const float u = 0.7978845608028654f * (x + 0.044715f * x * x * x); return x * sigmoidf_(2.f * u); }
DI float wave_sum(float v) {
#pragma unroll
    for (int o = 1; o < 64; o <<= 1) v += __shfl_xor(v, o);
    return v;
}
DI float wave_max(float v) {
#pragma unroll
    for (int o = 1; o < 64; o <<= 1) v = fmaxf(v, __shfl_xor(v, o));
    return v;
}
DI int red16_idx(int lane) { return 8 * ((lane >> 5) & 1) + 4 * ((lane >> 4) & 1) + 2 * ((lane >> 3) & 1) + ((lane >> 2) & 1); }
DI float red16(const float (&o)[16], int lane) {
    const bool b32 = lane & 32, b16 = lane & 16, b8 = lane & 8, b4 = lane & 4;
    float a8[8], a4[4], a2[2], a1;
#pragma unroll
    for (int j = 0; j < 8; ++j) { const float send = b32 ? o[j] : o[j + 8], keep = b32 ? o[j + 8] : o[j]; a8[j] = keep + __shfl_xor(send, 32); }
#pragma unroll
    for (int j = 0; j < 4; ++j) { const float send = b16 ? a8[j] : a8[j + 4], keep = b16 ? a8[j + 4] : a8[j]; a4[j] = keep + __shfl_xor(send, 16); }
#pragma unroll
    for (int j = 0; j < 2; ++j) { const float send = b8 ? a4[j] : a4[j + 2], keep = b8 ? a4[j + 2] : a4[j]; a2[j] = keep + __shfl_xor(send, 8); }
    { const float send = b4 ? a2[0] : a2[1], keep = b4 ? a2[1] : a2[0]; a1 = keep + __shfl_xor(send, 4); }
    a1 += __shfl_xor(a1, 2); a1 += __shfl_xor(a1, 1);
    return a1;
}
#define XB_TMO      128
#define XB_XCNT(j)  (256  + 64 * (j))
#define XB_XSUB(j)  (1280 + 64 * (j))
#define XB_XGEN(j)  (2304 + 64 * (j))
#define XB_TOP      3328
#define XB_TOPGEN   3392
#define XCD_BAR_WORDS 3456
#define XB_SPIN_CAP (1u << 18)

__device__ __forceinline__ unsigned xb_ld(unsigned* p)              { return __hip_atomic_load(p, __ATOMIC_RELAXED, __HIP_MEMORY_SCOPE_AGENT); }
__device__ __forceinline__ unsigned xb_add(unsigned* p, unsigned v) { return __hip_atomic_fetch_add(p, v, __ATOMIC_RELAXED, __HIP_MEMORY_SCOPE_AGENT); }
__device__ __forceinline__ unsigned xb_xcc_id() { return (unsigned)__builtin_amdgcn_s_getreg((3 << 11) | 20) & 0xFu; }
#define XB_SPIN(cond, bar) do { unsigned _sp = 0; while (cond) { __builtin_amdgcn_s_sleep(1); \
    if ((++_sp & 255u) == 0u) { if (xb_ld(&(bar)[XB_TMO])) break; if (_sp > XB_SPIN_CAP) { atomicAdd(&(bar)[XB_TMO], 1u); break; } } } } while (0)

struct XcdBarrier {
    unsigned* bar; unsigned x;
    volatile LAS unsigned* st;
};

__device__ __forceinline__ XcdBarrier xcd_barrier_post(unsigned* bar, volatile LAS unsigned* st) {
    XcdBarrier b; b.bar = bar; b.x = xb_xcc_id(); b.st = st;
    if (threadIdx.x == 0) (void)xb_add(&bar[XB_XCNT(b.x)], 1u);
    return b;
}
__device__ __forceinline__ void xcd_barrier_complete(unsigned* bar, unsigned x, unsigned& nloc, unsigned& nx) {
    const unsigned G = gridDim.x * gridDim.y * gridDim.z;
    unsigned sum, cnt, mine, sp = 0u;
    for (;;) {
        sum = 0u; cnt = 0u; mine = 0u;
#pragma unroll
        for (unsigned j = 0; j < 16; ++j) { const unsigned c = xb_ld(&bar[XB_XCNT(j)]); sum += c; cnt += (c > 0u) ? 1u : 0u; mine = (j == x) ? c : mine; }
        if (sum == G) break;
        __builtin_amdgcn_s_sleep(1);
        if ((++sp & 255u) == 0u) { if (xb_ld(&bar[XB_TMO])) break; if (sp > XB_SPIN_CAP) { atomicAdd(&bar[XB_TMO], 1u); break; } }
    }
    nloc = mine > 0u ? mine : 1u; nx = cnt > 0u ? cnt : 1u;
}

__device__ __forceinline__ void xcd_barrier(const XcdBarrier& b) {
    asm volatile("s_waitcnt vmcnt(0)" ::: "memory");
    __syncthreads();
    if (threadIdx.x == 0) {
        unsigned* bar = b.bar;
        __builtin_amdgcn_s_waitcnt(0);
        unsigned nloc = b.st[0], nx = b.st[1];
        if (nloc == 0u) { xcd_barrier_complete(bar, b.x, nloc, nx); b.st[0] = nloc; b.st[1] = nx; }
        const unsigned old = xb_add(&bar[XB_XSUB(b.x)], 1u);
        const unsigned gen = old / nloc;
        if (old + 1u == (gen + 1u) * nloc) {
            __builtin_amdgcn_fence(__ATOMIC_RELEASE, "agent");
            asm volatile("s_waitcnt vmcnt(0)" ::: "memory");
            const unsigned og = xb_add(&bar[XB_TOP], 1u);
            const unsigned tg = og / nx;
            if (og + 1u == (tg + 1u) * nx) xb_add(&bar[XB_TOPGEN], 1u);
            else XB_SPIN(xb_ld(&bar[XB_TOPGEN]) == tg, bar);
            __builtin_amdgcn_fence(__ATOMIC_ACQUIRE, "agent");
            xb_add(&bar[XB_XGEN(b.x)], 1u);
            asm volatile("s_waitcnt vmcnt(0)" ::: "memory");
        } else {
            XB_SPIN(xb_ld(&bar[XB_XGEN(b.x)]) == gen, bar);
            __builtin_amdgcn_fence(__ATOMIC_ACQUIRE, "agent");
            asm volatile("s_waitcnt vmcnt(0)" ::: "memory");
        }
    }
    __syncthreads();
}
constexpr int NWAVES = 8, NTHR = 512;
constexpr int BATCH = 2, SEQ = 8192, DM = 1024, MTOK = BATCH * SEQ;
constexpr int NIN = 3584;
constexpr int AW = 512;
constexpr int NEXP = 16, DFF = 1024, CAP = 1024, NROWS = BATCH * NEXP * CAP;
constexpr int NSC = 32, SCLEN = 256;
constexpr int NHEAD = 16, HD = 64, NQKV = 3072;
constexpr float EPS = 1e-6f;
constexpr int NPHASE = 21;

constexpr size_t MiB = 1u << 20;
constexpr size_t WS_CTL = 0, CTL_ZERO_BYTES = 1 * MiB;
constexpr size_t WS_AFF = 1 * MiB;
constexpr size_t WS_POS = 2 * MiB;
constexpr size_t WS_IDX = 3 * MiB;
constexpr size_t WS_GATE = 3 * MiB + 256 * 1024;
constexpr size_t WS_DEC = 3 * MiB + 512 * 1024;
constexpr size_t WS_LB = 4 * MiB;
constexpr size_t WS_BT = 4 * MiB + 64 * 1024;
constexpr size_t WS_WIN = 8 * MiB;
constexpr size_t WS_WOUT = 15 * MiB;
constexpr size_t WS_WQKV = 17 * MiB;
constexpr size_t WS_WO = 23 * MiB;
constexpr size_t WS_WSB = 25 * MiB;
constexpr size_t WS_WGU = 32 * MiB;
constexpr size_t WS_WDN = 96 * MiB;
constexpr size_t WS_H = 128 * MiB;
constexpr size_t WS_R1 = 160 * MiB;
constexpr size_t WS_U = WS_R1, WS_GV = WS_R1 + 16 * MiB, WS_Q = WS_R1 + 32 * MiB, WS_V = WS_R1 + 48 * MiB, WS_G = WS_R1 + 64 * MiB;
constexpr size_t WS_LFF = WS_R1 + 80 * MiB, WS_LFB = WS_R1 + 112 * MiB;
constexpr size_t WS_CAT = WS_R1 + 144 * MiB;
constexpr size_t WS_ST = WS_R1 + 176 * MiB;
constexpr size_t WS_ODIR = WS_R1 + 208 * MiB;
constexpr size_t WS_XE = WS_R1, WS_Y = WS_R1;
constexpr size_t WS_HMID = WS_R1 + 64 * MiB;
constexpr size_t WS_QKV = WS_R1;
constexpr size_t WS_ATT = WS_R1 + 96 * MiB;
constexpr size_t WS_KF = WS_R1 + 128 * MiB;
constexpr size_t WS_VF = WS_R1 + 224 * MiB;
constexpr size_t WS_END = WS_R1 + 320 * MiB;
constexpr int CW_BAR = 4096;
constexpr int MAX_BAR_REGIONS = 24;

constexpr int RING_BYTES = 131072;
constexpr int LDS_BYTES = 147456;
constexpr int LDSCTL_OFF = LDS_BYTES - 512, MISC_OFF = LDSCTL_OFF + 320;

struct Args { const float* in[19]; float* out; unsigned char* ws; int ph_lo, ph_hi, li, pad; };

struct Frame {
    LAS unsigned char* lds;
    volatile LAS unsigned* MISC;
    int tid, lane, wave, G, bid, gw, NGW;
    unsigned char* ws;
};

template <int NPN_> struct GroupedOrder {
    int G, c;
    DI bool next(int i, pg8::Unit& u) const {
        const int L = i * G + c; if (L >= 16 * 8 * NPN_) return false;
        const int e = L / (8 * NPN_), w = L % (8 * NPN_);
        u.pm = e * 8 + (w & 7); u.pn = e * NPN_ + (w >> 3); return true;
    }
    DI void a_ready(const pg8::Unit&) const {}
    DI void done(const pg8::Unit&) const {}
};

struct EpiInProj {
    static constexpr bool PERM = true, AFTER_DRAIN = false;
    bf16 *U, *GV, *Q, *V, *G; float *LFf, *LFb; const float* LB;
    DI void operator()(const pg8::f32x4 (&acc)[2][2][4][2], const pg8::Unit& u, int wr, int wc, int fr, int fq) const {
        const int seg = u.pn >> 1;
        const int row0 = u.pm * 256 + wr * 64 + fr, lc0 = (u.pn & 1) * 256 + wc * 32 + 8 * fq;
#pragma unroll
        for (int bj = 0; bj < 2; ++bj) {
            const int lc = lc0 + bj * 128;
            float lb[8];
            if (seg == 3 || seg == 4) {
#pragma unroll
                for (int j = 0; j < 8; ++j) lb[j] = LB[(seg - 3) * 512 + lc + j];
            }
#pragma unroll
            for (int ai = 0; ai < 2; ++ai)
#pragma unroll
                for (int m = 0; m < 4; ++m) {
                    const size_t off = (size_t)(row0 + ai * 128 + m * 16) * 512 + lc;
                    float v[8];
#pragma unroll
                    for (int j = 0; j < 8; ++j) v[j] = acc[ai][bj][m][j >> 2][j & 3];
                    if (seg == 3 || seg == 4) {
#pragma unroll
                        for (int j = 0; j < 8; ++j) v[j] = flog(lb[j] + (1.f - lb[j]) * sigmoidf_(v[j]));
                        float* o = (seg == 3 ? LFf : LFb) + off;
                        *(f32x4*)o = (f32x4){v[0], v[1], v[2], v[3]}; *(f32x4*)(o + 4) = (f32x4){v[4], v[5], v[6], v[7]};
                    } else {
                        bf16* o;
                        if (seg == 0) { o = U;
#pragma unroll
                            for (int j = 0; j < 8; ++j) v[j] = gelu_tanh(v[j]);
                        } else if (seg == 1) { o = GV;
#pragma unroll
                            for (int j = 0; j < 8; ++j) v[j] = gelu_tanh(v[j]);
                        } else if (seg == 2) { o = Q;
#pragma unroll
                            for (int j = 0; j < 8; ++j) v[j] = siluf_(v[j]);
                        } else if (seg == 5) { o = V;
                        } else { o = G;
#pragma unroll
                            for (int j = 0; j < 8; ++j) v[j] = sigmoidf_(v[j]);
                        }
                        v4u w; w.x = pk2(v[0], v[1]); w.y = pk2(v[2], v[3]); w.z = pk2(v[4], v[5]); w.w = pk2(v[6], v[7]);
                        *(v4u*)(o + off) = w;
                    }
                }
        }
    }
};
struct EpiResid {
    static constexpr bool PERM = false, AFTER_DRAIN = false;
    const float* base; float* out;
    DI void operator()(const pg8::f32x4 (&acc)[2][2][4][2], const pg8::Unit& u, int wr, int wc, int fr, int fq) const {
        const int row0 = u.pm * 256 + wr * 64 + fr, col0 = u.pn * 256 + wc * 32 + 4 * fq;
#pragma unroll
        for (int ai = 0; ai < 2; ++ai)
#pragma unroll
            for (int m = 0; m < 4; ++m) { const size_t ro = (size_t)(row0 + ai * 128 + m * 16) * DM + col0;
#pragma unroll
                for (int bj = 0; bj < 2; ++bj)
#pragma unroll
                    for (int n = 0; n < 2; ++n) { const size_t o = ro + bj * 128 + n * 16; *(f32x4*)(out + o) = *(const f32x4*)(base + o) + acc[ai][bj][m][n]; } }
    }
};
struct EpiGateUp {
    static constexpr bool PERM = true, AFTER_DRAIN = false;
    bf16* H;
    DI void operator()(const pg8::f32x4 (&acc)[2][2][4][2], const pg8::Unit& u, int wr, int wc, int fr, int fq) const {
        const int pnl = u.pn & 7;
        const int row0 = u.pm * 256 + wr * 64 + fr, col0 = pnl * 128 + wc * 32 + 8 * fq;
#pragma unroll
        for (int ai = 0; ai < 2; ++ai)
#pragma unroll
            for (int m = 0; m < 4; ++m) {
                float v[8];
#pragma unroll
                for (int j = 0; j < 8; ++j) v[j] = siluf_(acc[ai][0][m][j >> 2][j & 3]) * acc[ai][1][m][j >> 2][j & 3];
                v4u w; w.x = pk2(v[0], v[1]); w.y = pk2(v[2], v[3]); w.z = pk2(v[4], v[5]); w.w = pk2(v[6], v[7]);
                *(v4u*)(H + (size_t)(row0 + ai * 128 + m * 16) * DFF + col0) = w;
            }
    }
};
struct EpiDown {
    static constexpr bool PERM = true, AFTER_DRAIN = false;
    bf16* Y; const float* gate;
    DI void operator()(const pg8::f32x4 (&acc)[2][2][4][2], const pg8::Unit& u, int wr, int wc, int fr, int fq) const {
        const int pnl = u.pn & 3;
        const int row0 = u.pm * 256 + wr * 64 + fr, col0 = pnl * 256 + wc * 32 + 8 * fq;
#pragma unroll
        for (int ai = 0; ai < 2; ++ai)
#pragma unroll
            for (int m = 0; m < 4; ++m) { const int row = row0 + ai * 128 + m * 16; const float g = gate[row];
#pragma unroll
                for (int bj = 0; bj < 2; ++bj) {
                    float v[8];
#pragma unroll
                    for (int j = 0; j < 8; ++j) v[j] = acc[ai][bj][m][j >> 2][j & 3] * g;
                    v4u w; w.x = pk2(v[0], v[1]); w.y = pk2(v[2], v[3]); w.z = pk2(v[4], v[5]); w.w = pk2(v[6], v[7]);
                    *(v4u*)(Y + (size_t)row * DM + col0 + bj * 128) = w; } }
    }
};
struct EpiQKV {
    static constexpr bool PERM = true, AFTER_DRAIN = false;
    bf16* O;
    DI void operator()(const pg8::f32x4 (&acc)[2][2][4][2], const pg8::Unit& u, int wr, int wc, int fr, int fq) const {
        const float sc = (u.pn < 4) ? 0.125f : 1.f;
        const int row0 = u.pm * 256 + wr * 64 + fr, col0 = u.pn * 256 + wc * 32 + 8 * fq;
#pragma unroll
        for (int ai = 0; ai < 2; ++ai)
#pragma unroll
            for (int m = 0; m < 4; ++m)
#pragma unroll
                for (int bj = 0; bj < 2; ++bj) {
                    float v[8];
#pragma unroll
                    for (int j = 0; j < 8; ++j) v[j] = acc[ai][bj][m][j >> 2][j & 3] * sc;
                    v4u w; w.x = pk2(v[0], v[1]); w.y = pk2(v[2], v[3]); w.z = pk2(v[4], v[5]); w.w = pk2(v[6], v[7]);
                    *(v4u*)(O + (size_t)(row0 + ai * 128 + m * 16) * NQKV + col0 + bj * 128) = w; }
    }
};

DI void transpose_item(const float* W, int K, int N, bf16* WT, LAS float* scr, int k0, int n0, int drow0, int lane) {
#pragma unroll 8
    for (int i = 0; i < 32; ++i) { const int kk = 2 * i + (lane >> 5); scr[kk * 33 + (lane & 31)] = W[(size_t)(k0 + kk) * N + n0 + (lane & 31)]; }
    LDS_WAIT(); asm volatile("" ::: "memory");
    const int c = lane & 7;
#pragma unroll
    for (int j = 0; j < 4; ++j) { const int n = (lane >> 3) + 8 * j; const LAS float* s = scr + (8 * c) * 33 + n;
        v4u o; o.x = pk2(s[0 * 33], s[1 * 33]); o.y = pk2(s[2 * 33], s[3 * 33]); o.z = pk2(s[4 * 33], s[5 * 33]); o.w = pk2(s[6 * 33], s[7 * 33]);
        *(v4u*)(WT + (size_t)(drow0 + n) * K + k0 + 8 * c) = o; }
    LDS_WAIT(); asm volatile("" ::: "memory");
}
DI void transpose_matrix(Frame& F, const float* W, int K, int N, bf16* WT) {
    LAS float* scr = (LAS float*)(F.lds + F.wave * 16384);
    const int nblk = N / 32, nitems = (K / 64) * nblk;
    for (int it = F.gw; it < nitems; it += F.NGW) { const int kb = it / nblk, nb = it % nblk; transpose_item(W, K, N, WT, scr, 64 * kb, 32 * nb, 32 * nb, F.lane); }
}
DI void convert_moe_weights(Frame& F, const float* wg, const float* wu, const float* wd, int layer) {
    LAS float* scr = (LAS float*)(F.lds + F.wave * 16384);
    bf16* WGU = (bf16*)(F.ws + WS_WGU); bf16* WDN = (bf16*)(F.ws + WS_WDN);
    for (int it = F.gw; it < 3 * 16 * 512; it += F.NGW) {
        const int mat = it / 8192, rem = it % 8192, e = rem / 512, r = rem % 512, kb = r / 32, nb = r % 32, n0 = 32 * nb;
        const size_t so = ((size_t)layer * 16 + e) * 1024 * 1024;
        if (mat == 0) transpose_item(wg + so, 1024, 1024, WGU + (size_t)e * 2048 * 1024, scr, 64 * kb, n0, (n0 >> 7) * 256 + (n0 & 127), F.lane);
        else if (mat == 1) transpose_item(wu + so, 1024, 1024, WGU + (size_t)e * 2048 * 1024, scr, 64 * kb, n0, (n0 >> 7) * 256 + 128 + (n0 & 127), F.lane);
        else transpose_item(wd + so, 1024, 1024, WDN + (size_t)e * 1024 * 1024, scr, 64 * kb, n0, n0, F.lane);
    }
}
DI void rms_row(const float* xrow, const float* g, f32x4 (&v)[4], int lane) {
    const f32x4* xr = (const f32x4*)xrow + lane; float s = 0.f;
#pragma unroll
    for (int j = 0; j < 4; ++j) { v[j] = xr[64 * j]; s += (v[j].x * v[j].x + v[j].y * v[j].y) + (v[j].z * v[j].z + v[j].w * v[j].w); }
    const float rstd = 1.f / sqrtf(wave_sum(s) * (1.f / DM) + EPS);
    const f32x4* gr = (const f32x4*)g + lane;
#pragma unroll
    for (int j = 0; j < 4; ++j) v[j] = v[j] * rstd * gr[64 * j];
}
DI void store_row_bf16(bf16* orow, const f32x4 (&v)[4], int lane) {
    v2u* o8 = (v2u*)orow + lane;
#pragma unroll
    for (int j = 0; j < 4; ++j) { v2u w; w.x = pk2(v[j].x, v[j].y); w.y = pk2(v[j].z, v[j].w); o8[64 * j] = w; }
}
DI int t5_bucket(int rel) {
    const int n = rel < 0 ? -rel : rel;
    int val;
    if (n < 8) val = n;
    else { const float sc = logf((float)n / 8.f) / 4.852030263919617f; int lg = 8 + (int)(sc * 8.f); val = lg < 15 ? lg : 15; }
    return (rel > 0 ? 16 : 0) + val;
}

typedef float f32x16 __attribute__((ext_vector_type(16)));
#define MFMA32(a, b, c) __builtin_amdgcn_mfma_f32_32x32x16_bf16((a), (b), (c), 0, 0, 0)
DI int crow32(int j, int hh) { return (j & 3) + 8 * (j >> 2) + 4 * hh; }
DI void phase_prologue(Frame& F, const Args& a) {
    unsigned char* ws = F.ws;
    transpose_matrix(F, a.in[4], 1024, NIN, (bf16*)(ws + WS_WIN));
    transpose_matrix(F, a.in[5], 1024, 1024, (bf16*)(ws + WS_WOUT));
    transpose_matrix(F, a.in[12], 1024, NQKV, (bf16*)(ws + WS_WQKV));
    transpose_matrix(F, a.in[13], 1024, 1024, (bf16*)(ws + WS_WO));
    convert_moe_weights(F, a.in[16], a.in[17], a.in[18], 0);
    { bf16* WSB = (bf16*)(ws + WS_WSB); for (int i = F.bid * NTHR + F.tid; i < 4 * 128 * 128; i += F.G * NTHR) WSB[i] = (bf16)f2bf(a.in[8][i]); }
    { float* LB = (float*)(ws + WS_LB); const float* t = a.in[10];
      for (int i = F.bid * NTHR + F.tid; i < 2 * 512; i += F.G * NTHR) { const int d = i / 512, k = i % 512;
          const float a0 = t[(d * 3 + 0) * 512 + k], a1 = t[(d * 3 + 1) * 512 + k], a2 = t[(d * 3 + 2) * 512 + k];
          const float mx = fmaxf(a0, fmaxf(a1, a2)); const float e0 = expf(a0 - mx), e1 = expf(a1 - mx), e2 = expf(a2 - mx);
          LB[i] = e0 / (e0 + e1 + e2); } }
    { float* BT = (float*)(ws + WS_BT); const float* rb = a.in[14];
      for (int i = F.bid * NTHR + F.tid; i < 3 * 16 * 129; i += F.G * NTHR) { const int p = i / (16 * 129), h = (i / 129) % 16, j = i % 129;
          const int dil = (p == 0) ? 1 : (p == 1 ? 4 : 16);
          BT[i] = rb[t5_bucket((j - 64) * dil) * 16 + h]; } }
    { bf16* H = (bf16*)(ws + WS_H); const float* x = a.in[0];
      for (int m = F.gw; m < MTOK; m += F.NGW) { f32x4 v[4]; rms_row(x + (size_t)m * DM, a.in[1], v, F.lane); store_row_bf16(H + (size_t)m * DM, v, F.lane); } }
}

DI void phase_a_ln(Frame& F, const Args& a) {
    bf16* GV = (bf16*)(F.ws + WS_GV); const float* lg = a.in[6]; const float* lbv = a.in[7];
    for (int m = F.gw; m < MTOK; m += F.NGW) {
        v4u w = *((const v4u*)(GV + (size_t)m * AW) + F.lane);
        float v[8] = {bflo(w.x), bfhi(w.x), bflo(w.y), bfhi(w.y), bflo(w.z), bfhi(w.z), bflo(w.w), bfhi(w.w)};
        float s = 0.f;
#pragma unroll
        for (int j = 0; j < 8; ++j) s += v[j];
        const float mu = wave_sum(s) * (1.f / AW); float s2 = 0.f;
#pragma unroll
        for (int j = 0; j < 8; ++j) { v[j] -= mu; s2 += v[j] * v[j]; }
        const float rstd = 1.f / sqrtf(wave_sum(s2) * (1.f / AW) + EPS);
#pragma unroll
        for (int j = 0; j < 8; ++j) v[j] = v[j] * rstd * lg[8 * F.lane + j] + lbv[8 * F.lane + j];
        v4u o; o.x = pk2(v[0], v[1]); o.y = pk2(v[2], v[3]); o.z = pk2(v[4], v[5]); o.w = pk2(v[6], v[7]);
        *((v4u*)(GV + (size_t)m * AW) + F.lane) = o;
    }
}
DI void phase_a_mix_naive(Frame& F, const Args& a) {
    const bf16* VN = (const bf16*)(F.ws + WS_GV); const bf16* U = (const bf16*)(F.ws + WS_U); bf16* CAT = (bf16*)(F.ws + WS_CAT);
    LAS float* wl = (LAS float*)F.lds; LAS float* vl = (LAS float*)(F.lds + 65536);
    for (int u = F.bid; u < 512; u += F.G) {
        const int g = u & 3, ch = u >> 2; const int row0 = ch * 128;
        __syncthreads();
        for (int i = F.tid; i < 128 * 128; i += NTHR) { wl[i] = a.in[8][g * 16384 + i]; const int s = i >> 7, c = i & 127; vl[i] = bf2f(VN[(size_t)(row0 + s) * AW + g * 128 + c]); }
        __syncthreads();
        const int c = F.tid & 127, tq = F.tid >> 7;
        for (int tt = 0; tt < 32; ++tt) { const int t = tq * 32 + tt; float acc = 0.f;
            for (int s = 0; s < 128; ++s) acc += wl[t * 128 + s] * vl[s * 128 + c];
            const float uu = bf2f(U[(size_t)(row0 + t) * AW + g * 128 + c]);
            CAT[(size_t)(row0 + t) * DM + g * 128 + c] = (bf16)f2bf(uu * (acc + a.in[9][g * 128 + t])); }
    }
}

DI void phase_a_mix(Frame& F, const Args& a) {
    const bf16* VN = (const bf16*)(F.ws + WS_GV); const bf16* U = (const bf16*)(F.ws + WS_U); bf16* CAT = (bf16*)(F.ws + WS_CAT); const bf16* WSB = (const bf16*)(F.ws + WS_WSB);
    const int r32 = F.lane & 31, hh = F.lane >> 5, ci = F.wave & 3, tp = F.wave >> 2;
    for (int u = F.bid; u < 512; u += F.G) {
        const int g = u & 3, ch = u >> 2; const int row0 = ch * 128;
        f32x16 acc[2];
#pragma unroll
        for (int j = 0; j < 16; ++j) { acc[0][j] = 0.f; acc[1][j] = 0.f; }
        const bf16* vcol = VN + (size_t)row0 * AW + g * 128 + 32 * ci + r32;
        const bf16* w0 = WSB + (size_t)g * 16384 + (size_t)(64 * tp + r32) * 128 + 8 * hh;
#pragma unroll
        for (int s = 0; s < 8; ++s) {
            unsigned short e[8];
#pragma unroll
            for (int j = 0; j < 8; ++j) e[j] = vcol[(size_t)(16 * s + 8 * hh + j) * AW];
            v4u bw; bw.x = e[0] | ((unsigned)e[1] << 16); bw.y = e[2] | ((unsigned)e[3] << 16); bw.z = e[4] | ((unsigned)e[5] << 16); bw.w = e[6] | ((unsigned)e[7] << 16);
            const bf16x8 bt = __builtin_bit_cast(bf16x8, bw);
            acc[0] = MFMA32(*(const bf16x8*)(w0 + 16 * s), bt, acc[0]);
            acc[1] = MFMA32(*(const bf16x8*)(w0 + 32 * 128 + 16 * s), bt, acc[1]);
        }
#pragma unroll
        for (int q = 0; q < 2; ++q)
#pragma unroll
            for (int j = 0; j < 16; ++j) { const int t = 64 * tp + 32 * q + crow32(j, hh), c = g * 128 + 32 * ci + r32;
                const float uu = bf2f(U[(size_t)(row0 + t) * AW + c]);
                CAT[(size_t)(row0 + t) * DM + c] = (bf16)f2bf(uu * (acc[q][j] + a.in[9][g * 128 + t])); }
    }
}

DI void gla_naive_unit(Frame& F, int u, bool with_out) {
    const int sc = u & 31, dir = (u >> 5) & 1, h = (u >> 6) & 3, b = u >> 8;
    const bf16* Q = (const bf16*)(F.ws + WS_Q); const bf16* V = (const bf16*)(F.ws + WS_V);
    const float* LF = (const float*)(F.ws + (dir ? WS_LFB : WS_LFF));
    float* ST = (float*)(F.ws + WS_ST) + (size_t)u * 16384; float* DEC = (float*)(F.ws + WS_DEC) + u * 128;
    float* OD = (float*)(F.ws + WS_ODIR) + (size_t)dir * MTOK * AW;
    LAS bf16* qs = (LAS bf16*)F.lds; LAS bf16* vs = (LAS bf16*)(F.lds + 16384); LAS float* lfs = (LAS float*)(F.lds + 32768);
    const int lane = F.lane, w = F.wave;
    float S[2][16]; float lsum[2] = {0.f, 0.f};
#pragma unroll
    for (int aa = 0; aa < 2; ++aa)
#pragma unroll
        for (int j = 0; j < 16; ++j) S[aa][j] = with_out ? ST[(lane + 64 * aa) * 128 + 16 * w + j] : 0.f;
    for (int sub = 0; sub < 4; ++sub) {
        __syncthreads();
        for (int idx = F.tid; idx < 1024; idx += NTHR) { const int i = idx >> 4, c8 = (idx & 15) * 8; const int ii = sc * 256 + sub * 64 + i; const int tok = dir ? (SEQ - 1 - ii) : ii;
            const size_t go = (size_t)(b * SEQ + tok) * AW + h * 128 + c8;
            *(LAS v4u*)(qs + i * 128 + c8) = *(const v4u*)(Q + go); *(LAS v4u*)(vs + i * 128 + c8) = *(const v4u*)(V + go); }
        for (int idx = F.tid; idx < 2048; idx += NTHR) { const int i = idx >> 5, c4 = (idx & 31) * 4; const int ii = sc * 256 + sub * 64 + i; const int tok = dir ? (SEQ - 1 - ii) : ii;
            *(LAS f32x4*)(lfs + i * 128 + c4) = *(const f32x4*)(LF + (size_t)(b * SEQ + tok) * AW + h * 128 + c4); }
        __syncthreads();
        for (int i = 0; i < 64; ++i) {
            const float l0 = lfs[i * 128 + lane], l1 = lfs[i * 128 + lane + 64];
            const float f0 = fexp(l0), f1 = fexp(l1), k0 = 1.f - f0, k1 = 1.f - f1;
            lsum[0] += l0; lsum[1] += l1;
            float vv[16];
            { const v4u a0 = *(const LAS v4u*)(vs + i * 128 + 16 * w), a1 = *(const LAS v4u*)(vs + i * 128 + 16 * w + 8);
              vv[0] = bflo(a0.x); vv[1] = bfhi(a0.x); vv[2] = bflo(a0.y); vv[3] = bfhi(a0.y); vv[4] = bflo(a0.z); vv[5] = bfhi(a0.z); vv[6] = bflo(a0.w); vv[7] = bfhi(a0.w);
              vv[8] = bflo(a1.x); vv[9] = bfhi(a1.x); vv[10] = bflo(a1.y); vv[11] = bfhi(a1.y); vv[12] = bflo(a1.z); vv[13] = bfhi(a1.z); vv[14] = bflo(a1.w); vv[15] = bfhi(a1.w); }
#pragma unroll
            for (int j = 0; j < 16; ++j) { S[0][j] = f0 * S[0][j] + k0 * vv[j]; S[1][j] = f1 * S[1][j] + k1 * vv[j]; }
            if (with_out) {
                const float q0 = bf2f(qs[i * 128 + lane]), q1 = bf2f(qs[i * 128 + lane + 64]);
                float o[16];
#pragma unroll
                for (int j = 0; j < 16; ++j) o[j] = S[0][j] * q0 + S[1][j] * q1;
                const float tot = red16(o, lane);
                if ((lane & 3) == 0) { const int ii = sc * 256 + sub * 64 + i; const int tok = dir ? (SEQ - 1 - ii) : ii;
                    OD[(size_t)(b * SEQ + tok) * AW + h * 128 + 16 * w + red16_idx(lane)] = tot; }
            }
        }
    }
    if (!with_out) {
#pragma unroll
        for (int aa = 0; aa < 2; ++aa)
#pragma unroll
            for (int j = 0; j < 16; ++j) ST[(lane + 64 * aa) * 128 + 16 * w + j] = S[aa][j];
        if (w == 0) { DEC[lane] = fexp(lsum[0]); DEC[lane + 64] = fexp(lsum[1]); }
    }
}
DI void phase_gla_scan(Frame& F) {
    float* ST = (float*)(F.ws + WS_ST); const float* DEC = (const float*)(F.ws + WS_DEC);
    for (int idx = F.bid * NTHR + F.tid; idx < 16 * 16384; idx += F.G * NTHR) {
        const int chain = idx >> 14, kv = idx & 16383, k = kv >> 7; float S = 0.f;
        for (int sc = 0; sc < NSC; ++sc) { const int u = chain * NSC + sc; const size_t o = (size_t)u * 16384 + kv; const float d = ST[o]; ST[o] = S; S = S * DEC[u * 128 + k] + d; }
    }
}
DI void phase_b_combine(Frame& F, const Args& a) {
    const float* OD = (const float*)(F.ws + WS_ODIR); const bf16* G = (const bf16*)(F.ws + WS_G); bf16* CAT = (bf16*)(F.ws + WS_CAT); const float* ng = a.in[11];
    for (int t = F.gw; t < MTOK * 4; t += F.NGW) { const int row = t >> 2, h = t & 3; const size_t o = (size_t)row * AW + h * 128 + 2 * F.lane;
        const float o0 = OD[o] + OD[(size_t)MTOK * AW + o], o1 = OD[o + 1] + OD[(size_t)MTOK * AW + o + 1];
        const float rstd = 1.f / sqrtf(wave_sum(o0 * o0 + o1 * o1) * (1.f / 128.f) + EPS);
        const unsigned gw2 = *(const unsigned*)(G + o);
        const float r0 = o0 * rstd * ng[h * 128 + 2 * F.lane] * bflo(gw2), r1 = o1 * rstd * ng[h * 128 + 2 * F.lane + 1] * bfhi(gw2);
        *(unsigned*)(CAT + (size_t)row * DM + 512 + h * 128 + 2 * F.lane) = pk2(r0, r1); }
}

DI void phase_router(Frame& F, const float* XR, const float* gn, const float* wr) {
    LAS float* wl = (LAS float*)F.lds;
    __syncthreads();
    for (int i = F.tid; i < 1024 * 16 / 4; i += NTHR) { const f32x4 w4 = *(const f32x4*)(wr + 4 * i); const int d = i >> 2, e0 = 4 * (i & 3);
        wl[(e0 + 0) * 1024 + d] = w4.x; wl[(e0 + 1) * 1024 + d] = w4.y; wl[(e0 + 2) * 1024 + d] = w4.z; wl[(e0 + 3) * 1024 + d] = w4.w; }
    __syncthreads();
    bf16* H = (bf16*)(F.ws + WS_H); float* AFF = (float*)(F.ws + WS_AFF);
    for (int m = F.gw; m < MTOK; m += F.NGW) {
        asm volatile("" ::: "memory");
        f32x4 v[4]; rms_row(XR + (size_t)m * DM, gn, v, F.lane); store_row_bf16(H + (size_t)m * DM, v, F.lane);
        float p[16];
#pragma unroll
        for (int e = 0; e < 16; ++e) { float a = 0.f;
#pragma unroll
            for (int j = 0; j < 4; ++j) { const f32x4 w4 = *(const LAS f32x4*)(wl + e * 1024 + 4 * F.lane + 256 * j); a += (v[j].x * w4.x + v[j].y * w4.y) + (v[j].z * w4.z + v[j].w * w4.w); }
            p[e] = a; }
        const float lg = red16(p, F.lane);
        const float mx = wave_max(lg); const float ex = expf(lg - mx); const float sm = wave_sum(ex) * 0.25f;
        if ((F.lane & 3) == 0) { const int b = m / SEQ, s = m % SEQ; AFF[(size_t)(b * 16 + red16_idx(F.lane)) * SEQ + s] = ex / sm; }
    }
}

DI int block_excl_scan(int v, LAS int* scratch, int tid, int lane, int wave, int* tot) {
    int inc = v;
#pragma unroll
    for (int o = 1; o < 64; o <<= 1) { const int t = __shfl_up(inc, o); if (lane >= o) inc += t; }
    __syncthreads();
    if (lane == 63) scratch[wave] = inc;
    __syncthreads();
    int base = 0, total = 0;
#pragma unroll
    for (int w = 0; w < NWAVES; ++w) { const int s = scratch[w]; if (w < wave) base += s; total += s; }
    *tot = total;
    return base + inc - v;
}
DI void phase_topk(Frame& F) {
    const float* AFF = (const float*)(F.ws + WS_AFF); int* IDX = (int*)(F.ws + WS_IDX); float* GATE = (float*)(F.ws + WS_GATE); int* POS = (int*)(F.ws + WS_POS);
    LAS unsigned* hist = (LAS unsigned*)F.lds; LAS int* sc = (LAS int*)(F.lds + 16384); LAS unsigned* shv = (LAS unsigned*)(F.lds + 16384 + 256);
    for (int u = F.bid; u < BATCH * NEXP; u += F.G) {
        const int b = u / NEXP, e = u % NEXP;
        unsigned vals[16];
        { const v4u* src = (const v4u*)(AFF + (size_t)u * SEQ + 16 * F.tid);
#pragma unroll
          for (int j = 0; j < 4; ++j) { const v4u t = src[j]; vals[4 * j] = t.x; vals[4 * j + 1] = t.y; vals[4 * j + 2] = t.z; vals[4 * j + 3] = t.w; } }
        unsigned prefix = 0; int krem = CAP;
#pragma unroll
        for (int pass = 0; pass < 3; ++pass) {
            const int shift = (pass == 0) ? 20 : (pass == 1 ? 8 : 0); const unsigned mask = (pass == 2) ? 255u : 4095u; const int pshift = (pass == 2) ? 8 : 20;
            __syncthreads();
#pragma unroll
            for (int j = 0; j < 8; ++j) hist[F.tid + 512 * j] = 0u;
            __syncthreads();
#pragma unroll
            for (int j = 0; j < 16; ++j) { const unsigned v = vals[j]; if (pass == 0 || (v >> pshift) == prefix) __hip_atomic_fetch_add(&hist[(v >> shift) & mask], 1u, __ATOMIC_RELAXED, __HIP_MEMORY_SCOPE_WORKGROUP); }
            __syncthreads();
            const int hi = 4095 - 8 * F.tid; int ls = 0; unsigned hb[8];
#pragma unroll
            for (int j = 0; j < 8; ++j) { hb[j] = hist[hi - j]; ls += (int)hb[j]; }
            int tot; const int above = block_excl_scan(ls, sc, F.tid, F.lane, F.wave, &tot);
            if (above < krem && krem <= above + ls) { int cum = above, sel = hi, found = 0;
#pragma unroll
                for (int j = 0; j < 8; ++j) { if (!found) { if (cum + (int)hb[j] >= krem) { sel = hi - j; found = 1; } else cum += (int)hb[j]; } }
                shv[0] = (unsigned)sel; shv[1] = (unsigned)(krem - cum); }
            __syncthreads();
            prefix = (pass == 2) ? ((prefix << 8) | shv[0]) : ((prefix << 12) | shv[0]); krem = (int)shv[1];
        }
        const unsigned T = prefix;
        int ce = 0;
#pragma unroll
        for (int j = 0; j < 16; ++j) ce += (vals[j] == T) ? 1 : 0;
        int tot; int pe = block_excl_scan(ce, sc, F.tid, F.lane, F.wave, &tot);
        unsigned selmask = 0; int cs = 0;
#pragma unroll
        for (int j = 0; j < 16; ++j) { bool s = vals[j] > T; if (vals[j] == T) { s = pe < krem; ++pe; } if (s) { selmask |= 1u << j; ++cs; } }
        int slot = block_excl_scan(cs, sc, F.tid, F.lane, F.wave, &tot);
#pragma unroll
        for (int j = 0; j < 16; ++j) { const int s = 16 * F.tid + j; const int tokrow = b * SEQ + s;
            if (selmask & (1u << j)) { const int row = (e * 2 + b) * CAP + slot; ++slot; IDX[row] = tokrow; GATE[row] = __builtin_bit_cast(float, vals[j]); POS[tokrow * 16 + e] = row; }
            else POS[tokrow * 16 + e] = -1; }
    }
}
DI void phase_gather(Frame& F) {
    const bf16* H = (const bf16*)(F.ws + WS_H); bf16* XE = (bf16*)(F.ws + WS_XE); const int* IDX = (const int*)(F.ws + WS_IDX);
    for (int r = F.gw; r < NROWS; r += F.NGW) { const int src = IDX[r];
        const v4u* s = (const v4u*)(H + (size_t)src * DM) + F.lane; v4u* d = (v4u*)(XE + (size_t)r * DM) + F.lane;
        d[0] = s[0]; d[64] = s[64]; }
}
DI void phase_moe_combine(Frame& F, float* XR, const float* gnext, bool final_out) {
    const bf16* Y = (const bf16*)(F.ws + WS_Y); const int* POS = (const int*)(F.ws + WS_POS); bf16* H = (bf16*)(F.ws + WS_H);
    for (int m = F.gw; m < MTOK; m += F.NGW) {
        f32x4* xr = (f32x4*)(XR + (size_t)m * DM) + F.lane;
        f32x4 v[4];
#pragma unroll
        for (int j = 0; j < 4; ++j) v[j] = xr[64 * j];
        const int pmine = POS[m * 16 + (F.lane & 15)];
        for (int e = 0; e < 16; ++e) { const int p = __shfl(pmine, e);
            if (p >= 0) { const v2u* yr = (const v2u*)(Y + (size_t)p * DM) + F.lane;
#pragma unroll
                for (int j = 0; j < 4; ++j) { const v2u w = yr[64 * j]; v[j].x += bflo(w.x); v[j].y += bfhi(w.x); v[j].z += bflo(w.y); v[j].w += bfhi(w.y); } } }
        float s = 0.f;
#pragma unroll
        for (int j = 0; j < 4; ++j) s += (v[j].x * v[j].x + v[j].y * v[j].y) + (v[j].z * v[j].z + v[j].w * v[j].w);
        const float rstd = 1.f / sqrtf(wave_sum(s) * (1.f / DM) + EPS);
        const f32x4* gr = (const f32x4*)gnext + F.lane;
        if (final_out) {
#pragma unroll
            for (int j = 0; j < 4; ++j) xr[64 * j] = v[j] * rstd * gr[64 * j];
        } else {
#pragma unroll
            for (int j = 0; j < 4; ++j) xr[64 * j] = v[j];
            f32x4 nv[4];
#pragma unroll
            for (int j = 0; j < 4; ++j) nv[j] = v[j] * rstd * gr[64 * j];
            store_row_bf16(H + (size_t)m * DM, nv, F.lane);
        }
    }
}

DI void phase_attn_naive(Frame& F) {
    const bf16* QKV = (const bf16*)(F.ws + WS_QKV); bf16* ATT = (bf16*)(F.ws + WS_ATT); const float* BT = (const float*)(F.ws + WS_BT);
    LAS float* ql = (LAS float*)(F.lds + F.wave * 4096);
    LAS float* pl = ql + 64; LAS int* posl = (LAS int*)(ql + 512);
    const int lane = F.lane;
    for (int t = F.gw; t < MTOK * NHEAD; t += F.NGW) {
        const int row = t >> 4, h = t & 15, b = row / SEQ, tq = row % SEQ;
        ql[lane] = bf2f(QKV[(size_t)row * NQKV + h * 64 + lane]);
        LDS_WAIT();
        float s[7]; int pos[7];
#pragma unroll
        for (int i = 0; i < 7; ++i) {
            const int slot = lane + 64 * i; const int p = slot / 129, j = slot % 129;
            const int dil = (p == 0) ? 1 : (p == 1 ? 4 : 16);
            const int mq = tq / dil, r = tq % dil, mk = mq - 64 + j;
            const bool valid = (slot < 387) && (mk >= 0) && (mk < SEQ / dil);
            pos[i] = valid ? (b * SEQ + r + dil * mk) : -1;
            float d = -1e30f;
            if (valid) { const v4u* kr = (const v4u*)(QKV + (size_t)pos[i] * NQKV + 1024 + h * 64); float acc = 0.f;
#pragma unroll
                for (int c = 0; c < 8; ++c) { const v4u w = kr[c];
                    acc += ql[8 * c] * bflo(w.x) + ql[8 * c + 1] * bfhi(w.x) + ql[8 * c + 2] * bflo(w.y) + ql[8 * c + 3] * bfhi(w.y) + ql[8 * c + 4] * bflo(w.z) + ql[8 * c + 5] * bfhi(w.z) + ql[8 * c + 6] * bflo(w.w) + ql[8 * c + 7] * bfhi(w.w); }
                d = acc + BT[(p * 16 + h) * 129 + j]; }
            s[i] = d;
        }
        float mx = s[0];
#pragma unroll
        for (int i = 1; i < 7; ++i) mx = fmaxf(mx, s[i]);
        mx = wave_max(mx);
        float sum = 0.f;
#pragma unroll
        for (int i = 0; i < 7; ++i) { const float pv = (pos[i] >= 0) ? expf(s[i] - mx) : 0.f; sum += pv; pl[lane + 64 * i] = pv; posl[lane + 64 * i] = pos[i]; }
        sum = wave_sum(sum);
        LDS_WAIT();
        float o = 0.f;
        for (int k = 0; k < 387; ++k) { const int pp = posl[k]; if (pp >= 0) o += pl[k] * bf2f(QKV[(size_t)pp * NQKV + 2048 + h * 64 + lane]); }
        ATT[(size_t)row * DM + h * 64 + lane] = (bf16)f2bf(o / sum);
        LDS_WAIT();
    }
}

DI int kperm(int r) { return (r & ~12) | ((r & 4) << 1) | ((r & 8) >> 1); }
DI void phase_kvf(Frame& F) {
    const bf16* QKV = (const bf16*)(F.ws + WS_QKV); unsigned char* KF = F.ws + WS_KF; unsigned char* VF = F.ws + WS_VF;
    LAS unsigned char* kl = F.lds; LAS unsigned char* vl = F.lds + 69632;
    for (int u = F.bid; u < 512; u += F.G) {
        const int c = u & 15, h = (u >> 4) & 15, b = u >> 8, t0 = c * 512;
        __syncthreads();
        { const v4u* ks = (const v4u*)(QKV + (size_t)(b * SEQ + t0 + F.tid) * NQKV + 1024 + h * 64); const v4u* vs = (const v4u*)(QKV + (size_t)(b * SEQ + t0 + F.tid) * NQKV + 2048 + h * 64);
#pragma unroll
          for (int j = 0; j < 8; ++j) { const v4u w = ks[j]; LAS v2u* d = (LAS v2u*)(kl + F.tid * 136 + 16 * j); d[0] = (v2u){w.x, w.y}; d[1] = (v2u){w.z, w.w}; }
#pragma unroll
          for (int j = 0; j < 8; ++j) { const v4u w = vs[j]; LAS v2u* d = (LAS v2u*)(vl + F.tid * 136 + 16 * j); d[0] = (v2u){w.x, w.y}; d[1] = (v2u){w.z, w.w}; } }
        __syncthreads();
#pragma unroll
        for (int p = 0; p < 3; ++p) {
            const int dl = (p == 0) ? 1 : (p == 1 ? 4 : 16), tpr = 16 / dl, ntile = SEQ / dl / 32;
            unsigned char* kd = KF + (size_t)p * 32 * MiB; unsigned char* vd = VF + (size_t)p * 32 * MiB;
#pragma unroll 2
            for (int i = 0; i < 8; ++i) { const int q = F.tid + 512 * i, tl = q >> 8, ln = q & 63, hh = ln >> 5, rho = ln & 31, r = tl / tpr, tt = tl % tpr;
                const size_t tg = ((size_t)((b * 16 + h) * dl + r) * ntile + c * tpr + tt) * 4096;
                { const int s = (q >> 6) & 3, tokl = dl * (32 * tt + kperm(rho)) + r;
                  const LAS v2u* sp = (const LAS v2u*)(kl + tokl * 136 + 64 * hh + 16 * s); const v2u a0 = sp[0], a1 = sp[1];
                  *(v4u*)(kd + tg + s * 1024 + ln * 16) = (v4u){a0.x, a0.y, a1.x, a1.y}; }
                { const int dt = (q >> 7) & 1, s2 = (q >> 6) & 1, dim = 32 * dt + rho; unsigned short e[8];
#pragma unroll
                  for (int k = 0; k < 8; ++k) e[k] = *(const LAS unsigned short*)(vl + (dl * (32 * tt + 16 * s2 + 8 * hh + k) + r) * 136 + dim * 2);
                  v4u o; o.x = e[0] | ((unsigned)e[1] << 16); o.y = e[2] | ((unsigned)e[3] << 16); o.z = e[4] | ((unsigned)e[5] << 16); o.w = e[6] | ((unsigned)e[7] << 16);
                  *(v4u*)(vd + tg + (dt * 2 + s2) * 1024 + ln * 16) = o; }
            }
        }
    }
}

DI int osw(int tok, int chunk) { return tok * 256 + (((chunk ^ tok ^ (tok >> 4)) & 15) << 4); }
struct AttnK { bf16x8 k[4]; }; struct AttnV { bf16x8 v[2][2]; };
DI void attn_load_k(AttnK& t, const unsigned char* kt) {
#pragma unroll
    for (int s = 0; s < 4; ++s) t.k[s] = *(const bf16x8*)(kt + s * 1024);
}
DI void attn_load_v(AttnV& t, const unsigned char* vt) {
#pragma unroll
    for (int dt = 0; dt < 2; ++dt)
#pragma unroll
        for (int s = 0; s < 2; ++s) t.v[dt][s] = *(const bf16x8*)(vt + (dt * 2 + s) * 1024);
}
template <bool MASK> DI void attn_step(const AttnK& tk, const AttnV& tv, const bf16x8 (&qf)[4], f32x16& o0, f32x16& o1, float& m, float& l, const LAS float* bl, int rel0, int hh) {
    f32x16 sa;
#pragma unroll
    for (int i = 0; i < 16; ++i) sa[i] = 0.f;
#pragma unroll
    for (int s = 0; s < 4; ++s) sa = MFMA32(tk.k[s], qf[s], sa);
    float sc[16]; float tmax = -1e30f;
#pragma unroll
    for (int i = 0; i < 16; ++i) { const int rel = rel0 + 16 * (i >> 3) + (i & 7);
        const bool valid = !MASK || ((rel >= -64) && (rel <= 64)); const int idx = valid ? rel + 64 : 0;
        const float v = sa[i] + bl[idx]; sc[i] = valid ? v : -1e30f; tmax = fmaxf(tmax, sc[i]); }
    tmax = fmaxf(tmax, __shfl_xor(tmax, 32));
    const float mnew = fmaxf(m, tmax), alpha = fexp(m - mnew);
    float ps = 0.f; float p[16];
#pragma unroll
    for (int i = 0; i < 16; ++i) { p[i] = (!MASK || sc[i] > -1e29f) ? fexp(sc[i] - mnew) : 0.f; ps += p[i]; }
    l = l * alpha + ps; m = mnew;
#pragma unroll
    for (int i = 0; i < 16; ++i) { o0[i] *= alpha; o1[i] *= alpha; }
#pragma unroll
    for (int s = 0; s < 2; ++s) {
        v4u w; w.x = pk2(p[8 * s], p[8 * s + 1]); w.y = pk2(p[8 * s + 2], p[8 * s + 3]); w.z = pk2(p[8 * s + 4], p[8 * s + 5]); w.w = pk2(p[8 * s + 6], p[8 * s + 7]);
        const bf16x8 pf = __builtin_bit_cast(bf16x8, w);
        o0 = MFMA32(tv.v[0][s], pf, o0); o1 = MFMA32(tv.v[1][s], pf, o1);
    }
}
template <int P> DI void attn_stage(Frame& F, int b, int h, int t0) {
    constexpr int DL = (P == 0) ? 1 : (P == 1 ? 4 : 16), NS = SEQ / DL, NT = NS / 32;
    const bf16* QKV = (const bf16*)(F.ws + WS_QKV); const unsigned char* KF = F.ws + WS_KF + (size_t)P * 32 * MiB; const unsigned char* VF = F.ws + WS_VF + (size_t)P * 32 * MiB; bf16* ATT = (bf16*)(F.ws + WS_ATT);
    LAS unsigned char* ol = F.lds; LAS float* ml = (LAS float*)(F.lds + 131072); LAS float* ll = ml + 512; const LAS float* bl = (const LAS float*)(F.lds + 135168) + P * 132;
    int lane = F.lane; asm volatile("" : "+v"(lane));
    const int r32 = lane & 31, hh = lane >> 5, w = F.wave;
    asm volatile("" ::: "memory");
    int rr[2], mq[2], tq[2]; const unsigned char* kb[2]; const unsigned char* vb[2];
#pragma unroll
    for (int task = 0; task < 2; ++task) {
        int r, i0;
        if (P == 0) { r = 0; i0 = 64 * w + 32 * task; } else if (P == 1) { r = w & 3; i0 = 64 * (w >> 2) + 32 * task; } else { r = 2 * w + task; i0 = 0; }
        rr[task] = r; mq[task] = t0 / DL + i0; tq[task] = r + DL * (i0 + r32);
        const size_t tb0 = ((size_t)((b * 16 + h) * DL + r) * NT) * 4096 + lane * 16;
        kb[task] = KF + tb0; vb[task] = VF + tb0;
    }
    int relb = 8 * hh - 64 - r32;
    asm volatile("" : "+v"(relb));
    AttnK ka, kb_, kc; AttnV va, vb_; bf16x8 qf[4]; f32x16 o0, o1; float m, l;
#define ATT_T(task, kt) (mq[task] / 32 - 2 + (kt))
#define ATT_OK(task, kt) (ATT_T(task, kt) >= 0 && ATT_T(task, kt) < NT)
#define ATT_TC(task, kt) (ATT_T(task, kt) < 0 ? 0 : (ATT_T(task, kt) >= NT ? NT - 1 : ATT_T(task, kt)))
#define ATT_LDK(t, task, kt) attn_load_k(t, kb[task] + (size_t)ATT_TC(task, kt) * 4096)
#define ATT_LDV(t, task, kt) attn_load_v(t, vb[task] + (size_t)ATT_TC(task, kt) * 4096)
#define ATT_ST(tk, tv, task, kt, MSK) do { if (ATT_OK(task, kt)) attn_step<MSK>(tk, tv, qf, o0, o1, m, l, bl, relb + 32 * (kt), hh); } while (0)
#define ATT_Q(task) do { const bf16* qp = QKV + (size_t)(b * SEQ + t0 + tq[task]) * NQKV + h * 64 + 32 * hh; _Pragma("unroll") for (int s = 0; s < 4; ++s) qf[s] = *(const bf16x8*)(qp + 8 * s); } while (0)
#define ATT_INIT(task) do { if (P == 0) { _Pragma("unroll") for (int i = 0; i < 16; ++i) { o0[i] = 0.f; o1[i] = 0.f; } m = -1e30f; l = 0.f; } else { \
        _Pragma("unroll") for (int g = 0; g < 4; ++g) { const f32x4 a = *(const LAS f32x4*)(ol + osw(tq[task], 2 * g + hh)), c = *(const LAS f32x4*)(ol + osw(tq[task], 8 + 2 * g + hh)); \
            o0[4 * g] = a.x; o0[4 * g + 1] = a.y; o0[4 * g + 2] = a.z; o0[4 * g + 3] = a.w; o1[4 * g] = c.x; o1[4 * g + 1] = c.y; o1[4 * g + 2] = c.z; o1[4 * g + 3] = c.w; } \
        m = ml[tq[task]]; l = hh ? 0.f : ll[tq[task]]; } } while (0)
#define ATT_WB(task) do { const float lt = l + __shfl_xor(l, 32); int tw = tq[task]; asm volatile("" : "+v"(tw));     \
        if (P < 2) { _Pragma("unroll") for (int g = 0; g < 4; ++g) { *(LAS f32x4*)(ol + osw(tw, 2 * g + hh)) = (f32x4){o0[4 * g], o0[4 * g + 1], o0[4 * g + 2], o0[4 * g + 3]}; \
                *(LAS f32x4*)(ol + osw(tw, 8 + 2 * g + hh)) = (f32x4){o1[4 * g], o1[4 * g + 1], o1[4 * g + 2], o1[4 * g + 3]}; } \
            if (hh == 0) { ml[tw] = m; ll[tw] = lt; } } \
        else { const float inv = 1.f / lt; bf16* op = ATT + (size_t)(b * SEQ + t0 + tw) * DM + h * 64 + 4 * hh; \
            _Pragma("unroll") for (int g = 0; g < 4; ++g) { v2u a, c; a.x = pk2(o0[4 * g] * inv, o0[4 * g + 1] * inv); a.y = pk2(o0[4 * g + 2] * inv, o0[4 * g + 3] * inv); \
                c.x = pk2(o1[4 * g] * inv, o1[4 * g + 1] * inv); c.y = pk2(o1[4 * g + 2] * inv, o1[4 * g + 3] * inv); *(v2u*)(op + 8 * g) = a; *(v2u*)(op + 32 + 8 * g) = c; } } } while (0)
    ATT_LDK(ka, 0, 0); ATT_LDK(kb_, 0, 1); ATT_LDV(va, 0, 0);
    ATT_Q(0); ATT_INIT(0);
    ATT_LDK(kc, 0, 2); ATT_LDV(vb_, 0, 1); ATT_ST(ka, va, 0, 0, true);
    ATT_LDK(ka, 0, 3); ATT_LDV(va, 0, 2); ATT_ST(kb_, vb_, 0, 1, false);
    ATT_LDK(kb_, 0, 4); ATT_LDV(vb_, 0, 3); ATT_ST(kc, va, 0, 2, false);
    ATT_LDK(kc, 1, 0); ATT_LDV(va, 0, 4); ATT_ST(ka, vb_, 0, 3, false);
    ATT_LDK(ka, 1, 1); ATT_LDV(vb_, 1, 0); ATT_ST(kb_, va, 0, 4, true);
    ATT_WB(0);
    ATT_Q(1); ATT_INIT(1);
    ATT_LDK(kb_, 1, 2); ATT_LDV(va, 1, 1); ATT_ST(kc, vb_, 1, 0, true);
    ATT_LDK(kc, 1, 3); ATT_LDV(vb_, 1, 2); ATT_ST(ka, va, 1, 1, false);
    ATT_LDK(ka, 1, 4); ATT_LDV(va, 1, 3); ATT_ST(kb_, vb_, 1, 2, false);
    ATT_LDV(vb_, 1, 4); ATT_ST(kc, va, 1, 3, false);
    ATT_ST(ka, vb_, 1, 4, true);
    ATT_WB(1);
#undef ATT_T
#undef ATT_OK
#undef ATT_TC
#undef ATT_LDK
#undef ATT_LDV
#undef ATT_ST
#undef ATT_Q
#undef ATT_INIT
#undef ATT_WB
}
DI void phase_attn(Frame& F) {
    const float* BT = (const float*)(F.ws + WS_BT);
    LAS float* bl = (LAS float*)(F.lds + 135168);
    for (int u = F.bid; u < 512; u += F.G) {
        const int c = u & 15, h = (u >> 4) & 15, b = u >> 8, t0 = c * 512;
        __syncthreads();
        { int i0 = F.tid; asm volatile("" : "+v"(i0)); for (int i = i0; i < 3 * 129; i += NTHR) bl[(i / 129) * 132 + i % 129] = BT[((i / 129) * 16 + h) * 129 + i % 129]; }
        __syncthreads();
        attn_stage<0>(F, b, h, t0);
        __syncthreads();
        attn_stage<1>(F, b, h, t0);
        __syncthreads();
        attn_stage<2>(F, b, h, t0);
    }
}

constexpr int GL_QT = 0, GL_KT = 17408, GL_QB = 34816, GL_KHT = 52224, GL_VT = 70656, GL_P = 89088, GL_ST = 98304, GL_DEC = 133120, GL_TOT = 133632;
struct GlaRaw { float lf[16]; unsigned short q[16]; unsigned short v[16]; };
template <bool FULL> DI void gla_load_raw(GlaRaw& R, const float* LF, const bf16* Q, const bf16* V, int b, int h, int dir, int pos0, int ch) {
#pragma unroll
    for (int i = 0; i < 16; ++i) { const int ii = pos0 + i; const int tok = dir ? (SEQ - 1 - ii) : ii; const size_t off = (size_t)(b * SEQ + tok) * AW + h * 128 + ch;
        R.lf[i] = LF[off]; R.v[i] = V[off]; if (FULL) R.q[i] = Q[off]; }
}
template <bool FULL> DI float gla_prep(Frame& F, const GlaRaw& R) {
    LAS unsigned char* L = F.lds; LAS float* tot = (LAS float*)(L + GL_TOT);
    const int ch = F.tid & 127, qtr = F.tid >> 7;
    float c[16]; float run = 0.f;
#pragma unroll
    for (int i = 0; i < 16; ++i) { run += R.lf[i]; c[i] = run; }
    tot[qtr * 128 + ch] = run;
    __syncthreads();
    const float t0 = tot[ch], t1 = tot[128 + ch], t2 = tot[256 + ch], t3 = tot[384 + ch];
    const float off = (qtr > 0 ? t0 : 0.f) + (qtr > 1 ? t1 : 0.f) + (qtr > 2 ? t2 : 0.f), rr = t0 + t1, bend = (t0 + t1) + (t2 + t3);
    unsigned kh[8], vv[8];
#pragma unroll
    for (int i = 0; i < 16; i += 2) {
        const float b0 = off + c[i], b1 = off + c[i + 1];
        const float k0 = 1.f - fexp(R.lf[i]), k1 = 1.f - fexp(R.lf[i + 1]);
        kh[i >> 1] = pk2(k0 * fexp(bend - b0), k1 * fexp(bend - b1));
        vv[i >> 1] = (unsigned)R.v[i] | ((unsigned)R.v[i + 1] << 16);
        if (FULL) {
            const float q0 = bf2f(R.q[i]), q1 = bf2f(R.q[i + 1]);
            const int ta = 16 * qtr + i;
            *(LAS unsigned short*)(L + GL_QT + ta * 272 + 2 * ch) = (unsigned short)f2bf(q0 * fexp(b0 - rr));
            *(LAS unsigned short*)(L + GL_QT + (ta + 1) * 272 + 2 * ch) = (unsigned short)f2bf(q1 * fexp(b1 - rr));
            *(LAS unsigned short*)(L + GL_KT + ta * 272 + 2 * ch) = (unsigned short)f2bf(k0 * fexp(rr - b0));
            *(LAS unsigned short*)(L + GL_KT + (ta + 1) * 272 + 2 * ch) = (unsigned short)f2bf(k1 * fexp(rr - b1));
            *(LAS unsigned short*)(L + GL_QB + ta * 272 + 2 * ch) = (unsigned short)f2bf(q0 * fexp(b0));
            *(LAS unsigned short*)(L + GL_QB + (ta + 1) * 272 + 2 * ch) = (unsigned short)f2bf(q1 * fexp(b1));
        }
    }
    *(LAS v4u*)(L + GL_KHT + ch * 144 + 32 * qtr) = (v4u){kh[0], kh[1], kh[2], kh[3]}; *(LAS v4u*)(L + GL_KHT + ch * 144 + 32 * qtr + 16) = (v4u){kh[4], kh[5], kh[6], kh[7]};
    *(LAS v4u*)(L + GL_VT + ch * 144 + 32 * qtr) = (v4u){vv[0], vv[1], vv[2], vv[3]}; *(LAS v4u*)(L + GL_VT + ch * 144 + 32 * qtr + 16) = (v4u){vv[4], vv[5], vv[6], vv[7]};
    if (qtr == 0) *(LAS float*)(L + GL_DEC + 4 * ch) = fexp(bend);
    return bend;
}
DI bf16x8 gfrag(const LAS unsigned char* base, int row, int stride, int kel) { return *(const LAS bf16x8*)(base + row * stride + kel * 2); }
DI void gla_state_update(Frame& F, f32x16 (&S)[2]) {
    const LAS unsigned char* L = F.lds; const int r32 = F.lane & 31, hh = F.lane >> 5, vi = F.wave & 3, ki0 = 2 * (F.wave >> 2);
    bf16x8 a[4];
#pragma unroll
    for (int s = 0; s < 4; ++s) a[s] = gfrag(L + GL_VT, 32 * vi + r32, 144, 16 * s + 8 * hh);
#pragma unroll
    for (int q = 0; q < 2; ++q) { const int kr = 32 * (ki0 + q) + r32; const float d = *(const LAS float*)(L + GL_DEC + 4 * kr);
#pragma unroll
        for (int j = 0; j < 16; ++j) S[q][j] *= d;
#pragma unroll
        for (int s = 0; s < 4; ++s) S[q] = MFMA32(a[s], gfrag(L + GL_KHT, kr, 144, 16 * s + 8 * hh), S[q]); }
}
DI void gla_state_to_lds(Frame& F, const f32x16 (&S)[2]) {
    LAS unsigned char* L = F.lds; const int r32 = F.lane & 31, hh = F.lane >> 5, vi = F.wave & 3, ki0 = 2 * (F.wave >> 2);
#pragma unroll
    for (int q = 0; q < 2; ++q)
#pragma unroll
        for (int j = 0; j < 16; ++j) *(LAS unsigned short*)(L + GL_ST + (32 * vi + crow32(j, hh)) * 272 + 2 * (32 * (ki0 + q) + r32)) = (unsigned short)f2bf(S[q][j]);
}
DI void gla_unit_state(Frame& F, int u) {
    const int sc = u & 31, dir = (u >> 5) & 1, h = (u >> 6) & 3, b = u >> 8;
    const bf16* Q = (const bf16*)(F.ws + WS_Q); const bf16* V = (const bf16*)(F.ws + WS_V); const float* LF = (const float*)(F.ws + (dir ? WS_LFB : WS_LFF));
    float* ST = (float*)(F.ws + WS_ST) + (size_t)u * 16384; float* DEC = (float*)(F.ws + WS_DEC) + u * 128;
    const int ch = F.tid & 127, qtr = F.tid >> 7, r32 = F.lane & 31, hh = F.lane >> 5, vi = F.wave & 3, ki0 = 2 * (F.wave >> 2);
    f32x16 S[2];
#pragma unroll
    for (int j = 0; j < 16; ++j) { S[0][j] = 0.f; S[1][j] = 0.f; }
    float lsum = 0.f;
    GlaRaw cur, nxt;
    gla_load_raw<false>(cur, LF, Q, V, b, h, dir, sc * 256 + 16 * qtr, ch);
#pragma unroll 1
    for (int c = 0; c < 4; ++c) {
        __syncthreads();
        lsum += gla_prep<false>(F, cur);
        if (c < 3) gla_load_raw<false>(nxt, LF, Q, V, b, h, dir, sc * 256 + (c + 1) * 64 + 16 * qtr, ch);
        __syncthreads();
        gla_state_update(F, S);
        cur = nxt;
    }
#pragma unroll
    for (int q = 0; q < 2; ++q)
#pragma unroll
        for (int g = 0; g < 4; ++g) *(f32x4*)(ST + (size_t)(32 * (ki0 + q) + r32) * 128 + 32 * vi + 8 * g + 4 * hh) = (f32x4){S[q][4 * g], S[q][4 * g + 1], S[q][4 * g + 2], S[q][4 * g + 3]};
    if (qtr == 0) DEC[ch] = fexp(lsum);
}
DI void gla_unit_out(Frame& F, int u) {
    const int sc = u & 31, dir = (u >> 5) & 1, h = (u >> 6) & 3, b = u >> 8;
    const bf16* Q = (const bf16*)(F.ws + WS_Q); const bf16* V = (const bf16*)(F.ws + WS_V); const float* LF = (const float*)(F.ws + (dir ? WS_LFB : WS_LFF));
    const float* ST = (const float*)(F.ws + WS_ST) + (size_t)u * 16384; float* OD = (float*)(F.ws + WS_ODIR) + (size_t)dir * MTOK * AW;
    const LAS unsigned char* L = F.lds;
    const int ch = F.tid & 127, qtr = F.tid >> 7, r32 = F.lane & 31, hh = F.lane >> 5, w = F.wave, vi = w & 3, ki0 = 2 * (w >> 2), ti = w >> 2;
    f32x16 S[2];
#pragma unroll
    for (int q = 0; q < 2; ++q)
#pragma unroll
        for (int g = 0; g < 4; ++g) { const f32x4 t = *(const f32x4*)(ST + (size_t)(32 * (ki0 + q) + r32) * 128 + 32 * vi + 8 * g + 4 * hh); S[q][4 * g] = t.x; S[q][4 * g + 1] = t.y; S[q][4 * g + 2] = t.z; S[q][4 * g + 3] = t.w; }
    GlaRaw cur, nxt;
    gla_load_raw<true>(cur, LF, Q, V, b, h, dir, sc * 256 + 16 * qtr, ch);
    __syncthreads();
    gla_state_to_lds(F, S);
#pragma unroll 1
    for (int c = 0; c < 4; ++c) {
        (void)gla_prep<true>(F, cur);
        if (c < 3) gla_load_raw<true>(nxt, LF, Q, V, b, h, dir, sc * 256 + (c + 1) * 64 + 16 * qtr, ch);
        __syncthreads();
        f32x16 o;
#pragma unroll
        for (int j = 0; j < 16; ++j) o[j] = 0.f;
#pragma unroll
        for (int s = 0; s < 8; ++s) o = MFMA32(gfrag(L + GL_QB, 32 * ti + r32, 272, 16 * s + 8 * hh), gfrag(L + GL_ST, 32 * vi + r32, 272, 16 * s + 8 * hh), o);
        if (w < 3) {
            const int tp = (w + 1) >> 1, sp = (w == 2) ? 1 : 0;
            f32x16 p;
#pragma unroll
            for (int j = 0; j < 16; ++j) p[j] = 0.f;
#pragma unroll
            for (int s = 0; s < 8; ++s) p = MFMA32(gfrag(L + GL_QT, 32 * tp + r32, 272, 16 * s + 8 * hh), gfrag(L + GL_KT, 32 * sp + r32, 272, 16 * s + 8 * hh), p);
#pragma unroll
            for (int j = 0; j < 16; ++j) { const int t = 32 * tp + crow32(j, hh), s = 32 * sp + r32;
                *(LAS unsigned short*)(F.lds + GL_P + t * 144 + 2 * s) = (s <= t) ? (unsigned short)f2bf(p[j]) : (unsigned short)0; }
        }
        __syncthreads();
        { const int ns = ti ? 4 : 2;
#pragma unroll
          for (int s = 0; s < 4; ++s) if (s < ns) o = MFMA32(gfrag(L + GL_P, 32 * ti + r32, 144, 16 * s + 8 * hh), gfrag(L + GL_VT, 32 * vi + r32, 144, 16 * s + 8 * hh), o); }
#pragma unroll
        for (int j = 0; j < 16; ++j) { const int ii = sc * 256 + c * 64 + 32 * ti + crow32(j, hh); const int tok = dir ? (SEQ - 1 - ii) : ii;
            OD[(size_t)(b * SEQ + tok) * AW + h * 128 + 32 * vi + r32] = o[j]; }
        if (c < 3) { gla_state_update(F, S); gla_state_to_lds(F, S); }
        cur = nxt;
        __syncthreads();
    }
}

__global__ void __launch_bounds__(NTHR, 2) fwd_kernel(Args args) {
    extern __shared__ __attribute__((aligned(16))) unsigned char lds[];
    Frame F;
    F.lds = (LAS unsigned char*)lds;
    F.MISC = (volatile LAS unsigned*)(F.lds + MISC_OFF);
    F.tid = threadIdx.x; F.lane = F.tid & 63; F.wave = __builtin_amdgcn_readfirstlane(F.tid >> 6);
    F.G = gridDim.x; F.bid = blockIdx.x; F.gw = F.bid * NWAVES + F.wave; F.NGW = F.G * NWAVES;
    F.ws = args.ws;
    unsigned* ctl = (unsigned*)(args.ws + WS_CTL);
    for (int u = F.tid; u < (LDS_BYTES - LDSCTL_OFF) / 4; u += NTHR) ((LAS unsigned*)(F.lds + LDSCTL_OFF))[u] = 0u;
    __syncthreads();
    const int lo = args.ph_lo, hi = args.ph_hi;
    XcdBarrier bar; bar.bar = ctl + CW_BAR + args.li * XCD_BAR_WORDS; bar.x = 0; bar.st = nullptr;
    if (hi - lo > 1) bar = xcd_barrier_post(ctl + CW_BAR + args.li * XCD_BAR_WORDS, F.MISC + 8);
#define IN(k) (lo <= (k) && (k) < hi)
#ifndef PROBE_DUP
#define PROBE_DUP (-1)
#endif
#define REP(k) for (int rep_ = 0; rep_ < (((PROBE_DUP) == (k)) ? 2 : 1); ++rep_)
#define SEAM(k) do { if (IN(k) && IN((k) + 1)) xcd_barrier(bar); } while (0)
    unsigned char* ws = args.ws;
    float* XR = args.out;

    if (IN(0)) REP(0) { phase_prologue(F, args); } SEAM(0);
    if (IN(1)) REP(1) {
        pg8::Gemm g{(const bf16*)(ws + WS_H), (const bf16*)(ws + WS_WIN), MTOK, NIN, DM}; pg8::StaticOrder S; S.init(MTOK, NIN, F.G, F.bid);
        EpiInProj E{(bf16*)(ws + WS_U), (bf16*)(ws + WS_GV), (bf16*)(ws + WS_Q), (bf16*)(ws + WS_V), (bf16*)(ws + WS_G), (float*)(ws + WS_LFF), (float*)(ws + WS_LFB), (const float*)(ws + WS_LB)};
        pg8::gemm_phase<EpiInProj, pg8::StaticOrder, true, true>(F.lds, g, S, E);
    } SEAM(1);
    if (IN(2)) { phase_a_ln(F, args); REP(2) for (int u = F.bid; u < 512; u += F.G) gla_unit_state(F, u); } SEAM(2);
    if (IN(3)) { phase_gla_scan(F); REP(3) phase_a_mix(F, args); } SEAM(3);
    if (IN(4)) REP(4) { for (int u = F.bid; u < 512; u += F.G) gla_unit_out(F, u); } SEAM(4);
    if (IN(5)) REP(5) { phase_b_combine(F, args); } SEAM(5);
    if (IN(6)) REP(6) {
        pg8::Gemm g{(const bf16*)(ws + WS_CAT), (const bf16*)(ws + WS_WOUT), MTOK, DM, DM}; pg8::StaticOrder S; S.init(MTOK, DM, F.G, F.bid);
        EpiResid E{args.in[0], XR};
        pg8::gemm_phase<EpiResid, pg8::StaticOrder, false, true>(F.lds, g, S, E);
    } SEAM(6);
#define MOE_BLOCK(L, pb) do { \
        if (IN(pb)) REP(pb) { phase_router(F, XR, args.in[2] + (L) * DM, args.in[15] + (L) * DM * NEXP); } SEAM(pb); \
        if (IN((pb) + 1)) REP((pb) + 1) { phase_topk(F); } SEAM((pb) + 1); \
        if (IN((pb) + 2)) {     \
            pg8::Gemm g{(const bf16*)(ws + WS_H), (const bf16*)(ws + WS_WGU), NROWS, 16 * 2048, DM}; GroupedOrder<8> S{F.G, F.bid}; \
            EpiGateUp E{(bf16*)(ws + WS_HMID)}; \
            LAS int* rowtab = (LAS int*)(F.lds + RING_BYTES); const int* IDX = (const int*)(ws + WS_IDX); \
            for (int i = 0; i < 4; ++i) { pg8::Unit uu; if (!S.next(i, uu)) break; if (F.tid < 256) rowtab[i * 256 + F.tid] = IDX[uu.pm * 256 + F.tid]; } \
            __syncthreads(); \
            pg8::gemm_phase<EpiGateUp, GroupedOrder<8>, true, true, true>(F.lds, g, S, E, rowtab); \
        } SEAM((pb) + 2); \
        if (IN((pb) + 3)) { \
            pg8::Gemm g{(const bf16*)(ws + WS_HMID), (const bf16*)(ws + WS_WDN), NROWS, 16 * 1024, DFF}; GroupedOrder<4> S{F.G, F.bid}; \
            EpiDown E{(bf16*)(ws + WS_Y), (const float*)(ws + WS_GATE)}; \
            pg8::gemm_phase<EpiDown, GroupedOrder<4>, true, true>(F.lds, g, S, E); \
        } SEAM((pb) + 3); \
    } while (0)

    MOE_BLOCK(0, 7);
    if (IN(11)) { phase_moe_combine(F, XR, args.in[1] + DM, false); REP(11) convert_moe_weights(F, args.in[16], args.in[17], args.in[18], 1); } SEAM(11);
    if (IN(12)) REP(12) {
        pg8::Gemm g{(const bf16*)(ws + WS_H), (const bf16*)(ws + WS_WQKV), MTOK, NQKV, DM}; pg8::StaticOrder S; S.init(MTOK, NQKV, F.G, F.bid);
        EpiQKV E{(bf16*)(ws + WS_QKV)};
        pg8::gemm_phase<EpiQKV, pg8::StaticOrder, true, true>(F.lds, g, S, E);
    } SEAM(12);
    if (IN(13)) REP(13) { phase_kvf(F); } SEAM(13);
    if (IN(14)) REP(14) { phase_attn(F); } SEAM(14);
    if (IN(15)) {
        pg8::Gemm g{(const bf16*)(ws + WS_ATT), (const bf16*)(ws + WS_WO), MTOK, DM, DM}; pg8::StaticOrder S; S.init(MTOK, DM, F.G, F.bid);
        EpiResid E{XR, XR};
        pg8::gemm_phase<EpiResid, pg8::StaticOrder, false, true>(F.lds, g, S, E);
    } SEAM(15);
    MOE_BLOCK(1, 16);
    if (IN(20)) { phase_moe_combine(F, XR, args.in[3], true); }
#undef MOE_BLOCK
#undef IN
#undef SEAM
}

#ifndef MK_N_LAUNCHES
#define MK_N_LAUNCHES 1
#endif
extern "C" void kernel_launch(void* const* d_in, const int* in_sizes, int n_in, void* d_out, int out_size, void* d_ws, size_t ws_size, hipStream_t stream) {
    static int grid = 0;
    if (grid == 0) {
        if (n_in != 19 || in_sizes[0] != MTOK * DM || out_size != MTOK * DM || ws_size < WS_END) { fprintf(stderr, "kernel_launch: unexpected shapes (n_in %d, in0 %d, out %d, ws %zu < %zu); nothing launched\n", n_in, n_in > 0 ? in_sizes[0] : -1, out_size, ws_size, (size_t)WS_END); grid = -1; return; }
        int dev = 0, cus = 0, per_cu = 0;
        if (hipGetDevice(&dev) != hipSuccess || hipDeviceGetAttribute(&cus, hipDeviceAttributeMultiprocessorCount, dev) != hipSuccess) { grid = -1; return; }
        if (hipFuncSetAttribute((const void*)fwd_kernel, hipFuncAttributeMaxDynamicSharedMemorySize, LDS_BYTES) != hipSuccess) { fprintf(stderr, "kernel_launch: hipFuncSetAttribute failed\n"); grid = -1; return; }
        if (hipOccupancyMaxActiveBlocksPerMultiprocessor(&per_cu, (const void*)fwd_kernel, NTHR, LDS_BYTES) != hipSuccess || per_cu < 1) { fprintf(stderr, "kernel_launch: occupancy query reports %d workgroups per CU\n", per_cu); }
        (void)hipGetLastError();
        grid = cus;
    }
    if (grid < 0) return;
    if (hipMemsetAsync((char*)d_ws + WS_CTL, 0, CTL_ZERO_BYTES, stream) != hipSuccess) return;
    Args a{};
    for (int i = 0; i < 19; ++i) a.in[i] = (const float*)d_in[i];
    a.out = (float*)d_out; a.ws = (unsigned char*)d_ws; a.pad = 0;
    static_assert(CW_BAR + MAX_BAR_REGIONS * XCD_BAR_WORDS <= (int)(CTL_ZERO_BYTES / 4), "barrier regions inside the memset region");
    const int nl = MK_N_LAUNCHES;
    for (int li = 0; li < nl; ++li) {
        a.ph_lo = (int)((long)NPHASE * li / nl); a.ph_hi = (int)((long)NPHASE * (li + 1) / nl); a.li = li;
        hipLaunchKernelGGL(fwd_kernel, dim3(grid), dim3(NTHR), LDS_BYTES, stream, a);
        const hipError_t le = hipPeekAtLastError();
        if (le != hipSuccess) { fprintf(stderr, "kernel_launch: launch %d failed: %s\n", li, hipGetErrorName(le)); break; }
    }
}
```

```cpp
#include <hip/hip_runtime.h>
#include <cstdio>
#include <cstdint>
namespace pg8 {
#define PG8_LAS __attribute__((address_space(3)))
typedef unsigned short bf16_t;
typedef short bf16x8 __attribute__((ext_vector_type(8)));
typedef float f32x4 __attribute__((ext_vector_type(4)));
typedef unsigned u32x4 __attribute__((ext_vector_type(4)));
constexpr int BM = 256, BK = 64, HALF = 128, HTB = HALF * BK * 2  , STAGE_BYTES = 8 * HTB, NXCD = 8, WGM = 8;

__host__ __device__ __forceinline__ int lds_byte(int r, int c) { const int st = (r >> 4) * 2 + (c >> 5), rr = r & 15, cc = c & 31, ob = rr * 64 + cc * 2; return st * 1024 + (ob ^ (((ob >> 9) & 1) << 5)); }
__host__ __device__ __forceinline__ void stage_rc(int b, int& R, int& C) { const int st = b / 1024, sb = b % 1024, swz = sb ^ (((sb >> 9) & 1) << 5); R = (st >> 1) * 16 + swz / 64; C = (st & 1) * 32 + (swz % 64) / 2; }
__host__ __device__ __forceinline__ int perm32(int rho) { const int n = rho >> 4, i = rho & 15; return 8 * (i >> 2) + 4 * n + (i & 3); }

struct Unit { int pm, pn; };
struct Gemm { const bf16_t* A; const bf16_t* Bt; int M, N, K; };

struct StaticOrder {
    int nM, nN, nwg, G, c;
    __host__ __device__ void init(int M, int N, int G_, int c_) { nM = M / BM; nN = N / BM; nwg = nM * nN; G = G_; c = c_; }
    __host__ __device__ bool next(int i, Unit& u) const {
        const long L = (long)i * G + c; if (L >= nwg) return false;
        int wgid = (int)L; { const int q = nwg / NXCD, r = nwg % NXCD, xcd = wgid % NXCD, off = wgid / NXCD; wgid = (xcd < r ? xcd * (q + 1) : r * (q + 1) + (xcd - r) * q) + off; }
        const int nig = WGM * nN, gid = wgid / nig, fm = gid * WGM, gsz = (nM - fm) < WGM ? (nM - fm) : WGM;
        u.pm = fm + ((wgid % nig) % gsz); u.pn = (wgid % nig) / gsz; return true;
    }
    __device__ __forceinline__ void a_ready(const Unit&) const {}
    __device__ __forceinline__ void done(const Unit&) const {}
};

__device__ __forceinline__ unsigned cvt_pk_bf16(float lo, float hi) { unsigned r; asm volatile("v_cvt_pk_bf16_f32 %0, %1, %2" : "=v"(r) : "v"(lo), "v"(hi)); return r; }
typedef float f32x2 __attribute__((ext_vector_type(2)));
__device__ __forceinline__ f32x2 gelu_pk(f32x2 v) {
    const f32x2 av = __builtin_elementwise_abs(v), d = av * 0.2316418882f + 1.0f;
    f32x2 t; t.x = __builtin_amdgcn_rcpf(d.x); t.y = __builtin_amdgcn_rcpf(d.y);
    f32x2 q = t * 0.5307027145f + (-0.7265760135f); q = q * t + 0.7107068705f; q = q * t + (-0.142248368f); q = q * t + 0.127414796f; q = q * t;
    const f32x2 s = (v * v) * (-0.72134752044f);
    f32x2 e; e.x = __builtin_amdgcn_exp2f(s.x); e.y = __builtin_amdgcn_exp2f(s.y);
    const f32x2 m = v * (q * e), r = v - m;
    f32x2 o; o.x = v.x < 0.f ? m.x : r.x; o.y = v.y < 0.f ? m.y : r.y; return o;
}

template <int ACT  > struct EpiBf16 {
    static constexpr bool PERM = true, AFTER_DRAIN = false; static_assert(ACT == 0 || ACT == 1, "EpiBf16: ACT is 0 (none) or 1 (gelu_pk)");
    bf16_t* O; int ldc; const float* bias; int split_cols; size_t split_stride; float scale0;
    __device__ __forceinline__ void operator()(const f32x4 (&acc)[2][2][4][2], const Unit& u, int wr, int wc, int fr, int fq) const {
        const int row0 = u.pm * BM + wr * 64 + fr; int colt = u.pn * BM; bf16_t* base = O;
        float sc = 1.f; if (split_cols) { const int t = colt / split_cols; base += (size_t)t * split_stride; colt -= t * split_cols; if (t == 0) sc = scale0; }
        const int col0 = colt + wc * 32 + 8 * fq, bcol0 = u.pn * BM + wc * 32 + 8 * fq;
        f32x4 bv[2][2];
#pragma unroll
        for (int bj = 0; bj < 2; ++bj)
#pragma unroll
            for (int n = 0; n < 2; ++n) bv[bj][n] = bias ? *(const f32x4*)(bias + bcol0 + bj * HALF + 4 * n) : (f32x4){0.f, 0.f, 0.f, 0.f};
#pragma unroll
        for (int ai = 0; ai < 2; ++ai)
#pragma unroll
            for (int m = 0; m < 4; ++m) { bf16_t* rowp = base + (size_t)(row0 + ai * HALF + m * 16) * ldc + col0;
#pragma unroll
                for (int bj = 0; bj < 2; ++bj) { f32x4 v0 = acc[ai][bj][m][0] + bv[bj][0], v1 = acc[ai][bj][m][1] + bv[bj][1];
                    if (ACT == 1) { f32x2 a = gelu_pk((f32x2){v0[0], v0[1]}), b = gelu_pk((f32x2){v0[2], v0[3]}), c = gelu_pk((f32x2){v1[0], v1[1]}), d = gelu_pk((f32x2){v1[2], v1[3]});
                        v0 = (f32x4){a.x, a.y, b.x, b.y}; v1 = (f32x4){c.x, c.y, d.x, d.y}; }
                    v0 = v0 * sc; v1 = v1 * sc; u32x4 w; w.x = cvt_pk_bf16(v0[0], v0[1]); w.y = cvt_pk_bf16(v0[2], v0[3]); w.z = cvt_pk_bf16(v1[0], v1[1]); w.w = cvt_pk_bf16(v1[2], v1[3]);
                    *(u32x4*)(rowp + bj * HALF) = w; } }
    }
};
template <class Epi, class Sched, bool ALIGN_EPI = false, bool SP2 = false, bool GATHER = false>
__device__ __forceinline__ void gemm_phase(PG8_LAS unsigned char* lds, const Gemm g, const Sched& S, const Epi& E, const PG8_LAS int* rowtab = nullptr) {
    const int tid = threadIdx.x, wid = __builtin_amdgcn_readfirstlane(tid >> 6), lane = tid & 63, wr = wid >> 2, wc = wid & 3, fr = lane & 15, fq = lane >> 4;
    const int K = g.K, nt = K / BK;
    unsigned voffA[2], voffB[2]; int gR[2], gC[2];
#pragma unroll
    for (int i = 0; i < 2; ++i) { int R, C; stage_rc(tid * 16 + i * 8192, R, C); const int Rb = Epi::PERM ? ((R & ~31) + perm32(R & 31)) : R;
        voffA[i] = (unsigned)(R * K + C) * 2u; voffB[i] = (unsigned)(Rb * K + C) * 2u; gR[i] = R; gC[i] = C; }
    unsigned vC[2][2] = {{0u, 0u}, {0u, 0u}}, vN[2][2] = {{0u, 0u}, {0u, 0u}};
#define PG8_ROWS(dst, ui_) do { _Pragma("unroll") for (int _h = 0; _h < 2; ++_h) _Pragma("unroll") for (int _i = 0; _i < 2; ++_i) \
        dst[_h][_i] = (unsigned)(rowtab[(ui_) * 256 + _h * 128 + gR[_i]] * K + gC[_i]) * 2u; } while (0)
    const size_t kstep = (size_t)(BK * 2);
    const size_t hstep = (size_t)HALF * K * 2;
    const size_t tstep = 2 * hstep;
    const unsigned ldsw = (unsigned)wid * 1024u;
    const int aoff = lds_byte(wr * 64 + fr, fq * 8), boff = lds_byte(wc * 32 + fr, fq * 8);
#define PG8_SA(b, h) (((b) * 2 + (h)) * HTB)
#define PG8_SB(b, h) ((4 + (b) * 2 + (h)) * HTB)
#define PG8_STAGE(bufoff, gbase, voff) do { _Pragma("unroll") for (int _i = 0; _i < 2; ++_i) \
        __builtin_amdgcn_global_load_lds((const unsigned*)((const char*)(gbase) + (voff)[_i]), (PG8_LAS unsigned*)(lds + (bufoff) + ldsw + _i * 8192), 16, 0, 0); } while (0)
#define PG8_STGA(bufoff, abase, half, V) do { _Pragma("unroll") for (int _i = 0; _i < 2; ++_i) \
        __builtin_amdgcn_global_load_lds((const unsigned*)((const char*)(abase) + (GATHER ? (size_t)V[half][_i] : (size_t)((half) ? hstep : 0) + voffA[_i])), (PG8_LAS unsigned*)(lds + (bufoff) + ldsw + _i * 8192), 16, 0, 0); } while (0)
#define PG8_LDA(dst, b, h) do { _Pragma("unroll") for (int m = 0; m < 4; ++m) _Pragma("unroll") for (int k = 0; k < 2; ++k) dst[m][k] = *(const PG8_LAS bf16x8*)(lds + PG8_SA(b, h) + aoff + m * 2048 + k * 1024); } while (0)
#define PG8_LDB(dst, b, h) do { _Pragma("unroll") for (int n = 0; n < 2; ++n) _Pragma("unroll") for (int k = 0; k < 2; ++k) dst[n][k] = *(const PG8_LAS bf16x8*)(lds + PG8_SB(b, h) + boff + n * 2048 + k * 1024); } while (0)
#define PG8_MMA(ai, bj, At, Bt) do { __builtin_amdgcn_s_setprio(1); _Pragma("unroll") for (int m = 0; m < 4; ++m) _Pragma("unroll") for (int n = 0; n < 2; ++n) _Pragma("unroll") for (int k = 0; k < 2; ++k) \
        acc[ai][bj][m][n] = __builtin_amdgcn_mfma_f32_16x16x32_bf16(Bt[n][k], At[m][k], acc[ai][bj][m][n], 0, 0, 0); __builtin_amdgcn_s_setprio(0); } while (0)
#define PG8_WAIT_V(n) asm volatile("s_waitcnt vmcnt(" #n ")" ::: "memory")
#define PG8_WAIT_L(n) asm volatile("s_waitcnt lgkmcnt(" #n ")" ::: "memory")
#define PG8_BAR __builtin_amdgcn_s_barrier()
#define PG8_SCHED __builtin_amdgcn_sched_barrier(0)
    Unit cur, nxt; int ui = 0;
    if (!S.next(0, cur)) return;
    f32x4 acc[2][2][4][2];
#pragma unroll
    for (int a = 0; a < 2; ++a)
#pragma unroll
        for (int b = 0; b < 2; ++b)
#pragma unroll
            for (int m = 0; m < 4; ++m)
#pragma unroll
                for (int n = 0; n < 2; ++n) acc[a][b][m][n] = (f32x4){0.f, 0.f, 0.f, 0.f};
    bf16x8 At[4][2], B0[2][2], B1[2][2];
    const char* cA = (const char*)g.A + (GATHER ? (size_t)0 : (size_t)cur.pm * tstep); if constexpr (GATHER) PG8_ROWS(vC, 0);
    const char* cB = (const char*)g.Bt + (size_t)cur.pn * tstep;
    S.a_ready(cur);
    if constexpr (SP2) {
        PG8_STAGE(PG8_SB(0, 0), cB, voffB); PG8_STAGE(PG8_SB(0, 1), cB + hstep, voffB); PG8_STGA(PG8_SA(0, 0), cA, 0, vC); PG8_STGA(PG8_SA(0, 1), cA, 1, vC);
        if (wr == 1) PG8_BAR;
        PG8_WAIT_V(2); PG8_BAR;
        PG8_STAGE(PG8_SB(1, 0), cB + kstep, voffB); PG8_STGA(PG8_SA(1, 0), cA + kstep, 0, vC); PG8_STAGE(PG8_SB(1, 1), cB + hstep + kstep, voffB);
        PG8_WAIT_V(6); PG8_BAR;
    } else {
        PG8_STAGE(PG8_SB(0, 0), cB, voffB); PG8_STGA(PG8_SA(0, 0), cA, 0, vC); PG8_STAGE(PG8_SB(0, 1), cB + hstep, voffB); PG8_STGA(PG8_SA(0, 1), cA, 1, vC);
        if (wr == 1) PG8_BAR;
        PG8_WAIT_V(4); PG8_BAR;
        PG8_STAGE(PG8_SB(1, 0), cB + kstep, voffB); PG8_STGA(PG8_SA(1, 0), cA + kstep, 0, vC); PG8_STAGE(PG8_SB(1, 1), cB + hstep + kstep, voffB);
        PG8_WAIT_V(6); PG8_BAR;
    }
    for (;;) {
        const bool has_next = S.next(ui + 1, nxt);
        const char* nA = (has_next && !GATHER) ? (const char*)g.A + (size_t)nxt.pm * tstep : cA;
        if constexpr (GATHER) { if (has_next) PG8_ROWS(vN, ui + 1); else { _Pragma("unroll") for (int _h = 0; _h < 2; ++_h) _Pragma("unroll") for (int _i = 0; _i < 2; ++_i) vN[_h][_i] = vC[_h][_i]; } }
        const char* nB = has_next ? (const char*)g.Bt + (size_t)nxt.pn * tstep : cB;
        for (int t = 0; t < nt; t += 2) {
            const bool last = (t == nt - 2);
            unsigned vX[2][2];
            _Pragma("unroll") for (int _h = 0; _h < 2; ++_h) _Pragma("unroll") for (int _i = 0; _i < 2; ++_i) vX[_h][_i] = last ? vN[_h][_i] : vC[_h][_i];
            const char* a1 = cA + (size_t)(t + 1) * kstep;
            const char* a2 = last ? nA : cA + (size_t)(t + 2) * kstep; const char* b2 = last ? nB : cB + (size_t)(t + 2) * kstep;
            const char* a3 = a2 + kstep; const char* b3 = b2 + kstep;
            if (last && has_next) S.a_ready(nxt);
            if constexpr (SP2) {
            PG8_LDB(B0, 0, 0); PG8_LDB(B1, 0, 1); PG8_SCHED; PG8_LDA(At, 0, 0); PG8_STGA(PG8_SA(1, 1), a1, 1, vC);
            PG8_WAIT_V(8); PG8_WAIT_L(0); PG8_BAR; PG8_MMA(0, 0, At, B0); PG8_MMA(0, 1, At, B1); PG8_BAR; PG8_SCHED;
            PG8_LDA(At, 0, 1); PG8_STAGE(PG8_SB(0, 0), b2, voffB); PG8_STAGE(PG8_SB(0, 1), b2 + hstep, voffB); PG8_STGA(PG8_SA(0, 0), a2, 0, vX);
            PG8_WAIT_V(8); PG8_WAIT_L(0); PG8_BAR; PG8_MMA(1, 0, At, B0); PG8_MMA(1, 1, At, B1); PG8_BAR; PG8_SCHED;
            PG8_LDB(B0, 1, 0); PG8_LDB(B1, 1, 1); PG8_SCHED; PG8_LDA(At, 1, 0); PG8_STGA(PG8_SA(0, 1), a2, 1, vX);
            PG8_WAIT_V(8); PG8_WAIT_L(0); PG8_BAR; PG8_MMA(0, 0, At, B0); PG8_MMA(0, 1, At, B1); PG8_BAR; PG8_SCHED;
            PG8_LDA(At, 1, 1); PG8_STAGE(PG8_SB(1, 0), b3, voffB); PG8_STAGE(PG8_SB(1, 1), b3 + hstep, voffB); PG8_STGA(PG8_SA(1, 0), a3, 0, vX);
            PG8_WAIT_V(8); PG8_WAIT_L(0); PG8_BAR; PG8_MMA(1, 0, At, B0); PG8_MMA(1, 1, At, B1); PG8_BAR; PG8_SCHED;
            } else {
            PG8_LDB(B0, 0, 0); PG8_SCHED; PG8_LDA(At, 0, 0); PG8_STGA(PG8_SA(1, 1), a1, 1, vC);
            PG8_WAIT_L(8); PG8_BAR; PG8_WAIT_L(0); PG8_MMA(0, 0, At, B0); PG8_BAR; PG8_SCHED;
            PG8_LDB(B1, 0, 1); PG8_STAGE(PG8_SB(0, 0), b2, voffB);
            PG8_BAR; PG8_WAIT_L(0); PG8_MMA(0, 1, At, B1); PG8_BAR;
            PG8_LDA(At, 0, 1); PG8_STGA(PG8_SA(0, 0), a2, 0, vX);
            PG8_BAR; PG8_WAIT_L(0); PG8_MMA(1, 0, At, B0); PG8_BAR; PG8_SCHED;
            PG8_STAGE(PG8_SB(0, 1), b2 + hstep, voffB);
            PG8_WAIT_V(6); PG8_BAR; PG8_MMA(1, 1, At, B1); PG8_BAR;
            PG8_LDB(B0, 1, 0); PG8_SCHED; PG8_LDA(At, 1, 0); PG8_STGA(PG8_SA(0, 1), a2, 1, vX);
            PG8_WAIT_L(8); PG8_BAR; PG8_WAIT_L(0); PG8_MMA(0, 0, At, B0); PG8_BAR; PG8_SCHED;
            PG8_LDB(B1, 1, 1); PG8_STAGE(PG8_SB(1, 0), b3, voffB);
            PG8_BAR; PG8_WAIT_L(0); PG8_MMA(0, 1, At, B1); PG8_BAR;
            PG8_LDA(At, 1, 1); PG8_STGA(PG8_SA(1, 0), a3, 0, vX);
            PG8_BAR; PG8_WAIT_L(0); PG8_MMA(1, 0, At, B0); PG8_BAR; PG8_SCHED;
            PG8_STAGE(PG8_SB(1, 1), b3 + hstep, voffB);
            PG8_WAIT_V(6); PG8_BAR; PG8_MMA(1, 1, At, B1); PG8_BAR;
            }
        }
        if constexpr (ALIGN_EPI) { if (wr == 0) PG8_BAR; }
        if constexpr (!Epi::AFTER_DRAIN) { E(acc, cur, wr, wc, fr, fq); S.done(cur); }
        if (!has_next) break;
#pragma unroll
        for (int a = 0; a < 2; ++a)
#pragma unroll
            for (int b = 0; b < 2; ++b)
#pragma unroll
                for (int m = 0; m < 4; ++m)
#pragma unroll
                    for (int n = 0; n < 2; ++n) acc[a][b][m][n] = (f32x4){0.f, 0.f, 0.f, 0.f};
        cur = nxt; cA = nA; cB = nB; ++ui;
        if constexpr (GATHER) { _Pragma("unroll") for (int _h = 0; _h < 2; ++_h) _Pragma("unroll") for (int _i = 0; _i < 2; ++_i) vC[_h][_i] = vN[_h][_i]; }
        if constexpr (ALIGN_EPI) { if (wr == 1) PG8_BAR; }
    }
    PG8_WAIT_V(0);
    if constexpr (!ALIGN_EPI) { if (wr == 0) PG8_BAR; }
    PG8_BAR;
    if constexpr (Epi::AFTER_DRAIN) { E.fused(acc, cur, wr, wc, fr, fq, lds, wid, lane); S.done(cur); }
#undef PG8_SA
#undef PG8_SB
#undef PG8_STAGE
#undef PG8_STGA
#undef PG8_ROWS
#undef PG8_LDA
#undef PG8_LDB
#undef PG8_MMA
#undef PG8_WAIT_V
#undef PG8_WAIT_L
#undef PG8_BAR
#undef PG8_SCHED
}
}
#define LAS __attribute__((address_space(3)))
#define DI __device__ __forceinline__
typedef unsigned short bf16;
typedef unsigned v4u __attribute__((ext_vector_type(4)));
typedef unsigned v2u __attribute__((ext_vector_type(2)));
typedef float f32x4 __attribute__((ext_vector_type(4)));
typedef short bf16x8 __attribute__((ext_vector_type(8)));
#define LDS_WAIT() asm volatile("s_waitcnt lgkmcnt(0)" ::: "memory")
#define VM_WAIT() asm volatile("s_waitcnt vmcnt(0)" ::: "memory")
DI unsigned f2bf(float f) { unsigned u = __builtin_bit_cast(unsigned, f); return (u + 0x7fffu + ((u >> 16) & 1u)) >> 16; }
typedef float f32x2_t __attribute__((ext_vector_type(2))); typedef __bf16 bf16x2_t __attribute__((ext_vector_type(2)));
DI unsigned pk2(float lo, float hi) { f32x2_t v = {lo, hi}; bf16x2_t b = __builtin_convertvector(v, bf16x2_t); return __builtin_bit_cast(unsigned, b); }
DI float bf2f(unsigned b) { return __builtin_bit_cast(float, b << 16); }
DI float bflo(unsigned w) { return __builtin_bit_cast(float, w << 16); }
DI float bfhi(unsigned w) { return __builtin_bit_cast(float, w & 0xffff0000u); }
DI float fexp(float x) { return __builtin_amdgcn_exp2f(x * 1.4426950408889634f); }
DI float flog(float x) { return __builtin_amdgcn_logf(x) * 0.6931471805599453f; }
DI float frcp(float x) { return __builtin_amdgcn_rcpf(x); }
DI float sigmoidf_(float x) { return frcp(1.f + fexp(-x)); }
DI float siluf_(float x) { return x * sigmoidf_(x); }
DI float gelu_tanh(float x) { const float u = 0.7978845608028654f * (x + 0.044715f * x * x * x); return x * sigmoidf_(2.f * u); }
DI float wave_sum(float v) {
#pragma unroll
    for (int o = 1; o < 64; o <<= 1) v += __shfl_xor(v, o);
    return v;
}
DI float wave_max(float v) {
#pragma unroll
    for (int o = 1; o < 64; o <<= 1) v = fmaxf(v, __shfl_xor(v, o));
    return v;
}
DI int red16_idx(int lane) { return 8 * ((lane >> 5) & 1) + 4 * ((lane >> 4) & 1) + 2 * ((lane >> 3) & 1) + ((lane >> 2) & 1); }
DI float red16(const float (&o)[16], int lane) {
    const bool b32 = lane & 32, b16 = lane & 16, b8 = lane & 8, b4 = lane & 4;
    float a8[8], a4[4], a2[2], a1;
#pragma unroll
    for (int j = 0; j < 8; ++j) { const float send = b32 ? o[j] : o[j + 8], keep = b32 ? o[j + 8] : o[j]; a8[j] = keep + __shfl_xor(send, 32); }
#pragma unroll
    for (int j = 0; j < 4; ++j) { const float send = b16 ? a8[j] : a8[j + 4], keep = b16 ? a8[j + 4] : a8[j]; a4[j] = keep + __shfl_xor(send, 16); }
#pragma unroll
    for (int j = 0; j < 2; ++j) { const float send = b8 ? a4[j] : a4[j + 2], keep = b8 ? a4[j + 2] : a4[j]; a2[j] = keep + __shfl_xor(send, 8); }
    { const float send = b4 ? a2[0] : a2[1], keep = b4 ? a2[1] : a2[0]; a1 = keep + __shfl_xor(send, 4); }
    a1 += __shfl_xor(a1, 2); a1 += __shfl_xor(a1, 1);
    return a1;
}
#define XB_TMO      128
#define XB_XCNT(j)  (256  + 64 * (j))
#define XB_XSUB(j)  (1280 + 64 * (j))
#define XB_XGEN(j)  (2304 + 64 * (j))
#define XB_TOP      3328
#define XB_TOPGEN   3392
#define XCD_BAR_WORDS 3456
#define XB_SPIN_CAP (1u << 18)

__device__ __forceinline__ unsigned xb_ld(unsigned* p)              { return __hip_atomic_load(p, __ATOMIC_RELAXED, __HIP_MEMORY_SCOPE_AGENT); }
__device__ __forceinline__ unsigned xb_add(unsigned* p, unsigned v) { return __hip_atomic_fetch_add(p, v, __ATOMIC_RELAXED, __HIP_MEMORY_SCOPE_AGENT); }
__device__ __forceinline__ unsigned xb_xcc_id() { return (unsigned)__builtin_amdgcn_s_getreg((3 << 11) | 20) & 0xFu; }
#define XB_SPIN(cond, bar) do { unsigned _sp = 0; while (cond) { __builtin_amdgcn_s_sleep(1); \
    if ((++_sp & 255u) == 0u) { if (xb_ld(&(bar)[XB_TMO])) break; if (_sp > XB_SPIN_CAP) { atomicAdd(&(bar)[XB_TMO], 1u); break; } } } } while (0)

struct XcdBarrier {
    unsigned* bar; unsigned x;
    volatile LAS unsigned* st;
};

__device__ __forceinline__ XcdBarrier xcd_barrier_post(unsigned* bar, volatile LAS unsigned* st) {
    XcdBarrier b; b.bar = bar; b.x = xb_xcc_id(); b.st = st;
    if (threadIdx.x == 0) (void)xb_add(&bar[XB_XCNT(b.x)], 1u);
    return b;
}
__device__ __forceinline__ void xcd_barrier_complete(unsigned* bar, unsigned x, unsigned& nloc, unsigned& nx) {
    const unsigned G = gridDim.x * gridDim.y * gridDim.z;
    unsigned sum, cnt, mine, sp = 0u;
    for (;;) {
        sum = 0u; cnt = 0u; mine = 0u;
#pragma unroll
        for (unsigned j = 0; j < 16; ++j) { const unsigned c = xb_ld(&bar[XB_XCNT(j)]); sum += c; cnt += (c > 0u) ? 1u : 0u; mine = (j == x) ? c : mine; }
        if (sum == G) break;
        __builtin_amdgcn_s_sleep(1);
        if ((++sp & 255u) == 0u) { if (xb_ld(&bar[XB_TMO])) break; if (sp > XB_SPIN_CAP) { atomicAdd(&bar[XB_TMO], 1u); break; } }
    }
    nloc = mine > 0u ? mine : 1u; nx = cnt > 0u ? cnt : 1u;
}

__device__ __forceinline__ void xcd_barrier(const XcdBarrier& b) {
    asm volatile("s_waitcnt vmcnt(0)" ::: "memory");
    __syncthreads();
    if (threadIdx.x == 0) {
        unsigned* bar = b.bar;
        __builtin_amdgcn_s_waitcnt(0);
        unsigned nloc = b.st[0], nx = b.st[1];
        if (nloc == 0u) { xcd_barrier_complete(bar, b.x, nloc, nx); b.st[0] = nloc; b.st[1] = nx; }
        const unsigned old = xb_add(&bar[XB_XSUB(b.x)], 1u);
        const unsigned gen = old / nloc;
        if (old + 1u == (gen + 1u) * nloc) {
            __builtin_amdgcn_fence(__ATOMIC_RELEASE, "agent");
            asm volatile("s_waitcnt vmcnt(0)" ::: "memory");
            const unsigned og = xb_add(&bar[XB_TOP], 1u);
            const unsigned tg = og / nx;
            if (og + 1u == (tg + 1u) * nx) xb_add(&bar[XB_TOPGEN], 1u);
            else XB_SPIN(xb_ld(&bar[XB_TOPGEN]) == tg, bar);
            __builtin_amdgcn_fence(__ATOMIC_ACQUIRE, "agent");
            xb_add(&bar[XB_XGEN(b.x)], 1u);
            asm volatile("s_waitcnt vmcnt(0)" ::: "memory");
        } else {
            XB_SPIN(xb_ld(&bar[XB_XGEN(b.x)]) == gen, bar);
            __builtin_amdgcn_fence(__ATOMIC_ACQUIRE, "agent");
            asm volatile("s_waitcnt vmcnt(0)" ::: "memory");
        }
    }
    __syncthreads();
}
constexpr int NWAVES = 8, NTHR = 512;
constexpr int BATCH = 2, SEQ = 8192, DM = 1024, MTOK = BATCH * SEQ;
constexpr int NIN = 3584;
constexpr int AW = 512;
constexpr int NEXP = 16, DFF = 1024, CAP = 1024, NROWS = BATCH * NEXP * CAP;
constexpr int NSC = 32, SCLEN = 256;
constexpr int NHEAD = 16, HD = 64, NQKV = 3072;
constexpr float EPS = 1e-6f;
constexpr int NPHASE = 21;

constexpr size_t MiB = 1u << 20;
constexpr size_t WS_CTL = 0, CTL_ZERO_BYTES = 1 * MiB;
constexpr size_t WS_AFF = 1 * MiB;
constexpr size_t WS_POS = 2 * MiB;
constexpr size_t WS_IDX = 3 * MiB;
constexpr size_t WS_GATE = 3 * MiB + 256 * 1024;
constexpr size_t WS_DEC = 3 * MiB + 512 * 1024;
constexpr size_t WS_LB = 4 * MiB;
constexpr size_t WS_BT = 4 * MiB + 64 * 1024;
constexpr size_t WS_WIN = 8 * MiB;
constexpr size_t WS_WOUT = 15 * MiB;
constexpr size_t WS_WQKV = 17 * MiB;
constexpr size_t WS_WO = 23 * MiB;
constexpr size_t WS_WSB = 25 * MiB;
constexpr size_t WS_WGU = 32 * MiB;
constexpr size_t WS_WDN = 96 * MiB;
constexpr size_t WS_H = 128 * MiB;
constexpr size_t WS_R1 = 160 * MiB;
constexpr size_t WS_U = WS_R1, WS_GV = WS_R1 + 16 * MiB, WS_Q = WS_R1 + 32 * MiB, WS_V = WS_R1 + 48 * MiB, WS_G = WS_R1 + 64 * MiB;
constexpr size_t WS_LFF = WS_R1 + 80 * MiB, WS_LFB = WS_R1 + 112 * MiB;
constexpr size_t WS_CAT = WS_R1 + 144 * MiB;
constexpr size_t WS_ST = WS_R1 + 176 * MiB;
constexpr size_t WS_ODIR = WS_R1 + 208 * MiB;
constexpr size_t WS_XE = WS_R1, WS_Y = WS_R1;
constexpr size_t WS_HMID = WS_R1 + 64 * MiB;
constexpr size_t WS_QKV = WS_R1;
constexpr size_t WS_ATT = WS_R1 + 96 * MiB;
constexpr size_t WS_KF = WS_R1 + 128 * MiB;
constexpr size_t WS_VF = WS_R1 + 224 * MiB;
constexpr size_t WS_END = WS_R1 + 320 * MiB;
constexpr int CW_BAR = 4096;
constexpr int MAX_BAR_REGIONS = 24;

constexpr int RING_BYTES = 131072;
constexpr int LDS_BYTES = 147456;
constexpr int LDSCTL_OFF = LDS_BYTES - 512, MISC_OFF = LDSCTL_OFF + 320;

struct Args { const float* in[19]; float* out; unsigned char* ws; int ph_lo, ph_hi, li, pad; };

struct Frame {
    LAS unsigned char* lds;
    volatile LAS unsigned* MISC;
    int tid, lane, wave, G, bid, gw, NGW;
    unsigned char* ws;
};

template <int NPN_> struct GroupedOrder {
    int G, c;
    DI bool next(int i, pg8::Unit& u) const {
        const int L = i * G + c; if (L >= 16 * 8 * NPN_) return false;
        const int e = L / (8 * NPN_), w = L % (8 * NPN_);
        u.pm = e * 8 + (w & 7); u.pn = e * NPN_ + (w >> 3); return true;
    }
    DI void a_ready(const pg8::Unit&) const {}
    DI void done(const pg8::Unit&) const {}
};

struct EpiInProj {
    static constexpr bool PERM = true, AFTER_DRAIN = false;
    bf16 *U, *GV, *Q, *V, *G; float *LFf, *LFb; const float* LB;
    DI void operator()(const pg8::f32x4 (&acc)[2][2][4][2], const pg8::Unit& u, int wr, int wc, int fr, int fq) const {
        const int seg = u.pn >> 1;
        const int row0 = u.pm * 256 + wr * 64 + fr, lc0 = (u.pn & 1) * 256 + wc * 32 + 8 * fq;
#pragma unroll
        for (int bj = 0; bj < 2; ++bj) {
            const int lc = lc0 + bj * 128;
            float lb[8];
            if (seg == 3 || seg == 4) {
#pragma unroll
                for (int j = 0; j < 8; ++j) lb[j] = LB[(seg - 3) * 512 + lc + j];
            }
#pragma unroll
            for (int ai = 0; ai < 2; ++ai)
#pragma unroll
                for (int m = 0; m < 4; ++m) {
                    const size_t off = (size_t)(row0 + ai * 128 + m * 16) * 512 + lc;
                    float v[8];
#pragma unroll
                    for (int j = 0; j < 8; ++j) v[j] = acc[ai][bj][m][j >> 2][j & 3];
                    if (seg == 3 || seg == 4) {
#pragma unroll
                        for (int j = 0; j < 8; ++j) v[j] = flog(lb[j] + (1.f - lb[j]) * sigmoidf_(v[j]));
                        float* o = (seg == 3 ? LFf : LFb) + off;
                        *(f32x4*)o = (f32x4){v[0], v[1], v[2], v[3]}; *(f32x4*)(o + 4) = (f32x4){v[4], v[5], v[6], v[7]};
                    } else {
                        bf16* o;
                        if (seg == 0) { o = U;
#pragma unroll
                            for (int j = 0; j < 8; ++j) v[j] = gelu_tanh(v[j]);
                        } else if (seg == 1) { o = GV;
#pragma unroll
                            for (int j = 0; j < 8; ++j) v[j] = gelu_tanh(v[j]);
                        } else if (seg == 2) { o = Q;
#pragma unroll
                            for (int j = 0; j < 8; ++j) v[j] = siluf_(v[j]);
                        } else if (seg == 5) { o = V;
                        } else { o = G;
#pragma unroll
                            for (int j = 0; j < 8; ++j) v[j] = sigmoidf_(v[j]);
                        }
                        v4u w; w.x = pk2(v[0], v[1]); w.y = pk2(v[2], v[3]); w.z = pk2(v[4], v[5]); w.w = pk2(v[6], v[7]);
                        *(v4u*)(o + off) = w;
                    }
                }
        }
    }
};
struct EpiResid {
    static constexpr bool PERM = false, AFTER_DRAIN = false;
    const float* base; float* out;
    DI void operator()(const pg8::f32x4 (&acc)[2][2][4][2], const pg8::Unit& u, int wr, int wc, int fr, int fq) const {
        const int row0 = u.pm * 256 + wr * 64 + fr, col0 = u.pn * 256 + wc * 32 + 4 * fq;
#pragma unroll
        for (int ai = 0; ai < 2; ++ai)
#pragma unroll
            for (int m = 0; m < 4; ++m) { const size_t ro = (size_t)(row0 + ai * 128 + m * 16) * DM + col0;
#pragma unroll
                for (int bj = 0; bj < 2; ++bj)
#pragma unroll
                    for (int n = 0; n < 2; ++n) { const size_t o = ro + bj * 128 + n * 16; *(f32x4*)(out + o) = *(const f32x4*)(base + o) + acc[ai][bj][m][n]; } }
    }
};
struct EpiGateUp {
    static constexpr bool PERM = true, AFTER_DRAIN = false;
    bf16* H;
    DI void operator()(const pg8::f32x4 (&acc)[2][2][4][2], const pg8::Unit& u, int wr, int wc, int fr, int fq) const {
        const int pnl = u.pn & 7;
        const int row0 = u.pm * 256 + wr * 64 + fr, col0 = pnl * 128 + wc * 32 + 8 * fq;
#pragma unroll
        for (int ai = 0; ai < 2; ++ai)
#pragma unroll
            for (int m = 0; m < 4; ++m) {
                float v[8];
#pragma unroll
                for (int j = 0; j < 8; ++j) v[j] = siluf_(acc[ai][0][m][j >> 2][j & 3]) * acc[ai][1][m][j >> 2][j & 3];
                v4u w; w.x = pk2(v[0], v[1]); w.y = pk2(v[2], v[3]); w.z = pk2(v[4], v[5]); w.w = pk2(v[6], v[7]);
                *(v4u*)(H + (size_t)(row0 + ai * 128 + m * 16) * DFF + col0) = w;
            }
    }
};
struct EpiDown {
    static constexpr bool PERM = true, AFTER_DRAIN = false;
    bf16* Y; const float* gate;
    DI void operator()(const pg8::f32x4 (&acc)[2][2][4][2], const pg8::Unit& u, int wr, int wc, int fr, int fq) const {
        const int pnl = u.pn & 3;
        const int row0 = u.pm * 256 + wr * 64 + fr, col0 = pnl * 256 + wc * 32 + 8 * fq;
#pragma unroll
        for (int ai = 0; ai < 2; ++ai)
#pragma unroll
            for (int m = 0; m < 4; ++m) { const int row = row0 + ai * 128 + m * 16; const float g = gate[row];
#pragma unroll
                for (int bj = 0; bj < 2; ++bj) {
                    float v[8];
#pragma unroll
                    for (int j = 0; j < 8; ++j) v[j] = acc[ai][bj][m][j >> 2][j & 3] * g;
                    v4u w; w.x = pk2(v[0], v[1]); w.y = pk2(v[2], v[3]); w.z = pk2(v[4], v[5]); w.w = pk2(v[6], v[7]);
                    *(v4u*)(Y + (size_t)row * DM + col0 + bj * 128) = w; } }
    }
};
struct EpiQKV {
    static constexpr bool PERM = true, AFTER_DRAIN = false;
    bf16* O;
    DI void operator()(const pg8::f32x4 (&acc)[2][2][4][2], const pg8::Unit& u, int wr, int wc, int fr, int fq) const {
        const float sc = (u.pn < 4) ? 0.125f : 1.f;
        const int row0 = u.pm * 256 + wr * 64 + fr, col0 = u.pn * 256 + wc * 32 + 8 * fq;
#pragma unroll
        for (int ai = 0; ai < 2; ++ai)
#pragma unroll
            for (int m = 0; m < 4; ++m)
#pragma unroll
                for (int bj = 0; bj < 2; ++bj) {
                    float v[8];
#pragma unroll
                    for (int j = 0; j < 8; ++j) v[j] = acc[ai][bj][m][j >> 2][j & 3] * sc;
                    v4u w; w.x = pk2(v[0], v[1]); w.y = pk2(v[2], v[3]); w.z = pk2(v[4], v[5]); w.w = pk2(v[6], v[7]);
                    *(v4u*)(O + (size_t)(row0 + ai * 128 + m * 16) * NQKV + col0 + bj * 128) = w; }
    }
};

DI void transpose_item(const float* W, int K, int N, bf16* WT, LAS float* scr, int k0, int n0, int drow0, int lane) {
#pragma unroll 8
    for (int i = 0; i < 32; ++i) { const int kk = 2 * i + (lane >> 5); scr[kk * 33 + (lane & 31)] = W[(size_t)(k0 + kk) * N + n0 + (lane & 31)]; }
    LDS_WAIT(); asm volatile("" ::: "memory");
    const int c = lane & 7;
#pragma unroll
    for (int j = 0; j < 4; ++j) { const int n = (lane >> 3) + 8 * j; const LAS float* s = scr + (8 * c) * 33 + n;
        v4u o; o.x = pk2(s[0 * 33], s[1 * 33]); o.y = pk2(s[2 * 33], s[3 * 33]); o.z = pk2(s[4 * 33], s[5 * 33]); o.w = pk2(s[6 * 33], s[7 * 33]);
        *(v4u*)(WT + (size_t)(drow0 + n) * K + k0 + 8 * c) = o; }
    LDS_WAIT(); asm volatile("" ::: "memory");
}
DI void transpose_matrix(Frame& F, const float* W, int K, int N, bf16* WT) {
    LAS float* scr = (LAS float*)(F.lds + F.wave * 16384);
    const int nblk = N / 32, nitems = (K / 64) * nblk;
    for (int it = F.gw; it < nitems; it += F.NGW) { const int kb = it / nblk, nb = it % nblk; transpose_item(W, K, N, WT, scr, 64 * kb, 32 * nb, 32 * nb, F.lane); }
}
DI void convert_moe_weights(Frame& F, const float* wg, const float* wu, const float* wd, int layer, int nskip = 0) {
    LAS float* scr = (LAS float*)(F.lds + F.wave * 16384);
    bf16* WGU = (bf16*)(F.ws + WS_WGU); bf16* WDN = (bf16*)(F.ws + WS_WDN);
    if (F.bid < nskip) return;
    for (int it = F.gw - nskip * NWAVES; it < 3 * 16 * 512; it += F.NGW - nskip * NWAVES) {
        const int mat = it / 8192, rem = it % 8192, e = rem / 512, r = rem % 512, kb = r / 32, nb = r % 32, n0 = 32 * nb;
        const size_t so = ((size_t)layer * 16 + e) * 1024 * 1024;
        if (mat == 0) transpose_item(wg + so, 1024, 1024, WGU + (size_t)e * 2048 * 1024, scr, 64 * kb, n0, (n0 >> 7) * 256 + (n0 & 127), F.lane);
        else if (mat == 1) transpose_item(wu + so, 1024, 1024, WGU + (size_t)e * 2048 * 1024, scr, 64 * kb, n0, (n0 >> 7) * 256 + 128 + (n0 & 127), F.lane);
        else transpose_item(wd + so, 1024, 1024, WDN + (size_t)e * 1024 * 1024, scr, 64 * kb, n0, n0, F.lane);
    }
}
DI void rms_row(const float* xrow, const float* g, f32x4 (&v)[4], int lane) {
    const f32x4* xr = (const f32x4*)xrow + lane; float s = 0.f;
#pragma unroll
    for (int j = 0; j < 4; ++j) { v[j] = xr[64 * j]; s += (v[j].x * v[j].x + v[j].y * v[j].y) + (v[j].z * v[j].z + v[j].w * v[j].w); }
    const float rstd = 1.f / sqrtf(wave_sum(s) * (1.f / DM) + EPS);
    const f32x4* gr = (const f32x4*)g + lane;
#pragma unroll
    for (int j = 0; j < 4; ++j) v[j] = v[j] * rstd * gr[64 * j];
}
DI void store_row_bf16(bf16* orow, const f32x4 (&v)[4], int lane) {
    v2u* o8 = (v2u*)orow + lane;
#pragma unroll
    for (int j = 0; j < 4; ++j) { v2u w; w.x = pk2(v[j].x, v[j].y); w.y = pk2(v[j].z, v[j].w); o8[64 * j] = w; }
}
DI int t5_bucket(int rel) {
    const int n = rel < 0 ? -rel : rel;
    int val;
    if (n < 8) val = n;
    else { const float sc = logf((float)n / 8.f) / 4.852030263919617f; int lg = 8 + (int)(sc * 8.f); val = lg < 15 ? lg : 15; }
    return (rel > 0 ? 16 : 0) + val;
}

typedef float f32x16 __attribute__((ext_vector_type(16)));
#define MFMA32(a, b, c) __builtin_amdgcn_mfma_f32_32x32x16_bf16((a), (b), (c), 0, 0, 0)
DI int crow32(int j, int hh) { return (j & 3) + 8 * (j >> 2) + 4 * hh; }
DI void phase_prologue(Frame& F, const Args& a) {
    unsigned char* ws = F.ws;
    transpose_matrix(F, a.in[4], 1024, NIN, (bf16*)(ws + WS_WIN));
    transpose_matrix(F, a.in[5], 1024, 1024, (bf16*)(ws + WS_WOUT));
    transpose_matrix(F, a.in[12], 1024, NQKV, (bf16*)(ws + WS_WQKV));
    transpose_matrix(F, a.in[13], 1024, 1024, (bf16*)(ws + WS_WO));
    { bf16* WSB = (bf16*)(ws + WS_WSB); for (int i = F.bid * NTHR + F.tid; i < 4 * 128 * 128; i += F.G * NTHR) WSB[i] = (bf16)f2bf(a.in[8][i]); }
    { float* LB = (float*)(ws + WS_LB); const float* t = a.in[10];
      for (int i = F.bid * NTHR + F.tid; i < 2 * 512; i += F.G * NTHR) { const int d = i / 512, k = i % 512;
          const float a0 = t[(d * 3 + 0) * 512 + k], a1 = t[(d * 3 + 1) * 512 + k], a2 = t[(d * 3 + 2) * 512 + k];
          const float mx = fmaxf(a0, fmaxf(a1, a2)); const float e0 = expf(a0 - mx), e1 = expf(a1 - mx), e2 = expf(a2 - mx);
          LB[i] = e0 / (e0 + e1 + e2); } }
    { float* BT = (float*)(ws + WS_BT); const float* rb = a.in[14];
      for (int i = F.bid * NTHR + F.tid; i < 3 * 16 * 129; i += F.G * NTHR) { const int p = i / (16 * 129), h = (i / 129) % 16, j = i % 129;
          const int dil = (p == 0) ? 1 : (p == 1 ? 4 : 16);
          BT[i] = rb[t5_bucket((j - 64) * dil) * 16 + h]; } }
    { bf16* H = (bf16*)(ws + WS_H); const float* x = a.in[0];
      for (int m = F.gw; m < MTOK; m += F.NGW) { f32x4 v[4]; rms_row(x + (size_t)m * DM, a.in[1], v, F.lane); store_row_bf16(H + (size_t)m * DM, v, F.lane); } }
}

DI void phase_a_ln(Frame& F, const Args& a, bool dry = false) {
    bf16* GV = (bf16*)(F.ws + WS_GV); bf16* GO = dry ? (bf16*)(F.ws + WS_ODIR) : GV; const float* lg = a.in[6]; const float* lbv = a.in[7];
    for (int m = F.gw; m < MTOK; m += F.NGW) {
        v4u w = *((const v4u*)(GV + (size_t)m * AW) + F.lane);
        float v[8] = {bflo(w.x), bfhi(w.x), bflo(w.y), bfhi(w.y), bflo(w.z), bfhi(w.z), bflo(w.w), bfhi(w.w)};
        float s = 0.f;
#pragma unroll
        for (int j = 0; j < 8; ++j) s += v[j];
        const float mu = wave_sum(s) * (1.f / AW); float s2 = 0.f;
#pragma unroll
        for (int j = 0; j < 8; ++j) { v[j] -= mu; s2 += v[j] * v[j]; }
        const float rstd = 1.f / sqrtf(wave_sum(s2) * (1.f / AW) + EPS);
#pragma unroll
        for (int j = 0; j < 8; ++j) v[j] = v[j] * rstd * lg[8 * F.lane + j] + lbv[8 * F.lane + j];
        v4u o; o.x = pk2(v[0], v[1]); o.y = pk2(v[2], v[3]); o.z = pk2(v[4], v[5]); o.w = pk2(v[6], v[7]);
        *((v4u*)(GO + (size_t)m * AW) + F.lane) = o;
    }
}
DI void phase_a_mix_naive(Frame& F, const Args& a) {
    const bf16* VN = (const bf16*)(F.ws + WS_GV); const bf16* U = (const bf16*)(F.ws + WS_U); bf16* CAT = (bf16*)(F.ws + WS_CAT);
    LAS float* wl = (LAS float*)F.lds; LAS float* vl = (LAS float*)(F.lds + 65536);
    for (int u = F.bid; u < 512; u += F.G) {
        const int g = u & 3, ch = u >> 2; const int row0 = ch * 128;
        __syncthreads();
        for (int i = F.tid; i < 128 * 128; i += NTHR) { wl[i] = a.in[8][g * 16384 + i]; const int s = i >> 7, c = i & 127; vl[i] = bf2f(VN[(size_t)(row0 + s) * AW + g * 128 + c]); }
        __syncthreads();
        const int c = F.tid & 127, tq = F.tid >> 7;
        for (int tt = 0; tt < 32; ++tt) { const int t = tq * 32 + tt; float acc = 0.f;
            for (int s = 0; s < 128; ++s) acc += wl[t * 128 + s] * vl[s * 128 + c];
            const float uu = bf2f(U[(size_t)(row0 + t) * AW + g * 128 + c]);
            CAT[(size_t)(row0 + t) * DM + g * 128 + c] = (bf16)f2bf(uu * (acc + a.in[9][g * 128 + t])); }
    }
}

DI void phase_a_mix(Frame& F, const Args& a) {
    const bf16* VN = (const bf16*)(F.ws + WS_GV); const bf16* U = (const bf16*)(F.ws + WS_U); bf16* CAT = (bf16*)(F.ws + WS_CAT); const bf16* WSB = (const bf16*)(F.ws + WS_WSB);
    const int r32 = F.lane & 31, hh = F.lane >> 5, ci = F.wave & 3, tp = F.wave >> 2;
    for (int u = F.bid; u < 512; u += F.G) {
        const int g = u & 3, ch = u >> 2; const int row0 = ch * 128;
        f32x16 acc[2];
#pragma unroll
        for (int j = 0; j < 16; ++j) { acc[0][j] = 0.f; acc[1][j] = 0.f; }
        const bf16* vcol = VN + (size_t)row0 * AW + g * 128 + 32 * ci + r32;
        const bf16* w0 = WSB + (size_t)g * 16384 + (size_t)(64 * tp + r32) * 128 + 8 * hh;
#pragma unroll
        for (int s = 0; s < 8; ++s) {
            unsigned short e[8];
#pragma unroll
            for (int j = 0; j < 8; ++j) e[j] = vcol[(size_t)(16 * s + 8 * hh + j) * AW];
            v4u bw; bw.x = e[0] | ((unsigned)e[1] << 16); bw.y = e[2] | ((unsigned)e[3] << 16); bw.z = e[4] | ((unsigned)e[5] << 16); bw.w = e[6] | ((unsigned)e[7] << 16);
            const bf16x8 bt = __builtin_bit_cast(bf16x8, bw);
            acc[0] = MFMA32(*(const bf16x8*)(w0 + 16 * s), bt, acc[0]);
            acc[1] = MFMA32(*(const bf16x8*)(w0 + 32 * 128 + 16 * s), bt, acc[1]);
        }
#pragma unroll
        for (int q = 0; q < 2; ++q)
#pragma unroll
            for (int j = 0; j < 16; ++j) { const int t = 64 * tp + 32 * q + crow32(j, hh), c = g * 128 + 32 * ci + r32;
                const float uu = bf2f(U[(size_t)(row0 + t) * AW + c]);
                CAT[(size_t)(row0 + t) * DM + c] = (bf16)f2bf(uu * (acc[q][j] + a.in[9][g * 128 + t])); }
    }
}

DI void gla_naive_unit(Frame& F, int u, bool with_out) {
    const int sc = u & 31, dir = (u >> 5) & 1, h = (u >> 6) & 3, b = u >> 8;
    const bf16* Q = (const bf16*)(F.ws + WS_Q); const bf16* V = (const bf16*)(F.ws + WS_V);
    const float* LF = (const float*)(F.ws + (dir ? WS_LFB : WS_LFF));
    float* ST = (float*)(F.ws + WS_ST) + (size_t)u * 16384; float* DEC = (float*)(F.ws + WS_DEC) + u * 128;
    float* OD = (float*)(F.ws + WS_ODIR) + (size_t)dir * MTOK * AW;
    LAS bf16* qs = (LAS bf16*)F.lds; LAS bf16* vs = (LAS bf16*)(F.lds + 16384); LAS float* lfs = (LAS float*)(F.lds + 32768);
    const int lane = F.lane, w = F.wave;
    float S[2][16]; float lsum[2] = {0.f, 0.f};
#pragma unroll
    for (int aa = 0; aa < 2; ++aa)
#pragma unroll
        for (int j = 0; j < 16; ++j) S[aa][j] = with_out ? ST[(lane + 64 * aa) * 128 + 16 * w + j] : 0.f;
    for (int sub = 0; sub < 4; ++sub) {
        __syncthreads();
        for (int idx = F.tid; idx < 1024; idx += NTHR) { const int i = idx >> 4, c8 = (idx & 15) * 8; const int ii = sc * 256 + sub * 64 + i; const int tok = dir ? (SEQ - 1 - ii) : ii;
            const size_t go = (size_t)(b * SEQ + tok) * AW + h * 128 + c8;
            *(LAS v4u*)(qs + i * 128 + c8) = *(const v4u*)(Q + go); *(LAS v4u*)(vs + i * 128 + c8) = *(const v4u*)(V + go); }
        for (int idx = F.tid; idx < 2048; idx += NTHR) { const int i = idx >> 5, c4 = (idx & 31) * 4; const int ii = sc * 256 + sub * 64 + i; const int tok = dir ? (SEQ - 1 - ii) : ii;
            *(LAS f32x4*)(lfs + i * 128 + c4) = *(const f32x4*)(LF + (size_t)(b * SEQ + tok) * AW + h * 128 + c4); }
        __syncthreads();
        for (int i = 0; i < 64; ++i) {
            const float l0 = lfs[i * 128 + lane], l1 = lfs[i * 128 + lane + 64];
            const float f0 = fexp(l0), f1 = fexp(l1), k0 = 1.f - f0, k1 = 1.f - f1;
            lsum[0] += l0; lsum[1] += l1;
            float vv[16];
            { const v4u a0 = *(const LAS v4u*)(vs + i * 128 + 16 * w), a1 = *(const LAS v4u*)(vs + i * 128 + 16 * w + 8);
              vv[0] = bflo(a0.x); vv[1] = bfhi(a0.x); vv[2] = bflo(a0.y); vv[3] = bfhi(a0.y); vv[4] = bflo(a0.z); vv[5] = bfhi(a0.z); vv[6] = bflo(a0.w); vv[7] = bfhi(a0.w);
              vv[8] = bflo(a1.x); vv[9] = bfhi(a1.x); vv[10] = bflo(a1.y); vv[11] = bfhi(a1.y); vv[12] = bflo(a1.z); vv[13] = bfhi(a1.z); vv[14] = bflo(a1.w); vv[15] = bfhi(a1.w); }
#pragma unroll
            for (int j = 0; j < 16; ++j) { S[0][j] = f0 * S[0][j] + k0 * vv[j]; S[1][j] = f1 * S[1][j] + k1 * vv[j]; }
            if (with_out) {
                const float q0 = bf2f(qs[i * 128 + lane]), q1 = bf2f(qs[i * 128 + lane + 64]);
                float o[16];
#pragma unroll
                for (int j = 0; j < 16; ++j) o[j] = S[0][j] * q0 + S[1][j] * q1;
                const float tot = red16(o, lane);
                if ((lane & 3) == 0) { const int ii = sc * 256 + sub * 64 + i; const int tok = dir ? (SEQ - 1 - ii) : ii;
                    OD[(size_t)(b * SEQ + tok) * AW + h * 128 + 16 * w + red16_idx(lane)] = tot; }
            }
        }
    }
    if (!with_out) {
#pragma unroll
        for (int aa = 0; aa < 2; ++aa)
#pragma unroll
            for (int j = 0; j < 16; ++j) ST[(lane + 64 * aa) * 128 + 16 * w + j] = S[aa][j];
        if (w == 0) { DEC[lane] = fexp(lsum[0]); DEC[lane + 64] = fexp(lsum[1]); }
    }
}
DI void phase_gla_scan(Frame& F, bool dry = false) {
    float* ST = (float*)(F.ws + WS_ST); float* SO = dry ? (float*)(F.ws + WS_ODIR) : ST; const float* DEC = (const float*)(F.ws + WS_DEC);
    for (int idx = F.bid * NTHR + F.tid; idx < 16 * 16384; idx += F.G * NTHR) {
        const int chain = idx >> 14, kv = idx & 16383, k = kv >> 7; float S = 0.f;
        for (int sc = 0; sc < NSC; ++sc) { const int u = chain * NSC + sc; const size_t o = (size_t)u * 16384 + kv; const float d = ST[o]; SO[o] = S; S = S * DEC[u * 128 + k] + d; }
    }
}
DI void phase_b_combine(Frame& F, const Args& a) {
    const float* OD = (const float*)(F.ws + WS_ODIR); const bf16* G = (const bf16*)(F.ws + WS_G); bf16* CAT = (bf16*)(F.ws + WS_CAT); const float* ng = a.in[11];
    for (int t = F.gw; t < MTOK * 4; t += F.NGW) { const int row = t >> 2, h = t & 3; const size_t o = (size_t)row * AW + h * 128 + 2 * F.lane;
        const float o0 = OD[o] + OD[(size_t)MTOK * AW + o], o1 = OD[o + 1] + OD[(size_t)MTOK * AW + o + 1];
        const float rstd = 1.f / sqrtf(wave_sum(o0 * o0 + o1 * o1) * (1.f / 128.f) + EPS);
        const unsigned gw2 = *(const unsigned*)(G + o);
        const float r0 = o0 * rstd * ng[h * 128 + 2 * F.lane] * bflo(gw2), r1 = o1 * rstd * ng[h * 128 + 2 * F.lane + 1] * bfhi(gw2);
        *(unsigned*)(CAT + (size_t)row * DM + 512 + h * 128 + 2 * F.lane) = pk2(r0, r1); }
}

DI void phase_router(Frame& F, const float* XR, const float* gn, const float* wr) {
    LAS float* wl = (LAS float*)F.lds;
    __syncthreads();
    for (int i = F.tid; i < 1024 * 16 / 4; i += NTHR) { const f32x4 w4 = *(const f32x4*)(wr + 4 * i); const int d = i >> 2, e0 = 4 * (i & 3);
        wl[(e0 + 0) * 1024 + d] = w4.x; wl[(e0 + 1) * 1024 + d] = w4.y; wl[(e0 + 2) * 1024 + d] = w4.z; wl[(e0 + 3) * 1024 + d] = w4.w; }
    __syncthreads();
    bf16* H = (bf16*)(F.ws + WS_H); float* AFF = (float*)(F.ws + WS_AFF);
    for (int m = F.gw; m < MTOK; m += F.NGW) {
        asm volatile("" ::: "memory");
        f32x4 v[4]; rms_row(XR + (size_t)m * DM, gn, v, F.lane); store_row_bf16(H + (size_t)m * DM, v, F.lane);
        float p[16];
#pragma unroll
        for (int e = 0; e < 16; ++e) { float a = 0.f;
#pragma unroll
            for (int j = 0; j < 4; ++j) { const f32x4 w4 = *(const LAS f32x4*)(wl + e * 1024 + 4 * F.lane + 256 * j); a += (v[j].x * w4.x + v[j].y * w4.y) + (v[j].z * w4.z + v[j].w * w4.w); }
            p[e] = a; }
        const float lg = red16(p, F.lane);
        const float mx = wave_max(lg); const float ex = expf(lg - mx); const float sm = wave_sum(ex) * 0.25f;
        if ((F.lane & 3) == 0) { const int b = m / SEQ, s = m % SEQ; AFF[(size_t)(b * 16 + red16_idx(F.lane)) * SEQ + s] = ex / sm; }
    }
}

DI int block_excl_scan(int v, LAS int* scratch, int tid, int lane, int wave, int* tot) {
    int inc = v;
#pragma unroll
    for (int o = 1; o < 64; o <<= 1) { const int t = __shfl_up(inc, o); if (lane >= o) inc += t; }
    __syncthreads();
    if (lane == 63) scratch[wave] = inc;
    __syncthreads();
    int base = 0, total = 0;
#pragma unroll
    for (int w = 0; w < NWAVES; ++w) { const int s = scratch[w]; if (w < wave) base += s; total += s; }
    *tot = total;
    return base + inc - v;
}
DI void phase_topk(Frame& F) {
    const float* AFF = (const float*)(F.ws + WS_AFF); int* IDX = (int*)(F.ws + WS_IDX); float* GATE = (float*)(F.ws + WS_GATE); int* POS = (int*)(F.ws + WS_POS);
    LAS unsigned* hist = (LAS unsigned*)F.lds; LAS int* sc = (LAS int*)(F.lds + 16384); LAS unsigned* shv = (LAS unsigned*)(F.lds + 16384 + 256);
    for (int u = F.bid; u < BATCH * NEXP; u += F.G) {
        const int b = u / NEXP, e = u % NEXP;
        unsigned vals[16];
        { const v4u* src = (const v4u*)(AFF + (size_t)u * SEQ + 16 * F.tid);
#pragma unroll
          for (int j = 0; j < 4; ++j) { const v4u t = src[j]; vals[4 * j] = t.x; vals[4 * j + 1] = t.y; vals[4 * j + 2] = t.z; vals[4 * j + 3] = t.w; } }
        unsigned prefix = 0; int krem = CAP;
#pragma unroll
        for (int pass = 0; pass < 3; ++pass) {
            const int shift = (pass == 0) ? 20 : (pass == 1 ? 8 : 0); const unsigned mask = (pass == 2) ? 255u : 4095u; const int pshift = (pass == 2) ? 8 : 20;
            __syncthreads();
#pragma unroll
            for (int j = 0; j < 8; ++j) hist[F.tid + 512 * j] = 0u;
            __syncthreads();
#pragma unroll
            for (int j = 0; j < 16; ++j) { const unsigned v = vals[j]; if (pass == 0 || (v >> pshift) == prefix) __hip_atomic_fetch_add(&hist[(v >> shift) & mask], 1u, __ATOMIC_RELAXED, __HIP_MEMORY_SCOPE_WORKGROUP); }
            __syncthreads();
            const int hi = 4095 - 8 * F.tid; int ls = 0; unsigned hb[8];
#pragma unroll
            for (int j = 0; j < 8; ++j) { hb[j] = hist[hi - j]; ls += (int)hb[j]; }
            int tot; const int above = block_excl_scan(ls, sc, F.tid, F.lane, F.wave, &tot);
            if (above < krem && krem <= above + ls) { int cum = above, sel = hi, found = 0;
#pragma unroll
                for (int j = 0; j < 8; ++j) { if (!found) { if (cum + (int)hb[j] >= krem) { sel = hi - j; found = 1; } else cum += (int)hb[j]; } }
                shv[0] = (unsigned)sel; shv[1] = (unsigned)(krem - cum); }
            __syncthreads();
            prefix = (pass == 2) ? ((prefix << 8) | shv[0]) : ((prefix << 12) | shv[0]); krem = (int)shv[1];
        }
        const unsigned T = prefix;
        int ce = 0;
#pragma unroll
        for (int j = 0; j < 16; ++j) ce += (vals[j] == T) ? 1 : 0;
        int tot; int pe = block_excl_scan(ce, sc, F.tid, F.lane, F.wave, &tot);
        unsigned selmask = 0; int cs = 0;
#pragma unroll
        for (int j = 0; j < 16; ++j) { bool s = vals[j] > T; if (vals[j] == T) { s = pe < krem; ++pe; } if (s) { selmask |= 1u << j; ++cs; } }
        int slot = block_excl_scan(cs, sc, F.tid, F.lane, F.wave, &tot);
#pragma unroll
        for (int j = 0; j < 16; ++j) { const int s = 16 * F.tid + j; const int tokrow = b * SEQ + s;
            if (selmask & (1u << j)) { const int row = (e * 2 + b) * CAP + slot; ++slot; IDX[row] = tokrow; GATE[row] = __builtin_bit_cast(float, vals[j]); POS[tokrow * 16 + e] = row; }
            else POS[tokrow * 16 + e] = -1; }
    }
}
DI void phase_gather(Frame& F) {
    const bf16* H = (const bf16*)(F.ws + WS_H); bf16* XE = (bf16*)(F.ws + WS_XE); const int* IDX = (const int*)(F.ws + WS_IDX);
    for (int r = F.gw; r < NROWS; r += F.NGW) { const int src = IDX[r];
        const v4u* s = (const v4u*)(H + (size_t)src * DM) + F.lane; v4u* d = (v4u*)(XE + (size_t)r * DM) + F.lane;
        d[0] = s[0]; d[64] = s[64]; }
}
DI void phase_moe_combine(Frame& F, float* XR, const float* gnext, bool final_out, bool dry = false) {
    const bf16* Y = (const bf16*)(F.ws + WS_Y); const int* POS = (const int*)(F.ws + WS_POS); bf16* H = (bf16*)(F.ws + (dry ? WS_R1 + 256 * MiB : WS_H));
    float* XO = dry ? (float*)(F.ws + WS_R1 + 192 * MiB) : XR;
    for (int m = F.gw; m < MTOK; m += F.NGW) {
        const f32x4* xr = (const f32x4*)(XR + (size_t)m * DM) + F.lane; f32x4* xo = (f32x4*)(XO + (size_t)m * DM) + F.lane;
        f32x4 v[4];
#pragma unroll
        for (int j = 0; j < 4; ++j) v[j] = xr[64 * j];
        const int pmine = POS[m * 16 + (F.lane & 15)];
        for (int e = 0; e < 16; ++e) { const int p = __shfl(pmine, e);
            if (p >= 0) { const v2u* yr = (const v2u*)(Y + (size_t)p * DM) + F.lane;
#pragma unroll
                for (int j = 0; j < 4; ++j) { const v2u w = yr[64 * j]; v[j].x += bflo(w.x); v[j].y += bfhi(w.x); v[j].z += bflo(w.y); v[j].w += bfhi(w.y); } } }
        float s = 0.f;
#pragma unroll
        for (int j = 0; j < 4; ++j) s += (v[j].x * v[j].x + v[j].y * v[j].y) + (v[j].z * v[j].z + v[j].w * v[j].w);
        const float rstd = 1.f / sqrtf(wave_sum(s) * (1.f / DM) + EPS);
        const f32x4* gr = (const f32x4*)gnext + F.lane;
        if (final_out) {
#pragma unroll
            for (int j = 0; j < 4; ++j) xo[64 * j] = v[j] * rstd * gr[64 * j];
        } else {
#pragma unroll
            for (int j = 0; j < 4; ++j) xo[64 * j] = v[j];
            f32x4 nv[4];
#pragma unroll
            for (int j = 0; j < 4; ++j) nv[j] = v[j] * rstd * gr[64 * j];
            store_row_bf16(H + (size_t)m * DM, nv, F.lane);
        }
    }
}

DI void phase_attn_naive(Frame& F) {
    const bf16* QKV = (const bf16*)(F.ws + WS_QKV); bf16* ATT = (bf16*)(F.ws + WS_ATT); const float* BT = (const float*)(F.ws + WS_BT);
    LAS float* ql = (LAS float*)(F.lds + F.wave * 4096);
    LAS float* pl = ql + 64; LAS int* posl = (LAS int*)(ql + 512);
    const int lane = F.lane;
    for (int t = F.gw; t < MTOK * NHEAD; t += F.NGW) {
        const int row = t >> 4, h = t & 15, b = row / SEQ, tq = row % SEQ;
        ql[lane] = bf2f(QKV[(size_t)row * NQKV + h * 64 + lane]);
        LDS_WAIT();
        float s[7]; int pos[7];
#pragma unroll
        for (int i = 0; i < 7; ++i) {
            const int slot = lane + 64 * i; const int p = slot / 129, j = slot % 129;
            const int dil = (p == 0) ? 1 : (p == 1 ? 4 : 16);
            const int mq = tq / dil, r = tq % dil, mk = mq - 64 + j;
            const bool valid = (slot < 387) && (mk >= 0) && (mk < SEQ / dil);
            pos[i] = valid ? (b * SEQ + r + dil * mk) : -1;
            float d = -1e30f;
            if (valid) { const v4u* kr = (const v4u*)(QKV + (size_t)pos[i] * NQKV + 1024 + h * 64); float acc = 0.f;
#pragma unroll
                for (int c = 0; c < 8; ++c) { const v4u w = kr[c];
                    acc += ql[8 * c] * bflo(w.x) + ql[8 * c + 1] * bfhi(w.x) + ql[8 * c + 2] * bflo(w.y) + ql[8 * c + 3] * bfhi(w.y) + ql[8 * c + 4] * bflo(w.z) + ql[8 * c + 5] * bfhi(w.z) + ql[8 * c + 6] * bflo(w.w) + ql[8 * c + 7] * bfhi(w.w); }
                d = acc + BT[(p * 16 + h) * 129 + j]; }
            s[i] = d;
        }
        float mx = s[0];
#pragma unroll
        for (int i = 1; i < 7; ++i) mx = fmaxf(mx, s[i]);
        mx = wave_max(mx);
        float sum = 0.f;
#pragma unroll
        for (int i = 0; i < 7; ++i) { const float pv = (pos[i] >= 0) ? expf(s[i] - mx) : 0.f; sum += pv; pl[lane + 64 * i] = pv; posl[lane + 64 * i] = pos[i]; }
        sum = wave_sum(sum);
        LDS_WAIT();
        float o = 0.f;
        for (int k = 0; k < 387; ++k) { const int pp = posl[k]; if (pp >= 0) o += pl[k] * bf2f(QKV[(size_t)pp * NQKV + 2048 + h * 64 + lane]); }
        ATT[(size_t)row * DM + h * 64 + lane] = (bf16)f2bf(o / sum);
        LDS_WAIT();
    }
}

DI int kperm(int r) { return (r & ~12) | ((r & 4) << 1) | ((r & 8) >> 1); }
DI void phase_kvf(Frame& F) {
    const bf16* QKV = (const bf16*)(F.ws + WS_QKV); unsigned char* KF = F.ws + WS_KF; unsigned char* VF = F.ws + WS_VF;
    LAS unsigned char* kl = F.lds; LAS unsigned char* vl = F.lds + 69632;
    for (int u = F.bid; u < 512; u += F.G) {
        const int c = u & 15, h = (u >> 4) & 15, b = u >> 8, t0 = c * 512;
        __syncthreads();
        { const v4u* ks = (const v4u*)(QKV + (size_t)(b * SEQ + t0 + F.tid) * NQKV + 1024 + h * 64); const v4u* vs = (const v4u*)(QKV + (size_t)(b * SEQ + t0 + F.tid) * NQKV + 2048 + h * 64);
#pragma unroll
          for (int j = 0; j < 8; ++j) { const v4u w = ks[j]; LAS v2u* d = (LAS v2u*)(kl + F.tid * 136 + 16 * j); d[0] = (v2u){w.x, w.y}; d[1] = (v2u){w.z, w.w}; }
#pragma unroll
          for (int j = 0; j < 8; ++j) { const v4u w = vs[j]; LAS v2u* d = (LAS v2u*)(vl + F.tid * 136 + 16 * j); d[0] = (v2u){w.x, w.y}; d[1] = (v2u){w.z, w.w}; } }
        __syncthreads();
#pragma unroll
        for (int p = 0; p < 3; ++p) {
            const int dl = (p == 0) ? 1 : (p == 1 ? 4 : 16), tpr = 16 / dl, ntile = SEQ / dl / 32;
            unsigned char* kd = KF + (size_t)p * 32 * MiB; unsigned char* vd = VF + (size_t)p * 32 * MiB;
#pragma unroll 2
            for (int i = 0; i < 8; ++i) { const int q = F.tid + 512 * i, tl = q >> 8, ln = q & 63, hh = ln >> 5, rho = ln & 31, r = tl / tpr, tt = tl % tpr;
                const size_t tg = ((size_t)((b * 16 + h) * dl + r) * ntile + c * tpr + tt) * 4096;
                { const int s = (q >> 6) & 3, tokl = dl * (32 * tt + kperm(rho)) + r;
                  const LAS v2u* sp = (const LAS v2u*)(kl + tokl * 136 + 64 * hh + 16 * s); const v2u a0 = sp[0], a1 = sp[1];
                  *(v4u*)(kd + tg + s * 1024 + ln * 16) = (v4u){a0.x, a0.y, a1.x, a1.y}; }
                { const int dt = (q >> 7) & 1, s2 = (q >> 6) & 1, dim = 32 * dt + rho; unsigned short e[8];
#pragma unroll
                  for (int k = 0; k < 8; ++k) e[k] = *(const LAS unsigned short*)(vl + (dl * (32 * tt + 16 * s2 + 8 * hh + k) + r) * 136 + dim * 2);
                  v4u o; o.x = e[0] | ((unsigned)e[1] << 16); o.y = e[2] | ((unsigned)e[3] << 16); o.z = e[4] | ((unsigned)e[5] << 16); o.w = e[6] | ((unsigned)e[7] << 16);
                  *(v4u*)(vd + tg + (dt * 2 + s2) * 1024 + ln * 16) = o; }
            }
        }
    }
}

DI int osw(int tok, int chunk) { return tok * 256 + (((chunk ^ tok ^ (tok >> 4)) & 15) << 4); }
struct AttnK { bf16x8 k[4]; }; struct AttnV { bf16x8 v[2][2]; };
#ifndef PROBE_DUP
#define PROBE_DUP (-1)
#endif
#ifndef PROBE_SAME
#define PROBE_SAME 0
#endif
DI void attn_load_k(AttnK& t, const unsigned char* kt) {
#pragma unroll
    for (int s = 0; s < 4; ++s) t.k[s] = *(const bf16x8*)(kt + s * 1024);
    if (PROBE_DUP == 77) {
#pragma unroll
        for (int s = 0; s < 4; ++s) { bf16x8 d = *(const bf16x8*)(kt + s * 1024 + (PROBE_SAME ? 0 : 64 * MiB)); asm volatile("" :: "v"(d)); }
    }
}
DI void attn_load_v(AttnV& t, const unsigned char* vt) {
#pragma unroll
    for (int dt = 0; dt < 2; ++dt)
#pragma unroll
        for (int s = 0; s < 2; ++s) t.v[dt][s] = *(const bf16x8*)(vt + (dt * 2 + s) * 1024);
}
template <bool MASK> DI void attn_step(const AttnK& tk, const AttnV& tv, const bf16x8 (&qf)[4], f32x16& o0, f32x16& o1, float& m, float& l, const LAS float* bl, int rel0, int hh) {
    f32x16 sa;
#pragma unroll
    for (int i = 0; i < 16; ++i) sa[i] = 0.f;
#pragma unroll
    for (int s = 0; s < 4; ++s) sa = MFMA32(tk.k[s], qf[s], sa);
    float sc[16]; float tmax = -1e30f;
#pragma unroll
    for (int i = 0; i < 16; ++i) { const int rel = rel0 + 16 * (i >> 3) + (i & 7);
        const bool valid = !MASK || ((rel >= -64) && (rel <= 64)); const int idx = valid ? rel + 64 : 0;
        const float v = sa[i] + bl[idx]; sc[i] = valid ? v : -1e30f; tmax = fmaxf(tmax, sc[i]); }
    tmax = fmaxf(tmax, __shfl_xor(tmax, 32));
    const float mnew = fmaxf(m, tmax), alpha = fexp(m - mnew);
    float ps = 0.f; float p[16];
#pragma unroll
    for (int i = 0; i < 16; ++i) { p[i] = (!MASK || sc[i] > -1e29f) ? fexp(sc[i] - mnew) : 0.f; ps += p[i]; }
    l = l * alpha + ps; m = mnew;
#pragma unroll
    for (int i = 0; i < 16; ++i) { o0[i] *= alpha; o1[i] *= alpha; }
#pragma unroll
    for (int s = 0; s < 2; ++s) {
        v4u w; w.x = pk2(p[8 * s], p[8 * s + 1]); w.y = pk2(p[8 * s + 2], p[8 * s + 3]); w.z = pk2(p[8 * s + 4], p[8 * s + 5]); w.w = pk2(p[8 * s + 6], p[8 * s + 7]);
        const bf16x8 pf = __builtin_bit_cast(bf16x8, w);
        o0 = MFMA32(tv.v[0][s], pf, o0); o1 = MFMA32(tv.v[1][s], pf, o1);
    }
}
DI void attn_stage(Frame& F, int b, int h, int t0, const int P) {
    const int dsh = 2 * P, DL = 1 << dsh, NT = (SEQ / 32) >> dsh;
    const bf16* QKV = (const bf16*)(F.ws + WS_QKV); const unsigned char* KF = F.ws + WS_KF + (size_t)P * 32 * MiB; const unsigned char* VF = F.ws + WS_VF + (size_t)P * 32 * MiB; bf16* ATT = (bf16*)(F.ws + WS_ATT);
    LAS unsigned char* ol = F.lds; LAS float* ml = (LAS float*)(F.lds + 131072); LAS float* ll = ml + 512; const LAS float* bl = (const LAS float*)(F.lds + 135168) + P * 132;
    int lane = F.lane; asm volatile("" : "+v"(lane));
    const int r32 = lane & 31, hh = lane >> 5, w = F.wave;
    asm volatile("" ::: "memory");
    int rr[2], mq[2], tq[2]; const unsigned char* kb[2]; const unsigned char* vb[2];
#pragma unroll
    for (int task = 0; task < 2; ++task) {
        int r, i0;
        if (P == 0) { r = 0; i0 = 64 * w + 32 * task; } else if (P == 1) { r = w & 3; i0 = 64 * (w >> 2) + 32 * task; } else { r = 2 * w + task; i0 = 0; }
        rr[task] = r; mq[task] = (t0 >> dsh) + i0; tq[task] = r + ((i0 + r32) << dsh);
        const size_t tb0 = ((size_t)((b * 16 + h) * DL + r) * NT) * 4096 + lane * 16;
        kb[task] = KF + tb0; vb[task] = VF + tb0;
    }
    int relb = 8 * hh - 64 - r32;
    asm volatile("" : "+v"(relb));
    AttnK ka, kb_, kc; AttnV va, vb_; bf16x8 qf[4], qn[4]; f32x16 o0, o1; float m, l;
#define ATT_T(task, kt) (mq[task] / 32 - 2 + (kt))
#define ATT_OK(task, kt) (ATT_T(task, kt) >= 0 && ATT_T(task, kt) < NT)
#define ATT_TC(task, kt) (ATT_T(task, kt) < 0 ? 0 : (ATT_T(task, kt) >= NT ? NT - 1 : ATT_T(task, kt)))
#define ATT_LDK(t, task, kt) attn_load_k(t, kb[task] + (size_t)ATT_TC(task, kt) * 4096)
#define ATT_LDV(t, task, kt) attn_load_v(t, vb[task] + (size_t)ATT_TC(task, kt) * 4096)
#define ATT_ST(tk, tv, task, kt, MSK) do { if (ATT_OK(task, kt)) attn_step<MSK>(tk, tv, qf, o0, o1, m, l, bl, relb + 32 * (kt), hh); } while (0)
#define ATT_Q(dst, task) do { const bf16* qp = QKV + (size_t)(b * SEQ + t0 + tq[task]) * NQKV + h * 64 + 32 * hh; _Pragma("unroll") for (int s = 0; s < 4; ++s) dst[s] = *(const bf16x8*)(qp + 8 * s); } while (0)
#define ATT_INIT(task) do { if (P == 0) { _Pragma("unroll") for (int i = 0; i < 16; ++i) { o0[i] = 0.f; o1[i] = 0.f; } m = -1e30f; l = 0.f; } else { \
        _Pragma("unroll") for (int g = 0; g < 4; ++g) { const f32x4 a = *(const LAS f32x4*)(ol + osw(tq[task], 2 * g + hh)), c = *(const LAS f32x4*)(ol + osw(tq[task], 8 + 2 * g + hh)); \
            o0[4 * g] = a.x; o0[4 * g + 1] = a.y; o0[4 * g + 2] = a.z; o0[4 * g + 3] = a.w; o1[4 * g] = c.x; o1[4 * g + 1] = c.y; o1[4 * g + 2] = c.z; o1[4 * g + 3] = c.w; } \
        m = ml[tq[task]]; l = hh ? 0.f : ll[tq[task]]; } } while (0)
#define ATT_WB(task) do { const float lt = l + __shfl_xor(l, 32); int tw = tq[task]; asm volatile("" : "+v"(tw));     \
        if (P < 2) { _Pragma("unroll") for (int g = 0; g < 4; ++g) { *(LAS f32x4*)(ol + osw(tw, 2 * g + hh)) = (f32x4){o0[4 * g], o0[4 * g + 1], o0[4 * g + 2], o0[4 * g + 3]}; \
                *(LAS f32x4*)(ol + osw(tw, 8 + 2 * g + hh)) = (f32x4){o1[4 * g], o1[4 * g + 1], o1[4 * g + 2], o1[4 * g + 3]}; } \
            if (hh == 0) { ml[tw] = m; ll[tw] = lt; } } \
        else { const float inv = 1.f / lt; bf16* op = ATT + (size_t)(b * SEQ + t0 + tw) * DM + h * 64 + 4 * hh; \
            _Pragma("unroll") for (int g = 0; g < 4; ++g) { v2u a, c; a.x = pk2(o0[4 * g] * inv, o0[4 * g + 1] * inv); a.y = pk2(o0[4 * g + 2] * inv, o0[4 * g + 3] * inv); \
                c.x = pk2(o1[4 * g] * inv, o1[4 * g + 1] * inv); c.y = pk2(o1[4 * g + 2] * inv, o1[4 * g + 3] * inv); *(v2u*)(op + 8 * g) = a; *(v2u*)(op + 32 + 8 * g) = c; } } } while (0)
    ATT_LDK(ka, 0, 0); ATT_LDK(kb_, 0, 1); ATT_LDV(va, 0, 0);
    ATT_Q(qf, 0); ATT_INIT(0);
    ATT_LDK(kc, 0, 2); ATT_LDV(vb_, 0, 1); ATT_ST(ka, va, 0, 0, true);
    ATT_LDK(ka, 0, 3); ATT_LDV(va, 0, 2); ATT_ST(kb_, vb_, 0, 1, false);
    ATT_LDK(kb_, 0, 4); ATT_LDV(vb_, 0, 3); ATT_ST(kc, va, 0, 2, false);
    ATT_Q(qn, 1);
    ATT_LDK(kc, 1, 0); ATT_LDV(va, 0, 4); ATT_ST(ka, vb_, 0, 3, false);
    ATT_LDK(ka, 1, 1); ATT_LDV(vb_, 1, 0); ATT_ST(kb_, va, 0, 4, true);
    ATT_WB(0);
    _Pragma("unroll") for (int s = 0; s < 4; ++s) qf[s] = qn[s];
    ATT_INIT(1);
    ATT_LDK(kb_, 1, 2); ATT_LDV(va, 1, 1); ATT_ST(kc, vb_, 1, 0, true);
    ATT_LDK(kc, 1, 3); ATT_LDV(vb_, 1, 2); ATT_ST(ka, va, 1, 1, false);
    ATT_LDK(ka, 1, 4); ATT_LDV(va, 1, 3); ATT_ST(kb_, vb_, 1, 2, false);
    ATT_LDV(vb_, 1, 4); ATT_ST(kc, va, 1, 3, false);
    ATT_ST(ka, vb_, 1, 4, true);
    ATT_WB(1);
#undef ATT_T
#undef ATT_OK
#undef ATT_TC
#undef ATT_LDK
#undef ATT_LDV
#undef ATT_ST
#undef ATT_Q
#undef ATT_INIT
#undef ATT_WB
}
DI void phase_attn(Frame& F) {
    const float* BT = (const float*)(F.ws + WS_BT);
    LAS float* bl = (LAS float*)(F.lds + 135168);
    const int vb_ = (F.G % 8 == 0) ? (F.bid % 8) * (F.G / 8) + F.bid / 8 : F.bid;
    for (int u = vb_; u < 512; u += F.G) {
        const int c = u & 15, h = (u >> 4) & 15, b = u >> 8, t0 = c * 512;
        __syncthreads();
        { int i0 = F.tid; asm volatile("" : "+v"(i0)); for (int i = i0; i < 3 * 129; i += NTHR) bl[(i / 129) * 132 + i % 129] = BT[((i / 129) * 16 + h) * 129 + i % 129]; }
        __syncthreads();
#pragma unroll 1
        for (int P = 0; P < 3; ++P) { if (P) __syncthreads(); attn_stage(F, b, h, t0, P); }
    }
}

constexpr int GL_QT = 0, GL_KT = 17408, GL_QB = 34816, GL_KHT = 52224, GL_VT = 70656, GL_P = 89088, GL_ST = 98304, GL_DEC = 133120, GL_TOT = 133632;
struct GlaRaw { float lf[16]; unsigned short q[16]; unsigned short v[16]; };
template <bool FULL> DI void gla_load_raw(GlaRaw& R, const float* LF, const bf16* Q, const bf16* V, int b, int h, int dir, int pos0, int ch) {
#pragma unroll
    for (int i = 0; i < 16; ++i) { const int ii = pos0 + i; const int tok = dir ? (SEQ - 1 - ii) : ii; const size_t off = (size_t)(b * SEQ + tok) * AW + h * 128 + ch;
        R.lf[i] = LF[off]; R.v[i] = V[off]; if (FULL) R.q[i] = Q[off]; }
}
template <bool FULL> DI float gla_prep(Frame& F, const GlaRaw& R) {
    LAS unsigned char* L = F.lds; LAS float* tot = (LAS float*)(L + GL_TOT);
    const int ch = F.tid & 127, qtr = F.tid >> 7;
    float c[16]; float run = 0.f;
#pragma unroll
    for (int i = 0; i < 16; ++i) { run += R.lf[i]; c[i] = run; }
    tot[qtr * 128 + ch] = run;
    __syncthreads();
    const float t0 = tot[ch], t1 = tot[128 + ch], t2 = tot[256 + ch], t3 = tot[384 + ch];
    const float off = (qtr > 0 ? t0 : 0.f) + (qtr > 1 ? t1 : 0.f) + (qtr > 2 ? t2 : 0.f), rr = t0 + t1, bend = (t0 + t1) + (t2 + t3);
    unsigned kh[8], vv[8];
#pragma unroll
    for (int i = 0; i < 16; i += 2) {
        const float b0 = off + c[i], b1 = off + c[i + 1];
        const float k0 = 1.f - fexp(R.lf[i]), k1 = 1.f - fexp(R.lf[i + 1]);
        kh[i >> 1] = pk2(k0 * fexp(bend - b0), k1 * fexp(bend - b1));
        vv[i >> 1] = (unsigned)R.v[i] | ((unsigned)R.v[i + 1] << 16);
        if (FULL) {
            const float q0 = bf2f(R.q[i]), q1 = bf2f(R.q[i + 1]);
            const int ta = 16 * qtr + i;
            *(LAS unsigned short*)(L + GL_QT + ta * 272 + 2 * ch) = (unsigned short)f2bf(q0 * fexp(b0 - rr));
            *(LAS unsigned short*)(L + GL_QT + (ta + 1) * 272 + 2 * ch) = (unsigned short)f2bf(q1 * fexp(b1 - rr));
            *(LAS unsigned short*)(L + GL_KT + ta * 272 + 2 * ch) = (unsigned short)f2bf(k0 * fexp(rr - b0));
            *(LAS unsigned short*)(L + GL_KT + (ta + 1) * 272 + 2 * ch) = (unsigned short)f2bf(k1 * fexp(rr - b1));
            *(LAS unsigned short*)(L + GL_QB + ta * 272 + 2 * ch) = (unsigned short)f2bf(q0 * fexp(b0));
            *(LAS unsigned short*)(L + GL_QB + (ta + 1) * 272 + 2 * ch) = (unsigned short)f2bf(q1 * fexp(b1));
        }
    }
    *(LAS v4u*)(L + GL_KHT + ch * 144 + 32 * qtr) = (v4u){kh[0], kh[1], kh[2], kh[3]}; *(LAS v4u*)(L + GL_KHT + ch * 144 + 32 * qtr + 16) = (v4u){kh[4], kh[5], kh[6], kh[7]};
    *(LAS v4u*)(L + GL_VT + ch * 144 + 32 * qtr) = (v4u){vv[0], vv[1], vv[2], vv[3]}; *(LAS v4u*)(L + GL_VT + ch * 144 + 32 * qtr + 16) = (v4u){vv[4], vv[5], vv[6], vv[7]};
    if (qtr == 0) *(LAS float*)(L + GL_DEC + 4 * ch) = fexp(bend);
    return bend;
}
DI bf16x8 gfrag(const LAS unsigned char* base, int row, int stride, int kel) { return *(const LAS bf16x8*)(base + row * stride + kel * 2); }
DI void gla_state_update(Frame& F, f32x16 (&S)[2]) {
    const LAS unsigned char* L = F.lds; const int r32 = F.lane & 31, hh = F.lane >> 5, vi = F.wave & 3, ki0 = 2 * (F.wave >> 2);
    bf16x8 a[4];
#pragma unroll
    for (int s = 0; s < 4; ++s) a[s] = gfrag(L + GL_VT, 32 * vi + r32, 144, 16 * s + 8 * hh);
#pragma unroll
    for (int q = 0; q < 2; ++q) { const int kr = 32 * (ki0 + q) + r32; const float d = *(const LAS float*)(L + GL_DEC + 4 * kr);
#pragma unroll
        for (int j = 0; j < 16; ++j) S[q][j] *= d;
#pragma unroll
        for (int s = 0; s < 4; ++s) S[q] = MFMA32(a[s], gfrag(L + GL_KHT, kr, 144, 16 * s + 8 * hh), S[q]); }
}
DI void gla_state_to_lds(Frame& F, const f32x16 (&S)[2]) {
    LAS unsigned char* L = F.lds; const int r32 = F.lane & 31, hh = F.lane >> 5, vi = F.wave & 3, ki0 = 2 * (F.wave >> 2);
#pragma unroll
    for (int q = 0; q < 2; ++q)
#pragma unroll
        for (int j = 0; j < 16; ++j) *(LAS unsigned short*)(L + GL_ST + (32 * vi + crow32(j, hh)) * 272 + 2 * (32 * (ki0 + q) + r32)) = (unsigned short)f2bf(S[q][j]);
}
DI void gla_unit_state(Frame& F, int u) {
    const int sc = u & 31, dir = (u >> 5) & 1, h = (u >> 6) & 3, b = u >> 8;
    const bf16* Q = (const bf16*)(F.ws + WS_Q); const bf16* V = (const bf16*)(F.ws + WS_V); const float* LF = (const float*)(F.ws + (dir ? WS_LFB : WS_LFF));
    float* ST = (float*)(F.ws + WS_ST) + (size_t)u * 16384; float* DEC = (float*)(F.ws + WS_DEC) + u * 128;
    const int ch = F.tid & 127, qtr = F.tid >> 7, r32 = F.lane & 31, hh = F.lane >> 5, vi = F.wave & 3, ki0 = 2 * (F.wave >> 2);
    f32x16 S[2];
#pragma unroll
    for (int j = 0; j < 16; ++j) { S[0][j] = 0.f; S[1][j] = 0.f; }
    float lsum = 0.f;
    GlaRaw cur, nxt;
    gla_load_raw<false>(cur, LF, Q, V, b, h, dir, sc * 256 + 16 * qtr, ch);
#pragma unroll 1
    for (int c = 0; c < 4; ++c) {
        __syncthreads();
        lsum += gla_prep<false>(F, cur);
        if (c < 3) gla_load_raw<false>(nxt, LF, Q, V, b, h, dir, sc * 256 + (c + 1) * 64 + 16 * qtr, ch);
        __syncthreads();
        gla_state_update(F, S);
        cur = nxt;
    }
#pragma unroll
    for (int q = 0; q < 2; ++q)
#pragma unroll
        for (int g = 0; g < 4; ++g) *(f32x4*)(ST + (size_t)(32 * (ki0 + q) + r32) * 128 + 32 * vi + 8 * g + 4 * hh) = (f32x4){S[q][4 * g], S[q][4 * g + 1], S[q][4 * g + 2], S[q][4 * g + 3]};
    if (qtr == 0) DEC[ch] = fexp(lsum);
}
DI void gla_unit_out(Frame& F, int u) {
    const int sc = u & 31, dir = (u >> 5) & 1, h = (u >> 6) & 3, b = u >> 8;
    const bf16* Q = (const bf16*)(F.ws + WS_Q); const bf16* V = (const bf16*)(F.ws + WS_V); const float* LF = (const float*)(F.ws + (dir ? WS_LFB : WS_LFF));
    const float* ST = (const float*)(F.ws + WS_ST) + (size_t)u * 16384; float* OD = (float*)(F.ws + WS_ODIR) + (size_t)dir * MTOK * AW;
    const LAS unsigned char* L = F.lds;
    const int ch = F.tid & 127, qtr = F.tid >> 7, r32 = F.lane & 31, hh = F.lane >> 5, w = F.wave, vi = w & 3, ki0 = 2 * (w >> 2), ti = w >> 2;
    f32x16 S[2];
#pragma unroll
    for (int q = 0; q < 2; ++q)
#pragma unroll
        for (int g = 0; g < 4; ++g) { const f32x4 t = *(const f32x4*)(ST + (size_t)(32 * (ki0 + q) + r32) * 128 + 32 * vi + 8 * g + 4 * hh); S[q][4 * g] = t.x; S[q][4 * g + 1] = t.y; S[q][4 * g + 2] = t.z; S[q][4 * g + 3] = t.w; }
    GlaRaw cur, nxt;
    gla_load_raw<true>(cur, LF, Q, V, b, h, dir, sc * 256 + 16 * qtr, ch);
    __syncthreads();
    gla_state_to_lds(F, S);
#pragma unroll 1
    for (int c = 0; c < 4; ++c) {
        (void)gla_prep<true>(F, cur);
        if (c < 3) gla_load_raw<true>(nxt, LF, Q, V, b, h, dir, sc * 256 + (c + 1) * 64 + 16 * qtr, ch);
        __syncthreads();
        f32x16 o;
#pragma unroll
        for (int j = 0; j < 16; ++j) o[j] = 0.f;
#pragma unroll
        for (int s = 0; s < 8; ++s) o = MFMA32(gfrag(L + GL_QB, 32 * ti + r32, 272, 16 * s + 8 * hh), gfrag(L + GL_ST, 32 * vi + r32, 272, 16 * s + 8 * hh), o);
        if (w < 3) {
            const int tp = (w + 1) >> 1, sp = (w == 2) ? 1 : 0;
            f32x16 p;
#pragma unroll
            for (int j = 0; j < 16; ++j) p[j] = 0.f;
#pragma unroll
            for (int s = 0; s < 8; ++s) p = MFMA32(gfrag(L + GL_QT, 32 * tp + r32, 272, 16 * s + 8 * hh), gfrag(L + GL_KT, 32 * sp + r32, 272, 16 * s + 8 * hh), p);
#pragma unroll
            for (int j = 0; j < 16; ++j) { const int t = 32 * tp + crow32(j, hh), s = 32 * sp + r32;
                *(LAS unsigned short*)(F.lds + GL_P + t * 144 + 2 * s) = (s <= t) ? (unsigned short)f2bf(p[j]) : (unsigned short)0; }
        }
        __syncthreads();
        { const int ns = ti ? 4 : 2;
#pragma unroll
          for (int s = 0; s < 4; ++s) if (s < ns) o = MFMA32(gfrag(L + GL_P, 32 * ti + r32, 144, 16 * s + 8 * hh), gfrag(L + GL_VT, 32 * vi + r32, 144, 16 * s + 8 * hh), o); }
#pragma unroll
        for (int j = 0; j < 16; ++j) { const int ii = sc * 256 + c * 64 + 32 * ti + crow32(j, hh); const int tok = dir ? (SEQ - 1 - ii) : ii;
            OD[(size_t)(b * SEQ + tok) * AW + h * 128 + 32 * vi + r32] = o[j]; }
        if (c < 3) { gla_state_update(F, S); gla_state_to_lds(F, S); }
        cur = nxt;
        __syncthreads();
    }
}

__global__ void __launch_bounds__(NTHR, 2) fwd_kernel(Args args) {
    extern __shared__ __attribute__((aligned(16))) unsigned char lds[];
    Frame F;
    F.lds = (LAS unsigned char*)lds;
    F.MISC = (volatile LAS unsigned*)(F.lds + MISC_OFF);
    F.tid = threadIdx.x; F.lane = F.tid & 63; F.wave = __builtin_amdgcn_readfirstlane(F.tid >> 6);
    F.G = gridDim.x; F.bid = blockIdx.x; F.gw = F.bid * NWAVES + F.wave; F.NGW = F.G * NWAVES;
    F.ws = args.ws;
    unsigned* ctl = (unsigned*)(args.ws + WS_CTL);
    for (int u = F.tid; u < (LDS_BYTES - LDSCTL_OFF) / 4; u += NTHR) ((LAS unsigned*)(F.lds + LDSCTL_OFF))[u] = 0u;
    __syncthreads();
    const int lo = args.ph_lo, hi = args.ph_hi;
    XcdBarrier bar; bar.bar = ctl + CW_BAR + args.li * XCD_BAR_WORDS; bar.x = 0; bar.st = nullptr;
    if (hi - lo > 1) bar = xcd_barrier_post(ctl + CW_BAR + args.li * XCD_BAR_WORDS, F.MISC + 8);
#define IN(k) (lo <= (k) && (k) < hi)
#ifndef PROBE_DUP
#define PROBE_DUP (-1)
#endif
#define REP(k) for (int rep_ = 0; rep_ < (((PROBE_DUP) == (k)) ? 2 : 1); ++rep_)
#define SEAM(k) do { if (IN(k) && IN((k) + 1)) { xcd_barrier(bar); if (PROBE_DUP == 99) xcd_barrier(bar); } } while (0)
    unsigned char* ws = args.ws;
    float* XR = args.out;

    if (IN(0)) REP(0) { phase_prologue(F, args); } SEAM(0);
    if (IN(1)) {
        pg8::Gemm g{(const bf16*)(ws + WS_H), (const bf16*)(ws + WS_WIN), MTOK, NIN, DM}; pg8::StaticOrder S; S.init(MTOK, NIN, F.G, F.bid);
        EpiInProj E{(bf16*)(ws + WS_U), (bf16*)(ws + WS_GV), (bf16*)(ws + WS_Q), (bf16*)(ws + WS_V), (bf16*)(ws + WS_G), (float*)(ws + WS_LFF), (float*)(ws + WS_LFB), (const float*)(ws + WS_LB)};
        pg8::gemm_phase<EpiInProj, pg8::StaticOrder, true, true>(F.lds, g, S, E);
        if (PROBE_DUP == 1) pg8::gemm_phase<EpiInProj, pg8::StaticOrder, true, true>(F.lds, g, S, E);
    } SEAM(1);
    if (IN(2)) { if (PROBE_DUP == 30) phase_a_ln(F, args, true); phase_a_ln(F, args); REP(2) for (int u = F.bid; u < 512; u += F.G) gla_unit_state(F, u); } SEAM(2);
    if (IN(3)) { if (PROBE_DUP == 31) phase_gla_scan(F, true); phase_gla_scan(F); REP(3) phase_a_mix(F, args); } SEAM(3);
    if (IN(4)) REP(4) { for (int u = F.bid; u < 512; u += F.G) gla_unit_out(F, u); } SEAM(4);
    if (IN(5)) REP(5) { phase_b_combine(F, args); } SEAM(5);
    if (IN(6)) REP(6) {
        pg8::Gemm g{(const bf16*)(ws + WS_CAT), (const bf16*)(ws + WS_WOUT), MTOK, DM, DM}; pg8::StaticOrder S; S.init(MTOK, DM, F.G, F.bid);
        EpiResid E{args.in[0], XR};
        pg8::gemm_phase<EpiResid, pg8::StaticOrder, false, true>(F.lds, g, S, E);
    } SEAM(6);
#define MOE_BLOCK(L, pb) do { \
        if (IN(pb)) REP(pb) { phase_router(F, XR, args.in[2] + (L) * DM, args.in[15] + (L) * DM * NEXP); } SEAM(pb); \
        if (IN((pb) + 1)) { REP((pb) + 1) phase_topk(F); convert_moe_weights(F, args.in[16], args.in[17], args.in[18], (L), (F.G > 64) ? 32 : 0); } SEAM((pb) + 1);     \
        if (IN((pb) + 2)) {     \
            pg8::Gemm g{(const bf16*)(ws + WS_H), (const bf16*)(ws + WS_WGU), NROWS, 16 * 2048, DM}; GroupedOrder<8> S{F.G, F.bid}; \
            EpiGateUp E{(bf16*)(ws + WS_HMID)}; \
            LAS int* rowtab = (LAS int*)(F.lds + RING_BYTES); const int* IDX = (const int*)(ws + WS_IDX); \
            for (int i = 0; i < 4; ++i) { pg8::Unit uu; if (!S.next(i, uu)) break; if (F.tid < 256) rowtab[i * 256 + F.tid] = IDX[uu.pm * 256 + F.tid]; } \
            __syncthreads(); \
            pg8::gemm_phase<EpiGateUp, GroupedOrder<8>, true, true, true>(F.lds, g, S, E, rowtab); \
            if (PROBE_DUP == (pb) + 2) pg8::gemm_phase<EpiGateUp, GroupedOrder<8>, true, true, true>(F.lds, g, S, E, rowtab); \
        } SEAM((pb) + 2); \
        if (IN((pb) + 3)) { \
            pg8::Gemm g{(const bf16*)(ws + WS_HMID), (const bf16*)(ws + WS_WDN), NROWS, 16 * 1024, DFF}; GroupedOrder<4> S{F.G, F.bid}; \
            EpiDown E{(bf16*)(ws + WS_Y), (const float*)(ws + WS_GATE)}; \
            pg8::gemm_phase<EpiDown, GroupedOrder<4>, true, true>(F.lds, g, S, E); \
            if (PROBE_DUP == (pb) + 3) pg8::gemm_phase<EpiDown, GroupedOrder<4>, true, true>(F.lds, g, S, E); \
        } SEAM((pb) + 3); \
    } while (0)

    MOE_BLOCK(0, 7);
    if (IN(11)) { if (PROBE_DUP == 32) phase_moe_combine(F, XR, args.in[1] + DM, false, true); phase_moe_combine(F, XR, args.in[1] + DM, false); } SEAM(11);
    if (IN(12)) REP(12) {
        pg8::Gemm g{(const bf16*)(ws + WS_H), (const bf16*)(ws + WS_WQKV), MTOK, NQKV, DM}; pg8::StaticOrder S; S.init(MTOK, NQKV, F.G, F.bid);
        EpiQKV E{(bf16*)(ws + WS_QKV)};
        pg8::gemm_phase<EpiQKV, pg8::StaticOrder, true, true>(F.lds, g, S, E);
    } SEAM(12);
    if (IN(13)) REP(13) { phase_kvf(F); } SEAM(13);
    if (IN(14)) REP(14) { phase_attn(F); } SEAM(14);
    if (IN(15)) {
        pg8::Gemm g{(const bf16*)(ws + WS_ATT), (const bf16*)(ws + WS_WO), MTOK, DM, DM}; pg8::StaticOrder S; S.init(MTOK, DM, F.G, F.bid);
        EpiResid E{XR, XR};
        pg8::gemm_phase<EpiResid, pg8::StaticOrder, false, true>(F.lds, g, S, E);
    } SEAM(15);
    MOE_BLOCK(1, 16);
    if (IN(20)) { if (PROBE_DUP == 33) phase_moe_combine(F, XR, args.in[3], true, true); phase_moe_combine(F, XR, args.in[3], true); }
#undef MOE_BLOCK
#undef IN
#undef SEAM
}

#ifndef MK_N_LAUNCHES
#define MK_N_LAUNCHES 1
#endif
extern "C" void kernel_launch(void* const* d_in, const int* in_sizes, int n_in, void* d_out, int out_size, void* d_ws, size_t ws_size, hipStream_t stream) {
    static int grid = 0;
    if (grid == 0) {
        if (n_in != 19 || in_sizes[0] != MTOK * DM || out_size != MTOK * DM || ws_size < WS_END) { fprintf(stderr, "kernel_launch: unexpected shapes (n_in %d, in0 %d, out %d, ws %zu < %zu); nothing launched\n", n_in, n_in > 0 ? in_sizes[0] : -1, out_size, ws_size, (size_t)WS_END); grid = -1; return; }
        int dev = 0, cus = 0, per_cu = 0;
        if (hipGetDevice(&dev) != hipSuccess || hipDeviceGetAttribute(&cus, hipDeviceAttributeMultiprocessorCount, dev) != hipSuccess) { grid = -1; return; }
        if (hipFuncSetAttribute((const void*)fwd_kernel, hipFuncAttributeMaxDynamicSharedMemorySize, LDS_BYTES) != hipSuccess) { fprintf(stderr, "kernel_launch: hipFuncSetAttribute failed\n"); grid = -1; return; }
        if (hipOccupancyMaxActiveBlocksPerMultiprocessor(&per_cu, (const void*)fwd_kernel, NTHR, LDS_BYTES) != hipSuccess || per_cu < 1) { fprintf(stderr, "kernel_launch: occupancy query reports %d workgroups per CU\n", per_cu); }
        (void)hipGetLastError();
        grid = cus;
    }
    if (grid < 0) return;
    if (hipMemsetAsync((char*)d_ws + WS_CTL, 0, CTL_ZERO_BYTES, stream) != hipSuccess) return;
    Args a{};
    for (int i = 0; i < 19; ++i) a.in[i] = (const float*)d_in[i];
    a.out = (float*)d_out; a.ws = (unsigned char*)d_ws; a.pad = 0;
    static_assert(CW_BAR + MAX_BAR_REGIONS * XCD_BAR_WORDS <= (int)(CTL_ZERO_BYTES / 4), "barrier regions inside the memset region");
    const int nl = MK_N_LAUNCHES;
    for (int li = 0; li < nl; ++li) {
        a.ph_lo = (int)((long)NPHASE * li / nl); a.ph_hi = (int)((long)NPHASE * (li + 1) / nl); a.li = li;
        hipLaunchKernelGGL(fwd_kernel, dim3(grid), dim3(NTHR), LDS_BYTES, stream, a);
        const hipError_t le = hipPeekAtLastError();
        if (le != hipSuccess) { fprintf(stderr, "kernel_launch: launch %d failed: %s\n", li, hipGetErrorName(le)); break; }
    }
}
```

```cpp
#include <hip/hip_runtime.h>
#include <cstdio>
#include <cstdint>
namespace pg8 {
#define PG8_LAS __attribute__((address_space(3)))
typedef unsigned short bf16_t;
typedef short bf16x8 __attribute__((ext_vector_type(8)));
typedef float f32x4 __attribute__((ext_vector_type(4)));
typedef unsigned u32x4 __attribute__((ext_vector_type(4)));
constexpr int BM = 256, BK = 64, HALF = 128, HTB = HALF * BK * 2  , STAGE_BYTES = 8 * HTB, NXCD = 8, WGM = 8;

__host__ __device__ __forceinline__ int lds_byte(int r, int c) { const int st = (r >> 4) * 2 + (c >> 5), rr = r & 15, cc = c & 31, ob = rr * 64 + cc * 2; return st * 1024 + (ob ^ (((ob >> 9) & 1) << 5)); }
__host__ __device__ __forceinline__ void stage_rc(int b, int& R, int& C) { const int st = b / 1024, sb = b % 1024, swz = sb ^ (((sb >> 9) & 1) << 5); R = (st >> 1) * 16 + swz / 64; C = (st & 1) * 32 + (swz % 64) / 2; }
__host__ __device__ __forceinline__ int perm32(int rho) { const int n = rho >> 4, i = rho & 15; return 8 * (i >> 2) + 4 * n + (i & 3); }

struct Unit { int pm, pn; };
struct Gemm { const bf16_t* A; const bf16_t* Bt; int M, N, K; };

struct StaticOrder {
    int nM, nN, nwg, G, c;
    __host__ __device__ void init(int M, int N, int G_, int c_) { nM = M / BM; nN = N / BM; nwg = nM * nN; G = G_; c = c_; }
    __host__ __device__ bool next(int i, Unit& u) const {
        const long L = (long)i * G + c; if (L >= nwg) return false;
        int wgid = (int)L; { const int q = nwg / NXCD, r = nwg % NXCD, xcd = wgid % NXCD, off = wgid / NXCD; wgid = (xcd < r ? xcd * (q + 1) : r * (q + 1) + (xcd - r) * q) + off; }
        const int nig = WGM * nN, gid = wgid / nig, fm = gid * WGM, gsz = (nM - fm) < WGM ? (nM - fm) : WGM;
        u.pm = fm + ((wgid % nig) % gsz); u.pn = (wgid % nig) / gsz; return true;
    }
    __device__ __forceinline__ void a_ready(const Unit&) const {}
    __device__ __forceinline__ void done(const Unit&) const {}
};

__device__ __forceinline__ unsigned cvt_pk_bf16(float lo, float hi) { unsigned r; asm volatile("v_cvt_pk_bf16_f32 %0, %1, %2" : "=v"(r) : "v"(lo), "v"(hi)); return r; }
typedef float f32x2 __attribute__((ext_vector_type(2)));
__device__ __forceinline__ f32x2 gelu_pk(f32x2 v) {
    const f32x2 av = __builtin_elementwise_abs(v), d = av * 0.2316418882f + 1.0f;
    f32x2 t; t.x = __builtin_amdgcn_rcpf(d.x); t.y = __builtin_amdgcn_rcpf(d.y);
    f32x2 q = t * 0.5307027145f + (-0.7265760135f); q = q * t + 0.7107068705f; q = q * t + (-0.142248368f); q = q * t + 0.127414796f; q = q * t;
    const f32x2 s = (v * v) * (-0.72134752044f);
    f32x2 e; e.x = __builtin_amdgcn_exp2f(s.x); e.y = __builtin_amdgcn_exp2f(s.y);
    const f32x2 m = v * (q * e), r = v - m;
    f32x2 o; o.x = v.x < 0.f ? m.x : r.x; o.y = v.y < 0.f ? m.y : r.y; return o;
}

template <int ACT  > struct EpiBf16 {
    static constexpr bool PERM = true, AFTER_DRAIN = false; static_assert(ACT == 0 || ACT == 1, "EpiBf16: ACT is 0 (none) or 1 (gelu_pk)");
    bf16_t* O; int ldc; const float* bias; int split_cols; size_t split_stride; float scale0;
    __device__ __forceinline__ void operator()(const f32x4 (&acc)[2][2][4][2], const Unit& u, int wr, int wc, int fr, int fq) const {
        const int row0 = u.pm * BM + wr * 64 + fr; int colt = u.pn * BM; bf16_t* base = O;
        float sc = 1.f; if (split_cols) { const int t = colt / split_cols; base += (size_t)t * split_stride; colt -= t * split_cols; if (t == 0) sc = scale0; }
        const int col0 = colt + wc * 32 + 8 * fq, bcol0 = u.pn * BM + wc * 32 + 8 * fq;
        f32x4 bv[2][2];
#pragma unroll
        for (int bj = 0; bj < 2; ++bj)
#pragma unroll
            for (int n = 0; n < 2; ++n) bv[bj][n] = bias ? *(const f32x4*)(bias + bcol0 + bj * HALF + 4 * n) : (f32x4){0.f, 0.f, 0.f, 0.f};
#pragma unroll
        for (int ai = 0; ai < 2; ++ai)
#pragma unroll
            for (int m = 0; m < 4; ++m) { bf16_t* rowp = base + (size_t)(row0 + ai * HALF + m * 16) * ldc + col0;
#pragma unroll
                for (int bj = 0; bj < 2; ++bj) { f32x4 v0 = acc[ai][bj][m][0] + bv[bj][0], v1 = acc[ai][bj][m][1] + bv[bj][1];
                    if (ACT == 1) { f32x2 a = gelu_pk((f32x2){v0[0], v0[1]}), b = gelu_pk((f32x2){v0[2], v0[3]}), c = gelu_pk((f32x2){v1[0], v1[1]}), d = gelu_pk((f32x2){v1[2], v1[3]});
                        v0 = (f32x4){a.x, a.y, b.x, b.y}; v1 = (f32x4){c.x, c.y, d.x, d.y}; }
                    v0 = v0 * sc; v1 = v1 * sc; u32x4 w; w.x = cvt_pk_bf16(v0[0], v0[1]); w.y = cvt_pk_bf16(v0[2], v0[3]); w.z = cvt_pk_bf16(v1[0], v1[1]); w.w = cvt_pk_bf16(v1[2], v1[3]);
                    *(u32x4*)(rowp + bj * HALF) = w; } }
    }
};
template <class Epi, class Sched, bool ALIGN_EPI = false, bool SP2 = false, bool GATHER = false>
__device__ __forceinline__ void gemm_phase(PG8_LAS unsigned char* lds, const Gemm g, const Sched& S, const Epi& E, const PG8_LAS int* rowtab = nullptr) {
    const int tid = threadIdx.x, wid = __builtin_amdgcn_readfirstlane(tid >> 6), lane = tid & 63, wr = wid >> 2, wc = wid & 3, fr = lane & 15, fq = lane >> 4;
    const int K = g.K, nt = K / BK;
    unsigned voffA[2], voffB[2]; int gR[2], gC[2];
#pragma unroll
    for (int i = 0; i < 2; ++i) { int R, C; stage_rc(tid * 16 + i * 8192, R, C); const int Rb = Epi::PERM ? ((R & ~31) + perm32(R & 31)) : R;
        voffA[i] = (unsigned)(R * K + C) * 2u; voffB[i] = (unsigned)(Rb * K + C) * 2u; gR[i] = R; gC[i] = C; }
    unsigned vC[2][2] = {{0u, 0u}, {0u, 0u}}, vN[2][2] = {{0u, 0u}, {0u, 0u}};
#define PG8_ROWS(dst, ui_) do { _Pragma("unroll") for (int _h = 0; _h < 2; ++_h) _Pragma("unroll") for (int _i = 0; _i < 2; ++_i) \
        dst[_h][_i] = (unsigned)(rowtab[(ui_) * 256 + _h * 128 + gR[_i]] * K + gC[_i]) * 2u; } while (0)
    const size_t kstep = (size_t)(BK * 2);
    const size_t hstep = (size_t)HALF * K * 2;
    const size_t tstep = 2 * hstep;
    const unsigned ldsw = (unsigned)wid * 1024u;
    const int aoff = lds_byte(wr * 64 + fr, fq * 8), boff = lds_byte(wc * 32 + fr, fq * 8);
#define PG8_SA(b, h) (((b) * 2 + (h)) * HTB)
#define PG8_SB(b, h) ((4 + (b) * 2 + (h)) * HTB)
#define PG8_STAGE(bufoff, gbase, voff) do { _Pragma("unroll") for (int _i = 0; _i < 2; ++_i) \
        __builtin_amdgcn_global_load_lds((const unsigned*)((const char*)(gbase) + (voff)[_i]), (PG8_LAS unsigned*)(lds + (bufoff) + ldsw + _i * 8192), 16, 0, 0); } while (0)
#define PG8_STGA(bufoff, abase, half, V) do { _Pragma("unroll") for (int _i = 0; _i < 2; ++_i) \
        __builtin_amdgcn_global_load_lds((const unsigned*)((const char*)(abase) + (GATHER ? (size_t)V[half][_i] : (size_t)((half) ? hstep : 0) + voffA[_i])), (PG8_LAS unsigned*)(lds + (bufoff) + ldsw + _i * 8192), 16, 0, 0); } while (0)
#define PG8_LDA(dst, b, h) do { _Pragma("unroll") for (int m = 0; m < 4; ++m) _Pragma("unroll") for (int k = 0; k < 2; ++k) dst[m][k] = *(const PG8_LAS bf16x8*)(lds + PG8_SA(b, h) + aoff + m * 2048 + k * 1024); } while (0)
#define PG8_LDB(dst, b, h) do { _Pragma("unroll") for (int n = 0; n < 2; ++n) _Pragma("unroll") for (int k = 0; k < 2; ++k) dst[n][k] = *(const PG8_LAS bf16x8*)(lds + PG8_SB(b, h) + boff + n * 2048 + k * 1024); } while (0)
#define PG8_MMA(ai, bj, At, Bt) do { __builtin_amdgcn_s_setprio(1); _Pragma("unroll") for (int m = 0; m < 4; ++m) _Pragma("unroll") for (int n = 0; n < 2; ++n) _Pragma("unroll") for (int k = 0; k < 2; ++k) \
        acc[ai][bj][m][n] = __builtin_amdgcn_mfma_f32_16x16x32_bf16(Bt[n][k], At[m][k], acc[ai][bj][m][n], 0, 0, 0); __builtin_amdgcn_s_setprio(0); } while (0)
#define PG8_WAIT_V(n) asm volatile("s_waitcnt vmcnt(" #n ")" ::: "memory")
#define PG8_WAIT_L(n) asm volatile("s_waitcnt lgkmcnt(" #n ")" ::: "memory")
#define PG8_BAR __builtin_amdgcn_s_barrier()
#define PG8_SCHED __builtin_amdgcn_sched_barrier(0)
    Unit cur, nxt; int ui = 0;
    if (!S.next(0, cur)) return;
    f32x4 acc[2][2][4][2];
#pragma unroll
    for (int a = 0; a < 2; ++a)
#pragma unroll
        for (int b = 0; b < 2; ++b)
#pragma unroll
            for (int m = 0; m < 4; ++m)
#pragma unroll
                for (int n = 0; n < 2; ++n) acc[a][b][m][n] = (f32x4){0.f, 0.f, 0.f, 0.f};
    bf16x8 At[4][2], B0[2][2], B1[2][2];
    const char* cA = (const char*)g.A + (GATHER ? (size_t)0 : (size_t)cur.pm * tstep); if constexpr (GATHER) PG8_ROWS(vC, 0);
    const char* cB = (const char*)g.Bt + (size_t)cur.pn * tstep;
    S.a_ready(cur);
    if constexpr (SP2) {
        PG8_STAGE(PG8_SB(0, 0), cB, voffB); PG8_STAGE(PG8_SB(0, 1), cB + hstep, voffB); PG8_STGA(PG8_SA(0, 0), cA, 0, vC); PG8_STGA(PG8_SA(0, 1), cA, 1, vC);
        if (wr == 1) PG8_BAR;
        PG8_WAIT_V(2); PG8_BAR;
        PG8_STAGE(PG8_SB(1, 0), cB + kstep, voffB); PG8_STGA(PG8_SA(1, 0), cA + kstep, 0, vC); PG8_STAGE(PG8_SB(1, 1), cB + hstep + kstep, voffB);
        PG8_WAIT_V(6); PG8_BAR;
    } else {
        PG8_STAGE(PG8_SB(0, 0), cB, voffB); PG8_STGA(PG8_SA(0, 0), cA, 0, vC); PG8_STAGE(PG8_SB(0, 1), cB + hstep, voffB); PG8_STGA(PG8_SA(0, 1), cA, 1, vC);
        if (wr == 1) PG8_BAR;
        PG8_WAIT_V(4); PG8_BAR;
        PG8_STAGE(PG8_SB(1, 0), cB + kstep, voffB); PG8_STGA(PG8_SA(1, 0), cA + kstep, 0, vC); PG8_STAGE(PG8_SB(1, 1), cB + hstep + kstep, voffB);
        PG8_WAIT_V(6); PG8_BAR;
    }
    for (;;) {
        const bool has_next = S.next(ui + 1, nxt);
        const char* nA = (has_next && !GATHER) ? (const char*)g.A + (size_t)nxt.pm * tstep : cA;
        if constexpr (GATHER) { if (has_next) PG8_ROWS(vN, ui + 1); else { _Pragma("unroll") for (int _h = 0; _h < 2; ++_h) _Pragma("unroll") for (int _i = 0; _i < 2; ++_i) vN[_h][_i] = vC[_h][_i]; } }
        const char* nB = has_next ? (const char*)g.Bt + (size_t)nxt.pn * tstep : cB;
        for (int t = 0; t < nt; t += 2) {
            const bool last = (t == nt - 2);
            unsigned vX[2][2];
            _Pragma("unroll") for (int _h = 0; _h < 2; ++_h) _Pragma("unroll") for (int _i = 0; _i < 2; ++_i) vX[_h][_i] = last ? vN[_h][_i] : vC[_h][_i];
            const char* a1 = cA + (size_t)(t + 1) * kstep;
            const char* a2 = last ? nA : cA + (size_t)(t + 2) * kstep; const char* b2 = last ? nB : cB + (size_t)(t + 2) * kstep;
            const char* a3 = a2 + kstep; const char* b3 = b2 + kstep;
            if (last && has_next) S.a_ready(nxt);
            if constexpr (SP2) {
            PG8_LDB(B0, 0, 0); PG8_LDB(B1, 0, 1); PG8_SCHED; PG8_LDA(At, 0, 0); PG8_STGA(PG8_SA(1, 1), a1, 1, vC);
            PG8_WAIT_V(8); PG8_WAIT_L(0); PG8_BAR; PG8_MMA(0, 0, At, B0); PG8_MMA(0, 1, At, B1); PG8_BAR; PG8_SCHED;
            PG8_LDA(At, 0, 1); PG8_STAGE(PG8_SB(0, 0), b2, voffB); PG8_STAGE(PG8_SB(0, 1), b2 + hstep, voffB); PG8_STGA(PG8_SA(0, 0), a2, 0, vX);
            PG8_WAIT_V(8); PG8_WAIT_L(0); PG8_BAR; PG8_MMA(1, 0, At, B0); PG8_MMA(1, 1, At, B1); PG8_BAR; PG8_SCHED;
            PG8_LDB(B0, 1, 0); PG8_LDB(B1, 1, 1); PG8_SCHED; PG8_LDA(At, 1, 0); PG8_STGA(PG8_SA(0, 1), a2, 1, vX);
            PG8_WAIT_V(8); PG8_WAIT_L(0); PG8_BAR; PG8_MMA(0, 0, At, B0); PG8_MMA(0, 1, At, B1); PG8_BAR; PG8_SCHED;
            PG8_LDA(At, 1, 1); PG8_STAGE(PG8_SB(1, 0), b3, voffB); PG8_STAGE(PG8_SB(1, 1), b3 + hstep, voffB); PG8_STGA(PG8_SA(1, 0), a3, 0, vX);
            PG8_WAIT_V(8); PG8_WAIT_L(0); PG8_BAR; PG8_MMA(1, 0, At, B0); PG8_MMA(1, 1, At, B1); PG8_BAR; PG8_SCHED;
            } else {
            PG8_LDB(B0, 0, 0); PG8_SCHED; PG8_LDA(At, 0, 0); PG8_STGA(PG8_SA(1, 1), a1, 1, vC);
            PG8_WAIT_L(8); PG8_BAR; PG8_WAIT_L(0); PG8_MMA(0, 0, At, B0); PG8_BAR; PG8_SCHED;
            PG8_LDB(B1, 0, 1); PG8_STAGE(PG8_SB(0, 0), b2, voffB);
            PG8_BAR; PG8_WAIT_L(0); PG8_MMA(0, 1, At, B1); PG8_BAR;
            PG8_LDA(At, 0, 1); PG8_STGA(PG8_SA(0, 0), a2, 0, vX);
            PG8_BAR; PG8_WAIT_L(0); PG8_MMA(1, 0, At, B0); PG8_BAR; PG8_SCHED;
            PG8_STAGE(PG8_SB(0, 1), b2 + hstep, voffB);
            PG8_WAIT_V(6); PG8_BAR; PG8_MMA(1, 1, At, B1); PG8_BAR;
            PG8_LDB(B0, 1, 0); PG8_SCHED; PG8_LDA(At, 1, 0); PG8_STGA(PG8_SA(0, 1), a2, 1, vX);
            PG8_WAIT_L(8); PG8_BAR; PG8_WAIT_L(0); PG8_MMA(0, 0, At, B0); PG8_BAR; PG8_SCHED;
            PG8_LDB(B1, 1, 1); PG8_STAGE(PG8_SB(1, 0), b3, voffB);
            PG8_BAR; PG8_WAIT_L(0); PG8_MMA(0, 1, At, B1); PG8_BAR;
            PG8_LDA(At, 1, 1); PG8_STGA(PG8_SA(1, 0), a3, 0, vX);
            PG8_BAR; PG8_WAIT_L(0); PG8_MMA(1, 0, At, B0); PG8_BAR; PG8_SCHED;
            PG8_STAGE(PG8_SB(1, 1), b3 + hstep, voffB);
            PG8_WAIT_V(6); PG8_BAR; PG8_MMA(1, 1, At, B1); PG8_BAR;
            }
        }
        if constexpr (ALIGN_EPI) { if (wr == 0) PG8_BAR; }
        if constexpr (!Epi::AFTER_DRAIN) { E(acc, cur, wr, wc, fr, fq); S.done(cur); }
        if (!has_next) break;
#pragma unroll
        for (int a = 0; a < 2; ++a)
#pragma unroll
            for (int b = 0; b < 2; ++b)
#pragma unroll
                for (int m = 0; m < 4; ++m)
#pragma unroll
                    for (int n = 0; n < 2; ++n) acc[a][b][m][n] = (f32x4){0.f, 0.f, 0.f, 0.f};
        cur = nxt; cA = nA; cB = nB; ++ui;
        if constexpr (GATHER) { _Pragma("unroll") for (int _h = 0; _h < 2; ++_h) _Pragma("unroll") for (int _i = 0; _i < 2; ++_i) vC[_h][_i] = vN[_h][_i]; }
        if constexpr (ALIGN_EPI) { if (wr == 1) PG8_BAR; }
    }
    PG8_WAIT_V(0);
    if constexpr (!ALIGN_EPI) { if (wr == 0) PG8_BAR; }
    PG8_BAR;
    if constexpr (Epi::AFTER_DRAIN) { E.fused(acc, cur, wr, wc, fr, fq, lds, wid, lane); S.done(cur); }
#undef PG8_SA
#undef PG8_SB
#undef PG8_STAGE
#undef PG8_STGA
#undef PG8_ROWS
#undef PG8_LDA
#undef PG8_LDB
#undef PG8_MMA
#undef PG8_WAIT_V
#undef PG8_WAIT_L
#undef PG8_BAR
#undef PG8_SCHED
}
}
#define LAS __attribute__((address_space(3)))
#define DI __device__ __forceinline__
typedef unsigned short bf16;
typedef unsigned v4u __attribute__((ext_vector_type(4)));
typedef unsigned v2u __attribute__((ext_vector_type(2)));
typedef float f32x4 __attribute__((ext_vector_type(4)));
typedef short bf16x8 __attribute__((ext_vector_type(8)));
#define LDS_WAIT() asm volatile("s_waitcnt lgkmcnt(0)" ::: "memory")
#define VM_WAIT() asm volatile("s_waitcnt vmcnt(0)" ::: "memory")
DI unsigned f2bf(float f) { unsigned u = __builtin_bit_cast(unsigned, f); return (u + 0x7fffu + ((u >> 16) & 1u)) >> 16; }
typedef float f32x2_t __attribute__((ext_vector_type(2))); typedef __bf16 bf16x2_t __attribute__((ext_vector_type(2)));
DI unsigned pk2(float lo, float hi) { f32x2_t v = {lo, hi}; bf16x2_t b = __builtin_convertvector(v, bf16x2_t); return __builtin_bit_cast(unsigned, b); }
DI float bf2f(unsigned b) { return __builtin_bit_cast(float, b << 16); }
DI float bflo(unsigned w) { return __builtin_bit_cast(float, w << 16); }
DI float bfhi(unsigned w) { return __builtin_bit_cast(float, w & 0xffff0000u); }
DI float fexp(float x) { return __builtin_amdgcn_exp2f(x * 1.4426950408889634f); }
DI float flog(float x) { return __builtin_amdgcn_logf(x) * 0.6931471805599453f; }
DI float frcp(float x) { return __builtin_amdgcn_rcpf(x); }
DI float sigmoidf_(float x) { return frcp(1.f + fexp(-x)); }
DI float siluf_(float x) { return x * sigmoidf_(x); }
DI float gelu_tanh(float x) { const float u = 0.7978845608028654f * (x + 0.044715f * x * x * x); return x * sigmoidf_(2.f * u); }
DI float wave_sum(float v) {
#pragma unroll
    for (int o = 1; o < 64; o <<= 1) v += __shfl_xor(v, o);
    return v;
}
DI float wave_max(float v) {
#pragma unroll
    for (int o = 1; o < 64; o <<= 1) v = fmaxf(v, __shfl_xor(v, o));
    return v;
}
DI int red16_idx(int lane) { return 8 * ((lane >> 5) & 1) + 4 * ((lane >> 4) & 1) + 2 * ((lane >> 3) & 1) + ((lane >> 2) & 1); }
DI float red16(const float (&o)[16], int lane) {
    const bool b32 = lane & 32, b16 = lane & 16, b8 = lane & 8, b4 = lane & 4;
    float a8[8], a4[4], a2[2], a1;
#pragma unroll
    for (int j = 0; j < 8; ++j) { const float send = b32 ? o[j] : o[j + 8], keep = b32 ? o[j + 8] : o[j]; a8[j] = keep + __shfl_xor(send, 32); }
#pragma unroll
    for (int j = 0; j < 4; ++j) { const float send = b16 ? a8[j] : a8[j + 4], keep = b16 ? a8[j + 4] : a8[j]; a4[j] = keep + __shfl_xor(send, 16); }
#pragma unroll
    for (int j = 0; j < 2; ++j) { const float send = b8 ? a4[j] : a4[j + 2], keep = b8 ? a4[j + 2] : a4[j]; a2[j] = keep + __shfl_xor(send, 8); }
    { const float send = b4 ? a2[0] : a2[1], keep = b4 ? a2[1] : a2[0]; a1 = keep + __shfl_xor(send, 4); }
    a1 += __shfl_xor(a1, 2); a1 += __shfl_xor(a1, 1);
    return a1;
}
#define XB_TMO      128
#define XB_XCNT(j)  (256  + 64 * (j))
#define XB_XSUB(j)  (1280 + 64 * (j))
#define XB_XGEN(j)  (2304 + 64 * (j))
#define XB_TOP      3328
#define XB_TOPGEN   3392
#define XCD_BAR_WORDS 3456
#define XB_SPIN_CAP (1u << 18)

__device__ __forceinline__ unsigned xb_ld(unsigned* p)              { return __hip_atomic_load(p, __ATOMIC_RELAXED, __HIP_MEMORY_SCOPE_AGENT); }
__device__ __forceinline__ unsigned xb_add(unsigned* p, unsigned v) { return __hip_atomic_fetch_add(p, v, __ATOMIC_RELAXED, __HIP_MEMORY_SCOPE_AGENT); }
__device__ __forceinline__ unsigned xb_xcc_id() { return (unsigned)__builtin_amdgcn_s_getreg((3 << 11) | 20) & 0xFu; }
#define XB_SPIN(cond, bar) do { unsigned _sp = 0; while (cond) { __builtin_amdgcn_s_sleep(1); \
    if ((++_sp & 255u) == 0u) { if (xb_ld(&(bar)[XB_TMO])) break; if (_sp > XB_SPIN_CAP) { atomicAdd(&(bar)[XB_TMO], 1u); break; } } } } while (0)

struct XcdBarrier {
    unsigned* bar; unsigned x;
    volatile LAS unsigned* st;
};

__device__ __forceinline__ XcdBarrier xcd_barrier_post(unsigned* bar, volatile LAS unsigned* st) {
    XcdBarrier b; b.bar = bar; b.x = xb_xcc_id(); b.st = st;
    if (threadIdx.x == 0) (void)xb_add(&bar[XB_XCNT(b.x)], 1u);
    return b;
}
__device__ __forceinline__ void xcd_barrier_complete(unsigned* bar, unsigned x, unsigned& nloc, unsigned& nx) {
    const unsigned G = gridDim.x * gridDim.y * gridDim.z;
    unsigned sum, cnt, mine, sp = 0u;
    for (;;) {
        sum = 0u; cnt = 0u; mine = 0u;
#pragma unroll
        for (unsigned j = 0; j < 16; ++j) { const unsigned c = xb_ld(&bar[XB_XCNT(j)]); sum += c; cnt += (c > 0u) ? 1u : 0u; mine = (j == x) ? c : mine; }
        if (sum == G) break;
        __builtin_amdgcn_s_sleep(1);
        if ((++sp & 255u) == 0u) { if (xb_ld(&bar[XB_TMO])) break; if (sp > XB_SPIN_CAP) { atomicAdd(&bar[XB_TMO], 1u); break; } }
    }
    nloc = mine > 0u ? mine : 1u; nx = cnt > 0u ? cnt : 1u;
}

__device__ __forceinline__ void xcd_barrier(const XcdBarrier& b) {
    asm volatile("s_waitcnt vmcnt(0)" ::: "memory");
    __syncthreads();
    if (threadIdx.x == 0) {
        unsigned* bar = b.bar;
        __builtin_amdgcn_s_waitcnt(0);
        unsigned nloc = b.st[0], nx = b.st[1];
        if (nloc == 0u) { xcd_barrier_complete(bar, b.x, nloc, nx); b.st[0] = nloc; b.st[1] = nx; }
        const unsigned old = xb_add(&bar[XB_XSUB(b.x)], 1u);
        const unsigned gen = old / nloc;
        if (old + 1u == (gen + 1u) * nloc) {
            __builtin_amdgcn_fence(__ATOMIC_RELEASE, "agent");
            asm volatile("s_waitcnt vmcnt(0)" ::: "memory");
            const unsigned og = xb_add(&bar[XB_TOP], 1u);
            const unsigned tg = og / nx;
            if (og + 1u == (tg + 1u) * nx) xb_add(&bar[XB_TOPGEN], 1u);
            else XB_SPIN(xb_ld(&bar[XB_TOPGEN]) == tg, bar);
            __builtin_amdgcn_fence(__ATOMIC_ACQUIRE, "agent");
            xb_add(&bar[XB_XGEN(b.x)], 1u);
            asm volatile("s_waitcnt vmcnt(0)" ::: "memory");
        } else {
            XB_SPIN(xb_ld(&bar[XB_XGEN(b.x)]) == gen, bar);
            __builtin_amdgcn_fence(__ATOMIC_ACQUIRE, "agent");
            asm volatile("s_waitcnt vmcnt(0)" ::: "memory");
        }
    }
    __syncthreads();
}
constexpr int NWAVES = 8, NTHR = 512;
constexpr int BATCH = 2, SEQ = 8192, DM = 1024, MTOK = BATCH * SEQ;
constexpr int NIN = 3584;
constexpr int AW = 512;
constexpr int NEXP = 16, DFF = 1024, CAP = 1024, NROWS = BATCH * NEXP * CAP;
constexpr int NSC = 32, SCLEN = 256;
constexpr int NHEAD = 16, HD = 64, NQKV = 3072;
constexpr float EPS = 1e-6f;
constexpr int NPHASE = 21;

constexpr size_t MiB = 1u << 20;
constexpr size_t WS_CTL = 0, CTL_ZERO_BYTES = 1 * MiB;
constexpr size_t WS_AFF = 1 * MiB;
constexpr size_t WS_POS = 2 * MiB;
constexpr size_t WS_IDX = 3 * MiB;
constexpr size_t WS_GATE = 3 * MiB + 256 * 1024;
constexpr size_t WS_DEC = 3 * MiB + 512 * 1024;
constexpr size_t WS_LB = 4 * MiB;
constexpr size_t WS_BT = 4 * MiB + 64 * 1024;
constexpr size_t WS_WIN = 8 * MiB;
constexpr size_t WS_WOUT = 15 * MiB;
constexpr size_t WS_WQKV = 17 * MiB;
constexpr size_t WS_WO = 23 * MiB;
constexpr size_t WS_WSB = 25 * MiB;
constexpr size_t WS_WGU = 32 * MiB;
constexpr size_t WS_WDN = 96 * MiB;
constexpr size_t WS_H = 128 * MiB;
constexpr size_t WS_R1 = 160 * MiB;
constexpr size_t WS_U = WS_R1, WS_GV = WS_R1 + 16 * MiB, WS_Q = WS_R1 + 32 * MiB, WS_V = WS_R1 + 48 * MiB, WS_G = WS_R1 + 64 * MiB;
constexpr size_t WS_LFF = WS_R1 + 80 * MiB, WS_LFB = WS_R1 + 112 * MiB;
constexpr size_t WS_CAT = WS_R1 + 144 * MiB;
constexpr size_t WS_ST = WS_R1 + 176 * MiB;
constexpr size_t WS_ODIR = WS_R1 + 208 * MiB;
constexpr size_t WS_XE = WS_R1, WS_Y = WS_R1;
constexpr size_t WS_HMID = WS_R1 + 64 * MiB;
constexpr size_t WS_QKV = WS_R1;
constexpr size_t WS_ATT = WS_R1 + 96 * MiB;
constexpr size_t WS_KF = WS_R1 + 128 * MiB;
constexpr size_t WS_VF = WS_R1 + 224 * MiB;
constexpr size_t WS_END = WS_R1 + 320 * MiB;
constexpr int CW_BAR = 4096;
constexpr int MAX_BAR_REGIONS = 24;

constexpr int RING_BYTES = 131072;
constexpr int LDS_BYTES = 147456;
constexpr int LDSCTL_OFF = LDS_BYTES - 512, MISC_OFF = LDSCTL_OFF + 320;

struct Args { const float* in[19]; float* out; unsigned char* ws; int ph_lo, ph_hi, li, pad; };

struct Frame {
    LAS unsigned char* lds;
    volatile LAS unsigned* MISC;
    int tid, lane, wave, G, bid, gw, NGW;
    unsigned char* ws;
};

template <int NPN_> struct GroupedOrder {
    int G, c;
    DI bool next(int i, pg8::Unit& u) const {
        const int L = i * G + c; if (L >= 16 * 8 * NPN_) return false;
        const int e = L / (8 * NPN_), w = L % (8 * NPN_);
        u.pm = e * 8 + (w & 7); u.pn = e * NPN_ + (w >> 3); return true;
    }
    DI void a_ready(const pg8::Unit&) const {}
    DI void done(const pg8::Unit&) const {}
};

typedef _Float16 h16x8 __attribute__((ext_vector_type(8)));
struct EpiInProj {
    static constexpr bool PERM = true, AFTER_DRAIN = false;
    bf16 *U, *GV, *Q, *V, *G; _Float16 *LFf, *LFb; const float* LB;
    DI void operator()(const pg8::f32x4 (&acc)[2][2][4][2], const pg8::Unit& u, int wr, int wc, int fr, int fq) const {
        const int seg = u.pn >> 1;
        const int row0 = u.pm * 256 + wr * 64 + fr, lc0 = (u.pn & 1) * 256 + wc * 32 + 8 * fq;
#pragma unroll
        for (int bj = 0; bj < 2; ++bj) {
            const int lc = lc0 + bj * 128;
            float lb[8];
            if (seg == 3 || seg == 4) {
#pragma unroll
                for (int j = 0; j < 8; ++j) lb[j] = LB[(seg - 3) * 512 + lc + j];
            }
#pragma unroll
            for (int ai = 0; ai < 2; ++ai)
#pragma unroll
                for (int m = 0; m < 4; ++m) {
                    const size_t off = (size_t)(row0 + ai * 128 + m * 16) * 512 + lc;
                    float v[8];
#pragma unroll
                    for (int j = 0; j < 8; ++j) v[j] = acc[ai][bj][m][j >> 2][j & 3];
                    if (seg == 3 || seg == 4) {
#pragma unroll
                        for (int j = 0; j < 8; ++j) v[j] = flog(lb[j] + (1.f - lb[j]) * sigmoidf_(v[j]));
                        _Float16* o = (seg == 3 ? LFf : LFb) + off;
                        h16x8 hv;
#pragma unroll
                        for (int j = 0; j < 8; ++j) hv[j] = (_Float16)v[j];
                        *(h16x8*)o = hv;
                    } else {
                        bf16* o;
                        if (seg == 0) { o = U;
#pragma unroll
                            for (int j = 0; j < 8; ++j) v[j] = gelu_tanh(v[j]);
                        } else if (seg == 1) { o = GV;
#pragma unroll
                            for (int j = 0; j < 8; ++j) v[j] = gelu_tanh(v[j]);
                        } else if (seg == 2) { o = Q;
#pragma unroll
                            for (int j = 0; j < 8; ++j) v[j] = siluf_(v[j]);
                        } else if (seg == 5) { o = V;
                        } else { o = G;
#pragma unroll
                            for (int j = 0; j < 8; ++j) v[j] = sigmoidf_(v[j]);
                        }
                        v4u w; w.x = pk2(v[0], v[1]); w.y = pk2(v[2], v[3]); w.z = pk2(v[4], v[5]); w.w = pk2(v[6], v[7]);
                        *(v4u*)(o + off) = w;
                    }
                }
        }
    }
};
struct EpiResid {
    static constexpr bool PERM = false, AFTER_DRAIN = false;
    const float* base; float* out;
    DI void operator()(const pg8::f32x4 (&acc)[2][2][4][2], const pg8::Unit& u, int wr, int wc, int fr, int fq) const {
        const int row0 = u.pm * 256 + wr * 64 + fr, col0 = u.pn * 256 + wc * 32 + 4 * fq;
#pragma unroll
        for (int ai = 0; ai < 2; ++ai)
#pragma unroll
            for (int m = 0; m < 4; ++m) { const size_t ro = (size_t)(row0 + ai * 128 + m * 16) * DM + col0;
#pragma unroll
                for (int bj = 0; bj < 2; ++bj)
#pragma unroll
                    for (int n = 0; n < 2; ++n) { const size_t o = ro + bj * 128 + n * 16; *(f32x4*)(out + o) = *(const f32x4*)(base + o) + acc[ai][bj][m][n]; } }
    }
};
struct EpiGateUp {
    static constexpr bool PERM = true, AFTER_DRAIN = false;
    bf16* H;
    DI void operator()(const pg8::f32x4 (&acc)[2][2][4][2], const pg8::Unit& u, int wr, int wc, int fr, int fq) const {
        const int pnl = u.pn & 7;
        const int row0 = u.pm * 256 + wr * 64 + fr, col0 = pnl * 128 + wc * 32 + 8 * fq;
#pragma unroll
        for (int ai = 0; ai < 2; ++ai)
#pragma unroll
            for (int m = 0; m < 4; ++m) {
                float v[8];
#pragma unroll
                for (int j = 0; j < 8; ++j) v[j] = siluf_(acc[ai][0][m][j >> 2][j & 3]) * acc[ai][1][m][j >> 2][j & 3];
                v4u w; w.x = pk2(v[0], v[1]); w.y = pk2(v[2], v[3]); w.z = pk2(v[4], v[5]); w.w = pk2(v[6], v[7]);
                *(v4u*)(H + (size_t)(row0 + ai * 128 + m * 16) * DFF + col0) = w;
            }
    }
};
struct EpiDown {
    static constexpr bool PERM = true, AFTER_DRAIN = false;
    bf16* Y; const float* gate;
    DI void operator()(const pg8::f32x4 (&acc)[2][2][4][2], const pg8::Unit& u, int wr, int wc, int fr, int fq) const {
        const int pnl = u.pn & 3;
        const int row0 = u.pm * 256 + wr * 64 + fr, col0 = pnl * 256 + wc * 32 + 8 * fq;
#pragma unroll
        for (int ai = 0; ai < 2; ++ai)
#pragma unroll
            for (int m = 0; m < 4; ++m) { const int row = row0 + ai * 128 + m * 16; const float g = gate[row];
#pragma unroll
                for (int bj = 0; bj < 2; ++bj) {
                    float v[8];
#pragma unroll
                    for (int j = 0; j < 8; ++j) v[j] = acc[ai][bj][m][j >> 2][j & 3] * g;
                    v4u w; w.x = pk2(v[0], v[1]); w.y = pk2(v[2], v[3]); w.z = pk2(v[4], v[5]); w.w = pk2(v[6], v[7]);
                    *(v4u*)(Y + (size_t)row * DM + col0 + bj * 128) = w; } }
    }
};
struct EpiQKV {
    static constexpr bool PERM = true, AFTER_DRAIN = false;
    bf16* O;
    DI void operator()(const pg8::f32x4 (&acc)[2][2][4][2], const pg8::Unit& u, int wr, int wc, int fr, int fq) const {
        const float sc = (u.pn < 4) ? 0.125f : 1.f;
        const int row0 = u.pm * 256 + wr * 64 + fr, col0 = u.pn * 256 + wc * 32 + 8 * fq;
#pragma unroll
        for (int ai = 0; ai < 2; ++ai)
#pragma unroll
            for (int m = 0; m < 4; ++m)
#pragma unroll
                for (int bj = 0; bj < 2; ++bj) {
                    float v[8];
#pragma unroll
                    for (int j = 0; j < 8; ++j) v[j] = acc[ai][bj][m][j >> 2][j & 3] * sc;
                    v4u w; w.x = pk2(v[0], v[1]); w.y = pk2(v[2], v[3]); w.z = pk2(v[4], v[5]); w.w = pk2(v[6], v[7]);
                    *(v4u*)(O + (size_t)(row0 + ai * 128 + m * 16) * NQKV + col0 + bj * 128) = w; }
    }
};

DI void transpose_item(const float* W, int K, int N, bf16* WT, LAS float* scr, int k0, int n0, int drow0, int lane) {
#pragma unroll 8
    for (int i = 0; i < 32; ++i) { const int kk = 2 * i + (lane >> 5); scr[kk * 33 + (lane & 31)] = W[(size_t)(k0 + kk) * N + n0 + (lane & 31)]; }
    LDS_WAIT(); asm volatile("" ::: "memory");
    const int c = lane & 7;
#pragma unroll
    for (int j = 0; j < 4; ++j) { const int n = (lane >> 3) + 8 * j; const LAS float* s = scr + (8 * c) * 33 + n;
        v4u o; o.x = pk2(s[0 * 33], s[1 * 33]); o.y = pk2(s[2 * 33], s[3 * 33]); o.z = pk2(s[4 * 33], s[5 * 33]); o.w = pk2(s[6 * 33], s[7 * 33]);
        *(v4u*)(WT + (size_t)(drow0 + n) * K + k0 + 8 * c) = o; }
    LDS_WAIT(); asm volatile("" ::: "memory");
}
DI void transpose_matrix(Frame& F, const float* W, int K, int N, bf16* WT) {
    LAS float* scr = (LAS float*)(F.lds + F.wave * 16384);
    const int nblk = N / 32, nitems = (K / 64) * nblk;
    for (int it = F.gw; it < nitems; it += F.NGW) { const int kb = it / nblk, nb = it % nblk; transpose_item(W, K, N, WT, scr, 64 * kb, 32 * nb, 32 * nb, F.lane); }
}
DI void convert_moe_weights(Frame& F, const float* wg, const float* wu, const float* wd, int layer, int nskip = 0) {
    LAS float* scr = (LAS float*)(F.lds + F.wave * 16384);
    bf16* WGU = (bf16*)(F.ws + WS_WGU); bf16* WDN = (bf16*)(F.ws + WS_WDN);
    if (F.bid < nskip) return;
    for (int it = F.gw - nskip * NWAVES; it < 3 * 16 * 512; it += F.NGW - nskip * NWAVES) {
        const int mat = it / 8192, rem = it % 8192, e = rem / 512, r = rem % 512, kb = r / 32, nb = r % 32, n0 = 32 * nb;
        const size_t so = ((size_t)layer * 16 + e) * 1024 * 1024;
        if (mat == 0) transpose_item(wg + so, 1024, 1024, WGU + (size_t)e * 2048 * 1024, scr, 64 * kb, n0, (n0 >> 7) * 256 + (n0 & 127), F.lane);
        else if (mat == 1) transpose_item(wu + so, 1024, 1024, WGU + (size_t)e * 2048 * 1024, scr, 64 * kb, n0, (n0 >> 7) * 256 + 128 + (n0 & 127), F.lane);
        else transpose_item(wd + so, 1024, 1024, WDN + (size_t)e * 1024 * 1024, scr, 64 * kb, n0, n0, F.lane);
    }
}
DI void rms_row(const float* xrow, const float* g, f32x4 (&v)[4], int lane) {
    const f32x4* xr = (const f32x4*)xrow + lane; float s = 0.f;
#pragma unroll
    for (int j = 0; j < 4; ++j) { v[j] = xr[64 * j]; s += (v[j].x * v[j].x + v[j].y * v[j].y) + (v[j].z * v[j].z + v[j].w * v[j].w); }
    const float rstd = 1.f / sqrtf(wave_sum(s) * (1.f / DM) + EPS);
    const f32x4* gr = (const f32x4*)g + lane;
#pragma unroll
    for (int j = 0; j < 4; ++j) v[j] = v[j] * rstd * gr[64 * j];
}
DI void store_row_bf16(bf16* orow, const f32x4 (&v)[4], int lane) {
    v2u* o8 = (v2u*)orow + lane;
#pragma unroll
    for (int j = 0; j < 4; ++j) { v2u w; w.x = pk2(v[j].x, v[j].y); w.y = pk2(v[j].z, v[j].w); o8[64 * j] = w; }
}
DI int t5_bucket(int rel) {
    const int n = rel < 0 ? -rel : rel;
    int val;
    if (n < 8) val = n;
    else { const float sc = logf((float)n / 8.f) / 4.852030263919617f; int lg = 8 + (int)(sc * 8.f); val = lg < 15 ? lg : 15; }
    return (rel > 0 ? 16 : 0) + val;
}

typedef float f32x16 __attribute__((ext_vector_type(16)));
#define MFMA32(a, b, c) __builtin_amdgcn_mfma_f32_32x32x16_bf16((a), (b), (c), 0, 0, 0)
DI int crow32(int j, int hh) { return (j & 3) + 8 * (j >> 2) + 4 * hh; }
DI void phase_prologue(Frame& F, const Args& a) {
    unsigned char* ws = F.ws;
    transpose_matrix(F, a.in[4], 1024, NIN, (bf16*)(ws + WS_WIN));
    transpose_matrix(F, a.in[5], 1024, 1024, (bf16*)(ws + WS_WOUT));
    transpose_matrix(F, a.in[12], 1024, NQKV, (bf16*)(ws + WS_WQKV));
    transpose_matrix(F, a.in[13], 1024, 1024, (bf16*)(ws + WS_WO));
    { bf16* WSB = (bf16*)(ws + WS_WSB); for (int i = F.bid * NTHR + F.tid; i < 4 * 128 * 128; i += F.G * NTHR) WSB[i] = (bf16)f2bf(a.in[8][i]); }
    { float* LB = (float*)(ws + WS_LB); const float* t = a.in[10];
      for (int i = F.bid * NTHR + F.tid; i < 2 * 512; i += F.G * NTHR) { const int d = i / 512, k = i % 512;
          const float a0 = t[(d * 3 + 0) * 512 + k], a1 = t[(d * 3 + 1) * 512 + k], a2 = t[(d * 3 + 2) * 512 + k];
          const float mx = fmaxf(a0, fmaxf(a1, a2)); const float e0 = expf(a0 - mx), e1 = expf(a1 - mx), e2 = expf(a2 - mx);
          LB[i] = e0 / (e0 + e1 + e2); } }
    { float* BT = (float*)(ws + WS_BT); const float* rb = a.in[14];
      for (int i = F.bid * NTHR + F.tid; i < 3 * 16 * 129; i += F.G * NTHR) { const int p = i / (16 * 129), h = (i / 129) % 16, j = i % 129;
          const int dil = (p == 0) ? 1 : (p == 1 ? 4 : 16);
          BT[i] = rb[t5_bucket((j - 64) * dil) * 16 + h]; } }
    { bf16* H = (bf16*)(ws + WS_H); const float* x = a.in[0];
      for (int m = F.gw; m < MTOK; m += F.NGW) { f32x4 v[4]; rms_row(x + (size_t)m * DM, a.in[1], v, F.lane); store_row_bf16(H + (size_t)m * DM, v, F.lane); } }
}

DI void phase_a_ln(Frame& F, const Args& a, bool dry = false) {
    bf16* GV = (bf16*)(F.ws + WS_GV); bf16* GO = dry ? (bf16*)(F.ws + WS_ODIR) : GV; const float* lg = a.in[6]; const float* lbv = a.in[7];
    for (int m = F.gw; m < MTOK; m += F.NGW) {
        v4u w = *((const v4u*)(GV + (size_t)m * AW) + F.lane);
        float v[8] = {bflo(w.x), bfhi(w.x), bflo(w.y), bfhi(w.y), bflo(w.z), bfhi(w.z), bflo(w.w), bfhi(w.w)};
        float s = 0.f;
#pragma unroll
        for (int j = 0; j < 8; ++j) s += v[j];
        const float mu = wave_sum(s) * (1.f / AW); float s2 = 0.f;
#pragma unroll
        for (int j = 0; j < 8; ++j) { v[j] -= mu; s2 += v[j] * v[j]; }
        const float rstd = 1.f / sqrtf(wave_sum(s2) * (1.f / AW) + EPS);
#pragma unroll
        for (int j = 0; j < 8; ++j) v[j] = v[j] * rstd * lg[8 * F.lane + j] + lbv[8 * F.lane + j];
        v4u o; o.x = pk2(v[0], v[1]); o.y = pk2(v[2], v[3]); o.z = pk2(v[4], v[5]); o.w = pk2(v[6], v[7]);
        *((v4u*)(GO + (size_t)m * AW) + F.lane) = o;
    }
}
DI void phase_a_mix(Frame& F, const Args& a) {
    const bf16* VN = (const bf16*)(F.ws + WS_GV); const bf16* U = (const bf16*)(F.ws + WS_U); bf16* CAT = (bf16*)(F.ws + WS_CAT); const bf16* WSB = (const bf16*)(F.ws + WS_WSB);
    const int r32 = F.lane & 31, hh = F.lane >> 5, ci = F.wave & 3, tp = F.wave >> 2;
    for (int u = F.bid; u < 512; u += F.G) {
        const int g = u & 3, ch = u >> 2; const int row0 = ch * 128;
        f32x16 acc[2];
#pragma unroll
        for (int j = 0; j < 16; ++j) { acc[0][j] = 0.f; acc[1][j] = 0.f; }
        const bf16* vcol = VN + (size_t)row0 * AW + g * 128 + 32 * ci + r32;
        const bf16* w0 = WSB + (size_t)g * 16384 + (size_t)(64 * tp + r32) * 128 + 8 * hh;
#pragma unroll
        for (int s = 0; s < 8; ++s) {
            unsigned short e[8];
#pragma unroll
            for (int j = 0; j < 8; ++j) e[j] = vcol[(size_t)(16 * s + 8 * hh + j) * AW];
            v4u bw; bw.x = e[0] | ((unsigned)e[1] << 16); bw.y = e[2] | ((unsigned)e[3] << 16); bw.z = e[4] | ((unsigned)e[5] << 16); bw.w = e[6] | ((unsigned)e[7] << 16);
            const bf16x8 bt = __builtin_bit_cast(bf16x8, bw);
            acc[0] = MFMA32(*(const bf16x8*)(w0 + 16 * s), bt, acc[0]);
            acc[1] = MFMA32(*(const bf16x8*)(w0 + 32 * 128 + 16 * s), bt, acc[1]);
        }
#pragma unroll
        for (int q = 0; q < 2; ++q)
#pragma unroll
            for (int j = 0; j < 16; ++j) { const int t = 64 * tp + 32 * q + crow32(j, hh), c = g * 128 + 32 * ci + r32;
                const float uu = bf2f(U[(size_t)(row0 + t) * AW + c]);
                CAT[(size_t)(row0 + t) * DM + c] = (bf16)f2bf(uu * (acc[q][j] + a.in[9][g * 128 + t])); }
    }
}

DI void phase_gla_scan(Frame& F, bool dry = false) {
    float* ST = (float*)(F.ws + WS_ST); float* SO = dry ? (float*)(F.ws + WS_ODIR) : ST; const float* DEC = (const float*)(F.ws + WS_DEC);
    for (int idx = F.bid * NTHR + F.tid; idx < 16 * 16384; idx += F.G * NTHR) {
        const int chain = idx >> 14, kv = idx & 16383, k = kv >> 7;
        float d[NSC], dc[NSC];
#pragma unroll
        for (int sc = 0; sc < NSC; ++sc) { const int u = chain * NSC + sc; d[sc] = ST[(size_t)u * 16384 + kv]; dc[sc] = DEC[u * 128 + k]; }
        float S = 0.f;
#pragma unroll
        for (int sc = 0; sc < NSC; ++sc) { const int u = chain * NSC + sc; SO[(size_t)u * 16384 + kv] = S; S = S * dc[sc] + d[sc]; }
    }
}
DI void phase_b_combine(Frame& F, const Args& a) {
    const float* OD = (const float*)(F.ws + WS_ODIR); const bf16* G = (const bf16*)(F.ws + WS_G); bf16* CAT = (bf16*)(F.ws + WS_CAT); const float* ng = a.in[11];
    for (int t = F.gw; t < MTOK * 4; t += F.NGW) { const int row = t >> 2, h = t & 3; const size_t o = (size_t)row * AW + h * 128 + 2 * F.lane;
        const float o0 = OD[o] + OD[(size_t)MTOK * AW + o], o1 = OD[o + 1] + OD[(size_t)MTOK * AW + o + 1];
        const float rstd = 1.f / sqrtf(wave_sum(o0 * o0 + o1 * o1) * (1.f / 128.f) + EPS);
        const unsigned gw2 = *(const unsigned*)(G + o);
        const float r0 = o0 * rstd * ng[h * 128 + 2 * F.lane] * bflo(gw2), r1 = o1 * rstd * ng[h * 128 + 2 * F.lane + 1] * bfhi(gw2);
        *(unsigned*)(CAT + (size_t)row * DM + 512 + h * 128 + 2 * F.lane) = pk2(r0, r1); }
}

DI void phase_router(Frame& F, const float* XR, const float* gn, const float* wr) {
    LAS float* wl = (LAS float*)F.lds;
    __syncthreads();
    for (int i = F.tid; i < 1024 * 16 / 4; i += NTHR) { const f32x4 w4 = *(const f32x4*)(wr + 4 * i); const int d = i >> 2, e0 = 4 * (i & 3);
        wl[(e0 + 0) * 1024 + d] = w4.x; wl[(e0 + 1) * 1024 + d] = w4.y; wl[(e0 + 2) * 1024 + d] = w4.z; wl[(e0 + 3) * 1024 + d] = w4.w; }
    __syncthreads();
    bf16* H = (bf16*)(F.ws + WS_H); float* AFF = (float*)(F.ws + WS_AFF);
    for (int mp = F.gw; mp < MTOK / 2; mp += F.NGW) {
        asm volatile("" ::: "memory");
        const int m0 = 2 * mp;
        f32x4 va[4], vb[4];
        { const f32x4* xa = (const f32x4*)(XR + (size_t)m0 * DM) + F.lane; const f32x4* xb = xa + DM / 4;
#pragma unroll
          for (int j = 0; j < 4; ++j) { va[j] = xa[64 * j]; vb[j] = xb[64 * j]; } }
        float sa = 0.f, sb = 0.f;
#pragma unroll
        for (int j = 0; j < 4; ++j) { sa += (va[j].x * va[j].x + va[j].y * va[j].y) + (va[j].z * va[j].z + va[j].w * va[j].w); sb += (vb[j].x * vb[j].x + vb[j].y * vb[j].y) + (vb[j].z * vb[j].z + vb[j].w * vb[j].w); }
        const float ra = 1.f / sqrtf(wave_sum(sa) * (1.f / DM) + EPS), rb = 1.f / sqrtf(wave_sum(sb) * (1.f / DM) + EPS);
        { const f32x4* gr = (const f32x4*)gn + F.lane;
#pragma unroll
          for (int j = 0; j < 4; ++j) { const f32x4 g4 = gr[64 * j]; va[j] = va[j] * ra * g4; vb[j] = vb[j] * rb * g4; } }
        store_row_bf16(H + (size_t)m0 * DM, va, F.lane); store_row_bf16(H + (size_t)(m0 + 1) * DM, vb, F.lane);
        float pa[16], pb[16];
#pragma unroll
        for (int e = 0; e < 16; ++e) { float a = 0.f, c = 0.f;
#pragma unroll
            for (int j = 0; j < 4; ++j) { const f32x4 w4 = *(const LAS f32x4*)(wl + e * 1024 + 4 * F.lane + 256 * j);
                a += (va[j].x * w4.x + va[j].y * w4.y) + (va[j].z * w4.z + va[j].w * w4.w); c += (vb[j].x * w4.x + vb[j].y * w4.y) + (vb[j].z * w4.z + vb[j].w * w4.w); }
            pa[e] = a; pb[e] = c; }
        const float la = red16(pa, F.lane), lb = red16(pb, F.lane);
        const float ma = wave_max(la), mb = wave_max(lb); const float ea = expf(la - ma), eb = expf(lb - mb); const float za = wave_sum(ea) * 0.25f, zb = wave_sum(eb) * 0.25f;
        if ((F.lane & 3) == 0) { const int b = m0 / SEQ, sq = m0 % SEQ; float* ap = AFF + (size_t)(b * 16 + red16_idx(F.lane)) * SEQ + sq; ap[0] = ea / za; ap[1] = eb / zb; }
    }
}

DI int block_excl_scan(int v, LAS int* scratch, int tid, int lane, int wave, int* tot) {
    int inc = v;
#pragma unroll
    for (int o = 1; o < 64; o <<= 1) { const int t = __shfl_up(inc, o); if (lane >= o) inc += t; }
    __syncthreads();
    if (lane == 63) scratch[wave] = inc;
    __syncthreads();
    int base = 0, total = 0;
#pragma unroll
    for (int w = 0; w < NWAVES; ++w) { const int s = scratch[w]; if (w < wave) base += s; total += s; }
    *tot = total;
    return base + inc - v;
}
DI void phase_topk(Frame& F) {
    const float* AFF = (const float*)(F.ws + WS_AFF); int* IDX = (int*)(F.ws + WS_IDX); float* GATE = (float*)(F.ws + WS_GATE); int* POS = (int*)(F.ws + WS_POS);
    LAS unsigned* hist = (LAS unsigned*)F.lds; LAS int* sc = (LAS int*)(F.lds + 16384); LAS unsigned* shv = (LAS unsigned*)(F.lds + 16384 + 256);
    for (int u = F.bid; u < BATCH * NEXP; u += F.G) {
        const int b = u / NEXP, e = u % NEXP;
        unsigned vals[16];
        { const v4u* src = (const v4u*)(AFF + (size_t)u * SEQ + 16 * F.tid);
#pragma unroll
          for (int j = 0; j < 4; ++j) { const v4u t = src[j]; vals[4 * j] = t.x; vals[4 * j + 1] = t.y; vals[4 * j + 2] = t.z; vals[4 * j + 3] = t.w; } }
        unsigned prefix = 0; int krem = CAP;
#pragma unroll
        for (int pass = 0; pass < 3; ++pass) {
            const int shift = (pass == 0) ? 20 : (pass == 1 ? 8 : 0); const unsigned mask = (pass == 2) ? 255u : 4095u; const int pshift = (pass == 2) ? 8 : 20;
            __syncthreads();
#pragma unroll
            for (int j = 0; j < 8; ++j) hist[F.tid + 512 * j] = 0u;
            __syncthreads();
#pragma unroll
            for (int j = 0; j < 16; ++j) { const unsigned v = vals[j]; if (pass == 0 || (v >> pshift) == prefix) __hip_atomic_fetch_add(&hist[(v >> shift) & mask], 1u, __ATOMIC_RELAXED, __HIP_MEMORY_SCOPE_WORKGROUP); }
            __syncthreads();
            const int hi = 4095 - 8 * F.tid; int ls = 0; unsigned hb[8];
#pragma unroll
            for (int j = 0; j < 8; ++j) { hb[j] = hist[hi - j]; ls += (int)hb[j]; }
            int tot; const int above = block_excl_scan(ls, sc, F.tid, F.lane, F.wave, &tot);
            if (above < krem && krem <= above + ls) { int cum = above, sel = hi, found = 0;
#pragma unroll
                for (int j = 0; j < 8; ++j) { if (!found) { if (cum + (int)hb[j] >= krem) { sel = hi - j; found = 1; } else cum += (int)hb[j]; } }
                shv[0] = (unsigned)sel; shv[1] = (unsigned)(krem - cum); }
            __syncthreads();
            prefix = (pass == 2) ? ((prefix << 8) | shv[0]) : ((prefix << 12) | shv[0]); krem = (int)shv[1];
        }
        const unsigned T = prefix;
        int ce = 0;
#pragma unroll
        for (int j = 0; j < 16; ++j) ce += (vals[j] == T) ? 1 : 0;
        int tot; int pe = block_excl_scan(ce, sc, F.tid, F.lane, F.wave, &tot);
        unsigned selmask = 0; int cs = 0;
#pragma unroll
        for (int j = 0; j < 16; ++j) { bool s = vals[j] > T; if (vals[j] == T) { s = pe < krem; ++pe; } if (s) { selmask |= 1u << j; ++cs; } }
        int slot = block_excl_scan(cs, sc, F.tid, F.lane, F.wave, &tot);
#pragma unroll
        for (int j = 0; j < 16; ++j) { const int s = 16 * F.tid + j; const int tokrow = b * SEQ + s;
            if (selmask & (1u << j)) { const int row = (e * 2 + b) * CAP + slot; ++slot; IDX[row] = tokrow; GATE[row] = __builtin_bit_cast(float, vals[j]); POS[tokrow * 16 + e] = row; }
            else POS[tokrow * 16 + e] = -1; }
    }
}
DI void phase_gather(Frame& F) {
    const bf16* H = (const bf16*)(F.ws + WS_H); bf16* XE = (bf16*)(F.ws + WS_XE); const int* IDX = (const int*)(F.ws + WS_IDX);
    for (int r = F.gw; r < NROWS; r += F.NGW) { const int src = IDX[r];
        const v4u* s = (const v4u*)(H + (size_t)src * DM) + F.lane; v4u* d = (v4u*)(XE + (size_t)r * DM) + F.lane;
        d[0] = s[0]; d[64] = s[64]; }
}
struct CombRow { f32x4 v[4]; v2u y[4][4]; float sc[4]; unsigned rest; int pm; };
DI void comb_load(CombRow& c, const float* XR, const bf16* Y, const int* POS, int m, int lane) {
    const f32x4* xr = (const f32x4*)(XR + (size_t)m * DM) + lane;
#pragma unroll
    for (int j = 0; j < 4; ++j) c.v[j] = xr[64 * j];
    c.pm = POS[m * 16 + (lane & 15)];
    unsigned mk = (unsigned)__builtin_amdgcn_readfirstlane((int)(unsigned)(__ballot(lane < 16 && c.pm >= 0)));
#pragma unroll
    for (int q = 0; q < 4; ++q) {
        int p = -1;
        if (mk) { const int e = __builtin_ctz(mk); mk &= mk - 1u; p = __builtin_amdgcn_readlane(c.pm, e); }
        c.sc[q] = (p >= 0) ? 1.f : 0.f;
        const v2u* yr = (const v2u*)(Y + (size_t)(p >= 0 ? p : 0) * DM) + lane;
#pragma unroll
        for (int j = 0; j < 4; ++j) c.y[q][j] = yr[64 * j];
    }
    c.rest = mk;
}
DI void comb_finish(CombRow& c, float* XO, bf16* H, const bf16* Y, const float* gnext, bool final_out, int m, int lane) {
#pragma unroll
    for (int q = 0; q < 4; ++q)
#pragma unroll
        for (int j = 0; j < 4; ++j) { const v2u w = c.y[q][j]; const float s = c.sc[q]; c.v[j].x += s * bflo(w.x); c.v[j].y += s * bfhi(w.x); c.v[j].z += s * bflo(w.y); c.v[j].w += s * bfhi(w.y); }
    unsigned mk = c.rest;
    while (mk) { const int e = __builtin_ctz(mk); mk &= mk - 1u; const int p = __builtin_amdgcn_readlane(c.pm, e);
        const v2u* yr = (const v2u*)(Y + (size_t)p * DM) + lane;
#pragma unroll
        for (int j = 0; j < 4; ++j) { const v2u w = yr[64 * j]; c.v[j].x += bflo(w.x); c.v[j].y += bfhi(w.x); c.v[j].z += bflo(w.y); c.v[j].w += bfhi(w.y); } }
    float s = 0.f;
#pragma unroll
    for (int j = 0; j < 4; ++j) s += (c.v[j].x * c.v[j].x + c.v[j].y * c.v[j].y) + (c.v[j].z * c.v[j].z + c.v[j].w * c.v[j].w);
    const float rstd = 1.f / sqrtf(wave_sum(s) * (1.f / DM) + EPS);
    const f32x4* gr = (const f32x4*)gnext + lane; f32x4* xo = (f32x4*)(XO + (size_t)m * DM) + lane;
    if (final_out) {
#pragma unroll
        for (int j = 0; j < 4; ++j) xo[64 * j] = c.v[j] * rstd * gr[64 * j];
    } else {
#pragma unroll
        for (int j = 0; j < 4; ++j) xo[64 * j] = c.v[j];
        f32x4 nv[4];
#pragma unroll
        for (int j = 0; j < 4; ++j) nv[j] = c.v[j] * rstd * gr[64 * j];
        store_row_bf16(H + (size_t)m * DM, nv, lane);
    }
}
DI void phase_moe_combine(Frame& F, float* XR, const float* gnext, bool final_out, bool dry = false) {
    const bf16* Y = (const bf16*)(F.ws + WS_Y); const int* POS = (const int*)(F.ws + WS_POS); bf16* H = (bf16*)(F.ws + (dry ? WS_R1 + 256 * MiB : WS_H));
    float* XO = dry ? (float*)(F.ws + WS_R1 + 192 * MiB) : XR;
    for (int m = F.gw; m < MTOK; m += 2 * F.NGW) {
        CombRow ca, cb; const int m2 = m + F.NGW;
        comb_load(ca, XR, Y, POS, m, F.lane);
        if (m2 < MTOK) comb_load(cb, XR, Y, POS, m2, F.lane);
        comb_finish(ca, XO, H, Y, gnext, final_out, m, F.lane);
        if (m2 < MTOK) comb_finish(cb, XO, H, Y, gnext, final_out, m2, F.lane);
    }
}

DI int kperm(int r) { return (r & ~12) | ((r & 4) << 1) | ((r & 8) >> 1); }
DI void phase_kvf(Frame& F) {
    const bf16* QKV = (const bf16*)(F.ws + WS_QKV); unsigned char* KF = F.ws + WS_KF; unsigned char* VF = F.ws + WS_VF;
    LAS unsigned char* kl = F.lds; LAS unsigned char* vl = F.lds + 69632;
    for (int u = F.bid; u < 512; u += F.G) {
        const int c = u & 15, h = (u >> 4) & 15, b = u >> 8, t0 = c * 512;
        __syncthreads();
        { const v4u* ks = (const v4u*)(QKV + (size_t)(b * SEQ + t0 + F.tid) * NQKV + 1024 + h * 64); const v4u* vs = (const v4u*)(QKV + (size_t)(b * SEQ + t0 + F.tid) * NQKV + 2048 + h * 64);
#pragma unroll
          for (int j = 0; j < 8; ++j) { const v4u w = ks[j]; LAS v2u* d = (LAS v2u*)(kl + F.tid * 136 + 16 * j); d[0] = (v2u){w.x, w.y}; d[1] = (v2u){w.z, w.w}; }
#pragma unroll
          for (int j = 0; j < 8; ++j) { const v4u w = vs[j]; LAS v2u* d = (LAS v2u*)(vl + F.tid * 136 + 16 * j); d[0] = (v2u){w.x, w.y}; d[1] = (v2u){w.z, w.w}; } }
        __syncthreads();
#pragma unroll
        for (int p = 0; p < 3; ++p) {
            const int dl = (p == 0) ? 1 : (p == 1 ? 4 : 16), tpr = 16 / dl, ntile = SEQ / dl / 32;
            unsigned char* kd = KF + (size_t)p * 32 * MiB; unsigned char* vd = VF + (size_t)p * 32 * MiB;
#pragma unroll 2
            for (int i = 0; i < 8; ++i) { const int q = F.tid + 512 * i, tl = q >> 8, ln = q & 63, hh = ln >> 5, rho = ln & 31, r = tl / tpr, tt = tl % tpr;
                const size_t tg = ((size_t)((b * 16 + h) * dl + r) * ntile + c * tpr + tt) * 4096;
                { const int s = (q >> 6) & 3, tokl = dl * (32 * tt + kperm(rho)) + r;
                  const LAS v2u* sp = (const LAS v2u*)(kl + tokl * 136 + 64 * hh + 16 * s); const v2u a0 = sp[0], a1 = sp[1];
                  *(v4u*)(kd + tg + s * 1024 + ln * 16) = (v4u){a0.x, a0.y, a1.x, a1.y}; }
                { const int dt = (q >> 7) & 1, s2 = (q >> 6) & 1, dim = 32 * dt + rho; unsigned short e[8];
#pragma unroll
                  for (int k = 0; k < 8; ++k) e[k] = *(const LAS unsigned short*)(vl + (dl * (32 * tt + 16 * s2 + 8 * hh + k) + r) * 136 + dim * 2);
                  v4u o; o.x = e[0] | ((unsigned)e[1] << 16); o.y = e[2] | ((unsigned)e[3] << 16); o.z = e[4] | ((unsigned)e[5] << 16); o.w = e[6] | ((unsigned)e[7] << 16);
                  *(v4u*)(vd + tg + (dt * 2 + s2) * 1024 + ln * 16) = o; }
            }
        }
    }
}

DI int osw(int tok, int chunk) { return tok * 256 + (((chunk ^ tok ^ (tok >> 4)) & 15) << 4); }
struct AttnK { bf16x8 k[4]; }; struct AttnV { bf16x8 v[2][2]; };
#ifndef PROBE_DUP
#define PROBE_DUP (-1)
#endif
#ifndef PROBE_SAME
#define PROBE_SAME 0
#endif
DI void attn_load_k(AttnK& t, const unsigned char* kt) {
#pragma unroll
    for (int s = 0; s < 4; ++s) t.k[s] = *(const bf16x8*)(kt + s * 1024);
    if (PROBE_DUP == 77) {
#pragma unroll
        for (int s = 0; s < 4; ++s) { bf16x8 d = *(const bf16x8*)(kt + s * 1024 + (PROBE_SAME ? 0 : 64 * MiB)); asm volatile("" :: "v"(d)); }
    }
}
DI void attn_load_v(AttnV& t, const unsigned char* vt) {
#pragma unroll
    for (int dt = 0; dt < 2; ++dt)
#pragma unroll
        for (int s = 0; s < 2; ++s) t.v[dt][s] = *(const bf16x8*)(vt + (dt * 2 + s) * 1024);
}
template <bool MASK> DI void attn_step(const AttnK& tk, const AttnV& tv, const bf16x8 (&qf)[4], f32x16& o0, f32x16& o1, float& m, float& l, const LAS float* bl, int rel0, int hh) {
    f32x16 sa;
#pragma unroll
    for (int i = 0; i < 16; ++i) sa[i] = 0.f;
#pragma unroll
    for (int s = 0; s < 4; ++s) sa = MFMA32(tk.k[s], qf[s], sa);
    float sc[16]; float tmax = -1e30f;
#pragma unroll
    for (int i = 0; i < 16; ++i) { const int rel = rel0 + 16 * (i >> 3) + (i & 7);
        const bool valid = !MASK || ((rel >= -64) && (rel <= 64)); const int idx = valid ? rel + 64 : 0;
        const float v = sa[i] + bl[idx]; sc[i] = valid ? v : -1e30f; tmax = fmaxf(tmax, sc[i]); }
    tmax = fmaxf(tmax, __shfl_xor(tmax, 32));
    const float mnew = fmaxf(m, tmax), alpha = fexp(m - mnew);
    float ps = 0.f; float p[16];
#pragma unroll
    for (int i = 0; i < 16; ++i) { p[i] = (!MASK || sc[i] > -1e29f) ? fexp(sc[i] - mnew) : 0.f; ps += p[i]; }
    l = l * alpha + ps; m = mnew;
#pragma unroll
    for (int i = 0; i < 16; ++i) { o0[i] *= alpha; o1[i] *= alpha; }
#pragma unroll
    for (int s = 0; s < 2; ++s) {
        v4u w; w.x = pk2(p[8 * s], p[8 * s + 1]); w.y = pk2(p[8 * s + 2], p[8 * s + 3]); w.z = pk2(p[8 * s + 4], p[8 * s + 5]); w.w = pk2(p[8 * s + 6], p[8 * s + 7]);
        const bf16x8 pf = __builtin_bit_cast(bf16x8, w);
        o0 = MFMA32(tv.v[0][s], pf, o0); o1 = MFMA32(tv.v[1][s], pf, o1);
    }
}
DI void attn_stage(Frame& F, int b, int h, int t0, const int P) {
    const int dsh = 2 * P, DL = 1 << dsh, NT = (SEQ / 32) >> dsh;
    const bf16* QKV = (const bf16*)(F.ws + WS_QKV); const unsigned char* KF = F.ws + WS_KF + (size_t)P * 32 * MiB; const unsigned char* VF = F.ws + WS_VF + (size_t)P * 32 * MiB; bf16* ATT = (bf16*)(F.ws + WS_ATT);
    LAS unsigned char* ol = F.lds; LAS float* ml = (LAS float*)(F.lds + 131072); LAS float* ll = ml + 512; const LAS float* bl = (const LAS float*)(F.lds + 135168) + P * 132;
    int lane = F.lane; asm volatile("" : "+v"(lane));
    const int r32 = lane & 31, hh = lane >> 5, w = F.wave;
    asm volatile("" ::: "memory");
    int rr[2], mq[2], tq[2]; const unsigned char* kb[2]; const unsigned char* vb[2];
#pragma unroll
    for (int task = 0; task < 2; ++task) {
        int r, i0;
        if (P == 0) { r = 0; i0 = 64 * w + 32 * task; } else if (P == 1) { r = w & 3; i0 = 64 * (w >> 2) + 32 * task; } else { r = 2 * w + task; i0 = 0; }
        rr[task] = r; mq[task] = (t0 >> dsh) + i0; tq[task] = r + ((i0 + r32) << dsh);
        const size_t tb0 = ((size_t)((b * 16 + h) * DL + r) * NT) * 4096 + lane * 16;
        kb[task] = KF + tb0; vb[task] = VF + tb0;
    }
    int relb = 8 * hh - 64 - r32;
    asm volatile("" : "+v"(relb));
    AttnK ka, kb_, kc; AttnV va, vb_; bf16x8 qf[4], qn[4]; f32x16 o0, o1; float m, l;
#define ATT_T(task, kt) (mq[task] / 32 - 2 + (kt))
#define ATT_OK(task, kt) (ATT_T(task, kt) >= 0 && ATT_T(task, kt) < NT)
#define ATT_TC(task, kt) (ATT_T(task, kt) < 0 ? 0 : (ATT_T(task, kt) >= NT ? NT - 1 : ATT_T(task, kt)))
#define ATT_LDK(t, task, kt) attn_load_k(t, kb[task] + (size_t)ATT_TC(task, kt) * 4096)
#define ATT_LDV(t, task, kt) attn_load_v(t, vb[task] + (size_t)ATT_TC(task, kt) * 4096)
#define ATT_ST(tk, tv, task, kt, MSK) do { if (ATT_OK(task, kt)) attn_step<MSK>(tk, tv, qf, o0, o1, m, l, bl, relb + 32 * (kt), hh); } while (0)
#define ATT_Q(dst, task) do { const bf16* qp = QKV + (size_t)(b * SEQ + t0 + tq[task]) * NQKV + h * 64 + 32 * hh; _Pragma("unroll") for (int s = 0; s < 4; ++s) dst[s] = *(const bf16x8*)(qp + 8 * s); } while (0)
#define ATT_INIT(task) do { if (P == 0) { _Pragma("unroll") for (int i = 0; i < 16; ++i) { o0[i] = 0.f; o1[i] = 0.f; } m = -1e30f; l = 0.f; } else { \
        _Pragma("unroll") for (int g = 0; g < 4; ++g) { const f32x4 a = *(const LAS f32x4*)(ol + osw(tq[task], 2 * g + hh)), c = *(const LAS f32x4*)(ol + osw(tq[task], 8 + 2 * g + hh)); \
            o0[4 * g] = a.x; o0[4 * g + 1] = a.y; o0[4 * g + 2] = a.z; o0[4 * g + 3] = a.w; o1[4 * g] = c.x; o1[4 * g + 1] = c.y; o1[4 * g + 2] = c.z; o1[4 * g + 3] = c.w; } \
        m = ml[tq[task]]; l = hh ? 0.f : ll[tq[task]]; } } while (0)
#define ATT_WB(task) do { const float lt = l + __shfl_xor(l, 32); int tw = tq[task]; asm volatile("" : "+v"(tw));     \
        if (P < 2) { _Pragma("unroll") for (int g = 0; g < 4; ++g) { *(LAS f32x4*)(ol + osw(tw, 2 * g + hh)) = (f32x4){o0[4 * g], o0[4 * g + 1], o0[4 * g + 2], o0[4 * g + 3]}; \
                *(LAS f32x4*)(ol + osw(tw, 8 + 2 * g + hh)) = (f32x4){o1[4 * g], o1[4 * g + 1], o1[4 * g + 2], o1[4 * g + 3]}; } \
            if (hh == 0) { ml[tw] = m; ll[tw] = lt; } } \
        else { const float inv = 1.f / lt; bf16* op = ATT + (size_t)(b * SEQ + t0 + tw) * DM + h * 64 + 4 * hh; \
            _Pragma("unroll") for (int g = 0; g < 4; ++g) { v2u a, c; a.x = pk2(o0[4 * g] * inv, o0[4 * g + 1] * inv); a.y = pk2(o0[4 * g + 2] * inv, o0[4 * g + 3] * inv); \
                c.x = pk2(o1[4 * g] * inv, o1[4 * g + 1] * inv); c.y = pk2(o1[4 * g + 2] * inv, o1[4 * g + 3] * inv); *(v2u*)(op + 8 * g) = a; *(v2u*)(op + 32 + 8 * g) = c; } } } while (0)
    ATT_LDK(ka, 0, 0); ATT_LDK(kb_, 0, 1); ATT_LDV(va, 0, 0);
    ATT_Q(qf, 0); ATT_INIT(0);
    ATT_LDK(kc, 0, 2); ATT_LDV(vb_, 0, 1); ATT_ST(ka, va, 0, 0, true);
    ATT_LDK(ka, 0, 3); ATT_LDV(va, 0, 2); ATT_ST(kb_, vb_, 0, 1, false);
    ATT_LDK(kb_, 0, 4); ATT_LDV(vb_, 0, 3); ATT_ST(kc, va, 0, 2, false);
    ATT_Q(qn, 1);
    ATT_LDK(kc, 1, 0); ATT_LDV(va, 0, 4); ATT_ST(ka, vb_, 0, 3, false);
    ATT_LDK(ka, 1, 1); ATT_LDV(vb_, 1, 0); ATT_ST(kb_, va, 0, 4, true);
    ATT_WB(0);
    _Pragma("unroll") for (int s = 0; s < 4; ++s) qf[s] = qn[s];
    ATT_INIT(1);
    ATT_LDK(kb_, 1, 2); ATT_LDV(va, 1, 1); ATT_ST(kc, vb_, 1, 0, true);
    ATT_LDK(kc, 1, 3); ATT_LDV(vb_, 1, 2); ATT_ST(ka, va, 1, 1, false);
    ATT_LDK(ka, 1, 4); ATT_LDV(va, 1, 3); ATT_ST(kb_, vb_, 1, 2, false);
    ATT_LDV(vb_, 1, 4); ATT_ST(kc, va, 1, 3, false);
    ATT_ST(ka, vb_, 1, 4, true);
    ATT_WB(1);
#undef ATT_T
#undef ATT_OK
#undef ATT_TC
#undef ATT_LDK
#undef ATT_LDV
#undef ATT_ST
#undef ATT_Q
#undef ATT_INIT
#undef ATT_WB
}
DI void phase_attn(Frame& F) {
    const float* BT = (const float*)(F.ws + WS_BT);
    LAS float* bl = (LAS float*)(F.lds + 135168);
    const int vb_ = (F.G % 8 == 0) ? (F.bid % 8) * (F.G / 8) + F.bid / 8 : F.bid;
    for (int u = vb_; u < 512; u += F.G) {
        const int c = u & 15, h = (u >> 4) & 15, b = u >> 8, t0 = c * 512;
        __syncthreads();
        { int i0 = F.tid; asm volatile("" : "+v"(i0)); for (int i = i0; i < 3 * 129; i += NTHR) bl[(i / 129) * 132 + i % 129] = BT[((i / 129) * 16 + h) * 129 + i % 129]; }
        __syncthreads();
#pragma unroll 1
        for (int P = 0; P < 3; ++P) { if (P) __syncthreads(); attn_stage(F, b, h, t0, P); }
    }
}

constexpr int GL_QT = 0, GL_KT = 17408, GL_QB = 34816, GL_KHT = 52224, GL_VT = 70656, GL_P = 89088, GL_ST = 98304, GL_DEC = 133120, GL_TOT = 133632;
struct GlaRaw { float lf[16]; unsigned short q[16]; unsigned short v[16]; };
template <bool FULL> DI void gla_load_raw(GlaRaw& R, const _Float16* LF, const bf16* Q, const bf16* V, int b, int h, int dir, int pos0, int ch) {
#pragma unroll
    for (int i = 0; i < 16; ++i) { const int ii = pos0 + i; const int tok = dir ? (SEQ - 1 - ii) : ii; const size_t off = (size_t)(b * SEQ + tok) * AW + h * 128 + ch;
        R.lf[i] = (float)LF[off]; R.v[i] = V[off]; if (FULL) R.q[i] = Q[off]; }
}
template <bool FULL> DI float gla_prep(Frame& F, const GlaRaw& R) {
    LAS unsigned char* L = F.lds; LAS float* tot = (LAS float*)(L + GL_TOT);
    const int ch = F.tid & 127, qtr = F.tid >> 7;
    float c[16]; float run = 0.f;
#pragma unroll
    for (int i = 0; i < 16; ++i) { run += R.lf[i]; c[i] = run; }
    tot[qtr * 128 + ch] = run;
    __syncthreads();
    const float t0 = tot[ch], t1 = tot[128 + ch], t2 = tot[256 + ch], t3 = tot[384 + ch];
    const float off = (qtr > 0 ? t0 : 0.f) + (qtr > 1 ? t1 : 0.f) + (qtr > 2 ? t2 : 0.f), rr = t0 + t1, bend = (t0 + t1) + (t2 + t3);
    unsigned kh[8], vv[8];
#pragma unroll
    for (int i = 0; i < 16; i += 2) {
        const float b0 = off + c[i], b1 = off + c[i + 1];
        const float k0 = 1.f - fexp(R.lf[i]), k1 = 1.f - fexp(R.lf[i + 1]);
        kh[i >> 1] = pk2(k0 * fexp(bend - b0), k1 * fexp(bend - b1));
        vv[i >> 1] = (unsigned)R.v[i] | ((unsigned)R.v[i + 1] << 16);
        if (FULL) {
            const float q0 = bf2f(R.q[i]), q1 = bf2f(R.q[i + 1]);
            const int ta = 16 * qtr + i;
            *(LAS unsigned short*)(L + GL_QT + ta * 272 + 2 * ch) = (unsigned short)f2bf(q0 * fexp(b0 - rr));
            *(LAS unsigned short*)(L + GL_QT + (ta + 1) * 272 + 2 * ch) = (unsigned short)f2bf(q1 * fexp(b1 - rr));
            *(LAS unsigned short*)(L + GL_KT + ta * 272 + 2 * ch) = (unsigned short)f2bf(k0 * fexp(rr - b0));
            *(LAS unsigned short*)(L + GL_KT + (ta + 1) * 272 + 2 * ch) = (unsigned short)f2bf(k1 * fexp(rr - b1));
            *(LAS unsigned short*)(L + GL_QB + ta * 272 + 2 * ch) = (unsigned short)f2bf(q0 * fexp(b0));
            *(LAS unsigned short*)(L + GL_QB + (ta + 1) * 272 + 2 * ch) = (unsigned short)f2bf(q1 * fexp(b1));
        }
    }
    *(LAS v4u*)(L + GL_KHT + ch * 144 + 32 * qtr) = (v4u){kh[0], kh[1], kh[2], kh[3]}; *(LAS v4u*)(L + GL_KHT + ch * 144 + 32 * qtr + 16) = (v4u){kh[4], kh[5], kh[6], kh[7]};
    *(LAS v4u*)(L + GL_VT + ch * 144 + 32 * qtr) = (v4u){vv[0], vv[1], vv[2], vv[3]}; *(LAS v4u*)(L + GL_VT + ch * 144 + 32 * qtr + 16) = (v4u){vv[4], vv[5], vv[6], vv[7]};
    if (qtr == 0) *(LAS float*)(L + GL_DEC + 4 * ch) = fexp(bend);
    return bend;
}
DI bf16x8 gfrag(const LAS unsigned char* base, int row, int stride, int kel) { return *(const LAS bf16x8*)(base + row * stride + kel * 2); }
DI void gla_state_update(Frame& F, f32x16 (&S)[2]) {
    const LAS unsigned char* L = F.lds; const int r32 = F.lane & 31, hh = F.lane >> 5, vi = F.wave & 3, ki0 = 2 * (F.wave >> 2);
    bf16x8 a[4];
#pragma unroll
    for (int s = 0; s < 4; ++s) a[s] = gfrag(L + GL_VT, 32 * vi + r32, 144, 16 * s + 8 * hh);
#pragma unroll
    for (int q = 0; q < 2; ++q) { const int kr = 32 * (ki0 + q) + r32; const float d = *(const LAS float*)(L + GL_DEC + 4 * kr);
#pragma unroll
        for (int j = 0; j < 16; ++j) S[q][j] *= d;
#pragma unroll
        for (int s = 0; s < 4; ++s) S[q] = MFMA32(a[s], gfrag(L + GL_KHT, kr, 144, 16 * s + 8 * hh), S[q]); }
}
DI void gla_state_to_lds(Frame& F, const f32x16 (&S)[2]) {
    LAS unsigned char* L = F.lds; const int r32 = F.lane & 31, hh = F.lane >> 5, vi = F.wave & 3, ki0 = 2 * (F.wave >> 2);
#pragma unroll
    for (int q = 0; q < 2; ++q)
#pragma unroll
        for (int j = 0; j < 16; ++j) *(LAS unsigned short*)(L + GL_ST + (32 * vi + crow32(j, hh)) * 272 + 2 * (32 * (ki0 + q) + r32)) = (unsigned short)f2bf(S[q][j]);
}
DI void gla_unit_state(Frame& F, int u) {
    const int sc = u & 31, dir = (u >> 5) & 1, h = (u >> 6) & 3, b = u >> 8;
    const bf16* Q = (const bf16*)(F.ws + WS_Q); const bf16* V = (const bf16*)(F.ws + WS_V); const _Float16* LF = (const _Float16*)(F.ws + (dir ? WS_LFB : WS_LFF));
    float* ST = (float*)(F.ws + WS_ST) + (size_t)u * 16384; float* DEC = (float*)(F.ws + WS_DEC) + u * 128;
    const int ch = F.tid & 127, qtr = F.tid >> 7, r32 = F.lane & 31, hh = F.lane >> 5, vi = F.wave & 3, ki0 = 2 * (F.wave >> 2);
    f32x16 S[2];
#pragma unroll
    for (int j = 0; j < 16; ++j) { S[0][j] = 0.f; S[1][j] = 0.f; }
    float lsum = 0.f;
    GlaRaw cur, nxt;
    gla_load_raw<false>(cur, LF, Q, V, b, h, dir, sc * 256 + 16 * qtr, ch);
#pragma unroll 1
    for (int c = 0; c < 4; ++c) {
        __syncthreads();
        lsum += gla_prep<false>(F, cur);
        if (c < 3) gla_load_raw<false>(nxt, LF, Q, V, b, h, dir, sc * 256 + (c + 1) * 64 + 16 * qtr, ch);
        __syncthreads();
        gla_state_update(F, S);
        cur = nxt;
    }
#pragma unroll
    for (int q = 0; q < 2; ++q)
#pragma unroll
        for (int g = 0; g < 4; ++g) *(f32x4*)(ST + (size_t)(32 * (ki0 + q) + r32) * 128 + 32 * vi + 8 * g + 4 * hh) = (f32x4){S[q][4 * g], S[q][4 * g + 1], S[q][4 * g + 2], S[q][4 * g + 3]};
    if (qtr == 0) DEC[ch] = fexp(lsum);
}
DI void gla_unit_out(Frame& F, int u) {
    const int sc = u & 31, dir = (u >> 5) & 1, h = (u >> 6) & 3, b = u >> 8;
    const bf16* Q = (const bf16*)(F.ws + WS_Q); const bf16* V = (const bf16*)(F.ws + WS_V); const _Float16* LF = (const _Float16*)(F.ws + (dir ? WS_LFB : WS_LFF));
    const float* ST = (const float*)(F.ws + WS_ST) + (size_t)u * 16384; float* OD = (float*)(F.ws + WS_ODIR) + (size_t)dir * MTOK * AW;
    const LAS unsigned char* L = F.lds;
    const int ch = F.tid & 127, qtr = F.tid >> 7, r32 = F.lane & 31, hh = F.lane >> 5, w = F.wave, vi = w & 3, ki0 = 2 * (w >> 2), ti = w >> 2;
    f32x16 S[2];
#pragma unroll
    for (int q = 0; q < 2; ++q)
#pragma unroll
        for (int g = 0; g < 4; ++g) { const f32x4 t = *(const f32x4*)(ST + (size_t)(32 * (ki0 + q) + r32) * 128 + 32 * vi + 8 * g + 4 * hh); S[q][4 * g] = t.x; S[q][4 * g + 1] = t.y; S[q][4 * g + 2] = t.z; S[q][4 * g + 3] = t.w; }
    GlaRaw cur, nxt;
    gla_load_raw<true>(cur, LF, Q, V, b, h, dir, sc * 256 + 16 * qtr, ch);
    __syncthreads();
    gla_state_to_lds(F, S);
#pragma unroll 1
    for (int c = 0; c < 4; ++c) {
        (void)gla_prep<true>(F, cur);
        if (c < 3) gla_load_raw<true>(nxt, LF, Q, V, b, h, dir, sc * 256 + (c + 1) * 64 + 16 * qtr, ch);
        __syncthreads();
        f32x16 o;
#pragma unroll
        for (int j = 0; j < 16; ++j) o[j] = 0.f;
#pragma unroll
        for (int s = 0; s < 8; ++s) o = MFMA32(gfrag(L + GL_QB, 32 * ti + r32, 272, 16 * s + 8 * hh), gfrag(L + GL_ST, 32 * vi + r32, 272, 16 * s + 8 * hh), o);
        if (w < 3) {
            const int tp = (w + 1) >> 1, sp = (w == 2) ? 1 : 0;
            f32x16 p;
#pragma unroll
            for (int j = 0; j < 16; ++j) p[j] = 0.f;
#pragma unroll
            for (int s = 0; s < 8; ++s) p = MFMA32(gfrag(L + GL_QT, 32 * tp + r32, 272, 16 * s + 8 * hh), gfrag(L + GL_KT, 32 * sp + r32, 272, 16 * s + 8 * hh), p);
#pragma unroll
            for (int j = 0; j < 16; ++j) { const int t = 32 * tp + crow32(j, hh), s = 32 * sp + r32;
                *(LAS unsigned short*)(F.lds + GL_P + t * 144 + 2 * s) = (s <= t) ? (unsigned short)f2bf(p[j]) : (unsigned short)0; }
        }
        __syncthreads();
        { const int ns = ti ? 4 : 2;
#pragma unroll
          for (int s = 0; s < 4; ++s) if (s < ns) o = MFMA32(gfrag(L + GL_P, 32 * ti + r32, 144, 16 * s + 8 * hh), gfrag(L + GL_VT, 32 * vi + r32, 144, 16 * s + 8 * hh), o); }
#pragma unroll
        for (int j = 0; j < 16; ++j) { const int ii = sc * 256 + c * 64 + 32 * ti + crow32(j, hh); const int tok = dir ? (SEQ - 1 - ii) : ii;
            OD[(size_t)(b * SEQ + tok) * AW + h * 128 + 32 * vi + r32] = o[j]; }
        if (c < 3) { gla_state_update(F, S); gla_state_to_lds(F, S); }
        cur = nxt;
        __syncthreads();
    }
}

__global__ void __launch_bounds__(NTHR, 2) fwd_kernel(Args args) {
    extern __shared__ __attribute__((aligned(16))) unsigned char lds[];
    Frame F;
    F.lds = (LAS unsigned char*)lds;
    F.MISC = (volatile LAS unsigned*)(F.lds + MISC_OFF);
    F.tid = threadIdx.x; F.lane = F.tid & 63; F.wave = __builtin_amdgcn_readfirstlane(F.tid >> 6);
    F.G = gridDim.x; F.bid = blockIdx.x; F.gw = F.bid * NWAVES + F.wave; F.NGW = F.G * NWAVES;
    F.ws = args.ws;
    unsigned* ctl = (unsigned*)(args.ws + WS_CTL);
    for (int u = F.tid; u < (LDS_BYTES - LDSCTL_OFF) / 4; u += NTHR) ((LAS unsigned*)(F.lds + LDSCTL_OFF))[u] = 0u;
    __syncthreads();
    const int lo = args.ph_lo, hi = args.ph_hi;
    XcdBarrier bar; bar.bar = ctl + CW_BAR + args.li * XCD_BAR_WORDS; bar.x = 0; bar.st = nullptr;
    if (hi - lo > 1) bar = xcd_barrier_post(ctl + CW_BAR + args.li * XCD_BAR_WORDS, F.MISC + 8);
#define IN(k) (lo <= (k) && (k) < hi)
#ifndef PROBE_DUP
#define PROBE_DUP (-1)
#endif
#define REP(k) for (int rep_ = 0; rep_ < (((PROBE_DUP) == (k)) ? 2 : 1); ++rep_)
#define SEAM(k) do { if (IN(k) && IN((k) + 1)) { xcd_barrier(bar); if (PROBE_DUP == 99) xcd_barrier(bar); } } while (0)
    unsigned char* ws = args.ws;
    float* XR = args.out;

    if (IN(0)) REP(0) { phase_prologue(F, args); } SEAM(0);
    if (IN(1)) {
        pg8::Gemm g{(const bf16*)(ws + WS_H), (const bf16*)(ws + WS_WIN), MTOK, NIN, DM}; pg8::StaticOrder S; S.init(MTOK, NIN, F.G, F.bid);
        EpiInProj E{(bf16*)(ws + WS_U), (bf16*)(ws + WS_GV), (bf16*)(ws + WS_Q), (bf16*)(ws + WS_V), (bf16*)(ws + WS_G), (_Float16*)(ws + WS_LFF), (_Float16*)(ws + WS_LFB), (const float*)(ws + WS_LB)};
        pg8::gemm_phase<EpiInProj, pg8::StaticOrder, true, true>(F.lds, g, S, E);
        if (PROBE_DUP == 1) pg8::gemm_phase<EpiInProj, pg8::StaticOrder, true, true>(F.lds, g, S, E);
    } SEAM(1);
    if (IN(2)) { if (PROBE_DUP == 30) phase_a_ln(F, args, true); phase_a_ln(F, args); REP(2) for (int u = F.bid; u < 512; u += F.G) gla_unit_state(F, u); } SEAM(2);
    if (IN(3)) { if (PROBE_DUP == 31) phase_gla_scan(F, true); phase_gla_scan(F); REP(3) phase_a_mix(F, args); } SEAM(3);
    if (IN(4)) REP(4) { for (int u = F.bid; u < 512; u += F.G) gla_unit_out(F, u); } SEAM(4);
    if (IN(5)) REP(5) { phase_b_combine(F, args); } SEAM(5);
    if (IN(6)) REP(6) {
        pg8::Gemm g{(const bf16*)(ws + WS_CAT), (const bf16*)(ws + WS_WOUT), MTOK, DM, DM}; pg8::StaticOrder S; S.init(MTOK, DM, F.G, F.bid);
        EpiResid E{args.in[0], XR};
        pg8::gemm_phase<EpiResid, pg8::StaticOrder, false, true>(F.lds, g, S, E);
    } SEAM(6);
#define MOE_BLOCK(L, pb) do { \
        if (IN(pb)) REP(pb) { phase_router(F, XR, args.in[2] + (L) * DM, args.in[15] + (L) * DM * NEXP); } SEAM(pb); \
        if (IN((pb) + 1)) { REP((pb) + 1) phase_topk(F); convert_moe_weights(F, args.in[16], args.in[17], args.in[18], (L), (F.G > 64) ? 32 : 0); } SEAM((pb) + 1);     \
        if (IN((pb) + 2)) {     \
            pg8::Gemm g{(const bf16*)(ws + WS_H), (const bf16*)(ws + WS_WGU), NROWS, 16 * 2048, DM}; GroupedOrder<8> S{F.G, F.bid}; \
            EpiGateUp E{(bf16*)(ws + WS_HMID)}; \
            LAS int* rowtab = (LAS int*)(F.lds + RING_BYTES); const int* IDX = (const int*)(ws + WS_IDX); \
            for (int i = 0; i < 4; ++i) { pg8::Unit uu; if (!S.next(i, uu)) break; if (F.tid < 256) rowtab[i * 256 + F.tid] = IDX[uu.pm * 256 + F.tid]; } \
            __syncthreads(); \
            pg8::gemm_phase<EpiGateUp, GroupedOrder<8>, true, true, true>(F.lds, g, S, E, rowtab); \
            if (PROBE_DUP == (pb) + 2) pg8::gemm_phase<EpiGateUp, GroupedOrder<8>, true, true, true>(F.lds, g, S, E, rowtab); \
        } SEAM((pb) + 2); \
        if (IN((pb) + 3)) { \
            pg8::Gemm g{(const bf16*)(ws + WS_HMID), (const bf16*)(ws + WS_WDN), NROWS, 16 * 1024, DFF}; GroupedOrder<4> S{F.G, F.bid}; \
            EpiDown E{(bf16*)(ws + WS_Y), (const float*)(ws + WS_GATE)}; \
            pg8::gemm_phase<EpiDown, GroupedOrder<4>, true, true>(F.lds, g, S, E); \
            if (PROBE_DUP == (pb) + 3) pg8::gemm_phase<EpiDown, GroupedOrder<4>, true, true>(F.lds, g, S, E); \
        } SEAM((pb) + 3); \
    } while (0)

    MOE_BLOCK(0, 7);
    if (IN(11)) { if (PROBE_DUP == 32) phase_moe_combine(F, XR, args.in[1] + DM, false, true); phase_moe_combine(F, XR, args.in[1] + DM, false); } SEAM(11);
    if (IN(12)) REP(12) {
        pg8::Gemm g{(const bf16*)(ws + WS_H), (const bf16*)(ws + WS_WQKV), MTOK, NQKV, DM}; pg8::StaticOrder S; S.init(MTOK, NQKV, F.G, F.bid);
        EpiQKV E{(bf16*)(ws + WS_QKV)};
        pg8::gemm_phase<EpiQKV, pg8::StaticOrder, true, true>(F.lds, g, S, E);
    } SEAM(12);
    if (IN(13)) REP(13) { phase_kvf(F); } SEAM(13);
    if (IN(14)) REP(14) { phase_attn(F); } SEAM(14);
    if (IN(15)) {
        pg8::Gemm g{(const bf16*)(ws + WS_ATT), (const bf16*)(ws + WS_WO), MTOK, DM, DM}; pg8::StaticOrder S; S.init(MTOK, DM, F.G, F.bid);
        EpiResid E{XR, XR};
        pg8::gemm_phase<EpiResid, pg8::StaticOrder, false, true>(F.lds, g, S, E);
    } SEAM(15);
    MOE_BLOCK(1, 16);
    if (IN(20)) { if (PROBE_DUP == 33) phase_moe_combine(F, XR, args.in[3], true, true); phase_moe_combine(F, XR, args.in[3], true); }
#undef MOE_BLOCK
#undef IN
#undef SEAM
}

#ifndef MK_N_LAUNCHES
#define MK_N_LAUNCHES 1
#endif
extern "C" void kernel_launch(void* const* d_in, const int* in_sizes, int n_in, void* d_out, int out_size, void* d_ws, size_t ws_size, hipStream_t stream) {
    static int grid = 0;
    if (grid == 0) {
        if (n_in != 19 || in_sizes[0] != MTOK * DM || out_size != MTOK * DM || ws_size < WS_END) { fprintf(stderr, "kernel_launch: unexpected shapes (n_in %d, in0 %d, out %d, ws %zu < %zu); nothing launched\n", n_in, n_in > 0 ? in_sizes[0] : -1, out_size, ws_size, (size_t)WS_END); grid = -1; return; }
        int dev = 0, cus = 0, per_cu = 0;
        if (hipGetDevice(&dev) != hipSuccess || hipDeviceGetAttribute(&cus, hipDeviceAttributeMultiprocessorCount, dev) != hipSuccess) { grid = -1; return; }
        if (hipFuncSetAttribute((const void*)fwd_kernel, hipFuncAttributeMaxDynamicSharedMemorySize, LDS_BYTES) != hipSuccess) { fprintf(stderr, "kernel_launch: hipFuncSetAttribute failed\n"); grid = -1; return; }
        if (hipOccupancyMaxActiveBlocksPerMultiprocessor(&per_cu, (const void*)fwd_kernel, NTHR, LDS_BYTES) != hipSuccess || per_cu < 1) { fprintf(stderr, "kernel_launch: occupancy query reports %d workgroups per CU\n", per_cu); }
        (void)hipGetLastError();
        grid = cus;
    }
    if (grid < 0) return;
    if (hipMemsetAsync((char*)d_ws + WS_CTL, 0, CTL_ZERO_BYTES, stream) != hipSuccess) return;
    Args a{};
    for (int i = 0; i < 19; ++i) a.in[i] = (const float*)d_in[i];
    a.out = (float*)d_out; a.ws = (unsigned char*)d_ws; a.pad = 0;
    static_assert(CW_BAR + MAX_BAR_REGIONS * XCD_BAR_WORDS <= (int)(CTL_ZERO_BYTES / 4), "barrier regions inside the memset region");
#ifdef PROBE_PREFIX
    const int nl = 2;
    for (int li = 0; li < nl; ++li) {
        a.ph_lo = 0; a.ph_hi = (li == 0) ? PROBE_PREFIX : NPHASE; a.li = li;
#else
    const int nl = MK_N_LAUNCHES;
    for (int li = 0; li < nl; ++li) {
        a.ph_lo = (int)((long)NPHASE * li / nl); a.ph_hi = (int)((long)NPHASE * (li + 1) / nl); a.li = li;
#endif
        hipLaunchKernelGGL(fwd_kernel, dim3(grid), dim3(NTHR), LDS_BYTES, stream, a);
        const hipError_t le = hipPeekAtLastError();
        if (le != hipSuccess) { fprintf(stderr, "kernel_launch: launch %d failed: %s\n", li, hipGetErrorName(le)); break; }
    }
}
```

```cpp
#include <hip/hip_runtime.h>
#include <cstdio>
#include <cstdint>
namespace pg8 {
#define PG8_LAS __attribute__((address_space(3)))
typedef unsigned short bf16_t;
typedef short bf16x8 __attribute__((ext_vector_type(8)));
typedef float f32x4 __attribute__((ext_vector_type(4)));
typedef unsigned u32x4 __attribute__((ext_vector_type(4)));
constexpr int BM = 256, BK = 64, HALF = 128, HTB = HALF * BK * 2  , STAGE_BYTES = 8 * HTB, NXCD = 8, WGM = 8;

__host__ __device__ __forceinline__ int lds_byte(int r, int c) { const int st = (r >> 4) * 2 + (c >> 5), rr = r & 15, cc = c & 31, ob = rr * 64 + cc * 2; return st * 1024 + (ob ^ (((ob >> 9) & 1) << 5)); }
__host__ __device__ __forceinline__ void stage_rc(int b, int& R, int& C) { const int st = b / 1024, sb = b % 1024, swz = sb ^ (((sb >> 9) & 1) << 5); R = (st >> 1) * 16 + swz / 64; C = (st & 1) * 32 + (swz % 64) / 2; }
__host__ __device__ __forceinline__ int perm32(int rho) { const int n = rho >> 4, i = rho & 15; return 8 * (i >> 2) + 4 * n + (i & 3); }

struct Unit { int pm, pn; };
struct Gemm { const bf16_t* A; const bf16_t* Bt; int M, N, K; };

struct StaticOrder {
    int nM, nN, nwg, G, c;
    __host__ __device__ void init(int M, int N, int G_, int c_) { nM = M / BM; nN = N / BM; nwg = nM * nN; G = G_; c = c_; }
    __host__ __device__ bool next(int i, Unit& u) const {
        const long L = (long)i * G + c; if (L >= nwg) return false;
        int wgid = (int)L; { const int q = nwg / NXCD, r = nwg % NXCD, xcd = wgid % NXCD, off = wgid / NXCD; wgid = (xcd < r ? xcd * (q + 1) : r * (q + 1) + (xcd - r) * q) + off; }
        const int nig = WGM * nN, gid = wgid / nig, fm = gid * WGM, gsz = (nM - fm) < WGM ? (nM - fm) : WGM;
        u.pm = fm + ((wgid % nig) % gsz); u.pn = (wgid % nig) / gsz; return true;
    }
    __device__ __forceinline__ void a_ready(const Unit&) const {}
    __device__ __forceinline__ void done(const Unit&) const {}
};

__device__ __forceinline__ unsigned cvt_pk_bf16(float lo, float hi) { unsigned r; asm volatile("v_cvt_pk_bf16_f32 %0, %1, %2" : "=v"(r) : "v"(lo), "v"(hi)); return r; }
typedef float f32x2 __attribute__((ext_vector_type(2)));
__device__ __forceinline__ f32x2 gelu_pk(f32x2 v) {
    const f32x2 av = __builtin_elementwise_abs(v), d = av * 0.2316418882f + 1.0f;
    f32x2 t; t.x = __builtin_amdgcn_rcpf(d.x); t.y = __builtin_amdgcn_rcpf(d.y);
    f32x2 q = t * 0.5307027145f + (-0.7265760135f); q = q * t + 0.7107068705f; q = q * t + (-0.142248368f); q = q * t + 0.127414796f; q = q * t;
    const f32x2 s = (v * v) * (-0.72134752044f);
    f32x2 e; e.x = __builtin_amdgcn_exp2f(s.x); e.y = __builtin_amdgcn_exp2f(s.y);
    const f32x2 m = v * (q * e), r = v - m;
    f32x2 o; o.x = v.x < 0.f ? m.x : r.x; o.y = v.y < 0.f ? m.y : r.y; return o;
}

template <int ACT  > struct EpiBf16 {
    static constexpr bool PERM = true, AFTER_DRAIN = false; static_assert(ACT == 0 || ACT == 1, "EpiBf16: ACT is 0 (none) or 1 (gelu_pk)");
    bf16_t* O; int ldc; const float* bias; int split_cols; size_t split_stride; float scale0;
    __device__ __forceinline__ void operator()(const f32x4 (&acc)[2][2][4][2], const Unit& u, int wr, int wc, int fr, int fq) const {
        const int row0 = u.pm * BM + wr * 64 + fr; int colt = u.pn * BM; bf16_t* base = O;
        float sc = 1.f; if (split_cols) { const int t = colt / split_cols; base += (size_t)t * split_stride; colt -= t * split_cols; if (t == 0) sc = scale0; }
        const int col0 = colt + wc * 32 + 8 * fq, bcol0 = u.pn * BM + wc * 32 + 8 * fq;
        f32x4 bv[2][2];
#pragma unroll
        for (int bj = 0; bj < 2; ++bj)
#pragma unroll
            for (int n = 0; n < 2; ++n) bv[bj][n] = bias ? *(const f32x4*)(bias + bcol0 + bj * HALF + 4 * n) : (f32x4){0.f, 0.f, 0.f, 0.f};
#pragma unroll
        for (int ai = 0; ai < 2; ++ai)
#pragma unroll
            for (int m = 0; m < 4; ++m) { bf16_t* rowp = base + (size_t)(row0 + ai * HALF + m * 16) * ldc + col0;
#pragma unroll
                for (int bj = 0; bj < 2; ++bj) { f32x4 v0 = acc[ai][bj][m][0] + bv[bj][0], v1 = acc[ai][bj][m][1] + bv[bj][1];
                    if (ACT == 1) { f32x2 a = gelu_pk((f32x2){v0[0], v0[1]}), b = gelu_pk((f32x2){v0[2], v0[3]}), c = gelu_pk((f32x2){v1[0], v1[1]}), d = gelu_pk((f32x2){v1[2], v1[3]});
                        v0 = (f32x4){a.x, a.y, b.x, b.y}; v1 = (f32x4){c.x, c.y, d.x, d.y}; }
                    v0 = v0 * sc; v1 = v1 * sc; u32x4 w; w.x = cvt_pk_bf16(v0[0], v0[1]); w.y = cvt_pk_bf16(v0[2], v0[3]); w.z = cvt_pk_bf16(v1[0], v1[1]); w.w = cvt_pk_bf16(v1[2], v1[3]);
                    *(u32x4*)(rowp + bj * HALF) = w; } }
    }
};
template <class Epi, class Sched, bool ALIGN_EPI = false, bool SP2 = false, bool GATHER = false>
__device__ __forceinline__ void gemm_phase(PG8_LAS unsigned char* lds, const Gemm g, const Sched& S, const Epi& E, const PG8_LAS int* rowtab = nullptr) {
    const int tid = threadIdx.x, wid = __builtin_amdgcn_readfirstlane(tid >> 6), lane = tid & 63, wr = wid >> 2, wc = wid & 3, fr = lane & 15, fq = lane >> 4;
    const int K = g.K, nt = K / BK;
    unsigned voffA[2], voffB[2]; int gR[2], gC[2];
#pragma unroll
    for (int i = 0; i < 2; ++i) { int R, C; stage_rc(tid * 16 + i * 8192, R, C); const int Rb = Epi::PERM ? ((R & ~31) + perm32(R & 31)) : R;
        voffA[i] = (unsigned)(R * K + C) * 2u; voffB[i] = (unsigned)(Rb * K + C) * 2u; gR[i] = R; gC[i] = C; }
    unsigned vC[2][2] = {{0u, 0u}, {0u, 0u}}, vN[2][2] = {{0u, 0u}, {0u, 0u}};
#define PG8_ROWS(dst, ui_) do { _Pragma("unroll") for (int _h = 0; _h < 2; ++_h) _Pragma("unroll") for (int _i = 0; _i < 2; ++_i) \
        dst[_h][_i] = (unsigned)(rowtab[(ui_) * 256 + _h * 128 + gR[_i]] * K + gC[_i]) * 2u; } while (0)
    const size_t kstep = (size_t)(BK * 2);
    const size_t hstep = (size_t)HALF * K * 2;
    const size_t tstep = 2 * hstep;
    const unsigned ldsw = (unsigned)wid * 1024u;
    const int aoff = lds_byte(wr * 64 + fr, fq * 8), boff = lds_byte(wc * 32 + fr, fq * 8);
#define PG8_SA(b, h) (((b) * 2 + (h)) * HTB)
#define PG8_SB(b, h) ((4 + (b) * 2 + (h)) * HTB)
#define PG8_STAGE(bufoff, gbase, voff) do { _Pragma("unroll") for (int _i = 0; _i < 2; ++_i) \
        __builtin_amdgcn_global_load_lds((const unsigned*)((const char*)(gbase) + (voff)[_i]), (PG8_LAS unsigned*)(lds + (bufoff) + ldsw + _i * 8192), 16, 0, 0); } while (0)
#define PG8_STGA(bufoff, abase, half, V) do { _Pragma("unroll") for (int _i = 0; _i < 2; ++_i) \
        __builtin_amdgcn_global_load_lds((const unsigned*)((const char*)(abase) + (GATHER ? (size_t)V[half][_i] : (size_t)((half) ? hstep : 0) + voffA[_i])), (PG8_LAS unsigned*)(lds + (bufoff) + ldsw + _i * 8192), 16, 0, 0); } while (0)
#define PG8_LDA(dst, b, h) do { _Pragma("unroll") for (int m = 0; m < 4; ++m) _Pragma("unroll") for (int k = 0; k < 2; ++k) dst[m][k] = *(const PG8_LAS bf16x8*)(lds + PG8_SA(b, h) + aoff + m * 2048 + k * 1024); } while (0)
#define PG8_LDB(dst, b, h) do { _Pragma("unroll") for (int n = 0; n < 2; ++n) _Pragma("unroll") for (int k = 0; k < 2; ++k) dst[n][k] = *(const PG8_LAS bf16x8*)(lds + PG8_SB(b, h) + boff + n * 2048 + k * 1024); } while (0)
#define PG8_MMA(ai, bj, At, Bt) do { __builtin_amdgcn_s_setprio(1); _Pragma("unroll") for (int m = 0; m < 4; ++m) _Pragma("unroll") for (int n = 0; n < 2; ++n) _Pragma("unroll") for (int k = 0; k < 2; ++k) \
        acc[ai][bj][m][n] = __builtin_amdgcn_mfma_f32_16x16x32_bf16(Bt[n][k], At[m][k], acc[ai][bj][m][n], 0, 0, 0); __builtin_amdgcn_s_setprio(0); } while (0)
#define PG8_WAIT_V(n) asm volatile("s_waitcnt vmcnt(" #n ")" ::: "memory")
#define PG8_WAIT_L(n) asm volatile("s_waitcnt lgkmcnt(" #n ")" ::: "memory")
#define PG8_BAR __builtin_amdgcn_s_barrier()
#define PG8_SCHED __builtin_amdgcn_sched_barrier(0)
    Unit cur, nxt; int ui = 0;
    if (!S.next(0, cur)) return;
    f32x4 acc[2][2][4][2];
#pragma unroll
    for (int a = 0; a < 2; ++a)
#pragma unroll
        for (int b = 0; b < 2; ++b)
#pragma unroll
            for (int m = 0; m < 4; ++m)
#pragma unroll
                for (int n = 0; n < 2; ++n) acc[a][b][m][n] = (f32x4){0.f, 0.f, 0.f, 0.f};
    bf16x8 At[4][2], B0[2][2], B1[2][2];
    const char* cA = (const char*)g.A + (GATHER ? (size_t)0 : (size_t)cur.pm * tstep); if constexpr (GATHER) PG8_ROWS(vC, 0);
    const char* cB = (const char*)g.Bt + (size_t)cur.pn * tstep;
    S.a_ready(cur);
    if constexpr (SP2) {
        PG8_STAGE(PG8_SB(0, 0), cB, voffB); PG8_STAGE(PG8_SB(0, 1), cB + hstep, voffB); PG8_STGA(PG8_SA(0, 0), cA, 0, vC); PG8_STGA(PG8_SA(0, 1), cA, 1, vC);
        if (wr == 1) PG8_BAR;
        PG8_WAIT_V(2); PG8_BAR;
        PG8_STAGE(PG8_SB(1, 0), cB + kstep, voffB); PG8_STGA(PG8_SA(1, 0), cA + kstep, 0, vC); PG8_STAGE(PG8_SB(1, 1), cB + hstep + kstep, voffB);
        PG8_WAIT_V(6); PG8_BAR;
    } else {
        PG8_STAGE(PG8_SB(0, 0), cB, voffB); PG8_STGA(PG8_SA(0, 0), cA, 0, vC); PG8_STAGE(PG8_SB(0, 1), cB + hstep, voffB); PG8_STGA(PG8_SA(0, 1), cA, 1, vC);
        if (wr == 1) PG8_BAR;
        PG8_WAIT_V(4); PG8_BAR;
        PG8_STAGE(PG8_SB(1, 0), cB + kstep, voffB); PG8_STGA(PG8_SA(1, 0), cA + kstep, 0, vC); PG8_STAGE(PG8_SB(1, 1), cB + hstep + kstep, voffB);
        PG8_WAIT_V(6); PG8_BAR;
    }
    for (;;) {
        const bool has_next = S.next(ui + 1, nxt);
        const char* nA = (has_next && !GATHER) ? (const char*)g.A + (size_t)nxt.pm * tstep : cA;
        if constexpr (GATHER) { if (has_next) PG8_ROWS(vN, ui + 1); else { _Pragma("unroll") for (int _h = 0; _h < 2; ++_h) _Pragma("unroll") for (int _i = 0; _i < 2; ++_i) vN[_h][_i] = vC[_h][_i]; } }
        const char* nB = has_next ? (const char*)g.Bt + (size_t)nxt.pn * tstep : cB;
        for (int t = 0; t < nt; t += 2) {
            const bool last = (t == nt - 2);
            unsigned vX[2][2];
            _Pragma("unroll") for (int _h = 0; _h < 2; ++_h) _Pragma("unroll") for (int _i = 0; _i < 2; ++_i) vX[_h][_i] = last ? vN[_h][_i] : vC[_h][_i];
            const char* a1 = cA + (size_t)(t + 1) * kstep;
            const char* a2 = last ? nA : cA + (size_t)(t + 2) * kstep; const char* b2 = last ? nB : cB + (size_t)(t + 2) * kstep;
            const char* a3 = a2 + kstep; const char* b3 = b2 + kstep;
            if (last && has_next) S.a_ready(nxt);
            if constexpr (SP2) {
            PG8_LDB(B0, 0, 0); PG8_LDB(B1, 0, 1); PG8_SCHED; PG8_LDA(At, 0, 0); PG8_STGA(PG8_SA(1, 1), a1, 1, vC);
            PG8_WAIT_V(8); PG8_WAIT_L(0); PG8_BAR; PG8_MMA(0, 0, At, B0); PG8_MMA(0, 1, At, B1); PG8_BAR; PG8_SCHED;
            PG8_LDA(At, 0, 1); PG8_STAGE(PG8_SB(0, 0), b2, voffB); PG8_STAGE(PG8_SB(0, 1), b2 + hstep, voffB); PG8_STGA(PG8_SA(0, 0), a2, 0, vX);
            PG8_WAIT_V(8); PG8_WAIT_L(0); PG8_BAR; PG8_MMA(1, 0, At, B0); PG8_MMA(1, 1, At, B1); PG8_BAR; PG8_SCHED;
            PG8_LDB(B0, 1, 0); PG8_LDB(B1, 1, 1); PG8_SCHED; PG8_LDA(At, 1, 0); PG8_STGA(PG8_SA(0, 1), a2, 1, vX);
            PG8_WAIT_V(8); PG8_WAIT_L(0); PG8_BAR; PG8_MMA(0, 0, At, B0); PG8_MMA(0, 1, At, B1); PG8_BAR; PG8_SCHED;
            PG8_LDA(At, 1, 1); PG8_STAGE(PG8_SB(1, 0), b3, voffB); PG8_STAGE(PG8_SB(1, 1), b3 + hstep, voffB); PG8_STGA(PG8_SA(1, 0), a3, 0, vX);
            PG8_WAIT_V(8); PG8_WAIT_L(0); PG8_BAR; PG8_MMA(1, 0, At, B0); PG8_MMA(1, 1, At, B1); PG8_BAR; PG8_SCHED;
            } else {
            PG8_LDB(B0, 0, 0); PG8_SCHED; PG8_LDA(At, 0, 0); PG8_STGA(PG8_SA(1, 1), a1, 1, vC);
            PG8_WAIT_L(8); PG8_BAR; PG8_WAIT_L(0); PG8_MMA(0, 0, At, B0); PG8_BAR; PG8_SCHED;
            PG8_LDB(B1, 0, 1); PG8_STAGE(PG8_SB(0, 0), b2, voffB);
            PG8_BAR; PG8_WAIT_L(0); PG8_MMA(0, 1, At, B1); PG8_BAR;
            PG8_LDA(At, 0, 1); PG8_STGA(PG8_SA(0, 0), a2, 0, vX);
            PG8_BAR; PG8_WAIT_L(0); PG8_MMA(1, 0, At, B0); PG8_BAR; PG8_SCHED;
            PG8_STAGE(PG8_SB(0, 1), b2 + hstep, voffB);
            PG8_WAIT_V(6); PG8_BAR; PG8_MMA(1, 1, At, B1); PG8_BAR;
            PG8_LDB(B0, 1, 0); PG8_SCHED; PG8_LDA(At, 1, 0); PG8_STGA(PG8_SA(0, 1), a2, 1, vX);
            PG8_WAIT_L(8); PG8_BAR; PG8_WAIT_L(0); PG8_MMA(0, 0, At, B0); PG8_BAR; PG8_SCHED;
            PG8_LDB(B1, 1, 1); PG8_STAGE(PG8_SB(1, 0), b3, voffB);
            PG8_BAR; PG8_WAIT_L(0); PG8_MMA(0, 1, At, B1); PG8_BAR;
            PG8_LDA(At, 1, 1); PG8_STGA(PG8_SA(1, 0), a3, 0, vX);
            PG8_BAR; PG8_WAIT_L(0); PG8_MMA(1, 0, At, B0); PG8_BAR; PG8_SCHED;
            PG8_STAGE(PG8_SB(1, 1), b3 + hstep, voffB);
            PG8_WAIT_V(6); PG8_BAR; PG8_MMA(1, 1, At, B1); PG8_BAR;
            }
        }
        if constexpr (ALIGN_EPI) { if (wr == 0) PG8_BAR; }
        if constexpr (!Epi::AFTER_DRAIN) { E(acc, cur, wr, wc, fr, fq); S.done(cur); }
        if (!has_next) break;
#pragma unroll
        for (int a = 0; a < 2; ++a)
#pragma unroll
            for (int b = 0; b < 2; ++b)
#pragma unroll
                for (int m = 0; m < 4; ++m)
#pragma unroll
                    for (int n = 0; n < 2; ++n) acc[a][b][m][n] = (f32x4){0.f, 0.f, 0.f, 0.f};
        cur = nxt; cA = nA; cB = nB; ++ui;
        if constexpr (GATHER) { _Pragma("unroll") for (int _h = 0; _h < 2; ++_h) _Pragma("unroll") for (int _i = 0; _i < 2; ++_i) vC[_h][_i] = vN[_h][_i]; }
        if constexpr (ALIGN_EPI) { if (wr == 1) PG8_BAR; }
    }
    PG8_WAIT_V(0);
    if constexpr (!ALIGN_EPI) { if (wr == 0) PG8_BAR; }
    PG8_BAR;
    if constexpr (Epi::AFTER_DRAIN) { E.fused(acc, cur, wr, wc, fr, fq, lds, wid, lane); S.done(cur); }
#undef PG8_SA
#undef PG8_SB
#undef PG8_STAGE
#undef PG8_STGA
#undef PG8_ROWS
#undef PG8_LDA
#undef PG8_LDB
#undef PG8_MMA
#undef PG8_WAIT_V
#undef PG8_WAIT_L
#undef PG8_BAR
#undef PG8_SCHED
}
}
#define LAS __attribute__((address_space(3)))
#define DI __device__ __forceinline__
typedef unsigned short bf16;
typedef unsigned v4u __attribute__((ext_vector_type(4)));
typedef unsigned v2u __attribute__((ext_vector_type(2)));
typedef float f32x4 __attribute__((ext_vector_type(4)));
typedef short bf16x8 __attribute__((ext_vector_type(8)));
#define LDS_WAIT() asm volatile("s_waitcnt lgkmcnt(0)" ::: "memory")
#define VM_WAIT() asm volatile("s_waitcnt vmcnt(0)" ::: "memory")
DI unsigned f2bf(float f) { unsigned u = __builtin_bit_cast(unsigned, f); return (u + 0x7fffu + ((u >> 16) & 1u)) >> 16; }
typedef float f32x2_t __attribute__((ext_vector_type(2))); typedef __bf16 bf16x2_t __attribute__((ext_vector_type(2)));
DI unsigned pk2(float lo, float hi) { f32x2_t v = {lo, hi}; bf16x2_t b = __builtin_convertvector(v, bf16x2_t); return __builtin_bit_cast(unsigned, b); }
DI float bf2f(unsigned b) { return __builtin_bit_cast(float, b << 16); }
DI float bflo(unsigned w) { return __builtin_bit_cast(float, w << 16); }
DI float bfhi(unsigned w) { return __builtin_bit_cast(float, w & 0xffff0000u); }
DI float fexp(float x) { return __builtin_amdgcn_exp2f(x * 1.4426950408889634f); }
DI float flog(float x) { return __builtin_amdgcn_logf(x) * 0.6931471805599453f; }
DI float frcp(float x) { return __builtin_amdgcn_rcpf(x); }
DI float sigmoidf_(float x) { return frcp(1.f + fexp(-x)); }
DI float siluf_(float x) { return x * sigmoidf_(x); }
DI float gelu_tanh(float x) { const float u = 0.7978845608028654f * (x + 0.044715f * x * x * x); return x * sigmoidf_(2.f * u); }
DI float wave_sum(float v) {
#pragma unroll
    for (int o = 1; o < 64; o <<= 1) v += __shfl_xor(v, o);
    return v;
}
DI float wave_max(float v) {
#pragma unroll
    for (int o = 1; o < 64; o <<= 1) v = fmaxf(v, __shfl_xor(v, o));
    return v;
}
DI int red16_idx(int lane) { return 8 * ((lane >> 5) & 1) + 4 * ((lane >> 4) & 1) + 2 * ((lane >> 3) & 1) + ((lane >> 2) & 1); }
DI float red16(const float (&o)[16], int lane) {
    const bool b32 = lane & 32, b16 = lane & 16, b8 = lane & 8, b4 = lane & 4;
    float a8[8], a4[4], a2[2], a1;
#pragma unroll
    for (int j = 0; j < 8; ++j) { const float send = b32 ? o[j] : o[j + 8], keep = b32 ? o[j + 8] : o[j]; a8[j] = keep + __shfl_xor(send, 32); }
#pragma unroll
    for (int j = 0; j < 4; ++j) { const float send = b16 ? a8[j] : a8[j + 4], keep = b16 ? a8[j + 4] : a8[j]; a4[j] = keep + __shfl_xor(send, 16); }
#pragma unroll
    for (int j = 0; j < 2; ++j) { const float send = b8 ? a4[j] : a4[j + 2], keep = b8 ? a4[j + 2] : a4[j]; a2[j] = keep + __shfl_xor(send, 8); }
    { const float send = b4 ? a2[0] : a2[1], keep = b4 ? a2[1] : a2[0]; a1 = keep + __shfl_xor(send, 4); }
    a1 += __shfl_xor(a1, 2); a1 += __shfl_xor(a1, 1);
    return a1;
}
#define XB_TMO      128
#define XB_XCNT(j)  (256  + 64 * (j))
#define XB_XSUB(j)  (1280 + 64 * (j))
#define XB_XGEN(j)  (2304 + 64 * (j))
#define XB_TOP      3328
#define XB_TOPGEN   3392
#define XCD_BAR_WORDS 3456
#define XB_SPIN_CAP (1u << 18)

__device__ __forceinline__ unsigned xb_ld(unsigned* p)              { return __hip_atomic_load(p, __ATOMIC_RELAXED, __HIP_MEMORY_SCOPE_AGENT); }
__device__ __forceinline__ unsigned xb_add(unsigned* p, unsigned v) { return __hip_atomic_fetch_add(p, v, __ATOMIC_RELAXED, __HIP_MEMORY_SCOPE_AGENT); }
__device__ __forceinline__ unsigned xb_xcc_id() { return (unsigned)__builtin_amdgcn_s_getreg((3 << 11) | 20) & 0xFu; }
#define XB_SPIN(cond, bar) do { unsigned _sp = 0; while (cond) { __builtin_amdgcn_s_sleep(1); \
    if ((++_sp & 255u) == 0u) { if (xb_ld(&(bar)[XB_TMO])) break; if (_sp > XB_SPIN_CAP) { atomicAdd(&(bar)[XB_TMO], 1u); break; } } } } while (0)

struct XcdBarrier {
    unsigned* bar; unsigned x;
    volatile LAS unsigned* st;
};

__device__ __forceinline__ XcdBarrier xcd_barrier_post(unsigned* bar, volatile LAS unsigned* st) {
    XcdBarrier b; b.bar = bar; b.x = xb_xcc_id(); b.st = st;
    if (threadIdx.x == 0) (void)xb_add(&bar[XB_XCNT(b.x)], 1u);
    return b;
}
__device__ __forceinline__ void xcd_barrier_complete(unsigned* bar, unsigned x, unsigned& nloc, unsigned& nx) {
    const unsigned G = gridDim.x * gridDim.y * gridDim.z;
    unsigned sum, cnt, mine, sp = 0u;
    for (;;) {
        sum = 0u; cnt = 0u; mine = 0u;
#pragma unroll
        for (unsigned j = 0; j < 16; ++j) { const unsigned c = xb_ld(&bar[XB_XCNT(j)]); sum += c; cnt += (c > 0u) ? 1u : 0u; mine = (j == x) ? c : mine; }
        if (sum == G) break;
        __builtin_amdgcn_s_sleep(1);
        if ((++sp & 255u) == 0u) { if (xb_ld(&bar[XB_TMO])) break; if (sp > XB_SPIN_CAP) { atomicAdd(&bar[XB_TMO], 1u); break; } }
    }
    nloc = mine > 0u ? mine : 1u; nx = cnt > 0u ? cnt : 1u;
}

__device__ __forceinline__ void xcd_barrier(const XcdBarrier& b) {
    asm volatile("s_waitcnt vmcnt(0)" ::: "memory");
    __syncthreads();
    if (threadIdx.x == 0) {
        unsigned* bar = b.bar;
        __builtin_amdgcn_s_waitcnt(0);
        unsigned nloc = b.st[0], nx = b.st[1];
        if (nloc == 0u) { xcd_barrier_complete(bar, b.x, nloc, nx); b.st[0] = nloc; b.st[1] = nx; }
        const unsigned old = xb_add(&bar[XB_XSUB(b.x)], 1u);
        const unsigned gen = old / nloc;
        if (old + 1u == (gen + 1u) * nloc) {
            __builtin_amdgcn_fence(__ATOMIC_RELEASE, "agent");
            asm volatile("s_waitcnt vmcnt(0)" ::: "memory");
            const unsigned og = xb_add(&bar[XB_TOP], 1u);
            const unsigned tg = og / nx;
            if (og + 1u == (tg + 1u) * nx) xb_add(&bar[XB_TOPGEN], 1u);
            else XB_SPIN(xb_ld(&bar[XB_TOPGEN]) == tg, bar);
            __builtin_amdgcn_fence(__ATOMIC_ACQUIRE, "agent");
            xb_add(&bar[XB_XGEN(b.x)], 1u);
            asm volatile("s_waitcnt vmcnt(0)" ::: "memory");
        } else {
            XB_SPIN(xb_ld(&bar[XB_XGEN(b.x)]) == gen, bar);
            __builtin_amdgcn_fence(__ATOMIC_ACQUIRE, "agent");
            asm volatile("s_waitcnt vmcnt(0)" ::: "memory");
        }
    }
    __syncthreads();
}
constexpr int NWAVES = 8, NTHR = 512;
constexpr int BATCH = 2, SEQ = 8192, DM = 1024, MTOK = BATCH * SEQ;
constexpr int NIN = 3584;
constexpr int AW = 512;
constexpr int NEXP = 16, DFF = 1024, CAP = 1024, NROWS = BATCH * NEXP * CAP;
constexpr int NSC = 32, SCLEN = 256;
constexpr int NHEAD = 16, HD = 64, NQKV = 3072;
constexpr float EPS = 1e-6f;
constexpr int NPHASE = 21;

constexpr size_t MiB = 1u << 20;
constexpr size_t WS_CTL = 0, CTL_ZERO_BYTES = 1 * MiB;
constexpr size_t WS_AFF = 1 * MiB;
constexpr size_t WS_POS = 2 * MiB;
constexpr size_t WS_IDX = 3 * MiB;
constexpr size_t WS_GATE = 3 * MiB + 256 * 1024;
constexpr size_t WS_DEC = 3 * MiB + 512 * 1024;
constexpr size_t WS_LB = 4 * MiB;
constexpr size_t WS_BT = 4 * MiB + 64 * 1024;
constexpr size_t WS_WIN = 8 * MiB;
constexpr size_t WS_WOUT = 15 * MiB;
constexpr size_t WS_WQKV = 17 * MiB;
constexpr size_t WS_WO = 23 * MiB;
constexpr size_t WS_WSB = 25 * MiB;
constexpr size_t WS_WGU = 32 * MiB;
constexpr size_t WS_WDN = 96 * MiB;
constexpr size_t WS_H = 128 * MiB;
constexpr size_t WS_R1 = 160 * MiB;
constexpr size_t WS_U = WS_R1, WS_GV = WS_R1 + 16 * MiB, WS_Q = WS_R1 + 32 * MiB, WS_V = WS_R1 + 48 * MiB, WS_G = WS_R1 + 64 * MiB;
constexpr size_t WS_LFF = WS_R1 + 80 * MiB, WS_LFB = WS_R1 + 112 * MiB;
constexpr size_t WS_CAT = WS_R1 + 144 * MiB;
constexpr size_t WS_ST = WS_R1 + 176 * MiB;
constexpr size_t WS_ODIR = WS_R1 + 208 * MiB;
constexpr size_t WS_XE = WS_R1, WS_Y = WS_R1;
constexpr size_t WS_HMID = WS_R1 + 64 * MiB;
constexpr size_t WS_QKV = WS_R1;
constexpr size_t WS_ATT = WS_R1 + 96 * MiB;
constexpr size_t WS_KF = WS_R1 + 128 * MiB;
constexpr size_t WS_VF = WS_R1 + 224 * MiB;
constexpr size_t WS_END = WS_R1 + 320 * MiB;
constexpr int CW_BAR = 4096;
constexpr int MAX_BAR_REGIONS = 24;

constexpr int RING_BYTES = 131072;
constexpr int LDS_BYTES = 147456;
constexpr int LDSCTL_OFF = LDS_BYTES - 512, MISC_OFF = LDSCTL_OFF + 320;

struct Args { const float* in[19]; float* out; unsigned char* ws; int ph_lo, ph_hi, li, pad; };

struct Frame {
    LAS unsigned char* lds;
    volatile LAS unsigned* MISC;
    int tid, lane, wave, G, bid, gw, NGW;
    unsigned char* ws;
};

template <int NPN_> struct GroupedOrder {
    int G, c;
    DI bool next(int i, pg8::Unit& u) const {
        const int L = i * G + c; if (L >= 16 * 8 * NPN_) return false;
        const int e = L / (8 * NPN_), w = L % (8 * NPN_);
        u.pm = e * 8 + (w & 7); u.pn = e * NPN_ + (w >> 3); return true;
    }
    DI void a_ready(const pg8::Unit&) const {}
    DI void done(const pg8::Unit&) const {}
};

typedef _Float16 h16x8 __attribute__((ext_vector_type(8)));
struct EpiInProj {
    static constexpr bool PERM = true, AFTER_DRAIN = false;
    bf16 *U, *GV, *Q, *V, *G; _Float16 *LFf, *LFb; const float* LB;
    DI void operator()(const pg8::f32x4 (&acc)[2][2][4][2], const pg8::Unit& u, int wr, int wc, int fr, int fq) const {
        const int seg = u.pn >> 1;
        const int row0 = u.pm * 256 + wr * 64 + fr, lc0 = (u.pn & 1) * 256 + wc * 32 + 8 * fq;
#pragma unroll
        for (int bj = 0; bj < 2; ++bj) {
            const int lc = lc0 + bj * 128;
            float lb[8];
            if (seg == 3 || seg == 4) {
#pragma unroll
                for (int j = 0; j < 8; ++j) lb[j] = LB[(seg - 3) * 512 + lc + j];
            }
#pragma unroll
            for (int ai = 0; ai < 2; ++ai)
#pragma unroll
                for (int m = 0; m < 4; ++m) {
                    const size_t off = (size_t)(row0 + ai * 128 + m * 16) * 512 + lc;
                    float v[8];
#pragma unroll
                    for (int j = 0; j < 8; ++j) v[j] = acc[ai][bj][m][j >> 2][j & 3];
                    if (seg == 3 || seg == 4) {
#pragma unroll
                        for (int j = 0; j < 8; ++j) v[j] = flog(lb[j] + (1.f - lb[j]) * sigmoidf_(v[j]));
                        _Float16* o = (seg == 3 ? LFf : LFb) + off;
                        h16x8 hv;
#pragma unroll
                        for (int j = 0; j < 8; ++j) hv[j] = (_Float16)v[j];
                        *(h16x8*)o = hv;
                    } else {
                        bf16* o;
                        if (seg == 0) { o = U;
#pragma unroll
                            for (int j = 0; j < 8; ++j) v[j] = gelu_tanh(v[j]);
                        } else if (seg == 1) { o = GV;
#pragma unroll
                            for (int j = 0; j < 8; ++j) v[j] = gelu_tanh(v[j]);
                        } else if (seg == 2) { o = Q;
#pragma unroll
                            for (int j = 0; j < 8; ++j) v[j] = siluf_(v[j]);
                        } else if (seg == 5) { o = V;
                        } else { o = G;
#pragma unroll
                            for (int j = 0; j < 8; ++j) v[j] = sigmoidf_(v[j]);
                        }
                        v4u w; w.x = pk2(v[0], v[1]); w.y = pk2(v[2], v[3]); w.z = pk2(v[4], v[5]); w.w = pk2(v[6], v[7]);
                        *(v4u*)(o + off) = w;
                    }
                }
        }
    }
};
struct EpiResid {
    static constexpr bool PERM = false, AFTER_DRAIN = false;
    const float* base; float* out;
    DI void operator()(const pg8::f32x4 (&acc)[2][2][4][2], const pg8::Unit& u, int wr, int wc, int fr, int fq) const {
        const int row0 = u.pm * 256 + wr * 64 + fr, col0 = u.pn * 256 + wc * 32 + 4 * fq;
#pragma unroll
        for (int ai = 0; ai < 2; ++ai)
#pragma unroll
            for (int m = 0; m < 4; ++m) { const size_t ro = (size_t)(row0 + ai * 128 + m * 16) * DM + col0;
#pragma unroll
                for (int bj = 0; bj < 2; ++bj)
#pragma unroll
                    for (int n = 0; n < 2; ++n) { const size_t o = ro + bj * 128 + n * 16; *(f32x4*)(out + o) = *(const f32x4*)(base + o) + acc[ai][bj][m][n]; } }
    }
};
struct EpiGateUp {
    static constexpr bool PERM = true, AFTER_DRAIN = false;
    bf16* H;
    DI void operator()(const pg8::f32x4 (&acc)[2][2][4][2], const pg8::Unit& u, int wr, int wc, int fr, int fq) const {
        const int pnl = u.pn & 7;
        const int row0 = u.pm * 256 + wr * 64 + fr, col0 = pnl * 128 + wc * 32 + 8 * fq;
#pragma unroll
        for (int ai = 0; ai < 2; ++ai)
#pragma unroll
            for (int m = 0; m < 4; ++m) {
                float v[8];
#pragma unroll
                for (int j = 0; j < 8; ++j) v[j] = siluf_(acc[ai][0][m][j >> 2][j & 3]) * acc[ai][1][m][j >> 2][j & 3];
                v4u w; w.x = pk2(v[0], v[1]); w.y = pk2(v[2], v[3]); w.z = pk2(v[4], v[5]); w.w = pk2(v[6], v[7]);
                *(v4u*)(H + (size_t)(row0 + ai * 128 + m * 16) * DFF + col0) = w;
            }
    }
};
struct EpiDown {
    static constexpr bool PERM = true, AFTER_DRAIN = false;
    bf16* Y; const float* gate;
    DI void operator()(const pg8::f32x4 (&acc)[2][2][4][2], const pg8::Unit& u, int wr, int wc, int fr, int fq) const {
        const int pnl = u.pn & 3;
        const int row0 = u.pm * 256 + wr * 64 + fr, col0 = pnl * 256 + wc * 32 + 8 * fq;
#pragma unroll
        for (int ai = 0; ai < 2; ++ai)
#pragma unroll
            for (int m = 0; m < 4; ++m) { const int row = row0 + ai * 128 + m * 16; const float g = gate[row];
#pragma unroll
                for (int bj = 0; bj < 2; ++bj) {
                    float v[8];
#pragma unroll
                    for (int j = 0; j < 8; ++j) v[j] = acc[ai][bj][m][j >> 2][j & 3] * g;
                    v4u w; w.x = pk2(v[0], v[1]); w.y = pk2(v[2], v[3]); w.z = pk2(v[4], v[5]); w.w = pk2(v[6], v[7]);
                    *(v4u*)(Y + (size_t)row * DM + col0 + bj * 128) = w; } }
    }
};
struct EpiQKV {
    static constexpr bool PERM = true, AFTER_DRAIN = false;
    bf16* O;
    DI void operator()(const pg8::f32x4 (&acc)[2][2][4][2], const pg8::Unit& u, int wr, int wc, int fr, int fq) const {
        const float sc = (u.pn < 4) ? 0.125f : 1.f;
        const int row0 = u.pm * 256 + wr * 64 + fr, col0 = u.pn * 256 + wc * 32 + 8 * fq;
#pragma unroll
        for (int ai = 0; ai < 2; ++ai)
#pragma unroll
            for (int m = 0; m < 4; ++m)
#pragma unroll
                for (int bj = 0; bj < 2; ++bj) {
                    float v[8];
#pragma unroll
                    for (int j = 0; j < 8; ++j) v[j] = acc[ai][bj][m][j >> 2][j & 3] * sc;
                    v4u w; w.x = pk2(v[0], v[1]); w.y = pk2(v[2], v[3]); w.z = pk2(v[4], v[5]); w.w = pk2(v[6], v[7]);
                    *(v4u*)(O + (size_t)(row0 + ai * 128 + m * 16) * NQKV + col0 + bj * 128) = w; }
    }
};

DI void transpose_item(const float* W, int K, int N, bf16* WT, LAS float* scr, int k0, int n0, int drow0, int lane) {
#pragma unroll 8
    for (int i = 0; i < 32; ++i) { const int kk = 2 * i + (lane >> 5); scr[kk * 33 + (lane & 31)] = W[(size_t)(k0 + kk) * N + n0 + (lane & 31)]; }
    LDS_WAIT(); asm volatile("" ::: "memory");
    const int c = lane & 7;
#pragma unroll
    for (int j = 0; j < 4; ++j) { const int n = (lane >> 3) + 8 * j; const LAS float* s = scr + (8 * c) * 33 + n;
        v4u o; o.x = pk2(s[0 * 33], s[1 * 33]); o.y = pk2(s[2 * 33], s[3 * 33]); o.z = pk2(s[4 * 33], s[5 * 33]); o.w = pk2(s[6 * 33], s[7 * 33]);
        *(v4u*)(WT + (size_t)(drow0 + n) * K + k0 + 8 * c) = o; }
    LDS_WAIT(); asm volatile("" ::: "memory");
}
DI void transpose_matrix(Frame& F, const float* W, int K, int N, bf16* WT) {
    LAS float* scr = (LAS float*)(F.lds + F.wave * 16384);
    const int nblk = N / 32, nitems = (K / 64) * nblk;
    for (int it = F.gw; it < nitems; it += F.NGW) { const int kb = it / nblk, nb = it % nblk; transpose_item(W, K, N, WT, scr, 64 * kb, 32 * nb, 32 * nb, F.lane); }
}
DI void convert_moe_weights(Frame& F, const float* wg, const float* wu, const float* wd, int layer, int nskip = 0) {
    LAS float* scr = (LAS float*)(F.lds + F.wave * 16384);
    bf16* WGU = (bf16*)(F.ws + WS_WGU); bf16* WDN = (bf16*)(F.ws + WS_WDN);
    if (F.bid < nskip) return;
    for (int it = F.gw - nskip * NWAVES; it < 3 * 16 * 512; it += F.NGW - nskip * NWAVES) {
        const int mat = it / 8192, rem = it % 8192, e = rem / 512, r = rem % 512, kb = r / 32, nb = r % 32, n0 = 32 * nb;
        const size_t so = ((size_t)layer * 16 + e) * 1024 * 1024;
        if (mat == 0) transpose_item(wg + so, 1024, 1024, WGU + (size_t)e * 2048 * 1024, scr, 64 * kb, n0, (n0 >> 7) * 256 + (n0 & 127), F.lane);
        else if (mat == 1) transpose_item(wu + so, 1024, 1024, WGU + (size_t)e * 2048 * 1024, scr, 64 * kb, n0, (n0 >> 7) * 256 + 128 + (n0 & 127), F.lane);
        else transpose_item(wd + so, 1024, 1024, WDN + (size_t)e * 1024 * 1024, scr, 64 * kb, n0, n0, F.lane);
    }
}
DI void rms_row(const float* xrow, const float* g, f32x4 (&v)[4], int lane) {
    const f32x4* xr = (const f32x4*)xrow + lane; float s = 0.f;
#pragma unroll
    for (int j = 0; j < 4; ++j) { v[j] = xr[64 * j]; s += (v[j].x * v[j].x + v[j].y * v[j].y) + (v[j].z * v[j].z + v[j].w * v[j].w); }
    const float rstd = 1.f / sqrtf(wave_sum(s) * (1.f / DM) + EPS);
    const f32x4* gr = (const f32x4*)g + lane;
#pragma unroll
    for (int j = 0; j < 4; ++j) v[j] = v[j] * rstd * gr[64 * j];
}
DI void store_row_bf16(bf16* orow, const f32x4 (&v)[4], int lane) {
    v2u* o8 = (v2u*)orow + lane;
#pragma unroll
    for (int j = 0; j < 4; ++j) { v2u w; w.x = pk2(v[j].x, v[j].y); w.y = pk2(v[j].z, v[j].w); o8[64 * j] = w; }
}
DI int t5_bucket(int rel) {
    const int n = rel < 0 ? -rel : rel;
    int val;
    if (n < 8) val = n;
    else { const float sc = logf((float)n / 8.f) / 4.852030263919617f; int lg = 8 + (int)(sc * 8.f); val = lg < 15 ? lg : 15; }
    return (rel > 0 ? 16 : 0) + val;
}

typedef float f32x16 __attribute__((ext_vector_type(16)));
#define MFMA32(a, b, c) __builtin_amdgcn_mfma_f32_32x32x16_bf16((a), (b), (c), 0, 0, 0)
DI int crow32(int j, int hh) { return (j & 3) + 8 * (j >> 2) + 4 * hh; }
DI void phase_prologue(Frame& F, const Args& a) {
    unsigned char* ws = F.ws;
    transpose_matrix(F, a.in[4], 1024, NIN, (bf16*)(ws + WS_WIN));
    transpose_matrix(F, a.in[5], 1024, 1024, (bf16*)(ws + WS_WOUT));
    transpose_matrix(F, a.in[12], 1024, NQKV, (bf16*)(ws + WS_WQKV));
    transpose_matrix(F, a.in[13], 1024, 1024, (bf16*)(ws + WS_WO));
    { bf16* WSB = (bf16*)(ws + WS_WSB); for (int i = F.bid * NTHR + F.tid; i < 4 * 128 * 128; i += F.G * NTHR) WSB[i] = (bf16)f2bf(a.in[8][i]); }
    { float* LB = (float*)(ws + WS_LB); const float* t = a.in[10];
      for (int i = F.bid * NTHR + F.tid; i < 2 * 512; i += F.G * NTHR) { const int d = i / 512, k = i % 512;
          const float a0 = t[(d * 3 + 0) * 512 + k], a1 = t[(d * 3 + 1) * 512 + k], a2 = t[(d * 3 + 2) * 512 + k];
          const float mx = fmaxf(a0, fmaxf(a1, a2)); const float e0 = expf(a0 - mx), e1 = expf(a1 - mx), e2 = expf(a2 - mx);
          LB[i] = e0 / (e0 + e1 + e2); } }
    { float* BT = (float*)(ws + WS_BT); const float* rb = a.in[14];
      for (int i = F.bid * NTHR + F.tid; i < 3 * 16 * 129; i += F.G * NTHR) { const int p = i / (16 * 129), h = (i / 129) % 16, j = i % 129;
          const int dil = (p == 0) ? 1 : (p == 1 ? 4 : 16);
          BT[i] = rb[t5_bucket((j - 64) * dil) * 16 + h]; } }
    { bf16* H = (bf16*)(ws + WS_H); const float* x = a.in[0];
      for (int m = F.gw; m < MTOK; m += F.NGW) { f32x4 v[4]; rms_row(x + (size_t)m * DM, a.in[1], v, F.lane); store_row_bf16(H + (size_t)m * DM, v, F.lane); } }
}

DI void phase_a_mix(Frame& F, const Args& a) {
    const bf16* GV = (const bf16*)(F.ws + WS_GV); const bf16* U = (const bf16*)(F.ws + WS_U); bf16* CAT = (bf16*)(F.ws + WS_CAT); const bf16* WSB = (const bf16*)(F.ws + WS_WSB);
    LAS float* st = (LAS float*)F.lds;
    const int r32 = F.lane & 31, hh = F.lane >> 5, ci = F.wave & 3, tp = F.wave >> 2;
    for (int u = F.bid; u < 512; u += F.G) {
        const int g = u & 3, ch = u >> 2; const int row0 = ch * 128;
        __syncthreads();
        { float p1[16], p2[16];
#pragma unroll
          for (int r = 0; r < 16; ++r) { const v4u w = *((const v4u*)(GV + (size_t)(row0 + 16 * F.wave + r) * AW) + F.lane);
              const float x0 = bflo(w.x), x1 = bfhi(w.x), x2 = bflo(w.y), x3 = bfhi(w.y), x4 = bflo(w.z), x5 = bfhi(w.z), x6 = bflo(w.w), x7 = bfhi(w.w);
              p1[r] = ((x0 + x1) + (x2 + x3)) + ((x4 + x5) + (x6 + x7)); p2[r] = ((x0 * x0 + x1 * x1) + (x2 * x2 + x3 * x3)) + ((x4 * x4 + x5 * x5) + (x6 * x6 + x7 * x7)); }
          const float s1 = red16(p1, F.lane), s2 = red16(p2, F.lane);
          if ((F.lane & 3) == 0) { const float mu = s1 * (1.f / AW); const float var = fmaxf(s2 * (1.f / AW) - mu * mu, 0.f); const int r = 16 * F.wave + red16_idx(F.lane);
              st[2 * r] = mu; st[2 * r + 1] = 1.f / sqrtf(var + EPS); } }
        __syncthreads();
        f32x16 acc[2];
#pragma unroll
        for (int j = 0; j < 16; ++j) { acc[0][j] = 0.f; acc[1][j] = 0.f; }
        const int c = g * 128 + 32 * ci + r32;
        const float lg = a.in[6][c], lb = a.in[7][c];
        const bf16* vcol = GV + (size_t)row0 * AW + c;
        const bf16* w0 = WSB + (size_t)g * 16384 + (size_t)(64 * tp + r32) * 128 + 8 * hh;
#pragma unroll
        for (int s = 0; s < 8; ++s) {
            float e[8];
#pragma unroll
            for (int j = 0; j < 8; ++j) { const int tk = 16 * s + 8 * hh + j; e[j] = (bf2f(vcol[(size_t)tk * AW]) - st[2 * tk]) * st[2 * tk + 1] * lg + lb; }
            v4u bw; bw.x = pk2(e[0], e[1]); bw.y = pk2(e[2], e[3]); bw.z = pk2(e[4], e[5]); bw.w = pk2(e[6], e[7]);
            const bf16x8 bt = __builtin_bit_cast(bf16x8, bw);
            acc[0] = MFMA32(*(const bf16x8*)(w0 + 16 * s), bt, acc[0]);
            acc[1] = MFMA32(*(const bf16x8*)(w0 + 32 * 128 + 16 * s), bt, acc[1]);
        }
#pragma unroll
        for (int q = 0; q < 2; ++q)
#pragma unroll
            for (int j = 0; j < 16; ++j) { const int t = 64 * tp + 32 * q + crow32(j, hh);
                const float uu = bf2f(U[(size_t)(row0 + t) * AW + c]);
                CAT[(size_t)(row0 + t) * DM + c] = (bf16)f2bf(uu * (acc[q][j] + a.in[9][g * 128 + t])); }
    }
}

DI void phase_gla_scan(Frame& F, bool dry = false) {
    float* ST = (float*)(F.ws + WS_ST); float* SO = dry ? (float*)(F.ws + WS_ODIR) : ST; const float* DEC = (const float*)(F.ws + WS_DEC);
    for (int idx = F.bid * NTHR + F.tid; idx < 16 * 16384; idx += F.G * NTHR) {
        const int chain = idx >> 14, kv = idx & 16383, k = kv >> 7;
        float d[NSC], dc[NSC];
#pragma unroll
        for (int sc = 0; sc < NSC; ++sc) { const int u = chain * NSC + sc; d[sc] = ST[(size_t)u * 16384 + kv]; dc[sc] = DEC[u * 128 + k]; }
        float S = 0.f;
#pragma unroll
        for (int sc = 0; sc < NSC; ++sc) { const int u = chain * NSC + sc; SO[(size_t)u * 16384 + kv] = S; S = S * dc[sc] + d[sc]; }
    }
}
DI void phase_router(Frame& F, const float* XR, const float* gn, const float* wr) {
    LAS float* wl = (LAS float*)F.lds;
    __syncthreads();
    for (int i = F.tid; i < 1024 * 16 / 4; i += NTHR) { const f32x4 w4 = *(const f32x4*)(wr + 4 * i); const int d = i >> 2, e0 = 4 * (i & 3);
        wl[(e0 + 0) * 1024 + d] = w4.x; wl[(e0 + 1) * 1024 + d] = w4.y; wl[(e0 + 2) * 1024 + d] = w4.z; wl[(e0 + 3) * 1024 + d] = w4.w; }
    __syncthreads();
    bf16* H = (bf16*)(F.ws + WS_H); float* AFF = (float*)(F.ws + WS_AFF);
    for (int mp = F.gw; mp < MTOK / 2; mp += F.NGW) {
        asm volatile("" ::: "memory");
        const int m0 = 2 * mp;
        f32x4 va[4], vb[4];
        { const f32x4* xa = (const f32x4*)(XR + (size_t)m0 * DM) + F.lane; const f32x4* xb = xa + DM / 4;
#pragma unroll
          for (int j = 0; j < 4; ++j) { va[j] = xa[64 * j]; vb[j] = xb[64 * j]; } }
        float sa = 0.f, sb = 0.f;
#pragma unroll
        for (int j = 0; j < 4; ++j) { sa += (va[j].x * va[j].x + va[j].y * va[j].y) + (va[j].z * va[j].z + va[j].w * va[j].w); sb += (vb[j].x * vb[j].x + vb[j].y * vb[j].y) + (vb[j].z * vb[j].z + vb[j].w * vb[j].w); }
        const float ra = 1.f / sqrtf(wave_sum(sa) * (1.f / DM) + EPS), rb = 1.f / sqrtf(wave_sum(sb) * (1.f / DM) + EPS);
        { const f32x4* gr = (const f32x4*)gn + F.lane;
#pragma unroll
          for (int j = 0; j < 4; ++j) { const f32x4 g4 = gr[64 * j]; va[j] = va[j] * ra * g4; vb[j] = vb[j] * rb * g4; } }
        store_row_bf16(H + (size_t)m0 * DM, va, F.lane); store_row_bf16(H + (size_t)(m0 + 1) * DM, vb, F.lane);
        float pa[16], pb[16];
#pragma unroll
        for (int e = 0; e < 16; ++e) { float a = 0.f, c = 0.f;
#pragma unroll
            for (int j = 0; j < 4; ++j) { const f32x4 w4 = *(const LAS f32x4*)(wl + e * 1024 + 4 * F.lane + 256 * j);
                a += (va[j].x * w4.x + va[j].y * w4.y) + (va[j].z * w4.z + va[j].w * w4.w); c += (vb[j].x * w4.x + vb[j].y * w4.y) + (vb[j].z * w4.z + vb[j].w * w4.w); }
            pa[e] = a; pb[e] = c; }
        const float la = red16(pa, F.lane), lb = red16(pb, F.lane);
        const float ma = wave_max(la), mb = wave_max(lb); const float ea = expf(la - ma), eb = expf(lb - mb); const float za = wave_sum(ea) * 0.25f, zb = wave_sum(eb) * 0.25f;
        if ((F.lane & 3) == 0) { const int b = m0 / SEQ, sq = m0 % SEQ; float* ap = AFF + (size_t)(b * 16 + red16_idx(F.lane)) * SEQ + sq; ap[0] = ea / za; ap[1] = eb / zb; }
    }
}

DI int block_excl_scan(int v, LAS int* scratch, int tid, int lane, int wave, int* tot) {
    int inc = v;
#pragma unroll
    for (int o = 1; o < 64; o <<= 1) { const int t = __shfl_up(inc, o); if (lane >= o) inc += t; }
    __syncthreads();
    if (lane == 63) scratch[wave] = inc;
    __syncthreads();
    int base = 0, total = 0;
#pragma unroll
    for (int w = 0; w < NWAVES; ++w) { const int s = scratch[w]; if (w < wave) base += s; total += s; }
    *tot = total;
    return base + inc - v;
}
DI void phase_topk(Frame& F) {
    const float* AFF = (const float*)(F.ws + WS_AFF); int* IDX = (int*)(F.ws + WS_IDX); float* GATE = (float*)(F.ws + WS_GATE); int* POS = (int*)(F.ws + WS_POS);
    LAS unsigned* hist = (LAS unsigned*)F.lds; LAS int* sc = (LAS int*)(F.lds + 16384); LAS unsigned* shv = (LAS unsigned*)(F.lds + 16384 + 256);
    for (int u = F.bid; u < BATCH * NEXP; u += F.G) {
        const int b = u / NEXP, e = u % NEXP;
        unsigned vals[16];
        { const v4u* src = (const v4u*)(AFF + (size_t)u * SEQ + 16 * F.tid);
#pragma unroll
          for (int j = 0; j < 4; ++j) { const v4u t = src[j]; vals[4 * j] = t.x; vals[4 * j + 1] = t.y; vals[4 * j + 2] = t.z; vals[4 * j + 3] = t.w; } }
        unsigned prefix = 0; int krem = CAP;
#pragma unroll
        for (int pass = 0; pass < 3; ++pass) {
            const int shift = (pass == 0) ? 20 : (pass == 1 ? 8 : 0); const unsigned mask = (pass == 2) ? 255u : 4095u; const int pshift = (pass == 2) ? 8 : 20;
            __syncthreads();
#pragma unroll
            for (int j = 0; j < 8; ++j) hist[F.tid + 512 * j] = 0u;
            __syncthreads();
#pragma unroll
            for (int j = 0; j < 16; ++j) { const unsigned v = vals[j]; if (pass == 0 || (v >> pshift) == prefix) __hip_atomic_fetch_add(&hist[(v >> shift) & mask], 1u, __ATOMIC_RELAXED, __HIP_MEMORY_SCOPE_WORKGROUP); }
            __syncthreads();
            const int hi = 4095 - 8 * F.tid; int ls = 0; unsigned hb[8];
#pragma unroll
            for (int j = 0; j < 8; ++j) { hb[j] = hist[hi - j]; ls += (int)hb[j]; }
            int tot; const int above = block_excl_scan(ls, sc, F.tid, F.lane, F.wave, &tot);
            if (above < krem && krem <= above + ls) { int cum = above, sel = hi, found = 0;
#pragma unroll
                for (int j = 0; j < 8; ++j) { if (!found) { if (cum + (int)hb[j] >= krem) { sel = hi - j; found = 1; } else cum += (int)hb[j]; } }
                shv[0] = (unsigned)sel; shv[1] = (unsigned)(krem - cum); }
            __syncthreads();
            prefix = (pass == 2) ? ((prefix << 8) | shv[0]) : ((prefix << 12) | shv[0]); krem = (int)shv[1];
        }
        const unsigned T = prefix;
        int ce = 0;
#pragma unroll
        for (int j = 0; j < 16; ++j) ce += (vals[j] == T) ? 1 : 0;
        int tot; int pe = block_excl_scan(ce, sc, F.tid, F.lane, F.wave, &tot);
        unsigned selmask = 0; int cs = 0;
#pragma unroll
        for (int j = 0; j < 16; ++j) { bool s = vals[j] > T; if (vals[j] == T) { s = pe < krem; ++pe; } if (s) { selmask |= 1u << j; ++cs; } }
        int slot = block_excl_scan(cs, sc, F.tid, F.lane, F.wave, &tot);
#pragma unroll
        for (int j = 0; j < 16; ++j) { const int s = 16 * F.tid + j; const int tokrow = b * SEQ + s;
            if (selmask & (1u << j)) { const int row = (e * 2 + b) * CAP + slot; ++slot; IDX[row] = tokrow; GATE[row] = __builtin_bit_cast(float, vals[j]); POS[tokrow * 16 + e] = row; }
            else POS[tokrow * 16 + e] = -1; }
    }
}
DI void phase_gather(Frame& F) {
    const bf16* H = (const bf16*)(F.ws + WS_H); bf16* XE = (bf16*)(F.ws + WS_XE); const int* IDX = (const int*)(F.ws + WS_IDX);
    for (int r = F.gw; r < NROWS; r += F.NGW) { const int src = IDX[r];
        const v4u* s = (const v4u*)(H + (size_t)src * DM) + F.lane; v4u* d = (v4u*)(XE + (size_t)r * DM) + F.lane;
        d[0] = s[0]; d[64] = s[64]; }
}
struct CombRow { f32x4 v[4]; v2u y[4][4]; float sc[4]; unsigned rest; int pm; };
DI void comb_load(CombRow& c, const float* XR, const bf16* Y, const int* POS, int m, int lane) {
    const f32x4* xr = (const f32x4*)(XR + (size_t)m * DM) + lane;
#pragma unroll
    for (int j = 0; j < 4; ++j) c.v[j] = xr[64 * j];
    c.pm = POS[m * 16 + (lane & 15)];
    unsigned mk = (unsigned)__builtin_amdgcn_readfirstlane((int)(unsigned)(__ballot(lane < 16 && c.pm >= 0)));
#pragma unroll
    for (int q = 0; q < 4; ++q) {
        int p = -1;
        if (mk) { const int e = __builtin_ctz(mk); mk &= mk - 1u; p = __builtin_amdgcn_readlane(c.pm, e); }
        c.sc[q] = (p >= 0) ? 1.f : 0.f;
        const v2u* yr = (const v2u*)(Y + (size_t)(p >= 0 ? p : 0) * DM) + lane;
#pragma unroll
        for (int j = 0; j < 4; ++j) c.y[q][j] = yr[64 * j];
    }
    c.rest = mk;
}
DI void comb_finish(CombRow& c, float* XO, bf16* H, const bf16* Y, const float* gnext, bool final_out, int m, int lane) {
#pragma unroll
    for (int q = 0; q < 4; ++q)
#pragma unroll
        for (int j = 0; j < 4; ++j) { const v2u w = c.y[q][j]; const float s = c.sc[q]; c.v[j].x += s * bflo(w.x); c.v[j].y += s * bfhi(w.x); c.v[j].z += s * bflo(w.y); c.v[j].w += s * bfhi(w.y); }
    unsigned mk = c.rest;
    while (mk) { const int e = __builtin_ctz(mk); mk &= mk - 1u; const int p = __builtin_amdgcn_readlane(c.pm, e);
        const v2u* yr = (const v2u*)(Y + (size_t)p * DM) + lane;
#pragma unroll
        for (int j = 0; j < 4; ++j) { const v2u w = yr[64 * j]; c.v[j].x += bflo(w.x); c.v[j].y += bfhi(w.x); c.v[j].z += bflo(w.y); c.v[j].w += bfhi(w.y); } }
    float s = 0.f;
#pragma unroll
    for (int j = 0; j < 4; ++j) s += (c.v[j].x * c.v[j].x + c.v[j].y * c.v[j].y) + (c.v[j].z * c.v[j].z + c.v[j].w * c.v[j].w);
    const float rstd = 1.f / sqrtf(wave_sum(s) * (1.f / DM) + EPS);
    const f32x4* gr = (const f32x4*)gnext + lane; f32x4* xo = (f32x4*)(XO + (size_t)m * DM) + lane;
    if (final_out) {
#pragma unroll
        for (int j = 0; j < 4; ++j) xo[64 * j] = c.v[j] * rstd * gr[64 * j];
    } else {
#pragma unroll
        for (int j = 0; j < 4; ++j) xo[64 * j] = c.v[j];
        f32x4 nv[4];
#pragma unroll
        for (int j = 0; j < 4; ++j) nv[j] = c.v[j] * rstd * gr[64 * j];
        store_row_bf16(H + (size_t)m * DM, nv, lane);
    }
}
DI void phase_moe_combine(Frame& F, float* XR, const float* gnext, bool final_out, bool dry = false) {
    const bf16* Y = (const bf16*)(F.ws + WS_Y); const int* POS = (const int*)(F.ws + WS_POS); bf16* H = (bf16*)(F.ws + (dry ? WS_R1 + 256 * MiB : WS_H));
    float* XO = dry ? (float*)(F.ws + WS_R1 + 192 * MiB) : XR;
    for (int m = F.gw; m < MTOK; m += 2 * F.NGW) {
        CombRow ca, cb; const int m2 = m + F.NGW;
        comb_load(ca, XR, Y, POS, m, F.lane);
        if (m2 < MTOK) comb_load(cb, XR, Y, POS, m2, F.lane);
        comb_finish(ca, XO, H, Y, gnext, final_out, m, F.lane);
        if (m2 < MTOK) comb_finish(cb, XO, H, Y, gnext, final_out, m2, F.lane);
    }
}

DI int kperm(int r) { return (r & ~12) | ((r & 4) << 1) | ((r & 8) >> 1); }
DI void phase_kvf(Frame& F) {
    const bf16* QKV = (const bf16*)(F.ws + WS_QKV); unsigned char* KF = F.ws + WS_KF; unsigned char* VF = F.ws + WS_VF;
    LAS unsigned char* kl = F.lds; LAS unsigned char* vl = F.lds + 69632;
    for (int u = F.bid; u < 512; u += F.G) {
        const int c = u & 15, h = (u >> 4) & 15, b = u >> 8, t0 = c * 512;
        __syncthreads();
        { const v4u* ks = (const v4u*)(QKV + (size_t)(b * SEQ + t0 + F.tid) * NQKV + 1024 + h * 64); const v4u* vs = (const v4u*)(QKV + (size_t)(b * SEQ + t0 + F.tid) * NQKV + 2048 + h * 64);
#pragma unroll
          for (int j = 0; j < 8; ++j) { const v4u w = ks[j]; LAS v2u* d = (LAS v2u*)(kl + F.tid * 136 + 16 * j); d[0] = (v2u){w.x, w.y}; d[1] = (v2u){w.z, w.w}; }
#pragma unroll
          for (int j = 0; j < 8; ++j) { const v4u w = vs[j]; LAS v2u* d = (LAS v2u*)(vl + F.tid * 136 + 16 * j); d[0] = (v2u){w.x, w.y}; d[1] = (v2u){w.z, w.w}; } }
        __syncthreads();
#pragma unroll
        for (int p = 0; p < 3; ++p) {
            const int dl = (p == 0) ? 1 : (p == 1 ? 4 : 16), tpr = 16 / dl, ntile = SEQ / dl / 32;
            unsigned char* kd = KF + (size_t)p * 32 * MiB; unsigned char* vd = VF + (size_t)p * 32 * MiB;
#pragma unroll 2
            for (int i = 0; i < 8; ++i) { const int q = F.tid + 512 * i, tl = q >> 8, ln = q & 63, hh = ln >> 5, rho = ln & 31, r = tl / tpr, tt = tl % tpr;
                const size_t tg = ((size_t)((b * 16 + h) * dl + r) * ntile + c * tpr + tt) * 4096;
                { const int s = (q >> 6) & 3, tokl = dl * (32 * tt + kperm(rho)) + r;
                  const LAS v2u* sp = (const LAS v2u*)(kl + tokl * 136 + 64 * hh + 16 * s); const v2u a0 = sp[0], a1 = sp[1];
                  *(v4u*)(kd + tg + s * 1024 + ln * 16) = (v4u){a0.x, a0.y, a1.x, a1.y}; }
                { const int dt = (q >> 7) & 1, s2 = (q >> 6) & 1, dim = 32 * dt + rho; unsigned short e[8];
#pragma unroll
                  for (int k = 0; k < 8; ++k) e[k] = *(const LAS unsigned short*)(vl + (dl * (32 * tt + 16 * s2 + 8 * hh + k) + r) * 136 + dim * 2);
                  v4u o; o.x = e[0] | ((unsigned)e[1] << 16); o.y = e[2] | ((unsigned)e[3] << 16); o.z = e[4] | ((unsigned)e[5] << 16); o.w = e[6] | ((unsigned)e[7] << 16);
                  *(v4u*)(vd + tg + (dt * 2 + s2) * 1024 + ln * 16) = o; }
            }
        }
    }
}

DI int osw(int tok, int chunk) { return tok * 256 + (((chunk ^ tok ^ (tok >> 4)) & 15) << 4); }
struct AttnK { bf16x8 k[4]; }; struct AttnV { bf16x8 v[2][2]; };
#ifndef PROBE_DUP
#define PROBE_DUP (-1)
#endif
#ifndef PROBE_SAME
#define PROBE_SAME 0
#endif
DI void attn_load_k(AttnK& t, const unsigned char* kt) {
#pragma unroll
    for (int s = 0; s < 4; ++s) t.k[s] = *(const bf16x8*)(kt + s * 1024);
    if (PROBE_DUP == 77) {
#pragma unroll
        for (int s = 0; s < 4; ++s) { bf16x8 d = *(const bf16x8*)(kt + s * 1024 + (PROBE_SAME ? 0 : 64 * MiB)); asm volatile("" :: "v"(d)); }
    }
}
DI void attn_load_v(AttnV& t, const unsigned char* vt) {
#pragma unroll
    for (int dt = 0; dt < 2; ++dt)
#pragma unroll
        for (int s = 0; s < 2; ++s) t.v[dt][s] = *(const bf16x8*)(vt + (dt * 2 + s) * 1024);
}
template <bool MASK> DI void attn_step(const AttnK& tk, const AttnV& tv, const bf16x8 (&qf)[4], f32x16& o0, f32x16& o1, float& m, float& l, const LAS float* bl, int rel0, int hh) {
    f32x16 sa;
#pragma unroll
    for (int i = 0; i < 16; ++i) sa[i] = 0.f;
#pragma unroll
    for (int s = 0; s < 4; ++s) sa = MFMA32(tk.k[s], qf[s], sa);
    float sc[16]; float tmax = -1e30f;
#pragma unroll
    for (int i = 0; i < 16; ++i) { const int rel = rel0 + 16 * (i >> 3) + (i & 7);
        const bool valid = !MASK || ((rel >= -64) && (rel <= 64)); const int idx = valid ? rel + 64 : 0;
        const float v = sa[i] + bl[idx]; sc[i] = valid ? v : -1e30f; tmax = fmaxf(tmax, sc[i]); }
    tmax = fmaxf(tmax, __shfl_xor(tmax, 32));
    const float mnew = fmaxf(m, tmax), alpha = fexp(m - mnew);
    float ps = 0.f; float p[16];
#pragma unroll
    for (int i = 0; i < 16; ++i) { p[i] = (!MASK || sc[i] > -1e29f) ? fexp(sc[i] - mnew) : 0.f; ps += p[i]; }
    l = l * alpha + ps; m = mnew;
#pragma unroll
    for (int i = 0; i < 16; ++i) { o0[i] *= alpha; o1[i] *= alpha; }
#pragma unroll
    for (int s = 0; s < 2; ++s) {
        v4u w; w.x = pk2(p[8 * s], p[8 * s + 1]); w.y = pk2(p[8 * s + 2], p[8 * s + 3]); w.z = pk2(p[8 * s + 4], p[8 * s + 5]); w.w = pk2(p[8 * s + 6], p[8 * s + 7]);
        const bf16x8 pf = __builtin_bit_cast(bf16x8, w);
        o0 = MFMA32(tv.v[0][s], pf, o0); o1 = MFMA32(tv.v[1][s], pf, o1);
    }
}
DI void attn_stage(Frame& F, int b, int h, int t0, const int P) {
    const int dsh = 2 * P, DL = 1 << dsh, NT = (SEQ / 32) >> dsh;
    const bf16* QKV = (const bf16*)(F.ws + WS_QKV); const unsigned char* KF = F.ws + WS_KF + (size_t)P * 32 * MiB; const unsigned char* VF = F.ws + WS_VF + (size_t)P * 32 * MiB; bf16* ATT = (bf16*)(F.ws + WS_ATT);
    LAS unsigned char* ol = F.lds; LAS float* ml = (LAS float*)(F.lds + 131072); LAS float* ll = ml + 512; const LAS float* bl = (const LAS float*)(F.lds + 135168) + P * 132;
    int lane = F.lane; asm volatile("" : "+v"(lane));
    const int r32 = lane & 31, hh = lane >> 5, w = F.wave;
    asm volatile("" ::: "memory");
    int rr[2], mq[2], tq[2]; const unsigned char* kb[2]; const unsigned char* vb[2];
#pragma unroll
    for (int task = 0; task < 2; ++task) {
        int r, i0;
        if (P == 0) { r = 0; i0 = 64 * w + 32 * task; } else if (P == 1) { r = w & 3; i0 = 64 * (w >> 2) + 32 * task; } else { r = 2 * w + task; i0 = 0; }
        rr[task] = r; mq[task] = (t0 >> dsh) + i0; tq[task] = r + ((i0 + r32) << dsh);
        const size_t tb0 = ((size_t)((b * 16 + h) * DL + r) * NT) * 4096 + lane * 16;
        kb[task] = KF + tb0; vb[task] = VF + tb0;
    }
    int relb = 8 * hh - 64 - r32;
    asm volatile("" : "+v"(relb));
    AttnK ka, kb_, kc; AttnV va, vb_; bf16x8 qf[4], qn[4]; f32x16 o0, o1; float m, l;
#define ATT_T(task, kt) (mq[task] / 32 - 2 + (kt))
#define ATT_OK(task, kt) (ATT_T(task, kt) >= 0 && ATT_T(task, kt) < NT)
#define ATT_TC(task, kt) (ATT_T(task, kt) < 0 ? 0 : (ATT_T(task, kt) >= NT ? NT - 1 : ATT_T(task, kt)))
#define ATT_LDK(t, task, kt) attn_load_k(t, kb[task] + (size_t)ATT_TC(task, kt) * 4096)
#define ATT_LDV(t, task, kt) attn_load_v(t, vb[task] + (size_t)ATT_TC(task, kt) * 4096)
#define ATT_ST(tk, tv, task, kt, MSK) do { if (ATT_OK(task, kt)) attn_step<MSK>(tk, tv, qf, o0, o1, m, l, bl, relb + 32 * (kt), hh); } while (0)
#define ATT_Q(dst, task) do { const bf16* qp = QKV + (size_t)(b * SEQ + t0 + tq[task]) * NQKV + h * 64 + 32 * hh; _Pragma("unroll") for (int s = 0; s < 4; ++s) dst[s] = *(const bf16x8*)(qp + 8 * s); } while (0)
#define ATT_INIT(task) do { if (P == 0) { _Pragma("unroll") for (int i = 0; i < 16; ++i) { o0[i] = 0.f; o1[i] = 0.f; } m = -1e30f; l = 0.f; } else { \
        _Pragma("unroll") for (int g = 0; g < 4; ++g) { const f32x4 a = *(const LAS f32x4*)(ol + osw(tq[task], 2 * g + hh)), c = *(const LAS f32x4*)(ol + osw(tq[task], 8 + 2 * g + hh)); \
            o0[4 * g] = a.x; o0[4 * g + 1] = a.y; o0[4 * g + 2] = a.z; o0[4 * g + 3] = a.w; o1[4 * g] = c.x; o1[4 * g + 1] = c.y; o1[4 * g + 2] = c.z; o1[4 * g + 3] = c.w; } \
        m = ml[tq[task]]; l = hh ? 0.f : ll[tq[task]]; } } while (0)
#define ATT_WB(task) do { const float lt = l + __shfl_xor(l, 32); int tw = tq[task]; asm volatile("" : "+v"(tw));     \
        if (P < 2) { _Pragma("unroll") for (int g = 0; g < 4; ++g) { *(LAS f32x4*)(ol + osw(tw, 2 * g + hh)) = (f32x4){o0[4 * g], o0[4 * g + 1], o0[4 * g + 2], o0[4 * g + 3]}; \
                *(LAS f32x4*)(ol + osw(tw, 8 + 2 * g + hh)) = (f32x4){o1[4 * g], o1[4 * g + 1], o1[4 * g + 2], o1[4 * g + 3]}; } \
            if (hh == 0) { ml[tw] = m; ll[tw] = lt; } } \
        else { const float inv = 1.f / lt; bf16* op = ATT + (size_t)(b * SEQ + t0 + tw) * DM + h * 64 + 4 * hh; \
            _Pragma("unroll") for (int g = 0; g < 4; ++g) { v2u a, c; a.x = pk2(o0[4 * g] * inv, o0[4 * g + 1] * inv); a.y = pk2(o0[4 * g + 2] * inv, o0[4 * g + 3] * inv); \
                c.x = pk2(o1[4 * g] * inv, o1[4 * g + 1] * inv); c.y = pk2(o1[4 * g + 2] * inv, o1[4 * g + 3] * inv); *(v2u*)(op + 8 * g) = a; *(v2u*)(op + 32 + 8 * g) = c; } } } while (0)
    ATT_LDK(ka, 0, 0); ATT_LDK(kb_, 0, 1); ATT_LDV(va, 0, 0);
    ATT_Q(qf, 0); ATT_INIT(0);
    ATT_LDK(kc, 0, 2); ATT_LDV(vb_, 0, 1); ATT_ST(ka, va, 0, 0, true);
    ATT_LDK(ka, 0, 3); ATT_LDV(va, 0, 2); ATT_ST(kb_, vb_, 0, 1, false);
    ATT_LDK(kb_, 0, 4); ATT_LDV(vb_, 0, 3); ATT_ST(kc, va, 0, 2, false);
    ATT_Q(qn, 1);
    ATT_LDK(kc, 1, 0); ATT_LDV(va, 0, 4); ATT_ST(ka, vb_, 0, 3, false);
    ATT_LDK(ka, 1, 1); ATT_LDV(vb_, 1, 0); ATT_ST(kb_, va, 0, 4, true);
    ATT_WB(0);
    _Pragma("unroll") for (int s = 0; s < 4; ++s) qf[s] = qn[s];
    ATT_INIT(1);
    ATT_LDK(kb_, 1, 2); ATT_LDV(va, 1, 1); ATT_ST(kc, vb_, 1, 0, true);
    ATT_LDK(kc, 1, 3); ATT_LDV(vb_, 1, 2); ATT_ST(ka, va, 1, 1, false);
    ATT_LDK(ka, 1, 4); ATT_LDV(va, 1, 3); ATT_ST(kb_, vb_, 1, 2, false);
    ATT_LDV(vb_, 1, 4); ATT_ST(kc, va, 1, 3, false);
    ATT_ST(ka, vb_, 1, 4, true);
    ATT_WB(1);
#undef ATT_T
#undef ATT_OK
#undef ATT_TC
#undef ATT_LDK
#undef ATT_LDV
#undef ATT_ST
#undef ATT_Q
#undef ATT_INIT
#undef ATT_WB
}
DI void phase_attn(Frame& F) {
    const float* BT = (const float*)(F.ws + WS_BT);
    LAS float* bl = (LAS float*)(F.lds + 135168);
    const int vb_ = (F.G % 8 == 0) ? (F.bid % 8) * (F.G / 8) + F.bid / 8 : F.bid;
    for (int u = vb_; u < 512; u += F.G) {
        const int c = u & 15, h = (u >> 4) & 15, b = u >> 8, t0 = c * 512;
        __syncthreads();
        { int i0 = F.tid; asm volatile("" : "+v"(i0)); for (int i = i0; i < 3 * 129; i += NTHR) bl[(i / 129) * 132 + i % 129] = BT[((i / 129) * 16 + h) * 129 + i % 129]; }
        __syncthreads();
#pragma unroll 1
        for (int P = 0; P < 3; ++P) { if (P) __syncthreads(); attn_stage(F, b, h, t0, P); }
    }
}

constexpr int GL_QT = 0, GL_KT = 17408, GL_QB = 34816, GL_KHT = 52224, GL_VT = 70656, GL_P = 89088, GL_ST = 98304, GL_DEC = 133120, GL_TOT = 133632;
struct GlaRaw { float lf[16]; unsigned short q[16]; unsigned short v[16]; };
template <bool FULL> DI void gla_load_raw(GlaRaw& R, const _Float16* LF, const bf16* Q, const bf16* V, int b, int h, int dir, int pos0, int ch) {
#pragma unroll
    for (int i = 0; i < 16; ++i) { const int ii = pos0 + i; const int tok = dir ? (SEQ - 1 - ii) : ii; const size_t off = (size_t)(b * SEQ + tok) * AW + h * 128 + ch;
        R.lf[i] = (float)LF[off]; R.v[i] = V[off]; if (FULL) R.q[i] = Q[off]; }
}
DI void gla_prep(Frame& F, const GlaRaw& R) {
    LAS unsigned char* L = F.lds; LAS float* tot = (LAS float*)(L + GL_TOT);
    const int ch = F.tid & 127, qtr = F.tid >> 7;
    float c[16]; float run = 0.f;
#pragma unroll
    for (int i = 0; i < 16; ++i) { run += R.lf[i]; c[i] = run; }
    tot[qtr * 128 + ch] = run;
    __syncthreads();
    const float t0 = tot[ch], t1 = tot[128 + ch], t2 = tot[256 + ch], t3 = tot[384 + ch];
    const float off = (qtr > 0 ? t0 : 0.f) + (qtr > 1 ? t1 : 0.f) + (qtr > 2 ? t2 : 0.f), rr = t0 + t1, bend = (t0 + t1) + (t2 + t3);
    const float er = fexp(rr), ebr = fexp(bend - rr);
    unsigned kh[8], vv[8];
#pragma unroll
    for (int i = 0; i < 16; i += 2) {
        const float E0 = fexp(off + c[i] - rr), E1 = fexp(off + c[i + 1] - rr), I0 = frcp(E0), I1 = frcp(E1);
        const float k0 = 1.f - fexp(R.lf[i]), k1 = 1.f - fexp(R.lf[i + 1]);
        const float ki0 = k0 * I0, ki1 = k1 * I1;
        kh[i >> 1] = pk2(ki0 * ebr, ki1 * ebr);
        vv[i >> 1] = (unsigned)R.v[i] | ((unsigned)R.v[i + 1] << 16);
        const float q0 = bf2f(R.q[i]) * E0, q1 = bf2f(R.q[i + 1]) * E1;
        const int ta = 16 * qtr + i;
        *(LAS unsigned short*)(L + GL_QT + ta * 272 + 2 * ch) = (unsigned short)f2bf(q0);
        *(LAS unsigned short*)(L + GL_QT + (ta + 1) * 272 + 2 * ch) = (unsigned short)f2bf(q1);
        *(LAS unsigned short*)(L + GL_KT + ta * 272 + 2 * ch) = (unsigned short)f2bf(ki0);
        *(LAS unsigned short*)(L + GL_KT + (ta + 1) * 272 + 2 * ch) = (unsigned short)f2bf(ki1);
        *(LAS unsigned short*)(L + GL_QB + ta * 272 + 2 * ch) = (unsigned short)f2bf(q0 * er);
        *(LAS unsigned short*)(L + GL_QB + (ta + 1) * 272 + 2 * ch) = (unsigned short)f2bf(q1 * er);
    }
    *(LAS v4u*)(L + GL_KHT + ch * 144 + 32 * qtr) = (v4u){kh[0], kh[1], kh[2], kh[3]}; *(LAS v4u*)(L + GL_KHT + ch * 144 + 32 * qtr + 16) = (v4u){kh[4], kh[5], kh[6], kh[7]};
    *(LAS v4u*)(L + GL_VT + ch * 144 + 32 * qtr) = (v4u){vv[0], vv[1], vv[2], vv[3]}; *(LAS v4u*)(L + GL_VT + ch * 144 + 32 * qtr + 16) = (v4u){vv[4], vv[5], vv[6], vv[7]};
    if (qtr == 0) *(LAS float*)(L + GL_DEC + 4 * ch) = fexp(bend);
}
DI bf16x8 gfrag(const LAS unsigned char* base, int row, int stride, int kel) { return *(const LAS bf16x8*)(base + row * stride + kel * 2); }
DI void gla_state_update(Frame& F, f32x16 (&S)[2]) {
    const LAS unsigned char* L = F.lds; const int r32 = F.lane & 31, hh = F.lane >> 5, vi = F.wave & 3, ki0 = 2 * (F.wave >> 2);
    bf16x8 a[4];
#pragma unroll
    for (int s = 0; s < 4; ++s) a[s] = gfrag(L + GL_VT, 32 * vi + r32, 144, 16 * s + 8 * hh);
#pragma unroll
    for (int q = 0; q < 2; ++q) { const int kr = 32 * (ki0 + q) + r32; const float d = *(const LAS float*)(L + GL_DEC + 4 * kr);
#pragma unroll
        for (int j = 0; j < 16; ++j) S[q][j] *= d;
#pragma unroll
        for (int s = 0; s < 4; ++s) S[q] = MFMA32(a[s], gfrag(L + GL_KHT, kr, 144, 16 * s + 8 * hh), S[q]); }
}
DI void gla_state_to_lds(Frame& F, const f32x16 (&S)[2]) {
    LAS unsigned char* L = F.lds; const int r32 = F.lane & 31, hh = F.lane >> 5, vi = F.wave & 3, ki0 = 2 * (F.wave >> 2);
#pragma unroll
    for (int q = 0; q < 2; ++q)
#pragma unroll
        for (int j = 0; j < 16; ++j) *(LAS unsigned short*)(L + GL_ST + (32 * vi + crow32(j, hh)) * 272 + 2 * (32 * (ki0 + q) + r32)) = (unsigned short)f2bf(S[q][j]);
}
constexpr int G1_KHT = 0, G1_VT = 67584, G1_TOT = 135168;
DI void gla_unit_state(Frame& F, int u) {
    const int sc = u & 31, dir = (u >> 5) & 1, h = (u >> 6) & 3, b = u >> 8;
    const bf16* V = (const bf16*)(F.ws + WS_V); const _Float16* LF = (const _Float16*)(F.ws + (dir ? WS_LFB : WS_LFF));
    float* ST = (float*)(F.ws + WS_ST) + (size_t)u * 16384; float* DEC = (float*)(F.ws + WS_DEC) + u * 128;
    LAS unsigned char* L = F.lds; LAS float* tot = (LAS float*)(L + G1_TOT);
    const int ch = F.tid & 127, qtr = F.tid >> 7, r32 = F.lane & 31, hh = F.lane >> 5, vi = F.wave & 3, ki0 = 2 * (F.wave >> 2);
    float lf[64]; unsigned vv[32];
#pragma unroll
    for (int i = 0; i < 64; ++i) { const int ii = sc * 256 + 64 * qtr + i; const int tok = dir ? (SEQ - 1 - ii) : ii; const size_t off = (size_t)(b * SEQ + tok) * AW + h * 128 + ch;
        lf[i] = (float)LF[off]; const unsigned x = V[off]; if (i & 1) vv[i >> 1] |= x << 16; else vv[i >> 1] = x; }
    float run = 0.f;
#pragma unroll
    for (int i = 0; i < 64; ++i) run += lf[i];
    __syncthreads();
    tot[qtr * 128 + ch] = run;
#pragma unroll
    for (int i = 0; i < 32; i += 4) *(LAS v4u*)(L + G1_VT + ch * 528 + 128 * qtr + 4 * i) = (v4u){vv[i], vv[i + 1], vv[i + 2], vv[i + 3]};
    __syncthreads();
    const float t0 = tot[ch], t1 = tot[128 + ch], t2 = tot[256 + ch], t3 = tot[384 + ch];
    const float bend = (t0 + t1) + (t2 + t3);
    run = (qtr > 0 ? t0 : 0.f) + (qtr > 1 ? t1 : 0.f) + (qtr > 2 ? t2 : 0.f);
#pragma unroll
    for (int i = 0; i < 64; i += 2) { const float b0 = run + lf[i], b1 = b0 + lf[i + 1]; run = b1;
        vv[i >> 1] = pk2((1.f - fexp(lf[i])) * fexp(bend - b0), (1.f - fexp(lf[i + 1])) * fexp(bend - b1)); }
#pragma unroll
    for (int i = 0; i < 32; i += 4) *(LAS v4u*)(L + G1_KHT + ch * 528 + 128 * qtr + 4 * i) = (v4u){vv[i], vv[i + 1], vv[i + 2], vv[i + 3]};
    if (qtr == 0) DEC[ch] = fexp(bend);
    __syncthreads();
    f32x16 S[2];
#pragma unroll
    for (int j = 0; j < 16; ++j) { S[0][j] = 0.f; S[1][j] = 0.f; }
#pragma unroll 4
    for (int s = 0; s < 16; ++s) { const bf16x8 av = gfrag(L + G1_VT, 32 * vi + r32, 528, 16 * s + 8 * hh);
        S[0] = MFMA32(av, gfrag(L + G1_KHT, 32 * ki0 + r32, 528, 16 * s + 8 * hh), S[0]);
        S[1] = MFMA32(av, gfrag(L + G1_KHT, 32 * (ki0 + 1) + r32, 528, 16 * s + 8 * hh), S[1]); }
#pragma unroll
    for (int q = 0; q < 2; ++q)
#pragma unroll
        for (int g = 0; g < 4; ++g) *(f32x4*)(ST + (size_t)(32 * (ki0 + q) + r32) * 128 + 32 * vi + 8 * g + 4 * hh) = (f32x4){S[q][4 * g], S[q][4 * g + 1], S[q][4 * g + 2], S[q][4 * g + 3]};
}
DI int red16h_idx(int lane) { return 8 * ((lane >> 4) & 1) + 4 * ((lane >> 3) & 1) + 2 * ((lane >> 2) & 1) + ((lane >> 1) & 1); }
DI float red16h(const float (&o)[16], int lane) {
    const bool b16 = lane & 16, b8 = lane & 8, b4 = lane & 4, b2 = lane & 2;
    float a8[8], a4[4], a2[2], a1;
#pragma unroll
    for (int j = 0; j < 8; ++j) { const float send = b16 ? o[j] : o[j + 8], keep = b16 ? o[j + 8] : o[j]; a8[j] = keep + __shfl_xor(send, 16); }
#pragma unroll
    for (int j = 0; j < 4; ++j) { const float send = b8 ? a8[j] : a8[j + 4], keep = b8 ? a8[j + 4] : a8[j]; a4[j] = keep + __shfl_xor(send, 8); }
#pragma unroll
    for (int j = 0; j < 2; ++j) { const float send = b4 ? a4[j] : a4[j + 2], keep = b4 ? a4[j + 2] : a4[j]; a2[j] = keep + __shfl_xor(send, 4); }
    { const float send = b2 ? a2[0] : a2[1], keep = b2 ? a2[1] : a2[0]; a1 = keep + __shfl_xor(send, 2); }
    a1 += __shfl_xor(a1, 1);
    return a1;
}
constexpr int GL_RS = 135680;
template <bool FUSE> DI void gla_unit_out(Frame& F, const Args& a, int u) {
    const int sc = u & 31, dir = (u >> 5) & 1, h = (u >> 6) & 3, b = u >> 8;
    const bf16* Q = (const bf16*)(F.ws + WS_Q); const bf16* V = (const bf16*)(F.ws + WS_V); const _Float16* LF = (const _Float16*)(F.ws + (dir ? WS_LFB : WS_LFF));
    const float* ST = (const float*)(F.ws + WS_ST) + (size_t)u * 16384; float* OF = (float*)(F.ws + WS_ODIR);
    const bf16* G = (const bf16*)(F.ws + WS_G); bf16* CAT = (bf16*)(F.ws + WS_CAT);
    const LAS unsigned char* L = F.lds;
    const int ch = F.tid & 127, qtr = F.tid >> 7, r32 = F.lane & 31, hh = F.lane >> 5, w = F.wave, vi = w & 3, ki0 = 2 * (w >> 2), ti = w >> 2;
    f32x16 S[2];
#pragma unroll
    for (int q = 0; q < 2; ++q)
#pragma unroll
        for (int g = 0; g < 4; ++g) { const f32x4 t = *(const f32x4*)(ST + (size_t)(32 * (ki0 + q) + r32) * 128 + 32 * vi + 8 * g + 4 * hh); S[q][4 * g] = t.x; S[q][4 * g + 1] = t.y; S[q][4 * g + 2] = t.z; S[q][4 * g + 3] = t.w; }
    GlaRaw cur, nxt;
    gla_load_raw<true>(cur, LF, Q, V, b, h, dir, sc * 256 + 16 * qtr, ch);
    __syncthreads();
    gla_state_to_lds(F, S);
    const float ngv = FUSE ? a.in[11][h * 128 + 32 * vi + r32] : 0.f;
#pragma unroll 1
    for (int c = 0; c < 4; ++c) {
        gla_prep(F, cur);
        if (c < 3) gla_load_raw<true>(nxt, LF, Q, V, b, h, dir, sc * 256 + (c + 1) * 64 + 16 * qtr, ch);
        float of[16]; unsigned short gg[16];
        if (FUSE) {
#pragma unroll
            for (int j = 0; j < 16; ++j) { const int ii = sc * 256 + c * 64 + 32 * ti + crow32(j, hh); const int tok = dir ? (SEQ - 1 - ii) : ii; const size_t o = (size_t)(b * SEQ + tok) * AW + h * 128 + 32 * vi + r32;
                of[j] = OF[o]; gg[j] = G[o]; }
        }
        __syncthreads();
        f32x16 o;
#pragma unroll
        for (int j = 0; j < 16; ++j) o[j] = 0.f;
#pragma unroll
        for (int s = 0; s < 8; ++s) o = MFMA32(gfrag(L + GL_QB, 32 * ti + r32, 272, 16 * s + 8 * hh), gfrag(L + GL_ST, 32 * vi + r32, 272, 16 * s + 8 * hh), o);
        if (w < 3) {
            const int tp = (w + 1) >> 1, sp = (w == 2) ? 1 : 0;
            f32x16 p;
#pragma unroll
            for (int j = 0; j < 16; ++j) p[j] = 0.f;
#pragma unroll
            for (int s = 0; s < 8; ++s) p = MFMA32(gfrag(L + GL_QT, 32 * tp + r32, 272, 16 * s + 8 * hh), gfrag(L + GL_KT, 32 * sp + r32, 272, 16 * s + 8 * hh), p);
#pragma unroll
            for (int j = 0; j < 16; ++j) { const int t = 32 * tp + crow32(j, hh), s2 = 32 * sp + r32;
                *(LAS unsigned short*)(F.lds + GL_P + t * 144 + 2 * s2) = (s2 <= t) ? (unsigned short)f2bf(p[j]) : (unsigned short)0; }
        }
        __syncthreads();
        { const int ns = ti ? 4 : 2;
#pragma unroll
          for (int s = 0; s < 4; ++s) if (s < ns) o = MFMA32(gfrag(L + GL_P, 32 * ti + r32, 144, 16 * s + 8 * hh), gfrag(L + GL_VT, 32 * vi + r32, 144, 16 * s + 8 * hh), o); }
        if (!FUSE) {
#pragma unroll
            for (int j = 0; j < 16; ++j) { const int ii = sc * 256 + c * 64 + 32 * ti + crow32(j, hh); const int tok = dir ? (SEQ - 1 - ii) : ii;
                OF[(size_t)(b * SEQ + tok) * AW + h * 128 + 32 * vi + r32] = o[j]; }
        } else {
            float sq[16];
#pragma unroll
            for (int j = 0; j < 16; ++j) { o[j] += of[j]; sq[j] = o[j] * o[j]; }
            const float part = red16h(sq, F.lane);
            if ((F.lane & 1) == 0) *(LAS float*)(F.lds + GL_RS + ((ti * 32 + crow32(red16h_idx(F.lane), hh)) * 4 + vi) * 4) = part;
        }
        if (c < 3) { gla_state_update(F, S); gla_state_to_lds(F, S); }
        cur = nxt;
        __syncthreads();
        if (FUSE) {
#pragma unroll
            for (int j = 0; j < 16; ++j) { const int row = crow32(j, hh); const f32x4 ps = *(const LAS f32x4*)(L + GL_RS + (ti * 32 + row) * 16);
                const float rstd = 1.f / sqrtf(((ps.x + ps.y) + (ps.z + ps.w)) * (1.f / 128.f) + EPS);
                const int ii = sc * 256 + c * 64 + 32 * ti + row; const int tok = dir ? (SEQ - 1 - ii) : ii;
                CAT[(size_t)(b * SEQ + tok) * DM + 512 + h * 128 + 32 * vi + r32] = (bf16)f2bf(o[j] * rstd * ngv * bf2f(gg[j])); }
        }
    }
}

__global__ void __launch_bounds__(NTHR, 2) fwd_kernel(Args args) {
    extern __shared__ __attribute__((aligned(16))) unsigned char lds[];
    Frame F;
    F.lds = (LAS unsigned char*)lds;
    F.MISC = (volatile LAS unsigned*)(F.lds + MISC_OFF);
    F.tid = threadIdx.x; F.lane = F.tid & 63; F.wave = __builtin_amdgcn_readfirstlane(F.tid >> 6);
    F.G = gridDim.x; F.bid = blockIdx.x; F.gw = F.bid * NWAVES + F.wave; F.NGW = F.G * NWAVES;
    F.ws = args.ws;
    unsigned* ctl = (unsigned*)(args.ws + WS_CTL);
    for (int u = F.tid; u < (LDS_BYTES - LDSCTL_OFF) / 4; u += NTHR) ((LAS unsigned*)(F.lds + LDSCTL_OFF))[u] = 0u;
    __syncthreads();
    const int lo = args.ph_lo, hi = args.ph_hi;
    XcdBarrier bar; bar.bar = ctl + CW_BAR + args.li * XCD_BAR_WORDS; bar.x = 0; bar.st = nullptr;
    if (hi - lo > 1) bar = xcd_barrier_post(ctl + CW_BAR + args.li * XCD_BAR_WORDS, F.MISC + 8);
#define IN(k) (lo <= (k) && (k) < hi)
#ifndef PROBE_DUP
#define PROBE_DUP (-1)
#endif
#define REP(k) for (int rep_ = 0; rep_ < (((PROBE_DUP) == (k)) ? 2 : 1); ++rep_)
#define SEAM(k) do { if (IN(k) && IN((k) + 1)) { xcd_barrier(bar); if (PROBE_DUP == 99) xcd_barrier(bar); } } while (0)
    unsigned char* ws = args.ws;
    float* XR = args.out;

    if (IN(0)) REP(0) { phase_prologue(F, args); } SEAM(0);
    if (IN(1)) {
        pg8::Gemm g{(const bf16*)(ws + WS_H), (const bf16*)(ws + WS_WIN), MTOK, NIN, DM}; pg8::StaticOrder S; S.init(MTOK, NIN, F.G, F.bid);
        EpiInProj E{(bf16*)(ws + WS_U), (bf16*)(ws + WS_GV), (bf16*)(ws + WS_Q), (bf16*)(ws + WS_V), (bf16*)(ws + WS_G), (_Float16*)(ws + WS_LFF), (_Float16*)(ws + WS_LFB), (const float*)(ws + WS_LB)};
        pg8::gemm_phase<EpiInProj, pg8::StaticOrder, true, true>(F.lds, g, S, E);
        if (PROBE_DUP == 1) pg8::gemm_phase<EpiInProj, pg8::StaticOrder, true, true>(F.lds, g, S, E);
    } SEAM(1);
    if (IN(2)) { phase_a_mix(F, args); REP(2) for (int u = F.bid; u < 512; u += F.G) gla_unit_state(F, u); } SEAM(2);
    if (IN(3)) { phase_gla_scan(F); } SEAM(3);
    if (IN(4)) { for (int i = F.bid; i < 256; i += F.G) gla_unit_out<false>(F, args, ((i >> 5) << 6) | (i & 31)); } SEAM(4);
    if (IN(5)) { for (int i = F.bid; i < 256; i += F.G) gla_unit_out<true>(F, args, ((i >> 5) << 6) | 32 | (i & 31)); } SEAM(5);
    if (IN(6)) REP(6) {
        pg8::Gemm g{(const bf16*)(ws + WS_CAT), (const bf16*)(ws + WS_WOUT), MTOK, DM, DM}; pg8::StaticOrder S; S.init(MTOK, DM, F.G, F.bid);
        EpiResid E{args.in[0], XR};
        pg8::gemm_phase<EpiResid, pg8::StaticOrder, true, true>(F.lds, g, S, E);
    } SEAM(6);
#define MOE_BLOCK(L, pb) do { \
        if (IN(pb)) REP(pb) { phase_router(F, XR, args.in[2] + (L) * DM, args.in[15] + (L) * DM * NEXP); } SEAM(pb); \
        if (IN((pb) + 1)) { REP((pb) + 1) phase_topk(F); convert_moe_weights(F, args.in[16], args.in[17], args.in[18], (L), (F.G > 64) ? 32 : 0); } SEAM((pb) + 1);     \
        if (IN((pb) + 2)) {     \
            pg8::Gemm g{(const bf16*)(ws + WS_H), (const bf16*)(ws + WS_WGU), NROWS, 16 * 2048, DM}; GroupedOrder<8> S{F.G, F.bid}; \
            EpiGateUp E{(bf16*)(ws + WS_HMID)}; \
            LAS int* rowtab = (LAS int*)(F.lds + RING_BYTES); const int* IDX = (const int*)(ws + WS_IDX); \
            for (int i = 0; i < 4; ++i) { pg8::Unit uu; if (!S.next(i, uu)) break; if (F.tid < 256) rowtab[i * 256 + F.tid] = IDX[uu.pm * 256 + F.tid]; } \
            __syncthreads(); \
            pg8::gemm_phase<EpiGateUp, GroupedOrder<8>, true, true, true>(F.lds, g, S, E, rowtab); \
            if (PROBE_DUP == (pb) + 2) pg8::gemm_phase<EpiGateUp, GroupedOrder<8>, true, true, true>(F.lds, g, S, E, rowtab); \
        } SEAM((pb) + 2); \
        if (IN((pb) + 3)) { \
            pg8::Gemm g{(const bf16*)(ws + WS_HMID), (const bf16*)(ws + WS_WDN), NROWS, 16 * 1024, DFF}; GroupedOrder<4> S{F.G, F.bid}; \
            EpiDown E{(bf16*)(ws + WS_Y), (const float*)(ws + WS_GATE)}; \
            pg8::gemm_phase<EpiDown, GroupedOrder<4>, true, true>(F.lds, g, S, E); \
            if (PROBE_DUP == (pb) + 3) pg8::gemm_phase<EpiDown, GroupedOrder<4>, true, true>(F.lds, g, S, E); \
        } SEAM((pb) + 3); \
    } while (0)

    MOE_BLOCK(0, 7);
    if (IN(11)) { if (PROBE_DUP == 32) phase_moe_combine(F, XR, args.in[1] + DM, false, true); phase_moe_combine(F, XR, args.in[1] + DM, false); } SEAM(11);
    if (IN(12)) REP(12) {
        pg8::Gemm g{(const bf16*)(ws + WS_H), (const bf16*)(ws + WS_WQKV), MTOK, NQKV, DM}; pg8::StaticOrder S; S.init(MTOK, NQKV, F.G, F.bid);
        EpiQKV E{(bf16*)(ws + WS_QKV)};
        pg8::gemm_phase<EpiQKV, pg8::StaticOrder, true, true>(F.lds, g, S, E);
    } SEAM(12);
    if (IN(13)) REP(13) { phase_kvf(F); } SEAM(13);
    if (IN(14)) REP(14) { phase_attn(F); } SEAM(14);
    if (IN(15)) {
        pg8::Gemm g{(const bf16*)(ws + WS_ATT), (const bf16*)(ws + WS_WO), MTOK, DM, DM}; pg8::StaticOrder S; S.init(MTOK, DM, F.G, F.bid);
        EpiResid E{XR, XR};
        pg8::gemm_phase<EpiResid, pg8::StaticOrder, true, true>(F.lds, g, S, E);
    } SEAM(15);
    MOE_BLOCK(1, 16);
    if (IN(20)) { if (PROBE_DUP == 33) phase_moe_combine(F, XR, args.in[3], true, true); phase_moe_combine(F, XR, args.in[3], true); }
#undef MOE_BLOCK
#undef IN
#undef SEAM
}

#ifndef MK_N_LAUNCHES
#define MK_N_LAUNCHES 1
#endif
extern "C" void kernel_launch(void* const* d_in, const int* in_sizes, int n_in, void* d_out, int out_size, void* d_ws, size_t ws_size, hipStream_t stream) {
    static int grid = 0;
    if (grid == 0) {
        if (n_in != 19 || in_sizes[0] != MTOK * DM || out_size != MTOK * DM || ws_size < WS_END) { fprintf(stderr, "kernel_launch: unexpected shapes (n_in %d, in0 %d, out %d, ws %zu < %zu); nothing launched\n", n_in, n_in > 0 ? in_sizes[0] : -1, out_size, ws_size, (size_t)WS_END); grid = -1; return; }
        int dev = 0, cus = 0, per_cu = 0;
        if (hipGetDevice(&dev) != hipSuccess || hipDeviceGetAttribute(&cus, hipDeviceAttributeMultiprocessorCount, dev) != hipSuccess) { grid = -1; return; }
        if (hipFuncSetAttribute((const void*)fwd_kernel, hipFuncAttributeMaxDynamicSharedMemorySize, LDS_BYTES) != hipSuccess) { fprintf(stderr, "kernel_launch: hipFuncSetAttribute failed\n"); grid = -1; return; }
        if (hipOccupancyMaxActiveBlocksPerMultiprocessor(&per_cu, (const void*)fwd_kernel, NTHR, LDS_BYTES) != hipSuccess || per_cu < 1) { fprintf(stderr, "kernel_launch: occupancy query reports %d workgroups per CU\n", per_cu); }
        (void)hipGetLastError();
        grid = cus;
    }
    if (grid < 0) return;
    if (hipMemsetAsync((char*)d_ws + WS_CTL, 0, CTL_ZERO_BYTES, stream) != hipSuccess) return;
    Args a{};
    for (int i = 0; i < 19; ++i) a.in[i] = (const float*)d_in[i];
    a.out = (float*)d_out; a.ws = (unsigned char*)d_ws; a.pad = 0;
    static_assert(CW_BAR + MAX_BAR_REGIONS * XCD_BAR_WORDS <= (int)(CTL_ZERO_BYTES / 4), "barrier regions inside the memset region");
#ifdef PROBE_PREFIX
    const int nl = 2;
    for (int li = 0; li < nl; ++li) {
        a.ph_lo = 0; a.ph_hi = (li == 0) ? PROBE_PREFIX : NPHASE; a.li = li;
#else
    const int nl = MK_N_LAUNCHES;
    for (int li = 0; li < nl; ++li) {
        a.ph_lo = (int)((long)NPHASE * li / nl); a.ph_hi = (int)((long)NPHASE * (li + 1) / nl); a.li = li;
#endif
        hipLaunchKernelGGL(fwd_kernel, dim3(grid), dim3(NTHR), LDS_BYTES, stream, a);
        const hipError_t le = hipPeekAtLastError();
        if (le != hipSuccess) { fprintf(stderr, "kernel_launch: launch %d failed: %s\n", li, hipGetErrorName(le)); break; }
    }
}
```

```cpp
#include <hip/hip_runtime.h>
#include <cstdio>
#include <cstdint>
namespace pg8 {
#define PG8_LAS __attribute__((address_space(3)))
typedef unsigned short bf16_t;
typedef short bf16x8 __attribute__((ext_vector_type(8)));
typedef float f32x4 __attribute__((ext_vector_type(4)));
typedef unsigned u32x4 __attribute__((ext_vector_type(4)));
constexpr int BM = 256, BK = 64, HALF = 128, HTB = HALF * BK * 2  , STAGE_BYTES = 8 * HTB, NXCD = 8, WGM = 8;

__host__ __device__ __forceinline__ int lds_byte(int r, int c) { const int st = (r >> 4) * 2 + (c >> 5), rr = r & 15, cc = c & 31, ob = rr * 64 + cc * 2; return st * 1024 + (ob ^ (((ob >> 9) & 1) << 5)); }
__host__ __device__ __forceinline__ void stage_rc(int b, int& R, int& C) { const int st = b / 1024, sb = b % 1024, swz = sb ^ (((sb >> 9) & 1) << 5); R = (st >> 1) * 16 + swz / 64; C = (st & 1) * 32 + (swz % 64) / 2; }
__host__ __device__ __forceinline__ int perm32(int rho) { const int n = rho >> 4, i = rho & 15; return 8 * (i >> 2) + 4 * n + (i & 3); }

struct Unit { int pm, pn; };
struct Gemm { const bf16_t* A; const bf16_t* Bt; int M, N, K; };

struct StaticOrder {
    int nM, nN, nwg, G, c;
    __host__ __device__ void init(int M, int N, int G_, int c_) { nM = M / BM; nN = N / BM; nwg = nM * nN; G = G_; c = c_; }
    __host__ __device__ bool next(int i, Unit& u) const {
        const long L = (long)i * G + c; if (L >= nwg) return false;
        int wgid = (int)L; { const int q = nwg / NXCD, r = nwg % NXCD, xcd = wgid % NXCD, off = wgid / NXCD; wgid = (xcd < r ? xcd * (q + 1) : r * (q + 1) + (xcd - r) * q) + off; }
        const int nig = WGM * nN, gid = wgid / nig, fm = gid * WGM, gsz = (nM - fm) < WGM ? (nM - fm) : WGM;
        u.pm = fm + ((wgid % nig) % gsz); u.pn = (wgid % nig) / gsz; return true;
    }
    __device__ __forceinline__ void a_ready(const Unit&) const {}
    __device__ __forceinline__ void done(const Unit&) const {}
};

__device__ __forceinline__ unsigned cvt_pk_bf16(float lo, float hi) { unsigned r; asm volatile("v_cvt_pk_bf16_f32 %0, %1, %2" : "=v"(r) : "v"(lo), "v"(hi)); return r; }
typedef float f32x2 __attribute__((ext_vector_type(2)));
__device__ __forceinline__ f32x2 gelu_pk(f32x2 v) {
    const f32x2 av = __builtin_elementwise_abs(v), d = av * 0.2316418882f + 1.0f;
    f32x2 t; t.x = __builtin_amdgcn_rcpf(d.x); t.y = __builtin_amdgcn_rcpf(d.y);
    f32x2 q = t * 0.5307027145f + (-0.7265760135f); q = q * t + 0.7107068705f; q = q * t + (-0.142248368f); q = q * t + 0.127414796f; q = q * t;
    const f32x2 s = (v * v) * (-0.72134752044f);
    f32x2 e; e.x = __builtin_amdgcn_exp2f(s.x); e.y = __builtin_amdgcn_exp2f(s.y);
    const f32x2 m = v * (q * e), r = v - m;
    f32x2 o; o.x = v.x < 0.f ? m.x : r.x; o.y = v.y < 0.f ? m.y : r.y; return o;
}

template <int ACT  > struct EpiBf16 {
    static constexpr bool PERM = true, AFTER_DRAIN = false; static_assert(ACT == 0 || ACT == 1, "EpiBf16: ACT is 0 (none) or 1 (gelu_pk)");
    bf16_t* O; int ldc; const float* bias; int split_cols; size_t split_stride; float scale0;
    __device__ __forceinline__ void operator()(const f32x4 (&acc)[2][2][4][2], const Unit& u, int wr, int wc, int fr, int fq) const {
        const int row0 = u.pm * BM + wr * 64 + fr; int colt = u.pn * BM; bf16_t* base = O;
        float sc = 1.f; if (split_cols) { const int t = colt / split_cols; base += (size_t)t * split_stride; colt -= t * split_cols; if (t == 0) sc = scale0; }
        const int col0 = colt + wc * 32 + 8 * fq, bcol0 = u.pn * BM + wc * 32 + 8 * fq;
        f32x4 bv[2][2];
#pragma unroll
        for (int bj = 0; bj < 2; ++bj)
#pragma unroll
            for (int n = 0; n < 2; ++n) bv[bj][n] = bias ? *(const f32x4*)(bias + bcol0 + bj * HALF + 4 * n) : (f32x4){0.f, 0.f, 0.f, 0.f};
#pragma unroll
        for (int ai = 0; ai < 2; ++ai)
#pragma unroll
            for (int m = 0; m < 4; ++m) { bf16_t* rowp = base + (size_t)(row0 + ai * HALF + m * 16) * ldc + col0;
#pragma unroll
                for (int bj = 0; bj < 2; ++bj) { f32x4 v0 = acc[ai][bj][m][0] + bv[bj][0], v1 = acc[ai][bj][m][1] + bv[bj][1];
                    if (ACT == 1) { f32x2 a = gelu_pk((f32x2){v0[0], v0[1]}), b = gelu_pk((f32x2){v0[2], v0[3]}), c = gelu_pk((f32x2){v1[0], v1[1]}), d = gelu_pk((f32x2){v1[2], v1[3]});
                        v0 = (f32x4){a.x, a.y, b.x, b.y}; v1 = (f32x4){c.x, c.y, d.x, d.y}; }
                    v0 = v0 * sc; v1 = v1 * sc; u32x4 w; w.x = cvt_pk_bf16(v0[0], v0[1]); w.y = cvt_pk_bf16(v0[2], v0[3]); w.z = cvt_pk_bf16(v1[0], v1[1]); w.w = cvt_pk_bf16(v1[2], v1[3]);
                    *(u32x4*)(rowp + bj * HALF) = w; } }
    }
};
template <class Epi, class Sched, bool ALIGN_EPI = false, bool SP2 = false, bool GATHER = false>
__device__ __forceinline__ void gemm_phase(PG8_LAS unsigned char* lds, const Gemm g, const Sched& S, const Epi& E, const PG8_LAS int* rowtab = nullptr) {
    const int tid = threadIdx.x, wid = __builtin_amdgcn_readfirstlane(tid >> 6), lane = tid & 63, wr = wid >> 2, wc = wid & 3, fr = lane & 15, fq = lane >> 4;
    const int K = g.K, nt = K / BK;
    unsigned voffA[2], voffB[2]; int gR[2], gC[2];
#pragma unroll
    for (int i = 0; i < 2; ++i) { int R, C; stage_rc(tid * 16 + i * 8192, R, C); const int Rb = Epi::PERM ? ((R & ~31) + perm32(R & 31)) : R;
        voffA[i] = (unsigned)(R * K + C) * 2u; voffB[i] = (unsigned)(Rb * K + C) * 2u; gR[i] = R; gC[i] = C; }
    unsigned vC[2][2] = {{0u, 0u}, {0u, 0u}}, vN[2][2] = {{0u, 0u}, {0u, 0u}};
#define PG8_ROWS(dst, ui_) do { _Pragma("unroll") for (int _h = 0; _h < 2; ++_h) _Pragma("unroll") for (int _i = 0; _i < 2; ++_i) \
        dst[_h][_i] = (unsigned)(rowtab[(ui_) * 256 + _h * 128 + gR[_i]] * K + gC[_i]) * 2u; } while (0)
    const size_t kstep = (size_t)(BK * 2);
    const size_t hstep = (size_t)HALF * K * 2;
    const size_t tstep = 2 * hstep;
    const unsigned ldsw = (unsigned)wid * 1024u;
    const int aoff = lds_byte(wr * 64 + fr, fq * 8), boff = lds_byte(wc * 32 + fr, fq * 8);
#define PG8_SA(b, h) (((b) * 2 + (h)) * HTB)
#define PG8_SB(b, h) ((4 + (b) * 2 + (h)) * HTB)
#define PG8_STAGE(bufoff, gbase, voff) do { _Pragma("unroll") for (int _i = 0; _i < 2; ++_i) \
        __builtin_amdgcn_global_load_lds((const unsigned*)((const char*)(gbase) + (voff)[_i]), (PG8_LAS unsigned*)(lds + (bufoff) + ldsw + _i * 8192), 16, 0, 0); } while (0)
#define PG8_STGA(bufoff, abase, half, V) do { _Pragma("unroll") for (int _i = 0; _i < 2; ++_i) \
        __builtin_amdgcn_global_load_lds((const unsigned*)((const char*)(abase) + (GATHER ? (size_t)V[half][_i] : (size_t)((half) ? hstep : 0) + voffA[_i])), (PG8_LAS unsigned*)(lds + (bufoff) + ldsw + _i * 8192), 16, 0, 0); } while (0)
#define PG8_LDA(dst, b, h) do { _Pragma("unroll") for (int m = 0; m < 4; ++m) _Pragma("unroll") for (int k = 0; k < 2; ++k) dst[m][k] = *(const PG8_LAS bf16x8*)(lds + PG8_SA(b, h) + aoff + m * 2048 + k * 1024); } while (0)
#define PG8_LDB(dst, b, h) do { _Pragma("unroll") for (int n = 0; n < 2; ++n) _Pragma("unroll") for (int k = 0; k < 2; ++k) dst[n][k] = *(const PG8_LAS bf16x8*)(lds + PG8_SB(b, h) + boff + n * 2048 + k * 1024); } while (0)
#define PG8_MMA(ai, bj, At, Bt) do { __builtin_amdgcn_s_setprio(1); _Pragma("unroll") for (int m = 0; m < 4; ++m) _Pragma("unroll") for (int n = 0; n < 2; ++n) _Pragma("unroll") for (int k = 0; k < 2; ++k) \
        acc[ai][bj][m][n] = __builtin_amdgcn_mfma_f32_16x16x32_bf16(Bt[n][k], At[m][k], acc[ai][bj][m][n], 0, 0, 0); __builtin_amdgcn_s_setprio(0); } while (0)
#define PG8_WAIT_V(n) asm volatile("s_waitcnt vmcnt(" #n ")" ::: "memory")
#define PG8_WAIT_L(n) asm volatile("s_waitcnt lgkmcnt(" #n ")" ::: "memory")
#define PG8_BAR __builtin_amdgcn_s_barrier()
#define PG8_SCHED __builtin_amdgcn_sched_barrier(0)
    Unit cur, nxt; int ui = 0;
    if (!S.next(0, cur)) return;
    f32x4 acc[2][2][4][2];
#pragma unroll
    for (int a = 0; a < 2; ++a)
#pragma unroll
        for (int b = 0; b < 2; ++b)
#pragma unroll
            for (int m = 0; m < 4; ++m)
#pragma unroll
                for (int n = 0; n < 2; ++n) acc[a][b][m][n] = (f32x4){0.f, 0.f, 0.f, 0.f};
    bf16x8 At[4][2], B0[2][2], B1[2][2];
    const char* cA = (const char*)g.A + (GATHER ? (size_t)0 : (size_t)cur.pm * tstep); if constexpr (GATHER) PG8_ROWS(vC, 0);
    const char* cB = (const char*)g.Bt + (size_t)cur.pn * tstep;
    S.a_ready(cur);
    if constexpr (SP2) {
        PG8_STAGE(PG8_SB(0, 0), cB, voffB); PG8_STAGE(PG8_SB(0, 1), cB + hstep, voffB); PG8_STGA(PG8_SA(0, 0), cA, 0, vC); PG8_STGA(PG8_SA(0, 1), cA, 1, vC);
        if (wr == 1) PG8_BAR;
        PG8_WAIT_V(2); PG8_BAR;
        PG8_STAGE(PG8_SB(1, 0), cB + kstep, voffB); PG8_STGA(PG8_SA(1, 0), cA + kstep, 0, vC); PG8_STAGE(PG8_SB(1, 1), cB + hstep + kstep, voffB);
        PG8_WAIT_V(6); PG8_BAR;
    } else {
        PG8_STAGE(PG8_SB(0, 0), cB, voffB); PG8_STGA(PG8_SA(0, 0), cA, 0, vC); PG8_STAGE(PG8_SB(0, 1), cB + hstep, voffB); PG8_STGA(PG8_SA(0, 1), cA, 1, vC);
        if (wr == 1) PG8_BAR;
        PG8_WAIT_V(4); PG8_BAR;
        PG8_STAGE(PG8_SB(1, 0), cB + kstep, voffB); PG8_STGA(PG8_SA(1, 0), cA + kstep, 0, vC); PG8_STAGE(PG8_SB(1, 1), cB + hstep + kstep, voffB);
        PG8_WAIT_V(6); PG8_BAR;
    }
    for (;;) {
        const bool has_next = S.next(ui + 1, nxt);
        const char* nA = (has_next && !GATHER) ? (const char*)g.A + (size_t)nxt.pm * tstep : cA;
        if constexpr (GATHER) { if (has_next) PG8_ROWS(vN, ui + 1); else { _Pragma("unroll") for (int _h = 0; _h < 2; ++_h) _Pragma("unroll") for (int _i = 0; _i < 2; ++_i) vN[_h][_i] = vC[_h][_i]; } }
        const char* nB = has_next ? (const char*)g.Bt + (size_t)nxt.pn * tstep : cB;
        for (int t = 0; t < nt; t += 2) {
            const bool last = (t == nt - 2);
            unsigned vX[2][2];
            _Pragma("unroll") for (int _h = 0; _h < 2; ++_h) _Pragma("unroll") for (int _i = 0; _i < 2; ++_i) vX[_h][_i] = last ? vN[_h][_i] : vC[_h][_i];
            const char* a1 = cA + (size_t)(t + 1) * kstep;
            const char* a2 = last ? nA : cA + (size_t)(t + 2) * kstep; const char* b2 = last ? nB : cB + (size_t)(t + 2) * kstep;
            const char* a3 = a2 + kstep; const char* b3 = b2 + kstep;
            if (last && has_next) S.a_ready(nxt);
            if constexpr (SP2) {
            PG8_LDB(B0, 0, 0); PG8_LDB(B1, 0, 1); PG8_SCHED; PG8_LDA(At, 0, 0); PG8_STGA(PG8_SA(1, 1), a1, 1, vC);
            PG8_WAIT_V(8); PG8_WAIT_L(0); PG8_BAR; PG8_MMA(0, 0, At, B0); PG8_MMA(0, 1, At, B1); PG8_BAR; PG8_SCHED;
            PG8_LDA(At, 0, 1); PG8_STAGE(PG8_SB(0, 0), b2, voffB); PG8_STAGE(PG8_SB(0, 1), b2 + hstep, voffB); PG8_STGA(PG8_SA(0, 0), a2, 0, vX);
            PG8_WAIT_V(8); PG8_WAIT_L(0); PG8_BAR; PG8_MMA(1, 0, At, B0); PG8_MMA(1, 1, At, B1); PG8_BAR; PG8_SCHED;
            PG8_LDB(B0, 1, 0); PG8_LDB(B1, 1, 1); PG8_SCHED; PG8_LDA(At, 1, 0); PG8_STGA(PG8_SA(0, 1), a2, 1, vX);
            PG8_WAIT_V(8); PG8_WAIT_L(0); PG8_BAR; PG8_MMA(0, 0, At, B0); PG8_MMA(0, 1, At, B1); PG8_BAR; PG8_SCHED;
            PG8_LDA(At, 1, 1); PG8_STAGE(PG8_SB(1, 0), b3, voffB); PG8_STAGE(PG8_SB(1, 1), b3 + hstep, voffB); PG8_STGA(PG8_SA(1, 0), a3, 0, vX);
            PG8_WAIT_V(8); PG8_WAIT_L(0); PG8_BAR; PG8_MMA(1, 0, At, B0); PG8_MMA(1, 1, At, B1); PG8_BAR; PG8_SCHED;
            } else {
            PG8_LDB(B0, 0, 0); PG8_SCHED; PG8_LDA(At, 0, 0); PG8_STGA(PG8_SA(1, 1), a1, 1, vC);
            PG8_WAIT_L(8); PG8_BAR; PG8_WAIT_L(0); PG8_MMA(0, 0, At, B0); PG8_BAR; PG8_SCHED;
            PG8_LDB(B1, 0, 1); PG8_STAGE(PG8_SB(0, 0), b2, voffB);
            PG8_BAR; PG8_WAIT_L(0); PG8_MMA(0, 1, At, B1); PG8_BAR;
            PG8_LDA(At, 0, 1); PG8_STGA(PG8_SA(0, 0), a2, 0, vX);
            PG8_BAR; PG8_WAIT_L(0); PG8_MMA(1, 0, At, B0); PG8_BAR; PG8_SCHED;
            PG8_STAGE(PG8_SB(0, 1), b2 + hstep, voffB);
            PG8_WAIT_V(6); PG8_BAR; PG8_MMA(1, 1, At, B1); PG8_BAR;
            PG8_LDB(B0, 1, 0); PG8_SCHED; PG8_LDA(At, 1, 0); PG8_STGA(PG8_SA(0, 1), a2, 1, vX);
            PG8_WAIT_L(8); PG8_BAR; PG8_WAIT_L(0); PG8_MMA(0, 0, At, B0); PG8_BAR; PG8_SCHED;
            PG8_LDB(B1, 1, 1); PG8_STAGE(PG8_SB(1, 0), b3, voffB);
            PG8_BAR; PG8_WAIT_L(0); PG8_MMA(0, 1, At, B1); PG8_BAR;
            PG8_LDA(At, 1, 1); PG8_STGA(PG8_SA(1, 0), a3, 0, vX);
            PG8_BAR; PG8_WAIT_L(0); PG8_MMA(1, 0, At, B0); PG8_BAR; PG8_SCHED;
            PG8_STAGE(PG8_SB(1, 1), b3 + hstep, voffB);
            PG8_WAIT_V(6); PG8_BAR; PG8_MMA(1, 1, At, B1); PG8_BAR;
            }
        }
        if constexpr (ALIGN_EPI) { if (wr == 0) PG8_BAR; }
        if constexpr (!Epi::AFTER_DRAIN) { E(acc, cur, wr, wc, fr, fq); S.done(cur); }
        if (!has_next) break;
#pragma unroll
        for (int a = 0; a < 2; ++a)
#pragma unroll
            for (int b = 0; b < 2; ++b)
#pragma unroll
                for (int m = 0; m < 4; ++m)
#pragma unroll
                    for (int n = 0; n < 2; ++n) acc[a][b][m][n] = (f32x4){0.f, 0.f, 0.f, 0.f};
        cur = nxt; cA = nA; cB = nB; ++ui;
        if constexpr (GATHER) { _Pragma("unroll") for (int _h = 0; _h < 2; ++_h) _Pragma("unroll") for (int _i = 0; _i < 2; ++_i) vC[_h][_i] = vN[_h][_i]; }
        if constexpr (ALIGN_EPI) { if (wr == 1) PG8_BAR; }
    }
    PG8_WAIT_V(0);
    if constexpr (!ALIGN_EPI) { if (wr == 0) PG8_BAR; }
    PG8_BAR;
    if constexpr (Epi::AFTER_DRAIN) { E.fused(acc, cur, wr, wc, fr, fq, lds, wid, lane); S.done(cur); }
#undef PG8_SA
#undef PG8_SB
#undef PG8_STAGE
#undef PG8_STGA
#undef PG8_ROWS
#undef PG8_LDA
#undef PG8_LDB
#undef PG8_MMA
#undef PG8_WAIT_V
#undef PG8_WAIT_L
#undef PG8_BAR
#undef PG8_SCHED
}
}
#define LAS __attribute__((address_space(3)))
#define DI __device__ __forceinline__
typedef unsigned short bf16;
typedef unsigned v4u __attribute__((ext_vector_type(4)));
typedef unsigned v2u __attribute__((ext_vector_type(2)));
typedef float f32x4 __attribute__((ext_vector_type(4)));
typedef short bf16x8 __attribute__((ext_vector_type(8)));
#define LDS_WAIT() asm volatile("s_waitcnt lgkmcnt(0)" ::: "memory")
#define VM_WAIT() asm volatile("s_waitcnt vmcnt(0)" ::: "memory")
DI unsigned f2bf(float f) { unsigned u = __builtin_bit_cast(unsigned, f); return (u + 0x7fffu + ((u >> 16) & 1u)) >> 16; }
typedef float f32x2_t __attribute__((ext_vector_type(2))); typedef __bf16 bf16x2_t __attribute__((ext_vector_type(2)));
DI unsigned pk2(float lo, float hi) { f32x2_t v = {lo, hi}; bf16x2_t b = __builtin_convertvector(v, bf16x2_t); return __builtin_bit_cast(unsigned, b); }
DI float bf2f(unsigned b) { return __builtin_bit_cast(float, b << 16); }
DI float bflo(unsigned w) { return __builtin_bit_cast(float, w << 16); }
DI float bfhi(unsigned w) { return __builtin_bit_cast(float, w & 0xffff0000u); }
DI float fexp(float x) { return __builtin_amdgcn_exp2f(x * 1.4426950408889634f); }
DI float flog(float x) { return __builtin_amdgcn_logf(x) * 0.6931471805599453f; }
DI float frcp(float x) { return __builtin_amdgcn_rcpf(x); }
DI float sigmoidf_(float x) { return frcp(1.f + fexp(-x)); }
DI float siluf_(float x) { return x * sigmoidf_(x); }
DI float gelu_tanh(float x) { const float u = 0.7978845608028654f * (x + 0.044715f * x * x * x); return x * sigmoidf_(2.f * u); }
DI float wave_sum(float v) {
#pragma unroll
    for (int o = 1; o < 64; o <<= 1) v += __shfl_xor(v, o);
    return v;
}
DI float wave_max(float v) {
#pragma unroll
    for (int o = 1; o < 64; o <<= 1) v = fmaxf(v, __shfl_xor(v, o));
    return v;
}
DI int red16_idx(int lane) { return 8 * ((lane >> 5) & 1) + 4 * ((lane >> 4) & 1) + 2 * ((lane >> 3) & 1) + ((lane >> 2) & 1); }
DI float red16(const float (&o)[16], int lane) {
    const bool b32 = lane & 32, b16 = lane & 16, b8 = lane & 8, b4 = lane & 4;
    float a8[8], a4[4], a2[2], a1;
#pragma unroll
    for (int j = 0; j < 8; ++j) { const float send = b32 ? o[j] : o[j + 8], keep = b32 ? o[j + 8] : o[j]; a8[j] = keep + __shfl_xor(send, 32); }
#pragma unroll
    for (int j = 0; j < 4; ++j) { const float send = b16 ? a8[j] : a8[j + 4], keep = b16 ? a8[j + 4] : a8[j]; a4[j] = keep + __shfl_xor(send, 16); }
#pragma unroll
    for (int j = 0; j < 2; ++j) { const float send = b8 ? a4[j] : a4[j + 2], keep = b8 ? a4[j + 2] : a4[j]; a2[j] = keep + __shfl_xor(send, 8); }
    { const float send = b4 ? a2[0] : a2[1], keep = b4 ? a2[1] : a2[0]; a1 = keep + __shfl_xor(send, 4); }
    a1 += __shfl_xor(a1, 2); a1 += __shfl_xor(a1, 1);
    return a1;
}
#define XB_TMO      128
#define XB_XCNT(j)  (256  + 64 * (j))
#define XB_XSUB(j)  (1280 + 64 * (j))
#define XB_XGEN(j)  (2304 + 64 * (j))
#define XB_TOP      3328
#define XB_TOPGEN   3392
#define XCD_BAR_WORDS 3456
#define XB_SPIN_CAP (1u << 18)

__device__ __forceinline__ unsigned xb_ld(unsigned* p)              { return __hip_atomic_load(p, __ATOMIC_RELAXED, __HIP_MEMORY_SCOPE_AGENT); }
__device__ __forceinline__ unsigned xb_add(unsigned* p, unsigned v) { return __hip_atomic_fetch_add(p, v, __ATOMIC_RELAXED, __HIP_MEMORY_SCOPE_AGENT); }
__device__ __forceinline__ unsigned xb_xcc_id() { return (unsigned)__builtin_amdgcn_s_getreg((3 << 11) | 20) & 0xFu; }
#define XB_SPIN(cond, bar) do { unsigned _sp = 0; while (cond) { __builtin_amdgcn_s_sleep(1); \
    if ((++_sp & 255u) == 0u) { if (xb_ld(&(bar)[XB_TMO])) break; if (_sp > XB_SPIN_CAP) { atomicAdd(&(bar)[XB_TMO], 1u); break; } } } } while (0)

struct XcdBarrier {
    unsigned* bar; unsigned x;
    volatile LAS unsigned* st;
};

__device__ __forceinline__ XcdBarrier xcd_barrier_post(unsigned* bar, volatile LAS unsigned* st) {
    XcdBarrier b; b.bar = bar; b.x = xb_xcc_id(); b.st = st;
    if (threadIdx.x == 0) (void)xb_add(&bar[XB_XCNT(b.x)], 1u);
    return b;
}
__device__ __forceinline__ void xcd_barrier_complete(unsigned* bar, unsigned x, unsigned& nloc, unsigned& nx) {
    const unsigned G = gridDim.x * gridDim.y * gridDim.z;
    unsigned sum, cnt, mine, sp = 0u;
    for (;;) {
        sum = 0u; cnt = 0u; mine = 0u;
#pragma unroll
        for (unsigned j = 0; j < 16; ++j) { const unsigned c = xb_ld(&bar[XB_XCNT(j)]); sum += c; cnt += (c > 0u) ? 1u : 0u; mine = (j == x) ? c : mine; }
        if (sum == G) break;
        __builtin_amdgcn_s_sleep(1);
        if ((++sp & 255u) == 0u) { if (xb_ld(&bar[XB_TMO])) break; if (sp > XB_SPIN_CAP) { atomicAdd(&bar[XB_TMO], 1u); break; } }
    }
    nloc = mine > 0u ? mine : 1u; nx = cnt > 0u ? cnt : 1u;
}

__device__ __forceinline__ void xcd_barrier(const XcdBarrier& b) {
    asm volatile("s_waitcnt vmcnt(0)" ::: "memory");
    __syncthreads();
    if (threadIdx.x == 0) {
        unsigned* bar = b.bar;
        __builtin_amdgcn_s_waitcnt(0);
        unsigned nloc = b.st[0], nx = b.st[1];
        if (nloc == 0u) { xcd_barrier_complete(bar, b.x, nloc, nx); b.st[0] = nloc; b.st[1] = nx; }
        const unsigned old = xb_add(&bar[XB_XSUB(b.x)], 1u);
        const unsigned gen = old / nloc;
        if (old + 1u == (gen + 1u) * nloc) {
            __builtin_amdgcn_fence(__ATOMIC_RELEASE, "agent");
            asm volatile("s_waitcnt vmcnt(0)" ::: "memory");
            const unsigned og = xb_add(&bar[XB_TOP], 1u);
            const unsigned tg = og / nx;
            if (og + 1u == (tg + 1u) * nx) xb_add(&bar[XB_TOPGEN], 1u);
            else XB_SPIN(xb_ld(&bar[XB_TOPGEN]) == tg, bar);
            __builtin_amdgcn_fence(__ATOMIC_ACQUIRE, "agent");
            xb_add(&bar[XB_XGEN(b.x)], 1u);
            asm volatile("s_waitcnt vmcnt(0)" ::: "memory");
        } else {
            XB_SPIN(xb_ld(&bar[XB_XGEN(b.x)]) == gen, bar);
            __builtin_amdgcn_fence(__ATOMIC_ACQUIRE, "agent");
            asm volatile("s_waitcnt vmcnt(0)" ::: "memory");
        }
    }
    __syncthreads();
}
constexpr int NWAVES = 8, NTHR = 512;
constexpr int BATCH = 2, SEQ = 8192, DM = 1024, MTOK = BATCH * SEQ;
constexpr int NIN = 3584;
constexpr int AW = 512;
constexpr int NEXP = 16, DFF = 1024, CAP = 1024, NROWS = BATCH * NEXP * CAP;
constexpr int NSC = 32, SCLEN = 256;
constexpr int NHEAD = 16, HD = 64, NQKV = 3072;
constexpr float EPS = 1e-6f;
constexpr int NPHASE = 21;

constexpr size_t MiB = 1u << 20;
constexpr size_t WS_CTL = 0, CTL_ZERO_BYTES = 1 * MiB;
constexpr size_t WS_AFF = 1 * MiB;
constexpr size_t WS_POS = 2 * MiB;
constexpr size_t WS_IDX = 3 * MiB;
constexpr size_t WS_GATE = 3 * MiB + 256 * 1024;
constexpr size_t WS_DEC = 3 * MiB + 512 * 1024;
constexpr size_t WS_LB = 4 * MiB;
constexpr size_t WS_BT = 4 * MiB + 64 * 1024;
constexpr size_t WS_WIN = 8 * MiB;
constexpr size_t WS_WOUT = 15 * MiB;
constexpr size_t WS_WQKV = 17 * MiB;
constexpr size_t WS_WO = 23 * MiB;
constexpr size_t WS_WSB = 25 * MiB;
constexpr size_t WS_WGU = 32 * MiB;
constexpr size_t WS_WDN = 96 * MiB;
constexpr size_t WS_H = 128 * MiB;
constexpr size_t WS_R1 = 160 * MiB;
constexpr size_t WS_U = WS_R1, WS_GV = WS_R1 + 16 * MiB, WS_Q = WS_R1 + 32 * MiB, WS_V = WS_R1 + 48 * MiB, WS_G = WS_R1 + 64 * MiB;
constexpr size_t WS_LFF = WS_R1 + 80 * MiB, WS_LFB = WS_R1 + 112 * MiB;
constexpr size_t WS_CAT = WS_R1 + 144 * MiB;
constexpr size_t WS_ST = WS_R1 + 176 * MiB;
constexpr size_t WS_ODIR = WS_R1 + 208 * MiB;
constexpr size_t WS_XE = WS_R1, WS_Y = WS_R1;
constexpr size_t WS_HMID = WS_R1 + 64 * MiB;
constexpr size_t WS_QKV = WS_R1;
constexpr size_t WS_ATT = WS_R1 + 96 * MiB;
constexpr size_t WS_KF = WS_R1 + 128 * MiB;
constexpr size_t WS_VF = WS_R1 + 224 * MiB;
constexpr size_t WS_END = WS_R1 + 320 * MiB;
constexpr int CW_BAR = 4096;
constexpr int MAX_BAR_REGIONS = 24;

constexpr int RING_BYTES = 131072;
constexpr int LDS_BYTES = 147456;
constexpr int LDSCTL_OFF = LDS_BYTES - 512, MISC_OFF = LDSCTL_OFF + 320;

struct Args { const float* in[19]; float* out; unsigned char* ws; int ph_lo, ph_hi, li, pad; };

struct Frame {
    LAS unsigned char* lds;
    volatile LAS unsigned* MISC;
    int tid, lane, wave, G, bid, gw, NGW;
    unsigned char* ws;
};

template <int NPN_> struct GroupedOrder {
    int G, c;
    DI bool next(int i, pg8::Unit& u) const {
        if (G == 256) {
            const int x = c & 7, k = c >> 3;
            if (i >= NPN_ / 2) return false;
            const int e = (NPN_ == 8) ? 4 * i + (x >> 1) : 8 * i + x;
            u.pm = e * 8 + (k & 7); u.pn = e * NPN_ + ((NPN_ == 8) ? 4 * (x & 1) + (k >> 3) : (k >> 3)); return true;
        }
        const int L = i * G + c; if (L >= 16 * 8 * NPN_) return false;
        const int e = L / (8 * NPN_), w = L % (8 * NPN_);
        u.pm = e * 8 + (w & 7); u.pn = e * NPN_ + (w >> 3); return true;
    }
    DI void a_ready(const pg8::Unit&) const {}
    DI void done(const pg8::Unit&) const {}
};

typedef _Float16 h16x8 __attribute__((ext_vector_type(8)));
struct EpiInProj {
    static constexpr bool PERM = true, AFTER_DRAIN = false;
    bf16 *U, *GV, *Q, *V, *G; _Float16 *LFf, *LFb; const float* LB;
    DI void operator()(const pg8::f32x4 (&acc)[2][2][4][2], const pg8::Unit& u, int wr, int wc, int fr, int fq) const {
        const int seg = u.pn >> 1;
        const int row0 = u.pm * 256 + wr * 64 + fr, lc0 = (u.pn & 1) * 256 + wc * 32 + 8 * fq;
#pragma unroll
        for (int bj = 0; bj < 2; ++bj) {
            const int lc = lc0 + bj * 128;
            float lb[8];
            if (seg == 3 || seg == 4) {
#pragma unroll
                for (int j = 0; j < 8; ++j) lb[j] = LB[(seg - 3) * 512 + lc + j];
            }
#pragma unroll
            for (int ai = 0; ai < 2; ++ai)
#pragma unroll
                for (int m = 0; m < 4; ++m) {
                    const size_t off = (size_t)(row0 + ai * 128 + m * 16) * 512 + lc;
                    float v[8];
#pragma unroll
                    for (int j = 0; j < 8; ++j) v[j] = acc[ai][bj][m][j >> 2][j & 3];
                    if (seg == 3 || seg == 4) {
#pragma unroll
                        for (int j = 0; j < 8; ++j) v[j] = flog(lb[j] + (1.f - lb[j]) * sigmoidf_(v[j]));
                        _Float16* o = (seg == 3 ? LFf : LFb) + off;
                        h16x8 hv;
#pragma unroll
                        for (int j = 0; j < 8; ++j) hv[j] = (_Float16)v[j];
                        *(h16x8*)o = hv;
                    } else {
                        bf16* o;
                        if (seg == 0) { o = U;
#pragma unroll
                            for (int j = 0; j < 8; ++j) v[j] = gelu_tanh(v[j]);
                        } else if (seg == 1) { o = GV;
#pragma unroll
                            for (int j = 0; j < 8; ++j) v[j] = gelu_tanh(v[j]);
                        } else if (seg == 2) { o = Q;
#pragma unroll
                            for (int j = 0; j < 8; ++j) v[j] = siluf_(v[j]);
                        } else if (seg == 5) { o = V;
                        } else { o = G;
#pragma unroll
                            for (int j = 0; j < 8; ++j) v[j] = sigmoidf_(v[j]);
                        }
                        v4u w; w.x = pk2(v[0], v[1]); w.y = pk2(v[2], v[3]); w.z = pk2(v[4], v[5]); w.w = pk2(v[6], v[7]);
                        *(v4u*)(o + off) = w;
                    }
                }
        }
    }
};
struct EpiResid {
    static constexpr bool PERM = false, AFTER_DRAIN = false;
    const float* base; float* out;
    DI void operator()(const pg8::f32x4 (&acc)[2][2][4][2], const pg8::Unit& u, int wr, int wc, int fr, int fq) const {
        const int row0 = u.pm * 256 + wr * 64 + fr, col0 = u.pn * 256 + wc * 32 + 4 * fq;
#pragma unroll
        for (int ai = 0; ai < 2; ++ai)
#pragma unroll
            for (int m = 0; m < 4; ++m) { const size_t ro = (size_t)(row0 + ai * 128 + m * 16) * DM + col0;
#pragma unroll
                for (int bj = 0; bj < 2; ++bj)
#pragma unroll
                    for (int n = 0; n < 2; ++n) { const size_t o = ro + bj * 128 + n * 16; *(f32x4*)(out + o) = *(const f32x4*)(base + o) + acc[ai][bj][m][n]; } }
    }
};
struct EpiGateUp {
    static constexpr bool PERM = true, AFTER_DRAIN = false;
    bf16* H;
    DI void operator()(const pg8::f32x4 (&acc)[2][2][4][2], const pg8::Unit& u, int wr, int wc, int fr, int fq) const {
        const int pnl = u.pn & 7;
        const int row0 = u.pm * 256 + wr * 64 + fr, col0 = pnl * 128 + wc * 32 + 8 * fq;
#pragma unroll
        for (int ai = 0; ai < 2; ++ai)
#pragma unroll
            for (int m = 0; m < 4; ++m) {
                float v[8];
#pragma unroll
                for (int j = 0; j < 8; ++j) v[j] = siluf_(acc[ai][0][m][j >> 2][j & 3]) * acc[ai][1][m][j >> 2][j & 3];
                v4u w; w.x = pk2(v[0], v[1]); w.y = pk2(v[2], v[3]); w.z = pk2(v[4], v[5]); w.w = pk2(v[6], v[7]);
                *(v4u*)(H + (size_t)(row0 + ai * 128 + m * 16) * DFF + col0) = w;
            }
    }
};
struct EpiDown {
    static constexpr bool PERM = true, AFTER_DRAIN = false;
    bf16* Y; const float* gate;
    DI void operator()(const pg8::f32x4 (&acc)[2][2][4][2], const pg8::Unit& u, int wr, int wc, int fr, int fq) const {
        const int pnl = u.pn & 3;
        const int row0 = u.pm * 256 + wr * 64 + fr, col0 = pnl * 256 + wc * 32 + 8 * fq;
#pragma unroll
        for (int ai = 0; ai < 2; ++ai)
#pragma unroll
            for (int m = 0; m < 4; ++m) { const int row = row0 + ai * 128 + m * 16; const float g = gate[row];
#pragma unroll
                for (int bj = 0; bj < 2; ++bj) {
                    float v[8];
#pragma unroll
                    for (int j = 0; j < 8; ++j) v[j] = acc[ai][bj][m][j >> 2][j & 3] * g;
                    v4u w; w.x = pk2(v[0], v[1]); w.y = pk2(v[2], v[3]); w.z = pk2(v[4], v[5]); w.w = pk2(v[6], v[7]);
                    *(v4u*)(Y + (size_t)row * DM + col0 + bj * 128) = w; } }
    }
};
struct EpiQKV {
    static constexpr bool PERM = true, AFTER_DRAIN = false;
    bf16* O;
    DI void operator()(const pg8::f32x4 (&acc)[2][2][4][2], const pg8::Unit& u, int wr, int wc, int fr, int fq) const {
        const float sc = (u.pn < 4) ? 0.125f : 1.f;
        const int row0 = u.pm * 256 + wr * 64 + fr, col0 = u.pn * 256 + wc * 32 + 8 * fq;
#pragma unroll
        for (int ai = 0; ai < 2; ++ai)
#pragma unroll
            for (int m = 0; m < 4; ++m)
#pragma unroll
                for (int bj = 0; bj < 2; ++bj) {
                    float v[8];
#pragma unroll
                    for (int j = 0; j < 8; ++j) v[j] = acc[ai][bj][m][j >> 2][j & 3] * sc;
                    v4u w; w.x = pk2(v[0], v[1]); w.y = pk2(v[2], v[3]); w.z = pk2(v[4], v[5]); w.w = pk2(v[6], v[7]);
                    *(v4u*)(O + (size_t)(row0 + ai * 128 + m * 16) * NQKV + col0 + bj * 128) = w; }
    }
};

DI void transpose_item(const float* W, int K, int N, bf16* WT, LAS float* scr, int k0, int n0, int drow0, int lane) {
#pragma unroll 8
    for (int i = 0; i < 32; ++i) { const int kk = 2 * i + (lane >> 5); scr[kk * 33 + (lane & 31)] = W[(size_t)(k0 + kk) * N + n0 + (lane & 31)]; }
    LDS_WAIT(); asm volatile("" ::: "memory");
    const int c = lane & 7;
#pragma unroll
    for (int j = 0; j < 4; ++j) { const int n = (lane >> 3) + 8 * j; const LAS float* s = scr + (8 * c) * 33 + n;
        v4u o; o.x = pk2(s[0 * 33], s[1 * 33]); o.y = pk2(s[2 * 33], s[3 * 33]); o.z = pk2(s[4 * 33], s[5 * 33]); o.w = pk2(s[6 * 33], s[7 * 33]);
        *(v4u*)(WT + (size_t)(drow0 + n) * K + k0 + 8 * c) = o; }
    LDS_WAIT(); asm volatile("" ::: "memory");
}
DI void transpose_matrix(Frame& F, const float* W, int K, int N, bf16* WT) {
    LAS float* scr = (LAS float*)(F.lds + F.wave * 16384);
    const int nblk = N / 32, nitems = (K / 64) * nblk;
    for (int it = F.gw; it < nitems; it += F.NGW) { const int kb = it / nblk, nb = it % nblk; transpose_item(W, K, N, WT, scr, 64 * kb, 32 * nb, 32 * nb, F.lane); }
}
DI void convert_moe_weights(Frame& F, const float* wg, const float* wu, const float* wd, int layer, int nskip = 0) {
    LAS float* scr = (LAS float*)(F.lds + F.wave * 16384);
    bf16* WGU = (bf16*)(F.ws + WS_WGU); bf16* WDN = (bf16*)(F.ws + WS_WDN);
    if (F.bid < nskip) return;
    for (int it = F.gw - nskip * NWAVES; it < 3 * 16 * 512; it += F.NGW - nskip * NWAVES) {
        const int mat = it / 8192, rem = it % 8192, e = rem / 512, r = rem % 512, kb = r / 32, nb = r % 32, n0 = 32 * nb;
        const size_t so = ((size_t)layer * 16 + e) * 1024 * 1024;
        if (mat == 0) transpose_item(wg + so, 1024, 1024, WGU + (size_t)e * 2048 * 1024, scr, 64 * kb, n0, (n0 >> 7) * 256 + (n0 & 127), F.lane);
        else if (mat == 1) transpose_item(wu + so, 1024, 1024, WGU + (size_t)e * 2048 * 1024, scr, 64 * kb, n0, (n0 >> 7) * 256 + 128 + (n0 & 127), F.lane);
        else transpose_item(wd + so, 1024, 1024, WDN + (size_t)e * 1024 * 1024, scr, 64 * kb, n0, n0, F.lane);
    }
}
DI void rms_row(const float* xrow, const float* g, f32x4 (&v)[4], int lane) {
    const f32x4* xr = (const f32x4*)xrow + lane; float s = 0.f;
#pragma unroll
    for (int j = 0; j < 4; ++j) { v[j] = xr[64 * j]; s += (v[j].x * v[j].x + v[j].y * v[j].y) + (v[j].z * v[j].z + v[j].w * v[j].w); }
    const float rstd = 1.f / sqrtf(wave_sum(s) * (1.f / DM) + EPS);
    const f32x4* gr = (const f32x4*)g + lane;
#pragma unroll
    for (int j = 0; j < 4; ++j) v[j] = v[j] * rstd * gr[64 * j];
}
DI void store_row_bf16(bf16* orow, const f32x4 (&v)[4], int lane) {
    v2u* o8 = (v2u*)orow + lane;
#pragma unroll
    for (int j = 0; j < 4; ++j) { v2u w; w.x = pk2(v[j].x, v[j].y); w.y = pk2(v[j].z, v[j].w); o8[64 * j] = w; }
}
DI int t5_bucket(int rel) {
    const int n = rel < 0 ? -rel : rel;
    int val;
    if (n < 8) val = n;
    else { const float sc = logf((float)n / 8.f) / 4.852030263919617f; int lg = 8 + (int)(sc * 8.f); val = lg < 15 ? lg : 15; }
    return (rel > 0 ? 16 : 0) + val;
}

typedef float f32x16 __attribute__((ext_vector_type(16)));
#define MFMA32(a, b, c) __builtin_amdgcn_mfma_f32_32x32x16_bf16((a), (b), (c), 0, 0, 0)
DI int crow32(int j, int hh) { return (j & 3) + 8 * (j >> 2) + 4 * hh; }
DI void phase_prologue(Frame& F, const Args& a) {
    unsigned char* ws = F.ws;
    transpose_matrix(F, a.in[4], 1024, NIN, (bf16*)(ws + WS_WIN));
    transpose_matrix(F, a.in[5], 1024, 1024, (bf16*)(ws + WS_WOUT));
    transpose_matrix(F, a.in[12], 1024, NQKV, (bf16*)(ws + WS_WQKV));
    transpose_matrix(F, a.in[13], 1024, 1024, (bf16*)(ws + WS_WO));
    { bf16* WSB = (bf16*)(ws + WS_WSB); for (int i = F.bid * NTHR + F.tid; i < 4 * 128 * 128; i += F.G * NTHR) WSB[i] = (bf16)f2bf(a.in[8][i]); }
    { float* LB = (float*)(ws + WS_LB); const float* t = a.in[10];
      for (int i = F.bid * NTHR + F.tid; i < 2 * 512; i += F.G * NTHR) { const int d = i / 512, k = i % 512;
          const float a0 = t[(d * 3 + 0) * 512 + k], a1 = t[(d * 3 + 1) * 512 + k], a2 = t[(d * 3 + 2) * 512 + k];
          const float mx = fmaxf(a0, fmaxf(a1, a2)); const float e0 = expf(a0 - mx), e1 = expf(a1 - mx), e2 = expf(a2 - mx);
          LB[i] = e0 / (e0 + e1 + e2); } }
    { float* BT = (float*)(ws + WS_BT); const float* rb = a.in[14];
      for (int i = F.bid * NTHR + F.tid; i < 3 * 16 * 129; i += F.G * NTHR) { const int p = i / (16 * 129), h = (i / 129) % 16, j = i % 129;
          const int dil = (p == 0) ? 1 : (p == 1 ? 4 : 16);
          BT[i] = rb[t5_bucket((j - 64) * dil) * 16 + h]; } }
    { bf16* H = (bf16*)(ws + WS_H); const float* x = a.in[0];
      for (int m = F.gw; m < MTOK; m += F.NGW) { f32x4 v[4]; rms_row(x + (size_t)m * DM, a.in[1], v, F.lane); store_row_bf16(H + (size_t)m * DM, v, F.lane); } }
}

DI void phase_a_mix(Frame& F, const Args& a) {
    const bf16* GV = (const bf16*)(F.ws + WS_GV); const bf16* U = (const bf16*)(F.ws + WS_U); bf16* CAT = (bf16*)(F.ws + WS_CAT); const bf16* WSB = (const bf16*)(F.ws + WS_WSB);
    LAS float* st = (LAS float*)F.lds;
    const int r32 = F.lane & 31, hh = F.lane >> 5, ci = F.wave & 3, tp = F.wave >> 2;
    for (int u = F.bid; u < 512; u += F.G) {
        const int g = u & 3, ch = u >> 2; const int row0 = ch * 128;
        __syncthreads();
        { float p1[16], p2[16];
#pragma unroll
          for (int r = 0; r < 16; ++r) { const v4u w = *((const v4u*)(GV + (size_t)(row0 + 16 * F.wave + r) * AW) + F.lane);
              const float x0 = bflo(w.x), x1 = bfhi(w.x), x2 = bflo(w.y), x3 = bfhi(w.y), x4 = bflo(w.z), x5 = bfhi(w.z), x6 = bflo(w.w), x7 = bfhi(w.w);
              p1[r] = ((x0 + x1) + (x2 + x3)) + ((x4 + x5) + (x6 + x7)); p2[r] = ((x0 * x0 + x1 * x1) + (x2 * x2 + x3 * x3)) + ((x4 * x4 + x5 * x5) + (x6 * x6 + x7 * x7)); }
          const float s1 = red16(p1, F.lane), s2 = red16(p2, F.lane);
          if ((F.lane & 3) == 0) { const float mu = s1 * (1.f / AW); const float var = fmaxf(s2 * (1.f / AW) - mu * mu, 0.f); const int r = 16 * F.wave + red16_idx(F.lane);
              st[2 * r] = mu; st[2 * r + 1] = 1.f / sqrtf(var + EPS); } }
        __syncthreads();
        f32x16 acc[2];
#pragma unroll
        for (int j = 0; j < 16; ++j) { acc[0][j] = 0.f; acc[1][j] = 0.f; }
        const int c = g * 128 + 32 * ci + r32;
        const float lg = a.in[6][c], lb = a.in[7][c];
        const bf16* vcol = GV + (size_t)row0 * AW + c;
        const bf16* w0 = WSB + (size_t)g * 16384 + (size_t)(64 * tp + r32) * 128 + 8 * hh;
#pragma unroll
        for (int s = 0; s < 8; ++s) {
            float e[8];
#pragma unroll
            for (int j = 0; j < 8; ++j) { const int tk = 16 * s + 8 * hh + j; e[j] = (bf2f(vcol[(size_t)tk * AW]) - st[2 * tk]) * st[2 * tk + 1] * lg + lb; }
            v4u bw; bw.x = pk2(e[0], e[1]); bw.y = pk2(e[2], e[3]); bw.z = pk2(e[4], e[5]); bw.w = pk2(e[6], e[7]);
            const bf16x8 bt = __builtin_bit_cast(bf16x8, bw);
            acc[0] = MFMA32(*(const bf16x8*)(w0 + 16 * s), bt, acc[0]);
            acc[1] = MFMA32(*(const bf16x8*)(w0 + 32 * 128 + 16 * s), bt, acc[1]);
        }
#pragma unroll
        for (int q = 0; q < 2; ++q)
#pragma unroll
            for (int j = 0; j < 16; ++j) { const int t = 64 * tp + 32 * q + crow32(j, hh);
                const float uu = bf2f(U[(size_t)(row0 + t) * AW + c]);
                CAT[(size_t)(row0 + t) * DM + c] = (bf16)f2bf(uu * (acc[q][j] + a.in[9][g * 128 + t])); }
    }
}

DI void phase_gla_scan(Frame& F, bool dry = false) {
    float* ST = (float*)(F.ws + WS_ST); float* SO = dry ? (float*)(F.ws + WS_ODIR) : ST; const float* DEC = (const float*)(F.ws + WS_DEC);
    for (int idx = F.bid * NTHR + F.tid; idx < 16 * 16384; idx += F.G * NTHR) {
        const int chain = idx >> 14, kv = idx & 16383, k = kv >> 7;
        float d[NSC], dc[NSC];
#pragma unroll
        for (int sc = 0; sc < NSC; ++sc) { const int u = chain * NSC + sc; d[sc] = ST[(size_t)u * 16384 + kv]; dc[sc] = DEC[u * 128 + k]; }
        float S = 0.f;
#pragma unroll
        for (int sc = 0; sc < NSC; ++sc) { const int u = chain * NSC + sc; SO[(size_t)u * 16384 + kv] = S; S = S * dc[sc] + d[sc]; }
    }
}
DI void phase_router(Frame& F, const float* XR, const float* gn, const float* wr) {
    LAS float* wl = (LAS float*)F.lds;
    __syncthreads();
    for (int i = F.tid; i < 1024 * 16 / 4; i += NTHR) { const f32x4 w4 = *(const f32x4*)(wr + 4 * i); const int d = i >> 2, e0 = 4 * (i & 3);
        wl[(e0 + 0) * 1024 + d] = w4.x; wl[(e0 + 1) * 1024 + d] = w4.y; wl[(e0 + 2) * 1024 + d] = w4.z; wl[(e0 + 3) * 1024 + d] = w4.w; }
    __syncthreads();
    bf16* H = (bf16*)(F.ws + WS_H); float* AFF = (float*)(F.ws + WS_AFF);
    for (int mp = F.gw; mp < MTOK / 2; mp += F.NGW) {
        asm volatile("" ::: "memory");
        const int m0 = 2 * mp;
        f32x4 va[4], vb[4];
        { const f32x4* xa = (const f32x4*)(XR + (size_t)m0 * DM) + F.lane; const f32x4* xb = xa + DM / 4;
#pragma unroll
          for (int j = 0; j < 4; ++j) { va[j] = xa[64 * j]; vb[j] = xb[64 * j]; } }
        float sa = 0.f, sb = 0.f;
#pragma unroll
        for (int j = 0; j < 4; ++j) { sa += (va[j].x * va[j].x + va[j].y * va[j].y) + (va[j].z * va[j].z + va[j].w * va[j].w); sb += (vb[j].x * vb[j].x + vb[j].y * vb[j].y) + (vb[j].z * vb[j].z + vb[j].w * vb[j].w); }
        const float ra = 1.f / sqrtf(wave_sum(sa) * (1.f / DM) + EPS), rb = 1.f / sqrtf(wave_sum(sb) * (1.f / DM) + EPS);
        { const f32x4* gr = (const f32x4*)gn + F.lane;
#pragma unroll
          for (int j = 0; j < 4; ++j) { const f32x4 g4 = gr[64 * j]; va[j] = va[j] * ra * g4; vb[j] = vb[j] * rb * g4; } }
        store_row_bf16(H + (size_t)m0 * DM, va, F.lane); store_row_bf16(H + (size_t)(m0 + 1) * DM, vb, F.lane);
        float pa[16], pb[16];
#pragma unroll
        for (int e = 0; e < 16; ++e) { float a = 0.f, c = 0.f;
#pragma unroll
            for (int j = 0; j < 4; ++j) { const f32x4 w4 = *(const LAS f32x4*)(wl + e * 1024 + 4 * F.lane + 256 * j);
                a += (va[j].x * w4.x + va[j].y * w4.y) + (va[j].z * w4.z + va[j].w * w4.w); c += (vb[j].x * w4.x + vb[j].y * w4.y) + (vb[j].z * w4.z + vb[j].w * w4.w); }
            pa[e] = a; pb[e] = c; }
        const float la = red16(pa, F.lane), lb = red16(pb, F.lane);
        const float ma = wave_max(la), mb = wave_max(lb); const float ea = expf(la - ma), eb = expf(lb - mb); const float za = wave_sum(ea) * 0.25f, zb = wave_sum(eb) * 0.25f;
        if ((F.lane & 3) == 0) { const int b = m0 / SEQ, sq = m0 % SEQ; float* ap = AFF + (size_t)(b * 16 + red16_idx(F.lane)) * SEQ + sq; ap[0] = ea / za; ap[1] = eb / zb; }
    }
}

DI int block_excl_scan(int v, LAS int* scratch, int tid, int lane, int wave, int* tot) {
    int inc = v;
#pragma unroll
    for (int o = 1; o < 64; o <<= 1) { const int t = __shfl_up(inc, o); if (lane >= o) inc += t; }
    __syncthreads();
    if (lane == 63) scratch[wave] = inc;
    __syncthreads();
    int base = 0, total = 0;
#pragma unroll
    for (int w = 0; w < NWAVES; ++w) { const int s = scratch[w]; if (w < wave) base += s; total += s; }
    *tot = total;
    return base + inc - v;
}
DI void phase_topk(Frame& F) {
    const float* AFF = (const float*)(F.ws + WS_AFF); int* IDX = (int*)(F.ws + WS_IDX); float* GATE = (float*)(F.ws + WS_GATE); int* POS = (int*)(F.ws + WS_POS);
    LAS unsigned* hist = (LAS unsigned*)F.lds; LAS int* sc = (LAS int*)(F.lds + 16384); LAS unsigned* shv = (LAS unsigned*)(F.lds + 16384 + 256);
    for (int u = F.bid; u < BATCH * NEXP; u += F.G) {
        const int b = u / NEXP, e = u % NEXP;
        unsigned vals[16];
        { const v4u* src = (const v4u*)(AFF + (size_t)u * SEQ + 16 * F.tid);
#pragma unroll
          for (int j = 0; j < 4; ++j) { const v4u t = src[j]; vals[4 * j] = t.x; vals[4 * j + 1] = t.y; vals[4 * j + 2] = t.z; vals[4 * j + 3] = t.w; } }
        unsigned prefix = 0; int krem = CAP;
#pragma unroll
        for (int pass = 0; pass < 3; ++pass) {
            const int shift = (pass == 0) ? 20 : (pass == 1 ? 8 : 0); const unsigned mask = (pass == 2) ? 255u : 4095u; const int pshift = (pass == 2) ? 8 : 20;
            __syncthreads();
#pragma unroll
            for (int j = 0; j < 8; ++j) hist[F.tid + 512 * j] = 0u;
            __syncthreads();
#pragma unroll
            for (int j = 0; j < 16; ++j) { const unsigned v = vals[j]; if (pass == 0 || (v >> pshift) == prefix) __hip_atomic_fetch_add(&hist[(v >> shift) & mask], 1u, __ATOMIC_RELAXED, __HIP_MEMORY_SCOPE_WORKGROUP); }
            __syncthreads();
            const int hi = 4095 - 8 * F.tid; int ls = 0; unsigned hb[8];
#pragma unroll
            for (int j = 0; j < 8; ++j) { hb[j] = hist[hi - j]; ls += (int)hb[j]; }
            int tot; const int above = block_excl_scan(ls, sc, F.tid, F.lane, F.wave, &tot);
            if (above < krem && krem <= above + ls) { int cum = above, sel = hi, found = 0;
#pragma unroll
                for (int j = 0; j < 8; ++j) { if (!found) { if (cum + (int)hb[j] >= krem) { sel = hi - j; found = 1; } else cum += (int)hb[j]; } }
                shv[0] = (unsigned)sel; shv[1] = (unsigned)(krem - cum); }
            __syncthreads();
            prefix = (pass == 2) ? ((prefix << 8) | shv[0]) : ((prefix << 12) | shv[0]); krem = (int)shv[1];
        }
        const unsigned T = prefix;
        int ce = 0;
#pragma unroll
        for (int j = 0; j < 16; ++j) ce += (vals[j] == T) ? 1 : 0;
        int tot; int pe = block_excl_scan(ce, sc, F.tid, F.lane, F.wave, &tot);
        unsigned selmask = 0; int cs = 0;
#pragma unroll
        for (int j = 0; j < 16; ++j) { bool s = vals[j] > T; if (vals[j] == T) { s = pe < krem; ++pe; } if (s) { selmask |= 1u << j; ++cs; } }
        int slot = block_excl_scan(cs, sc, F.tid, F.lane, F.wave, &tot);
#pragma unroll
        for (int j = 0; j < 16; ++j) { const int s = 16 * F.tid + j; const int tokrow = b * SEQ + s;
            if (selmask & (1u << j)) { const int row = (e * 2 + b) * CAP + slot; ++slot; IDX[row] = tokrow; GATE[row] = __builtin_bit_cast(float, vals[j]); POS[tokrow * 16 + e] = row; }
            else POS[tokrow * 16 + e] = -1; }
    }
}
DI void phase_gather(Frame& F) {
    const bf16* H = (const bf16*)(F.ws + WS_H); bf16* XE = (bf16*)(F.ws + WS_XE); const int* IDX = (const int*)(F.ws + WS_IDX);
    for (int r = F.gw; r < NROWS; r += F.NGW) { const int src = IDX[r];
        const v4u* s = (const v4u*)(H + (size_t)src * DM) + F.lane; v4u* d = (v4u*)(XE + (size_t)r * DM) + F.lane;
        d[0] = s[0]; d[64] = s[64]; }
}
struct CombRow { f32x4 v[4]; v2u y[4][4]; float sc[4]; unsigned rest; int pm; };
DI void comb_load(CombRow& c, const float* XR, const bf16* Y, const int* POS, int m, int lane) {
    const f32x4* xr = (const f32x4*)(XR + (size_t)m * DM) + lane;
#pragma unroll
    for (int j = 0; j < 4; ++j) c.v[j] = xr[64 * j];
    c.pm = POS[m * 16 + (lane & 15)];
    unsigned mk = (unsigned)__builtin_amdgcn_readfirstlane((int)(unsigned)(__ballot(lane < 16 && c.pm >= 0)));
#pragma unroll
    for (int q = 0; q < 4; ++q) {
        int p = -1;
        if (mk) { const int e = __builtin_ctz(mk); mk &= mk - 1u; p = __builtin_amdgcn_readlane(c.pm, e); }
        c.sc[q] = (p >= 0) ? 1.f : 0.f;
        const v2u* yr = (const v2u*)(Y + (size_t)(p >= 0 ? p : 0) * DM) + lane;
#pragma unroll
        for (int j = 0; j < 4; ++j) c.y[q][j] = yr[64 * j];
    }
    c.rest = mk;
}
DI void comb_finish(CombRow& c, float* XO, bf16* H, const bf16* Y, const float* gnext, bool final_out, int m, int lane) {
#pragma unroll
    for (int q = 0; q < 4; ++q)
#pragma unroll
        for (int j = 0; j < 4; ++j) { const v2u w = c.y[q][j]; const float s = c.sc[q]; c.v[j].x += s * bflo(w.x); c.v[j].y += s * bfhi(w.x); c.v[j].z += s * bflo(w.y); c.v[j].w += s * bfhi(w.y); }
    unsigned mk = c.rest;
    while (mk) { const int e = __builtin_ctz(mk); mk &= mk - 1u; const int p = __builtin_amdgcn_readlane(c.pm, e);
        const v2u* yr = (const v2u*)(Y + (size_t)p * DM) + lane;
#pragma unroll
        for (int j = 0; j < 4; ++j) { const v2u w = yr[64 * j]; c.v[j].x += bflo(w.x); c.v[j].y += bfhi(w.x); c.v[j].z += bflo(w.y); c.v[j].w += bfhi(w.y); } }
    float s = 0.f;
#pragma unroll
    for (int j = 0; j < 4; ++j) s += (c.v[j].x * c.v[j].x + c.v[j].y * c.v[j].y) + (c.v[j].z * c.v[j].z + c.v[j].w * c.v[j].w);
    const float rstd = 1.f / sqrtf(wave_sum(s) * (1.f / DM) + EPS);
    const f32x4* gr = (const f32x4*)gnext + lane; f32x4* xo = (f32x4*)(XO + (size_t)m * DM) + lane;
    if (final_out) {
#pragma unroll
        for (int j = 0; j < 4; ++j) xo[64 * j] = c.v[j] * rstd * gr[64 * j];
    } else {
#pragma unroll
        for (int j = 0; j < 4; ++j) xo[64 * j] = c.v[j];
        f32x4 nv[4];
#pragma unroll
        for (int j = 0; j < 4; ++j) nv[j] = c.v[j] * rstd * gr[64 * j];
        store_row_bf16(H + (size_t)m * DM, nv, lane);
    }
}
DI void phase_moe_combine(Frame& F, float* XR, const float* gnext, bool final_out, bool dry = false) {
    const bf16* Y = (const bf16*)(F.ws + WS_Y); const int* POS = (const int*)(F.ws + WS_POS); bf16* H = (bf16*)(F.ws + (dry ? WS_R1 + 256 * MiB : WS_H));
    float* XO = dry ? (float*)(F.ws + WS_R1 + 192 * MiB) : XR;
    for (int m = F.gw; m < MTOK; m += 2 * F.NGW) {
        CombRow ca, cb; const int m2 = m + F.NGW;
        comb_load(ca, XR, Y, POS, m, F.lane);
        if (m2 < MTOK) comb_load(cb, XR, Y, POS, m2, F.lane);
        comb_finish(ca, XO, H, Y, gnext, final_out, m, F.lane);
        if (m2 < MTOK) comb_finish(cb, XO, H, Y, gnext, final_out, m2, F.lane);
    }
}

DI int kperm(int r) { return (r & ~12) | ((r & 4) << 1) | ((r & 8) >> 1); }
DI void phase_kvf(Frame& F) {
    const bf16* QKV = (const bf16*)(F.ws + WS_QKV); unsigned char* KF = F.ws + WS_KF; unsigned char* VF = F.ws + WS_VF;
    LAS unsigned char* kl = F.lds; LAS unsigned char* vl = F.lds + 69632;
    for (int u = F.bid; u < 512; u += F.G) {
        const int c = u & 15, h = (u >> 4) & 15, b = u >> 8, t0 = c * 512;
        __syncthreads();
        { const v4u* ks = (const v4u*)(QKV + (size_t)(b * SEQ + t0 + F.tid) * NQKV + 1024 + h * 64); const v4u* vs = (const v4u*)(QKV + (size_t)(b * SEQ + t0 + F.tid) * NQKV + 2048 + h * 64);
#pragma unroll
          for (int j = 0; j < 8; ++j) { const v4u w = ks[j]; LAS v2u* d = (LAS v2u*)(kl + F.tid * 136 + 16 * j); d[0] = (v2u){w.x, w.y}; d[1] = (v2u){w.z, w.w}; }
#pragma unroll
          for (int j = 0; j < 8; ++j) { const v4u w = vs[j]; LAS v2u* d = (LAS v2u*)(vl + F.tid * 136 + 16 * j); d[0] = (v2u){w.x, w.y}; d[1] = (v2u){w.z, w.w}; } }
        __syncthreads();
#pragma unroll
        for (int p = 0; p < 3; ++p) {
            const int dl = (p == 0) ? 1 : (p == 1 ? 4 : 16), tpr = 16 / dl, ntile = SEQ / dl / 32;
            unsigned char* kd = KF + (size_t)p * 32 * MiB; unsigned char* vd = VF + (size_t)p * 32 * MiB;
#pragma unroll 2
            for (int i = 0; i < 8; ++i) { const int q = F.tid + 512 * i, tl = q >> 8, ln = q & 63, hh = ln >> 5, rho = ln & 31, r = tl / tpr, tt = tl % tpr;
                const size_t tg = ((size_t)((b * 16 + h) * dl + r) * ntile + c * tpr + tt) * 4096;
                { const int s = (q >> 6) & 3, tokl = dl * (32 * tt + kperm(rho)) + r;
                  const LAS v2u* sp = (const LAS v2u*)(kl + tokl * 136 + 64 * hh + 16 * s); const v2u a0 = sp[0], a1 = sp[1];
                  *(v4u*)(kd + tg + s * 1024 + ln * 16) = (v4u){a0.x, a0.y, a1.x, a1.y}; }
                { const int dt = (q >> 7) & 1, s2 = (q >> 6) & 1, dim = 32 * dt + rho; unsigned short e[8];
#pragma unroll
                  for (int k = 0; k < 8; ++k) e[k] = *(const LAS unsigned short*)(vl + (dl * (32 * tt + 16 * s2 + 8 * hh + k) + r) * 136 + dim * 2);
                  v4u o; o.x = e[0] | ((unsigned)e[1] << 16); o.y = e[2] | ((unsigned)e[3] << 16); o.z = e[4] | ((unsigned)e[5] << 16); o.w = e[6] | ((unsigned)e[7] << 16);
                  *(v4u*)(vd + tg + (dt * 2 + s2) * 1024 + ln * 16) = o; }
            }
        }
    }
}

DI int osw(int tok, int chunk) { return tok * 256 + (((chunk ^ tok ^ (tok >> 4)) & 15) << 4); }
struct AttnK { bf16x8 k[4]; }; struct AttnV { bf16x8 v[2][2]; };
#ifndef PROBE_DUP
#define PROBE_DUP (-1)
#endif
#ifndef PROBE_SAME
#define PROBE_SAME 0
#endif
DI void attn_load_k(AttnK& t, const unsigned char* kt) {
#pragma unroll
    for (int s = 0; s < 4; ++s) t.k[s] = *(const bf16x8*)(kt + s * 1024);
    if (PROBE_DUP == 77) {
#pragma unroll
        for (int s = 0; s < 4; ++s) { bf16x8 d = *(const bf16x8*)(kt + s * 1024 + (PROBE_SAME ? 0 : 64 * MiB)); asm volatile("" :: "v"(d)); }
    }
}
DI void attn_load_v(AttnV& t, const unsigned char* vt) {
#pragma unroll
    for (int dt = 0; dt < 2; ++dt)
#pragma unroll
        for (int s = 0; s < 2; ++s) t.v[dt][s] = *(const bf16x8*)(vt + (dt * 2 + s) * 1024);
}
template <bool MASK> DI void attn_step(const AttnK& tk, const AttnV& tv, const bf16x8 (&qf)[4], f32x16& o0, f32x16& o1, float& m, float& l, const LAS float* bl, int rel0, int hh) {
    f32x16 sa;
#pragma unroll
    for (int i = 0; i < 16; ++i) sa[i] = 0.f;
#pragma unroll
    for (int s = 0; s < 4; ++s) sa = MFMA32(tk.k[s], qf[s], sa);
    float sc[16]; float tmax = -1e30f;
#pragma unroll
    for (int i = 0; i < 16; ++i) { const int rel = rel0 + 16 * (i >> 3) + (i & 7);
        const bool valid = !MASK || ((rel >= -64) && (rel <= 64)); const int idx = valid ? rel + 64 : 0;
        const float v = sa[i] + bl[idx]; sc[i] = valid ? v : -1e30f; tmax = fmaxf(tmax, sc[i]); }
    tmax = fmaxf(tmax, __shfl_xor(tmax, 32));
    const float mnew = fmaxf(m, tmax), alpha = fexp(m - mnew);
    float ps = 0.f; float p[16];
#pragma unroll
    for (int i = 0; i < 16; ++i) { p[i] = (!MASK || sc[i] > -1e29f) ? fexp(sc[i] - mnew) : 0.f; ps += p[i]; }
    l = l * alpha + ps; m = mnew;
#pragma unroll
    for (int i = 0; i < 16; ++i) { o0[i] *= alpha; o1[i] *= alpha; }
#pragma unroll
    for (int s = 0; s < 2; ++s) {
        v4u w; w.x = pk2(p[8 * s], p[8 * s + 1]); w.y = pk2(p[8 * s + 2], p[8 * s + 3]); w.z = pk2(p[8 * s + 4], p[8 * s + 5]); w.w = pk2(p[8 * s + 6], p[8 * s + 7]);
        const bf16x8 pf = __builtin_bit_cast(bf16x8, w);
        o0 = MFMA32(tv.v[0][s], pf, o0); o1 = MFMA32(tv.v[1][s], pf, o1);
    }
}
DI void attn_stage(Frame& F, int b, int h, int t0, const int P) {
    const int dsh = 2 * P, DL = 1 << dsh, NT = (SEQ / 32) >> dsh;
    const bf16* QKV = (const bf16*)(F.ws + WS_QKV); const unsigned char* KF = F.ws + WS_KF + (size_t)P * 32 * MiB; const unsigned char* VF = F.ws + WS_VF + (size_t)P * 32 * MiB; bf16* ATT = (bf16*)(F.ws + WS_ATT);
    LAS unsigned char* ol = F.lds; LAS float* ml = (LAS float*)(F.lds + 131072); LAS float* ll = ml + 512; const LAS float* bl = (const LAS float*)(F.lds + 135168) + P * 132;
    int lane = F.lane; asm volatile("" : "+v"(lane));
    const int r32 = lane & 31, hh = lane >> 5, w = F.wave;
    asm volatile("" ::: "memory");
    int rr[2], mq[2], tq[2]; const unsigned char* kb[2]; const unsigned char* vb[2];
#pragma unroll
    for (int task = 0; task < 2; ++task) {
        int r, i0;
        if (P == 0) { r = 0; i0 = 64 * w + 32 * task; } else if (P == 1) { r = w & 3; i0 = 64 * (w >> 2) + 32 * task; } else { r = 2 * w + task; i0 = 0; }
        rr[task] = r; mq[task] = (t0 >> dsh) + i0; tq[task] = r + ((i0 + r32) << dsh);
        const size_t tb0 = ((size_t)((b * 16 + h) * DL + r) * NT) * 4096 + lane * 16;
        kb[task] = KF + tb0; vb[task] = VF + tb0;
    }
    int relb = 8 * hh - 64 - r32;
    asm volatile("" : "+v"(relb));
    AttnK ka, kb_, kc; AttnV va, vb_; bf16x8 qf[4], qn[4]; f32x16 o0, o1; float m, l;
#define ATT_T(task, kt) (mq[task] / 32 - 2 + (kt))
#define ATT_OK(task, kt) (ATT_T(task, kt) >= 0 && ATT_T(task, kt) < NT)
#define ATT_TC(task, kt) (ATT_T(task, kt) < 0 ? 0 : (ATT_T(task, kt) >= NT ? NT - 1 : ATT_T(task, kt)))
#define ATT_LDK(t, task, kt) attn_load_k(t, kb[task] + (size_t)ATT_TC(task, kt) * 4096)
#define ATT_LDV(t, task, kt) attn_load_v(t, vb[task] + (size_t)ATT_TC(task, kt) * 4096)
#define ATT_ST(tk, tv, task, kt, MSK) do { if (ATT_OK(task, kt)) attn_step<MSK>(tk, tv, qf, o0, o1, m, l, bl, relb + 32 * (kt), hh); } while (0)
#define ATT_Q(dst, task) do { const bf16* qp = QKV + (size_t)(b * SEQ + t0 + tq[task]) * NQKV + h * 64 + 32 * hh; _Pragma("unroll") for (int s = 0; s < 4; ++s) dst[s] = *(const bf16x8*)(qp + 8 * s); } while (0)
#define ATT_INIT(task) do { if (P == 0) { _Pragma("unroll") for (int i = 0; i < 16; ++i) { o0[i] = 0.f; o1[i] = 0.f; } m = -1e30f; l = 0.f; } else { \
        _Pragma("unroll") for (int g = 0; g < 4; ++g) { const f32x4 a = *(const LAS f32x4*)(ol + osw(tq[task], 2 * g + hh)), c = *(const LAS f32x4*)(ol + osw(tq[task], 8 + 2 * g + hh)); \
            o0[4 * g] = a.x; o0[4 * g + 1] = a.y; o0[4 * g + 2] = a.z; o0[4 * g + 3] = a.w; o1[4 * g] = c.x; o1[4 * g + 1] = c.y; o1[4 * g + 2] = c.z; o1[4 * g + 3] = c.w; } \
        m = ml[tq[task]]; l = hh ? 0.f : ll[tq[task]]; } } while (0)
#define ATT_WB(task) do { const float lt = l + __shfl_xor(l, 32); int tw = tq[task]; asm volatile("" : "+v"(tw));     \
        if (P < 2) { _Pragma("unroll") for (int g = 0; g < 4; ++g) { *(LAS f32x4*)(ol + osw(tw, 2 * g + hh)) = (f32x4){o0[4 * g], o0[4 * g + 1], o0[4 * g + 2], o0[4 * g + 3]}; \
                *(LAS f32x4*)(ol + osw(tw, 8 + 2 * g + hh)) = (f32x4){o1[4 * g], o1[4 * g + 1], o1[4 * g + 2], o1[4 * g + 3]}; } \
            if (hh == 0) { ml[tw] = m; ll[tw] = lt; } } \
        else { const float inv = 1.f / lt; bf16* op = ATT + (size_t)(b * SEQ + t0 + tw) * DM + h * 64 + 4 * hh; \
            _Pragma("unroll") for (int g = 0; g < 4; ++g) { v2u a, c; a.x = pk2(o0[4 * g] * inv, o0[4 * g + 1] * inv); a.y = pk2(o0[4 * g + 2] * inv, o0[4 * g + 3] * inv); \
                c.x = pk2(o1[4 * g] * inv, o1[4 * g + 1] * inv); c.y = pk2(o1[4 * g + 2] * inv, o1[4 * g + 3] * inv); *(v2u*)(op + 8 * g) = a; *(v2u*)(op + 32 + 8 * g) = c; } } } while (0)
    ATT_LDK(ka, 0, 0); ATT_LDK(kb_, 0, 1); ATT_LDV(va, 0, 0);
    ATT_Q(qf, 0); ATT_INIT(0);
    ATT_LDK(kc, 0, 2); ATT_LDV(vb_, 0, 1); ATT_ST(ka, va, 0, 0, true);
    ATT_LDK(ka, 0, 3); ATT_LDV(va, 0, 2); ATT_ST(kb_, vb_, 0, 1, false);
    ATT_LDK(kb_, 0, 4); ATT_LDV(vb_, 0, 3); ATT_ST(kc, va, 0, 2, false);
    ATT_Q(qn, 1);
    ATT_LDK(kc, 1, 0); ATT_LDV(va, 0, 4); ATT_ST(ka, vb_, 0, 3, false);
    ATT_LDK(ka, 1, 1); ATT_LDV(vb_, 1, 0); ATT_ST(kb_, va, 0, 4, true);
    ATT_WB(0);
    _Pragma("unroll") for (int s = 0; s < 4; ++s) qf[s] = qn[s];
    ATT_INIT(1);
    ATT_LDK(kb_, 1, 2); ATT_LDV(va, 1, 1); ATT_ST(kc, vb_, 1, 0, true);
    ATT_LDK(kc, 1, 3); ATT_LDV(vb_, 1, 2); ATT_ST(ka, va, 1, 1, false);
    ATT_LDK(ka, 1, 4); ATT_LDV(va, 1, 3); ATT_ST(kb_, vb_, 1, 2, false);
    ATT_LDV(vb_, 1, 4); ATT_ST(kc, va, 1, 3, false);
    ATT_ST(ka, vb_, 1, 4, true);
    ATT_WB(1);
#undef ATT_T
#undef ATT_OK
#undef ATT_TC
#undef ATT_LDK
#undef ATT_LDV
#undef ATT_ST
#undef ATT_Q
#undef ATT_INIT
#undef ATT_WB
}
DI void phase_attn(Frame& F) {
    const float* BT = (const float*)(F.ws + WS_BT);
    LAS float* bl = (LAS float*)(F.lds + 135168);
    const int vb_ = (F.G % 8 == 0) ? (F.bid % 8) * (F.G / 8) + F.bid / 8 : F.bid;
    for (int u = vb_; u < 512; u += F.G) {
        const int c = u & 15, h = (u >> 4) & 15, b = u >> 8, t0 = c * 512;
        __syncthreads();
        { int i0 = F.tid; asm volatile("" : "+v"(i0)); for (int i = i0; i < 3 * 129; i += NTHR) bl[(i / 129) * 132 + i % 129] = BT[((i / 129) * 16 + h) * 129 + i % 129]; }
        __syncthreads();
#pragma unroll 1
        for (int P = 0; P < 3; ++P) { if (P) __syncthreads(); attn_stage(F, b, h, t0, P); }
    }
}

constexpr int GL_QT = 0, GL_KT = 17408, GL_QB = 34816, GL_KHT = 52224, GL_VT = 70656, GL_P = 89088, GL_ST = 98304, GL_DEC = 133120, GL_TOT = 133632;
struct GlaRaw { float lf[16]; unsigned short q[16]; unsigned short v[16]; };
template <bool FULL> DI void gla_load_raw(GlaRaw& R, const _Float16* LF, const bf16* Q, const bf16* V, int b, int h, int dir, int pos0, int ch) {
#pragma unroll
    for (int i = 0; i < 16; ++i) { const int ii = pos0 + i; const int tok = dir ? (SEQ - 1 - ii) : ii; const size_t off = (size_t)(b * SEQ + tok) * AW + h * 128 + ch;
        R.lf[i] = (float)LF[off]; R.v[i] = V[off]; if (FULL) R.q[i] = Q[off]; }
}
DI void gla_prep(Frame& F, const GlaRaw& R) {
    LAS unsigned char* L = F.lds; LAS float* tot = (LAS float*)(L + GL_TOT);
    const int ch = F.tid & 127, qtr = F.tid >> 7;
    float c[16]; float run = 0.f;
#pragma unroll
    for (int i = 0; i < 16; ++i) { run += R.lf[i]; c[i] = run; }
    tot[qtr * 128 + ch] = run;
    __syncthreads();
    const float t0 = tot[ch], t1 = tot[128 + ch], t2 = tot[256 + ch], t3 = tot[384 + ch];
    const float off = (qtr > 0 ? t0 : 0.f) + (qtr > 1 ? t1 : 0.f) + (qtr > 2 ? t2 : 0.f), rr = t0 + t1, bend = (t0 + t1) + (t2 + t3);
    const float er = fexp(rr), ebr = fexp(bend - rr);
    unsigned kh[8], vv[8];
#pragma unroll
    for (int i = 0; i < 16; i += 2) {
        const float E0 = fexp(off + c[i] - rr), E1 = fexp(off + c[i + 1] - rr), I0 = frcp(E0), I1 = frcp(E1);
        const float k0 = 1.f - fexp(R.lf[i]), k1 = 1.f - fexp(R.lf[i + 1]);
        const float ki0 = k0 * I0, ki1 = k1 * I1;
        kh[i >> 1] = pk2(ki0 * ebr, ki1 * ebr);
        vv[i >> 1] = (unsigned)R.v[i] | ((unsigned)R.v[i + 1] << 16);
        const float q0 = bf2f(R.q[i]) * E0, q1 = bf2f(R.q[i + 1]) * E1;
        const int ta = 16 * qtr + i;
        *(LAS unsigned short*)(L + GL_QT + ta * 272 + 2 * ch) = (unsigned short)f2bf(q0);
        *(LAS unsigned short*)(L + GL_QT + (ta + 1) * 272 + 2 * ch) = (unsigned short)f2bf(q1);
        *(LAS unsigned short*)(L + GL_KT + ta * 272 + 2 * ch) = (unsigned short)f2bf(ki0);
        *(LAS unsigned short*)(L + GL_KT + (ta + 1) * 272 + 2 * ch) = (unsigned short)f2bf(ki1);
        *(LAS unsigned short*)(L + GL_QB + ta * 272 + 2 * ch) = (unsigned short)f2bf(q0 * er);
        *(LAS unsigned short*)(L + GL_QB + (ta + 1) * 272 + 2 * ch) = (unsigned short)f2bf(q1 * er);
    }
    *(LAS v4u*)(L + GL_KHT + ch * 144 + 32 * qtr) = (v4u){kh[0], kh[1], kh[2], kh[3]}; *(LAS v4u*)(L + GL_KHT + ch * 144 + 32 * qtr + 16) = (v4u){kh[4], kh[5], kh[6], kh[7]};
    *(LAS v4u*)(L + GL_VT + ch * 144 + 32 * qtr) = (v4u){vv[0], vv[1], vv[2], vv[3]}; *(LAS v4u*)(L + GL_VT + ch * 144 + 32 * qtr + 16) = (v4u){vv[4], vv[5], vv[6], vv[7]};
    if (qtr == 0) *(LAS float*)(L + GL_DEC + 4 * ch) = fexp(bend);
}
DI bf16x8 gfrag(const LAS unsigned char* base, int row, int stride, int kel) { return *(const LAS bf16x8*)(base + row * stride + kel * 2); }
DI void gla_state_update(Frame& F, f32x16 (&S)[2]) {
    const LAS unsigned char* L = F.lds; const int r32 = F.lane & 31, hh = F.lane >> 5, vi = F.wave & 3, ki0 = 2 * (F.wave >> 2);
    bf16x8 a[4];
#pragma unroll
    for (int s = 0; s < 4; ++s) a[s] = gfrag(L + GL_VT, 32 * vi + r32, 144, 16 * s + 8 * hh);
#pragma unroll
    for (int q = 0; q < 2; ++q) { const int kr = 32 * (ki0 + q) + r32; const float d = *(const LAS float*)(L + GL_DEC + 4 * kr);
#pragma unroll
        for (int j = 0; j < 16; ++j) S[q][j] *= d;
#pragma unroll
        for (int s = 0; s < 4; ++s) S[q] = MFMA32(a[s], gfrag(L + GL_KHT, kr, 144, 16 * s + 8 * hh), S[q]); }
}
DI void gla_state_to_lds(Frame& F, const f32x16 (&S)[2]) {
    LAS unsigned char* L = F.lds; const int r32 = F.lane & 31, hh = F.lane >> 5, vi = F.wave & 3, ki0 = 2 * (F.wave >> 2);
#pragma unroll
    for (int q = 0; q < 2; ++q)
#pragma unroll
        for (int j = 0; j < 16; ++j) *(LAS unsigned short*)(L + GL_ST + (32 * vi + crow32(j, hh)) * 272 + 2 * (32 * (ki0 + q) + r32)) = (unsigned short)f2bf(S[q][j]);
}
constexpr int G1_KHT = 0, G1_VT = 67584, G1_TOT = 135168;
DI void gla_unit_state(Frame& F, int u) {
    const int sc = u & 31, dir = (u >> 5) & 1, h = (u >> 6) & 3, b = u >> 8;
    const bf16* V = (const bf16*)(F.ws + WS_V); const _Float16* LF = (const _Float16*)(F.ws + (dir ? WS_LFB : WS_LFF));
    float* ST = (float*)(F.ws + WS_ST) + (size_t)u * 16384; float* DEC = (float*)(F.ws + WS_DEC) + u * 128;
    LAS unsigned char* L = F.lds; LAS float* tot = (LAS float*)(L + G1_TOT);
    const int ch = F.tid & 127, qtr = F.tid >> 7, r32 = F.lane & 31, hh = F.lane >> 5, vi = F.wave & 3, ki0 = 2 * (F.wave >> 2);
    float lf[64]; unsigned vv[32];
#pragma unroll
    for (int i = 0; i < 64; ++i) { const int ii = sc * 256 + 64 * qtr + i; const int tok = dir ? (SEQ - 1 - ii) : ii; const size_t off = (size_t)(b * SEQ + tok) * AW + h * 128 + ch;
        lf[i] = (float)LF[off]; const unsigned x = V[off]; if (i & 1) vv[i >> 1] |= x << 16; else vv[i >> 1] = x; }
    float run = 0.f;
#pragma unroll
    for (int i = 0; i < 64; ++i) run += lf[i];
    __syncthreads();
    tot[qtr * 128 + ch] = run;
#pragma unroll
    for (int i = 0; i < 32; i += 4) *(LAS v4u*)(L + G1_VT + ch * 528 + 128 * qtr + 4 * i) = (v4u){vv[i], vv[i + 1], vv[i + 2], vv[i + 3]};
    __syncthreads();
    const float t0 = tot[ch], t1 = tot[128 + ch], t2 = tot[256 + ch], t3 = tot[384 + ch];
    const float bend = (t0 + t1) + (t2 + t3);
    run = (qtr > 0 ? t0 : 0.f) + (qtr > 1 ? t1 : 0.f) + (qtr > 2 ? t2 : 0.f);
#pragma unroll
    for (int i = 0; i < 64; i += 2) { const float b0 = run + lf[i], b1 = b0 + lf[i + 1]; run = b1;
        vv[i >> 1] = pk2((1.f - fexp(lf[i])) * fexp(bend - b0), (1.f - fexp(lf[i + 1])) * fexp(bend - b1)); }
#pragma unroll
    for (int i = 0; i < 32; i += 4) *(LAS v4u*)(L + G1_KHT + ch * 528 + 128 * qtr + 4 * i) = (v4u){vv[i], vv[i + 1], vv[i + 2], vv[i + 3]};
    if (qtr == 0) DEC[ch] = fexp(bend);
    __syncthreads();
    f32x16 S[2];
#pragma unroll
    for (int j = 0; j < 16; ++j) { S[0][j] = 0.f; S[1][j] = 0.f; }
#pragma unroll 4
    for (int s = 0; s < 16; ++s) { const bf16x8 av = gfrag(L + G1_VT, 32 * vi + r32, 528, 16 * s + 8 * hh);
        S[0] = MFMA32(av, gfrag(L + G1_KHT, 32 * ki0 + r32, 528, 16 * s + 8 * hh), S[0]);
        S[1] = MFMA32(av, gfrag(L + G1_KHT, 32 * (ki0 + 1) + r32, 528, 16 * s + 8 * hh), S[1]); }
#pragma unroll
    for (int q = 0; q < 2; ++q)
#pragma unroll
        for (int g = 0; g < 4; ++g) *(f32x4*)(ST + (size_t)(32 * (ki0 + q) + r32) * 128 + 32 * vi + 8 * g + 4 * hh) = (f32x4){S[q][4 * g], S[q][4 * g + 1], S[q][4 * g + 2], S[q][4 * g + 3]};
}
DI int red16h_idx(int lane) { return 8 * ((lane >> 4) & 1) + 4 * ((lane >> 3) & 1) + 2 * ((lane >> 2) & 1) + ((lane >> 1) & 1); }
DI float red16h(const float (&o)[16], int lane) {
    const bool b16 = lane & 16, b8 = lane & 8, b4 = lane & 4, b2 = lane & 2;
    float a8[8], a4[4], a2[2], a1;
#pragma unroll
    for (int j = 0; j < 8; ++j) { const float send = b16 ? o[j] : o[j + 8], keep = b16 ? o[j + 8] : o[j]; a8[j] = keep + __shfl_xor(send, 16); }
#pragma unroll
    for (int j = 0; j < 4; ++j) { const float send = b8 ? a8[j] : a8[j + 4], keep = b8 ? a8[j + 4] : a8[j]; a4[j] = keep + __shfl_xor(send, 8); }
#pragma unroll
    for (int j = 0; j < 2; ++j) { const float send = b4 ? a4[j] : a4[j + 2], keep = b4 ? a4[j + 2] : a4[j]; a2[j] = keep + __shfl_xor(send, 4); }
    { const float send = b2 ? a2[0] : a2[1], keep = b2 ? a2[1] : a2[0]; a1 = keep + __shfl_xor(send, 2); }
    a1 += __shfl_xor(a1, 1);
    return a1;
}
constexpr int GL_RS = 135680;
template <bool FUSE> DI void gla_unit_out(Frame& F, const Args& a, int u) {
    const int sc = u & 31, dir = (u >> 5) & 1, h = (u >> 6) & 3, b = u >> 8;
    const bf16* Q = (const bf16*)(F.ws + WS_Q); const bf16* V = (const bf16*)(F.ws + WS_V); const _Float16* LF = (const _Float16*)(F.ws + (dir ? WS_LFB : WS_LFF));
    const float* ST = (const float*)(F.ws + WS_ST) + (size_t)u * 16384; float* OF = (float*)(F.ws + WS_ODIR);
    const bf16* G = (const bf16*)(F.ws + WS_G); bf16* CAT = (bf16*)(F.ws + WS_CAT);
    const LAS unsigned char* L = F.lds;
    const int ch = F.tid & 127, qtr = F.tid >> 7, r32 = F.lane & 31, hh = F.lane >> 5, w = F.wave, vi = w & 3, ki0 = 2 * (w >> 2), ti = w >> 2;
    f32x16 S[2];
#pragma unroll
    for (int q = 0; q < 2; ++q)
#pragma unroll
        for (int g = 0; g < 4; ++g) { const f32x4 t = *(const f32x4*)(ST + (size_t)(32 * (ki0 + q) + r32) * 128 + 32 * vi + 8 * g + 4 * hh); S[q][4 * g] = t.x; S[q][4 * g + 1] = t.y; S[q][4 * g + 2] = t.z; S[q][4 * g + 3] = t.w; }
    GlaRaw cur, nxt;
    gla_load_raw<true>(cur, LF, Q, V, b, h, dir, sc * 256 + 16 * qtr, ch);
    __syncthreads();
    gla_state_to_lds(F, S);
    const float ngv = FUSE ? a.in[11][h * 128 + 32 * vi + r32] : 0.f;
#pragma unroll 1
    for (int c = 0; c < 4; ++c) {
        gla_prep(F, cur);
        if (c < 3) gla_load_raw<true>(nxt, LF, Q, V, b, h, dir, sc * 256 + (c + 1) * 64 + 16 * qtr, ch);
        float of[16]; unsigned short gg[16];
        if (FUSE) {
#pragma unroll
            for (int j = 0; j < 16; ++j) { const int ii = sc * 256 + c * 64 + 32 * ti + crow32(j, hh); const int tok = dir ? (SEQ - 1 - ii) : ii; const size_t o = (size_t)(b * SEQ + tok) * AW + h * 128 + 32 * vi + r32;
                of[j] = OF[o]; gg[j] = G[o]; }
        }
        __syncthreads();
        f32x16 o;
#pragma unroll
        for (int j = 0; j < 16; ++j) o[j] = 0.f;
#pragma unroll
        for (int s = 0; s < 8; ++s) o = MFMA32(gfrag(L + GL_QB, 32 * ti + r32, 272, 16 * s + 8 * hh), gfrag(L + GL_ST, 32 * vi + r32, 272, 16 * s + 8 * hh), o);
        if (w < 3) {
            const int tp = (w + 1) >> 1, sp = (w == 2) ? 1 : 0;
            f32x16 p;
#pragma unroll
            for (int j = 0; j < 16; ++j) p[j] = 0.f;
#pragma unroll
            for (int s = 0; s < 8; ++s) p = MFMA32(gfrag(L + GL_QT, 32 * tp + r32, 272, 16 * s + 8 * hh), gfrag(L + GL_KT, 32 * sp + r32, 272, 16 * s + 8 * hh), p);
#pragma unroll
            for (int j = 0; j < 16; ++j) { const int t = 32 * tp + crow32(j, hh), s2 = 32 * sp + r32;
                *(LAS unsigned short*)(F.lds + GL_P + t * 144 + 2 * s2) = (s2 <= t) ? (unsigned short)f2bf(p[j]) : (unsigned short)0; }
        }
        __syncthreads();
        { const int ns = ti ? 4 : 2;
#pragma unroll
          for (int s = 0; s < 4; ++s) if (s < ns) o = MFMA32(gfrag(L + GL_P, 32 * ti + r32, 144, 16 * s + 8 * hh), gfrag(L + GL_VT, 32 * vi + r32, 144, 16 * s + 8 * hh), o); }
        if (!FUSE) {
#pragma unroll
            for (int j = 0; j < 16; ++j) { const int ii = sc * 256 + c * 64 + 32 * ti + crow32(j, hh); const int tok = dir ? (SEQ - 1 - ii) : ii;
                OF[(size_t)(b * SEQ + tok) * AW + h * 128 + 32 * vi + r32] = o[j]; }
        } else {
            float sq[16];
#pragma unroll
            for (int j = 0; j < 16; ++j) { o[j] += of[j]; sq[j] = o[j] * o[j]; }
            const float part = red16h(sq, F.lane);
            if ((F.lane & 1) == 0) *(LAS float*)(F.lds + GL_RS + ((ti * 32 + crow32(red16h_idx(F.lane), hh)) * 4 + vi) * 4) = part;
        }
        if (c < 3) { gla_state_update(F, S); gla_state_to_lds(F, S); }
        cur = nxt;
        __syncthreads();
        if (FUSE) {
#pragma unroll
            for (int j = 0; j < 16; ++j) { const int row = crow32(j, hh); const f32x4 ps = *(const LAS f32x4*)(L + GL_RS + (ti * 32 + row) * 16);
                const float rstd = 1.f / sqrtf(((ps.x + ps.y) + (ps.z + ps.w)) * (1.f / 128.f) + EPS);
                const int ii = sc * 256 + c * 64 + 32 * ti + row; const int tok = dir ? (SEQ - 1 - ii) : ii;
                CAT[(size_t)(b * SEQ + tok) * DM + 512 + h * 128 + 32 * vi + r32] = (bf16)f2bf(o[j] * rstd * ngv * bf2f(gg[j])); }
        }
    }
}

__global__ void __launch_bounds__(NTHR, 2) fwd_kernel(Args args) {
    extern __shared__ __attribute__((aligned(16))) unsigned char lds[];
    Frame F;
    F.lds = (LAS unsigned char*)lds;
    F.MISC = (volatile LAS unsigned*)(F.lds + MISC_OFF);
    F.tid = threadIdx.x; F.lane = F.tid & 63; F.wave = __builtin_amdgcn_readfirstlane(F.tid >> 6);
    F.G = gridDim.x; F.bid = blockIdx.x; F.gw = F.bid * NWAVES + F.wave; F.NGW = F.G * NWAVES;
    F.ws = args.ws;
    unsigned* ctl = (unsigned*)(args.ws + WS_CTL);
    for (int u = F.tid; u < (LDS_BYTES - LDSCTL_OFF) / 4; u += NTHR) ((LAS unsigned*)(F.lds + LDSCTL_OFF))[u] = 0u;
    __syncthreads();
    const int lo = args.ph_lo, hi = args.ph_hi;
    XcdBarrier bar; bar.bar = ctl + CW_BAR + args.li * XCD_BAR_WORDS; bar.x = 0; bar.st = nullptr;
    if (hi - lo > 1) bar = xcd_barrier_post(ctl + CW_BAR + args.li * XCD_BAR_WORDS, F.MISC + 8);
#define IN(k) (lo <= (k) && (k) < hi)
#ifndef PROBE_DUP
#define PROBE_DUP (-1)
#endif
#define REP(k) for (int rep_ = 0; rep_ < (((PROBE_DUP) == (k)) ? 2 : 1); ++rep_)
#define SEAM(k) do { if (IN(k) && IN((k) + 1)) { xcd_barrier(bar); if (PROBE_DUP == 99) xcd_barrier(bar); } } while (0)
    unsigned char* ws = args.ws;
    float* XR = args.out;

    if (IN(0)) REP(0) { phase_prologue(F, args); } SEAM(0);
    if (IN(1)) {
        pg8::Gemm g{(const bf16*)(ws + WS_H), (const bf16*)(ws + WS_WIN), MTOK, NIN, DM}; pg8::StaticOrder S; S.init(MTOK, NIN, F.G, F.bid);
        EpiInProj E{(bf16*)(ws + WS_U), (bf16*)(ws + WS_GV), (bf16*)(ws + WS_Q), (bf16*)(ws + WS_V), (bf16*)(ws + WS_G), (_Float16*)(ws + WS_LFF), (_Float16*)(ws + WS_LFB), (const float*)(ws + WS_LB)};
        pg8::gemm_phase<EpiInProj, pg8::StaticOrder, true, true>(F.lds, g, S, E);
        if (PROBE_DUP == 1) pg8::gemm_phase<EpiInProj, pg8::StaticOrder, true, true>(F.lds, g, S, E);
    } SEAM(1);
    if (IN(2)) { phase_a_mix(F, args); REP(2) for (int u = F.bid; u < 512; u += F.G) gla_unit_state(F, u); } SEAM(2);
    if (IN(3)) { phase_gla_scan(F); } SEAM(3);
    if (IN(4)) { for (int i = F.bid; i < 256; i += F.G) gla_unit_out<false>(F, args, ((i >> 5) << 6) | (i & 31)); } SEAM(4);
    if (IN(5)) { for (int i = F.bid; i < 256; i += F.G) gla_unit_out<true>(F, args, ((i >> 5) << 6) | 32 | (i & 31)); } SEAM(5);
    if (IN(6)) REP(6) {
        pg8::Gemm g{(const bf16*)(ws + WS_CAT), (const bf16*)(ws + WS_WOUT), MTOK, DM, DM}; pg8::StaticOrder S; S.init(MTOK, DM, F.G, F.bid);
        EpiResid E{args.in[0], XR};
        pg8::gemm_phase<EpiResid, pg8::StaticOrder, true, true>(F.lds, g, S, E);
    } SEAM(6);
#define MOE_BLOCK(L, pb) do { \
        if (IN(pb)) REP(pb) { phase_router(F, XR, args.in[2] + (L) * DM, args.in[15] + (L) * DM * NEXP); } SEAM(pb); \
        if (IN((pb) + 1)) { REP((pb) + 1) phase_topk(F); convert_moe_weights(F, args.in[16], args.in[17], args.in[18], (L), (F.G > 64) ? 32 : 0); } SEAM((pb) + 1);     \
        if (IN((pb) + 2)) {     \
            pg8::Gemm g{(const bf16*)(ws + WS_H), (const bf16*)(ws + WS_WGU), NROWS, 16 * 2048, DM}; GroupedOrder<8> S{F.G, F.bid}; \
            EpiGateUp E{(bf16*)(ws + WS_HMID)}; \
            LAS int* rowtab = (LAS int*)(F.lds + RING_BYTES); const int* IDX = (const int*)(ws + WS_IDX); \
            for (int i = 0; i < 4; ++i) { pg8::Unit uu; if (!S.next(i, uu)) break; if (F.tid < 256) rowtab[i * 256 + F.tid] = IDX[uu.pm * 256 + F.tid]; } \
            __syncthreads(); \
            pg8::gemm_phase<EpiGateUp, GroupedOrder<8>, true, true, true>(F.lds, g, S, E, rowtab); \
            if (PROBE_DUP == (pb) + 2) pg8::gemm_phase<EpiGateUp, GroupedOrder<8>, true, true, true>(F.lds, g, S, E, rowtab); \
        } SEAM((pb) + 2); \
        if (IN((pb) + 3)) { \
            pg8::Gemm g{(const bf16*)(ws + WS_HMID), (const bf16*)(ws + WS_WDN), NROWS, 16 * 1024, DFF}; GroupedOrder<4> S{F.G, F.bid}; \
            EpiDown E{(bf16*)(ws + WS_Y), (const float*)(ws + WS_GATE)}; \
            pg8::gemm_phase<EpiDown, GroupedOrder<4>, true, true>(F.lds, g, S, E); \
            if (PROBE_DUP == (pb) + 3) pg8::gemm_phase<EpiDown, GroupedOrder<4>, true, true>(F.lds, g, S, E); \
        } SEAM((pb) + 3); \
    } while (0)

    MOE_BLOCK(0, 7);
    if (IN(11)) { if (PROBE_DUP == 32) phase_moe_combine(F, XR, args.in[1] + DM, false, true); phase_moe_combine(F, XR, args.in[1] + DM, false); } SEAM(11);
    if (IN(12)) REP(12) {
        pg8::Gemm g{(const bf16*)(ws + WS_H), (const bf16*)(ws + WS_WQKV), MTOK, NQKV, DM}; pg8::StaticOrder S; S.init(MTOK, NQKV, F.G, F.bid);
        EpiQKV E{(bf16*)(ws + WS_QKV)};
        pg8::gemm_phase<EpiQKV, pg8::StaticOrder, true, true>(F.lds, g, S, E);
    } SEAM(12);
    if (IN(13)) REP(13) { phase_kvf(F); } SEAM(13);
    if (IN(14)) REP(14) { phase_attn(F); } SEAM(14);
    if (IN(15)) {
        pg8::Gemm g{(const bf16*)(ws + WS_ATT), (const bf16*)(ws + WS_WO), MTOK, DM, DM}; pg8::StaticOrder S; S.init(MTOK, DM, F.G, F.bid);
        EpiResid E{XR, XR};
        pg8::gemm_phase<EpiResid, pg8::StaticOrder, true, true>(F.lds, g, S, E);
    } SEAM(15);
    MOE_BLOCK(1, 16);
    if (IN(20)) { if (PROBE_DUP == 33) phase_moe_combine(F, XR, args.in[3], true, true); phase_moe_combine(F, XR, args.in[3], true); }
#undef MOE_BLOCK
#undef IN
#undef SEAM
}

#ifndef MK_N_LAUNCHES
#define MK_N_LAUNCHES 1
#endif
extern "C" void kernel_launch(void* const* d_in, const int* in_sizes, int n_in, void* d_out, int out_size, void* d_ws, size_t ws_size, hipStream_t stream) {
    static int grid = 0;
    if (grid == 0) {
        if (n_in != 19 || in_sizes[0] != MTOK * DM || out_size != MTOK * DM || ws_size < WS_END) { fprintf(stderr, "kernel_launch: unexpected shapes (n_in %d, in0 %d, out %d, ws %zu < %zu); nothing launched\n", n_in, n_in > 0 ? in_sizes[0] : -1, out_size, ws_size, (size_t)WS_END); grid = -1; return; }
        int dev = 0, cus = 0, per_cu = 0;
        if (hipGetDevice(&dev) != hipSuccess || hipDeviceGetAttribute(&cus, hipDeviceAttributeMultiprocessorCount, dev) != hipSuccess) { grid = -1; return; }
        if (hipFuncSetAttribute((const void*)fwd_kernel, hipFuncAttributeMaxDynamicSharedMemorySize, LDS_BYTES) != hipSuccess) { fprintf(stderr, "kernel_launch: hipFuncSetAttribute failed\n"); grid = -1; return; }
        if (hipOccupancyMaxActiveBlocksPerMultiprocessor(&per_cu, (const void*)fwd_kernel, NTHR, LDS_BYTES) != hipSuccess || per_cu < 1) { fprintf(stderr, "kernel_launch: occupancy query reports %d workgroups per CU\n", per_cu); }
        (void)hipGetLastError();
        grid = cus;
    }
    if (grid < 0) return;
    if (hipMemsetAsync((char*)d_ws + WS_CTL, 0, CTL_ZERO_BYTES, stream) != hipSuccess) return;
    Args a{};
    for (int i = 0; i < 19; ++i) a.in[i] = (const float*)d_in[i];
    a.out = (float*)d_out; a.ws = (unsigned char*)d_ws; a.pad = 0;
    static_assert(CW_BAR + MAX_BAR_REGIONS * XCD_BAR_WORDS <= (int)(CTL_ZERO_BYTES / 4), "barrier regions inside the memset region");
#ifdef PROBE_PREFIX
    const int nl = 2;
    for (int li = 0; li < nl; ++li) {
        a.ph_lo = 0; a.ph_hi = (li == 0) ? PROBE_PREFIX : NPHASE; a.li = li;
#else
    const int nl = MK_N_LAUNCHES;
    for (int li = 0; li < nl; ++li) {
        a.ph_lo = (int)((long)NPHASE * li / nl); a.ph_hi = (int)((long)NPHASE * (li + 1) / nl); a.li = li;
#endif
        hipLaunchKernelGGL(fwd_kernel, dim3(grid), dim3(NTHR), LDS_BYTES, stream, a);
        const hipError_t le = hipPeekAtLastError();
        if (le != hipSuccess) { fprintf(stderr, "kernel_launch: launch %d failed: %s\n", li, hipGetErrorName(le)); break; }
    }
}
```

```cpp
#include <hip/hip_runtime.h>
#include <cstdio>
#include <cstdint>
namespace pg8 {
#define PG8_LAS __attribute__((address_space(3)))
typedef unsigned short bf16_t;
typedef short bf16x8 __attribute__((ext_vector_type(8)));
typedef float f32x4 __attribute__((ext_vector_type(4)));
typedef unsigned u32x4 __attribute__((ext_vector_type(4)));
constexpr int BM = 256, BK = 64, HALF = 128, HTB = HALF * BK * 2  , STAGE_BYTES = 8 * HTB, NXCD = 8, WGM = 8;

__host__ __device__ __forceinline__ int lds_byte(int r, int c) { const int st = (r >> 4) * 2 + (c >> 5), rr = r & 15, cc = c & 31, ob = rr * 64 + cc * 2; return st * 1024 + (ob ^ (((ob >> 9) & 1) << 5)); }
__host__ __device__ __forceinline__ void stage_rc(int b, int& R, int& C) { const int st = b / 1024, sb = b % 1024, swz = sb ^ (((sb >> 9) & 1) << 5); R = (st >> 1) * 16 + swz / 64; C = (st & 1) * 32 + (swz % 64) / 2; }
__host__ __device__ __forceinline__ int perm32(int rho) { const int n = rho >> 4, i = rho & 15; return 8 * (i >> 2) + 4 * n + (i & 3); }

struct Unit { int pm, pn; };
struct Gemm { const bf16_t* A; const bf16_t* Bt; int M, N, K; };

struct StaticOrder {
    int nM, nN, nwg, G, c;
    __host__ __device__ void init(int M, int N, int G_, int c_) { nM = M / BM; nN = N / BM; nwg = nM * nN; G = G_; c = c_; }
    __host__ __device__ bool next(int i, Unit& u) const {
        const long L = (long)i * G + c; if (L >= nwg) return false;
        int wgid = (int)L; { const int q = nwg / NXCD, r = nwg % NXCD, xcd = wgid % NXCD, off = wgid / NXCD; wgid = (xcd < r ? xcd * (q + 1) : r * (q + 1) + (xcd - r) * q) + off; }
        const int nig = WGM * nN, gid = wgid / nig, fm = gid * WGM, gsz = (nM - fm) < WGM ? (nM - fm) : WGM;
        u.pm = fm + ((wgid % nig) % gsz); u.pn = (wgid % nig) / gsz; return true;
    }
    __device__ __forceinline__ void a_ready(const Unit&) const {}
    __device__ __forceinline__ void done(const Unit&) const {}
};

__device__ __forceinline__ unsigned cvt_pk_bf16(float lo, float hi) { unsigned r; asm volatile("v_cvt_pk_bf16_f32 %0, %1, %2" : "=v"(r) : "v"(lo), "v"(hi)); return r; }
typedef float f32x2 __attribute__((ext_vector_type(2)));
__device__ __forceinline__ f32x2 gelu_pk(f32x2 v) {
    const f32x2 av = __builtin_elementwise_abs(v), d = av * 0.2316418882f + 1.0f;
    f32x2 t; t.x = __builtin_amdgcn_rcpf(d.x); t.y = __builtin_amdgcn_rcpf(d.y);
    f32x2 q = t * 0.5307027145f + (-0.7265760135f); q = q * t + 0.7107068705f; q = q * t + (-0.142248368f); q = q * t + 0.127414796f; q = q * t;
    const f32x2 s = (v * v) * (-0.72134752044f);
    f32x2 e; e.x = __builtin_amdgcn_exp2f(s.x); e.y = __builtin_amdgcn_exp2f(s.y);
    const f32x2 m = v * (q * e), r = v - m;
    f32x2 o; o.x = v.x < 0.f ? m.x : r.x; o.y = v.y < 0.f ? m.y : r.y; return o;
}

template <int ACT  > struct EpiBf16 {
    static constexpr bool PERM = true, AFTER_DRAIN = false; static_assert(ACT == 0 || ACT == 1, "EpiBf16: ACT is 0 (none) or 1 (gelu_pk)");
    bf16_t* O; int ldc; const float* bias; int split_cols; size_t split_stride; float scale0;
    __device__ __forceinline__ void operator()(const f32x4 (&acc)[2][2][4][2], const Unit& u, int wr, int wc, int fr, int fq) const {
        const int row0 = u.pm * BM + wr * 64 + fr; int colt = u.pn * BM; bf16_t* base = O;
        float sc = 1.f; if (split_cols) { const int t = colt / split_cols; base += (size_t)t * split_stride; colt -= t * split_cols; if (t == 0) sc = scale0; }
        const int col0 = colt + wc * 32 + 8 * fq, bcol0 = u.pn * BM + wc * 32 + 8 * fq;
        f32x4 bv[2][2];
#pragma unroll
        for (int bj = 0; bj < 2; ++bj)
#pragma unroll
            for (int n = 0; n < 2; ++n) bv[bj][n] = bias ? *(const f32x4*)(bias + bcol0 + bj * HALF + 4 * n) : (f32x4){0.f, 0.f, 0.f, 0.f};
#pragma unroll
        for (int ai = 0; ai < 2; ++ai)
#pragma unroll
            for (int m = 0; m < 4; ++m) { bf16_t* rowp = base + (size_t)(row0 + ai * HALF + m * 16) * ldc + col0;
#pragma unroll
                for (int bj = 0; bj < 2; ++bj) { f32x4 v0 = acc[ai][bj][m][0] + bv[bj][0], v1 = acc[ai][bj][m][1] + bv[bj][1];
                    if (ACT == 1) { f32x2 a = gelu_pk((f32x2){v0[0], v0[1]}), b = gelu_pk((f32x2){v0[2], v0[3]}), c = gelu_pk((f32x2){v1[0], v1[1]}), d = gelu_pk((f32x2){v1[2], v1[3]});
                        v0 = (f32x4){a.x, a.y, b.x, b.y}; v1 = (f32x4){c.x, c.y, d.x, d.y}; }
                    v0 = v0 * sc; v1 = v1 * sc; u32x4 w; w.x = cvt_pk_bf16(v0[0], v0[1]); w.y = cvt_pk_bf16(v0[2], v0[3]); w.z = cvt_pk_bf16(v1[0], v1[1]); w.w = cvt_pk_bf16(v1[2], v1[3]);
                    *(u32x4*)(rowp + bj * HALF) = w; } }
    }
};
template <class Epi, class Sched, bool ALIGN_EPI = false, bool SP2 = false, bool GATHER = false>
__device__ __forceinline__ void gemm_phase(PG8_LAS unsigned char* lds, const Gemm g, const Sched& S, const Epi& E, const PG8_LAS int* rowtab = nullptr) {
    const int tid = threadIdx.x, wid = __builtin_amdgcn_readfirstlane(tid >> 6), lane = tid & 63, wr = wid >> 2, wc = wid & 3, fr = lane & 15, fq = lane >> 4;
    const int K = g.K, nt = K / BK;
    unsigned voffA[2], voffB[2]; int gR[2], gC[2];
#pragma unroll
    for (int i = 0; i < 2; ++i) { int R, C; stage_rc(tid * 16 + i * 8192, R, C); const int Rb = Epi::PERM ? ((R & ~31) + perm32(R & 31)) : R;
        voffA[i] = (unsigned)(R * K + C) * 2u; voffB[i] = (unsigned)(Rb * K + C) * 2u; gR[i] = R; gC[i] = C; }
    unsigned vC[2][2] = {{0u, 0u}, {0u, 0u}}, vN[2][2] = {{0u, 0u}, {0u, 0u}};
#define PG8_ROWS(dst, ui_) do { _Pragma("unroll") for (int _h = 0; _h < 2; ++_h) _Pragma("unroll") for (int _i = 0; _i < 2; ++_i) \
        dst[_h][_i] = (unsigned)(rowtab[(ui_) * 256 + _h * 128 + gR[_i]] * K + gC[_i]) * 2u; } while (0)
    const size_t kstep = (size_t)(BK * 2);
    const size_t hstep = (size_t)HALF * K * 2;
    const size_t tstep = 2 * hstep;
    const unsigned ldsw = (unsigned)wid * 1024u;
    const int aoff = lds_byte(wr * 64 + fr, fq * 8), boff = lds_byte(wc * 32 + fr, fq * 8);
#define PG8_SA(b, h) (((b) * 2 + (h)) * HTB)
#define PG8_SB(b, h) ((4 + (b) * 2 + (h)) * HTB)
#define PG8_STAGE(bufoff, gbase, voff) do { _Pragma("unroll") for (int _i = 0; _i < 2; ++_i) \
        __builtin_amdgcn_global_load_lds((const unsigned*)((const char*)(gbase) + (voff)[_i]), (PG8_LAS unsigned*)(lds + (bufoff) + ldsw + _i * 8192), 16, 0, 0); } while (0)
#define PG8_STGA(bufoff, abase, half, V) do { _Pragma("unroll") for (int _i = 0; _i < 2; ++_i) \
        __builtin_amdgcn_global_load_lds((const unsigned*)((const char*)(abase) + (GATHER ? (size_t)V[half][_i] : (size_t)((half) ? hstep : 0) + voffA[_i])), (PG8_LAS unsigned*)(lds + (bufoff) + ldsw + _i * 8192), 16, 0, 0); } while (0)
#define PG8_LDA(dst, b, h) do { _Pragma("unroll") for (int m = 0; m < 4; ++m) _Pragma("unroll") for (int k = 0; k < 2; ++k) dst[m][k] = *(const PG8_LAS bf16x8*)(lds + PG8_SA(b, h) + aoff + m * 2048 + k * 1024); } while (0)
#define PG8_LDB(dst, b, h) do { _Pragma("unroll") for (int n = 0; n < 2; ++n) _Pragma("unroll") for (int k = 0; k < 2; ++k) dst[n][k] = *(const PG8_LAS bf16x8*)(lds + PG8_SB(b, h) + boff + n * 2048 + k * 1024); } while (0)
#define PG8_MMA(ai, bj, At, Bt) do { __builtin_amdgcn_s_setprio(1); _Pragma("unroll") for (int m = 0; m < 4; ++m) _Pragma("unroll") for (int n = 0; n < 2; ++n) _Pragma("unroll") for (int k = 0; k < 2; ++k) \
        acc[ai][bj][m][n] = __builtin_amdgcn_mfma_f32_16x16x32_bf16(Bt[n][k], At[m][k], acc[ai][bj][m][n], 0, 0, 0); __builtin_amdgcn_s_setprio(0); } while (0)
#define PG8_WAIT_V(n) asm volatile("s_waitcnt vmcnt(" #n ")" ::: "memory")
#define PG8_WAIT_L(n) asm volatile("s_waitcnt lgkmcnt(" #n ")" ::: "memory")
#define PG8_BAR __builtin_amdgcn_s_barrier()
#define PG8_SCHED __builtin_amdgcn_sched_barrier(0)
    Unit cur, nxt; int ui = 0;
    if (!S.next(0, cur)) return;
    f32x4 acc[2][2][4][2];
#pragma unroll
    for (int a = 0; a < 2; ++a)
#pragma unroll
        for (int b = 0; b < 2; ++b)
#pragma unroll
            for (int m = 0; m < 4; ++m)
#pragma unroll
                for (int n = 0; n < 2; ++n) acc[a][b][m][n] = (f32x4){0.f, 0.f, 0.f, 0.f};
    bf16x8 At[4][2], B0[2][2], B1[2][2];
    const char* cA = (const char*)g.A + (GATHER ? (size_t)0 : (size_t)cur.pm * tstep); if constexpr (GATHER) PG8_ROWS(vC, 0);
    const char* cB = (const char*)g.Bt + (size_t)cur.pn * tstep;
    S.a_ready(cur);
    if constexpr (SP2) {
        PG8_STAGE(PG8_SB(0, 0), cB, voffB); PG8_STAGE(PG8_SB(0, 1), cB + hstep, voffB); PG8_STGA(PG8_SA(0, 0), cA, 0, vC); PG8_STGA(PG8_SA(0, 1), cA, 1, vC);
        if (wr == 1) PG8_BAR;
        PG8_WAIT_V(2); PG8_BAR;
        PG8_STAGE(PG8_SB(1, 0), cB + kstep, voffB); PG8_STGA(PG8_SA(1, 0), cA + kstep, 0, vC); PG8_STAGE(PG8_SB(1, 1), cB + hstep + kstep, voffB);
        PG8_WAIT_V(6); PG8_BAR;
    } else {
        PG8_STAGE(PG8_SB(0, 0), cB, voffB); PG8_STGA(PG8_SA(0, 0), cA, 0, vC); PG8_STAGE(PG8_SB(0, 1), cB + hstep, voffB); PG8_STGA(PG8_SA(0, 1), cA, 1, vC);
        if (wr == 1) PG8_BAR;
        PG8_WAIT_V(4); PG8_BAR;
        PG8_STAGE(PG8_SB(1, 0), cB + kstep, voffB); PG8_STGA(PG8_SA(1, 0), cA + kstep, 0, vC); PG8_STAGE(PG8_SB(1, 1), cB + hstep + kstep, voffB);
        PG8_WAIT_V(6); PG8_BAR;
    }
    for (;;) {
        const bool has_next = S.next(ui + 1, nxt);
        const char* nA = (has_next && !GATHER) ? (const char*)g.A + (size_t)nxt.pm * tstep : cA;
        if constexpr (GATHER) { if (has_next) PG8_ROWS(vN, ui + 1); else { _Pragma("unroll") for (int _h = 0; _h < 2; ++_h) _Pragma("unroll") for (int _i = 0; _i < 2; ++_i) vN[_h][_i] = vC[_h][_i]; } }
        const char* nB = has_next ? (const char*)g.Bt + (size_t)nxt.pn * tstep : cB;
        for (int t = 0; t < nt; t += 2) {
            const bool last = (t == nt - 2);
            unsigned vX[2][2];
            _Pragma("unroll") for (int _h = 0; _h < 2; ++_h) _Pragma("unroll") for (int _i = 0; _i < 2; ++_i) vX[_h][_i] = last ? vN[_h][_i] : vC[_h][_i];
            const char* a1 = cA + (size_t)(t + 1) * kstep;
            const char* a2 = last ? nA : cA + (size_t)(t + 2) * kstep; const char* b2 = last ? nB : cB + (size_t)(t + 2) * kstep;
            const char* a3 = a2 + kstep; const char* b3 = b2 + kstep;
            if (last && has_next) S.a_ready(nxt);
            if constexpr (SP2) {
            PG8_LDB(B0, 0, 0); PG8_LDB(B1, 0, 1); PG8_SCHED; PG8_LDA(At, 0, 0); PG8_STGA(PG8_SA(1, 1), a1, 1, vC);
            PG8_WAIT_V(8); PG8_WAIT_L(0); PG8_BAR; PG8_MMA(0, 0, At, B0); PG8_MMA(0, 1, At, B1); PG8_BAR; PG8_SCHED;
            PG8_LDA(At, 0, 1); PG8_STAGE(PG8_SB(0, 0), b2, voffB); PG8_STAGE(PG8_SB(0, 1), b2 + hstep, voffB); PG8_STGA(PG8_SA(0, 0), a2, 0, vX);
            PG8_WAIT_V(8); PG8_WAIT_L(0); PG8_BAR; PG8_MMA(1, 0, At, B0); PG8_MMA(1, 1, At, B1); PG8_BAR; PG8_SCHED;
            PG8_LDB(B0, 1, 0); PG8_LDB(B1, 1, 1); PG8_SCHED; PG8_LDA(At, 1, 0); PG8_STGA(PG8_SA(0, 1), a2, 1, vX);
            PG8_WAIT_V(8); PG8_WAIT_L(0); PG8_BAR; PG8_MMA(0, 0, At, B0); PG8_MMA(0, 1, At, B1); PG8_BAR; PG8_SCHED;
            PG8_LDA(At, 1, 1); PG8_STAGE(PG8_SB(1, 0), b3, voffB); PG8_STAGE(PG8_SB(1, 1), b3 + hstep, voffB); PG8_STGA(PG8_SA(1, 0), a3, 0, vX);
            PG8_WAIT_V(8); PG8_WAIT_L(0); PG8_BAR; PG8_MMA(1, 0, At, B0); PG8_MMA(1, 1, At, B1); PG8_BAR; PG8_SCHED;
            } else {
            PG8_LDB(B0, 0, 0); PG8_SCHED; PG8_LDA(At, 0, 0); PG8_STGA(PG8_SA(1, 1), a1, 1, vC);
            PG8_WAIT_L(8); PG8_BAR; PG8_WAIT_L(0); PG8_MMA(0, 0, At, B0); PG8_BAR; PG8_SCHED;
            PG8_LDB(B1, 0, 1); PG8_STAGE(PG8_SB(0, 0), b2, voffB);
            PG8_BAR; PG8_WAIT_L(0); PG8_MMA(0, 1, At, B1); PG8_BAR;
            PG8_LDA(At, 0, 1); PG8_STGA(PG8_SA(0, 0), a2, 0, vX);
            PG8_BAR; PG8_WAIT_L(0); PG8_MMA(1, 0, At, B0); PG8_BAR; PG8_SCHED;
            PG8_STAGE(PG8_SB(0, 1), b2 + hstep, voffB);
            PG8_WAIT_V(6); PG8_BAR; PG8_MMA(1, 1, At, B1); PG8_BAR;
            PG8_LDB(B0, 1, 0); PG8_SCHED; PG8_LDA(At, 1, 0); PG8_STGA(PG8_SA(0, 1), a2, 1, vX);
            PG8_WAIT_L(8); PG8_BAR; PG8_WAIT_L(0); PG8_MMA(0, 0, At, B0); PG8_BAR; PG8_SCHED;
            PG8_LDB(B1, 1, 1); PG8_STAGE(PG8_SB(1, 0), b3, voffB);
            PG8_BAR; PG8_WAIT_L(0); PG8_MMA(0, 1, At, B1); PG8_BAR;
            PG8_LDA(At, 1, 1); PG8_STGA(PG8_SA(1, 0), a3, 0, vX);
            PG8_BAR; PG8_WAIT_L(0); PG8_MMA(1, 0, At, B0); PG8_BAR; PG8_SCHED;
            PG8_STAGE(PG8_SB(1, 1), b3 + hstep, voffB);
            PG8_WAIT_V(6); PG8_BAR; PG8_MMA(1, 1, At, B1); PG8_BAR;
            }
        }
        if constexpr (ALIGN_EPI) { if (wr == 0) PG8_BAR; }
        if constexpr (!Epi::AFTER_DRAIN) { E(acc, cur, wr, wc, fr, fq); S.done(cur); }
        if (!has_next) break;
#pragma unroll
        for (int a = 0; a < 2; ++a)
#pragma unroll
            for (int b = 0; b < 2; ++b)
#pragma unroll
                for (int m = 0; m < 4; ++m)
#pragma unroll
                    for (int n = 0; n < 2; ++n) acc[a][b][m][n] = (f32x4){0.f, 0.f, 0.f, 0.f};
        cur = nxt; cA = nA; cB = nB; ++ui;
        if constexpr (GATHER) { _Pragma("unroll") for (int _h = 0; _h < 2; ++_h) _Pragma("unroll") for (int _i = 0; _i < 2; ++_i) vC[_h][_i] = vN[_h][_i]; }
        if constexpr (ALIGN_EPI) { if (wr == 1) PG8_BAR; }
    }
    PG8_WAIT_V(0);
    if constexpr (!ALIGN_EPI) { if (wr == 0) PG8_BAR; }
    PG8_BAR;
    if constexpr (Epi::AFTER_DRAIN) { E.fused(acc, cur, wr, wc, fr, fq, lds, wid, lane); S.done(cur); }
#undef PG8_SA
#undef PG8_SB
#undef PG8_STAGE
#undef PG8_STGA
#undef PG8_ROWS
#undef PG8_LDA
#undef PG8_LDB
#undef PG8_MMA
#undef PG8_WAIT_V
#undef PG8_WAIT_L
#undef PG8_BAR
#undef PG8_SCHED
}
}
#define LAS __attribute__((address_space(3)))
#define DI __device__ __forceinline__
typedef unsigned short bf16;
typedef unsigned v4u __attribute__((ext_vector_type(4)));
typedef unsigned v2u __attribute__((ext_vector_type(2)));
typedef float f32x4 __attribute__((ext_vector_type(4)));
typedef short bf16x8 __attribute__((ext_vector_type(8)));
#define LDS_WAIT() asm volatile("s_waitcnt lgkmcnt(0)" ::: "memory")
#define VM_WAIT() asm volatile("s_waitcnt vmcnt(0)" ::: "memory")
DI unsigned f2bf(float f) { unsigned u = __builtin_bit_cast(unsigned, f); return (u + 0x7fffu + ((u >> 16) & 1u)) >> 16; }
typedef float f32x2_t __attribute__((ext_vector_type(2))); typedef __bf16 bf16x2_t __attribute__((ext_vector_type(2)));
DI unsigned pk2(float lo, float hi) { f32x2_t v = {lo, hi}; bf16x2_t b = __builtin_convertvector(v, bf16x2_t); return __builtin_bit_cast(unsigned, b); }
DI float bf2f(unsigned b) { return __builtin_bit_cast(float, b << 16); }
DI float bflo(unsigned w) { return __builtin_bit_cast(float, w << 16); }
DI float bfhi(unsigned w) { return __builtin_bit_cast(float, w & 0xffff0000u); }
DI float fexp(float x) { return __builtin_amdgcn_exp2f(x * 1.4426950408889634f); }
DI float flog(float x) { return __builtin_amdgcn_logf(x) * 0.6931471805599453f; }
DI float frcp(float x) { return __builtin_amdgcn_rcpf(x); }
DI float sigmoidf_(float x) { return frcp(1.f + fexp(-x)); }
DI float siluf_(float x) { return x * sigmoidf_(x); }
DI float gelu_tanh(float x) { const float u = 0.7978845608028654f * (x + 0.044715f * x * x * x); return x * sigmoidf_(2.f * u); }
DI float wave_sum(float v) {
#pragma unroll
    for (int o = 1; o < 64; o <<= 1) v += __shfl_xor(v, o);
    return v;
}
DI float wave_max(float v) {
#pragma unroll
    for (int o = 1; o < 64; o <<= 1) v = fmaxf(v, __shfl_xor(v, o));
    return v;
}
DI int red16_idx(int lane) { return 8 * ((lane >> 5) & 1) + 4 * ((lane >> 4) & 1) + 2 * ((lane >> 3) & 1) + ((lane >> 2) & 1); }
DI float red16(const float (&o)[16], int lane) {
    const bool b32 = lane & 32, b16 = lane & 16, b8 = lane & 8, b4 = lane & 4;
    float a8[8], a4[4], a2[2], a1;
#pragma unroll
    for (int j = 0; j < 8; ++j) { const float send = b32 ? o[j] : o[j + 8], keep = b32 ? o[j + 8] : o[j]; a8[j] = keep + __shfl_xor(send, 32); }
#pragma unroll
    for (int j = 0; j < 4; ++j) { const float send = b16 ? a8[j] : a8[j + 4], keep = b16 ? a8[j + 4] : a8[j]; a4[j] = keep + __shfl_xor(send, 16); }
#pragma unroll
    for (int j = 0; j < 2; ++j) { const float send = b8 ? a4[j] : a4[j + 2], keep = b8 ? a4[j + 2] : a4[j]; a2[j] = keep + __shfl_xor(send, 8); }
    { const float send = b4 ? a2[0] : a2[1], keep = b4 ? a2[1] : a2[0]; a1 = keep + __shfl_xor(send, 4); }
    a1 += __shfl_xor(a1, 2); a1 += __shfl_xor(a1, 1);
    return a1;
}
#define XB_TMO      128
#define XB_XCNT(j)  (256  + 64 * (j))
#define XB_XSUB(j)  (1280 + 64 * (j))
#define XB_XGEN(j)  (2304 + 64 * (j))
#define XB_TOP      3328
#define XB_TOPGEN   3392
#define XCD_BAR_WORDS 3456
#define XB_SPIN_CAP (1u << 18)

__device__ __forceinline__ unsigned xb_ld(unsigned* p)              { return __hip_atomic_load(p, __ATOMIC_RELAXED, __HIP_MEMORY_SCOPE_AGENT); }
__device__ __forceinline__ unsigned xb_add(unsigned* p, unsigned v) { return __hip_atomic_fetch_add(p, v, __ATOMIC_RELAXED, __HIP_MEMORY_SCOPE_AGENT); }
__device__ __forceinline__ unsigned xb_xcc_id() { return (unsigned)__builtin_amdgcn_s_getreg((3 << 11) | 20) & 0xFu; }
#define XB_SPIN(cond, bar) do { unsigned _sp = 0; while (cond) { __builtin_amdgcn_s_sleep(1); \
    if ((++_sp & 255u) == 0u) { if (xb_ld(&(bar)[XB_TMO])) break; if (_sp > XB_SPIN_CAP) { atomicAdd(&(bar)[XB_TMO], 1u); break; } } } } while (0)

struct XcdBarrier {
    unsigned* bar; unsigned x;
    volatile LAS unsigned* st;
};

__device__ __forceinline__ XcdBarrier xcd_barrier_post(unsigned* bar, volatile LAS unsigned* st) {
    XcdBarrier b; b.bar = bar; b.x = xb_xcc_id(); b.st = st;
    if (threadIdx.x == 0) (void)xb_add(&bar[XB_XCNT(b.x)], 1u);
    return b;
}
__device__ __forceinline__ void xcd_barrier_complete(unsigned* bar, unsigned x, unsigned& nloc, unsigned& nx) {
    const unsigned G = gridDim.x * gridDim.y * gridDim.z;
    unsigned sum, cnt, mine, sp = 0u;
    for (;;) {
        sum = 0u; cnt = 0u; mine = 0u;
#pragma unroll
        for (unsigned j = 0; j < 16; ++j) { const unsigned c = xb_ld(&bar[XB_XCNT(j)]); sum += c; cnt += (c > 0u) ? 1u : 0u; mine = (j == x) ? c : mine; }
        if (sum == G) break;
        __builtin_amdgcn_s_sleep(1);
        if ((++sp & 255u) == 0u) { if (xb_ld(&bar[XB_TMO])) break; if (sp > XB_SPIN_CAP) { atomicAdd(&bar[XB_TMO], 1u); break; } }
    }
    nloc = mine > 0u ? mine : 1u; nx = cnt > 0u ? cnt : 1u;
}

__device__ __forceinline__ void xcd_barrier(const XcdBarrier& b) {
    asm volatile("s_waitcnt vmcnt(0)" ::: "memory");
    __syncthreads();
    if (threadIdx.x == 0) {
        unsigned* bar = b.bar;
        __builtin_amdgcn_s_waitcnt(0);
        unsigned nloc = b.st[0], nx = b.st[1];
        if (nloc == 0u) { xcd_barrier_complete(bar, b.x, nloc, nx); b.st[0] = nloc; b.st[1] = nx; }
        const unsigned old = xb_add(&bar[XB_XSUB(b.x)], 1u);
        const unsigned gen = old / nloc;
        if (old + 1u == (gen + 1u) * nloc) {
            __builtin_amdgcn_fence(__ATOMIC_RELEASE, "agent");
            asm volatile("s_waitcnt vmcnt(0)" ::: "memory");
            const unsigned og = xb_add(&bar[XB_TOP], 1u);
            const unsigned tg = og / nx;
            if (og + 1u == (tg + 1u) * nx) xb_add(&bar[XB_TOPGEN], 1u);
            else XB_SPIN(xb_ld(&bar[XB_TOPGEN]) == tg, bar);
            __builtin_amdgcn_fence(__ATOMIC_ACQUIRE, "agent");
            xb_add(&bar[XB_XGEN(b.x)], 1u);
            asm volatile("s_waitcnt vmcnt(0)" ::: "memory");
        } else {
            XB_SPIN(xb_ld(&bar[XB_XGEN(b.x)]) == gen, bar);
            __builtin_amdgcn_fence(__ATOMIC_ACQUIRE, "agent");
            asm volatile("s_waitcnt vmcnt(0)" ::: "memory");
        }
    }
    __syncthreads();
}
constexpr int NWAVES = 8, NTHR = 512;
constexpr int BATCH = 2, SEQ = 8192, DM = 1024, MTOK = BATCH * SEQ;
constexpr int NIN = 3584;
constexpr int AW = 512;
constexpr int NEXP = 16, DFF = 1024, CAP = 1024, NROWS = BATCH * NEXP * CAP;
constexpr int NSC = 32, SCLEN = 256;
constexpr int NHEAD = 16, HD = 64, NQKV = 3072;
constexpr float EPS = 1e-6f;
constexpr int NPHASE = 21;

constexpr size_t MiB = 1u << 20;
constexpr size_t WS_CTL = 0, CTL_ZERO_BYTES = 1 * MiB;
constexpr size_t WS_AFF = 1 * MiB;
constexpr size_t WS_POS = 2 * MiB;
constexpr size_t WS_IDX = 3 * MiB;
constexpr size_t WS_GATE = 3 * MiB + 256 * 1024;
constexpr size_t WS_DEC = 3 * MiB + 512 * 1024;
constexpr size_t WS_LB = 4 * MiB;
constexpr size_t WS_BT = 4 * MiB + 64 * 1024;
constexpr size_t WS_WIN = 8 * MiB;
constexpr size_t WS_WOUT = 15 * MiB;
constexpr size_t WS_WQKV = 17 * MiB;
constexpr size_t WS_WO = 23 * MiB;
constexpr size_t WS_WSB = 25 * MiB;
constexpr size_t WS_WGU = 32 * MiB;
constexpr size_t WS_WDN = 96 * MiB;
constexpr size_t WS_H = 128 * MiB;
constexpr size_t WS_R1 = 160 * MiB;
constexpr size_t WS_U = WS_R1, WS_GV = WS_R1 + 16 * MiB, WS_Q = WS_R1 + 32 * MiB, WS_V = WS_R1 + 48 * MiB, WS_G = WS_R1 + 64 * MiB;
constexpr size_t WS_LFF = WS_R1 + 80 * MiB, WS_LFB = WS_R1 + 112 * MiB;
constexpr size_t WS_CAT = WS_R1 + 144 * MiB;
constexpr size_t WS_ST = WS_R1 + 176 * MiB;
constexpr size_t WS_ODIR = WS_R1 + 208 * MiB;
constexpr size_t WS_XE = WS_R1, WS_Y = WS_R1;
constexpr size_t WS_HMID = WS_R1 + 64 * MiB;
constexpr size_t WS_QKV = WS_R1;
constexpr size_t WS_ATT = WS_R1 + 96 * MiB;
constexpr size_t WS_KF = WS_R1 + 128 * MiB;
constexpr size_t WS_VF = WS_R1 + 224 * MiB;
constexpr size_t WS_XR = WS_R1 + 320 * MiB;
constexpr size_t WS_END = WS_R1 + 352 * MiB;
constexpr int CW_BAR = 4096;
constexpr int MAX_BAR_REGIONS = 24;

constexpr int RING_BYTES = 131072;
constexpr int LDS_BYTES = 147456;
constexpr int LDSCTL_OFF = LDS_BYTES - 512, MISC_OFF = LDSCTL_OFF + 320;

struct Args { const float* in[19]; float* out; unsigned char* ws; int ph_lo, ph_hi, li, pad; };

struct Frame {
    LAS unsigned char* lds;
    volatile LAS unsigned* MISC;
    int tid, lane, wave, G, bid, gw, NGW;
    unsigned char* ws;
};

template <int NPN_> struct GroupedOrder {
    int G, c;
    DI bool next(int i, pg8::Unit& u) const {
        if (G == 256) {
            const int x = c & 7, k = c >> 3;
            if (i >= NPN_ / 2) return false;
            const int e = (NPN_ == 8) ? 4 * i + (x >> 1) : 8 * i + x;
            u.pm = e * 8 + (k & 7); u.pn = e * NPN_ + ((NPN_ == 8) ? 4 * (x & 1) + (k >> 3) : (k >> 3)); return true;
        }
        const int L = i * G + c; if (L >= 16 * 8 * NPN_) return false;
        const int e = L / (8 * NPN_), w = L % (8 * NPN_);
        u.pm = e * 8 + (w & 7); u.pn = e * NPN_ + (w >> 3); return true;
    }
    DI void a_ready(const pg8::Unit&) const {}
    DI void done(const pg8::Unit&) const {}
};

typedef _Float16 h16x8 __attribute__((ext_vector_type(8)));
struct EpiInProj {
    static constexpr bool PERM = true, AFTER_DRAIN = false;
    bf16 *U, *GV, *Q, *V, *G; _Float16 *LFf, *LFb; const float* LB;
    DI void operator()(const pg8::f32x4 (&acc)[2][2][4][2], const pg8::Unit& u, int wr, int wc, int fr, int fq) const {
        const int seg = u.pn >> 1;
        const int row0 = u.pm * 256 + wr * 64 + fr, lc0 = (u.pn & 1) * 256 + wc * 32 + 8 * fq;
#pragma unroll
        for (int bj = 0; bj < 2; ++bj) {
            const int lc = lc0 + bj * 128;
            float lb[8];
            if (seg == 3 || seg == 4) {
#pragma unroll
                for (int j = 0; j < 8; ++j) lb[j] = LB[(seg - 3) * 512 + lc + j];
            }
#pragma unroll
            for (int ai = 0; ai < 2; ++ai)
#pragma unroll
                for (int m = 0; m < 4; ++m) {
                    const size_t off = (size_t)(row0 + ai * 128 + m * 16) * 512 + lc;
                    float v[8];
#pragma unroll
                    for (int j = 0; j < 8; ++j) v[j] = acc[ai][bj][m][j >> 2][j & 3];
                    if (seg == 3 || seg == 4) {
#pragma unroll
                        for (int j = 0; j < 8; ++j) v[j] = flog(lb[j] + (1.f - lb[j]) * sigmoidf_(v[j]));
                        _Float16* o = (seg == 3 ? LFf : LFb) + off;
                        h16x8 hv;
#pragma unroll
                        for (int j = 0; j < 8; ++j) hv[j] = (_Float16)v[j];
                        *(h16x8*)o = hv;
                    } else {
                        bf16* o;
                        if (seg == 0) { o = U;
#pragma unroll
                            for (int j = 0; j < 8; ++j) v[j] = gelu_tanh(v[j]);
                        } else if (seg == 1) { o = GV;
#pragma unroll
                            for (int j = 0; j < 8; ++j) v[j] = gelu_tanh(v[j]);
                        } else if (seg == 2) { o = Q;
#pragma unroll
                            for (int j = 0; j < 8; ++j) v[j] = siluf_(v[j]);
                        } else if (seg == 5) { o = V;
                        } else { o = G;
#pragma unroll
                            for (int j = 0; j < 8; ++j) v[j] = sigmoidf_(v[j]);
                        }
                        v4u w; w.x = pk2(v[0], v[1]); w.y = pk2(v[2], v[3]); w.z = pk2(v[4], v[5]); w.w = pk2(v[6], v[7]);
                        *(v4u*)(o + off) = w;
                    }
                }
        }
    }
};
template <bool BASE_F32> struct EpiResid {
    static constexpr bool PERM = true, AFTER_DRAIN = false;
    const float* basef; bf16* XR;
    DI void operator()(const pg8::f32x4 (&acc)[2][2][4][2], const pg8::Unit& u, int wr, int wc, int fr, int fq) const {
        const int row0 = u.pm * 256 + wr * 64 + fr, col0 = u.pn * 256 + wc * 32 + 8 * fq;
#pragma unroll
        for (int ai = 0; ai < 2; ++ai)
#pragma unroll
            for (int m = 0; m < 4; ++m) { const size_t ro = (size_t)(row0 + ai * 128 + m * 16) * DM + col0;
#pragma unroll
                for (int bj = 0; bj < 2; ++bj) { const size_t o = ro + bj * 128;
                    float v[8];
                    if (BASE_F32) { const f32x4 b0 = *(const f32x4*)(basef + o), b1 = *(const f32x4*)(basef + o + 4);
                        v[0] = b0.x; v[1] = b0.y; v[2] = b0.z; v[3] = b0.w; v[4] = b1.x; v[5] = b1.y; v[6] = b1.z; v[7] = b1.w; }
                    else { const v4u w = *(const v4u*)(XR + o); v[0] = bflo(w.x); v[1] = bfhi(w.x); v[2] = bflo(w.y); v[3] = bfhi(w.y); v[4] = bflo(w.z); v[5] = bfhi(w.z); v[6] = bflo(w.w); v[7] = bfhi(w.w); }
#pragma unroll
                    for (int j = 0; j < 8; ++j) v[j] += acc[ai][bj][m][j >> 2][j & 3];
                    v4u w; w.x = pk2(v[0], v[1]); w.y = pk2(v[2], v[3]); w.z = pk2(v[4], v[5]); w.w = pk2(v[6], v[7]);
                    *(v4u*)(XR + o) = w; } }
    }
};
struct EpiGateUp {
    static constexpr bool PERM = true, AFTER_DRAIN = false;
    bf16* H;
    DI void operator()(const pg8::f32x4 (&acc)[2][2][4][2], const pg8::Unit& u, int wr, int wc, int fr, int fq) const {
        const int pnl = u.pn & 7;
        const int row0 = u.pm * 256 + wr * 64 + fr, col0 = pnl * 128 + wc * 32 + 8 * fq;
#pragma unroll
        for (int ai = 0; ai < 2; ++ai)
#pragma unroll
            for (int m = 0; m < 4; ++m) {
                float v[8];
#pragma unroll
                for (int j = 0; j < 8; ++j) v[j] = siluf_(acc[ai][0][m][j >> 2][j & 3]) * acc[ai][1][m][j >> 2][j & 3];
                v4u w; w.x = pk2(v[0], v[1]); w.y = pk2(v[2], v[3]); w.z = pk2(v[4], v[5]); w.w = pk2(v[6], v[7]);
                *(v4u*)(H + (size_t)(row0 + ai * 128 + m * 16) * DFF + col0) = w;
            }
    }
};
struct EpiDown {
    static constexpr bool PERM = true, AFTER_DRAIN = false;
    bf16* Y; const float* gate;
    DI void operator()(const pg8::f32x4 (&acc)[2][2][4][2], const pg8::Unit& u, int wr, int wc, int fr, int fq) const {
        const int pnl = u.pn & 3;
        const int row0 = u.pm * 256 + wr * 64 + fr, col0 = pnl * 256 + wc * 32 + 8 * fq;
#pragma unroll
        for (int ai = 0; ai < 2; ++ai)
#pragma unroll
            for (int m = 0; m < 4; ++m) { const int row = row0 + ai * 128 + m * 16; const float g = gate[row];
#pragma unroll
                for (int bj = 0; bj < 2; ++bj) {
                    float v[8];
#pragma unroll
                    for (int j = 0; j < 8; ++j) v[j] = acc[ai][bj][m][j >> 2][j & 3] * g;
                    v4u w; w.x = pk2(v[0], v[1]); w.y = pk2(v[2], v[3]); w.z = pk2(v[4], v[5]); w.w = pk2(v[6], v[7]);
                    *(v4u*)(Y + (size_t)row * DM + col0 + bj * 128) = w; } }
    }
};
struct EpiQKV {
    static constexpr bool PERM = true, AFTER_DRAIN = false;
    bf16* O;
    DI void operator()(const pg8::f32x4 (&acc)[2][2][4][2], const pg8::Unit& u, int wr, int wc, int fr, int fq) const {
        const float sc = (u.pn < 4) ? 0.125f : 1.f;
        const int row0 = u.pm * 256 + wr * 64 + fr, col0 = u.pn * 256 + wc * 32 + 8 * fq;
#pragma unroll
        for (int ai = 0; ai < 2; ++ai)
#pragma unroll
            for (int m = 0; m < 4; ++m)
#pragma unroll
                for (int bj = 0; bj < 2; ++bj) {
                    float v[8];
#pragma unroll
                    for (int j = 0; j < 8; ++j) v[j] = acc[ai][bj][m][j >> 2][j & 3] * sc;
                    v4u w; w.x = pk2(v[0], v[1]); w.y = pk2(v[2], v[3]); w.z = pk2(v[4], v[5]); w.w = pk2(v[6], v[7]);
                    *(v4u*)(O + (size_t)(row0 + ai * 128 + m * 16) * NQKV + col0 + bj * 128) = w; }
    }
};

DI void transpose_item(const float* W, int K, int N, bf16* WT, LAS float* scr, int k0, int n0, int drow0, int lane) {
#pragma unroll 8
    for (int i = 0; i < 32; ++i) { const int kk = 2 * i + (lane >> 5); scr[kk * 33 + (lane & 31)] = W[(size_t)(k0 + kk) * N + n0 + (lane & 31)]; }
    LDS_WAIT(); asm volatile("" ::: "memory");
    const int c = lane & 7;
#pragma unroll
    for (int j = 0; j < 4; ++j) { const int n = (lane >> 3) + 8 * j; const LAS float* s = scr + (8 * c) * 33 + n;
        v4u o; o.x = pk2(s[0 * 33], s[1 * 33]); o.y = pk2(s[2 * 33], s[3 * 33]); o.z = pk2(s[4 * 33], s[5 * 33]); o.w = pk2(s[6 * 33], s[7 * 33]);
        *(v4u*)(WT + (size_t)(drow0 + n) * K + k0 + 8 * c) = o; }
    LDS_WAIT(); asm volatile("" ::: "memory");
}
DI void transpose_matrix(Frame& F, const float* W, int K, int N, bf16* WT) {
    LAS float* scr = (LAS float*)(F.lds + F.wave * 16384);
    const int nblk = N / 32, nitems = (K / 64) * nblk;
    for (int it = F.gw; it < nitems; it += F.NGW) { const int kb = it / nblk, nb = it % nblk; transpose_item(W, K, N, WT, scr, 64 * kb, 32 * nb, 32 * nb, F.lane); }
}
DI void convert_moe_weights(Frame& F, const float* wg, const float* wu, const float* wd, int layer, int nskip = 0) {
    LAS float* scr = (LAS float*)(F.lds + F.wave * 16384);
    bf16* WGU = (bf16*)(F.ws + WS_WGU); bf16* WDN = (bf16*)(F.ws + WS_WDN);
    if (F.bid < nskip) return;
    for (int it = F.gw - nskip * NWAVES; it < 3 * 16 * 512; it += F.NGW - nskip * NWAVES) {
        const int mat = it / 8192, rem = it % 8192, e = rem / 512, r = rem % 512, kb = r / 32, nb = r % 32, n0 = 32 * nb;
        const size_t so = ((size_t)layer * 16 + e) * 1024 * 1024;
        if (mat == 0) transpose_item(wg + so, 1024, 1024, WGU + (size_t)e * 2048 * 1024, scr, 64 * kb, n0, (n0 >> 7) * 256 + (n0 & 127), F.lane);
        else if (mat == 1) transpose_item(wu + so, 1024, 1024, WGU + (size_t)e * 2048 * 1024, scr, 64 * kb, n0, (n0 >> 7) * 256 + 128 + (n0 & 127), F.lane);
        else transpose_item(wd + so, 1024, 1024, WDN + (size_t)e * 1024 * 1024, scr, 64 * kb, n0, n0, F.lane);
    }
}
DI void rms_row(const float* xrow, const float* g, f32x4 (&v)[4], int lane) {
    const f32x4* xr = (const f32x4*)xrow + lane; float s = 0.f;
#pragma unroll
    for (int j = 0; j < 4; ++j) { v[j] = xr[64 * j]; s += (v[j].x * v[j].x + v[j].y * v[j].y) + (v[j].z * v[j].z + v[j].w * v[j].w); }
    const float rstd = 1.f / sqrtf(wave_sum(s) * (1.f / DM) + EPS);
    const f32x4* gr = (const f32x4*)g + lane;
#pragma unroll
    for (int j = 0; j < 4; ++j) v[j] = v[j] * rstd * gr[64 * j];
}
DI void store_row_bf16(bf16* orow, const f32x4 (&v)[4], int lane) {
    v2u* o8 = (v2u*)orow + lane;
#pragma unroll
    for (int j = 0; j < 4; ++j) { v2u w; w.x = pk2(v[j].x, v[j].y); w.y = pk2(v[j].z, v[j].w); o8[64 * j] = w; }
}
DI int t5_bucket(int rel) {
    const int n = rel < 0 ? -rel : rel;
    int val;
    if (n < 8) val = n;
    else { const float sc = logf((float)n / 8.f) / 4.852030263919617f; int lg = 8 + (int)(sc * 8.f); val = lg < 15 ? lg : 15; }
    return (rel > 0 ? 16 : 0) + val;
}

typedef float f32x16 __attribute__((ext_vector_type(16)));
#define MFMA32(a, b, c) __builtin_amdgcn_mfma_f32_32x32x16_bf16((a), (b), (c), 0, 0, 0)
DI int crow32(int j, int hh) { return (j & 3) + 8 * (j >> 2) + 4 * hh; }
DI void phase_prologue(Frame& F, const Args& a) {
    unsigned char* ws = F.ws;
    transpose_matrix(F, a.in[4], 1024, NIN, (bf16*)(ws + WS_WIN));
    transpose_matrix(F, a.in[5], 1024, 1024, (bf16*)(ws + WS_WOUT));
    transpose_matrix(F, a.in[12], 1024, NQKV, (bf16*)(ws + WS_WQKV));
    transpose_matrix(F, a.in[13], 1024, 1024, (bf16*)(ws + WS_WO));
    { bf16* WSB = (bf16*)(ws + WS_WSB); for (int i = F.bid * NTHR + F.tid; i < 4 * 128 * 128; i += F.G * NTHR) WSB[i] = (bf16)f2bf(a.in[8][i]); }
    { float* LB = (float*)(ws + WS_LB); const float* t = a.in[10];
      for (int i = F.bid * NTHR + F.tid; i < 2 * 512; i += F.G * NTHR) { const int d = i / 512, k = i % 512;
          const float a0 = t[(d * 3 + 0) * 512 + k], a1 = t[(d * 3 + 1) * 512 + k], a2 = t[(d * 3 + 2) * 512 + k];
          const float mx = fmaxf(a0, fmaxf(a1, a2)); const float e0 = expf(a0 - mx), e1 = expf(a1 - mx), e2 = expf(a2 - mx);
          LB[i] = e0 / (e0 + e1 + e2); } }
    { float* BT = (float*)(ws + WS_BT); const float* rb = a.in[14];
      for (int i = F.bid * NTHR + F.tid; i < 3 * 16 * 129; i += F.G * NTHR) { const int p = i / (16 * 129), h = (i / 129) % 16, j = i % 129;
          const int dil = (p == 0) ? 1 : (p == 1 ? 4 : 16);
          BT[i] = rb[t5_bucket((j - 64) * dil) * 16 + h]; } }
    { bf16* H = (bf16*)(ws + WS_H); const float* x = a.in[0];
      for (int m = F.gw; m < MTOK; m += F.NGW) { f32x4 v[4]; rms_row(x + (size_t)m * DM, a.in[1], v, F.lane); store_row_bf16(H + (size_t)m * DM, v, F.lane); } }
}

DI void phase_a_mix(Frame& F, const Args& a) {
    const bf16* GV = (const bf16*)(F.ws + WS_GV); const bf16* U = (const bf16*)(F.ws + WS_U); bf16* CAT = (bf16*)(F.ws + WS_CAT); const bf16* WSB = (const bf16*)(F.ws + WS_WSB);
    LAS float* st = (LAS float*)F.lds;
    const int r32 = F.lane & 31, hh = F.lane >> 5, ci = F.wave & 3, tp = F.wave >> 2;
    for (int u = F.bid; u < 512; u += F.G) {
        const int g = u & 3, ch = u >> 2; const int row0 = ch * 128;
        __syncthreads();
        { float p1[16], p2[16];
#pragma unroll
          for (int r = 0; r < 16; ++r) { const v4u w = *((const v4u*)(GV + (size_t)(row0 + 16 * F.wave + r) * AW) + F.lane);
              const float x0 = bflo(w.x), x1 = bfhi(w.x), x2 = bflo(w.y), x3 = bfhi(w.y), x4 = bflo(w.z), x5 = bfhi(w.z), x6 = bflo(w.w), x7 = bfhi(w.w);
              p1[r] = ((x0 + x1) + (x2 + x3)) + ((x4 + x5) + (x6 + x7)); p2[r] = ((x0 * x0 + x1 * x1) + (x2 * x2 + x3 * x3)) + ((x4 * x4 + x5 * x5) + (x6 * x6 + x7 * x7)); }
          const float s1 = red16(p1, F.lane), s2 = red16(p2, F.lane);
          if ((F.lane & 3) == 0) { const float mu = s1 * (1.f / AW); const float var = fmaxf(s2 * (1.f / AW) - mu * mu, 0.f); const int r = 16 * F.wave + red16_idx(F.lane);
              st[2 * r] = mu; st[2 * r + 1] = 1.f / sqrtf(var + EPS); } }
        __syncthreads();
        f32x16 acc[2];
#pragma unroll
        for (int j = 0; j < 16; ++j) { acc[0][j] = 0.f; acc[1][j] = 0.f; }
        const int c = g * 128 + 32 * ci + r32;
        const float lg = a.in[6][c], lb = a.in[7][c];
        const bf16* vcol = GV + (size_t)row0 * AW + c;
        const bf16* w0 = WSB + (size_t)g * 16384 + (size_t)(64 * tp + r32) * 128 + 8 * hh;
#pragma unroll
        for (int s = 0; s < 8; ++s) {
            float e[8];
#pragma unroll
            for (int j = 0; j < 8; ++j) { const int tk = 16 * s + 8 * hh + j; e[j] = (bf2f(vcol[(size_t)tk * AW]) - st[2 * tk]) * st[2 * tk + 1] * lg + lb; }
            v4u bw; bw.x = pk2(e[0], e[1]); bw.y = pk2(e[2], e[3]); bw.z = pk2(e[4], e[5]); bw.w = pk2(e[6], e[7]);
            const bf16x8 bt = __builtin_bit_cast(bf16x8, bw);
            acc[0] = MFMA32(*(const bf16x8*)(w0 + 16 * s), bt, acc[0]);
            acc[1] = MFMA32(*(const bf16x8*)(w0 + 32 * 128 + 16 * s), bt, acc[1]);
        }
#pragma unroll
        for (int q = 0; q < 2; ++q)
#pragma unroll
            for (int j = 0; j < 16; ++j) { const int t = 64 * tp + 32 * q + crow32(j, hh);
                const float uu = bf2f(U[(size_t)(row0 + t) * AW + c]);
                CAT[(size_t)(row0 + t) * DM + c] = (bf16)f2bf(uu * (acc[q][j] + a.in[9][g * 128 + t])); }
    }
}

DI void phase_gla_scan(Frame& F, bool dry = false) {
    float* ST = (float*)(F.ws + WS_ST); float* SO = dry ? (float*)(F.ws + WS_ODIR) : ST; const float* DEC = (const float*)(F.ws + WS_DEC);
    for (int idx = F.bid * NTHR + F.tid; idx < 16 * 16384; idx += F.G * NTHR) {
        const int chain = idx >> 14, kv = idx & 16383, k = kv >> 7;
        float d[NSC], dc[NSC];
#pragma unroll
        for (int sc = 0; sc < NSC; ++sc) { const int u = chain * NSC + sc; d[sc] = ST[(size_t)u * 16384 + kv]; dc[sc] = DEC[u * 128 + k]; }
        float S = 0.f;
#pragma unroll
        for (int sc = 0; sc < NSC; ++sc) { const int u = chain * NSC + sc; SO[(size_t)u * 16384 + kv] = S; S = S * dc[sc] + d[sc]; }
    }
}
DI void phase_router(Frame& F, const bf16* XR, const float* gn, const float* wr) {
    LAS float* wl = (LAS float*)F.lds;
    __syncthreads();
    for (int i = F.tid; i < 1024 * 16 / 4; i += NTHR) { const f32x4 w4 = *(const f32x4*)(wr + 4 * i); const int d = i >> 2, e0 = 4 * (i & 3);
        wl[(e0 + 0) * 1024 + d] = w4.x; wl[(e0 + 1) * 1024 + d] = w4.y; wl[(e0 + 2) * 1024 + d] = w4.z; wl[(e0 + 3) * 1024 + d] = w4.w; }
    __syncthreads();
    bf16* H = (bf16*)(F.ws + WS_H); float* AFF = (float*)(F.ws + WS_AFF);
    for (int mp = F.gw; mp < MTOK / 2; mp += F.NGW) {
        asm volatile("" ::: "memory");
        const int m0 = 2 * mp;
        f32x4 va[4], vb[4];
        { const v2u* xa = (const v2u*)(XR + (size_t)m0 * DM) + F.lane; const v2u* xb = xa + DM / 4;
#pragma unroll
          for (int j = 0; j < 4; ++j) { const v2u wa = xa[64 * j], wb = xb[64 * j]; va[j] = (f32x4){bflo(wa.x), bfhi(wa.x), bflo(wa.y), bfhi(wa.y)}; vb[j] = (f32x4){bflo(wb.x), bfhi(wb.x), bflo(wb.y), bfhi(wb.y)}; } }
        float sa = 0.f, sb = 0.f;
#pragma unroll
        for (int j = 0; j < 4; ++j) { sa += (va[j].x * va[j].x + va[j].y * va[j].y) + (va[j].z * va[j].z + va[j].w * va[j].w); sb += (vb[j].x * vb[j].x + vb[j].y * vb[j].y) + (vb[j].z * vb[j].z + vb[j].w * vb[j].w); }
        const float ra = 1.f / sqrtf(wave_sum(sa) * (1.f / DM) + EPS), rb = 1.f / sqrtf(wave_sum(sb) * (1.f / DM) + EPS);
        { const f32x4* gr = (const f32x4*)gn + F.lane;
#pragma unroll
          for (int j = 0; j < 4; ++j) { const f32x4 g4 = gr[64 * j]; va[j] = va[j] * ra * g4; vb[j] = vb[j] * rb * g4; } }
        store_row_bf16(H + (size_t)m0 * DM, va, F.lane); store_row_bf16(H + (size_t)(m0 + 1) * DM, vb, F.lane);
        float pa[16], pb[16];
#pragma unroll
        for (int e = 0; e < 16; ++e) { float a = 0.f, c = 0.f;
#pragma unroll
            for (int j = 0; j < 4; ++j) { const f32x4 w4 = *(const LAS f32x4*)(wl + e * 1024 + 4 * F.lane + 256 * j);
                a += (va[j].x * w4.x + va[j].y * w4.y) + (va[j].z * w4.z + va[j].w * w4.w); c += (vb[j].x * w4.x + vb[j].y * w4.y) + (vb[j].z * w4.z + vb[j].w * w4.w); }
            pa[e] = a; pb[e] = c; }
        const float la = red16(pa, F.lane), lb = red16(pb, F.lane);
        const float ma = wave_max(la), mb = wave_max(lb); const float ea = expf(la - ma), eb = expf(lb - mb); const float za = wave_sum(ea) * 0.25f, zb = wave_sum(eb) * 0.25f;
        if ((F.lane & 3) == 0) { const int b = m0 / SEQ, sq = m0 % SEQ; float* ap = AFF + (size_t)(b * 16 + red16_idx(F.lane)) * SEQ + sq; ap[0] = ea / za; ap[1] = eb / zb; }
    }
}

DI int block_excl_scan(int v, LAS int* scratch, int tid, int lane, int wave, int* tot) {
    int inc = v;
#pragma unroll
    for (int o = 1; o < 64; o <<= 1) { const int t = __shfl_up(inc, o); if (lane >= o) inc += t; }
    __syncthreads();
    if (lane == 63) scratch[wave] = inc;
    __syncthreads();
    int base = 0, total = 0;
#pragma unroll
    for (int w = 0; w < NWAVES; ++w) { const int s = scratch[w]; if (w < wave) base += s; total += s; }
    *tot = total;
    return base + inc - v;
}
DI void phase_topk(Frame& F) {
    const float* AFF = (const float*)(F.ws + WS_AFF); int* IDX = (int*)(F.ws + WS_IDX); float* GATE = (float*)(F.ws + WS_GATE); int* POS = (int*)(F.ws + WS_POS);
    LAS unsigned* hist = (LAS unsigned*)F.lds; LAS int* sc = (LAS int*)(F.lds + 16384); LAS unsigned* shv = (LAS unsigned*)(F.lds + 16384 + 256);
    for (int u = F.bid; u < BATCH * NEXP; u += F.G) {
        const int b = u / NEXP, e = u % NEXP;
        unsigned vals[16];
        { const v4u* src = (const v4u*)(AFF + (size_t)u * SEQ + 16 * F.tid);
#pragma unroll
          for (int j = 0; j < 4; ++j) { const v4u t = src[j]; vals[4 * j] = t.x; vals[4 * j + 1] = t.y; vals[4 * j + 2] = t.z; vals[4 * j + 3] = t.w; } }
        unsigned prefix = 0; int krem = CAP;
#pragma unroll
        for (int pass = 0; pass < 3; ++pass) {
            const int shift = (pass == 0) ? 20 : (pass == 1 ? 8 : 0); const unsigned mask = (pass == 2) ? 255u : 4095u; const int pshift = (pass == 2) ? 8 : 20;
            __syncthreads();
#pragma unroll
            for (int j = 0; j < 8; ++j) hist[F.tid + 512 * j] = 0u;
            __syncthreads();
#pragma unroll
            for (int j = 0; j < 16; ++j) { const unsigned v = vals[j]; if (pass == 0 || (v >> pshift) == prefix) __hip_atomic_fetch_add(&hist[(v >> shift) & mask], 1u, __ATOMIC_RELAXED, __HIP_MEMORY_SCOPE_WORKGROUP); }
            __syncthreads();
            const int hi = 4095 - 8 * F.tid; int ls = 0; unsigned hb[8];
#pragma unroll
            for (int j = 0; j < 8; ++j) { hb[j] = hist[hi - j]; ls += (int)hb[j]; }
            int tot; const int above = block_excl_scan(ls, sc, F.tid, F.lane, F.wave, &tot);
            if (above < krem && krem <= above + ls) { int cum = above, sel = hi, found = 0;
#pragma unroll
                for (int j = 0; j < 8; ++j) { if (!found) { if (cum + (int)hb[j] >= krem) { sel = hi - j; found = 1; } else cum += (int)hb[j]; } }
                shv[0] = (unsigned)sel; shv[1] = (unsigned)(krem - cum); }
            __syncthreads();
            prefix = (pass == 2) ? ((prefix << 8) | shv[0]) : ((prefix << 12) | shv[0]); krem = (int)shv[1];
        }
        const unsigned T = prefix;
        int ce = 0;
#pragma unroll
        for (int j = 0; j < 16; ++j) ce += (vals[j] == T) ? 1 : 0;
        int tot; int pe = block_excl_scan(ce, sc, F.tid, F.lane, F.wave, &tot);
        unsigned selmask = 0; int cs = 0;
#pragma unroll
        for (int j = 0; j < 16; ++j) { bool s = vals[j] > T; if (vals[j] == T) { s = pe < krem; ++pe; } if (s) { selmask |= 1u << j; ++cs; } }
        int slot = block_excl_scan(cs, sc, F.tid, F.lane, F.wave, &tot);
#pragma unroll
        for (int j = 0; j < 16; ++j) { const int s = 16 * F.tid + j; const int tokrow = b * SEQ + s;
            if (selmask & (1u << j)) { const int row = (e * 2 + b) * CAP + slot; ++slot; IDX[row] = tokrow; GATE[row] = __builtin_bit_cast(float, vals[j]); POS[tokrow * 16 + e] = row; }
            else POS[tokrow * 16 + e] = -1; }
    }
}
DI void phase_gather(Frame& F) {
    const bf16* H = (const bf16*)(F.ws + WS_H); bf16* XE = (bf16*)(F.ws + WS_XE); const int* IDX = (const int*)(F.ws + WS_IDX);
    for (int r = F.gw; r < NROWS; r += F.NGW) { const int src = IDX[r];
        const v4u* s = (const v4u*)(H + (size_t)src * DM) + F.lane; v4u* d = (v4u*)(XE + (size_t)r * DM) + F.lane;
        d[0] = s[0]; d[64] = s[64]; }
}
struct CombRow { f32x4 v[4]; v2u y[4][4]; float sc[4]; unsigned rest; int pm; };
DI void comb_load(CombRow& c, const bf16* XR, const bf16* Y, const int* POS, int m, int lane) {
    const v2u* xr = (const v2u*)(XR + (size_t)m * DM) + lane;
#pragma unroll
    for (int j = 0; j < 4; ++j) { const v2u w = xr[64 * j]; c.v[j] = (f32x4){bflo(w.x), bfhi(w.x), bflo(w.y), bfhi(w.y)}; }
    c.pm = POS[m * 16 + (lane & 15)];
    unsigned mk = (unsigned)__builtin_amdgcn_readfirstlane((int)(unsigned)(__ballot(lane < 16 && c.pm >= 0)));
#pragma unroll
    for (int q = 0; q < 4; ++q) {
        int p = -1;
        if (mk) { const int e = __builtin_ctz(mk); mk &= mk - 1u; p = __builtin_amdgcn_readlane(c.pm, e); }
        c.sc[q] = (p >= 0) ? 1.f : 0.f;
        const v2u* yr = (const v2u*)(Y + (size_t)(p >= 0 ? p : 0) * DM) + lane;
#pragma unroll
        for (int j = 0; j < 4; ++j) c.y[q][j] = yr[64 * j];
    }
    c.rest = mk;
}
DI void comb_finish(CombRow& c, bf16* XR, float* out, bf16* H, const bf16* Y, const float* gnext, bool final_out, int m, int lane) {
#pragma unroll
    for (int q = 0; q < 4; ++q)
#pragma unroll
        for (int j = 0; j < 4; ++j) { const v2u w = c.y[q][j]; const float s = c.sc[q]; c.v[j].x += s * bflo(w.x); c.v[j].y += s * bfhi(w.x); c.v[j].z += s * bflo(w.y); c.v[j].w += s * bfhi(w.y); }
    unsigned mk = c.rest;
    while (mk) { const int e = __builtin_ctz(mk); mk &= mk - 1u; const int p = __builtin_amdgcn_readlane(c.pm, e);
        const v2u* yr = (const v2u*)(Y + (size_t)p * DM) + lane;
#pragma unroll
        for (int j = 0; j < 4; ++j) { const v2u w = yr[64 * j]; c.v[j].x += bflo(w.x); c.v[j].y += bfhi(w.x); c.v[j].z += bflo(w.y); c.v[j].w += bfhi(w.y); } }
    float s = 0.f;
#pragma unroll
    for (int j = 0; j < 4; ++j) s += (c.v[j].x * c.v[j].x + c.v[j].y * c.v[j].y) + (c.v[j].z * c.v[j].z + c.v[j].w * c.v[j].w);
    const float rstd = 1.f / sqrtf(wave_sum(s) * (1.f / DM) + EPS);
    const f32x4* gr = (const f32x4*)gnext + lane;
    if (final_out) {
        f32x4* xo = (f32x4*)(out + (size_t)m * DM) + lane;
#pragma unroll
        for (int j = 0; j < 4; ++j) xo[64 * j] = c.v[j] * rstd * gr[64 * j];
    } else {
        store_row_bf16(XR + (size_t)m * DM, c.v, lane);
        f32x4 nv[4];
#pragma unroll
        for (int j = 0; j < 4; ++j) nv[j] = c.v[j] * rstd * gr[64 * j];
        store_row_bf16(H + (size_t)m * DM, nv, lane);
    }
}
DI void phase_moe_combine(Frame& F, bf16* XR, float* out, const float* gnext, bool final_out) {
    const bf16* Y = (const bf16*)(F.ws + WS_Y); const int* POS = (const int*)(F.ws + WS_POS); bf16* H = (bf16*)(F.ws + WS_H);
    for (int m = F.gw; m < MTOK; m += 2 * F.NGW) {
        CombRow ca, cb; const int m2 = m + F.NGW;
        comb_load(ca, XR, Y, POS, m, F.lane);
        if (m2 < MTOK) comb_load(cb, XR, Y, POS, m2, F.lane);
        comb_finish(ca, XR, out, H, Y, gnext, final_out, m, F.lane);
        if (m2 < MTOK) comb_finish(cb, XR, out, H, Y, gnext, final_out, m2, F.lane);
    }
}

DI int kperm(int r) { return (r & ~12) | ((r & 4) << 1) | ((r & 8) >> 1); }
DI void phase_kvf(Frame& F) {
    const bf16* QKV = (const bf16*)(F.ws + WS_QKV); unsigned char* KF = F.ws + WS_KF; unsigned char* VF = F.ws + WS_VF;
    LAS unsigned char* kl = F.lds; LAS unsigned char* vl = F.lds + 69632;
    for (int u = F.bid; u < 512; u += F.G) {
        const int c = u & 15, h = (u >> 4) & 15, b = u >> 8, t0 = c * 512;
        __syncthreads();
        { const v4u* ks = (const v4u*)(QKV + (size_t)(b * SEQ + t0 + F.tid) * NQKV + 1024 + h * 64); const v4u* vs = (const v4u*)(QKV + (size_t)(b * SEQ + t0 + F.tid) * NQKV + 2048 + h * 64);
#pragma unroll
          for (int j = 0; j < 8; ++j) { const v4u w = ks[j]; LAS v2u* d = (LAS v2u*)(kl + F.tid * 136 + 16 * j); d[0] = (v2u){w.x, w.y}; d[1] = (v2u){w.z, w.w}; }
#pragma unroll
          for (int j = 0; j < 8; ++j) { const v4u w = vs[j]; LAS v2u* d = (LAS v2u*)(vl + F.tid * 136 + 16 * j); d[0] = (v2u){w.x, w.y}; d[1] = (v2u){w.z, w.w}; } }
        __syncthreads();
#pragma unroll
        for (int p = 0; p < 3; ++p) {
            const int dl = (p == 0) ? 1 : (p == 1 ? 4 : 16), tpr = 16 / dl, ntile = SEQ / dl / 32;
            unsigned char* kd = KF + (size_t)p * 32 * MiB; unsigned char* vd = VF + (size_t)p * 32 * MiB;
#pragma unroll 2
            for (int i = 0; i < 8; ++i) { const int q = F.tid + 512 * i, tl = q >> 8, ln = q & 63, hh = ln >> 5, rho = ln & 31, r = tl / tpr, tt = tl % tpr;
                const size_t tg = ((size_t)((b * 16 + h) * dl + r) * ntile + c * tpr + tt) * 4096;
                { const int s = (q >> 6) & 3, tokl = dl * (32 * tt + kperm(rho)) + r;
                  const LAS v2u* sp = (const LAS v2u*)(kl + tokl * 136 + 64 * hh + 16 * s); const v2u a0 = sp[0], a1 = sp[1];
                  *(v4u*)(kd + tg + s * 1024 + ln * 16) = (v4u){a0.x, a0.y, a1.x, a1.y}; }
                { const int dt = (q >> 7) & 1, s2 = (q >> 6) & 1, dim = 32 * dt + rho; unsigned short e[8];
#pragma unroll
                  for (int k = 0; k < 8; ++k) e[k] = *(const LAS unsigned short*)(vl + (dl * (32 * tt + 16 * s2 + 8 * hh + k) + r) * 136 + dim * 2);
                  v4u o; o.x = e[0] | ((unsigned)e[1] << 16); o.y = e[2] | ((unsigned)e[3] << 16); o.z = e[4] | ((unsigned)e[5] << 16); o.w = e[6] | ((unsigned)e[7] << 16);
                  *(v4u*)(vd + tg + (dt * 2 + s2) * 1024 + ln * 16) = o; }
            }
        }
    }
}

DI int osw(int tok, int chunk) { return tok * 256 + (((chunk ^ tok ^ (tok >> 4)) & 15) << 4); }
struct AttnK { bf16x8 k[4]; }; struct AttnV { bf16x8 v[2][2]; };
#ifndef PROBE_DUP
#define PROBE_DUP (-1)
#endif
#ifndef PROBE_SAME
#define PROBE_SAME 0
#endif
DI void attn_load_k(AttnK& t, const unsigned char* kt) {
#pragma unroll
    for (int s = 0; s < 4; ++s) t.k[s] = *(const bf16x8*)(kt + s * 1024);
    if (PROBE_DUP == 77) {
#pragma unroll
        for (int s = 0; s < 4; ++s) { bf16x8 d = *(const bf16x8*)(kt + s * 1024 + (PROBE_SAME ? 0 : 64 * MiB)); asm volatile("" :: "v"(d)); }
    }
}
DI void attn_load_v(AttnV& t, const unsigned char* vt) {
#pragma unroll
    for (int dt = 0; dt < 2; ++dt)
#pragma unroll
        for (int s = 0; s < 2; ++s) t.v[dt][s] = *(const bf16x8*)(vt + (dt * 2 + s) * 1024);
}
template <bool MASK> DI void attn_step(const AttnK& tk, const AttnV& tv, const bf16x8 (&qf)[4], f32x16& o0, f32x16& o1, float& m, float& l, const LAS float* bl, int rel0, int hh) {
    f32x16 sa;
#pragma unroll
    for (int i = 0; i < 16; ++i) sa[i] = 0.f;
#pragma unroll
    for (int s = 0; s < 4; ++s) sa = MFMA32(tk.k[s], qf[s], sa);
    float sc[16]; float tmax = -1e30f;
#pragma unroll
    for (int i = 0; i < 16; ++i) { const int rel = rel0 + 16 * (i >> 3) + (i & 7);
        const bool valid = !MASK || ((rel >= -64) && (rel <= 64)); const int idx = valid ? rel + 64 : 0;
        const float v = sa[i] + bl[idx]; sc[i] = valid ? v : -1e30f; tmax = fmaxf(tmax, sc[i]); }
    tmax = fmaxf(tmax, __shfl_xor(tmax, 32));
    const float mnew = fmaxf(m, tmax), alpha = fexp(m - mnew);
    float ps = 0.f; float p[16];
#pragma unroll
    for (int i = 0; i < 16; ++i) { p[i] = (!MASK || sc[i] > -1e29f) ? fexp(sc[i] - mnew) : 0.f; ps += p[i]; }
    l = l * alpha + ps; m = mnew;
#pragma unroll
    for (int i = 0; i < 16; ++i) { o0[i] *= alpha; o1[i] *= alpha; }
#pragma unroll
    for (int s = 0; s < 2; ++s) {
        v4u w; w.x = pk2(p[8 * s], p[8 * s + 1]); w.y = pk2(p[8 * s + 2], p[8 * s + 3]); w.z = pk2(p[8 * s + 4], p[8 * s + 5]); w.w = pk2(p[8 * s + 6], p[8 * s + 7]);
        const bf16x8 pf = __builtin_bit_cast(bf16x8, w);
        o0 = MFMA32(tv.v[0][s], pf, o0); o1 = MFMA32(tv.v[1][s], pf, o1);
    }
}
DI void attn_stage(Frame& F, int b, int h, int t0, const int P) {
    const int dsh = 2 * P, DL = 1 << dsh, NT = (SEQ / 32) >> dsh;
    const bf16* QKV = (const bf16*)(F.ws + WS_QKV); const unsigned char* KF = F.ws + WS_KF + (size_t)P * 32 * MiB; const unsigned char* VF = F.ws + WS_VF + (size_t)P * 32 * MiB; bf16* ATT = (bf16*)(F.ws + WS_ATT);
    LAS unsigned char* ol = F.lds; LAS float* ml = (LAS float*)(F.lds + 131072); LAS float* ll = ml + 512; const LAS float* bl = (const LAS float*)(F.lds + 135168) + P * 132;
    int lane = F.lane; asm volatile("" : "+v"(lane));
    const int r32 = lane & 31, hh = lane >> 5, w = F.wave;
    asm volatile("" ::: "memory");
    int rr[2], mq[2], tq[2]; const unsigned char* kb[2]; const unsigned char* vb[2];
#pragma unroll
    for (int task = 0; task < 2; ++task) {
        int r, i0;
        if (P == 0) { r = 0; i0 = 64 * w + 32 * task; } else if (P == 1) { r = w & 3; i0 = 64 * (w >> 2) + 32 * task; } else { r = 2 * w + task; i0 = 0; }
        rr[task] = r; mq[task] = (t0 >> dsh) + i0; tq[task] = r + ((i0 + r32) << dsh);
        const size_t tb0 = ((size_t)((b * 16 + h) * DL + r) * NT) * 4096 + lane * 16;
        kb[task] = KF + tb0; vb[task] = VF + tb0;
    }
    int relb = 8 * hh - 64 - r32;
    asm volatile("" : "+v"(relb));
    AttnK ka, kb_, kc; AttnV va, vb_; bf16x8 qf[4], qn[4]; f32x16 o0, o1; float m, l;
#define ATT_T(task, kt) (mq[task] / 32 - 2 + (kt))
#define ATT_OK(task, kt) (ATT_T(task, kt) >= 0 && ATT_T(task, kt) < NT)
#define ATT_TC(task, kt) (ATT_T(task, kt) < 0 ? 0 : (ATT_T(task, kt) >= NT ? NT - 1 : ATT_T(task, kt)))
#define ATT_LDK(t, task, kt) attn_load_k(t, kb[task] + (size_t)ATT_TC(task, kt) * 4096)
#define ATT_LDV(t, task, kt) attn_load_v(t, vb[task] + (size_t)ATT_TC(task, kt) * 4096)
#define ATT_ST(tk, tv, task, kt, MSK) do { if (ATT_OK(task, kt)) attn_step<MSK>(tk, tv, qf, o0, o1, m, l, bl, relb + 32 * (kt), hh); } while (0)
#define ATT_Q(dst, task) do { const bf16* qp = QKV + (size_t)(b * SEQ + t0 + tq[task]) * NQKV + h * 64 + 32 * hh; _Pragma("unroll") for (int s = 0; s < 4; ++s) dst[s] = *(const bf16x8*)(qp + 8 * s); } while (0)
#define ATT_INIT(task) do { if (P == 0) { _Pragma("unroll") for (int i = 0; i < 16; ++i) { o0[i] = 0.f; o1[i] = 0.f; } m = -1e30f; l = 0.f; } else { \
        _Pragma("unroll") for (int g = 0; g < 4; ++g) { const f32x4 a = *(const LAS f32x4*)(ol + osw(tq[task], 2 * g + hh)), c = *(const LAS f32x4*)(ol + osw(tq[task], 8 + 2 * g + hh)); \
            o0[4 * g] = a.x; o0[4 * g + 1] = a.y; o0[4 * g + 2] = a.z; o0[4 * g + 3] = a.w; o1[4 * g] = c.x; o1[4 * g + 1] = c.y; o1[4 * g + 2] = c.z; o1[4 * g + 3] = c.w; } \
        m = ml[tq[task]]; l = hh ? 0.f : ll[tq[task]]; } } while (0)
#define ATT_WB(task) do { const float lt = l + __shfl_xor(l, 32); int tw = tq[task]; asm volatile("" : "+v"(tw));     \
        if (P < 2) { _Pragma("unroll") for (int g = 0; g < 4; ++g) { *(LAS f32x4*)(ol + osw(tw, 2 * g + hh)) = (f32x4){o0[4 * g], o0[4 * g + 1], o0[4 * g + 2], o0[4 * g + 3]}; \
                *(LAS f32x4*)(ol + osw(tw, 8 + 2 * g + hh)) = (f32x4){o1[4 * g], o1[4 * g + 1], o1[4 * g + 2], o1[4 * g + 3]}; } \
            if (hh == 0) { ml[tw] = m; ll[tw] = lt; } } \
        else { const float inv = 1.f / lt; bf16* op = ATT + (size_t)(b * SEQ + t0 + tw) * DM + h * 64 + 4 * hh; \
            _Pragma("unroll") for (int g = 0; g < 4; ++g) { v2u a, c; a.x = pk2(o0[4 * g] * inv, o0[4 * g + 1] * inv); a.y = pk2(o0[4 * g + 2] * inv, o0[4 * g + 3] * inv); \
                c.x = pk2(o1[4 * g] * inv, o1[4 * g + 1] * inv); c.y = pk2(o1[4 * g + 2] * inv, o1[4 * g + 3] * inv); *(v2u*)(op + 8 * g) = a; *(v2u*)(op + 32 + 8 * g) = c; } } } while (0)
    ATT_LDK(ka, 0, 0); ATT_LDK(kb_, 0, 1); ATT_LDV(va, 0, 0);
    ATT_Q(qf, 0); ATT_INIT(0);
    ATT_LDK(kc, 0, 2); ATT_LDV(vb_, 0, 1); ATT_ST(ka, va, 0, 0, true);
    ATT_LDK(ka, 0, 3); ATT_LDV(va, 0, 2); ATT_ST(kb_, vb_, 0, 1, false);
    ATT_LDK(kb_, 0, 4); ATT_LDV(vb_, 0, 3); ATT_ST(kc, va, 0, 2, false);
    ATT_Q(qn, 1);
    ATT_LDK(kc, 1, 0); ATT_LDV(va, 0, 4); ATT_ST(ka, vb_, 0, 3, false);
    ATT_LDK(ka, 1, 1); ATT_LDV(vb_, 1, 0); ATT_ST(kb_, va, 0, 4, true);
    ATT_WB(0);
    _Pragma("unroll") for (int s = 0; s < 4; ++s) qf[s] = qn[s];
    ATT_INIT(1);
    ATT_LDK(kb_, 1, 2); ATT_LDV(va, 1, 1); ATT_ST(kc, vb_, 1, 0, true);
    ATT_LDK(kc, 1, 3); ATT_LDV(vb_, 1, 2); ATT_ST(ka, va, 1, 1, false);
    ATT_LDK(ka, 1, 4); ATT_LDV(va, 1, 3); ATT_ST(kb_, vb_, 1, 2, false);
    ATT_LDV(vb_, 1, 4); ATT_ST(kc, va, 1, 3, false);
    ATT_ST(ka, vb_, 1, 4, true);
    ATT_WB(1);
#undef ATT_T
#undef ATT_OK
#undef ATT_TC
#undef ATT_LDK
#undef ATT_LDV
#undef ATT_ST
#undef ATT_Q
#undef ATT_INIT
#undef ATT_WB
}
DI void phase_attn(Frame& F) {
    const float* BT = (const float*)(F.ws + WS_BT);
    LAS float* bl = (LAS float*)(F.lds + 135168);
    const int vb_ = (F.G % 8 == 0) ? (F.bid % 8) * (F.G / 8) + F.bid / 8 : F.bid;
    for (int u = vb_; u < 512; u += F.G) {
        const int c = u & 15, h = (u >> 4) & 15, b = u >> 8, t0 = c * 512;
        __syncthreads();
        { int i0 = F.tid; asm volatile("" : "+v"(i0)); for (int i = i0; i < 3 * 129; i += NTHR) bl[(i / 129) * 132 + i % 129] = BT[((i / 129) * 16 + h) * 129 + i % 129]; }
        __syncthreads();
#pragma unroll 1
        for (int P = 0; P < 3; ++P) { if (P) __syncthreads(); attn_stage(F, b, h, t0, P); }
    }
}

constexpr int GL_QT = 0, GL_KT = 17408, GL_QB = 34816, GL_KHT = 52224, GL_VT = 70656, GL_P = 89088, GL_ST = 98304, GL_DEC = 133120, GL_TOT = 133632;
struct GlaRaw { float lf[16]; unsigned short q[16]; unsigned short v[16]; };
template <bool FULL> DI void gla_load_raw(GlaRaw& R, const _Float16* LF, const bf16* Q, const bf16* V, int b, int h, int dir, int pos0, int ch) {
#pragma unroll
    for (int i = 0; i < 16; ++i) { const int ii = pos0 + i; const int tok = dir ? (SEQ - 1 - ii) : ii; const size_t off = (size_t)(b * SEQ + tok) * AW + h * 128 + ch;
        R.lf[i] = (float)LF[off]; R.v[i] = V[off]; if (FULL) R.q[i] = Q[off]; }
}
DI void gla_prep(Frame& F, const GlaRaw& R) {
    LAS unsigned char* L = F.lds; LAS float* tot = (LAS float*)(L + GL_TOT);
    const int ch = F.tid & 127, qtr = F.tid >> 7;
    float c[16]; float run = 0.f;
#pragma unroll
    for (int i = 0; i < 16; ++i) { run += R.lf[i]; c[i] = run; }
    tot[qtr * 128 + ch] = run;
    __syncthreads();
    const float t0 = tot[ch], t1 = tot[128 + ch], t2 = tot[256 + ch], t3 = tot[384 + ch];
    const float off = (qtr > 0 ? t0 : 0.f) + (qtr > 1 ? t1 : 0.f) + (qtr > 2 ? t2 : 0.f), rr = t0 + t1, bend = (t0 + t1) + (t2 + t3);
    const float er = fexp(rr), ebr = fexp(bend - rr);
    unsigned kh[8], vv[8];
#pragma unroll
    for (int i = 0; i < 16; i += 2) {
        const float E0 = fexp(off + c[i] - rr), E1 = fexp(off + c[i + 1] - rr), I0 = frcp(E0), I1 = frcp(E1);
        const float k0 = 1.f - fexp(R.lf[i]), k1 = 1.f - fexp(R.lf[i + 1]);
        const float ki0 = k0 * I0, ki1 = k1 * I1;
        kh[i >> 1] = pk2(ki0 * ebr, ki1 * ebr);
        vv[i >> 1] = (unsigned)R.v[i] | ((unsigned)R.v[i + 1] << 16);
        const float q0 = bf2f(R.q[i]) * E0, q1 = bf2f(R.q[i + 1]) * E1;
        const int ta = 16 * qtr + i;
        *(LAS unsigned short*)(L + GL_QT + ta * 272 + 2 * ch) = (unsigned short)f2bf(q0);
        *(LAS unsigned short*)(L + GL_QT + (ta + 1) * 272 + 2 * ch) = (unsigned short)f2bf(q1);
        *(LAS unsigned short*)(L + GL_KT + ta * 272 + 2 * ch) = (unsigned short)f2bf(ki0);
        *(LAS unsigned short*)(L + GL_KT + (ta + 1) * 272 + 2 * ch) = (unsigned short)f2bf(ki1);
        *(LAS unsigned short*)(L + GL_QB + ta * 272 + 2 * ch) = (unsigned short)f2bf(q0 * er);
        *(LAS unsigned short*)(L + GL_QB + (ta + 1) * 272 + 2 * ch) = (unsigned short)f2bf(q1 * er);
    }
    *(LAS v4u*)(L + GL_KHT + ch * 144 + 32 * qtr) = (v4u){kh[0], kh[1], kh[2], kh[3]}; *(LAS v4u*)(L + GL_KHT + ch * 144 + 32 * qtr + 16) = (v4u){kh[4], kh[5], kh[6], kh[7]};
    *(LAS v4u*)(L + GL_VT + ch * 144 + 32 * qtr) = (v4u){vv[0], vv[1], vv[2], vv[3]}; *(LAS v4u*)(L + GL_VT + ch * 144 + 32 * qtr + 16) = (v4u){vv[4], vv[5], vv[6], vv[7]};
    if (qtr == 0) *(LAS float*)(L + GL_DEC + 4 * ch) = fexp(bend);
}
DI bf16x8 gfrag(const LAS unsigned char* base, int row, int stride, int kel) { return *(const LAS bf16x8*)(base + row * stride + kel * 2); }
DI void gla_state_update(Frame& F, f32x16 (&S)[2]) {
    const LAS unsigned char* L = F.lds; const int r32 = F.lane & 31, hh = F.lane >> 5, vi = F.wave & 3, ki0 = 2 * (F.wave >> 2);
    bf16x8 a[4];
#pragma unroll
    for (int s = 0; s < 4; ++s) a[s] = gfrag(L + GL_VT, 32 * vi + r32, 144, 16 * s + 8 * hh);
#pragma unroll
    for (int q = 0; q < 2; ++q) { const int kr = 32 * (ki0 + q) + r32; const float d = *(const LAS float*)(L + GL_DEC + 4 * kr);
#pragma unroll
        for (int j = 0; j < 16; ++j) S[q][j] *= d;
#pragma unroll
        for (int s = 0; s < 4; ++s) S[q] = MFMA32(a[s], gfrag(L + GL_KHT, kr, 144, 16 * s + 8 * hh), S[q]); }
}
DI void gla_state_to_lds(Frame& F, const f32x16 (&S)[2]) {
    LAS unsigned char* L = F.lds; const int r32 = F.lane & 31, hh = F.lane >> 5, vi = F.wave & 3, ki0 = 2 * (F.wave >> 2);
#pragma unroll
    for (int q = 0; q < 2; ++q)
#pragma unroll
        for (int j = 0; j < 16; ++j) *(LAS unsigned short*)(L + GL_ST + (32 * vi + crow32(j, hh)) * 272 + 2 * (32 * (ki0 + q) + r32)) = (unsigned short)f2bf(S[q][j]);
}
constexpr int G1_KHT = 0, G1_VT = 67584, G1_TOT = 135168;
DI void gla_unit_state(Frame& F, int u) {
    const int sc = u & 31, dir = (u >> 5) & 1, h = (u >> 6) & 3, b = u >> 8;
    const bf16* V = (const bf16*)(F.ws + WS_V); const _Float16* LF = (const _Float16*)(F.ws + (dir ? WS_LFB : WS_LFF));
    float* ST = (float*)(F.ws + WS_ST) + (size_t)u * 16384; float* DEC = (float*)(F.ws + WS_DEC) + u * 128;
    LAS unsigned char* L = F.lds; LAS float* tot = (LAS float*)(L + G1_TOT);
    const int ch = F.tid & 127, qtr = F.tid >> 7, r32 = F.lane & 31, hh = F.lane >> 5, vi = F.wave & 3, ki0 = 2 * (F.wave >> 2);
    float lf[64]; unsigned vv[32];
#pragma unroll
    for (int i = 0; i < 64; ++i) { const int ii = sc * 256 + 64 * qtr + i; const int tok = dir ? (SEQ - 1 - ii) : ii; const size_t off = (size_t)(b * SEQ + tok) * AW + h * 128 + ch;
        lf[i] = (float)LF[off]; const unsigned x = V[off]; if (i & 1) vv[i >> 1] |= x << 16; else vv[i >> 1] = x; }
    float run = 0.f;
#pragma unroll
    for (int i = 0; i < 64; ++i) run += lf[i];
    __syncthreads();
    tot[qtr * 128 + ch] = run;
#pragma unroll
    for (int i = 0; i < 32; i += 4) *(LAS v4u*)(L + G1_VT + ch * 528 + 128 * qtr + 4 * i) = (v4u){vv[i], vv[i + 1], vv[i + 2], vv[i + 3]};
    __syncthreads();
    const float t0 = tot[ch], t1 = tot[128 + ch], t2 = tot[256 + ch], t3 = tot[384 + ch];
    const float bend = (t0 + t1) + (t2 + t3);
    run = (qtr > 0 ? t0 : 0.f) + (qtr > 1 ? t1 : 0.f) + (qtr > 2 ? t2 : 0.f);
#pragma unroll
    for (int i = 0; i < 64; i += 2) { const float b0 = run + lf[i], b1 = b0 + lf[i + 1]; run = b1;
        vv[i >> 1] = pk2((1.f - fexp(lf[i])) * fexp(bend - b0), (1.f - fexp(lf[i + 1])) * fexp(bend - b1)); }
#pragma unroll
    for (int i = 0; i < 32; i += 4) *(LAS v4u*)(L + G1_KHT + ch * 528 + 128 * qtr + 4 * i) = (v4u){vv[i], vv[i + 1], vv[i + 2], vv[i + 3]};
    if (qtr == 0) DEC[ch] = fexp(bend);
    __syncthreads();
    f32x16 S[2];
#pragma unroll
    for (int j = 0; j < 16; ++j) { S[0][j] = 0.f; S[1][j] = 0.f; }
#pragma unroll 4
    for (int s = 0; s < 16; ++s) { const bf16x8 av = gfrag(L + G1_VT, 32 * vi + r32, 528, 16 * s + 8 * hh);
        S[0] = MFMA32(av, gfrag(L + G1_KHT, 32 * ki0 + r32, 528, 16 * s + 8 * hh), S[0]);
        S[1] = MFMA32(av, gfrag(L + G1_KHT, 32 * (ki0 + 1) + r32, 528, 16 * s + 8 * hh), S[1]); }
#pragma unroll
    for (int q = 0; q < 2; ++q)
#pragma unroll
        for (int g = 0; g < 4; ++g) *(f32x4*)(ST + (size_t)(32 * (ki0 + q) + r32) * 128 + 32 * vi + 8 * g + 4 * hh) = (f32x4){S[q][4 * g], S[q][4 * g + 1], S[q][4 * g + 2], S[q][4 * g + 3]};
}
DI int red16h_idx(int lane) { return 8 * ((lane >> 4) & 1) + 4 * ((lane >> 3) & 1) + 2 * ((lane >> 2) & 1) + ((lane >> 1) & 1); }
DI float red16h(const float (&o)[16], int lane) {
    const bool b16 = lane & 16, b8 = lane & 8, b4 = lane & 4, b2 = lane & 2;
    float a8[8], a4[4], a2[2], a1;
#pragma unroll
    for (int j = 0; j < 8; ++j) { const float send = b16 ? o[j] : o[j + 8], keep = b16 ? o[j + 8] : o[j]; a8[j] = keep + __shfl_xor(send, 16); }
#pragma unroll
    for (int j = 0; j < 4; ++j) { const float send = b8 ? a8[j] : a8[j + 4], keep = b8 ? a8[j + 4] : a8[j]; a4[j] = keep + __shfl_xor(send, 8); }
#pragma unroll
    for (int j = 0; j < 2; ++j) { const float send = b4 ? a4[j] : a4[j + 2], keep = b4 ? a4[j + 2] : a4[j]; a2[j] = keep + __shfl_xor(send, 4); }
    { const float send = b2 ? a2[0] : a2[1], keep = b2 ? a2[1] : a2[0]; a1 = keep + __shfl_xor(send, 2); }
    a1 += __shfl_xor(a1, 1);
    return a1;
}
constexpr int GL_RS = 135680;
template <bool FUSE> DI void gla_unit_out(Frame& F, const Args& a, int u) {
    const int sc = u & 31, dir = (u >> 5) & 1, h = (u >> 6) & 3, b = u >> 8;
    const bf16* Q = (const bf16*)(F.ws + WS_Q); const bf16* V = (const bf16*)(F.ws + WS_V); const _Float16* LF = (const _Float16*)(F.ws + (dir ? WS_LFB : WS_LFF));
    const float* ST = (const float*)(F.ws + WS_ST) + (size_t)u * 16384; float* OF = (float*)(F.ws + WS_ODIR);
    const bf16* G = (const bf16*)(F.ws + WS_G); bf16* CAT = (bf16*)(F.ws + WS_CAT);
    const LAS unsigned char* L = F.lds;
    const int ch = F.tid & 127, qtr = F.tid >> 7, r32 = F.lane & 31, hh = F.lane >> 5, w = F.wave, vi = w & 3, ki0 = 2 * (w >> 2), ti = w >> 2;
    f32x16 S[2];
#pragma unroll
    for (int q = 0; q < 2; ++q)
#pragma unroll
        for (int g = 0; g < 4; ++g) { const f32x4 t = *(const f32x4*)(ST + (size_t)(32 * (ki0 + q) + r32) * 128 + 32 * vi + 8 * g + 4 * hh); S[q][4 * g] = t.x; S[q][4 * g + 1] = t.y; S[q][4 * g + 2] = t.z; S[q][4 * g + 3] = t.w; }
    GlaRaw cur, nxt;
    gla_load_raw<true>(cur, LF, Q, V, b, h, dir, sc * 256 + 16 * qtr, ch);
    __syncthreads();
    gla_state_to_lds(F, S);
    const float ngv = FUSE ? a.in[11][h * 128 + 32 * vi + r32] : 0.f;
#pragma unroll 1
    for (int c = 0; c < 4; ++c) {
        gla_prep(F, cur);
        if (c < 3) gla_load_raw<true>(nxt, LF, Q, V, b, h, dir, sc * 256 + (c + 1) * 64 + 16 * qtr, ch);
        float of[16]; unsigned short gg[16];
        if (FUSE) {
#pragma unroll
            for (int j = 0; j < 16; ++j) { const int ii = sc * 256 + c * 64 + 32 * ti + crow32(j, hh); const int tok = dir ? (SEQ - 1 - ii) : ii; const size_t o = (size_t)(b * SEQ + tok) * AW + h * 128 + 32 * vi + r32;
                of[j] = OF[o]; gg[j] = G[o]; }
        }
        __syncthreads();
        f32x16 o;
#pragma unroll
        for (int j = 0; j < 16; ++j) o[j] = 0.f;
#pragma unroll
        for (int s = 0; s < 8; ++s) o = MFMA32(gfrag(L + GL_QB, 32 * ti + r32, 272, 16 * s + 8 * hh), gfrag(L + GL_ST, 32 * vi + r32, 272, 16 * s + 8 * hh), o);
        if (w < 3) {
            const int tp = (w + 1) >> 1, sp = (w == 2) ? 1 : 0;
            f32x16 p;
#pragma unroll
            for (int j = 0; j < 16; ++j) p[j] = 0.f;
#pragma unroll
            for (int s = 0; s < 8; ++s) p = MFMA32(gfrag(L + GL_QT, 32 * tp + r32, 272, 16 * s + 8 * hh), gfrag(L + GL_KT, 32 * sp + r32, 272, 16 * s + 8 * hh), p);
#pragma unroll
            for (int j = 0; j < 16; ++j) { const int t = 32 * tp + crow32(j, hh), s2 = 32 * sp + r32;
                *(LAS unsigned short*)(F.lds + GL_P + t * 144 + 2 * s2) = (s2 <= t) ? (unsigned short)f2bf(p[j]) : (unsigned short)0; }
        }
        __syncthreads();
        { const int ns = ti ? 4 : 2;
#pragma unroll
          for (int s = 0; s < 4; ++s) if (s < ns) o = MFMA32(gfrag(L + GL_P, 32 * ti + r32, 144, 16 * s + 8 * hh), gfrag(L + GL_VT, 32 * vi + r32, 144, 16 * s + 8 * hh), o); }
        if (!FUSE) {
#pragma unroll
            for (int j = 0; j < 16; ++j) { const int ii = sc * 256 + c * 64 + 32 * ti + crow32(j, hh); const int tok = dir ? (SEQ - 1 - ii) : ii;
                OF[(size_t)(b * SEQ + tok) * AW + h * 128 + 32 * vi + r32] = o[j]; }
        } else {
            float sq[16];
#pragma unroll
            for (int j = 0; j < 16; ++j) { o[j] += of[j]; sq[j] = o[j] * o[j]; }
            const float part = red16h(sq, F.lane);
            if ((F.lane & 1) == 0) *(LAS float*)(F.lds + GL_RS + ((ti * 32 + crow32(red16h_idx(F.lane), hh)) * 4 + vi) * 4) = part;
        }
        if (c < 3) { gla_state_update(F, S); gla_state_to_lds(F, S); }
        cur = nxt;
        __syncthreads();
        if (FUSE) {
#pragma unroll
            for (int j = 0; j < 16; ++j) { const int row = crow32(j, hh); const f32x4 ps = *(const LAS f32x4*)(L + GL_RS + (ti * 32 + row) * 16);
                const float rstd = 1.f / sqrtf(((ps.x + ps.y) + (ps.z + ps.w)) * (1.f / 128.f) + EPS);
                const int ii = sc * 256 + c * 64 + 32 * ti + row; const int tok = dir ? (SEQ - 1 - ii) : ii;
                CAT[(size_t)(b * SEQ + tok) * DM + 512 + h * 128 + 32 * vi + r32] = (bf16)f2bf(o[j] * rstd * ngv * bf2f(gg[j])); }
        }
    }
}

__global__ void __launch_bounds__(NTHR, 2) fwd_kernel(Args args) {
    extern __shared__ __attribute__((aligned(16))) unsigned char lds[];
    Frame F;
    F.lds = (LAS unsigned char*)lds;
    F.MISC = (volatile LAS unsigned*)(F.lds + MISC_OFF);
    F.tid = threadIdx.x; F.lane = F.tid & 63; F.wave = __builtin_amdgcn_readfirstlane(F.tid >> 6);
    F.G = gridDim.x; F.bid = blockIdx.x; F.gw = F.bid * NWAVES + F.wave; F.NGW = F.G * NWAVES;
    F.ws = args.ws;
    unsigned* ctl = (unsigned*)(args.ws + WS_CTL);
    for (int u = F.tid; u < (LDS_BYTES - LDSCTL_OFF) / 4; u += NTHR) ((LAS unsigned*)(F.lds + LDSCTL_OFF))[u] = 0u;
    __syncthreads();
    const int lo = args.ph_lo, hi = args.ph_hi;
    XcdBarrier bar; bar.bar = ctl + CW_BAR + args.li * XCD_BAR_WORDS; bar.x = 0; bar.st = nullptr;
    if (hi - lo > 1) bar = xcd_barrier_post(ctl + CW_BAR + args.li * XCD_BAR_WORDS, F.MISC + 8);
#define IN(k) (lo <= (k) && (k) < hi)
#ifndef PROBE_DUP
#define PROBE_DUP (-1)
#endif
#define REP(k) for (int rep_ = 0; rep_ < (((PROBE_DUP) == (k)) ? 2 : 1); ++rep_)
#define SEAM(k) do { if (IN(k) && IN((k) + 1)) { xcd_barrier(bar); if (PROBE_DUP == 99) xcd_barrier(bar); } } while (0)
    unsigned char* ws = args.ws;
    bf16* XR = (bf16*)(ws + WS_XR);

    if (IN(0)) REP(0) { phase_prologue(F, args); } SEAM(0);
    if (IN(1)) {
        pg8::Gemm g{(const bf16*)(ws + WS_H), (const bf16*)(ws + WS_WIN), MTOK, NIN, DM}; pg8::StaticOrder S; S.init(MTOK, NIN, F.G, F.bid);
        EpiInProj E{(bf16*)(ws + WS_U), (bf16*)(ws + WS_GV), (bf16*)(ws + WS_Q), (bf16*)(ws + WS_V), (bf16*)(ws + WS_G), (_Float16*)(ws + WS_LFF), (_Float16*)(ws + WS_LFB), (const float*)(ws + WS_LB)};
        pg8::gemm_phase<EpiInProj, pg8::StaticOrder, true, true>(F.lds, g, S, E);
        if (PROBE_DUP == 1) pg8::gemm_phase<EpiInProj, pg8::StaticOrder, true, true>(F.lds, g, S, E);
    } SEAM(1);
    if (IN(2)) { phase_a_mix(F, args); REP(2) for (int u = F.bid; u < 512; u += F.G) gla_unit_state(F, u); } SEAM(2);
    if (IN(3)) { phase_gla_scan(F); } SEAM(3);
    if (IN(4)) { for (int i = F.bid; i < 256; i += F.G) gla_unit_out<false>(F, args, ((i >> 5) << 6) | (i & 31)); } SEAM(4);
    if (IN(5)) { for (int i = F.bid; i < 256; i += F.G) gla_unit_out<true>(F, args, ((i >> 5) << 6) | 32 | (i & 31)); } SEAM(5);
    if (IN(6)) REP(6) {
        pg8::Gemm g{(const bf16*)(ws + WS_CAT), (const bf16*)(ws + WS_WOUT), MTOK, DM, DM}; pg8::StaticOrder S; S.init(MTOK, DM, F.G, F.bid);
        EpiResid<true> E{args.in[0], XR};
        pg8::gemm_phase<EpiResid<true>, pg8::StaticOrder, true, true>(F.lds, g, S, E);
    } SEAM(6);
#define MOE_BLOCK(L, pb) do { \
        if (IN(pb)) REP(pb) { phase_router(F, XR, args.in[2] + (L) * DM, args.in[15] + (L) * DM * NEXP); } SEAM(pb); \
        if (IN((pb) + 1)) { REP((pb) + 1) phase_topk(F); convert_moe_weights(F, args.in[16], args.in[17], args.in[18], (L), (F.G > 64) ? 32 : 0); } SEAM((pb) + 1);     \
        if (IN((pb) + 2)) {     \
            pg8::Gemm g{(const bf16*)(ws + WS_H), (const bf16*)(ws + WS_WGU), NROWS, 16 * 2048, DM}; GroupedOrder<8> S{F.G, F.bid}; \
            EpiGateUp E{(bf16*)(ws + WS_HMID)}; \
            LAS int* rowtab = (LAS int*)(F.lds + RING_BYTES); const int* IDX = (const int*)(ws + WS_IDX); \
            for (int i = 0; i < 4; ++i) { pg8::Unit uu; if (!S.next(i, uu)) break; if (F.tid < 256) rowtab[i * 256 + F.tid] = IDX[uu.pm * 256 + F.tid]; } \
            __syncthreads(); \
            pg8::gemm_phase<EpiGateUp, GroupedOrder<8>, true, true, true>(F.lds, g, S, E, rowtab); \
            if (PROBE_DUP == (pb) + 2) pg8::gemm_phase<EpiGateUp, GroupedOrder<8>, true, true, true>(F.lds, g, S, E, rowtab); \
        } SEAM((pb) + 2); \
        if (IN((pb) + 3)) { \
            pg8::Gemm g{(const bf16*)(ws + WS_HMID), (const bf16*)(ws + WS_WDN), NROWS, 16 * 1024, DFF}; GroupedOrder<4> S{F.G, F.bid}; \
            EpiDown E{(bf16*)(ws + WS_Y), (const float*)(ws + WS_GATE)}; \
            pg8::gemm_phase<EpiDown, GroupedOrder<4>, true, true>(F.lds, g, S, E); \
            if (PROBE_DUP == (pb) + 3) pg8::gemm_phase<EpiDown, GroupedOrder<4>, true, true>(F.lds, g, S, E); \
        } SEAM((pb) + 3); \
    } while (0)

    MOE_BLOCK(0, 7);
    if (IN(11)) { phase_moe_combine(F, XR, args.out, args.in[1] + DM, false); } SEAM(11);
    if (IN(12)) REP(12) {
        pg8::Gemm g{(const bf16*)(ws + WS_H), (const bf16*)(ws + WS_WQKV), MTOK, NQKV, DM}; pg8::StaticOrder S; S.init(MTOK, NQKV, F.G, F.bid);
        EpiQKV E{(bf16*)(ws + WS_QKV)};
        pg8::gemm_phase<EpiQKV, pg8::StaticOrder, true, true>(F.lds, g, S, E);
    } SEAM(12);
    if (IN(13)) REP(13) { phase_kvf(F); } SEAM(13);
    if (IN(14)) REP(14) { phase_attn(F); } SEAM(14);
    if (IN(15)) {
        pg8::Gemm g{(const bf16*)(ws + WS_ATT), (const bf16*)(ws + WS_WO), MTOK, DM, DM}; pg8::StaticOrder S; S.init(MTOK, DM, F.G, F.bid);
        EpiResid<false> E{nullptr, XR};
        pg8::gemm_phase<EpiResid<false>, pg8::StaticOrder, true, true>(F.lds, g, S, E);
    } SEAM(15);
    MOE_BLOCK(1, 16);
    if (IN(20)) { phase_moe_combine(F, XR, args.out, args.in[3], true); }
#undef MOE_BLOCK
#undef IN
#undef SEAM
}

#ifndef MK_N_LAUNCHES
#define MK_N_LAUNCHES 1
#endif
extern "C" void kernel_launch(void* const* d_in, const int* in_sizes, int n_in, void* d_out, int out_size, void* d_ws, size_t ws_size, hipStream_t stream) {
    static int grid = 0;
    if (grid == 0) {
        if (n_in != 19 || in_sizes[0] != MTOK * DM || out_size != MTOK * DM || ws_size < WS_END) { fprintf(stderr, "kernel_launch: unexpected shapes (n_in %d, in0 %d, out %d, ws %zu < %zu); nothing launched\n", n_in, n_in > 0 ? in_sizes[0] : -1, out_size, ws_size, (size_t)WS_END); grid = -1; return; }
        int dev = 0, cus = 0, per_cu = 0;
        if (hipGetDevice(&dev) != hipSuccess || hipDeviceGetAttribute(&cus, hipDeviceAttributeMultiprocessorCount, dev) != hipSuccess) { grid = -1; return; }
        if (hipFuncSetAttribute((const void*)fwd_kernel, hipFuncAttributeMaxDynamicSharedMemorySize, LDS_BYTES) != hipSuccess) { fprintf(stderr, "kernel_launch: hipFuncSetAttribute failed\n"); grid = -1; return; }
        if (hipOccupancyMaxActiveBlocksPerMultiprocessor(&per_cu, (const void*)fwd_kernel, NTHR, LDS_BYTES) != hipSuccess || per_cu < 1) { fprintf(stderr, "kernel_launch: occupancy query reports %d workgroups per CU\n", per_cu); }
        (void)hipGetLastError();
        grid = cus;
    }
    if (grid < 0) return;
    if (hipMemsetAsync((char*)d_ws + WS_CTL, 0, CTL_ZERO_BYTES, stream) != hipSuccess) return;
    Args a{};
    for (int i = 0; i < 19; ++i) a.in[i] = (const float*)d_in[i];
    a.out = (float*)d_out; a.ws = (unsigned char*)d_ws; a.pad = 0;
    static_assert(CW_BAR + MAX_BAR_REGIONS * XCD_BAR_WORDS <= (int)(CTL_ZERO_BYTES / 4), "barrier regions inside the memset region");
#ifdef PROBE_PREFIX
    const int nl = 2;
    for (int li = 0; li < nl; ++li) {
        a.ph_lo = 0; a.ph_hi = (li == 0) ? PROBE_PREFIX : NPHASE; a.li = li;
#else
    const int nl = MK_N_LAUNCHES;
    for (int li = 0; li < nl; ++li) {
        a.ph_lo = (int)((long)NPHASE * li / nl); a.ph_hi = (int)((long)NPHASE * (li + 1) / nl); a.li = li;
#endif
        hipLaunchKernelGGL(fwd_kernel, dim3(grid), dim3(NTHR), LDS_BYTES, stream, a);
        const hipError_t le = hipPeekAtLastError();
        if (le != hipSuccess) { fprintf(stderr, "kernel_launch: launch %d failed: %s\n", li, hipGetErrorName(le)); break; }
    }
}
```

```cpp
#include <hip/hip_runtime.h>
#include <cstdio>
#include <cstdint>
namespace pg8 {
#define PG8_LAS __attribute__((address_space(3)))
typedef unsigned short bf16_t;
typedef short bf16x8 __attribute__((ext_vector_type(8)));
typedef float f32x4 __attribute__((ext_vector_type(4)));
typedef unsigned u32x4 __attribute__((ext_vector_type(4)));
constexpr int BM = 256, BK = 64, HALF = 128, HTB = HALF * BK * 2  , STAGE_BYTES = 8 * HTB, NXCD = 8, WGM = 8;

__host__ __device__ __forceinline__ int lds_byte(int r, int c) { const int st = (r >> 4) * 2 + (c >> 5), rr = r & 15, cc = c & 31, ob = rr * 64 + cc * 2; return st * 1024 + (ob ^ (((ob >> 9) & 1) << 5)); }
__host__ __device__ __forceinline__ void stage_rc(int b, int& R, int& C) { const int st = b / 1024, sb = b % 1024, swz = sb ^ (((sb >> 9) & 1) << 5); R = (st >> 1) * 16 + swz / 64; C = (st & 1) * 32 + (swz % 64) / 2; }
__host__ __device__ __forceinline__ int perm32(int rho) { const int n = rho >> 4, i = rho & 15; return 8 * (i >> 2) + 4 * n + (i & 3); }

struct Unit { int pm, pn; };
struct Gemm { const bf16_t* A; const bf16_t* Bt; int M, N, K; };

struct StaticOrder {
    int nM, nN, nwg, G, c;
    __host__ __device__ void init(int M, int N, int G_, int c_) { nM = M / BM; nN = N / BM; nwg = nM * nN; G = G_; c = c_; }
    __host__ __device__ bool next(int i, Unit& u) const {
        const long L = (long)i * G + c; if (L >= nwg) return false;
        int wgid = (int)L; { const int q = nwg / NXCD, r = nwg % NXCD, xcd = wgid % NXCD, off = wgid / NXCD; wgid = (xcd < r ? xcd * (q + 1) : r * (q + 1) + (xcd - r) * q) + off; }
        const int nig = WGM * nN, gid = wgid / nig, fm = gid * WGM, gsz = (nM - fm) < WGM ? (nM - fm) : WGM;
        u.pm = fm + ((wgid % nig) % gsz); u.pn = (wgid % nig) / gsz; return true;
    }
    __device__ __forceinline__ void a_ready(const Unit&) const {}
    __device__ __forceinline__ void done(const Unit&) const {}
};

__device__ __forceinline__ unsigned cvt_pk_bf16(float lo, float hi) { unsigned r; asm volatile("v_cvt_pk_bf16_f32 %0, %1, %2" : "=v"(r) : "v"(lo), "v"(hi)); return r; }
typedef float f32x2 __attribute__((ext_vector_type(2)));
__device__ __forceinline__ f32x2 gelu_pk(f32x2 v) {
    const f32x2 av = __builtin_elementwise_abs(v), d = av * 0.2316418882f + 1.0f;
    f32x2 t; t.x = __builtin_amdgcn_rcpf(d.x); t.y = __builtin_amdgcn_rcpf(d.y);
    f32x2 q = t * 0.5307027145f + (-0.7265760135f); q = q * t + 0.7107068705f; q = q * t + (-0.142248368f); q = q * t + 0.127414796f; q = q * t;
    const f32x2 s = (v * v) * (-0.72134752044f);
    f32x2 e; e.x = __builtin_amdgcn_exp2f(s.x); e.y = __builtin_amdgcn_exp2f(s.y);
    const f32x2 m = v * (q * e), r = v - m;
    f32x2 o; o.x = v.x < 0.f ? m.x : r.x; o.y = v.y < 0.f ? m.y : r.y; return o;
}

template <int ACT  > struct EpiBf16 {
    static constexpr bool PERM = true, AFTER_DRAIN = false; static_assert(ACT == 0 || ACT == 1, "EpiBf16: ACT is 0 (none) or 1 (gelu_pk)");
    bf16_t* O; int ldc; const float* bias; int split_cols; size_t split_stride; float scale0;
    __device__ __forceinline__ void operator()(const f32x4 (&acc)[2][2][4][2], const Unit& u, int wr, int wc, int fr, int fq) const {
        const int row0 = u.pm * BM + wr * 64 + fr; int colt = u.pn * BM; bf16_t* base = O;
        float sc = 1.f; if (split_cols) { const int t = colt / split_cols; base += (size_t)t * split_stride; colt -= t * split_cols; if (t == 0) sc = scale0; }
        const int col0 = colt + wc * 32 + 8 * fq, bcol0 = u.pn * BM + wc * 32 + 8 * fq;
        f32x4 bv[2][2];
#pragma unroll
        for (int bj = 0; bj < 2; ++bj)
#pragma unroll
            for (int n = 0; n < 2; ++n) bv[bj][n] = bias ? *(const f32x4*)(bias + bcol0 + bj * HALF + 4 * n) : (f32x4){0.f, 0.f, 0.f, 0.f};
#pragma unroll
        for (int ai = 0; ai < 2; ++ai)
#pragma unroll
            for (int m = 0; m < 4; ++m) { bf16_t* rowp = base + (size_t)(row0 + ai * HALF + m * 16) * ldc + col0;
#pragma unroll
                for (int bj = 0; bj < 2; ++bj) { f32x4 v0 = acc[ai][bj][m][0] + bv[bj][0], v1 = acc[ai][bj][m][1] + bv[bj][1];
                    if (ACT == 1) { f32x2 a = gelu_pk((f32x2){v0[0], v0[1]}), b = gelu_pk((f32x2){v0[2], v0[3]}), c = gelu_pk((f32x2){v1[0], v1[1]}), d = gelu_pk((f32x2){v1[2], v1[3]});
                        v0 = (f32x4){a.x, a.y, b.x, b.y}; v1 = (f32x4){c.x, c.y, d.x, d.y}; }
                    v0 = v0 * sc; v1 = v1 * sc; u32x4 w; w.x = cvt_pk_bf16(v0[0], v0[1]); w.y = cvt_pk_bf16(v0[2], v0[3]); w.z = cvt_pk_bf16(v1[0], v1[1]); w.w = cvt_pk_bf16(v1[2], v1[3]);
                    *(u32x4*)(rowp + bj * HALF) = w; } }
    }
};
template <class Epi, class Sched, bool ALIGN_EPI = false, bool SP2 = false, bool GATHER = false>
__device__ __forceinline__ void gemm_phase(PG8_LAS unsigned char* lds, const Gemm g, const Sched& S, const Epi& E, const PG8_LAS int* rowtab = nullptr) {
    const int tid = threadIdx.x, wid = __builtin_amdgcn_readfirstlane(tid >> 6), lane = tid & 63, wr = wid >> 2, wc = wid & 3, fr = lane & 15, fq = lane >> 4;
    const int K = g.K, nt = K / BK;
    unsigned voffA[2], voffB[2]; int gR[2], gC[2];
#pragma unroll
    for (int i = 0; i < 2; ++i) { int R, C; stage_rc(tid * 16 + i * 8192, R, C); const int Rb = Epi::PERM ? ((R & ~31) + perm32(R & 31)) : R;
        voffA[i] = (unsigned)(R * K + C) * 2u; voffB[i] = (unsigned)(Rb * K + C) * 2u; gR[i] = R; gC[i] = C; }
    unsigned vC[2][2] = {{0u, 0u}, {0u, 0u}}, vN[2][2] = {{0u, 0u}, {0u, 0u}};
#define PG8_ROWS(dst, ui_) do { _Pragma("unroll") for (int _h = 0; _h < 2; ++_h) _Pragma("unroll") for (int _i = 0; _i < 2; ++_i) \
        dst[_h][_i] = (unsigned)(rowtab[(ui_) * 256 + _h * 128 + gR[_i]] * K + gC[_i]) * 2u; } while (0)
    const size_t kstep = (size_t)(BK * 2);
    const size_t hstep = (size_t)HALF * K * 2;
    const size_t tstep = 2 * hstep;
    const unsigned ldsw = (unsigned)wid * 1024u;
    const int aoff = lds_byte(wr * 64 + fr, fq * 8), boff = lds_byte(wc * 32 + fr, fq * 8);
#define PG8_SA(b, h) (((b) * 2 + (h)) * HTB)
#define PG8_SB(b, h) ((4 + (b) * 2 + (h)) * HTB)
#define PG8_STAGE(bufoff, gbase, voff) do { _Pragma("unroll") for (int _i = 0; _i < 2; ++_i) \
        __builtin_amdgcn_global_load_lds((const unsigned*)((const char*)(gbase) + (voff)[_i]), (PG8_LAS unsigned*)(lds + (bufoff) + ldsw + _i * 8192), 16, 0, 0); } while (0)
#define PG8_STGA(bufoff, abase, half, V) do { _Pragma("unroll") for (int _i = 0; _i < 2; ++_i) \
        __builtin_amdgcn_global_load_lds((const unsigned*)((const char*)(abase) + (GATHER ? (size_t)V[half][_i] : (size_t)((half) ? hstep : 0) + voffA[_i])), (PG8_LAS unsigned*)(lds + (bufoff) + ldsw + _i * 8192), 16, 0, 0); } while (0)
#define PG8_LDA(dst, b, h) do { _Pragma("unroll") for (int m = 0; m < 4; ++m) _Pragma("unroll") for (int k = 0; k < 2; ++k) dst[m][k] = *(const PG8_LAS bf16x8*)(lds + PG8_SA(b, h) + aoff + m * 2048 + k * 1024); } while (0)
#define PG8_LDB(dst, b, h) do { _Pragma("unroll") for (int n = 0; n < 2; ++n) _Pragma("unroll") for (int k = 0; k < 2; ++k) dst[n][k] = *(const PG8_LAS bf16x8*)(lds + PG8_SB(b, h) + boff + n * 2048 + k * 1024); } while (0)
#define PG8_MMA(ai, bj, At, Bt) do { __builtin_amdgcn_s_setprio(1); _Pragma("unroll") for (int m = 0; m < 4; ++m) _Pragma("unroll") for (int n = 0; n < 2; ++n) _Pragma("unroll") for (int k = 0; k < 2; ++k) \
        acc[ai][bj][m][n] = __builtin_amdgcn_mfma_f32_16x16x32_bf16(Bt[n][k], At[m][k], acc[ai][bj][m][n], 0, 0, 0); __builtin_amdgcn_s_setprio(0); } while (0)
#define PG8_WAIT_V(n) asm volatile("s_waitcnt vmcnt(" #n ")" ::: "memory")
#define PG8_WAIT_L(n) asm volatile("s_waitcnt lgkmcnt(" #n ")" ::: "memory")
#define PG8_BAR __builtin_amdgcn_s_barrier()
#define PG8_SCHED __builtin_amdgcn_sched_barrier(0)
    Unit cur, nxt; int ui = 0;
    if (!S.next(0, cur)) return;
    f32x4 acc[2][2][4][2];
#pragma unroll
    for (int a = 0; a < 2; ++a)
#pragma unroll
        for (int b = 0; b < 2; ++b)
#pragma unroll
            for (int m = 0; m < 4; ++m)
#pragma unroll
                for (int n = 0; n < 2; ++n) acc[a][b][m][n] = (f32x4){0.f, 0.f, 0.f, 0.f};
    bf16x8 At[4][2], B0[2][2], B1[2][2];
    const char* cA = (const char*)g.A + (GATHER ? (size_t)0 : (size_t)cur.pm * tstep); if constexpr (GATHER) PG8_ROWS(vC, 0);
    const char* cB = (const char*)g.Bt + (size_t)cur.pn * tstep;
    S.a_ready(cur);
    if constexpr (SP2) {
        PG8_STAGE(PG8_SB(0, 0), cB, voffB); PG8_STAGE(PG8_SB(0, 1), cB + hstep, voffB); PG8_STGA(PG8_SA(0, 0), cA, 0, vC); PG8_STGA(PG8_SA(0, 1), cA, 1, vC);
        if (wr == 1) PG8_BAR;
        PG8_WAIT_V(2); PG8_BAR;
        PG8_STAGE(PG8_SB(1, 0), cB + kstep, voffB); PG8_STGA(PG8_SA(1, 0), cA + kstep, 0, vC); PG8_STAGE(PG8_SB(1, 1), cB + hstep + kstep, voffB);
        PG8_WAIT_V(6); PG8_BAR;
    } else {
        PG8_STAGE(PG8_SB(0, 0), cB, voffB); PG8_STGA(PG8_SA(0, 0), cA, 0, vC); PG8_STAGE(PG8_SB(0, 1), cB + hstep, voffB); PG8_STGA(PG8_SA(0, 1), cA, 1, vC);
        if (wr == 1) PG8_BAR;
        PG8_WAIT_V(4); PG8_BAR;
        PG8_STAGE(PG8_SB(1, 0), cB + kstep, voffB); PG8_STGA(PG8_SA(1, 0), cA + kstep, 0, vC); PG8_STAGE(PG8_SB(1, 1), cB + hstep + kstep, voffB);
        PG8_WAIT_V(6); PG8_BAR;
    }
    for (;;) {
        const bool has_next = S.next(ui + 1, nxt);
        const char* nA = (has_next && !GATHER) ? (const char*)g.A + (size_t)nxt.pm * tstep : cA;
        if constexpr (GATHER) { if (has_next) PG8_ROWS(vN, ui + 1); else { _Pragma("unroll") for (int _h = 0; _h < 2; ++_h) _Pragma("unroll") for (int _i = 0; _i < 2; ++_i) vN[_h][_i] = vC[_h][_i]; } }
        const char* nB = has_next ? (const char*)g.Bt + (size_t)nxt.pn * tstep : cB;
        for (int t = 0; t < nt; t += 2) {
            const bool last = (t == nt - 2);
            unsigned vX[2][2];
            _Pragma("unroll") for (int _h = 0; _h < 2; ++_h) _Pragma("unroll") for (int _i = 0; _i < 2; ++_i) vX[_h][_i] = last ? vN[_h][_i] : vC[_h][_i];
            const char* a1 = cA + (size_t)(t + 1) * kstep;
            const char* a2 = last ? nA : cA + (size_t)(t + 2) * kstep; const char* b2 = last ? nB : cB + (size_t)(t + 2) * kstep;
            const char* a3 = a2 + kstep; const char* b3 = b2 + kstep;
            if (last && has_next) S.a_ready(nxt);
            if constexpr (SP2) {
            PG8_LDB(B0, 0, 0); PG8_LDB(B1, 0, 1); PG8_SCHED; PG8_LDA(At, 0, 0); PG8_STGA(PG8_SA(1, 1), a1, 1, vC);
            PG8_WAIT_V(8); PG8_WAIT_L(0); PG8_BAR; PG8_MMA(0, 0, At, B0); PG8_MMA(0, 1, At, B1); PG8_BAR; PG8_SCHED;
            PG8_LDA(At, 0, 1); PG8_STAGE(PG8_SB(0, 0), b2, voffB); PG8_STAGE(PG8_SB(0, 1), b2 + hstep, voffB); PG8_STGA(PG8_SA(0, 0), a2, 0, vX);
            PG8_WAIT_V(8); PG8_WAIT_L(0); PG8_BAR; PG8_MMA(1, 0, At, B0); PG8_MMA(1, 1, At, B1); PG8_BAR; PG8_SCHED;
            PG8_LDB(B0, 1, 0); PG8_LDB(B1, 1, 1); PG8_SCHED; PG8_LDA(At, 1, 0); PG8_STGA(PG8_SA(0, 1), a2, 1, vX);
            PG8_WAIT_V(8); PG8_WAIT_L(0); PG8_BAR; PG8_MMA(0, 0, At, B0); PG8_MMA(0, 1, At, B1); PG8_BAR; PG8_SCHED;
            PG8_LDA(At, 1, 1); PG8_STAGE(PG8_SB(1, 0), b3, voffB); PG8_STAGE(PG8_SB(1, 1), b3 + hstep, voffB); PG8_STGA(PG8_SA(1, 0), a3, 0, vX);
            PG8_WAIT_V(8); PG8_WAIT_L(0); PG8_BAR; PG8_MMA(1, 0, At, B0); PG8_MMA(1, 1, At, B1); PG8_BAR; PG8_SCHED;
            } else {
            PG8_LDB(B0, 0, 0); PG8_SCHED; PG8_LDA(At, 0, 0); PG8_STGA(PG8_SA(1, 1), a1, 1, vC);
            PG8_WAIT_L(8); PG8_BAR; PG8_WAIT_L(0); PG8_MMA(0, 0, At, B0); PG8_BAR; PG8_SCHED;
            PG8_LDB(B1, 0, 1); PG8_STAGE(PG8_SB(0, 0), b2, voffB);
            PG8_BAR; PG8_WAIT_L(0); PG8_MMA(0, 1, At, B1); PG8_BAR;
            PG8_LDA(At, 0, 1); PG8_STGA(PG8_SA(0, 0), a2, 0, vX);
            PG8_BAR; PG8_WAIT_L(0); PG8_MMA(1, 0, At, B0); PG8_BAR; PG8_SCHED;
            PG8_STAGE(PG8_SB(0, 1), b2 + hstep, voffB);
            PG8_WAIT_V(6); PG8_BAR; PG8_MMA(1, 1, At, B1); PG8_BAR;
            PG8_LDB(B0, 1, 0); PG8_SCHED; PG8_LDA(At, 1, 0); PG8_STGA(PG8_SA(0, 1), a2, 1, vX);
            PG8_WAIT_L(8); PG8_BAR; PG8_WAIT_L(0); PG8_MMA(0, 0, At, B0); PG8_BAR; PG8_SCHED;
            PG8_LDB(B1, 1, 1); PG8_STAGE(PG8_SB(1, 0), b3, voffB);
            PG8_BAR; PG8_WAIT_L(0); PG8_MMA(0, 1, At, B1); PG8_BAR;
            PG8_LDA(At, 1, 1); PG8_STGA(PG8_SA(1, 0), a3, 0, vX);
            PG8_BAR; PG8_WAIT_L(0); PG8_MMA(1, 0, At, B0); PG8_BAR; PG8_SCHED;
            PG8_STAGE(PG8_SB(1, 1), b3 + hstep, voffB);
            PG8_WAIT_V(6); PG8_BAR; PG8_MMA(1, 1, At, B1); PG8_BAR;
            }
        }
        if constexpr (ALIGN_EPI) { if (wr == 0) PG8_BAR; }
        if constexpr (!Epi::AFTER_DRAIN) { E(acc, cur, wr, wc, fr, fq); S.done(cur); }
        if (!has_next) break;
#pragma unroll
        for (int a = 0; a < 2; ++a)
#pragma unroll
            for (int b = 0; b < 2; ++b)
#pragma unroll
                for (int m = 0; m < 4; ++m)
#pragma unroll
                    for (int n = 0; n < 2; ++n) acc[a][b][m][n] = (f32x4){0.f, 0.f, 0.f, 0.f};
        cur = nxt; cA = nA; cB = nB; ++ui;
        if constexpr (GATHER) { _Pragma("unroll") for (int _h = 0; _h < 2; ++_h) _Pragma("unroll") for (int _i = 0; _i < 2; ++_i) vC[_h][_i] = vN[_h][_i]; }
        if constexpr (ALIGN_EPI) { if (wr == 1) PG8_BAR; }
    }
    PG8_WAIT_V(0);
    if constexpr (!ALIGN_EPI) { if (wr == 0) PG8_BAR; }
    PG8_BAR;
    if constexpr (Epi::AFTER_DRAIN) { E.fused(acc, cur, wr, wc, fr, fq, lds, wid, lane); S.done(cur); }
#undef PG8_SA
#undef PG8_SB
#undef PG8_STAGE
#undef PG8_STGA
#undef PG8_ROWS
#undef PG8_LDA
#undef PG8_LDB
#undef PG8_MMA
#undef PG8_WAIT_V
#undef PG8_WAIT_L
#undef PG8_BAR
#undef PG8_SCHED
}
}
#define LAS __attribute__((address_space(3)))
#define DI __device__ __forceinline__
typedef unsigned short bf16;
typedef unsigned v4u __attribute__((ext_vector_type(4)));
typedef unsigned v2u __attribute__((ext_vector_type(2)));
typedef float f32x4 __attribute__((ext_vector_type(4)));
typedef short bf16x8 __attribute__((ext_vector_type(8)));
#define LDS_WAIT() asm volatile("s_waitcnt lgkmcnt(0)" ::: "memory")
#define VM_WAIT() asm volatile("s_waitcnt vmcnt(0)" ::: "memory")
DI unsigned f2bf(float f) { unsigned u = __builtin_bit_cast(unsigned, f); return (u + 0x7fffu + ((u >> 16) & 1u)) >> 16; }
typedef float f32x2_t __attribute__((ext_vector_type(2))); typedef __bf16 bf16x2_t __attribute__((ext_vector_type(2)));
DI unsigned pk2(float lo, float hi) { f32x2_t v = {lo, hi}; bf16x2_t b = __builtin_convertvector(v, bf16x2_t); return __builtin_bit_cast(unsigned, b); }
DI float bf2f(unsigned b) { return __builtin_bit_cast(float, b << 16); }
DI float bflo(unsigned w) { return __builtin_bit_cast(float, w << 16); }
DI float bfhi(unsigned w) { return __builtin_bit_cast(float, w & 0xffff0000u); }
DI float fexp(float x) { return __builtin_amdgcn_exp2f(x * 1.4426950408889634f); }
DI float flog(float x) { return __builtin_amdgcn_logf(x) * 0.6931471805599453f; }
DI float frcp(float x) { return __builtin_amdgcn_rcpf(x); }
DI float sigmoidf_(float x) { return frcp(1.f + fexp(-x)); }
DI float siluf_(float x) { return x * sigmoidf_(x); }
DI float gelu_tanh(float x) { const float u = 0.7978845608028654f * (x + 0.044715f * x * x * x); return x * sigmoidf_(2.f * u); }
DI float wave_sum(float v) {
#pragma unroll
    for (int o = 1; o < 64; o <<= 1) v += __shfl_xor(v, o);
    return v;
}
DI float wave_max(float v) {
#pragma unroll
    for (int o = 1; o < 64; o <<= 1) v = fmaxf(v, __shfl_xor(v, o));
    return v;
}
DI int red16_idx(int lane) { return 8 * ((lane >> 5) & 1) + 4 * ((lane >> 4) & 1) + 2 * ((lane >> 3) & 1) + ((lane >> 2) & 1); }
DI float red16(const float (&o)[16], int lane) {
    const bool b32 = lane & 32, b16 = lane & 16, b8 = lane & 8, b4 = lane & 4;
    float a8[8], a4[4], a2[2], a1;
#pragma unroll
    for (int j = 0; j < 8; ++j) { const float send = b32 ? o[j] : o[j + 8], keep = b32 ? o[j + 8] : o[j]; a8[j] = keep + __shfl_xor(send, 32); }
#pragma unroll
    for (int j = 0; j < 4; ++j) { const float send = b16 ? a8[j] : a8[j + 4], keep = b16 ? a8[j + 4] : a8[j]; a4[j] = keep + __shfl_xor(send, 16); }
#pragma unroll
    for (int j = 0; j < 2; ++j) { const float send = b8 ? a4[j] : a4[j + 2], keep = b8 ? a4[j + 2] : a4[j]; a2[j] = keep + __shfl_xor(send, 8); }
    { const float send = b4 ? a2[0] : a2[1], keep = b4 ? a2[1] : a2[0]; a1 = keep + __shfl_xor(send, 4); }
    a1 += __shfl_xor(a1, 2); a1 += __shfl_xor(a1, 1);
    return a1;
}
#define XB_TMO      128
#define XB_XCNT(j)  (256  + 64 * (j))
#define XB_XSUB(j)  (1280 + 64 * (j))
#define XB_XGEN(j)  (2304 + 64 * (j))
#define XB_TOP      3328
#define XB_TOPGEN   3392
#define XCD_BAR_WORDS 3456
#define XB_SPIN_CAP (1u << 18)

__device__ __forceinline__ unsigned xb_ld(unsigned* p)              { return __hip_atomic_load(p, __ATOMIC_RELAXED, __HIP_MEMORY_SCOPE_AGENT); }
__device__ __forceinline__ unsigned xb_add(unsigned* p, unsigned v) { return __hip_atomic_fetch_add(p, v, __ATOMIC_RELAXED, __HIP_MEMORY_SCOPE_AGENT); }
__device__ __forceinline__ unsigned xb_xcc_id() { return (unsigned)__builtin_amdgcn_s_getreg((3 << 11) | 20) & 0xFu; }
#define XB_SPIN(cond, bar) do { unsigned _sp = 0; while (cond) { __builtin_amdgcn_s_sleep(1); \
    if ((++_sp & 255u) == 0u) { if (xb_ld(&(bar)[XB_TMO])) break; if (_sp > XB_SPIN_CAP) { atomicAdd(&(bar)[XB_TMO], 1u); break; } } } } while (0)

struct XcdBarrier {
    unsigned* bar; unsigned x;
    volatile LAS unsigned* st;
};

__device__ __forceinline__ XcdBarrier xcd_barrier_post(unsigned* bar, volatile LAS unsigned* st) {
    XcdBarrier b; b.bar = bar; b.x = xb_xcc_id(); b.st = st;
    if (threadIdx.x == 0) (void)xb_add(&bar[XB_XCNT(b.x)], 1u);
    return b;
}
__device__ __forceinline__ void xcd_barrier_complete(unsigned* bar, unsigned x, unsigned& nloc, unsigned& nx) {
    const unsigned G = gridDim.x * gridDim.y * gridDim.z;
    unsigned sum, cnt, mine, sp = 0u;
    for (;;) {
        sum = 0u; cnt = 0u; mine = 0u;
#pragma unroll
        for (unsigned j = 0; j < 16; ++j) { const unsigned c = xb_ld(&bar[XB_XCNT(j)]); sum += c; cnt += (c > 0u) ? 1u : 0u; mine = (j == x) ? c : mine; }
        if (sum == G) break;
        __builtin_amdgcn_s_sleep(1);
        if ((++sp & 255u) == 0u) { if (xb_ld(&bar[XB_TMO])) break; if (sp > XB_SPIN_CAP) { atomicAdd(&bar[XB_TMO], 1u); break; } }
    }
    nloc = mine > 0u ? mine : 1u; nx = cnt > 0u ? cnt : 1u;
}

__device__ __forceinline__ void xcd_barrier(const XcdBarrier& b) {
    asm volatile("s_waitcnt vmcnt(0)" ::: "memory");
    __syncthreads();
    if (threadIdx.x == 0) {
        unsigned* bar = b.bar;
        __builtin_amdgcn_s_waitcnt(0);
        unsigned nloc = b.st[0], nx = b.st[1];
        if (nloc == 0u) { xcd_barrier_complete(bar, b.x, nloc, nx); b.st[0] = nloc; b.st[1] = nx; }
        const unsigned old = xb_add(&bar[XB_XSUB(b.x)], 1u);
        const unsigned gen = old / nloc;
        if (old + 1u == (gen + 1u) * nloc) {
            __builtin_amdgcn_fence(__ATOMIC_RELEASE, "agent");
            asm volatile("s_waitcnt vmcnt(0)" ::: "memory");
            const unsigned og = xb_add(&bar[XB_TOP], 1u);
            const unsigned tg = og / nx;
            if (og + 1u == (tg + 1u) * nx) xb_add(&bar[XB_TOPGEN], 1u);
            else XB_SPIN(xb_ld(&bar[XB_TOPGEN]) == tg, bar);
            __builtin_amdgcn_fence(__ATOMIC_ACQUIRE, "agent");
            xb_add(&bar[XB_XGEN(b.x)], 1u);
            asm volatile("s_waitcnt vmcnt(0)" ::: "memory");
        } else {
            XB_SPIN(xb_ld(&bar[XB_XGEN(b.x)]) == gen, bar);
            __builtin_amdgcn_fence(__ATOMIC_ACQUIRE, "agent");
            asm volatile("s_waitcnt vmcnt(0)" ::: "memory");
        }
    }
    __syncthreads();
}
#ifndef PROBE_DUP
#define PROBE_DUP (-1)
#endif
constexpr int NWAVES = 8, NTHR = 512;
constexpr int BATCH = 2, SEQ = 8192, DM = 1024, MTOK = BATCH * SEQ;
constexpr int NIN = 3584;
constexpr int AW = 512;
constexpr int NEXP = 16, DFF = 1024, CAP = 1024, NROWS = BATCH * NEXP * CAP;
constexpr int NSC = 32, SCLEN = 256;
constexpr int NHEAD = 16, HD = 64, NQKV = 3072;
constexpr float EPS = 1e-6f;
constexpr int NPHASE = 21;

constexpr size_t MiB = 1u << 20;
constexpr size_t WS_CTL = 0, CTL_ZERO_BYTES = 1 * MiB;
constexpr size_t WS_AFF = 1 * MiB;
constexpr size_t WS_POS = 2 * MiB;
constexpr size_t WS_IDX = 3 * MiB;
constexpr size_t WS_GATE = 3 * MiB + 256 * 1024;
constexpr size_t WS_DEC = 3 * MiB + 512 * 1024;
constexpr size_t WS_LB = 4 * MiB;
constexpr size_t WS_BT = 4 * MiB + 64 * 1024;
constexpr size_t WS_WIN = 8 * MiB;
constexpr size_t WS_WOUT = 15 * MiB;
constexpr size_t WS_WQKV = 17 * MiB;
constexpr size_t WS_WO = 23 * MiB;
constexpr size_t WS_WSB = 25 * MiB;
constexpr size_t WS_WGU = 32 * MiB;
constexpr size_t WS_WDN = 96 * MiB;
constexpr size_t WS_H = 128 * MiB;
constexpr size_t WS_R1 = 160 * MiB;
constexpr size_t WS_U = WS_R1, WS_GV = WS_R1 + 16 * MiB, WS_Q = WS_R1 + 32 * MiB, WS_V = WS_R1 + 48 * MiB, WS_G = WS_R1 + 64 * MiB;
constexpr size_t WS_LFF = WS_R1 + 80 * MiB, WS_LFB = WS_R1 + 112 * MiB;
constexpr size_t WS_CAT = WS_R1 + 144 * MiB;
constexpr size_t WS_ST = WS_R1 + 176 * MiB;
constexpr size_t WS_ODIR = WS_R1 + 208 * MiB;
constexpr size_t WS_XE = WS_R1, WS_Y = WS_R1;
constexpr size_t WS_HMID = WS_R1 + 64 * MiB;
constexpr size_t WS_QKV = WS_R1;
constexpr size_t WS_ATT = WS_R1 + 96 * MiB;
constexpr size_t WS_KF = WS_R1 + 128 * MiB;
constexpr size_t WS_VF = WS_R1 + 224 * MiB;
constexpr size_t WS_XR = WS_R1 + 320 * MiB;
constexpr size_t WS_END = WS_R1 + 352 * MiB;
constexpr int CW_BAR = 4096;
constexpr int MAX_BAR_REGIONS = 24;

constexpr int RING_BYTES = 131072;
constexpr int LDS_BYTES = 147456;
constexpr int LDSCTL_OFF = LDS_BYTES - 512, MISC_OFF = LDSCTL_OFF + 320;

struct Args { const float* in[19]; float* out; unsigned char* ws; int ph_lo, ph_hi, li, pad; };

struct Frame {
    LAS unsigned char* lds;
    volatile LAS unsigned* MISC;
    int tid, lane, wave, G, bid, gw, NGW;
    unsigned char* ws;
};

template <int NPN_> struct GroupedOrder {
    int G, c;
    DI bool next(int i, pg8::Unit& u) const {
        if (G == 256) {
            const int x = c & 7, k = c >> 3;
            if (i >= NPN_ / 2) return false;
            const int e = (NPN_ == 8) ? 4 * i + (x >> 1) : 8 * i + x;
            u.pm = e * 8 + (k & 7); u.pn = e * NPN_ + ((NPN_ == 8) ? 4 * (x & 1) + (k >> 3) : (k >> 3)); return true;
        }
        const int L = i * G + c; if (L >= 16 * 8 * NPN_) return false;
        const int e = L / (8 * NPN_), w = L % (8 * NPN_);
        u.pm = e * 8 + (w & 7); u.pn = e * NPN_ + (w >> 3); return true;
    }
    DI void a_ready(const pg8::Unit&) const {}
    DI void done(const pg8::Unit&) const {}
};

typedef _Float16 h16x8 __attribute__((ext_vector_type(8)));
struct EpiInProj {
    static constexpr bool PERM = true, AFTER_DRAIN = false;
    bf16 *U, *GV, *Q, *V, *G; _Float16 *LFf, *LFb; const float* LB;
    DI void operator()(const pg8::f32x4 (&acc)[2][2][4][2], const pg8::Unit& u, int wr, int wc, int fr, int fq) const {
        const int seg = u.pn >> 1;
        const int row0 = u.pm * 256 + wr * 64 + fr, lc0 = (u.pn & 1) * 256 + wc * 32 + 8 * fq;
#pragma unroll
        for (int bj = 0; bj < 2; ++bj) {
            const int lc = lc0 + bj * 128;
            float lb[8];
            if (seg == 3 || seg == 4) {
#pragma unroll
                for (int j = 0; j < 8; ++j) lb[j] = LB[(seg - 3) * 512 + lc + j];
            }
#pragma unroll
            for (int ai = 0; ai < 2; ++ai)
#pragma unroll
                for (int m = 0; m < 4; ++m) {
                    const size_t off = (size_t)(row0 + ai * 128 + m * 16) * 512 + lc;
                    float v[8];
#pragma unroll
                    for (int j = 0; j < 8; ++j) v[j] = acc[ai][bj][m][j >> 2][j & 3];
                    if (seg == 3 || seg == 4) {
#pragma unroll
                        for (int j = 0; j < 8; ++j) v[j] = flog(lb[j] + (1.f - lb[j]) * sigmoidf_(v[j]));
                        _Float16* o = (seg == 3 ? LFf : LFb) + off;
                        h16x8 hv;
#pragma unroll
                        for (int j = 0; j < 8; ++j) hv[j] = (_Float16)v[j];
                        *(h16x8*)o = hv;
                    } else {
                        bf16* o;
                        if (seg == 0) { o = U;
#pragma unroll
                            for (int j = 0; j < 8; ++j) v[j] = gelu_tanh(v[j]);
                        } else if (seg == 1) { o = GV;
#pragma unroll
                            for (int j = 0; j < 8; ++j) v[j] = gelu_tanh(v[j]);
                        } else if (seg == 2) { o = Q;
#pragma unroll
                            for (int j = 0; j < 8; ++j) v[j] = siluf_(v[j]);
                        } else if (seg == 5) { o = V;
                        } else { o = G;
#pragma unroll
                            for (int j = 0; j < 8; ++j) v[j] = sigmoidf_(v[j]);
                        }
                        v4u w; w.x = pk2(v[0], v[1]); w.y = pk2(v[2], v[3]); w.z = pk2(v[4], v[5]); w.w = pk2(v[6], v[7]);
                        *(v4u*)(o + off) = w;
                    }
                }
        }
    }
};
template <bool BASE_F32> struct EpiResid {
    static constexpr bool PERM = true, AFTER_DRAIN = false;
    const float* basef; bf16* XR;
    DI void operator()(const pg8::f32x4 (&acc)[2][2][4][2], const pg8::Unit& u, int wr, int wc, int fr, int fq) const {
        const int row0 = u.pm * 256 + wr * 64 + fr, col0 = u.pn * 256 + wc * 32 + 8 * fq;
#pragma unroll
        for (int ai = 0; ai < 2; ++ai)
#pragma unroll
            for (int m = 0; m < 4; ++m) { const size_t ro = (size_t)(row0 + ai * 128 + m * 16) * DM + col0;
#pragma unroll
                for (int bj = 0; bj < 2; ++bj) { const size_t o = ro + bj * 128;
                    float v[8];
                    if (BASE_F32) { const f32x4 b0 = *(const f32x4*)(basef + o), b1 = *(const f32x4*)(basef + o + 4);
                        v[0] = b0.x; v[1] = b0.y; v[2] = b0.z; v[3] = b0.w; v[4] = b1.x; v[5] = b1.y; v[6] = b1.z; v[7] = b1.w; }
                    else { const v4u w = *(const v4u*)(XR + o); v[0] = bflo(w.x); v[1] = bfhi(w.x); v[2] = bflo(w.y); v[3] = bfhi(w.y); v[4] = bflo(w.z); v[5] = bfhi(w.z); v[6] = bflo(w.w); v[7] = bfhi(w.w); }
#pragma unroll
                    for (int j = 0; j < 8; ++j) v[j] += acc[ai][bj][m][j >> 2][j & 3];
                    v4u w; w.x = pk2(v[0], v[1]); w.y = pk2(v[2], v[3]); w.z = pk2(v[4], v[5]); w.w = pk2(v[6], v[7]);
                    *(v4u*)(XR + o) = w; } }
    }
};
struct EpiGateUp {
    static constexpr bool PERM = true, AFTER_DRAIN = false;
    bf16* H;
    DI void operator()(const pg8::f32x4 (&acc)[2][2][4][2], const pg8::Unit& u, int wr, int wc, int fr, int fq) const {
        const int pnl = u.pn & 7;
        const int row0 = u.pm * 256 + wr * 64 + fr, col0 = pnl * 128 + wc * 32 + 8 * fq;
#pragma unroll
        for (int ai = 0; ai < 2; ++ai)
#pragma unroll
            for (int m = 0; m < 4; ++m) {
                float v[8];
#pragma unroll
                for (int j = 0; j < 8; ++j) v[j] = siluf_(acc[ai][0][m][j >> 2][j & 3]) * acc[ai][1][m][j >> 2][j & 3];
                v4u w; w.x = pk2(v[0], v[1]); w.y = pk2(v[2], v[3]); w.z = pk2(v[4], v[5]); w.w = pk2(v[6], v[7]);
                *(v4u*)(H + (size_t)(row0 + ai * 128 + m * 16) * DFF + col0) = w;
            }
    }
};
struct EpiDown {
    static constexpr bool PERM = true, AFTER_DRAIN = false;
    bf16* Y; const float* gate;
    DI void operator()(const pg8::f32x4 (&acc)[2][2][4][2], const pg8::Unit& u, int wr, int wc, int fr, int fq) const {
        const int pnl = u.pn & 3;
        const int row0 = u.pm * 256 + wr * 64 + fr, col0 = pnl * 256 + wc * 32 + 8 * fq;
#pragma unroll
        for (int ai = 0; ai < 2; ++ai)
#pragma unroll
            for (int m = 0; m < 4; ++m) { const int row = row0 + ai * 128 + m * 16; const float g = gate[row];
#pragma unroll
                for (int bj = 0; bj < 2; ++bj) {
                    float v[8];
#pragma unroll
                    for (int j = 0; j < 8; ++j) v[j] = acc[ai][bj][m][j >> 2][j & 3] * g;
                    v4u w; w.x = pk2(v[0], v[1]); w.y = pk2(v[2], v[3]); w.z = pk2(v[4], v[5]); w.w = pk2(v[6], v[7]);
                    *(v4u*)(Y + (size_t)row * DM + col0 + bj * 128) = w; } }
    }
};
struct EpiQKV {
    static constexpr bool PERM = true, AFTER_DRAIN = false;
    bf16* O;
    DI void operator()(const pg8::f32x4 (&acc)[2][2][4][2], const pg8::Unit& u, int wr, int wc, int fr, int fq) const {
        const float sc = (u.pn < 4) ? 0.125f : 1.f;
        const int row0 = u.pm * 256 + wr * 64 + fr, col0 = u.pn * 256 + wc * 32 + 8 * fq;
#pragma unroll
        for (int ai = 0; ai < 2; ++ai)
#pragma unroll
            for (int m = 0; m < 4; ++m)
#pragma unroll
                for (int bj = 0; bj < 2; ++bj) {
                    float v[8];
#pragma unroll
                    for (int j = 0; j < 8; ++j) v[j] = acc[ai][bj][m][j >> 2][j & 3] * sc;
                    v4u w; w.x = pk2(v[0], v[1]); w.y = pk2(v[2], v[3]); w.z = pk2(v[4], v[5]); w.w = pk2(v[6], v[7]);
                    *(v4u*)(O + (size_t)(row0 + ai * 128 + m * 16) * NQKV + col0 + bj * 128) = w; }
    }
};

DI void transpose_item(const float* W, int K, int N, bf16* WT, LAS float* scr, int k0, int n0, int drow0, int lane) {
#pragma unroll 8
    for (int i = 0; i < 32; ++i) { const int kk = 2 * i + (lane >> 5); scr[kk * 33 + (lane & 31)] = W[(size_t)(k0 + kk) * N + n0 + (lane & 31)]; }
    LDS_WAIT(); asm volatile("" ::: "memory");
    const int c = lane & 7;
#pragma unroll
    for (int j = 0; j < 4; ++j) { const int n = (lane >> 3) + 8 * j; const LAS float* s = scr + (8 * c) * 33 + n;
        v4u o; o.x = pk2(s[0 * 33], s[1 * 33]); o.y = pk2(s[2 * 33], s[3 * 33]); o.z = pk2(s[4 * 33], s[5 * 33]); o.w = pk2(s[6 * 33], s[7 * 33]);
        *(v4u*)(WT + (size_t)(drow0 + n) * K + k0 + 8 * c) = o; }
    LDS_WAIT(); asm volatile("" ::: "memory");
}
DI void transpose_matrix(Frame& F, const float* W, int K, int N, bf16* WT) {
    LAS float* scr = (LAS float*)(F.lds + F.wave * 16384);
    const int nblk = N / 32, nitems = (K / 64) * nblk;
    for (int it = F.gw; it < nitems; it += F.NGW) { const int kb = it / nblk, nb = it % nblk; transpose_item(W, K, N, WT, scr, 64 * kb, 32 * nb, 32 * nb, F.lane); }
}
DI void convert_moe_weights(Frame& F, const float* wg, const float* wu, const float* wd, int layer, int nskip = 0) {
    LAS float* scr = (LAS float*)(F.lds + F.wave * 16384);
    bf16* WGU = (bf16*)(F.ws + WS_WGU); bf16* WDN = (bf16*)(F.ws + WS_WDN);
    if (F.bid < nskip) return;
    for (int it = F.gw - nskip * NWAVES; it < 3 * 16 * 512; it += F.NGW - nskip * NWAVES) {
        const int mat = it / 8192, rem = it % 8192, e = rem / 512, r = rem % 512, kb = r / 32, nb = r % 32, n0 = 32 * nb;
        const size_t so = ((size_t)layer * 16 + e) * 1024 * 1024;
        if (mat == 0) transpose_item(wg + so, 1024, 1024, WGU + (size_t)e * 2048 * 1024, scr, 64 * kb, n0, (n0 >> 7) * 256 + (n0 & 127), F.lane);
        else if (mat == 1) transpose_item(wu + so, 1024, 1024, WGU + (size_t)e * 2048 * 1024, scr, 64 * kb, n0, (n0 >> 7) * 256 + 128 + (n0 & 127), F.lane);
        else transpose_item(wd + so, 1024, 1024, WDN + (size_t)e * 1024 * 1024, scr, 64 * kb, n0, n0, F.lane);
    }
}
DI void rms_row(const float* xrow, const float* g, f32x4 (&v)[4], int lane) {
    const f32x4* xr = (const f32x4*)xrow + lane; float s = 0.f;
#pragma unroll
    for (int j = 0; j < 4; ++j) { v[j] = xr[64 * j]; s += (v[j].x * v[j].x + v[j].y * v[j].y) + (v[j].z * v[j].z + v[j].w * v[j].w); }
    const float rstd = 1.f / sqrtf(wave_sum(s) * (1.f / DM) + EPS);
    const f32x4* gr = (const f32x4*)g + lane;
#pragma unroll
    for (int j = 0; j < 4; ++j) v[j] = v[j] * rstd * gr[64 * j];
}
DI void store_row_bf16(bf16* orow, const f32x4 (&v)[4], int lane) {
    v2u* o8 = (v2u*)orow + lane;
#pragma unroll
    for (int j = 0; j < 4; ++j) { v2u w; w.x = pk2(v[j].x, v[j].y); w.y = pk2(v[j].z, v[j].w); o8[64 * j] = w; }
}
DI int t5_bucket(int rel) {
    const int n = rel < 0 ? -rel : rel;
    int val;
    if (n < 8) val = n;
    else { const float sc = logf((float)n / 8.f) / 4.852030263919617f; int lg = 8 + (int)(sc * 8.f); val = lg < 15 ? lg : 15; }
    return (rel > 0 ? 16 : 0) + val;
}

typedef float f32x16 __attribute__((ext_vector_type(16)));
#define MFMA32(a, b, c) __builtin_amdgcn_mfma_f32_32x32x16_bf16((a), (b), (c), 0, 0, 0)
DI int crow32(int j, int hh) { return (j & 3) + 8 * (j >> 2) + 4 * hh; }
DI void phase_prologue(Frame& F, const Args& a) {
    unsigned char* ws = F.ws;
    transpose_matrix(F, a.in[4], 1024, NIN, (bf16*)(ws + WS_WIN));
    transpose_matrix(F, a.in[5], 1024, 1024, (bf16*)(ws + WS_WOUT));
    transpose_matrix(F, a.in[12], 1024, NQKV, (bf16*)(ws + WS_WQKV));
    transpose_matrix(F, a.in[13], 1024, 1024, (bf16*)(ws + WS_WO));
    { bf16* WSB = (bf16*)(ws + WS_WSB); for (int i = F.bid * NTHR + F.tid; i < 4 * 128 * 128; i += F.G * NTHR) WSB[i] = (bf16)f2bf(a.in[8][i]); }
    { float* LB = (float*)(ws + WS_LB); const float* t = a.in[10];
      for (int i = F.bid * NTHR + F.tid; i < 2 * 512; i += F.G * NTHR) { const int d = i / 512, k = i % 512;
          const float a0 = t[(d * 3 + 0) * 512 + k], a1 = t[(d * 3 + 1) * 512 + k], a2 = t[(d * 3 + 2) * 512 + k];
          const float mx = fmaxf(a0, fmaxf(a1, a2)); const float e0 = expf(a0 - mx), e1 = expf(a1 - mx), e2 = expf(a2 - mx);
          LB[i] = e0 / (e0 + e1 + e2); } }
    { float* BT = (float*)(ws + WS_BT); const float* rb = a.in[14];
      for (int i = F.bid * NTHR + F.tid; i < 3 * 16 * 129; i += F.G * NTHR) { const int p = i / (16 * 129), h = (i / 129) % 16, j = i % 129;
          const int dil = (p == 0) ? 1 : (p == 1 ? 4 : 16);
          BT[i] = rb[t5_bucket((j - 64) * dil) * 16 + h]; } }
    { bf16* H = (bf16*)(ws + WS_H); const float* x = a.in[0];
      for (int m = F.gw; m < MTOK; m += F.NGW) { f32x4 v[4]; rms_row(x + (size_t)m * DM, a.in[1], v, F.lane); store_row_bf16(H + (size_t)m * DM, v, F.lane); } }
}

DI void phase_a_mix(Frame& F, const Args& a) {
    const bf16* GV = (const bf16*)(F.ws + WS_GV); const bf16* U = (const bf16*)(F.ws + WS_U); bf16* CAT = (bf16*)(F.ws + WS_CAT); const bf16* WSB = (const bf16*)(F.ws + WS_WSB);
    LAS float* st = (LAS float*)F.lds;
    LAS unsigned char* tl = F.lds + 1024;
    const int r32 = F.lane & 31, hh = F.lane >> 5, ci = F.wave & 3, tp = F.wave >> 2;
    for (int u = F.bid; u < 512; u += F.G) {
        const int g = u & 3, ch = u >> 2; const int row0 = ch * 128;
        v4u tw[4];
#pragma unroll
        for (int i = 0; i < 4; ++i) { const int p = F.tid + 512 * i; tw[i] = *(const v4u*)(GV + (size_t)(row0 + (p >> 4)) * AW + g * 128 + 8 * (p & 15)); }
        float p1[16], p2[16];
#pragma unroll
        for (int r = 0; r < 16; ++r) { const v4u w = *((const v4u*)(GV + (size_t)(row0 + 16 * F.wave + r) * AW) + F.lane);
            const float x0 = bflo(w.x), x1 = bfhi(w.x), x2 = bflo(w.y), x3 = bfhi(w.y), x4 = bflo(w.z), x5 = bfhi(w.z), x6 = bflo(w.w), x7 = bfhi(w.w);
            p1[r] = ((x0 + x1) + (x2 + x3)) + ((x4 + x5) + (x6 + x7)); p2[r] = ((x0 * x0 + x1 * x1) + (x2 * x2 + x3 * x3)) + ((x4 * x4 + x5 * x5) + (x6 * x6 + x7 * x7)); }
        const float s1 = red16(p1, F.lane), s2 = red16(p2, F.lane);
        __syncthreads();
        if ((F.lane & 3) == 0) { const float mu = s1 * (1.f / AW); const float var = fmaxf(s2 * (1.f / AW) - mu * mu, 0.f); const int r = 16 * F.wave + red16_idx(F.lane);
            st[2 * r] = mu; st[2 * r + 1] = 1.f / sqrtf(var + EPS); }
#pragma unroll
        for (int i = 0; i < 4; ++i) { const int p = F.tid + 512 * i; *(LAS v4u*)(tl + (p >> 4) * 272 + 16 * (p & 15)) = tw[i]; }
        __syncthreads();
        f32x16 acc[2];
#pragma unroll
        for (int j = 0; j < 16; ++j) { acc[0][j] = 0.f; acc[1][j] = 0.f; }
        const int cl = 32 * ci + r32;
        const float lg = a.in[6][g * 128 + cl], lb = a.in[7][g * 128 + cl];
        const bf16* w0 = WSB + (size_t)g * 16384 + (size_t)(64 * tp + r32) * 128 + 8 * hh;
#pragma unroll
        for (int s = 0; s < 8; ++s) {
            float e[8];
#pragma unroll
            for (int j = 0; j < 8; ++j) { const int tk = 16 * s + 8 * hh + j; e[j] = (bf2f(*(const LAS unsigned short*)(tl + tk * 272 + 2 * cl)) - st[2 * tk]) * st[2 * tk + 1] * lg + lb; }
            v4u bw; bw.x = pk2(e[0], e[1]); bw.y = pk2(e[2], e[3]); bw.z = pk2(e[4], e[5]); bw.w = pk2(e[6], e[7]);
            const bf16x8 at = __builtin_bit_cast(bf16x8, bw);
            acc[0] = MFMA32(at, *(const bf16x8*)(w0 + 16 * s), acc[0]);
            acc[1] = MFMA32(at, *(const bf16x8*)(w0 + 32 * 128 + 16 * s), acc[1]);
        }
#pragma unroll
        for (int q = 0; q < 2; ++q) { const int t = 64 * tp + 32 * q + r32; const float bs = a.in[9][g * 128 + t];
            const size_t ub = (size_t)(row0 + t) * AW + g * 128 + 32 * ci + 4 * hh, cb = (size_t)(row0 + t) * DM + g * 128 + 32 * ci + 4 * hh;
#pragma unroll
            for (int gq = 0; gq < 4; ++gq) { const v2u uw = *(const v2u*)(U + ub + 8 * gq); v2u o;
                o.x = pk2(bflo(uw.x) * (acc[q][4 * gq] + bs), bfhi(uw.x) * (acc[q][4 * gq + 1] + bs)); o.y = pk2(bflo(uw.y) * (acc[q][4 * gq + 2] + bs), bfhi(uw.y) * (acc[q][4 * gq + 3] + bs));
                *(v2u*)(CAT + cb + 8 * gq) = o; } }
    }
}

DI void phase_gla_scan(Frame& F, bool dry = false) {
    float* ST = (float*)(F.ws + WS_ST); float* SO = dry ? (float*)(F.ws + WS_ODIR) : ST; const float* DEC = (const float*)(F.ws + WS_DEC);
    for (int idx = F.bid * NTHR + F.tid; idx < 16 * 16384; idx += F.G * NTHR) {
        const int chain = idx >> 14, kv = idx & 16383, k = kv >> 7;
        float d[NSC], dc[NSC];
#pragma unroll
        for (int sc = 0; sc < NSC; ++sc) { const int u = chain * NSC + sc; d[sc] = ST[(size_t)u * 16384 + kv]; dc[sc] = DEC[u * 128 + k]; }
        float S = 0.f;
#pragma unroll
        for (int sc = 0; sc < NSC; ++sc) { const int u = chain * NSC + sc; SO[(size_t)u * 16384 + kv] = S; S = S * dc[sc] + d[sc]; }
    }
}
DI void phase_router(Frame& F, const bf16* XR, const float* gn, const float* wr) {
    LAS float* wl = (LAS float*)F.lds;
    __syncthreads();
    for (int i = F.tid; i < 1024 * 16 / 4; i += NTHR) { const f32x4 w4 = *(const f32x4*)(wr + 4 * i); const int d = i >> 2, e0 = 4 * (i & 3);
        wl[(e0 + 0) * 1024 + d] = w4.x; wl[(e0 + 1) * 1024 + d] = w4.y; wl[(e0 + 2) * 1024 + d] = w4.z; wl[(e0 + 3) * 1024 + d] = w4.w; }
    __syncthreads();
    bf16* H = (bf16*)(F.ws + WS_H); float* AFF = (float*)(F.ws + WS_AFF);
    for (int mp = F.gw; mp < MTOK / 2; mp += F.NGW) {
        asm volatile("" ::: "memory");
        const int m0 = 2 * mp;
        f32x4 va[4], vb[4];
        { const v2u* xa = (const v2u*)(XR + (size_t)m0 * DM) + F.lane; const v2u* xb = xa + DM / 4;
#pragma unroll
          for (int j = 0; j < 4; ++j) { const v2u wa = xa[64 * j], wb = xb[64 * j]; va[j] = (f32x4){bflo(wa.x), bfhi(wa.x), bflo(wa.y), bfhi(wa.y)}; vb[j] = (f32x4){bflo(wb.x), bfhi(wb.x), bflo(wb.y), bfhi(wb.y)}; } }
        float sa = 0.f, sb = 0.f;
#pragma unroll
        for (int j = 0; j < 4; ++j) { sa += (va[j].x * va[j].x + va[j].y * va[j].y) + (va[j].z * va[j].z + va[j].w * va[j].w); sb += (vb[j].x * vb[j].x + vb[j].y * vb[j].y) + (vb[j].z * vb[j].z + vb[j].w * vb[j].w); }
        const float ra = 1.f / sqrtf(wave_sum(sa) * (1.f / DM) + EPS), rb = 1.f / sqrtf(wave_sum(sb) * (1.f / DM) + EPS);
        { const f32x4* gr = (const f32x4*)gn + F.lane;
#pragma unroll
          for (int j = 0; j < 4; ++j) { const f32x4 g4 = gr[64 * j]; va[j] = va[j] * ra * g4; vb[j] = vb[j] * rb * g4; } }
        store_row_bf16(H + (size_t)m0 * DM, va, F.lane); store_row_bf16(H + (size_t)(m0 + 1) * DM, vb, F.lane);
        float pa[16], pb[16];
#pragma unroll
        for (int e = 0; e < 16; ++e) { float a = 0.f, c = 0.f;
#pragma unroll
            for (int j = 0; j < 4; ++j) { const f32x4 w4 = *(const LAS f32x4*)(wl + e * 1024 + 4 * F.lane + 256 * j);
                a += (va[j].x * w4.x + va[j].y * w4.y) + (va[j].z * w4.z + va[j].w * w4.w); c += (vb[j].x * w4.x + vb[j].y * w4.y) + (vb[j].z * w4.z + vb[j].w * w4.w); }
            pa[e] = a; pb[e] = c; }
        const float la = red16(pa, F.lane), lb = red16(pb, F.lane);
        const float ma = wave_max(la), mb = wave_max(lb); const float ea = expf(la - ma), eb = expf(lb - mb); const float za = wave_sum(ea) * 0.25f, zb = wave_sum(eb) * 0.25f;
        if ((F.lane & 3) == 0) { const int b = m0 / SEQ, sq = m0 % SEQ; float* ap = AFF + (size_t)(b * 16 + red16_idx(F.lane)) * SEQ + sq; ap[0] = ea / za; ap[1] = eb / zb; }
    }
}

DI int block_excl_scan(int v, LAS int* scratch, int tid, int lane, int wave, int* tot) {
    int inc = v;
#pragma unroll
    for (int o = 1; o < 64; o <<= 1) { const int t = __shfl_up(inc, o); if (lane >= o) inc += t; }
    __syncthreads();
    if (lane == 63) scratch[wave] = inc;
    __syncthreads();
    int base = 0, total = 0;
#pragma unroll
    for (int w = 0; w < NWAVES; ++w) { const int s = scratch[w]; if (w < wave) base += s; total += s; }
    *tot = total;
    return base + inc - v;
}
DI void phase_topk(Frame& F) {
    const float* AFF = (const float*)(F.ws + WS_AFF); int* IDX = (int*)(F.ws + WS_IDX); float* GATE = (float*)(F.ws + WS_GATE); int* POS = (int*)(F.ws + WS_POS);
    LAS unsigned* hist = (LAS unsigned*)F.lds; LAS int* sc = (LAS int*)(F.lds + 16384); LAS unsigned* shv = (LAS unsigned*)(F.lds + 16384 + 256);
    for (int u = F.bid; u < BATCH * NEXP; u += F.G) {
        const int b = u / NEXP, e = u % NEXP;
        unsigned vals[16];
        { const v4u* src = (const v4u*)(AFF + (size_t)u * SEQ + 16 * F.tid);
#pragma unroll
          for (int j = 0; j < 4; ++j) { const v4u t = src[j]; vals[4 * j] = t.x; vals[4 * j + 1] = t.y; vals[4 * j + 2] = t.z; vals[4 * j + 3] = t.w; } }
        unsigned prefix = 0; int krem = CAP;
#pragma unroll
        for (int pass = 0; pass < 3; ++pass) {
            const int shift = (pass == 0) ? 20 : (pass == 1 ? 8 : 0); const unsigned mask = (pass == 2) ? 255u : 4095u; const int pshift = (pass == 2) ? 8 : 20;
            __syncthreads();
#pragma unroll
            for (int j = 0; j < 8; ++j) hist[F.tid + 512 * j] = 0u;
            __syncthreads();
#pragma unroll
            for (int j = 0; j < 16; ++j) { const unsigned v = vals[j]; if (pass == 0 || (v >> pshift) == prefix) __hip_atomic_fetch_add(&hist[(v >> shift) & mask], 1u, __ATOMIC_RELAXED, __HIP_MEMORY_SCOPE_WORKGROUP); }
            __syncthreads();
            const int hi = 4095 - 8 * F.tid; int ls = 0; unsigned hb[8];
#pragma unroll
            for (int j = 0; j < 8; ++j) { hb[j] = hist[hi - j]; ls += (int)hb[j]; }
            int tot; const int above = block_excl_scan(ls, sc, F.tid, F.lane, F.wave, &tot);
            if (above < krem && krem <= above + ls) { int cum = above, sel = hi, found = 0;
#pragma unroll
                for (int j = 0; j < 8; ++j) { if (!found) { if (cum + (int)hb[j] >= krem) { sel = hi - j; found = 1; } else cum += (int)hb[j]; } }
                shv[0] = (unsigned)sel; shv[1] = (unsigned)(krem - cum); }
            __syncthreads();
            prefix = (pass == 2) ? ((prefix << 8) | shv[0]) : ((prefix << 12) | shv[0]); krem = (int)shv[1];
        }
        const unsigned T = prefix;
        int ce = 0;
#pragma unroll
        for (int j = 0; j < 16; ++j) ce += (vals[j] == T) ? 1 : 0;
        int tot; int pe = block_excl_scan(ce, sc, F.tid, F.lane, F.wave, &tot);
        unsigned selmask = 0; int cs = 0;
#pragma unroll
        for (int j = 0; j < 16; ++j) { bool s = vals[j] > T; if (vals[j] == T) { s = pe < krem; ++pe; } if (s) { selmask |= 1u << j; ++cs; } }
        int slot = block_excl_scan(cs, sc, F.tid, F.lane, F.wave, &tot);
#pragma unroll
        for (int j = 0; j < 16; ++j) { const int s = 16 * F.tid + j; const int tokrow = b * SEQ + s;
            if (selmask & (1u << j)) { const int row = (e * 2 + b) * CAP + slot; ++slot; IDX[row] = tokrow; GATE[row] = __builtin_bit_cast(float, vals[j]); POS[tokrow * 16 + e] = row; }
            else POS[tokrow * 16 + e] = -1; }
    }
}
DI void phase_gather(Frame& F) {
    const bf16* H = (const bf16*)(F.ws + WS_H); bf16* XE = (bf16*)(F.ws + WS_XE); const int* IDX = (const int*)(F.ws + WS_IDX);
    for (int r = F.gw; r < NROWS; r += F.NGW) { const int src = IDX[r];
        const v4u* s = (const v4u*)(H + (size_t)src * DM) + F.lane; v4u* d = (v4u*)(XE + (size_t)r * DM) + F.lane;
        d[0] = s[0]; d[64] = s[64]; }
}
struct CombRow { f32x4 v[4]; v2u y[4][4]; float sc[4]; unsigned rest; int pm; };
DI void comb_load(CombRow& c, const bf16* XR, const bf16* Y, const int* POS, int m, int lane) {
    const v2u* xr = (const v2u*)(XR + (size_t)m * DM) + lane;
#pragma unroll
    for (int j = 0; j < 4; ++j) { const v2u w = xr[64 * j]; c.v[j] = (f32x4){bflo(w.x), bfhi(w.x), bflo(w.y), bfhi(w.y)}; }
    c.pm = POS[m * 16 + (lane & 15)];
    unsigned mk = (unsigned)__builtin_amdgcn_readfirstlane((int)(unsigned)(__ballot(lane < 16 && c.pm >= 0)));
#pragma unroll
    for (int q = 0; q < 4; ++q) {
        int p = -1;
        if (mk) { const int e = __builtin_ctz(mk); mk &= mk - 1u; p = __builtin_amdgcn_readlane(c.pm, e); }
        c.sc[q] = (p >= 0) ? 1.f : 0.f;
        const v2u* yr = (const v2u*)(Y + (size_t)(p >= 0 ? p : 0) * DM) + lane;
#pragma unroll
        for (int j = 0; j < 4; ++j) c.y[q][j] = yr[64 * j];
    }
    c.rest = mk;
}
DI void comb_finish(CombRow& c, bf16* XR, float* out, bf16* H, const bf16* Y, const float* gnext, bool final_out, int m, int lane) {
#pragma unroll
    for (int q = 0; q < 4; ++q)
#pragma unroll
        for (int j = 0; j < 4; ++j) { const v2u w = c.y[q][j]; const float s = c.sc[q]; c.v[j].x += s * bflo(w.x); c.v[j].y += s * bfhi(w.x); c.v[j].z += s * bflo(w.y); c.v[j].w += s * bfhi(w.y); }
    unsigned mk = c.rest;
    while (mk) { const int e = __builtin_ctz(mk); mk &= mk - 1u; const int p = __builtin_amdgcn_readlane(c.pm, e);
        const v2u* yr = (const v2u*)(Y + (size_t)p * DM) + lane;
#pragma unroll
        for (int j = 0; j < 4; ++j) { const v2u w = yr[64 * j]; c.v[j].x += bflo(w.x); c.v[j].y += bfhi(w.x); c.v[j].z += bflo(w.y); c.v[j].w += bfhi(w.y); } }
    float s = 0.f;
#pragma unroll
    for (int j = 0; j < 4; ++j) s += (c.v[j].x * c.v[j].x + c.v[j].y * c.v[j].y) + (c.v[j].z * c.v[j].z + c.v[j].w * c.v[j].w);
    const float rstd = 1.f / sqrtf(wave_sum(s) * (1.f / DM) + EPS);
    const f32x4* gr = (const f32x4*)gnext + lane;
    if (final_out) {
        f32x4* xo = (f32x4*)(out + (size_t)m * DM) + lane;
#pragma unroll
        for (int j = 0; j < 4; ++j) xo[64 * j] = c.v[j] * rstd * gr[64 * j];
    } else {
        store_row_bf16(XR + (size_t)m * DM, c.v, lane);
        f32x4 nv[4];
#pragma unroll
        for (int j = 0; j < 4; ++j) nv[j] = c.v[j] * rstd * gr[64 * j];
        store_row_bf16(H + (size_t)m * DM, nv, lane);
    }
}
DI void phase_moe_combine(Frame& F, bf16* XR, float* out, const float* gnext, bool final_out) {
    const bf16* Y = (const bf16*)(F.ws + WS_Y); const int* POS = (const int*)(F.ws + WS_POS); bf16* H = (bf16*)(F.ws + WS_H);
    for (int m = F.gw; m < MTOK; m += 2 * F.NGW) {
        CombRow ca, cb; const int m2 = m + F.NGW;
        comb_load(ca, XR, Y, POS, m, F.lane);
        if (m2 < MTOK) comb_load(cb, XR, Y, POS, m2, F.lane);
        comb_finish(ca, XR, out, H, Y, gnext, final_out, m, F.lane);
        if (m2 < MTOK) comb_finish(cb, XR, out, H, Y, gnext, final_out, m2, F.lane);
    }
}

DI int kperm(int r) { return (r & ~12) | ((r & 4) << 1) | ((r & 8) >> 1); }
DI void phase_kvf(Frame& F) {
    const bf16* QKV = (const bf16*)(F.ws + WS_QKV); unsigned char* KF = F.ws + WS_KF; unsigned char* VF = F.ws + WS_VF;
    LAS unsigned char* kl = F.lds; LAS unsigned char* vl = F.lds + 69632;
    for (int u = F.bid; u < 512; u += F.G) {
        const int c = u & 15, h = (u >> 4) & 15, b = u >> 8, t0 = c * 512;
        __syncthreads();
        { const v4u* ks = (const v4u*)(QKV + (size_t)(b * SEQ + t0 + F.tid) * NQKV + 1024 + h * 64); const v4u* vs = (const v4u*)(QKV + (size_t)(b * SEQ + t0 + F.tid) * NQKV + 2048 + h * 64);
#pragma unroll
          for (int j = 0; j < 8; ++j) { const v4u w = ks[j]; LAS v2u* d = (LAS v2u*)(kl + F.tid * 136 + 16 * j); d[0] = (v2u){w.x, w.y}; d[1] = (v2u){w.z, w.w}; }
#pragma unroll
          for (int j = 0; j < 8; ++j) { const v4u w = vs[j]; LAS v2u* d = (LAS v2u*)(vl + F.tid * 136 + 16 * j); d[0] = (v2u){w.x, w.y}; d[1] = (v2u){w.z, w.w}; } }
        __syncthreads();
#pragma unroll
        for (int p = 0; p < 3; ++p) {
            const int dl = (p == 0) ? 1 : (p == 1 ? 4 : 16), tpr = 16 / dl, ntile = SEQ / dl / 32;
            unsigned char* kd = KF + (size_t)p * 32 * MiB; unsigned char* vd = VF + (size_t)p * 32 * MiB;
#pragma unroll 2
            for (int i = 0; i < 8; ++i) { const int q = F.tid + 512 * i, tl = q >> 8, ln = q & 63, hh = ln >> 5, rho = ln & 31, r = tl / tpr, tt = tl % tpr;
                const size_t tg = ((size_t)((b * 16 + h) * dl + r) * ntile + c * tpr + tt) * 4096;
                { const int s = (q >> 6) & 3, tokl = dl * (32 * tt + kperm(rho)) + r;
                  const LAS v2u* sp = (const LAS v2u*)(kl + tokl * 136 + 64 * hh + 16 * s); const v2u a0 = sp[0], a1 = sp[1];
                  *(v4u*)(kd + tg + s * 1024 + ln * 16) = (v4u){a0.x, a0.y, a1.x, a1.y}; }
                { const int dt = (q >> 7) & 1, s2 = (q >> 6) & 1, dim = 32 * dt + rho; unsigned short e[8];
#pragma unroll
                  for (int k = 0; k < 8; ++k) e[k] = *(const LAS unsigned short*)(vl + (dl * (32 * tt + 16 * s2 + 8 * hh + k) + r) * 136 + dim * 2);
                  v4u o; o.x = e[0] | ((unsigned)e[1] << 16); o.y = e[2] | ((unsigned)e[3] << 16); o.z = e[4] | ((unsigned)e[5] << 16); o.w = e[6] | ((unsigned)e[7] << 16);
                  *(v4u*)(vd + tg + (dt * 2 + s2) * 1024 + ln * 16) = o; }
            }
        }
    }
}

DI int osw(int tok, int chunk) { return tok * 256 + (((chunk ^ tok ^ (tok >> 4)) & 15) << 4); }
struct AttnK { bf16x8 k[4]; }; struct AttnV { bf16x8 v[2][2]; };
#ifndef PROBE_DUP
#define PROBE_DUP (-1)
#endif
#ifndef PROBE_SAME
#define PROBE_SAME 0
#endif
DI void attn_load_k(AttnK& t, const unsigned char* kt) {
#pragma unroll
    for (int s = 0; s < 4; ++s) t.k[s] = *(const bf16x8*)(kt + s * 1024);
    if (PROBE_DUP == 77) {
#pragma unroll
        for (int s = 0; s < 4; ++s) { bf16x8 d = *(const bf16x8*)(kt + s * 1024 + (PROBE_SAME ? 0 : 64 * MiB)); asm volatile("" :: "v"(d)); }
    }
}
DI void attn_load_v(AttnV& t, const unsigned char* vt) {
#pragma unroll
    for (int dt = 0; dt < 2; ++dt)
#pragma unroll
        for (int s = 0; s < 2; ++s) t.v[dt][s] = *(const bf16x8*)(vt + (dt * 2 + s) * 1024);
}
template <bool MASK> DI void attn_step(const AttnK& tk, const AttnV& tv, const bf16x8 (&qf)[4], f32x16& o0, f32x16& o1, float& m, float& l, const LAS float* bl, int rel0, int hh) {
    f32x16 sa;
#pragma unroll
    for (int i = 0; i < 16; ++i) sa[i] = 0.f;
#pragma unroll
    for (int s = 0; s < 4; ++s) sa = MFMA32(tk.k[s], qf[s], sa);
    float sc[16]; float tmax = -1e30f;
#pragma unroll
    for (int i = 0; i < 16; ++i) { const int rel = rel0 + 16 * (i >> 3) + (i & 7);
        const bool valid = !MASK || ((rel >= -64) && (rel <= 64)); const int idx = valid ? rel + 64 : 0;
        const float v = sa[i] + bl[idx]; sc[i] = valid ? v : -1e30f; tmax = fmaxf(tmax, sc[i]); }
    tmax = fmaxf(tmax, __shfl_xor(tmax, 32));
    const float mnew = fmaxf(m, tmax), alpha = fexp(m - mnew);
    float ps = 0.f; float p[16];
#pragma unroll
    for (int i = 0; i < 16; ++i) { p[i] = (!MASK || sc[i] > -1e29f) ? fexp(sc[i] - mnew) : 0.f; ps += p[i]; }
    l = l * alpha + ps; m = mnew;
#pragma unroll
    for (int i = 0; i < 16; ++i) { o0[i] *= alpha; o1[i] *= alpha; }
#pragma unroll
    for (int s = 0; s < 2; ++s) {
        v4u w; w.x = pk2(p[8 * s], p[8 * s + 1]); w.y = pk2(p[8 * s + 2], p[8 * s + 3]); w.z = pk2(p[8 * s + 4], p[8 * s + 5]); w.w = pk2(p[8 * s + 6], p[8 * s + 7]);
        const bf16x8 pf = __builtin_bit_cast(bf16x8, w);
        o0 = MFMA32(tv.v[0][s], pf, o0); o1 = MFMA32(tv.v[1][s], pf, o1);
    }
}
DI void attn_stage(Frame& F, int b, int h, int t0, const int P) {
    const int dsh = 2 * P, DL = 1 << dsh, NT = (SEQ / 32) >> dsh;
    const bf16* QKV = (const bf16*)(F.ws + WS_QKV); const unsigned char* KF = F.ws + WS_KF + (size_t)P * 32 * MiB; const unsigned char* VF = F.ws + WS_VF + (size_t)P * 32 * MiB; bf16* ATT = (bf16*)(F.ws + WS_ATT);
    LAS unsigned char* ol = F.lds; LAS float* ml = (LAS float*)(F.lds + 131072); LAS float* ll = ml + 512; const LAS float* bl = (const LAS float*)(F.lds + 135168) + P * 132;
    int lane = F.lane; asm volatile("" : "+v"(lane));
    const int r32 = lane & 31, hh = lane >> 5, w = F.wave;
    asm volatile("" ::: "memory");
    int rr[2], mq[2], tq[2]; const unsigned char* kb[2]; const unsigned char* vb[2];
#pragma unroll
    for (int task = 0; task < 2; ++task) {
        int r, i0;
        if (P == 0) { r = 0; i0 = 64 * w + 32 * task; } else if (P == 1) { r = w & 3; i0 = 64 * (w >> 2) + 32 * task; } else { r = 2 * w + task; i0 = 0; }
        rr[task] = r; mq[task] = (t0 >> dsh) + i0; tq[task] = r + ((i0 + r32) << dsh);
        const size_t tb0 = ((size_t)((b * 16 + h) * DL + r) * NT) * 4096 + lane * 16;
        kb[task] = KF + tb0; vb[task] = VF + tb0;
    }
    int relb = 8 * hh - 64 - r32;
    asm volatile("" : "+v"(relb));
    AttnK ka, kb_, kc; AttnV va, vb_; bf16x8 qf[4], qn[4]; f32x16 o0, o1; float m, l;
#define ATT_T(task, kt) (mq[task] / 32 - 2 + (kt))
#define ATT_OK(task, kt) (ATT_T(task, kt) >= 0 && ATT_T(task, kt) < NT)
#define ATT_TC(task, kt) (ATT_T(task, kt) < 0 ? 0 : (ATT_T(task, kt) >= NT ? NT - 1 : ATT_T(task, kt)))
#define ATT_LDK(t, task, kt) attn_load_k(t, kb[task] + (size_t)ATT_TC(task, kt) * 4096)
#define ATT_LDV(t, task, kt) attn_load_v(t, vb[task] + (size_t)ATT_TC(task, kt) * 4096)
#define ATT_ST(tk, tv, task, kt, MSK) do { if (ATT_OK(task, kt)) attn_step<MSK>(tk, tv, qf, o0, o1, m, l, bl, relb + 32 * (kt), hh); } while (0)
#define ATT_Q(dst, task) do { const bf16* qp = QKV + (size_t)(b * SEQ + t0 + tq[task]) * NQKV + h * 64 + 32 * hh; _Pragma("unroll") for (int s = 0; s < 4; ++s) dst[s] = *(const bf16x8*)(qp + 8 * s); } while (0)
#define ATT_INIT(task) do { if (P == 0) { _Pragma("unroll") for (int i = 0; i < 16; ++i) { o0[i] = 0.f; o1[i] = 0.f; } m = -1e30f; l = 0.f; } else { \
        _Pragma("unroll") for (int g = 0; g < 4; ++g) { const f32x4 a = *(const LAS f32x4*)(ol + osw(tq[task], 2 * g + hh)), c = *(const LAS f32x4*)(ol + osw(tq[task], 8 + 2 * g + hh)); \
            o0[4 * g] = a.x; o0[4 * g + 1] = a.y; o0[4 * g + 2] = a.z; o0[4 * g + 3] = a.w; o1[4 * g] = c.x; o1[4 * g + 1] = c.y; o1[4 * g + 2] = c.z; o1[4 * g + 3] = c.w; } \
        m = ml[tq[task]]; l = hh ? 0.f : ll[tq[task]]; } } while (0)
#define ATT_WB(task) do { const float lt = l + __shfl_xor(l, 32); int tw = tq[task]; asm volatile("" : "+v"(tw));     \
        if (P < 2) { _Pragma("unroll") for (int g = 0; g < 4; ++g) { *(LAS f32x4*)(ol + osw(tw, 2 * g + hh)) = (f32x4){o0[4 * g], o0[4 * g + 1], o0[4 * g + 2], o0[4 * g + 3]}; \
                *(LAS f32x4*)(ol + osw(tw, 8 + 2 * g + hh)) = (f32x4){o1[4 * g], o1[4 * g + 1], o1[4 * g + 2], o1[4 * g + 3]}; } \
            if (hh == 0) { ml[tw] = m; ll[tw] = lt; } } \
        else { const float inv = 1.f / lt; bf16* op = ATT + (size_t)(b * SEQ + t0 + tw) * DM + h * 64 + 4 * hh; \
            _Pragma("unroll") for (int g = 0; g < 4; ++g) { v2u a, c; a.x = pk2(o0[4 * g] * inv, o0[4 * g + 1] * inv); a.y = pk2(o0[4 * g + 2] * inv, o0[4 * g + 3] * inv); \
                c.x = pk2(o1[4 * g] * inv, o1[4 * g + 1] * inv); c.y = pk2(o1[4 * g + 2] * inv, o1[4 * g + 3] * inv); *(v2u*)(op + 8 * g) = a; *(v2u*)(op + 32 + 8 * g) = c; } } } while (0)
    ATT_LDK(ka, 0, 0); ATT_LDK(kb_, 0, 1); ATT_LDV(va, 0, 0);
    ATT_Q(qf, 0); ATT_INIT(0);
    ATT_LDK(kc, 0, 2); ATT_LDV(vb_, 0, 1); ATT_ST(ka, va, 0, 0, true);
    ATT_LDK(ka, 0, 3); ATT_LDV(va, 0, 2); ATT_ST(kb_, vb_, 0, 1, false);
    ATT_LDK(kb_, 0, 4); ATT_LDV(vb_, 0, 3); ATT_ST(kc, va, 0, 2, false);
    ATT_Q(qn, 1);
    ATT_LDK(kc, 1, 0); ATT_LDV(va, 0, 4); ATT_ST(ka, vb_, 0, 3, false);
    ATT_LDK(ka, 1, 1); ATT_LDV(vb_, 1, 0); ATT_ST(kb_, va, 0, 4, true);
    ATT_WB(0);
    _Pragma("unroll") for (int s = 0; s < 4; ++s) qf[s] = qn[s];
    ATT_INIT(1);
    ATT_LDK(kb_, 1, 2); ATT_LDV(va, 1, 1); ATT_ST(kc, vb_, 1, 0, true);
    ATT_LDK(kc, 1, 3); ATT_LDV(vb_, 1, 2); ATT_ST(ka, va, 1, 1, false);
    ATT_LDK(ka, 1, 4); ATT_LDV(va, 1, 3); ATT_ST(kb_, vb_, 1, 2, false);
    ATT_LDV(vb_, 1, 4); ATT_ST(kc, va, 1, 3, false);
    ATT_ST(ka, vb_, 1, 4, true);
    ATT_WB(1);
#undef ATT_T
#undef ATT_OK
#undef ATT_TC
#undef ATT_LDK
#undef ATT_LDV
#undef ATT_ST
#undef ATT_Q
#undef ATT_INIT
#undef ATT_WB
}
DI void phase_attn(Frame& F) {
    const float* BT = (const float*)(F.ws + WS_BT);
    LAS float* bl = (LAS float*)(F.lds + 135168);
    const int vb_ = (F.G % 8 == 0) ? (F.bid % 8) * (F.G / 8) + F.bid / 8 : F.bid;
    for (int u = vb_; u < 512; u += F.G) {
        const int c = u & 15, h = (u >> 4) & 15, b = u >> 8, t0 = c * 512;
        __syncthreads();
        { int i0 = F.tid; asm volatile("" : "+v"(i0)); for (int i = i0; i < 3 * 129; i += NTHR) bl[(i / 129) * 132 + i % 129] = BT[((i / 129) * 16 + h) * 129 + i % 129]; }
        __syncthreads();
#pragma unroll 1
        for (int P = 0; P < 3; ++P) { if (P) __syncthreads(); attn_stage(F, b, h, t0, P); }
    }
}

constexpr int GL_QT = 0, GL_KT = 17408, GL_QB = 34816, GL_KHT = 52224, GL_VT = 70656, GL_P = 89088, GL_ST = 98304, GL_DEC = 133120, GL_TOT = 133632;
struct GlaRaw { v4u q[2], lf[2], v[2]; };
DI void gla_load_raw(GlaRaw& R, const _Float16* LF, const bf16* Q, const bf16* V, int b, int h, int dir, int pos0, int tid) {
#pragma unroll
    for (int i = 0; i < 2; ++i) { const int p = tid + 512 * i, ii = pos0 + (p >> 4); const int tok = dir ? (SEQ - 1 - ii) : ii; const size_t off = (size_t)(b * SEQ + tok) * AW + h * 128 + 8 * (p & 15);
        R.q[i] = *(const v4u*)(Q + off); R.lf[i] = *(const v4u*)(LF + off); R.v[i] = *(const v4u*)(V + off); }
}
DI void gla_prep(Frame& F, const GlaRaw& R) {
    LAS unsigned char* L = F.lds; LAS float* tot = (LAS float*)(L + GL_TOT);
    const int ch = F.tid & 127, qtr = F.tid >> 7;
#pragma unroll
    for (int i = 0; i < 2; ++i) { const int p = F.tid + 512 * i; const int so = (p >> 4) * 272 + 16 * (p & 15);
        *(LAS v4u*)(L + GL_QT + so) = R.q[i]; *(LAS v4u*)(L + GL_KT + so) = R.lf[i]; *(LAS v4u*)(L + GL_QB + so) = R.v[i]; }
    __syncthreads();
    float lf[16]; unsigned short qr[16], vr[16];
#pragma unroll
    for (int i = 0; i < 16; ++i) { const int so = (16 * qtr + i) * 272 + 2 * ch;
        qr[i] = *(const LAS unsigned short*)(L + GL_QT + so); lf[i] = (float)*(const LAS _Float16*)(L + GL_KT + so); vr[i] = *(const LAS unsigned short*)(L + GL_QB + so); }
    float c[16]; float run = 0.f;
#pragma unroll
    for (int i = 0; i < 16; ++i) { run += lf[i]; c[i] = run; }
    tot[qtr * 128 + ch] = run;
    __syncthreads();
    const float t0 = tot[ch], t1 = tot[128 + ch], t2 = tot[256 + ch], t3 = tot[384 + ch];
    const float off = (qtr > 0 ? t0 : 0.f) + (qtr > 1 ? t1 : 0.f) + (qtr > 2 ? t2 : 0.f), rr = t0 + t1, bend = (t0 + t1) + (t2 + t3);
    const float er = fexp(rr), ebr = fexp(bend - rr);
    unsigned kh[8], vv[8];
#pragma unroll
    for (int i = 0; i < 16; i += 2) {
        const float E0 = fexp(off + c[i] - rr), E1 = fexp(off + c[i + 1] - rr), I0 = frcp(E0), I1 = frcp(E1);
        const float k0 = 1.f - fexp(lf[i]), k1 = 1.f - fexp(lf[i + 1]);
        const float ki0 = k0 * I0, ki1 = k1 * I1;
        kh[i >> 1] = pk2(ki0 * ebr, ki1 * ebr);
        vv[i >> 1] = (unsigned)vr[i] | ((unsigned)vr[i + 1] << 16);
        const float q0 = bf2f(qr[i]) * E0, q1 = bf2f(qr[i + 1]) * E1;
        const int ta = 16 * qtr + i;
        *(LAS unsigned short*)(L + GL_QT + ta * 272 + 2 * ch) = (unsigned short)f2bf(q0);
        *(LAS unsigned short*)(L + GL_QT + (ta + 1) * 272 + 2 * ch) = (unsigned short)f2bf(q1);
        *(LAS unsigned short*)(L + GL_KT + ta * 272 + 2 * ch) = (unsigned short)f2bf(ki0);
        *(LAS unsigned short*)(L + GL_KT + (ta + 1) * 272 + 2 * ch) = (unsigned short)f2bf(ki1);
        *(LAS unsigned short*)(L + GL_QB + ta * 272 + 2 * ch) = (unsigned short)f2bf(q0 * er);
        *(LAS unsigned short*)(L + GL_QB + (ta + 1) * 272 + 2 * ch) = (unsigned short)f2bf(q1 * er);
    }
    *(LAS v4u*)(L + GL_KHT + ch * 144 + 32 * qtr) = (v4u){kh[0], kh[1], kh[2], kh[3]}; *(LAS v4u*)(L + GL_KHT + ch * 144 + 32 * qtr + 16) = (v4u){kh[4], kh[5], kh[6], kh[7]};
    *(LAS v4u*)(L + GL_VT + ch * 144 + 32 * qtr) = (v4u){vv[0], vv[1], vv[2], vv[3]}; *(LAS v4u*)(L + GL_VT + ch * 144 + 32 * qtr + 16) = (v4u){vv[4], vv[5], vv[6], vv[7]};
    if (qtr == 0) *(LAS float*)(L + GL_DEC + 4 * ch) = fexp(bend);
}
DI bf16x8 gfrag(const LAS unsigned char* base, int row, int stride, int kel) { return *(const LAS bf16x8*)(base + row * stride + kel * 2); }
DI void gla_state_update(Frame& F, f32x16 (&S)[2]) {
    const LAS unsigned char* L = F.lds; const int r32 = F.lane & 31, hh = F.lane >> 5, vi = F.wave & 3, ki0 = 2 * (F.wave >> 2);
    bf16x8 a[4];
#pragma unroll
    for (int s = 0; s < 4; ++s) a[s] = gfrag(L + GL_VT, 32 * vi + r32, 144, 16 * s + 8 * hh);
#pragma unroll
    for (int q = 0; q < 2; ++q) { const int kr = 32 * (ki0 + q) + r32; const float d = *(const LAS float*)(L + GL_DEC + 4 * kr);
#pragma unroll
        for (int j = 0; j < 16; ++j) S[q][j] *= d;
#pragma unroll
        for (int s = 0; s < 4; ++s) S[q] = MFMA32(a[s], gfrag(L + GL_KHT, kr, 144, 16 * s + 8 * hh), S[q]); }
}
DI void gla_state_to_lds(Frame& F, const f32x16 (&S)[2]) {
    LAS unsigned char* L = F.lds; const int r32 = F.lane & 31, hh = F.lane >> 5, vi = F.wave & 3, ki0 = 2 * (F.wave >> 2);
#pragma unroll
    for (int q = 0; q < 2; ++q)
#pragma unroll
        for (int j = 0; j < 16; ++j) *(LAS unsigned short*)(L + GL_ST + (32 * vi + crow32(j, hh)) * 272 + 2 * (32 * (ki0 + q) + r32)) = (unsigned short)f2bf(S[q][j]);
}
constexpr int G1_KHT = 0, G1_VT = 69632, G1_TOT = 139264;
DI void gla_unit_state(Frame& F, int u) {
    const int sc = u & 31, dir = (u >> 5) & 1, h = (u >> 6) & 3, b = u >> 8;
    const bf16* V = (const bf16*)(F.ws + WS_V); const _Float16* LF = (const _Float16*)(F.ws + (dir ? WS_LFB : WS_LFF));
    float* ST = (float*)(F.ws + WS_ST) + (size_t)u * 16384; float* DEC = (float*)(F.ws + WS_DEC) + u * 128;
    LAS unsigned char* L = F.lds; LAS float* tot = (LAS float*)(L + G1_TOT);
    const int ch = F.tid & 127, qtr = F.tid >> 7, r32 = F.lane & 31, hh = F.lane >> 5, vi = F.wave & 3, ki0 = 2 * (F.wave >> 2);
    { v4u rl[8], rv[8];
#pragma unroll
      for (int i = 0; i < 8; ++i) { const int p = F.tid + 512 * i, ii = sc * 256 + (p >> 4); const int tok = dir ? (SEQ - 1 - ii) : ii; const size_t off = (size_t)(b * SEQ + tok) * AW + h * 128 + 8 * (p & 15);
          rl[i] = *(const v4u*)(LF + off); rv[i] = *(const v4u*)(V + off); }
      __syncthreads();
#pragma unroll
      for (int i = 0; i < 8; ++i) { const int p = F.tid + 512 * i; const int so = (p >> 4) * 272 + 16 * (p & 15); *(LAS v4u*)(L + G1_KHT + so) = rl[i]; *(LAS v4u*)(L + G1_VT + so) = rv[i]; } }
    __syncthreads();
    float lf[64]; unsigned vv[32];
#pragma unroll
    for (int i = 0; i < 64; ++i) { const int so = (64 * qtr + i) * 272 + 2 * ch;
        lf[i] = (float)*(const LAS _Float16*)(L + G1_KHT + so); const unsigned x = *(const LAS unsigned short*)(L + G1_VT + so); if (i & 1) vv[i >> 1] |= x << 16; else vv[i >> 1] = x; }
    float run = 0.f;
#pragma unroll
    for (int i = 0; i < 64; ++i) run += lf[i];
    __syncthreads();
    tot[qtr * 128 + ch] = run;
#pragma unroll
    for (int i = 0; i < 32; i += 4) *(LAS v4u*)(L + G1_VT + ch * 528 + 128 * qtr + 4 * i) = (v4u){vv[i], vv[i + 1], vv[i + 2], vv[i + 3]};
    __syncthreads();
    const float t0 = tot[ch], t1 = tot[128 + ch], t2 = tot[256 + ch], t3 = tot[384 + ch];
    const float bend = (t0 + t1) + (t2 + t3);
    run = (qtr > 0 ? t0 : 0.f) + (qtr > 1 ? t1 : 0.f) + (qtr > 2 ? t2 : 0.f);
#pragma unroll
    for (int i = 0; i < 64; i += 2) { const float b0 = run + lf[i], b1 = b0 + lf[i + 1]; run = b1;
        vv[i >> 1] = pk2((1.f - fexp(lf[i])) * fexp(bend - b0), (1.f - fexp(lf[i + 1])) * fexp(bend - b1)); }
#pragma unroll
    for (int i = 0; i < 32; i += 4) *(LAS v4u*)(L + G1_KHT + ch * 528 + 128 * qtr + 4 * i) = (v4u){vv[i], vv[i + 1], vv[i + 2], vv[i + 3]};
    if (qtr == 0) DEC[ch] = fexp(bend);
    __syncthreads();
    f32x16 S[2];
#pragma unroll
    for (int j = 0; j < 16; ++j) { S[0][j] = 0.f; S[1][j] = 0.f; }
#pragma unroll 4
    for (int s = 0; s < 16; ++s) { const bf16x8 av = gfrag(L + G1_VT, 32 * vi + r32, 528, 16 * s + 8 * hh);
        S[0] = MFMA32(av, gfrag(L + G1_KHT, 32 * ki0 + r32, 528, 16 * s + 8 * hh), S[0]);
        S[1] = MFMA32(av, gfrag(L + G1_KHT, 32 * (ki0 + 1) + r32, 528, 16 * s + 8 * hh), S[1]); }
#pragma unroll
    for (int q = 0; q < 2; ++q)
#pragma unroll
        for (int g = 0; g < 4; ++g) *(f32x4*)(ST + (size_t)(32 * (ki0 + q) + r32) * 128 + 32 * vi + 8 * g + 4 * hh) = (f32x4){S[q][4 * g], S[q][4 * g + 1], S[q][4 * g + 2], S[q][4 * g + 3]};
}
DI int red16h_idx(int lane) { return 8 * ((lane >> 4) & 1) + 4 * ((lane >> 3) & 1) + 2 * ((lane >> 2) & 1) + ((lane >> 1) & 1); }
DI float red16h(const float (&o)[16], int lane) {
    const bool b16 = lane & 16, b8 = lane & 8, b4 = lane & 4, b2 = lane & 2;
    float a8[8], a4[4], a2[2], a1;
#pragma unroll
    for (int j = 0; j < 8; ++j) { const float send = b16 ? o[j] : o[j + 8], keep = b16 ? o[j + 8] : o[j]; a8[j] = keep + __shfl_xor(send, 16); }
#pragma unroll
    for (int j = 0; j < 4; ++j) { const float send = b8 ? a8[j] : a8[j + 4], keep = b8 ? a8[j + 4] : a8[j]; a4[j] = keep + __shfl_xor(send, 8); }
#pragma unroll
    for (int j = 0; j < 2; ++j) { const float send = b4 ? a4[j] : a4[j + 2], keep = b4 ? a4[j + 2] : a4[j]; a2[j] = keep + __shfl_xor(send, 4); }
    { const float send = b2 ? a2[0] : a2[1], keep = b2 ? a2[1] : a2[0]; a1 = keep + __shfl_xor(send, 2); }
    a1 += __shfl_xor(a1, 1);
    return a1;
}
constexpr int GL_RS = 135680;
template <bool FUSE> DI void gla_unit_out(Frame& F, const Args& a, int u) {
    const int sc = u & 31, dir = (u >> 5) & 1, h = (u >> 6) & 3, b = u >> 8;
    const bf16* Q = (const bf16*)(F.ws + WS_Q); const bf16* V = (const bf16*)(F.ws + WS_V); const _Float16* LF = (const _Float16*)(F.ws + (dir ? WS_LFB : WS_LFF));
    const float* ST = (const float*)(F.ws + WS_ST) + (size_t)u * 16384; float* OF = (float*)(F.ws + WS_ODIR);
    const bf16* G = (const bf16*)(F.ws + WS_G); bf16* CAT = (bf16*)(F.ws + WS_CAT);
    const LAS unsigned char* L = F.lds;
    const int ch = F.tid & 127, qtr = F.tid >> 7, r32 = F.lane & 31, hh = F.lane >> 5, w = F.wave, vi = w & 3, ki0 = 2 * (w >> 2), ti = w >> 2;
    f32x16 S[2];
#pragma unroll
    for (int q = 0; q < 2; ++q)
#pragma unroll
        for (int g = 0; g < 4; ++g) { const f32x4 t = *(const f32x4*)(ST + (size_t)(32 * (ki0 + q) + r32) * 128 + 32 * vi + 8 * g + 4 * hh); S[q][4 * g] = t.x; S[q][4 * g + 1] = t.y; S[q][4 * g + 2] = t.z; S[q][4 * g + 3] = t.w; }
    GlaRaw cur, nxt;
    gla_load_raw(cur, LF, Q, V, b, h, dir, sc * 256, F.tid);
    __syncthreads();
    gla_state_to_lds(F, S);
    f32x4 ngv[4];
    if (FUSE) {
#pragma unroll
        for (int g = 0; g < 4; ++g) ngv[g] = *(const f32x4*)(a.in[11] + h * 128 + 32 * vi + 8 * g + 4 * hh);
    }
#pragma unroll 1
    for (int c = 0; c < 4; ++c) {
        gla_prep(F, cur);
        if (c < 3) gla_load_raw(nxt, LF, Q, V, b, h, dir, sc * 256 + (c + 1) * 64, F.tid);
        const int ii = sc * 256 + c * 64 + 32 * ti + r32; const int tok = dir ? (SEQ - 1 - ii) : ii;
        const size_t orow = (size_t)(b * SEQ + tok) * AW + h * 128 + 32 * vi + 4 * hh;
        f32x4 of[4]; v2u gg[4];
        if (FUSE) {
#pragma unroll
            for (int g = 0; g < 4; ++g) { of[g] = *(const f32x4*)(OF + orow + 8 * g); gg[g] = *(const v2u*)(G + orow + 8 * g); }
        }
        __syncthreads();
        f32x16 o;
#pragma unroll
        for (int j = 0; j < 16; ++j) o[j] = 0.f;
#pragma unroll
        for (int s = 0; s < 8; ++s) o = MFMA32(gfrag(L + GL_ST, 32 * vi + r32, 272, 16 * s + 8 * hh), gfrag(L + GL_QB, 32 * ti + r32, 272, 16 * s + 8 * hh), o);
        if (w < 3) {
            const int tp = (w + 1) >> 1, sp = (w == 2) ? 1 : 0;
            f32x16 p;
#pragma unroll
            for (int j = 0; j < 16; ++j) p[j] = 0.f;
#pragma unroll
            for (int s = 0; s < 8; ++s) p = MFMA32(gfrag(L + GL_QT, 32 * tp + r32, 272, 16 * s + 8 * hh), gfrag(L + GL_KT, 32 * sp + r32, 272, 16 * s + 8 * hh), p);
#pragma unroll
            for (int j = 0; j < 16; ++j) { const int t = 32 * tp + crow32(j, hh), s2 = 32 * sp + r32;
                *(LAS unsigned short*)(F.lds + GL_P + t * 144 + 2 * s2) = (s2 <= t) ? (unsigned short)f2bf(p[j]) : (unsigned short)0; }
        }
        __syncthreads();
        { const int ns = ti ? 4 : 2;
#pragma unroll
          for (int s = 0; s < 4; ++s) if (s < ns) o = MFMA32(gfrag(L + GL_VT, 32 * vi + r32, 144, 16 * s + 8 * hh), gfrag(L + GL_P, 32 * ti + r32, 144, 16 * s + 8 * hh), o); }
        if (!FUSE) {
#pragma unroll
            for (int g = 0; g < 4; ++g) *(f32x4*)(OF + orow + 8 * g) = (f32x4){o[4 * g], o[4 * g + 1], o[4 * g + 2], o[4 * g + 3]};
        } else {
            float part = 0.f;
#pragma unroll
            for (int g = 0; g < 4; ++g) { o[4 * g] += of[g].x; o[4 * g + 1] += of[g].y; o[4 * g + 2] += of[g].z; o[4 * g + 3] += of[g].w; }
#pragma unroll
            for (int j = 0; j < 16; ++j) part += o[j] * o[j];
            part += __shfl_xor(part, 32);
            if (hh == 0) *(LAS float*)(F.lds + GL_RS + ((ti * 32 + r32) * 4 + vi) * 4) = part;
        }
        if (c < 3) { gla_state_update(F, S); gla_state_to_lds(F, S); }
        cur = nxt;
        __syncthreads();
        if (FUSE) {
            const f32x4 ps = *(const LAS f32x4*)(L + GL_RS + (ti * 32 + r32) * 16);
            const float rstd = 1.f / sqrtf(((ps.x + ps.y) + (ps.z + ps.w)) * (1.f / 128.f) + EPS);
            bf16* crow_ = CAT + (size_t)(b * SEQ + tok) * DM + 512 + h * 128 + 32 * vi + 4 * hh;
#pragma unroll
            for (int g = 0; g < 4; ++g) { v2u wv; wv.x = pk2(o[4 * g] * rstd * ngv[g].x * bflo(gg[g].x), o[4 * g + 1] * rstd * ngv[g].y * bfhi(gg[g].x));
                wv.y = pk2(o[4 * g + 2] * rstd * ngv[g].z * bflo(gg[g].y), o[4 * g + 3] * rstd * ngv[g].w * bfhi(gg[g].y));
                *(v2u*)(crow_ + 8 * g) = wv; }
        }
    }
}

__global__ void __launch_bounds__(NTHR, 2) fwd_kernel(Args args) {
    extern __shared__ __attribute__((aligned(16))) unsigned char lds[];
    Frame F;
    F.lds = (LAS unsigned char*)lds;
    F.MISC = (volatile LAS unsigned*)(F.lds + MISC_OFF);
    F.tid = threadIdx.x; F.lane = F.tid & 63; F.wave = __builtin_amdgcn_readfirstlane(F.tid >> 6);
    F.G = gridDim.x; F.bid = blockIdx.x; F.gw = F.bid * NWAVES + F.wave; F.NGW = F.G * NWAVES;
    F.ws = args.ws;
    unsigned* ctl = (unsigned*)(args.ws + WS_CTL);
    for (int u = F.tid; u < (LDS_BYTES - LDSCTL_OFF) / 4; u += NTHR) ((LAS unsigned*)(F.lds + LDSCTL_OFF))[u] = 0u;
    __syncthreads();
    const int lo = args.ph_lo, hi = args.ph_hi;
    XcdBarrier bar; bar.bar = ctl + CW_BAR + args.li * XCD_BAR_WORDS; bar.x = 0; bar.st = nullptr;
    if (hi - lo > 1) bar = xcd_barrier_post(ctl + CW_BAR + args.li * XCD_BAR_WORDS, F.MISC + 8);
#define IN(k) (lo <= (k) && (k) < hi)
#ifndef PROBE_DUP
#define PROBE_DUP (-1)
#endif
#define REP(k) for (int rep_ = 0; rep_ < (((PROBE_DUP) == (k)) ? 2 : 1); ++rep_)
#define SEAM(k) do { if (IN(k) && IN((k) + 1)) { xcd_barrier(bar); if (PROBE_DUP == 99) xcd_barrier(bar); } } while (0)
    unsigned char* ws = args.ws;
    bf16* XR = (bf16*)(ws + WS_XR);

    if (IN(0)) REP(0) { phase_prologue(F, args); } SEAM(0);
    if (IN(1)) {
        pg8::Gemm g{(const bf16*)(ws + WS_H), (const bf16*)(ws + WS_WIN), MTOK, NIN, DM}; pg8::StaticOrder S; S.init(MTOK, NIN, F.G, F.bid);
        EpiInProj E{(bf16*)(ws + WS_U), (bf16*)(ws + WS_GV), (bf16*)(ws + WS_Q), (bf16*)(ws + WS_V), (bf16*)(ws + WS_G), (_Float16*)(ws + WS_LFF), (_Float16*)(ws + WS_LFB), (const float*)(ws + WS_LB)};
        pg8::gemm_phase<EpiInProj, pg8::StaticOrder, true, true>(F.lds, g, S, E);
        if (PROBE_DUP == 1) pg8::gemm_phase<EpiInProj, pg8::StaticOrder, true, true>(F.lds, g, S, E);
    } SEAM(1);
    if (IN(2)) { phase_a_mix(F, args); REP(2) for (int u = F.bid; u < 512; u += F.G) gla_unit_state(F, u); } SEAM(2);
    if (IN(3)) { phase_gla_scan(F); } SEAM(3);
    if (IN(4)) { for (int i = F.bid; i < 256; i += F.G) gla_unit_out<false>(F, args, ((i >> 5) << 6) | (i & 31)); } SEAM(4);
    if (IN(5)) { for (int i = F.bid; i < 256; i += F.G) gla_unit_out<true>(F, args, ((i >> 5) << 6) | 32 | (i & 31)); } SEAM(5);
    if (IN(6)) REP(6) {
        pg8::Gemm g{(const bf16*)(ws + WS_CAT), (const bf16*)(ws + WS_WOUT), MTOK, DM, DM}; pg8::StaticOrder S; S.init(MTOK, DM, F.G, F.bid);
        EpiResid<true> E{args.in[0], XR};
        pg8::gemm_phase<EpiResid<true>, pg8::StaticOrder, true, true>(F.lds, g, S, E);
    } SEAM(6);
#define MOE_BLOCK(L, pb) do { \
        if (IN(pb)) REP(pb) { phase_router(F, XR, args.in[2] + (L) * DM, args.in[15] + (L) * DM * NEXP); } SEAM(pb); \
        if (IN((pb) + 1)) { REP((pb) + 1) phase_topk(F); convert_moe_weights(F, args.in[16], args.in[17], args.in[18], (L), (F.G > 64) ? 32 : 0); } SEAM((pb) + 1);     \
        if (IN((pb) + 2)) {     \
            pg8::Gemm g{(const bf16*)(ws + WS_H), (const bf16*)(ws + WS_WGU), NROWS, 16 * 2048, DM}; GroupedOrder<8> S{F.G, F.bid}; \
            EpiGateUp E{(bf16*)(ws + WS_HMID)}; \
            LAS int* rowtab = (LAS int*)(F.lds + RING_BYTES); const int* IDX = (const int*)(ws + WS_IDX); \
            for (int i = 0; i < 4; ++i) { pg8::Unit uu; if (!S.next(i, uu)) break; if (F.tid < 256) rowtab[i * 256 + F.tid] = IDX[uu.pm * 256 + F.tid]; } \
            __syncthreads(); \
            pg8::gemm_phase<EpiGateUp, GroupedOrder<8>, true, true, true>(F.lds, g, S, E, rowtab); \
            if (PROBE_DUP == (pb) + 2) pg8::gemm_phase<EpiGateUp, GroupedOrder<8>, true, true, true>(F.lds, g, S, E, rowtab); \
        } SEAM((pb) + 2); \
        if (IN((pb) + 3)) { \
            pg8::Gemm g{(const bf16*)(ws + WS_HMID), (const bf16*)(ws + WS_WDN), NROWS, 16 * 1024, DFF}; GroupedOrder<4> S{F.G, F.bid}; \
            EpiDown E{(bf16*)(ws + WS_Y), (const float*)(ws + WS_GATE)}; \
            pg8::gemm_phase<EpiDown, GroupedOrder<4>, true, true>(F.lds, g, S, E); \
            if (PROBE_DUP == (pb) + 3) pg8::gemm_phase<EpiDown, GroupedOrder<4>, true, true>(F.lds, g, S, E); \
        } SEAM((pb) + 3); \
    } while (0)

    MOE_BLOCK(0, 7);
    if (IN(11)) { phase_moe_combine(F, XR, args.out, args.in[1] + DM, false); } SEAM(11);
    if (IN(12)) REP(12) {
        pg8::Gemm g{(const bf16*)(ws + WS_H), (const bf16*)(ws + WS_WQKV), MTOK, NQKV, DM}; pg8::StaticOrder S; S.init(MTOK, NQKV, F.G, F.bid);
        EpiQKV E{(bf16*)(ws + WS_QKV)};
        pg8::gemm_phase<EpiQKV, pg8::StaticOrder, true, true>(F.lds, g, S, E);
    } SEAM(12);
    if (IN(13)) REP(13) { phase_kvf(F); } SEAM(13);
    if (IN(14)) REP(14) { phase_attn(F); } SEAM(14);
    if (IN(15)) {
        pg8::Gemm g{(const bf16*)(ws + WS_ATT), (const bf16*)(ws + WS_WO), MTOK, DM, DM}; pg8::StaticOrder S; S.init(MTOK, DM, F.G, F.bid);
        EpiResid<false> E{nullptr, XR};
        pg8::gemm_phase<EpiResid<false>, pg8::StaticOrder, true, true>(F.lds, g, S, E);
    } SEAM(15);
    MOE_BLOCK(1, 16);
    if (IN(20)) { phase_moe_combine(F, XR, args.out, args.in[3], true); }
#undef MOE_BLOCK
#undef IN
#undef SEAM
}

#ifndef MK_N_LAUNCHES
#define MK_N_LAUNCHES 1
#endif
extern "C" void kernel_launch(void* const* d_in, const int* in_sizes, int n_in, void* d_out, int out_size, void* d_ws, size_t ws_size, hipStream_t stream) {
    static int grid = 0;
    if (grid == 0) {
        if (n_in != 19 || in_sizes[0] != MTOK * DM || out_size != MTOK * DM || ws_size < WS_END) { fprintf(stderr, "kernel_launch: unexpected shapes (n_in %d, in0 %d, out %d, ws %zu < %zu); nothing launched\n", n_in, n_in > 0 ? in_sizes[0] : -1, out_size, ws_size, (size_t)WS_END); grid = -1; return; }
        int dev = 0, cus = 0, per_cu = 0;
        if (hipGetDevice(&dev) != hipSuccess || hipDeviceGetAttribute(&cus, hipDeviceAttributeMultiprocessorCount, dev) != hipSuccess) { grid = -1; return; }
        if (hipFuncSetAttribute((const void*)fwd_kernel, hipFuncAttributeMaxDynamicSharedMemorySize, LDS_BYTES) != hipSuccess) { fprintf(stderr, "kernel_launch: hipFuncSetAttribute failed\n"); grid = -1; return; }
        if (hipOccupancyMaxActiveBlocksPerMultiprocessor(&per_cu, (const void*)fwd_kernel, NTHR, LDS_BYTES) != hipSuccess || per_cu < 1) { fprintf(stderr, "kernel_launch: occupancy query reports %d workgroups per CU\n", per_cu); }
        (void)hipGetLastError();
        grid = cus;
    }
    if (grid < 0) return;
    if (hipMemsetAsync((char*)d_ws + WS_CTL, 0, CTL_ZERO_BYTES, stream) != hipSuccess) return;
    Args a{};
    for (int i = 0; i < 19; ++i) a.in[i] = (const float*)d_in[i];
    a.out = (float*)d_out; a.ws = (unsigned char*)d_ws; a.pad = 0;
    static_assert(CW_BAR + MAX_BAR_REGIONS * XCD_BAR_WORDS <= (int)(CTL_ZERO_BYTES / 4), "barrier regions inside the memset region");
#ifdef PROBE_PREFIX
    const int nl = 2;
    for (int li = 0; li < nl; ++li) {
        a.ph_lo = 0; a.ph_hi = (li == 0) ? PROBE_PREFIX : NPHASE; a.li = li;
#else
    const int nl = MK_N_LAUNCHES;
    for (int li = 0; li < nl; ++li) {
        a.ph_lo = (int)((long)NPHASE * li / nl); a.ph_hi = (int)((long)NPHASE * (li + 1) / nl); a.li = li;
#endif
        hipLaunchKernelGGL(fwd_kernel, dim3(grid), dim3(NTHR), LDS_BYTES, stream, a);
        const hipError_t le = hipPeekAtLastError();
        if (le != hipSuccess) { fprintf(stderr, "kernel_launch: launch %d failed: %s\n", li, hipGetErrorName(le)); break; }
    }
}
```

```cpp
#include <hip/hip_runtime.h>
#include <cstdio>
#include <cstdint>
namespace pg8 {
#define PG8_LAS __attribute__((address_space(3)))
typedef unsigned short bf16_t;
typedef short bf16x8 __attribute__((ext_vector_type(8)));
typedef float f32x4 __attribute__((ext_vector_type(4)));
typedef unsigned u32x4 __attribute__((ext_vector_type(4)));
constexpr int BM = 256, BK = 64, HALF = 128, HTB = HALF * BK * 2  , STAGE_BYTES = 8 * HTB, NXCD = 8, WGM = 8;

__host__ __device__ __forceinline__ int lds_byte(int r, int c) { const int st = (r >> 4) * 2 + (c >> 5), rr = r & 15, cc = c & 31, ob = rr * 64 + cc * 2; return st * 1024 + (ob ^ (((ob >> 9) & 1) << 5)); }
__host__ __device__ __forceinline__ void stage_rc(int b, int& R, int& C) { const int st = b / 1024, sb = b % 1024, swz = sb ^ (((sb >> 9) & 1) << 5); R = (st >> 1) * 16 + swz / 64; C = (st & 1) * 32 + (swz % 64) / 2; }
__host__ __device__ __forceinline__ int perm32(int rho) { const int n = rho >> 4, i = rho & 15; return 8 * (i >> 2) + 4 * n + (i & 3); }

struct Unit { int pm, pn; };
struct Gemm { const bf16_t* A; const bf16_t* Bt; int M, N, K; };

struct StaticOrder {
    int nM, nN, nwg, G, c;
    __host__ __device__ void init(int M, int N, int G_, int c_) { nM = M / BM; nN = N / BM; nwg = nM * nN; G = G_; c = c_; }
    __host__ __device__ bool next(int i, Unit& u) const {
        const long L = (long)i * G + c; if (L >= nwg) return false;
        int wgid = (int)L; { const int q = nwg / NXCD, r = nwg % NXCD, xcd = wgid % NXCD, off = wgid / NXCD; wgid = (xcd < r ? xcd * (q + 1) : r * (q + 1) + (xcd - r) * q) + off; }
        const int nig = WGM * nN, gid = wgid / nig, fm = gid * WGM, gsz = (nM - fm) < WGM ? (nM - fm) : WGM;
        u.pm = fm + ((wgid % nig) % gsz); u.pn = (wgid % nig) / gsz; return true;
    }
    __device__ __forceinline__ void a_ready(const Unit&) const {}
    __device__ __forceinline__ void done(const Unit&) const {}
};

__device__ __forceinline__ unsigned cvt_pk_bf16(float lo, float hi) { unsigned r; asm volatile("v_cvt_pk_bf16_f32 %0, %1, %2" : "=v"(r) : "v"(lo), "v"(hi)); return r; }
typedef float f32x2 __attribute__((ext_vector_type(2)));
__device__ __forceinline__ f32x2 gelu_pk(f32x2 v) {
    const f32x2 av = __builtin_elementwise_abs(v), d = av * 0.2316418882f + 1.0f;
    f32x2 t; t.x = __builtin_amdgcn_rcpf(d.x); t.y = __builtin_amdgcn_rcpf(d.y);
    f32x2 q = t * 0.5307027145f + (-0.7265760135f); q = q * t + 0.7107068705f; q = q * t + (-0.142248368f); q = q * t + 0.127414796f; q = q * t;
    const f32x2 s = (v * v) * (-0.72134752044f);
    f32x2 e; e.x = __builtin_amdgcn_exp2f(s.x); e.y = __builtin_amdgcn_exp2f(s.y);
    const f32x2 m = v * (q * e), r = v - m;
    f32x2 o; o.x = v.x < 0.f ? m.x : r.x; o.y = v.y < 0.f ? m.y : r.y; return o;
}

template <int ACT  > struct EpiBf16 {
    static constexpr bool PERM = true, AFTER_DRAIN = false; static_assert(ACT == 0 || ACT == 1, "EpiBf16: ACT is 0 (none) or 1 (gelu_pk)");
    bf16_t* O; int ldc; const float* bias; int split_cols; size_t split_stride; float scale0;
    __device__ __forceinline__ void operator()(const f32x4 (&acc)[2][2][4][2], const Unit& u, int wr, int wc, int fr, int fq) const {
        const int row0 = u.pm * BM + wr * 64 + fr; int colt = u.pn * BM; bf16_t* base = O;
        float sc = 1.f; if (split_cols) { const int t = colt / split_cols; base += (size_t)t * split_stride; colt -= t * split_cols; if (t == 0) sc = scale0; }
        const int col0 = colt + wc * 32 + 8 * fq, bcol0 = u.pn * BM + wc * 32 + 8 * fq;
        f32x4 bv[2][2];
#pragma unroll
        for (int bj = 0; bj < 2; ++bj)
#pragma unroll
            for (int n = 0; n < 2; ++n) bv[bj][n] = bias ? *(const f32x4*)(bias + bcol0 + bj * HALF + 4 * n) : (f32x4){0.f, 0.f, 0.f, 0.f};
#pragma unroll
        for (int ai = 0; ai < 2; ++ai)
#pragma unroll
            for (int m = 0; m < 4; ++m) { bf16_t* rowp = base + (size_t)(row0 + ai * HALF + m * 16) * ldc + col0;
#pragma unroll
                for (int bj = 0; bj < 2; ++bj) { f32x4 v0 = acc[ai][bj][m][0] + bv[bj][0], v1 = acc[ai][bj][m][1] + bv[bj][1];
                    if (ACT == 1) { f32x2 a = gelu_pk((f32x2){v0[0], v0[1]}), b = gelu_pk((f32x2){v0[2], v0[3]}), c = gelu_pk((f32x2){v1[0], v1[1]}), d = gelu_pk((f32x2){v1[2], v1[3]});
                        v0 = (f32x4){a.x, a.y, b.x, b.y}; v1 = (f32x4){c.x, c.y, d.x, d.y}; }
                    v0 = v0 * sc; v1 = v1 * sc; u32x4 w; w.x = cvt_pk_bf16(v0[0], v0[1]); w.y = cvt_pk_bf16(v0[2], v0[3]); w.z = cvt_pk_bf16(v1[0], v1[1]); w.w = cvt_pk_bf16(v1[2], v1[3]);
                    *(u32x4*)(rowp + bj * HALF) = w; } }
    }
};
template <class Epi, class Sched, bool ALIGN_EPI = false, bool SP2 = false, bool GATHER = false>
__device__ __forceinline__ void gemm_phase(PG8_LAS unsigned char* lds, const Gemm g, const Sched& S, const Epi& E, const PG8_LAS int* rowtab = nullptr) {
    const int tid = threadIdx.x, wid = __builtin_amdgcn_readfirstlane(tid >> 6), lane = tid & 63, wr = wid >> 2, wc = wid & 3, fr = lane & 15, fq = lane >> 4;
    const int K = g.K, nt = K / BK;
    unsigned voffA[2], voffB[2]; int gR[2], gC[2];
#pragma unroll
    for (int i = 0; i < 2; ++i) { int R, C; stage_rc(tid * 16 + i * 8192, R, C); const int Rb = Epi::PERM ? ((R & ~31) + perm32(R & 31)) : R;
        voffA[i] = (unsigned)(R * K + C) * 2u; voffB[i] = (unsigned)(Rb * K + C) * 2u; gR[i] = R; gC[i] = C; }
    unsigned vC[2][2] = {{0u, 0u}, {0u, 0u}}, vN[2][2] = {{0u, 0u}, {0u, 0u}};
#define PG8_ROWS(dst, ui_) do { _Pragma("unroll") for (int _h = 0; _h < 2; ++_h) _Pragma("unroll") for (int _i = 0; _i < 2; ++_i) \
        dst[_h][_i] = (unsigned)(rowtab[(ui_) * 256 + _h * 128 + gR[_i]] * K + gC[_i]) * 2u; } while (0)
    const size_t kstep = (size_t)(BK * 2);
    const size_t hstep = (size_t)HALF * K * 2;
    const size_t tstep = 2 * hstep;
    const unsigned ldsw = (unsigned)wid * 1024u;
    const int aoff = lds_byte(wr * 64 + fr, fq * 8), boff = lds_byte(wc * 32 + fr, fq * 8);
#define PG8_SA(b, h) (((b) * 2 + (h)) * HTB)
#define PG8_SB(b, h) ((4 + (b) * 2 + (h)) * HTB)
#define PG8_STAGE(bufoff, gbase, voff) do { _Pragma("unroll") for (int _i = 0; _i < 2; ++_i) \
        __builtin_amdgcn_global_load_lds((const unsigned*)((const char*)(gbase) + (voff)[_i]), (PG8_LAS unsigned*)(lds + (bufoff) + ldsw + _i * 8192), 16, 0, 0); } while (0)
#define PG8_STGA(bufoff, abase, half, V) do { _Pragma("unroll") for (int _i = 0; _i < 2; ++_i) \
        __builtin_amdgcn_global_load_lds((const unsigned*)((const char*)(abase) + (GATHER ? (size_t)V[half][_i] : (size_t)((half) ? hstep : 0) + voffA[_i])), (PG8_LAS unsigned*)(lds + (bufoff) + ldsw + _i * 8192), 16, 0, 0); } while (0)
#define PG8_LDA(dst, b, h) do { _Pragma("unroll") for (int m = 0; m < 4; ++m) _Pragma("unroll") for (int k = 0; k < 2; ++k) dst[m][k] = *(const PG8_LAS bf16x8*)(lds + PG8_SA(b, h) + aoff + m * 2048 + k * 1024); } while (0)
#define PG8_LDB(dst, b, h) do { _Pragma("unroll") for (int n = 0; n < 2; ++n) _Pragma("unroll") for (int k = 0; k < 2; ++k) dst[n][k] = *(const PG8_LAS bf16x8*)(lds + PG8_SB(b, h) + boff + n * 2048 + k * 1024); } while (0)
#define PG8_MMA(ai, bj, At, Bt) do { __builtin_amdgcn_s_setprio(1); _Pragma("unroll") for (int m = 0; m < 4; ++m) _Pragma("unroll") for (int n = 0; n < 2; ++n) _Pragma("unroll") for (int k = 0; k < 2; ++k) \
        acc[ai][bj][m][n] = __builtin_amdgcn_mfma_f32_16x16x32_bf16(Bt[n][k], At[m][k], acc[ai][bj][m][n], 0, 0, 0); __builtin_amdgcn_s_setprio(0); } while (0)
#define PG8_WAIT_V(n) asm volatile("s_waitcnt vmcnt(" #n ")" ::: "memory")
#define PG8_WAIT_L(n) asm volatile("s_waitcnt lgkmcnt(" #n ")" ::: "memory")
#define PG8_BAR __builtin_amdgcn_s_barrier()
#define PG8_SCHED __builtin_amdgcn_sched_barrier(0)
    Unit cur, nxt; int ui = 0;
    if (!S.next(0, cur)) return;
    f32x4 acc[2][2][4][2];
#pragma unroll
    for (int a = 0; a < 2; ++a)
#pragma unroll
        for (int b = 0; b < 2; ++b)
#pragma unroll
            for (int m = 0; m < 4; ++m)
#pragma unroll
                for (int n = 0; n < 2; ++n) acc[a][b][m][n] = (f32x4){0.f, 0.f, 0.f, 0.f};
    bf16x8 At[4][2], B0[2][2], B1[2][2];
    const char* cA = (const char*)g.A + (GATHER ? (size_t)0 : (size_t)cur.pm * tstep); if constexpr (GATHER) PG8_ROWS(vC, 0);
    const char* cB = (const char*)g.Bt + (size_t)cur.pn * tstep;
    S.a_ready(cur);
    if constexpr (SP2) {
        PG8_STAGE(PG8_SB(0, 0), cB, voffB); PG8_STAGE(PG8_SB(0, 1), cB + hstep, voffB); PG8_STGA(PG8_SA(0, 0), cA, 0, vC); PG8_STGA(PG8_SA(0, 1), cA, 1, vC);
        if (wr == 1) PG8_BAR;
        PG8_WAIT_V(2); PG8_BAR;
        PG8_STAGE(PG8_SB(1, 0), cB + kstep, voffB); PG8_STGA(PG8_SA(1, 0), cA + kstep, 0, vC); PG8_STAGE(PG8_SB(1, 1), cB + hstep + kstep, voffB);
        PG8_WAIT_V(6); PG8_BAR;
    } else {
        PG8_STAGE(PG8_SB(0, 0), cB, voffB); PG8_STGA(PG8_SA(0, 0), cA, 0, vC); PG8_STAGE(PG8_SB(0, 1), cB + hstep, voffB); PG8_STGA(PG8_SA(0, 1), cA, 1, vC);
        if (wr == 1) PG8_BAR;
        PG8_WAIT_V(4); PG8_BAR;
        PG8_STAGE(PG8_SB(1, 0), cB + kstep, voffB); PG8_STGA(PG8_SA(1, 0), cA + kstep, 0, vC); PG8_STAGE(PG8_SB(1, 1), cB + hstep + kstep, voffB);
        PG8_WAIT_V(6); PG8_BAR;
    }
    for (;;) {
        const bool has_next = S.next(ui + 1, nxt);
        const char* nA = (has_next && !GATHER) ? (const char*)g.A + (size_t)nxt.pm * tstep : cA;
        if constexpr (GATHER) { if (has_next) PG8_ROWS(vN, ui + 1); else { _Pragma("unroll") for (int _h = 0; _h < 2; ++_h) _Pragma("unroll") for (int _i = 0; _i < 2; ++_i) vN[_h][_i] = vC[_h][_i]; } }
        const char* nB = has_next ? (const char*)g.Bt + (size_t)nxt.pn * tstep : cB;
        for (int t = 0; t < nt; t += 2) {
            const bool last = (t == nt - 2);
            unsigned vX[2][2];
            _Pragma("unroll") for (int _h = 0; _h < 2; ++_h) _Pragma("unroll") for (int _i = 0; _i < 2; ++_i) vX[_h][_i] = last ? vN[_h][_i] : vC[_h][_i];
            const char* a1 = cA + (size_t)(t + 1) * kstep;
            const char* a2 = last ? nA : cA + (size_t)(t + 2) * kstep; const char* b2 = last ? nB : cB + (size_t)(t + 2) * kstep;
            const char* a3 = a2 + kstep; const char* b3 = b2 + kstep;
            if (last && has_next) S.a_ready(nxt);
            if constexpr (SP2) {
            PG8_LDB(B0, 0, 0); PG8_LDB(B1, 0, 1); PG8_SCHED; PG8_LDA(At, 0, 0); PG8_STGA(PG8_SA(1, 1), a1, 1, vC);
            PG8_WAIT_V(8); PG8_WAIT_L(0); PG8_BAR; PG8_MMA(0, 0, At, B0); PG8_MMA(0, 1, At, B1); PG8_BAR; PG8_SCHED;
            PG8_LDA(At, 0, 1); PG8_STAGE(PG8_SB(0, 0), b2, voffB); PG8_STAGE(PG8_SB(0, 1), b2 + hstep, voffB); PG8_STGA(PG8_SA(0, 0), a2, 0, vX);
            PG8_WAIT_V(8); PG8_WAIT_L(0); PG8_BAR; PG8_MMA(1, 0, At, B0); PG8_MMA(1, 1, At, B1); PG8_BAR; PG8_SCHED;
            PG8_LDB(B0, 1, 0); PG8_LDB(B1, 1, 1); PG8_SCHED; PG8_LDA(At, 1, 0); PG8_STGA(PG8_SA(0, 1), a2, 1, vX);
            PG8_WAIT_V(8); PG8_WAIT_L(0); PG8_BAR; PG8_MMA(0, 0, At, B0); PG8_MMA(0, 1, At, B1); PG8_BAR; PG8_SCHED;
            PG8_LDA(At, 1, 1); PG8_STAGE(PG8_SB(1, 0), b3, voffB); PG8_STAGE(PG8_SB(1, 1), b3 + hstep, voffB); PG8_STGA(PG8_SA(1, 0), a3, 0, vX);
            PG8_WAIT_V(8); PG8_WAIT_L(0); PG8_BAR; PG8_MMA(1, 0, At, B0); PG8_MMA(1, 1, At, B1); PG8_BAR; PG8_SCHED;
            } else {
            PG8_LDB(B0, 0, 0); PG8_SCHED; PG8_LDA(At, 0, 0); PG8_STGA(PG8_SA(1, 1), a1, 1, vC);
            PG8_WAIT_L(8); PG8_BAR; PG8_WAIT_L(0); PG8_MMA(0, 0, At, B0); PG8_BAR; PG8_SCHED;
            PG8_LDB(B1, 0, 1); PG8_STAGE(PG8_SB(0, 0), b2, voffB);
            PG8_BAR; PG8_WAIT_L(0); PG8_MMA(0, 1, At, B1); PG8_BAR;
            PG8_LDA(At, 0, 1); PG8_STGA(PG8_SA(0, 0), a2, 0, vX);
            PG8_BAR; PG8_WAIT_L(0); PG8_MMA(1, 0, At, B0); PG8_BAR; PG8_SCHED;
            PG8_STAGE(PG8_SB(0, 1), b2 + hstep, voffB);
            PG8_WAIT_V(6); PG8_BAR; PG8_MMA(1, 1, At, B1); PG8_BAR;
            PG8_LDB(B0, 1, 0); PG8_SCHED; PG8_LDA(At, 1, 0); PG8_STGA(PG8_SA(0, 1), a2, 1, vX);
            PG8_WAIT_L(8); PG8_BAR; PG8_WAIT_L(0); PG8_MMA(0, 0, At, B0); PG8_BAR; PG8_SCHED;
            PG8_LDB(B1, 1, 1); PG8_STAGE(PG8_SB(1, 0), b3, voffB);
            PG8_BAR; PG8_WAIT_L(0); PG8_MMA(0, 1, At, B1); PG8_BAR;
            PG8_LDA(At, 1, 1); PG8_STGA(PG8_SA(1, 0), a3, 0, vX);
            PG8_BAR; PG8_WAIT_L(0); PG8_MMA(1, 0, At, B0); PG8_BAR; PG8_SCHED;
            PG8_STAGE(PG8_SB(1, 1), b3 + hstep, voffB);
            PG8_WAIT_V(6); PG8_BAR; PG8_MMA(1, 1, At, B1); PG8_BAR;
            }
        }
        if constexpr (ALIGN_EPI) { if (wr == 0) PG8_BAR; }
        if constexpr (!Epi::AFTER_DRAIN) { E(acc, cur, wr, wc, fr, fq); S.done(cur); }
        if (!has_next) break;
#pragma unroll
        for (int a = 0; a < 2; ++a)
#pragma unroll
            for (int b = 0; b < 2; ++b)
#pragma unroll
                for (int m = 0; m < 4; ++m)
#pragma unroll
                    for (int n = 0; n < 2; ++n) acc[a][b][m][n] = (f32x4){0.f, 0.f, 0.f, 0.f};
        cur = nxt; cA = nA; cB = nB; ++ui;
        if constexpr (GATHER) { _Pragma("unroll") for (int _h = 0; _h < 2; ++_h) _Pragma("unroll") for (int _i = 0; _i < 2; ++_i) vC[_h][_i] = vN[_h][_i]; }
        if constexpr (ALIGN_EPI) { if (wr == 1) PG8_BAR; }
    }
    PG8_WAIT_V(0);
    if constexpr (!ALIGN_EPI) { if (wr == 0) PG8_BAR; }
    PG8_BAR;
    if constexpr (Epi::AFTER_DRAIN) { E.fused(acc, cur, wr, wc, fr, fq, lds, wid, lane); S.done(cur); }
#undef PG8_SA
#undef PG8_SB
#undef PG8_STAGE
#undef PG8_STGA
#undef PG8_ROWS
#undef PG8_LDA
#undef PG8_LDB
#undef PG8_MMA
#undef PG8_WAIT_V
#undef PG8_WAIT_L
#undef PG8_BAR
#undef PG8_SCHED
}
}
#define LAS __attribute__((address_space(3)))
#define DI __device__ __forceinline__
typedef unsigned short bf16;
typedef unsigned v4u __attribute__((ext_vector_type(4)));
typedef unsigned v2u __attribute__((ext_vector_type(2)));
typedef float f32x4 __attribute__((ext_vector_type(4)));
typedef short bf16x8 __attribute__((ext_vector_type(8)));
#define LDS_WAIT() asm volatile("s_waitcnt lgkmcnt(0)" ::: "memory")
#define VM_WAIT() asm volatile("s_waitcnt vmcnt(0)" ::: "memory")
DI unsigned f2bf(float f) { unsigned u = __builtin_bit_cast(unsigned, f); return (u + 0x7fffu + ((u >> 16) & 1u)) >> 16; }
typedef float f32x2_t __attribute__((ext_vector_type(2))); typedef __bf16 bf16x2_t __attribute__((ext_vector_type(2)));
DI unsigned pk2(float lo, float hi) { f32x2_t v = {lo, hi}; bf16x2_t b = __builtin_convertvector(v, bf16x2_t); return __builtin_bit_cast(unsigned, b); }
DI float bf2f(unsigned b) { return __builtin_bit_cast(float, b << 16); }
DI float bflo(unsigned w) { return __builtin_bit_cast(float, w << 16); }
DI float bfhi(unsigned w) { return __builtin_bit_cast(float, w & 0xffff0000u); }
DI float fexp(float x) { return __builtin_amdgcn_exp2f(x * 1.4426950408889634f); }
DI float flog(float x) { return __builtin_amdgcn_logf(x) * 0.6931471805599453f; }
DI float frcp(float x) { return __builtin_amdgcn_rcpf(x); }
DI float sigmoidf_(float x) { return frcp(1.f + fexp(-x)); }
DI float siluf_(float x) { return x * sigmoidf_(x); }
DI float gelu_tanh(float x) { const float u = 0.7978845608028654f * (x + 0.044715f * x * x * x); return x * sigmoidf_(2.f * u); }
DI float wave_sum(float v) {
#pragma unroll
    for (int o = 1; o < 64; o <<= 1) v += __shfl_xor(v, o);
    return v;
}
DI float wave_max(float v) {
#pragma unroll
    for (int o = 1; o < 64; o <<= 1) v = fmaxf(v, __shfl_xor(v, o));
    return v;
}
DI int red16_idx(int lane) { return 8 * ((lane >> 5) & 1) + 4 * ((lane >> 4) & 1) + 2 * ((lane >> 3) & 1) + ((lane >> 2) & 1); }
DI float red16(const float (&o)[16], int lane) {
    const bool b32 = lane & 32, b16 = lane & 16, b8 = lane & 8, b4 = lane & 4;
    float a8[8], a4[4], a2[2], a1;
#pragma unroll
    for (int j = 0; j < 8; ++j) { const float send = b32 ? o[j] : o[j + 8], keep = b32 ? o[j + 8] : o[j]; a8[j] = keep + __shfl_xor(send, 32); }
#pragma unroll
    for (int j = 0; j < 4; ++j) { const float send = b16 ? a8[j] : a8[j + 4], keep = b16 ? a8[j + 4] : a8[j]; a4[j] = keep + __shfl_xor(send, 16); }
#pragma unroll
    for (int j = 0; j < 2; ++j) { const float send = b8 ? a4[j] : a4[j + 2], keep = b8 ? a4[j + 2] : a4[j]; a2[j] = keep + __shfl_xor(send, 8); }
    { const float send = b4 ? a2[0] : a2[1], keep = b4 ? a2[1] : a2[0]; a1 = keep + __shfl_xor(send, 4); }
    a1 += __shfl_xor(a1, 2); a1 += __shfl_xor(a1, 1);
    return a1;
}
#define XB_TMO      128
#define XB_XCNT(j)  (256  + 64 * (j))
#define XB_XSUB(j)  (1280 + 64 * (j))
#define XB_XGEN(j)  (2304 + 64 * (j))
#define XB_TOP      3328
#define XB_TOPGEN   3392
#define XCD_BAR_WORDS 3456
#define XB_SPIN_CAP (1u << 18)

__device__ __forceinline__ unsigned xb_ld(unsigned* p)              { return __hip_atomic_load(p, __ATOMIC_RELAXED, __HIP_MEMORY_SCOPE_AGENT); }
__device__ __forceinline__ unsigned xb_add(unsigned* p, unsigned v) { return __hip_atomic_fetch_add(p, v, __ATOMIC_RELAXED, __HIP_MEMORY_SCOPE_AGENT); }
__device__ __forceinline__ unsigned xb_xcc_id() { return (unsigned)__builtin_amdgcn_s_getreg((3 << 11) | 20) & 0xFu; }
#define XB_SPIN(cond, bar) do { unsigned _sp = 0; while (cond) { __builtin_amdgcn_s_sleep(1); \
    if ((++_sp & 255u) == 0u) { if (xb_ld(&(bar)[XB_TMO])) break; if (_sp > XB_SPIN_CAP) { atomicAdd(&(bar)[XB_TMO], 1u); break; } } } } while (0)

struct XcdBarrier {
    unsigned* bar; unsigned x;
    volatile LAS unsigned* st;
};

__device__ __forceinline__ XcdBarrier xcd_barrier_post(unsigned* bar, volatile LAS unsigned* st) {
    XcdBarrier b; b.bar = bar; b.x = xb_xcc_id(); b.st = st;
    if (threadIdx.x == 0) (void)xb_add(&bar[XB_XCNT(b.x)], 1u);
    return b;
}
__device__ __forceinline__ void xcd_barrier_complete(unsigned* bar, unsigned x, unsigned& nloc, unsigned& nx) {
    const unsigned G = gridDim.x * gridDim.y * gridDim.z;
    unsigned sum, cnt, mine, sp = 0u;
    for (;;) {
        sum = 0u; cnt = 0u; mine = 0u;
#pragma unroll
        for (unsigned j = 0; j < 16; ++j) { const unsigned c = xb_ld(&bar[XB_XCNT(j)]); sum += c; cnt += (c > 0u) ? 1u : 0u; mine = (j == x) ? c : mine; }
        if (sum == G) break;
        __builtin_amdgcn_s_sleep(1);
        if ((++sp & 255u) == 0u) { if (xb_ld(&bar[XB_TMO])) break; if (sp > XB_SPIN_CAP) { atomicAdd(&bar[XB_TMO], 1u); break; } }
    }
    nloc = mine > 0u ? mine : 1u; nx = cnt > 0u ? cnt : 1u;
}

__device__ __forceinline__ void xcd_barrier(const XcdBarrier& b) {
    asm volatile("s_waitcnt vmcnt(0)" ::: "memory");
    __syncthreads();
    if (threadIdx.x == 0) {
        unsigned* bar = b.bar;
        __builtin_amdgcn_s_waitcnt(0);
        unsigned nloc = b.st[0], nx = b.st[1];
        if (nloc == 0u) { xcd_barrier_complete(bar, b.x, nloc, nx); b.st[0] = nloc; b.st[1] = nx; }
        const unsigned old = xb_add(&bar[XB_XSUB(b.x)], 1u);
        const unsigned gen = old / nloc;
        if (old + 1u == (gen + 1u) * nloc) {
            __builtin_amdgcn_fence(__ATOMIC_RELEASE, "agent");
            asm volatile("s_waitcnt vmcnt(0)" ::: "memory");
            const unsigned og = xb_add(&bar[XB_TOP], 1u);
            const unsigned tg = og / nx;
            if (og + 1u == (tg + 1u) * nx) xb_add(&bar[XB_TOPGEN], 1u);
            else XB_SPIN(xb_ld(&bar[XB_TOPGEN]) == tg, bar);
            __builtin_amdgcn_fence(__ATOMIC_ACQUIRE, "agent");
            xb_add(&bar[XB_XGEN(b.x)], 1u);
            asm volatile("s_waitcnt vmcnt(0)" ::: "memory");
        } else {
            XB_SPIN(xb_ld(&bar[XB_XGEN(b.x)]) == gen, bar);
            __builtin_amdgcn_fence(__ATOMIC_ACQUIRE, "agent");
            asm volatile("s_waitcnt vmcnt(0)" ::: "memory");
        }
    }
    __syncthreads();
}
#ifndef PROBE_DUP
#define PROBE_DUP (-1)
#endif
constexpr int NWAVES = 8, NTHR = 512;
constexpr int BATCH = 2, SEQ = 8192, DM = 1024, MTOK = BATCH * SEQ;
constexpr int NIN = 3584;
constexpr int AW = 512;
constexpr int NEXP = 16, DFF = 1024, CAP = 1024, NROWS = BATCH * NEXP * CAP;
constexpr int NSC = 32, SCLEN = 256;
constexpr int NHEAD = 16, HD = 64, NQKV = 3072;
constexpr float EPS = 1e-6f;
constexpr int NPHASE = 21;

constexpr size_t MiB = 1u << 20;
constexpr size_t WS_CTL = 0, CTL_ZERO_BYTES = 1 * MiB;
constexpr size_t WS_AFF = 1 * MiB;
constexpr size_t WS_POS = 2 * MiB;
constexpr size_t WS_IDX = 3 * MiB;
constexpr size_t WS_GATE = 3 * MiB + 256 * 1024;
constexpr size_t WS_DEC = 3 * MiB + 512 * 1024;
constexpr size_t WS_LB = 4 * MiB;
constexpr size_t WS_BT = 4 * MiB + 64 * 1024;
constexpr size_t WS_WIN = 8 * MiB;
constexpr size_t WS_WOUT = 15 * MiB;
constexpr size_t WS_WQKV = 17 * MiB;
constexpr size_t WS_WO = 23 * MiB;
constexpr size_t WS_WSB = 25 * MiB;
constexpr size_t WS_WGU = 32 * MiB;
constexpr size_t WS_WDN = 96 * MiB;
constexpr size_t WS_H = 128 * MiB;
constexpr size_t WS_R1 = 160 * MiB;
constexpr size_t WS_U = WS_R1, WS_GV = WS_R1 + 16 * MiB, WS_Q = WS_R1 + 32 * MiB, WS_V = WS_R1 + 48 * MiB, WS_G = WS_R1 + 64 * MiB;
constexpr size_t WS_LFF = WS_R1 + 80 * MiB, WS_LFB = WS_R1 + 112 * MiB;
constexpr size_t WS_CAT = WS_R1 + 144 * MiB;
constexpr size_t WS_ST = WS_R1 + 176 * MiB;
constexpr size_t WS_ODIR = WS_R1 + 208 * MiB;
constexpr size_t WS_XE = WS_R1, WS_Y = WS_R1;
constexpr size_t WS_HMID = WS_R1 + 64 * MiB;
constexpr size_t WS_QKV = WS_R1;
constexpr size_t WS_ATT = WS_R1 + 96 * MiB;
constexpr size_t WS_KF = WS_R1 + 128 * MiB;
constexpr size_t WS_VF = WS_R1 + 224 * MiB;
constexpr size_t WS_XR = WS_R1 + 320 * MiB;
constexpr size_t WS_END = WS_R1 + 352 * MiB;
constexpr int CW_BAR = 4096;
constexpr int MAX_BAR_REGIONS = 24;

constexpr int RING_BYTES = 131072;
constexpr int LDS_BYTES = 147456;
constexpr int LDSCTL_OFF = LDS_BYTES - 512, MISC_OFF = LDSCTL_OFF + 320;

struct Args { const float* in[19]; float* out; unsigned char* ws; int ph_lo, ph_hi, li, pad; };

struct Frame {
    LAS unsigned char* lds;
    volatile LAS unsigned* MISC;
    int tid, lane, wave, G, bid, gw, NGW;
    unsigned char* ws;
};

template <int NPN_> struct GroupedOrder {
    int G, c;
    DI bool next(int i, pg8::Unit& u) const {
        if (G == 256) {
            const int x = c & 7, k = c >> 3;
            if (i >= NPN_ / 2) return false;
            const int e = (NPN_ == 8) ? 4 * i + (x >> 1) : 8 * i + x;
            u.pm = e * 8 + (k & 7); u.pn = e * NPN_ + ((NPN_ == 8) ? 4 * (x & 1) + (k >> 3) : (k >> 3)); return true;
        }
        const int L = i * G + c; if (L >= 16 * 8 * NPN_) return false;
        const int e = L / (8 * NPN_), w = L % (8 * NPN_);
        u.pm = e * 8 + (w & 7); u.pn = e * NPN_ + (w >> 3); return true;
    }
    DI void a_ready(const pg8::Unit&) const {}
    DI void done(const pg8::Unit&) const {}
};

typedef _Float16 h16x8 __attribute__((ext_vector_type(8)));
struct EpiInProj {
    static constexpr bool PERM = true, AFTER_DRAIN = false;
    bf16 *U, *GV, *Q, *V, *G; _Float16 *LFf, *LFb; const float* LB;
    DI void operator()(const pg8::f32x4 (&acc)[2][2][4][2], const pg8::Unit& u, int wr, int wc, int fr, int fq) const {
        const int seg = u.pn >> 1;
        const int row0 = u.pm * 256 + wr * 64 + fr, lc0 = (u.pn & 1) * 256 + wc * 32 + 8 * fq;
#pragma unroll
        for (int bj = 0; bj < 2; ++bj) {
            const int lc = lc0 + bj * 128;
            float lb[8];
            if (seg == 3 || seg == 4) {
#pragma unroll
                for (int j = 0; j < 8; ++j) lb[j] = LB[(seg - 3) * 512 + lc + j];
            }
#pragma unroll
            for (int ai = 0; ai < 2; ++ai)
#pragma unroll
                for (int m = 0; m < 4; ++m) {
                    const size_t off = (size_t)(row0 + ai * 128 + m * 16) * 512 + lc;
                    float v[8];
#pragma unroll
                    for (int j = 0; j < 8; ++j) v[j] = acc[ai][bj][m][j >> 2][j & 3];
                    if (seg == 3 || seg == 4) {
#pragma unroll
                        for (int j = 0; j < 8; ++j) v[j] = flog(lb[j] + (1.f - lb[j]) * sigmoidf_(v[j]));
                        _Float16* o = (seg == 3 ? LFf : LFb) + off;
                        h16x8 hv;
#pragma unroll
                        for (int j = 0; j < 8; ++j) hv[j] = (_Float16)v[j];
                        *(h16x8*)o = hv;
                    } else {
                        bf16* o;
                        if (seg == 0) { o = U;
#pragma unroll
                            for (int j = 0; j < 8; ++j) v[j] = gelu_tanh(v[j]);
                        } else if (seg == 1) { o = GV;
#pragma unroll
                            for (int j = 0; j < 8; ++j) v[j] = gelu_tanh(v[j]);
                        } else if (seg == 2) { o = Q;
#pragma unroll
                            for (int j = 0; j < 8; ++j) v[j] = siluf_(v[j]);
                        } else if (seg == 5) { o = V;
                        } else { o = G;
#pragma unroll
                            for (int j = 0; j < 8; ++j) v[j] = sigmoidf_(v[j]);
                        }
                        v4u w; w.x = pk2(v[0], v[1]); w.y = pk2(v[2], v[3]); w.z = pk2(v[4], v[5]); w.w = pk2(v[6], v[7]);
                        *(v4u*)(o + off) = w;
                    }
                }
        }
    }
};
template <bool BASE_F32> struct EpiResid {
    static constexpr bool PERM = true, AFTER_DRAIN = false;
    const float* basef; bf16* XR;
    DI void operator()(const pg8::f32x4 (&acc)[2][2][4][2], const pg8::Unit& u, int wr, int wc, int fr, int fq) const {
        const int row0 = u.pm * 256 + wr * 64 + fr, col0 = u.pn * 256 + wc * 32 + 8 * fq;
#pragma unroll
        for (int ai = 0; ai < 2; ++ai)
#pragma unroll
            for (int m = 0; m < 4; ++m) { const size_t ro = (size_t)(row0 + ai * 128 + m * 16) * DM + col0;
#pragma unroll
                for (int bj = 0; bj < 2; ++bj) { const size_t o = ro + bj * 128;
                    float v[8];
                    if (BASE_F32) { const f32x4 b0 = *(const f32x4*)(basef + o), b1 = *(const f32x4*)(basef + o + 4);
                        v[0] = b0.x; v[1] = b0.y; v[2] = b0.z; v[3] = b0.w; v[4] = b1.x; v[5] = b1.y; v[6] = b1.z; v[7] = b1.w; }
                    else { const v4u w = *(const v4u*)(XR + o); v[0] = bflo(w.x); v[1] = bfhi(w.x); v[2] = bflo(w.y); v[3] = bfhi(w.y); v[4] = bflo(w.z); v[5] = bfhi(w.z); v[6] = bflo(w.w); v[7] = bfhi(w.w); }
#pragma unroll
                    for (int j = 0; j < 8; ++j) v[j] += acc[ai][bj][m][j >> 2][j & 3];
                    v4u w; w.x = pk2(v[0], v[1]); w.y = pk2(v[2], v[3]); w.z = pk2(v[4], v[5]); w.w = pk2(v[6], v[7]);
                    *(v4u*)(XR + o) = w; } }
    }
};
struct EpiGateUp {
    static constexpr bool PERM = true, AFTER_DRAIN = false;
    bf16* H;
    DI void operator()(const pg8::f32x4 (&acc)[2][2][4][2], const pg8::Unit& u, int wr, int wc, int fr, int fq) const {
        const int pnl = u.pn & 7;
        const int row0 = u.pm * 256 + wr * 64 + fr, col0 = pnl * 128 + wc * 32 + 8 * fq;
#pragma unroll
        for (int ai = 0; ai < 2; ++ai)
#pragma unroll
            for (int m = 0; m < 4; ++m) {
                float v[8];
#pragma unroll
                for (int j = 0; j < 8; ++j) v[j] = siluf_(acc[ai][0][m][j >> 2][j & 3]) * acc[ai][1][m][j >> 2][j & 3];
                v4u w; w.x = pk2(v[0], v[1]); w.y = pk2(v[2], v[3]); w.z = pk2(v[4], v[5]); w.w = pk2(v[6], v[7]);
                *(v4u*)(H + (size_t)(row0 + ai * 128 + m * 16) * DFF + col0) = w;
            }
    }
};
struct EpiDown {
    static constexpr bool PERM = true, AFTER_DRAIN = false;
    bf16* Y; const float* gate;
    DI void operator()(const pg8::f32x4 (&acc)[2][2][4][2], const pg8::Unit& u, int wr, int wc, int fr, int fq) const {
        const int pnl = u.pn & 3;
        const int row0 = u.pm * 256 + wr * 64 + fr, col0 = pnl * 256 + wc * 32 + 8 * fq;
#pragma unroll
        for (int ai = 0; ai < 2; ++ai)
#pragma unroll
            for (int m = 0; m < 4; ++m) { const int row = row0 + ai * 128 + m * 16; const float g = gate[row];
#pragma unroll
                for (int bj = 0; bj < 2; ++bj) {
                    float v[8];
#pragma unroll
                    for (int j = 0; j < 8; ++j) v[j] = acc[ai][bj][m][j >> 2][j & 3] * g;
                    v4u w; w.x = pk2(v[0], v[1]); w.y = pk2(v[2], v[3]); w.z = pk2(v[4], v[5]); w.w = pk2(v[6], v[7]);
                    *(v4u*)(Y + (size_t)row * DM + col0 + bj * 128) = w; } }
    }
};
struct EpiQKV {
    static constexpr bool PERM = true, AFTER_DRAIN = false;
    bf16* O;
    DI void operator()(const pg8::f32x4 (&acc)[2][2][4][2], const pg8::Unit& u, int wr, int wc, int fr, int fq) const {
        const float sc = (u.pn < 4) ? 0.125f : 1.f;
        const int row0 = u.pm * 256 + wr * 64 + fr, col0 = u.pn * 256 + wc * 32 + 8 * fq;
#pragma unroll
        for (int ai = 0; ai < 2; ++ai)
#pragma unroll
            for (int m = 0; m < 4; ++m)
#pragma unroll
                for (int bj = 0; bj < 2; ++bj) {
                    float v[8];
#pragma unroll
                    for (int j = 0; j < 8; ++j) v[j] = acc[ai][bj][m][j >> 2][j & 3] * sc;
                    v4u w; w.x = pk2(v[0], v[1]); w.y = pk2(v[2], v[3]); w.z = pk2(v[4], v[5]); w.w = pk2(v[6], v[7]);
                    *(v4u*)(O + (size_t)(row0 + ai * 128 + m * 16) * NQKV + col0 + bj * 128) = w; }
    }
};

DI void transpose_item(const float* W, int K, int N, bf16* WT, LAS float* scr, int k0, int n0, int drow0, int lane) {
#pragma unroll 8
    for (int i = 0; i < 32; ++i) { const int kk = 2 * i + (lane >> 5); scr[kk * 33 + (lane & 31)] = W[(size_t)(k0 + kk) * N + n0 + (lane & 31)]; }
    LDS_WAIT(); asm volatile("" ::: "memory");
    const int c = lane & 7;
#pragma unroll
    for (int j = 0; j < 4; ++j) { const int n = (lane >> 3) + 8 * j; const LAS float* s = scr + (8 * c) * 33 + n;
        v4u o; o.x = pk2(s[0 * 33], s[1 * 33]); o.y = pk2(s[2 * 33], s[3 * 33]); o.z = pk2(s[4 * 33], s[5 * 33]); o.w = pk2(s[6 * 33], s[7 * 33]);
        *(v4u*)(WT + (size_t)(drow0 + n) * K + k0 + 8 * c) = o; }
    LDS_WAIT(); asm volatile("" ::: "memory");
}
DI void transpose_matrix(Frame& F, const float* W, int K, int N, bf16* WT) {
    LAS float* scr = (LAS float*)(F.lds + F.wave * 16384);
    const int nblk = N / 32, nitems = (K / 64) * nblk;
    for (int it = F.gw; it < nitems; it += F.NGW) { const int kb = it / nblk, nb = it % nblk; transpose_item(W, K, N, WT, scr, 64 * kb, 32 * nb, 32 * nb, F.lane); }
}
DI void convert_moe_weights(Frame& F, const float* wg, const float* wu, const float* wd, int layer, int nskip = 0) {
    LAS float* scr = (LAS float*)(F.lds + F.wave * 16384);
    bf16* WGU = (bf16*)(F.ws + WS_WGU); bf16* WDN = (bf16*)(F.ws + WS_WDN);
    if (F.bid < nskip) return;
    for (int it = F.gw - nskip * NWAVES; it < 3 * 16 * 512; it += F.NGW - nskip * NWAVES) {
        const int mat = it / 8192, rem = it % 8192, e = rem / 512, r = rem % 512, kb = r / 32, nb = r % 32, n0 = 32 * nb;
        const size_t so = ((size_t)layer * 16 + e) * 1024 * 1024;
        if (mat == 0) transpose_item(wg + so, 1024, 1024, WGU + (size_t)e * 2048 * 1024, scr, 64 * kb, n0, (n0 >> 7) * 256 + (n0 & 127), F.lane);
        else if (mat == 1) transpose_item(wu + so, 1024, 1024, WGU + (size_t)e * 2048 * 1024, scr, 64 * kb, n0, (n0 >> 7) * 256 + 128 + (n0 & 127), F.lane);
        else transpose_item(wd + so, 1024, 1024, WDN + (size_t)e * 1024 * 1024, scr, 64 * kb, n0, n0, F.lane);
    }
}
DI void rms_row(const float* xrow, const float* g, f32x4 (&v)[4], int lane) {
    const f32x4* xr = (const f32x4*)xrow + lane; float s = 0.f;
#pragma unroll
    for (int j = 0; j < 4; ++j) { v[j] = xr[64 * j]; s += (v[j].x * v[j].x + v[j].y * v[j].y) + (v[j].z * v[j].z + v[j].w * v[j].w); }
    const float rstd = 1.f / sqrtf(wave_sum(s) * (1.f / DM) + EPS);
    const f32x4* gr = (const f32x4*)g + lane;
#pragma unroll
    for (int j = 0; j < 4; ++j) v[j] = v[j] * rstd * gr[64 * j];
}
DI void store_row_bf16(bf16* orow, const f32x4 (&v)[4], int lane) {
    v2u* o8 = (v2u*)orow + lane;
#pragma unroll
    for (int j = 0; j < 4; ++j) { v2u w; w.x = pk2(v[j].x, v[j].y); w.y = pk2(v[j].z, v[j].w); o8[64 * j] = w; }
}
DI int t5_bucket(int rel) {
    const int n = rel < 0 ? -rel : rel;
    int val;
    if (n < 8) val = n;
    else { const float sc = logf((float)n / 8.f) / 4.852030263919617f; int lg = 8 + (int)(sc * 8.f); val = lg < 15 ? lg : 15; }
    return (rel > 0 ? 16 : 0) + val;
}

typedef float f32x16 __attribute__((ext_vector_type(16)));
#define MFMA32(a, b, c) __builtin_amdgcn_mfma_f32_32x32x16_bf16((a), (b), (c), 0, 0, 0)
DI int crow32(int j, int hh) { return (j & 3) + 8 * (j >> 2) + 4 * hh; }
DI void phase_prologue(Frame& F, const Args& a) {
    unsigned char* ws = F.ws;
    transpose_matrix(F, a.in[4], 1024, NIN, (bf16*)(ws + WS_WIN));
    transpose_matrix(F, a.in[5], 1024, 1024, (bf16*)(ws + WS_WOUT));
    transpose_matrix(F, a.in[12], 1024, NQKV, (bf16*)(ws + WS_WQKV));
    transpose_matrix(F, a.in[13], 1024, 1024, (bf16*)(ws + WS_WO));
    { bf16* WSB = (bf16*)(ws + WS_WSB); for (int i = F.bid * NTHR + F.tid; i < 4 * 128 * 128; i += F.G * NTHR) WSB[i] = (bf16)f2bf(a.in[8][i]); }
    { float* LB = (float*)(ws + WS_LB); const float* t = a.in[10];
      for (int i = F.bid * NTHR + F.tid; i < 2 * 512; i += F.G * NTHR) { const int d = i / 512, k = i % 512;
          const float a0 = t[(d * 3 + 0) * 512 + k], a1 = t[(d * 3 + 1) * 512 + k], a2 = t[(d * 3 + 2) * 512 + k];
          const float mx = fmaxf(a0, fmaxf(a1, a2)); const float e0 = expf(a0 - mx), e1 = expf(a1 - mx), e2 = expf(a2 - mx);
          LB[i] = e0 / (e0 + e1 + e2); } }
    { float* BT = (float*)(ws + WS_BT); const float* rb = a.in[14];
      for (int i = F.bid * NTHR + F.tid; i < 3 * 16 * 129; i += F.G * NTHR) { const int p = i / (16 * 129), h = (i / 129) % 16, j = i % 129;
          const int dil = (p == 0) ? 1 : (p == 1 ? 4 : 16);
          BT[i] = rb[t5_bucket((j - 64) * dil) * 16 + h]; } }
    { bf16* H = (bf16*)(ws + WS_H); const float* x = a.in[0];
      for (int m = F.gw; m < MTOK; m += F.NGW) { f32x4 v[4]; rms_row(x + (size_t)m * DM, a.in[1], v, F.lane); store_row_bf16(H + (size_t)m * DM, v, F.lane); } }
}

DI void phase_a_mix(Frame& F, const Args& a) {
    const bf16* GV = (const bf16*)(F.ws + WS_GV); const bf16* U = (const bf16*)(F.ws + WS_U); bf16* CAT = (bf16*)(F.ws + WS_CAT); const bf16* WSB = (const bf16*)(F.ws + WS_WSB);
    LAS float* st = (LAS float*)F.lds;
    LAS unsigned char* tl = F.lds + 1024;
    const int r32 = F.lane & 31, hh = F.lane >> 5, ci = F.wave & 3, tp = F.wave >> 2;
    for (int u = F.bid; u < 512; u += F.G) {
        const int g = u & 3, ch = u >> 2; const int row0 = ch * 128;
        v4u tw[4];
#pragma unroll
        for (int i = 0; i < 4; ++i) { const int p = F.tid + 512 * i; tw[i] = *(const v4u*)(GV + (size_t)(row0 + (p >> 4)) * AW + g * 128 + 8 * (p & 15)); }
        float p1[16], p2[16];
#pragma unroll
        for (int r = 0; r < 16; ++r) { const v4u w = *((const v4u*)(GV + (size_t)(row0 + 16 * F.wave + r) * AW) + F.lane);
            const float x0 = bflo(w.x), x1 = bfhi(w.x), x2 = bflo(w.y), x3 = bfhi(w.y), x4 = bflo(w.z), x5 = bfhi(w.z), x6 = bflo(w.w), x7 = bfhi(w.w);
            p1[r] = ((x0 + x1) + (x2 + x3)) + ((x4 + x5) + (x6 + x7)); p2[r] = ((x0 * x0 + x1 * x1) + (x2 * x2 + x3 * x3)) + ((x4 * x4 + x5 * x5) + (x6 * x6 + x7 * x7)); }
        const float s1 = red16(p1, F.lane), s2 = red16(p2, F.lane);
        __syncthreads();
        if ((F.lane & 3) == 0) { const float mu = s1 * (1.f / AW); const float var = fmaxf(s2 * (1.f / AW) - mu * mu, 0.f); const int r = 16 * F.wave + red16_idx(F.lane);
            st[2 * r] = mu; st[2 * r + 1] = 1.f / sqrtf(var + EPS); }
#pragma unroll
        for (int i = 0; i < 4; ++i) { const int p = F.tid + 512 * i; *(LAS v4u*)(tl + (p >> 4) * 272 + 16 * (p & 15)) = tw[i]; }
        __syncthreads();
        f32x16 acc[2];
#pragma unroll
        for (int j = 0; j < 16; ++j) { acc[0][j] = 0.f; acc[1][j] = 0.f; }
        const int cl = 32 * ci + r32;
        const float lg = a.in[6][g * 128 + cl], lb = a.in[7][g * 128 + cl];
        const bf16* w0 = WSB + (size_t)g * 16384 + (size_t)(64 * tp + r32) * 128 + 8 * hh;
#pragma unroll
        for (int s = 0; s < 8; ++s) {
            float e[8];
#pragma unroll
            for (int j = 0; j < 8; ++j) { const int tk = 16 * s + 8 * hh + j; e[j] = (bf2f(*(const LAS unsigned short*)(tl + tk * 272 + 2 * cl)) - st[2 * tk]) * st[2 * tk + 1] * lg + lb; }
            v4u bw; bw.x = pk2(e[0], e[1]); bw.y = pk2(e[2], e[3]); bw.z = pk2(e[4], e[5]); bw.w = pk2(e[6], e[7]);
            const bf16x8 at = __builtin_bit_cast(bf16x8, bw);
            acc[0] = MFMA32(at, *(const bf16x8*)(w0 + 16 * s), acc[0]);
            acc[1] = MFMA32(at, *(const bf16x8*)(w0 + 32 * 128 + 16 * s), acc[1]);
        }
#pragma unroll
        for (int q = 0; q < 2; ++q) { const int t = 64 * tp + 32 * q + r32; const float bs = a.in[9][g * 128 + t];
            const size_t ub = (size_t)(row0 + t) * AW + g * 128 + 32 * ci + 4 * hh, cb = (size_t)(row0 + t) * DM + g * 128 + 32 * ci + 4 * hh;
#pragma unroll
            for (int gq = 0; gq < 4; ++gq) { const v2u uw = *(const v2u*)(U + ub + 8 * gq); v2u o;
                o.x = pk2(bflo(uw.x) * (acc[q][4 * gq] + bs), bfhi(uw.x) * (acc[q][4 * gq + 1] + bs)); o.y = pk2(bflo(uw.y) * (acc[q][4 * gq + 2] + bs), bfhi(uw.y) * (acc[q][4 * gq + 3] + bs));
                *(v2u*)(CAT + cb + 8 * gq) = o; } }
    }
}

DI void phase_gla_scan(Frame& F) {
    float* ST = (float*)(F.ws + WS_ST); const float* DEC = (const float*)(F.ws + WS_DEC);
    for (int idx = F.bid * NTHR + F.tid; idx < 16 * 4096; idx += F.G * NTHR) {
        const int chain = idx >> 12, kv = (idx & 4095) * 4, k = kv >> 7;
        f32x4 d[16]; float dc[NSC];
#pragma unroll
        for (int sc = 0; sc < NSC; ++sc) dc[sc] = DEC[(chain * NSC + sc) * 128 + k];
#pragma unroll
        for (int sc = 0; sc < 16; ++sc) d[sc] = *(const f32x4*)(ST + (size_t)(chain * NSC + sc) * 16384 + kv);
        f32x4 S = (f32x4){0.f, 0.f, 0.f, 0.f};
#pragma unroll
        for (int sc = 0; sc < NSC; ++sc) { const f32x4 cur = d[sc & 15];
            if (sc + 16 < NSC) d[sc & 15] = *(const f32x4*)(ST + (size_t)(chain * NSC + sc + 16) * 16384 + kv);
            *(f32x4*)(ST + (size_t)(chain * NSC + sc) * 16384 + kv) = S; S = S * dc[sc] + cur; }
    }
}
DI void row16_load(const bf16* row, float (&v)[16], int lane) {
#pragma unroll
    for (int j = 0; j < 2; ++j) { const v4u w = *((const v4u*)row + 64 * j + lane);
        v[8 * j] = bflo(w.x); v[8 * j + 1] = bfhi(w.x); v[8 * j + 2] = bflo(w.y); v[8 * j + 3] = bfhi(w.y); v[8 * j + 4] = bflo(w.z); v[8 * j + 5] = bfhi(w.z); v[8 * j + 6] = bflo(w.w); v[8 * j + 7] = bfhi(w.w); }
}
DI void row16_add(const v4u (&w)[2], float sc, float (&v)[16]) {
#pragma unroll
    for (int j = 0; j < 2; ++j) { v[8 * j] += sc * bflo(w[j].x); v[8 * j + 1] += sc * bfhi(w[j].x); v[8 * j + 2] += sc * bflo(w[j].y); v[8 * j + 3] += sc * bfhi(w[j].y);
        v[8 * j + 4] += sc * bflo(w[j].z); v[8 * j + 5] += sc * bfhi(w[j].z); v[8 * j + 6] += sc * bflo(w[j].w); v[8 * j + 7] += sc * bfhi(w[j].w); }
}
DI void row16_store(bf16* row, const float (&v)[16], int lane) {
#pragma unroll
    for (int j = 0; j < 2; ++j) { v4u w; w.x = pk2(v[8 * j], v[8 * j + 1]); w.y = pk2(v[8 * j + 2], v[8 * j + 3]); w.z = pk2(v[8 * j + 4], v[8 * j + 5]); w.w = pk2(v[8 * j + 6], v[8 * j + 7]); *((v4u*)row + 64 * j + lane) = w; }
}
DI void row16_gain(const float* g, float (&gv)[16], int lane) {
#pragma unroll
    for (int j = 0; j < 2; ++j)
#pragma unroll
        for (int hq = 0; hq < 2; ++hq) { const f32x4 t = *(const f32x4*)(g + 512 * j + 8 * lane + 4 * hq); gv[8 * j + 4 * hq] = t.x; gv[8 * j + 4 * hq + 1] = t.y; gv[8 * j + 4 * hq + 2] = t.z; gv[8 * j + 4 * hq + 3] = t.w; }
}
DI float row16_sumsq(const float (&v)[16]) { float s = 0.f;
#pragma unroll
    for (int i = 0; i < 16; i += 4) s += (v[i] * v[i] + v[i + 1] * v[i + 1]) + (v[i + 2] * v[i + 2] + v[i + 3] * v[i + 3]);
    return s; }
DI void phase_router(Frame& F, const bf16* XR, const float* gn, const float* wr) {
    LAS float* wl = (LAS float*)F.lds;
    __syncthreads();
    for (int i = F.tid; i < 1024 * 16 / 4; i += NTHR) { const f32x4 w4 = *(const f32x4*)(wr + 4 * i); const int d = i >> 2, e0 = 4 * (i & 3);
        const int pos = (d & 512) + 256 * ((d >> 2) & 1) + 4 * ((d >> 3) & 63) + (d & 3);
        wl[(e0 + 0) * 1024 + pos] = w4.x; wl[(e0 + 1) * 1024 + pos] = w4.y; wl[(e0 + 2) * 1024 + pos] = w4.z; wl[(e0 + 3) * 1024 + pos] = w4.w; }
    __syncthreads();
    bf16* H = (bf16*)(F.ws + WS_H); float* AFF = (float*)(F.ws + WS_AFF);
    for (int mp = F.gw; mp < MTOK / 2; mp += F.NGW) {
        asm volatile("" ::: "memory");
        const int m0 = 2 * mp;
        float va[16], vb[16], gv[16];
        row16_load(XR + (size_t)m0 * DM, va, F.lane); row16_load(XR + (size_t)(m0 + 1) * DM, vb, F.lane); row16_gain(gn, gv, F.lane);
        const float ra = 1.f / sqrtf(wave_sum(row16_sumsq(va)) * (1.f / DM) + EPS), rb = 1.f / sqrtf(wave_sum(row16_sumsq(vb)) * (1.f / DM) + EPS);
#pragma unroll
        for (int i = 0; i < 16; ++i) { va[i] = va[i] * ra * gv[i]; vb[i] = vb[i] * rb * gv[i]; }
        row16_store(H + (size_t)m0 * DM, va, F.lane); row16_store(H + (size_t)(m0 + 1) * DM, vb, F.lane);
        float pa[16], pb[16];
#pragma unroll
        for (int e = 0; e < 16; ++e) { float a = 0.f, c = 0.f;
#pragma unroll
            for (int j = 0; j < 2; ++j)
#pragma unroll
                for (int hq = 0; hq < 2; ++hq) { const f32x4 w4 = *(const LAS f32x4*)(wl + e * 1024 + 512 * j + 256 * hq + 4 * F.lane); const int o = 8 * j + 4 * hq;
                    a += (va[o] * w4.x + va[o + 1] * w4.y) + (va[o + 2] * w4.z + va[o + 3] * w4.w); c += (vb[o] * w4.x + vb[o + 1] * w4.y) + (vb[o + 2] * w4.z + vb[o + 3] * w4.w); }
            pa[e] = a; pb[e] = c; }
        const float la = red16(pa, F.lane), lb = red16(pb, F.lane);
        const float ma = wave_max(la), mb = wave_max(lb); const float ea = expf(la - ma), eb = expf(lb - mb); const float za = wave_sum(ea) * 0.25f, zb = wave_sum(eb) * 0.25f;
        if ((F.lane & 3) == 0) { const int b = m0 / SEQ, sq = m0 % SEQ; float* ap = AFF + (size_t)(b * 16 + red16_idx(F.lane)) * SEQ + sq; ap[0] = ea / za; ap[1] = eb / zb; }
    }
}

DI int block_excl_scan(int v, LAS int* scratch, int tid, int lane, int wave, int* tot) {
    int inc = v;
#pragma unroll
    for (int o = 1; o < 64; o <<= 1) { const int t = __shfl_up(inc, o); if (lane >= o) inc += t; }
    __syncthreads();
    if (lane == 63) scratch[wave] = inc;
    __syncthreads();
    int base = 0, total = 0;
#pragma unroll
    for (int w = 0; w < NWAVES; ++w) { const int s = scratch[w]; if (w < wave) base += s; total += s; }
    *tot = total;
    return base + inc - v;
}
DI void phase_topk(Frame& F) {
    const float* AFF = (const float*)(F.ws + WS_AFF); int* IDX = (int*)(F.ws + WS_IDX); float* GATE = (float*)(F.ws + WS_GATE); int* POS = (int*)(F.ws + WS_POS);
    LAS unsigned* hist = (LAS unsigned*)F.lds; LAS int* sc = (LAS int*)(F.lds + 16384); LAS unsigned* shv = (LAS unsigned*)(F.lds + 16384 + 256);
    for (int u = F.bid; u < BATCH * NEXP; u += F.G) {
        const int b = u / NEXP, e = u % NEXP;
        unsigned vals[16];
        { const v4u* src = (const v4u*)(AFF + (size_t)u * SEQ + 16 * F.tid);
#pragma unroll
          for (int j = 0; j < 4; ++j) { const v4u t = src[j]; vals[4 * j] = t.x; vals[4 * j + 1] = t.y; vals[4 * j + 2] = t.z; vals[4 * j + 3] = t.w; } }
        unsigned prefix = 0; int krem = CAP;
#pragma unroll
        for (int pass = 0; pass < 3; ++pass) {
            const int shift = (pass == 0) ? 20 : (pass == 1 ? 8 : 0); const unsigned mask = (pass == 2) ? 255u : 4095u; const int pshift = (pass == 2) ? 8 : 20;
            __syncthreads();
#pragma unroll
            for (int j = 0; j < 8; ++j) hist[F.tid + 512 * j] = 0u;
            __syncthreads();
#pragma unroll
            for (int j = 0; j < 16; ++j) { const unsigned v = vals[j]; if (pass == 0 || (v >> pshift) == prefix) __hip_atomic_fetch_add(&hist[(v >> shift) & mask], 1u, __ATOMIC_RELAXED, __HIP_MEMORY_SCOPE_WORKGROUP); }
            __syncthreads();
            const int hi = 4095 - 8 * F.tid; int ls = 0; unsigned hb[8];
#pragma unroll
            for (int j = 0; j < 8; ++j) { hb[j] = hist[hi - j]; ls += (int)hb[j]; }
            int tot; const int above = block_excl_scan(ls, sc, F.tid, F.lane, F.wave, &tot);
            if (above < krem && krem <= above + ls) { int cum = above, sel = hi, found = 0;
#pragma unroll
                for (int j = 0; j < 8; ++j) { if (!found) { if (cum + (int)hb[j] >= krem) { sel = hi - j; found = 1; } else cum += (int)hb[j]; } }
                shv[0] = (unsigned)sel; shv[1] = (unsigned)(krem - cum); }
            __syncthreads();
            prefix = (pass == 2) ? ((prefix << 8) | shv[0]) : ((prefix << 12) | shv[0]); krem = (int)shv[1];
        }
        const unsigned T = prefix;
        int ce = 0;
#pragma unroll
        for (int j = 0; j < 16; ++j) ce += (vals[j] == T) ? 1 : 0;
        int tot; int pe = block_excl_scan(ce, sc, F.tid, F.lane, F.wave, &tot);
        unsigned selmask = 0; int cs = 0;
#pragma unroll
        for (int j = 0; j < 16; ++j) { bool s = vals[j] > T; if (vals[j] == T) { s = pe < krem; ++pe; } if (s) { selmask |= 1u << j; ++cs; } }
        int slot = block_excl_scan(cs, sc, F.tid, F.lane, F.wave, &tot);
#pragma unroll
        for (int j = 0; j < 16; ++j) { const int s = 16 * F.tid + j; const int tokrow = b * SEQ + s;
            if (selmask & (1u << j)) { const int row = (e * 2 + b) * CAP + slot; ++slot; IDX[row] = tokrow; GATE[row] = __builtin_bit_cast(float, vals[j]); POS[tokrow * 16 + e] = row; }
            else POS[tokrow * 16 + e] = -1; }
    }
}
DI void phase_gather(Frame& F) {
    const bf16* H = (const bf16*)(F.ws + WS_H); bf16* XE = (bf16*)(F.ws + WS_XE); const int* IDX = (const int*)(F.ws + WS_IDX);
    for (int r = F.gw; r < NROWS; r += F.NGW) { const int src = IDX[r];
        const v4u* s = (const v4u*)(H + (size_t)src * DM) + F.lane; v4u* d = (v4u*)(XE + (size_t)r * DM) + F.lane;
        d[0] = s[0]; d[64] = s[64]; }
}
struct CombRow { float v[16]; v4u y[4][2]; float sc[4]; unsigned rest; int pm; };
DI void comb_load(CombRow& c, const bf16* XR, const bf16* Y, const int* POS, int m, int lane) {
    row16_load(XR + (size_t)m * DM, c.v, lane);
    c.pm = POS[m * 16 + (lane & 15)];
    unsigned mk = (unsigned)__builtin_amdgcn_readfirstlane((int)(unsigned)(__ballot(lane < 16 && c.pm >= 0)));
#pragma unroll
    for (int q = 0; q < 4; ++q) {
        int p = -1;
        if (mk) { const int e = __builtin_ctz(mk); mk &= mk - 1u; p = __builtin_amdgcn_readlane(c.pm, e); }
        c.sc[q] = (p >= 0) ? 1.f : 0.f;
        const v4u* yr = (const v4u*)(Y + (size_t)(p >= 0 ? p : 0) * DM) + lane;
        c.y[q][0] = yr[0]; c.y[q][1] = yr[64];
    }
    c.rest = mk;
}
DI void comb_finish(CombRow& c, bf16* XR, float* out, bf16* H, const bf16* Y, const float* gnext, bool final_out, int m, int lane) {
#pragma unroll
    for (int q = 0; q < 4; ++q) row16_add(c.y[q], c.sc[q], c.v);
    unsigned mk = c.rest;
    while (mk) { const int e = __builtin_ctz(mk); mk &= mk - 1u; const int p = __builtin_amdgcn_readlane(c.pm, e);
        const v4u* yr = (const v4u*)(Y + (size_t)p * DM) + lane; v4u w[2]; w[0] = yr[0]; w[1] = yr[64]; row16_add(w, 1.f, c.v); }
    const float rstd = 1.f / sqrtf(wave_sum(row16_sumsq(c.v)) * (1.f / DM) + EPS);
    float gv[16]; row16_gain(gnext, gv, lane);
    if (final_out) {
        float* xo = out + (size_t)m * DM;
#pragma unroll
        for (int j = 0; j < 2; ++j)
#pragma unroll
            for (int hq = 0; hq < 2; ++hq) { const int o = 8 * j + 4 * hq;
                *(f32x4*)(xo + 512 * j + 8 * lane + 4 * hq) = (f32x4){c.v[o] * rstd * gv[o], c.v[o + 1] * rstd * gv[o + 1], c.v[o + 2] * rstd * gv[o + 2], c.v[o + 3] * rstd * gv[o + 3]}; }
    } else {
        row16_store(XR + (size_t)m * DM, c.v, lane);
        float nv[16];
#pragma unroll
        for (int i = 0; i < 16; ++i) nv[i] = c.v[i] * rstd * gv[i];
        row16_store(H + (size_t)m * DM, nv, lane);
    }
}
DI void phase_moe_combine(Frame& F, bf16* XR, float* out, const float* gnext, bool final_out) {
    const bf16* Y = (const bf16*)(F.ws + WS_Y); const int* POS = (const int*)(F.ws + WS_POS); bf16* H = (bf16*)(F.ws + WS_H);
    for (int m = F.gw; m < MTOK; m += 2 * F.NGW) {
        CombRow ca, cb; const int m2 = m + F.NGW;
        comb_load(ca, XR, Y, POS, m, F.lane);
        if (m2 < MTOK) comb_load(cb, XR, Y, POS, m2, F.lane);
        comb_finish(ca, XR, out, H, Y, gnext, final_out, m, F.lane);
        if (m2 < MTOK) comb_finish(cb, XR, out, H, Y, gnext, final_out, m2, F.lane);
    }
}

DI int kperm(int r) { return (r & ~12) | ((r & 4) << 1) | ((r & 8) >> 1); }
DI void phase_kvf(Frame& F) {
    const bf16* QKV = (const bf16*)(F.ws + WS_QKV); unsigned char* KF = F.ws + WS_KF; unsigned char* VF = F.ws + WS_VF;
    LAS unsigned char* kl = F.lds; LAS unsigned char* vl = F.lds + 69632;
    for (int u = F.bid; u < 512; u += F.G) {
        const int c = u & 15, h = (u >> 4) & 15, b = u >> 8, t0 = c * 512;
        __syncthreads();
        { const v4u* ks = (const v4u*)(QKV + (size_t)(b * SEQ + t0 + F.tid) * NQKV + 1024 + h * 64); const v4u* vs = (const v4u*)(QKV + (size_t)(b * SEQ + t0 + F.tid) * NQKV + 2048 + h * 64);
#pragma unroll
          for (int j = 0; j < 8; ++j) { const v4u w = ks[j]; LAS v2u* d = (LAS v2u*)(kl + F.tid * 136 + 16 * j); d[0] = (v2u){w.x, w.y}; d[1] = (v2u){w.z, w.w}; }
#pragma unroll
          for (int j = 0; j < 8; ++j) { const v4u w = vs[j]; LAS v2u* d = (LAS v2u*)(vl + F.tid * 136 + 16 * j); d[0] = (v2u){w.x, w.y}; d[1] = (v2u){w.z, w.w}; } }
        __syncthreads();
#pragma unroll
        for (int p = 0; p < 3; ++p) {
            const int dl = (p == 0) ? 1 : (p == 1 ? 4 : 16), tpr = 16 / dl, ntile = SEQ / dl / 32;
            unsigned char* kd = KF + (size_t)p * 32 * MiB; unsigned char* vd = VF + (size_t)p * 32 * MiB;
#pragma unroll 2
            for (int i = 0; i < 8; ++i) { const int q = F.tid + 512 * i, tl = q >> 8, ln = q & 63, hh = ln >> 5, rho = ln & 31, r = tl / tpr, tt = tl % tpr;
                const size_t tg = ((size_t)((b * 16 + h) * dl + r) * ntile + c * tpr + tt) * 4096;
                { const int s = (q >> 6) & 3, tokl = dl * (32 * tt + kperm(rho)) + r;
                  const LAS v2u* sp = (const LAS v2u*)(kl + tokl * 136 + 64 * hh + 16 * s); const v2u a0 = sp[0], a1 = sp[1];
                  *(v4u*)(kd + tg + s * 1024 + ln * 16) = (v4u){a0.x, a0.y, a1.x, a1.y}; }
                { const int dt = (q >> 7) & 1, s2 = (q >> 6) & 1, dim = 32 * dt + rho; unsigned short e[8];
#pragma unroll
                  for (int k = 0; k < 8; ++k) e[k] = *(const LAS unsigned short*)(vl + (dl * (32 * tt + 16 * s2 + 8 * hh + k) + r) * 136 + dim * 2);
                  v4u o; o.x = e[0] | ((unsigned)e[1] << 16); o.y = e[2] | ((unsigned)e[3] << 16); o.z = e[4] | ((unsigned)e[5] << 16); o.w = e[6] | ((unsigned)e[7] << 16);
                  *(v4u*)(vd + tg + (dt * 2 + s2) * 1024 + ln * 16) = o; }
            }
        }
    }
}

DI int osw(int tok, int chunk) { return tok * 256 + (((chunk ^ tok ^ (tok >> 4)) & 15) << 4); }
struct AttnK { bf16x8 k[4]; }; struct AttnV { bf16x8 v[2][2]; };
#ifndef PROBE_DUP
#define PROBE_DUP (-1)
#endif
#ifndef PROBE_SAME
#define PROBE_SAME 0
#endif
DI void attn_load_k(AttnK& t, const unsigned char* kt) {
#pragma unroll
    for (int s = 0; s < 4; ++s) t.k[s] = *(const bf16x8*)(kt + s * 1024);
    if (PROBE_DUP == 77) {
#pragma unroll
        for (int s = 0; s < 4; ++s) { bf16x8 d = *(const bf16x8*)(kt + s * 1024 + (PROBE_SAME ? 0 : 64 * MiB)); asm volatile("" :: "v"(d)); }
    }
}
DI void attn_load_v(AttnV& t, const unsigned char* vt) {
#pragma unroll
    for (int dt = 0; dt < 2; ++dt)
#pragma unroll
        for (int s = 0; s < 2; ++s) t.v[dt][s] = *(const bf16x8*)(vt + (dt * 2 + s) * 1024);
}
template <bool MASK> DI void attn_step(const AttnK& tk, const AttnV& tv, const bf16x8 (&qf)[4], f32x16& o0, f32x16& o1, float& m, float& l, const LAS float* bl, int rel0, int hh) {
    f32x16 sa;
#pragma unroll
    for (int i = 0; i < 16; ++i) sa[i] = 0.f;
#pragma unroll
    for (int s = 0; s < 4; ++s) sa = MFMA32(tk.k[s], qf[s], sa);
    float sc[16]; float tmax = -1e30f;
#pragma unroll
    for (int i = 0; i < 16; ++i) { const int rel = rel0 + 16 * (i >> 3) + (i & 7);
        const bool valid = !MASK || ((rel >= -64) && (rel <= 64)); const int idx = valid ? rel + 64 : 0;
        const float v = sa[i] + bl[idx]; sc[i] = valid ? v : -1e30f; tmax = fmaxf(tmax, sc[i]); }
    tmax = fmaxf(tmax, __shfl_xor(tmax, 32));
    const float mnew = fmaxf(m, tmax), alpha = fexp(m - mnew);
    float ps = 0.f; float p[16];
#pragma unroll
    for (int i = 0; i < 16; ++i) { p[i] = (!MASK || sc[i] > -1e29f) ? fexp(sc[i] - mnew) : 0.f; ps += p[i]; }
    l = l * alpha + ps; m = mnew;
#pragma unroll
    for (int i = 0; i < 16; ++i) { o0[i] *= alpha; o1[i] *= alpha; }
#pragma unroll
    for (int s = 0; s < 2; ++s) {
        v4u w; w.x = pk2(p[8 * s], p[8 * s + 1]); w.y = pk2(p[8 * s + 2], p[8 * s + 3]); w.z = pk2(p[8 * s + 4], p[8 * s + 5]); w.w = pk2(p[8 * s + 6], p[8 * s + 7]);
        const bf16x8 pf = __builtin_bit_cast(bf16x8, w);
        o0 = MFMA32(tv.v[0][s], pf, o0); o1 = MFMA32(tv.v[1][s], pf, o1);
    }
}
DI void attn_stage(Frame& F, int b, int h, int t0, const int P) {
    const int dsh = 2 * P, DL = 1 << dsh, NT = (SEQ / 32) >> dsh;
    const bf16* QKV = (const bf16*)(F.ws + WS_QKV); const unsigned char* KF = F.ws + WS_KF + (size_t)P * 32 * MiB; const unsigned char* VF = F.ws + WS_VF + (size_t)P * 32 * MiB; bf16* ATT = (bf16*)(F.ws + WS_ATT);
    LAS unsigned char* ol = F.lds; LAS float* ml = (LAS float*)(F.lds + 131072); LAS float* ll = ml + 512; const LAS float* bl = (const LAS float*)(F.lds + 135168) + P * 132;
    int lane = F.lane; asm volatile("" : "+v"(lane));
    const int r32 = lane & 31, hh = lane >> 5, w = F.wave;
    asm volatile("" ::: "memory");
    int rr[2], mq[2], tq[2]; const unsigned char* kb[2]; const unsigned char* vb[2];
#pragma unroll
    for (int task = 0; task < 2; ++task) {
        int r, i0;
        if (P == 0) { r = 0; i0 = 64 * w + 32 * task; } else if (P == 1) { r = w & 3; i0 = 64 * (w >> 2) + 32 * task; } else { r = 2 * w + task; i0 = 0; }
        rr[task] = r; mq[task] = (t0 >> dsh) + i0; tq[task] = r + ((i0 + r32) << dsh);
        const size_t tb0 = ((size_t)((b * 16 + h) * DL + r) * NT) * 4096 + lane * 16;
        kb[task] = KF + tb0; vb[task] = VF + tb0;
    }
    int relb = 8 * hh - 64 - r32;
    asm volatile("" : "+v"(relb));
    AttnK ka, kb_, kc; AttnV va, vb_; bf16x8 qf[4], qn[4]; f32x16 o0, o1; float m, l;
#define ATT_T(task, kt) (mq[task] / 32 - 2 + (kt))
#define ATT_OK(task, kt) (ATT_T(task, kt) >= 0 && ATT_T(task, kt) < NT)
#define ATT_TC(task, kt) (ATT_T(task, kt) < 0 ? 0 : (ATT_T(task, kt) >= NT ? NT - 1 : ATT_T(task, kt)))
#define ATT_LDK(t, task, kt) attn_load_k(t, kb[task] + (size_t)ATT_TC(task, kt) * 4096)
#define ATT_LDV(t, task, kt) attn_load_v(t, vb[task] + (size_t)ATT_TC(task, kt) * 4096)
#define ATT_ST(tk, tv, task, kt, MSK) do { if (ATT_OK(task, kt)) attn_step<MSK>(tk, tv, qf, o0, o1, m, l, bl, relb + 32 * (kt), hh); } while (0)
#define ATT_Q(dst, task) do { const bf16* qp = QKV + (size_t)(b * SEQ + t0 + tq[task]) * NQKV + h * 64 + 32 * hh; _Pragma("unroll") for (int s = 0; s < 4; ++s) dst[s] = *(const bf16x8*)(qp + 8 * s); } while (0)
#define ATT_INIT(task) do { if (P == 0) { _Pragma("unroll") for (int i = 0; i < 16; ++i) { o0[i] = 0.f; o1[i] = 0.f; } m = -1e30f; l = 0.f; } else { \
        _Pragma("unroll") for (int g = 0; g < 4; ++g) { const f32x4 a = *(const LAS f32x4*)(ol + osw(tq[task], 2 * g + hh)), c = *(const LAS f32x4*)(ol + osw(tq[task], 8 + 2 * g + hh)); \
            o0[4 * g] = a.x; o0[4 * g + 1] = a.y; o0[4 * g + 2] = a.z; o0[4 * g + 3] = a.w; o1[4 * g] = c.x; o1[4 * g + 1] = c.y; o1[4 * g + 2] = c.z; o1[4 * g + 3] = c.w; } \
        m = ml[tq[task]]; l = hh ? 0.f : ll[tq[task]]; } } while (0)
#define ATT_WB(task) do { const float lt = l + __shfl_xor(l, 32); int tw = tq[task]; asm volatile("" : "+v"(tw));     \
        if (P < 2) { _Pragma("unroll") for (int g = 0; g < 4; ++g) { *(LAS f32x4*)(ol + osw(tw, 2 * g + hh)) = (f32x4){o0[4 * g], o0[4 * g + 1], o0[4 * g + 2], o0[4 * g + 3]}; \
                *(LAS f32x4*)(ol + osw(tw, 8 + 2 * g + hh)) = (f32x4){o1[4 * g], o1[4 * g + 1], o1[4 * g + 2], o1[4 * g + 3]}; } \
            if (hh == 0) { ml[tw] = m; ll[tw] = lt; } } \
        else { const float inv = 1.f / lt; bf16* op = ATT + (size_t)(b * SEQ + t0 + tw) * DM + h * 64 + 4 * hh; \
            _Pragma("unroll") for (int g = 0; g < 4; ++g) { v2u a, c; a.x = pk2(o0[4 * g] * inv, o0[4 * g + 1] * inv); a.y = pk2(o0[4 * g + 2] * inv, o0[4 * g + 3] * inv); \
                c.x = pk2(o1[4 * g] * inv, o1[4 * g + 1] * inv); c.y = pk2(o1[4 * g + 2] * inv, o1[4 * g + 3] * inv); *(v2u*)(op + 8 * g) = a; *(v2u*)(op + 32 + 8 * g) = c; } } } while (0)
    ATT_LDK(ka, 0, 0); ATT_LDK(kb_, 0, 1); ATT_LDV(va, 0, 0);
    ATT_Q(qf, 0); ATT_INIT(0);
    ATT_LDK(kc, 0, 2); ATT_LDV(vb_, 0, 1); ATT_ST(ka, va, 0, 0, true);
    ATT_LDK(ka, 0, 3); ATT_LDV(va, 0, 2); ATT_ST(kb_, vb_, 0, 1, false);
    ATT_LDK(kb_, 0, 4); ATT_LDV(vb_, 0, 3); ATT_ST(kc, va, 0, 2, false);
    ATT_Q(qn, 1);
    ATT_LDK(kc, 1, 0); ATT_LDV(va, 0, 4); ATT_ST(ka, vb_, 0, 3, false);
    ATT_LDK(ka, 1, 1); ATT_LDV(vb_, 1, 0); ATT_ST(kb_, va, 0, 4, true);
    ATT_WB(0);
    _Pragma("unroll") for (int s = 0; s < 4; ++s) qf[s] = qn[s];
    ATT_INIT(1);
    ATT_LDK(kb_, 1, 2); ATT_LDV(va, 1, 1); ATT_ST(kc, vb_, 1, 0, true);
    ATT_LDK(kc, 1, 3); ATT_LDV(vb_, 1, 2); ATT_ST(ka, va, 1, 1, false);
    ATT_LDK(ka, 1, 4); ATT_LDV(va, 1, 3); ATT_ST(kb_, vb_, 1, 2, false);
    ATT_LDV(vb_, 1, 4); ATT_ST(kc, va, 1, 3, false);
    ATT_ST(ka, vb_, 1, 4, true);
    ATT_WB(1);
#undef ATT_T
#undef ATT_OK
#undef ATT_TC
#undef ATT_LDK
#undef ATT_LDV
#undef ATT_ST
#undef ATT_Q
#undef ATT_INIT
#undef ATT_WB
}
DI void phase_attn(Frame& F) {
    const float* BT = (const float*)(F.ws + WS_BT);
    LAS float* bl = (LAS float*)(F.lds + 135168);
    const int vb_ = (F.G % 8 == 0) ? (F.bid % 8) * (F.G / 8) + F.bid / 8 : F.bid;
    for (int u = vb_; u < 512; u += F.G) {
        const int c = u & 15, h = (u >> 4) & 15, b = u >> 8, t0 = c * 512;
        __syncthreads();
        { int i0 = F.tid; asm volatile("" : "+v"(i0)); for (int i = i0; i < 3 * 129; i += NTHR) bl[(i / 129) * 132 + i % 129] = BT[((i / 129) * 16 + h) * 129 + i % 129]; }
        __syncthreads();
#pragma unroll 1
        for (int P = 0; P < 3; ++P) { if (P) __syncthreads(); attn_stage(F, b, h, t0, P); }
    }
}

constexpr int GL_QT = 0, GL_KT = 17408, GL_QB = 34816, GL_KHT = 52224, GL_VT = 70656, GL_P = 89088, GL_ST = 98304, GL_DEC = 133120, GL_TOT = 133632;
struct GlaRaw { v4u q[2], lf[2], v[2]; };
DI void gla_load_raw(GlaRaw& R, const _Float16* LF, const bf16* Q, const bf16* V, int b, int h, int dir, int pos0, int tid) {
#pragma unroll
    for (int i = 0; i < 2; ++i) { const int p = tid + 512 * i, ii = pos0 + (p >> 4); const int tok = dir ? (SEQ - 1 - ii) : ii; const size_t off = (size_t)(b * SEQ + tok) * AW + h * 128 + 8 * (p & 15);
        R.q[i] = *(const v4u*)(Q + off); R.lf[i] = *(const v4u*)(LF + off); R.v[i] = *(const v4u*)(V + off); }
}
DI void gla_prep(Frame& F, const GlaRaw& R) {
    LAS unsigned char* L = F.lds; LAS float* tot = (LAS float*)(L + GL_TOT);
    const int ch = F.tid & 127, qtr = F.tid >> 7;
#pragma unroll
    for (int i = 0; i < 2; ++i) { const int p = F.tid + 512 * i; const int so = (p >> 4) * 272 + 16 * (p & 15);
        *(LAS v4u*)(L + GL_QT + so) = R.q[i]; *(LAS v4u*)(L + GL_KT + so) = R.lf[i]; *(LAS v4u*)(L + GL_QB + so) = R.v[i]; }
    __syncthreads();
    float lf[16]; unsigned short qr[16], vr[16];
#pragma unroll
    for (int i = 0; i < 16; ++i) { const int so = (16 * qtr + i) * 272 + 2 * ch;
        qr[i] = *(const LAS unsigned short*)(L + GL_QT + so); lf[i] = (float)*(const LAS _Float16*)(L + GL_KT + so); vr[i] = *(const LAS unsigned short*)(L + GL_QB + so); }
    float c[16]; float run = 0.f;
#pragma unroll
    for (int i = 0; i < 16; ++i) { run += lf[i]; c[i] = run; }
    tot[qtr * 128 + ch] = run;
    __syncthreads();
    const float t0 = tot[ch], t1 = tot[128 + ch], t2 = tot[256 + ch], t3 = tot[384 + ch];
    const float off = (qtr > 0 ? t0 : 0.f) + (qtr > 1 ? t1 : 0.f) + (qtr > 2 ? t2 : 0.f), rr = t0 + t1, bend = (t0 + t1) + (t2 + t3);
    const float er = fexp(rr), ebr = fexp(bend - rr);
    unsigned kh[8], vv[8];
#pragma unroll
    for (int i = 0; i < 16; i += 2) {
        const float E0 = fexp(off + c[i] - rr), E1 = fexp(off + c[i + 1] - rr), I0 = frcp(E0), I1 = frcp(E1);
        const float k0 = 1.f - fexp(lf[i]), k1 = 1.f - fexp(lf[i + 1]);
        const float ki0 = k0 * I0, ki1 = k1 * I1;
        kh[i >> 1] = pk2(ki0 * ebr, ki1 * ebr);
        vv[i >> 1] = (unsigned)vr[i] | ((unsigned)vr[i + 1] << 16);
        const float q0 = bf2f(qr[i]) * E0, q1 = bf2f(qr[i + 1]) * E1;
        const int ta = 16 * qtr + i;
        *(LAS unsigned short*)(L + GL_QT + ta * 272 + 2 * ch) = (unsigned short)f2bf(q0);
        *(LAS unsigned short*)(L + GL_QT + (ta + 1) * 272 + 2 * ch) = (unsigned short)f2bf(q1);
        *(LAS unsigned short*)(L + GL_KT + ta * 272 + 2 * ch) = (unsigned short)f2bf(ki0);
        *(LAS unsigned short*)(L + GL_KT + (ta + 1) * 272 + 2 * ch) = (unsigned short)f2bf(ki1);
        *(LAS unsigned short*)(L + GL_QB + ta * 272 + 2 * ch) = (unsigned short)f2bf(q0 * er);
        *(LAS unsigned short*)(L + GL_QB + (ta + 1) * 272 + 2 * ch) = (unsigned short)f2bf(q1 * er);
    }
    *(LAS v4u*)(L + GL_KHT + ch * 144 + 32 * qtr) = (v4u){kh[0], kh[1], kh[2], kh[3]}; *(LAS v4u*)(L + GL_KHT + ch * 144 + 32 * qtr + 16) = (v4u){kh[4], kh[5], kh[6], kh[7]};
    *(LAS v4u*)(L + GL_VT + ch * 144 + 32 * qtr) = (v4u){vv[0], vv[1], vv[2], vv[3]}; *(LAS v4u*)(L + GL_VT + ch * 144 + 32 * qtr + 16) = (v4u){vv[4], vv[5], vv[6], vv[7]};
    if (qtr == 0) *(LAS float*)(L + GL_DEC + 4 * ch) = fexp(bend);
}
DI bf16x8 gfrag(const LAS unsigned char* base, int row, int stride, int kel) { return *(const LAS bf16x8*)(base + row * stride + kel * 2); }
DI void gla_state_update(Frame& F, f32x16 (&S)[2]) {
    const LAS unsigned char* L = F.lds; const int r32 = F.lane & 31, hh = F.lane >> 5, vi = F.wave & 3, ki0 = 2 * (F.wave >> 2);
    bf16x8 a[4];
#pragma unroll
    for (int s = 0; s < 4; ++s) a[s] = gfrag(L + GL_VT, 32 * vi + r32, 144, 16 * s + 8 * hh);
#pragma unroll
    for (int q = 0; q < 2; ++q) { const int kr = 32 * (ki0 + q) + r32; const float d = *(const LAS float*)(L + GL_DEC + 4 * kr);
#pragma unroll
        for (int j = 0; j < 16; ++j) S[q][j] *= d;
#pragma unroll
        for (int s = 0; s < 4; ++s) S[q] = MFMA32(a[s], gfrag(L + GL_KHT, kr, 144, 16 * s + 8 * hh), S[q]); }
}
DI void gla_state_to_lds(Frame& F, const f32x16 (&S)[2]) {
    LAS unsigned char* L = F.lds; const int r32 = F.lane & 31, hh = F.lane >> 5, vi = F.wave & 3, ki0 = 2 * (F.wave >> 2);
#pragma unroll
    for (int q = 0; q < 2; ++q)
#pragma unroll
        for (int j = 0; j < 16; ++j) *(LAS unsigned short*)(L + GL_ST + (32 * vi + crow32(j, hh)) * 272 + 2 * (32 * (ki0 + q) + r32)) = (unsigned short)f2bf(S[q][j]);
}
constexpr int G1_KHT = 0, G1_VT = 69632, G1_TOT = 139264;
DI void gla_unit_state(Frame& F, int u) {
    const int sc = u & 31, dir = (u >> 5) & 1, h = (u >> 6) & 3, b = u >> 8;
    const bf16* V = (const bf16*)(F.ws + WS_V); const _Float16* LF = (const _Float16*)(F.ws + (dir ? WS_LFB : WS_LFF));
    float* ST = (float*)(F.ws + WS_ST) + (size_t)u * 16384; float* DEC = (float*)(F.ws + WS_DEC) + u * 128;
    LAS unsigned char* L = F.lds; LAS float* tot = (LAS float*)(L + G1_TOT);
    const int ch = F.tid & 127, qtr = F.tid >> 7, r32 = F.lane & 31, hh = F.lane >> 5, vi = F.wave & 3, ki0 = 2 * (F.wave >> 2);
    { v4u rl[8], rv[8];
#pragma unroll
      for (int i = 0; i < 8; ++i) { const int p = F.tid + 512 * i, ii = sc * 256 + (p >> 4); const int tok = dir ? (SEQ - 1 - ii) : ii; const size_t off = (size_t)(b * SEQ + tok) * AW + h * 128 + 8 * (p & 15);
          rl[i] = *(const v4u*)(LF + off); rv[i] = *(const v4u*)(V + off); }
      __syncthreads();
#pragma unroll
      for (int i = 0; i < 8; ++i) { const int p = F.tid + 512 * i; const int so = (p >> 4) * 272 + 16 * (p & 15); *(LAS v4u*)(L + G1_KHT + so) = rl[i]; *(LAS v4u*)(L + G1_VT + so) = rv[i]; } }
    __syncthreads();
    float lf[64]; unsigned vv[32];
#pragma unroll
    for (int i = 0; i < 64; ++i) { const int so = (64 * qtr + i) * 272 + 2 * ch;
        lf[i] = (float)*(const LAS _Float16*)(L + G1_KHT + so); const unsigned x = *(const LAS unsigned short*)(L + G1_VT + so); if (i & 1) vv[i >> 1] |= x << 16; else vv[i >> 1] = x; }
    float run = 0.f;
#pragma unroll
    for (int i = 0; i < 64; ++i) run += lf[i];
    __syncthreads();
    tot[qtr * 128 + ch] = run;
#pragma unroll
    for (int i = 0; i < 32; i += 4) *(LAS v4u*)(L + G1_VT + ch * 528 + 128 * qtr + 4 * i) = (v4u){vv[i], vv[i + 1], vv[i + 2], vv[i + 3]};
    __syncthreads();
    const float t0 = tot[ch], t1 = tot[128 + ch], t2 = tot[256 + ch], t3 = tot[384 + ch];
    const float bend = (t0 + t1) + (t2 + t3);
    run = (qtr > 0 ? t0 : 0.f) + (qtr > 1 ? t1 : 0.f) + (qtr > 2 ? t2 : 0.f);
#pragma unroll
    for (int i = 0; i < 64; i += 2) { const float b0 = run + lf[i], b1 = b0 + lf[i + 1]; run = b1;
        vv[i >> 1] = pk2((1.f - fexp(lf[i])) * fexp(bend - b0), (1.f - fexp(lf[i + 1])) * fexp(bend - b1)); }
#pragma unroll
    for (int i = 0; i < 32; i += 4) *(LAS v4u*)(L + G1_KHT + ch * 528 + 128 * qtr + 4 * i) = (v4u){vv[i], vv[i + 1], vv[i + 2], vv[i + 3]};
    if (qtr == 0) DEC[ch] = fexp(bend);
    __syncthreads();
    f32x16 S[2];
#pragma unroll
    for (int j = 0; j < 16; ++j) { S[0][j] = 0.f; S[1][j] = 0.f; }
#pragma unroll 4
    for (int s = 0; s < 16; ++s) { const bf16x8 av = gfrag(L + G1_VT, 32 * vi + r32, 528, 16 * s + 8 * hh);
        S[0] = MFMA32(av, gfrag(L + G1_KHT, 32 * ki0 + r32, 528, 16 * s + 8 * hh), S[0]);
        S[1] = MFMA32(av, gfrag(L + G1_KHT, 32 * (ki0 + 1) + r32, 528, 16 * s + 8 * hh), S[1]); }
#pragma unroll
    for (int q = 0; q < 2; ++q)
#pragma unroll
        for (int g = 0; g < 4; ++g) *(f32x4*)(ST + (size_t)(32 * (ki0 + q) + r32) * 128 + 32 * vi + 8 * g + 4 * hh) = (f32x4){S[q][4 * g], S[q][4 * g + 1], S[q][4 * g + 2], S[q][4 * g + 3]};
}
DI int red16h_idx(int lane) { return 8 * ((lane >> 4) & 1) + 4 * ((lane >> 3) & 1) + 2 * ((lane >> 2) & 1) + ((lane >> 1) & 1); }
DI float red16h(const float (&o)[16], int lane) {
    const bool b16 = lane & 16, b8 = lane & 8, b4 = lane & 4, b2 = lane & 2;
    float a8[8], a4[4], a2[2], a1;
#pragma unroll
    for (int j = 0; j < 8; ++j) { const float send = b16 ? o[j] : o[j + 8], keep = b16 ? o[j + 8] : o[j]; a8[j] = keep + __shfl_xor(send, 16); }
#pragma unroll
    for (int j = 0; j < 4; ++j) { const float send = b8 ? a8[j] : a8[j + 4], keep = b8 ? a8[j + 4] : a8[j]; a4[j] = keep + __shfl_xor(send, 8); }
#pragma unroll
    for (int j = 0; j < 2; ++j) { const float send = b4 ? a4[j] : a4[j + 2], keep = b4 ? a4[j + 2] : a4[j]; a2[j] = keep + __shfl_xor(send, 4); }
    { const float send = b2 ? a2[0] : a2[1], keep = b2 ? a2[1] : a2[0]; a1 = keep + __shfl_xor(send, 2); }
    a1 += __shfl_xor(a1, 1);
    return a1;
}
constexpr int GL_RS = 135680;
template <bool FUSE> DI void gla_unit_out(Frame& F, const Args& a, int u) {
    const int sc = u & 31, dir = (u >> 5) & 1, h = (u >> 6) & 3, b = u >> 8;
    const bf16* Q = (const bf16*)(F.ws + WS_Q); const bf16* V = (const bf16*)(F.ws + WS_V); const _Float16* LF = (const _Float16*)(F.ws + (dir ? WS_LFB : WS_LFF));
    const float* ST = (const float*)(F.ws + WS_ST) + (size_t)u * 16384; float* OF = (float*)(F.ws + WS_ODIR);
    const bf16* G = (const bf16*)(F.ws + WS_G); bf16* CAT = (bf16*)(F.ws + WS_CAT);
    const LAS unsigned char* L = F.lds;
    const int ch = F.tid & 127, qtr = F.tid >> 7, r32 = F.lane & 31, hh = F.lane >> 5, w = F.wave, vi = w & 3, ki0 = 2 * (w >> 2), ti = w >> 2;
    f32x16 S[2];
#pragma unroll
    for (int q = 0; q < 2; ++q)
#pragma unroll
        for (int g = 0; g < 4; ++g) { const f32x4 t = *(const f32x4*)(ST + (size_t)(32 * (ki0 + q) + r32) * 128 + 32 * vi + 8 * g + 4 * hh); S[q][4 * g] = t.x; S[q][4 * g + 1] = t.y; S[q][4 * g + 2] = t.z; S[q][4 * g + 3] = t.w; }
    GlaRaw cur, nxt;
    gla_load_raw(cur, LF, Q, V, b, h, dir, sc * 256, F.tid);
    __syncthreads();
    gla_state_to_lds(F, S);
    f32x4 ngv[4];
    if (FUSE) {
#pragma unroll
        for (int g = 0; g < 4; ++g) ngv[g] = *(const f32x4*)(a.in[11] + h * 128 + 32 * vi + 8 * g + 4 * hh);
    }
#pragma unroll 1
    for (int c = 0; c < 4; ++c) {
        gla_prep(F, cur);
        if (c < 3) gla_load_raw(nxt, LF, Q, V, b, h, dir, sc * 256 + (c + 1) * 64, F.tid);
        const int ii = sc * 256 + c * 64 + 32 * ti + r32; const int tok = dir ? (SEQ - 1 - ii) : ii;
        const size_t orow = (size_t)(b * SEQ + tok) * AW + h * 128 + 32 * vi + 4 * hh;
        f32x4 of[4]; v2u gg[4];
        if (FUSE) {
#pragma unroll
            for (int g = 0; g < 4; ++g) { of[g] = *(const f32x4*)(OF + orow + 8 * g); gg[g] = *(const v2u*)(G + orow + 8 * g); }
        }
        __syncthreads();
        f32x16 o;
#pragma unroll
        for (int j = 0; j < 16; ++j) o[j] = 0.f;
#pragma unroll
        for (int s = 0; s < 8; ++s) o = MFMA32(gfrag(L + GL_ST, 32 * vi + r32, 272, 16 * s + 8 * hh), gfrag(L + GL_QB, 32 * ti + r32, 272, 16 * s + 8 * hh), o);
        if (w < 3) {
            const int tp = (w + 1) >> 1, sp = (w == 2) ? 1 : 0;
            f32x16 p;
#pragma unroll
            for (int j = 0; j < 16; ++j) p[j] = 0.f;
#pragma unroll
            for (int s = 0; s < 8; ++s) p = MFMA32(gfrag(L + GL_QT, 32 * tp + r32, 272, 16 * s + 8 * hh), gfrag(L + GL_KT, 32 * sp + r32, 272, 16 * s + 8 * hh), p);
#pragma unroll
            for (int j = 0; j < 16; ++j) { const int t = 32 * tp + crow32(j, hh), s2 = 32 * sp + r32;
                *(LAS unsigned short*)(F.lds + GL_P + t * 144 + 2 * s2) = (s2 <= t) ? (unsigned short)f2bf(p[j]) : (unsigned short)0; }
        }
        __syncthreads();
        { const int ns = ti ? 4 : 2;
#pragma unroll
          for (int s = 0; s < 4; ++s) if (s < ns) o = MFMA32(gfrag(L + GL_VT, 32 * vi + r32, 144, 16 * s + 8 * hh), gfrag(L + GL_P, 32 * ti + r32, 144, 16 * s + 8 * hh), o); }
        if (!FUSE) {
#pragma unroll
            for (int g = 0; g < 4; ++g) *(f32x4*)(OF + orow + 8 * g) = (f32x4){o[4 * g], o[4 * g + 1], o[4 * g + 2], o[4 * g + 3]};
        } else {
            float part = 0.f;
#pragma unroll
            for (int g = 0; g < 4; ++g) { o[4 * g] += of[g].x; o[4 * g + 1] += of[g].y; o[4 * g + 2] += of[g].z; o[4 * g + 3] += of[g].w; }
#pragma unroll
            for (int j = 0; j < 16; ++j) part += o[j] * o[j];
            part += __shfl_xor(part, 32);
            if (hh == 0) *(LAS float*)(F.lds + GL_RS + ((ti * 32 + r32) * 4 + vi) * 4) = part;
        }
        if (c < 3) { gla_state_update(F, S); gla_state_to_lds(F, S); }
        cur = nxt;
        __syncthreads();
        if (FUSE) {
            const f32x4 ps = *(const LAS f32x4*)(L + GL_RS + (ti * 32 + r32) * 16);
            const float rstd = 1.f / sqrtf(((ps.x + ps.y) + (ps.z + ps.w)) * (1.f / 128.f) + EPS);
            bf16* crow_ = CAT + (size_t)(b * SEQ + tok) * DM + 512 + h * 128 + 32 * vi + 4 * hh;
#pragma unroll
            for (int g = 0; g < 4; ++g) { v2u wv; wv.x = pk2(o[4 * g] * rstd * ngv[g].x * bflo(gg[g].x), o[4 * g + 1] * rstd * ngv[g].y * bfhi(gg[g].x));
                wv.y = pk2(o[4 * g + 2] * rstd * ngv[g].z * bflo(gg[g].y), o[4 * g + 3] * rstd * ngv[g].w * bfhi(gg[g].y));
                *(v2u*)(crow_ + 8 * g) = wv; }
        }
    }
}

__global__ void __launch_bounds__(NTHR, 2) fwd_kernel(Args args) {
    extern __shared__ __attribute__((aligned(16))) unsigned char lds[];
    Frame F;
    F.lds = (LAS unsigned char*)lds;
    F.MISC = (volatile LAS unsigned*)(F.lds + MISC_OFF);
    F.tid = threadIdx.x; F.lane = F.tid & 63; F.wave = __builtin_amdgcn_readfirstlane(F.tid >> 6);
    F.G = gridDim.x; F.bid = blockIdx.x; F.gw = F.bid * NWAVES + F.wave; F.NGW = F.G * NWAVES;
    F.ws = args.ws;
    unsigned* ctl = (unsigned*)(args.ws + WS_CTL);
    for (int u = F.tid; u < (LDS_BYTES - LDSCTL_OFF) / 4; u += NTHR) ((LAS unsigned*)(F.lds + LDSCTL_OFF))[u] = 0u;
    __syncthreads();
    const int lo = args.ph_lo, hi = args.ph_hi;
    XcdBarrier bar; bar.bar = ctl + CW_BAR + args.li * XCD_BAR_WORDS; bar.x = 0; bar.st = nullptr;
    if (hi - lo > 1) bar = xcd_barrier_post(ctl + CW_BAR + args.li * XCD_BAR_WORDS, F.MISC + 8);
#define IN(k) (lo <= (k) && (k) < hi)
#ifndef PROBE_DUP
#define PROBE_DUP (-1)
#endif
#define REP(k) for (int rep_ = 0; rep_ < (((PROBE_DUP) == (k)) ? 2 : 1); ++rep_)
#define SEAM(k) do { if (IN(k) && IN((k) + 1)) { xcd_barrier(bar); if (PROBE_DUP == 99) xcd_barrier(bar); } } while (0)
    unsigned char* ws = args.ws;
    bf16* XR = (bf16*)(ws + WS_XR);

    if (IN(0)) REP(0) { phase_prologue(F, args); } SEAM(0);
    if (IN(1)) {
        pg8::Gemm g{(const bf16*)(ws + WS_H), (const bf16*)(ws + WS_WIN), MTOK, NIN, DM}; pg8::StaticOrder S; S.init(MTOK, NIN, F.G, F.bid);
        EpiInProj E{(bf16*)(ws + WS_U), (bf16*)(ws + WS_GV), (bf16*)(ws + WS_Q), (bf16*)(ws + WS_V), (bf16*)(ws + WS_G), (_Float16*)(ws + WS_LFF), (_Float16*)(ws + WS_LFB), (const float*)(ws + WS_LB)};
        pg8::gemm_phase<EpiInProj, pg8::StaticOrder, true, true>(F.lds, g, S, E);
        if (PROBE_DUP == 1) pg8::gemm_phase<EpiInProj, pg8::StaticOrder, true, true>(F.lds, g, S, E);
    } SEAM(1);
    if (IN(2)) { phase_a_mix(F, args); REP(2) for (int u = F.bid; u < 512; u += F.G) gla_unit_state(F, u); } SEAM(2);
    if (IN(3)) { phase_gla_scan(F); } SEAM(3);
    if (IN(4)) { for (int i = F.bid; i < 256; i += F.G) gla_unit_out<false>(F, args, ((i >> 5) << 6) | (i & 31)); } SEAM(4);
    if (IN(5)) { for (int i = F.bid; i < 256; i += F.G) gla_unit_out<true>(F, args, ((i >> 5) << 6) | 32 | (i & 31)); } SEAM(5);
    if (IN(6)) REP(6) {
        pg8::Gemm g{(const bf16*)(ws + WS_CAT), (const bf16*)(ws + WS_WOUT), MTOK, DM, DM}; pg8::StaticOrder S; S.init(MTOK, DM, F.G, F.bid);
        EpiResid<true> E{args.in[0], XR};
        pg8::gemm_phase<EpiResid<true>, pg8::StaticOrder, true, true>(F.lds, g, S, E);
    } SEAM(6);
#define MOE_BLOCK(L, pb) do { \
        if (IN(pb)) REP(pb) { phase_router(F, XR, args.in[2] + (L) * DM, args.in[15] + (L) * DM * NEXP); } SEAM(pb); \
        if (IN((pb) + 1)) { REP((pb) + 1) phase_topk(F); convert_moe_weights(F, args.in[16], args.in[17], args.in[18], (L), (F.G > 64) ? 32 : 0); } SEAM((pb) + 1);     \
        if (IN((pb) + 2)) {     \
            pg8::Gemm g{(const bf16*)(ws + WS_H), (const bf16*)(ws + WS_WGU), NROWS, 16 * 2048, DM}; GroupedOrder<8> S{F.G, F.bid}; \
            EpiGateUp E{(bf16*)(ws + WS_HMID)}; \
            LAS int* rowtab = (LAS int*)(F.lds + RING_BYTES); const int* IDX = (const int*)(ws + WS_IDX); \
            for (int i = 0; i < 4; ++i) { pg8::Unit uu; if (!S.next(i, uu)) break; if (F.tid < 256) rowtab[i * 256 + F.tid] = IDX[uu.pm * 256 + F.tid]; } \
            __syncthreads(); \
            pg8::gemm_phase<EpiGateUp, GroupedOrder<8>, true, true, true>(F.lds, g, S, E, rowtab); \
            if (PROBE_DUP == (pb) + 2) pg8::gemm_phase<EpiGateUp, GroupedOrder<8>, true, true, true>(F.lds, g, S, E, rowtab); \
        } SEAM((pb) + 2); \
        if (IN((pb) + 3)) { \
            pg8::Gemm g{(const bf16*)(ws + WS_HMID), (const bf16*)(ws + WS_WDN), NROWS, 16 * 1024, DFF}; GroupedOrder<4> S{F.G, F.bid}; \
            EpiDown E{(bf16*)(ws + WS_Y), (const float*)(ws + WS_GATE)}; \
            pg8::gemm_phase<EpiDown, GroupedOrder<4>, true, true>(F.lds, g, S, E); \
            if (PROBE_DUP == (pb) + 3) pg8::gemm_phase<EpiDown, GroupedOrder<4>, true, true>(F.lds, g, S, E); \
        } SEAM((pb) + 3); \
    } while (0)

    MOE_BLOCK(0, 7);
    if (IN(11)) { phase_moe_combine(F, XR, args.out, args.in[1] + DM, false); } SEAM(11);
    if (IN(12)) REP(12) {
        pg8::Gemm g{(const bf16*)(ws + WS_H), (const bf16*)(ws + WS_WQKV), MTOK, NQKV, DM}; pg8::StaticOrder S; S.init(MTOK, NQKV, F.G, F.bid);
        EpiQKV E{(bf16*)(ws + WS_QKV)};
        pg8::gemm_phase<EpiQKV, pg8::StaticOrder, true, true>(F.lds, g, S, E);
    } SEAM(12);
    if (IN(13)) REP(13) { phase_kvf(F); } SEAM(13);
    if (IN(14)) REP(14) { phase_attn(F); } SEAM(14);
    if (IN(15)) {
        pg8::Gemm g{(const bf16*)(ws + WS_ATT), (const bf16*)(ws + WS_WO), MTOK, DM, DM}; pg8::StaticOrder S; S.init(MTOK, DM, F.G, F.bid);
        EpiResid<false> E{nullptr, XR};
        pg8::gemm_phase<EpiResid<false>, pg8::StaticOrder, true, true>(F.lds, g, S, E);
    } SEAM(15);
    MOE_BLOCK(1, 16);
    if (IN(20)) { phase_moe_combine(F, XR, args.out, args.in[3], true); }
#undef MOE_BLOCK
#undef IN
#undef SEAM
}

#ifndef MK_N_LAUNCHES
#define MK_N_LAUNCHES 1
#endif
extern "C" void kernel_launch(void* const* d_in, const int* in_sizes, int n_in, void* d_out, int out_size, void* d_ws, size_t ws_size, hipStream_t stream) {
    static int grid = 0;
    if (grid == 0) {
        if (n_in != 19 || in_sizes[0] != MTOK * DM || out_size != MTOK * DM || ws_size < WS_END) { fprintf(stderr, "kernel_launch: unexpected shapes (n_in %d, in0 %d, out %d, ws %zu < %zu); nothing launched\n", n_in, n_in > 0 ? in_sizes[0] : -1, out_size, ws_size, (size_t)WS_END); grid = -1; return; }
        int dev = 0, cus = 0, per_cu = 0;
        if (hipGetDevice(&dev) != hipSuccess || hipDeviceGetAttribute(&cus, hipDeviceAttributeMultiprocessorCount, dev) != hipSuccess) { grid = -1; return; }
        if (hipFuncSetAttribute((const void*)fwd_kernel, hipFuncAttributeMaxDynamicSharedMemorySize, LDS_BYTES) != hipSuccess) { fprintf(stderr, "kernel_launch: hipFuncSetAttribute failed\n"); grid = -1; return; }
        if (hipOccupancyMaxActiveBlocksPerMultiprocessor(&per_cu, (const void*)fwd_kernel, NTHR, LDS_BYTES) != hipSuccess || per_cu < 1) { fprintf(stderr, "kernel_launch: occupancy query reports %d workgroups per CU\n", per_cu); }
        (void)hipGetLastError();
        grid = cus;
    }
    if (grid < 0) return;
    if (hipMemsetAsync((char*)d_ws + WS_CTL, 0, CTL_ZERO_BYTES, stream) != hipSuccess) return;
    Args a{};
    for (int i = 0; i < 19; ++i) a.in[i] = (const float*)d_in[i];
    a.out = (float*)d_out; a.ws = (unsigned char*)d_ws; a.pad = 0;
    static_assert(CW_BAR + MAX_BAR_REGIONS * XCD_BAR_WORDS <= (int)(CTL_ZERO_BYTES / 4), "barrier regions inside the memset region");
#ifdef PROBE_PREFIX
    const int nl = 2;
    for (int li = 0; li < nl; ++li) {
        a.ph_lo = 0; a.ph_hi = (li == 0) ? PROBE_PREFIX : NPHASE; a.li = li;
#else
    const int nl = MK_N_LAUNCHES;
    for (int li = 0; li < nl; ++li) {
        a.ph_lo = (int)((long)NPHASE * li / nl); a.ph_hi = (int)((long)NPHASE * (li + 1) / nl); a.li = li;
#endif
        hipLaunchKernelGGL(fwd_kernel, dim3(grid), dim3(NTHR), LDS_BYTES, stream, a);
        const hipError_t le = hipPeekAtLastError();
        if (le != hipSuccess) { fprintf(stderr, "kernel_launch: launch %d failed: %s\n", li, hipGetErrorName(le)); break; }
    }
}
```

```cpp
#include <hip/hip_runtime.h>
#include <cstdio>
#include <cstdint>
namespace pg8 {
#define PG8_LAS __attribute__((address_space(3)))
typedef unsigned short bf16_t;
typedef short bf16x8 __attribute__((ext_vector_type(8)));
typedef float f32x4 __attribute__((ext_vector_type(4)));
typedef unsigned u32x4 __attribute__((ext_vector_type(4)));
constexpr int BM = 256, BK = 64, HALF = 128, HTB = HALF * BK * 2  , STAGE_BYTES = 8 * HTB, NXCD = 8, WGM = 8;

__host__ __device__ __forceinline__ int lds_byte(int r, int c) { const int st = (r >> 4) * 2 + (c >> 5), rr = r & 15, cc = c & 31, ob = rr * 64 + cc * 2; return st * 1024 + (ob ^ (((ob >> 9) & 1) << 5)); }
__host__ __device__ __forceinline__ void stage_rc(int b, int& R, int& C) { const int st = b / 1024, sb = b % 1024, swz = sb ^ (((sb >> 9) & 1) << 5); R = (st >> 1) * 16 + swz / 64; C = (st & 1) * 32 + (swz % 64) / 2; }
__host__ __device__ __forceinline__ int perm32(int rho) { const int n = rho >> 4, i = rho & 15; return 8 * (i >> 2) + 4 * n + (i & 3); }

struct Unit { int pm, pn; };
struct Gemm { const bf16_t* A; const bf16_t* Bt; int M, N, K; };

struct StaticOrder {
    int nM, nN, nwg, G, c;
    __host__ __device__ void init(int M, int N, int G_, int c_) { nM = M / BM; nN = N / BM; nwg = nM * nN; G = G_; c = c_; }
    __host__ __device__ bool next(int i, Unit& u) const {
        const long L = (long)i * G + c; if (L >= nwg) return false;
        int wgid = (int)L; { const int q = nwg / NXCD, r = nwg % NXCD, xcd = wgid % NXCD, off = wgid / NXCD; wgid = (xcd < r ? xcd * (q + 1) : r * (q + 1) + (xcd - r) * q) + off; }
        const int nig = WGM * nN, gid = wgid / nig, fm = gid * WGM, gsz = (nM - fm) < WGM ? (nM - fm) : WGM;
        u.pm = fm + ((wgid % nig) % gsz); u.pn = (wgid % nig) / gsz; return true;
    }
    __device__ __forceinline__ void a_ready(const Unit&) const {}
    __device__ __forceinline__ void done(const Unit&) const {}
};

__device__ __forceinline__ unsigned cvt_pk_bf16(float lo, float hi) { unsigned r; asm volatile("v_cvt_pk_bf16_f32 %0, %1, %2" : "=v"(r) : "v"(lo), "v"(hi)); return r; }
typedef float f32x2 __attribute__((ext_vector_type(2)));
__device__ __forceinline__ f32x2 gelu_pk(f32x2 v) {
    const f32x2 av = __builtin_elementwise_abs(v), d = av * 0.2316418882f + 1.0f;
    f32x2 t; t.x = __builtin_amdgcn_rcpf(d.x); t.y = __builtin_amdgcn_rcpf(d.y);
    f32x2 q = t * 0.5307027145f + (-0.7265760135f); q = q * t + 0.7107068705f; q = q * t + (-0.142248368f); q = q * t + 0.127414796f; q = q * t;
    const f32x2 s = (v * v) * (-0.72134752044f);
    f32x2 e; e.x = __builtin_amdgcn_exp2f(s.x); e.y = __builtin_amdgcn_exp2f(s.y);
    const f32x2 m = v * (q * e), r = v - m;
    f32x2 o; o.x = v.x < 0.f ? m.x : r.x; o.y = v.y < 0.f ? m.y : r.y; return o;
}

template <int ACT  > struct EpiBf16 {
    static constexpr bool PERM = true, AFTER_DRAIN = false; static_assert(ACT == 0 || ACT == 1, "EpiBf16: ACT is 0 (none) or 1 (gelu_pk)");
    bf16_t* O; int ldc; const float* bias; int split_cols; size_t split_stride; float scale0;
    __device__ __forceinline__ void operator()(const f32x4 (&acc)[2][2][4][2], const Unit& u, int wr, int wc, int fr, int fq) const {
        const int row0 = u.pm * BM + wr * 64 + fr; int colt = u.pn * BM; bf16_t* base = O;
        float sc = 1.f; if (split_cols) { const int t = colt / split_cols; base += (size_t)t * split_stride; colt -= t * split_cols; if (t == 0) sc = scale0; }
        const int col0 = colt + wc * 32 + 8 * fq, bcol0 = u.pn * BM + wc * 32 + 8 * fq;
        f32x4 bv[2][2];
#pragma unroll
        for (int bj = 0; bj < 2; ++bj)
#pragma unroll
            for (int n = 0; n < 2; ++n) bv[bj][n] = bias ? *(const f32x4*)(bias + bcol0 + bj * HALF + 4 * n) : (f32x4){0.f, 0.f, 0.f, 0.f};
#pragma unroll
        for (int ai = 0; ai < 2; ++ai)
#pragma unroll
            for (int m = 0; m < 4; ++m) { bf16_t* rowp = base + (size_t)(row0 + ai * HALF + m * 16) * ldc + col0;
#pragma unroll
                for (int bj = 0; bj < 2; ++bj) { f32x4 v0 = acc[ai][bj][m][0] + bv[bj][0], v1 = acc[ai][bj][m][1] + bv[bj][1];
                    if (ACT == 1) { f32x2 a = gelu_pk((f32x2){v0[0], v0[1]}), b = gelu_pk((f32x2){v0[2], v0[3]}), c = gelu_pk((f32x2){v1[0], v1[1]}), d = gelu_pk((f32x2){v1[2], v1[3]});
                        v0 = (f32x4){a.x, a.y, b.x, b.y}; v1 = (f32x4){c.x, c.y, d.x, d.y}; }
                    v0 = v0 * sc; v1 = v1 * sc; u32x4 w; w.x = cvt_pk_bf16(v0[0], v0[1]); w.y = cvt_pk_bf16(v0[2], v0[3]); w.z = cvt_pk_bf16(v1[0], v1[1]); w.w = cvt_pk_bf16(v1[2], v1[3]);
                    *(u32x4*)(rowp + bj * HALF) = w; } }
    }
};
template <class Epi, class Sched, bool ALIGN_EPI = false, bool SP2 = false, bool GATHER = false>
__device__ __forceinline__ void gemm_phase(PG8_LAS unsigned char* lds, const Gemm g, const Sched& S, const Epi& E, const PG8_LAS int* rowtab = nullptr) {
    const int tid = threadIdx.x, wid = __builtin_amdgcn_readfirstlane(tid >> 6), lane = tid & 63, wr = wid >> 2, wc = wid & 3, fr = lane & 15, fq = lane >> 4;
    const int K = g.K, nt = K / BK;
    unsigned voffA[2], voffB[2]; int gR[2], gC[2];
#pragma unroll
    for (int i = 0; i < 2; ++i) { int R, C; stage_rc(tid * 16 + i * 8192, R, C); const int Rb = Epi::PERM ? ((R & ~31) + perm32(R & 31)) : R;
        voffA[i] = (unsigned)(R * K + C) * 2u; voffB[i] = (unsigned)(Rb * K + C) * 2u; gR[i] = R; gC[i] = C; }
    unsigned vC[2][2] = {{0u, 0u}, {0u, 0u}}, vN[2][2] = {{0u, 0u}, {0u, 0u}};
#define PG8_ROWS(dst, ui_) do { _Pragma("unroll") for (int _h = 0; _h < 2; ++_h) _Pragma("unroll") for (int _i = 0; _i < 2; ++_i) \
        dst[_h][_i] = (unsigned)(rowtab[(ui_) * 256 + _h * 128 + gR[_i]] * K + gC[_i]) * 2u; } while (0)
    const size_t kstep = (size_t)(BK * 2);
    const size_t hstep = (size_t)HALF * K * 2;
    const size_t tstep = 2 * hstep;
    const unsigned ldsw = (unsigned)wid * 1024u;
    const int aoff = lds_byte(wr * 64 + fr, fq * 8), boff = lds_byte(wc * 32 + fr, fq * 8);
#define PG8_SA(b, h) (((b) * 2 + (h)) * HTB)
#define PG8_SB(b, h) ((4 + (b) * 2 + (h)) * HTB)
#define PG8_STAGE(bufoff, gbase, voff) do { _Pragma("unroll") for (int _i = 0; _i < 2; ++_i) \
        __builtin_amdgcn_global_load_lds((const unsigned*)((const char*)(gbase) + (voff)[_i]), (PG8_LAS unsigned*)(lds + (bufoff) + ldsw + _i * 8192), 16, 0, 0); } while (0)
#define PG8_STGA(bufoff, abase, half, V) do { _Pragma("unroll") for (int _i = 0; _i < 2; ++_i) \
        __builtin_amdgcn_global_load_lds((const unsigned*)((const char*)(abase) + (GATHER ? (size_t)V[half][_i] : (size_t)((half) ? hstep : 0) + voffA[_i])), (PG8_LAS unsigned*)(lds + (bufoff) + ldsw + _i * 8192), 16, 0, 0); } while (0)
#define PG8_LDA(dst, b, h) do { _Pragma("unroll") for (int m = 0; m < 4; ++m) _Pragma("unroll") for (int k = 0; k < 2; ++k) dst[m][k] = *(const PG8_LAS bf16x8*)(lds + PG8_SA(b, h) + aoff + m * 2048 + k * 1024); } while (0)
#define PG8_LDB(dst, b, h) do { _Pragma("unroll") for (int n = 0; n < 2; ++n) _Pragma("unroll") for (int k = 0; k < 2; ++k) dst[n][k] = *(const PG8_LAS bf16x8*)(lds + PG8_SB(b, h) + boff + n * 2048 + k * 1024); } while (0)
#define PG8_MMA(ai, bj, At, Bt) do { __builtin_amdgcn_s_setprio(1); _Pragma("unroll") for (int m = 0; m < 4; ++m) _Pragma("unroll") for (int n = 0; n < 2; ++n) _Pragma("unroll") for (int k = 0; k < 2; ++k) \
        acc[ai][bj][m][n] = __builtin_amdgcn_mfma_f32_16x16x32_bf16(Bt[n][k], At[m][k], acc[ai][bj][m][n], 0, 0, 0); __builtin_amdgcn_s_setprio(0); } while (0)
#define PG8_WAIT_V(n) asm volatile("s_waitcnt vmcnt(" #n ")" ::: "memory")
#define PG8_WAIT_L(n) asm volatile("s_waitcnt lgkmcnt(" #n ")" ::: "memory")
#define PG8_BAR __builtin_amdgcn_s_barrier()
#define PG8_SCHED __builtin_amdgcn_sched_barrier(0)
    Unit cur, nxt; int ui = 0;
    if (!S.next(0, cur)) return;
    f32x4 acc[2][2][4][2];
#pragma unroll
    for (int a = 0; a < 2; ++a)
#pragma unroll
        for (int b = 0; b < 2; ++b)
#pragma unroll
            for (int m = 0; m < 4; ++m)
#pragma unroll
                for (int n = 0; n < 2; ++n) acc[a][b][m][n] = (f32x4){0.f, 0.f, 0.f, 0.f};
    bf16x8 At[4][2], B0[2][2], B1[2][2];
    const char* cA = (const char*)g.A + (GATHER ? (size_t)0 : (size_t)cur.pm * tstep); if constexpr (GATHER) PG8_ROWS(vC, 0);
    const char* cB = (const char*)g.Bt + (size_t)cur.pn * tstep;
    S.a_ready(cur);
    if constexpr (SP2) {
        PG8_STAGE(PG8_SB(0, 0), cB, voffB); PG8_STAGE(PG8_SB(0, 1), cB + hstep, voffB); PG8_STGA(PG8_SA(0, 0), cA, 0, vC); PG8_STGA(PG8_SA(0, 1), cA, 1, vC);
        if (wr == 1) PG8_BAR;
        PG8_WAIT_V(2); PG8_BAR;
        PG8_STAGE(PG8_SB(1, 0), cB + kstep, voffB); PG8_STGA(PG8_SA(1, 0), cA + kstep, 0, vC); PG8_STAGE(PG8_SB(1, 1), cB + hstep + kstep, voffB);
        PG8_WAIT_V(6); PG8_BAR;
    } else {
        PG8_STAGE(PG8_SB(0, 0), cB, voffB); PG8_STGA(PG8_SA(0, 0), cA, 0, vC); PG8_STAGE(PG8_SB(0, 1), cB + hstep, voffB); PG8_STGA(PG8_SA(0, 1), cA, 1, vC);
        if (wr == 1) PG8_BAR;
        PG8_WAIT_V(4); PG8_BAR;
        PG8_STAGE(PG8_SB(1, 0), cB + kstep, voffB); PG8_STGA(PG8_SA(1, 0), cA + kstep, 0, vC); PG8_STAGE(PG8_SB(1, 1), cB + hstep + kstep, voffB);
        PG8_WAIT_V(6); PG8_BAR;
    }
    for (;;) {
        const bool has_next = S.next(ui + 1, nxt);
        const char* nA = (has_next && !GATHER) ? (const char*)g.A + (size_t)nxt.pm * tstep : cA;
        if constexpr (GATHER) { if (has_next) PG8_ROWS(vN, ui + 1); else { _Pragma("unroll") for (int _h = 0; _h < 2; ++_h) _Pragma("unroll") for (int _i = 0; _i < 2; ++_i) vN[_h][_i] = vC[_h][_i]; } }
        const char* nB = has_next ? (const char*)g.Bt + (size_t)nxt.pn * tstep : cB;
        for (int t = 0; t < nt; t += 2) {
            const bool last = (t == nt - 2);
            unsigned vX[2][2];
            _Pragma("unroll") for (int _h = 0; _h < 2; ++_h) _Pragma("unroll") for (int _i = 0; _i < 2; ++_i) vX[_h][_i] = last ? vN[_h][_i] : vC[_h][_i];
            const char* a1 = cA + (size_t)(t + 1) * kstep;
            const char* a2 = last ? nA : cA + (size_t)(t + 2) * kstep; const char* b2 = last ? nB : cB + (size_t)(t + 2) * kstep;
            const char* a3 = a2 + kstep; const char* b3 = b2 + kstep;
            if (last && has_next) S.a_ready(nxt);
            if constexpr (SP2) {
            PG8_LDB(B0, 0, 0); PG8_LDB(B1, 0, 1); PG8_SCHED; PG8_LDA(At, 0, 0); PG8_STGA(PG8_SA(1, 1), a1, 1, vC);
            PG8_WAIT_V(8); PG8_WAIT_L(0); PG8_BAR; PG8_MMA(0, 0, At, B0); PG8_MMA(0, 1, At, B1); PG8_BAR; PG8_SCHED;
            PG8_LDA(At, 0, 1); PG8_STAGE(PG8_SB(0, 0), b2, voffB); PG8_STAGE(PG8_SB(0, 1), b2 + hstep, voffB); PG8_STGA(PG8_SA(0, 0), a2, 0, vX);
            PG8_WAIT_V(8); PG8_WAIT_L(0); PG8_BAR; PG8_MMA(1, 0, At, B0); PG8_MMA(1, 1, At, B1); PG8_BAR; PG8_SCHED;
            PG8_LDB(B0, 1, 0); PG8_LDB(B1, 1, 1); PG8_SCHED; PG8_LDA(At, 1, 0); PG8_STGA(PG8_SA(0, 1), a2, 1, vX);
            PG8_WAIT_V(8); PG8_WAIT_L(0); PG8_BAR; PG8_MMA(0, 0, At, B0); PG8_MMA(0, 1, At, B1); PG8_BAR; PG8_SCHED;
            PG8_LDA(At, 1, 1); PG8_STAGE(PG8_SB(1, 0), b3, voffB); PG8_STAGE(PG8_SB(1, 1), b3 + hstep, voffB); PG8_STGA(PG8_SA(1, 0), a3, 0, vX);
            PG8_WAIT_V(8); PG8_WAIT_L(0); PG8_BAR; PG8_MMA(1, 0, At, B0); PG8_MMA(1, 1, At, B1); PG8_BAR; PG8_SCHED;
            } else {
            PG8_LDB(B0, 0, 0); PG8_SCHED; PG8_LDA(At, 0, 0); PG8_STGA(PG8_SA(1, 1), a1, 1, vC);
            PG8_WAIT_L(8); PG8_BAR; PG8_WAIT_L(0); PG8_MMA(0, 0, At, B0); PG8_BAR; PG8_SCHED;
            PG8_LDB(B1, 0, 1); PG8_STAGE(PG8_SB(0, 0), b2, voffB);
            PG8_BAR; PG8_WAIT_L(0); PG8_MMA(0, 1, At, B1); PG8_BAR;
            PG8_LDA(At, 0, 1); PG8_STGA(PG8_SA(0, 0), a2, 0, vX);
            PG8_BAR; PG8_WAIT_L(0); PG8_MMA(1, 0, At, B0); PG8_BAR; PG8_SCHED;
            PG8_STAGE(PG8_SB(0, 1), b2 + hstep, voffB);
            PG8_WAIT_V(6); PG8_BAR; PG8_MMA(1, 1, At, B1); PG8_BAR;
            PG8_LDB(B0, 1, 0); PG8_SCHED; PG8_LDA(At, 1, 0); PG8_STGA(PG8_SA(0, 1), a2, 1, vX);
            PG8_WAIT_L(8); PG8_BAR; PG8_WAIT_L(0); PG8_MMA(0, 0, At, B0); PG8_BAR; PG8_SCHED;
            PG8_LDB(B1, 1, 1); PG8_STAGE(PG8_SB(1, 0), b3, voffB);
            PG8_BAR; PG8_WAIT_L(0); PG8_MMA(0, 1, At, B1); PG8_BAR;
            PG8_LDA(At, 1, 1); PG8_STGA(PG8_SA(1, 0), a3, 0, vX);
            PG8_BAR; PG8_WAIT_L(0); PG8_MMA(1, 0, At, B0); PG8_BAR; PG8_SCHED;
            PG8_STAGE(PG8_SB(1, 1), b3 + hstep, voffB);
            PG8_WAIT_V(6); PG8_BAR; PG8_MMA(1, 1, At, B1); PG8_BAR;
            }
        }
        if constexpr (ALIGN_EPI) { if (wr == 0) PG8_BAR; }
        if constexpr (!Epi::AFTER_DRAIN) { E(acc, cur, wr, wc, fr, fq); S.done(cur); }
        if (!has_next) break;
#pragma unroll
        for (int a = 0; a < 2; ++a)
#pragma unroll
            for (int b = 0; b < 2; ++b)
#pragma unroll
                for (int m = 0; m < 4; ++m)
#pragma unroll
                    for (int n = 0; n < 2; ++n) acc[a][b][m][n] = (f32x4){0.f, 0.f, 0.f, 0.f};
        cur = nxt; cA = nA; cB = nB; ++ui;
        if constexpr (GATHER) { _Pragma("unroll") for (int _h = 0; _h < 2; ++_h) _Pragma("unroll") for (int _i = 0; _i < 2; ++_i) vC[_h][_i] = vN[_h][_i]; }
        if constexpr (ALIGN_EPI) { if (wr == 1) PG8_BAR; }
    }
    PG8_WAIT_V(0);
    if constexpr (!ALIGN_EPI) { if (wr == 0) PG8_BAR; }
    PG8_BAR;
    if constexpr (Epi::AFTER_DRAIN) { E.fused(acc, cur, wr, wc, fr, fq, lds, wid, lane); S.done(cur); }
#undef PG8_SA
#undef PG8_SB
#undef PG8_STAGE
#undef PG8_STGA
#undef PG8_ROWS
#undef PG8_LDA
#undef PG8_LDB
#undef PG8_MMA
#undef PG8_WAIT_V
#undef PG8_WAIT_L
#undef PG8_BAR
#undef PG8_SCHED
}
}
#define LAS __attribute__((address_space(3)))
#define DI __device__ __forceinline__
typedef unsigned short bf16;
typedef unsigned v4u __attribute__((ext_vector_type(4)));
typedef unsigned v2u __attribute__((ext_vector_type(2)));
typedef float f32x4 __attribute__((ext_vector_type(4)));
typedef short bf16x8 __attribute__((ext_vector_type(8)));
#define LDS_WAIT() asm volatile("s_waitcnt lgkmcnt(0)" ::: "memory")
#define VM_WAIT() asm volatile("s_waitcnt vmcnt(0)" ::: "memory")
DI unsigned f2bf(float f) { unsigned u = __builtin_bit_cast(unsigned, f); return (u + 0x7fffu + ((u >> 16) & 1u)) >> 16; }
typedef float f32x2_t __attribute__((ext_vector_type(2))); typedef __bf16 bf16x2_t __attribute__((ext_vector_type(2)));
DI unsigned pk2(float lo, float hi) { f32x2_t v = {lo, hi}; bf16x2_t b = __builtin_convertvector(v, bf16x2_t); return __builtin_bit_cast(unsigned, b); }
DI float bf2f(unsigned b) { return __builtin_bit_cast(float, b << 16); }
DI float bflo(unsigned w) { return __builtin_bit_cast(float, w << 16); }
DI float bfhi(unsigned w) { return __builtin_bit_cast(float, w & 0xffff0000u); }
DI float fexp(float x) { return __builtin_amdgcn_exp2f(x * 1.4426950408889634f); }
DI float flog(float x) { return __builtin_amdgcn_logf(x) * 0.6931471805599453f; }
DI float frcp(float x) { return __builtin_amdgcn_rcpf(x); }
DI float sigmoidf_(float x) { return frcp(1.f + fexp(-x)); }
DI float siluf_(float x) { return x * sigmoidf_(x); }
DI float gelu_tanh(float x) { const float u = 0.7978845608028654f * (x + 0.044715f * x * x * x); return x * sigmoidf_(2.f * u); }
DI float wave_sum(float v) {
#pragma unroll
    for (int o = 1; o < 64; o <<= 1) v += __shfl_xor(v, o);
    return v;
}
DI float wave_max(float v) {
#pragma unroll
    for (int o = 1; o < 64; o <<= 1) v = fmaxf(v, __shfl_xor(v, o));
    return v;
}
DI int red16_idx(int lane) { return 8 * ((lane >> 5) & 1) + 4 * ((lane >> 4) & 1) + 2 * ((lane >> 3) & 1) + ((lane >> 2) & 1); }
DI float red16(const float (&o)[16], int lane) {
    const bool b32 = lane & 32, b16 = lane & 16, b8 = lane & 8, b4 = lane & 4;
    float a8[8], a4[4], a2[2], a1;
#pragma unroll
    for (int j = 0; j < 8; ++j) { const float send = b32 ? o[j] : o[j + 8], keep = b32 ? o[j + 8] : o[j]; a8[j] = keep + __shfl_xor(send, 32); }
#pragma unroll
    for (int j = 0; j < 4; ++j) { const float send = b16 ? a8[j] : a8[j + 4], keep = b16 ? a8[j + 4] : a8[j]; a4[j] = keep + __shfl_xor(send, 16); }
#pragma unroll
    for (int j = 0; j < 2; ++j) { const float send = b8 ? a4[j] : a4[j + 2], keep = b8 ? a4[j + 2] : a4[j]; a2[j] = keep + __shfl_xor(send, 8); }
    { const float send = b4 ? a2[0] : a2[1], keep = b4 ? a2[1] : a2[0]; a1 = keep + __shfl_xor(send, 4); }
    a1 += __shfl_xor(a1, 2); a1 += __shfl_xor(a1, 1);
    return a1;
}
#define XB_TMO      128
#define XB_XCNT(j)  (256  + 64 * (j))
#define XB_XSUB(j)  (1280 + 64 * (j))
#define XB_XGEN(j)  (2304 + 64 * (j))
#define XB_TOP      3328
#define XB_TOPGEN   3392
#define XCD_BAR_WORDS 3456
#define XB_SPIN_CAP (1u << 18)

__device__ __forceinline__ unsigned xb_ld(unsigned* p)              { return __hip_atomic_load(p, __ATOMIC_RELAXED, __HIP_MEMORY_SCOPE_AGENT); }
__device__ __forceinline__ unsigned xb_add(unsigned* p, unsigned v) { return __hip_atomic_fetch_add(p, v, __ATOMIC_RELAXED, __HIP_MEMORY_SCOPE_AGENT); }
__device__ __forceinline__ unsigned xb_xcc_id() { return (unsigned)__builtin_amdgcn_s_getreg((3 << 11) | 20) & 0xFu; }
#define XB_SPIN(cond, bar) do { unsigned _sp = 0; while (cond) { __builtin_amdgcn_s_sleep(1); \
    if ((++_sp & 255u) == 0u) { if (xb_ld(&(bar)[XB_TMO])) break; if (_sp > XB_SPIN_CAP) { atomicAdd(&(bar)[XB_TMO], 1u); break; } } } } while (0)

struct XcdBarrier {
    unsigned* bar; unsigned x;
    volatile LAS unsigned* st;
};

__device__ __forceinline__ XcdBarrier xcd_barrier_post(unsigned* bar, volatile LAS unsigned* st) {
    XcdBarrier b; b.bar = bar; b.x = xb_xcc_id(); b.st = st;
    if (threadIdx.x == 0) (void)xb_add(&bar[XB_XCNT(b.x)], 1u);
    return b;
}
__device__ __forceinline__ void xcd_barrier_complete(unsigned* bar, unsigned x, unsigned& nloc, unsigned& nx) {
    const unsigned G = gridDim.x * gridDim.y * gridDim.z;
    unsigned sum, cnt, mine, sp = 0u;
    for (;;) {
        sum = 0u; cnt = 0u; mine = 0u;
#pragma unroll
        for (unsigned j = 0; j < 16; ++j) { const unsigned c = xb_ld(&bar[XB_XCNT(j)]); sum += c; cnt += (c > 0u) ? 1u : 0u; mine = (j == x) ? c : mine; }
        if (sum == G) break;
        __builtin_amdgcn_s_sleep(1);
        if ((++sp & 255u) == 0u) { if (xb_ld(&bar[XB_TMO])) break; if (sp > XB_SPIN_CAP) { atomicAdd(&bar[XB_TMO], 1u); break; } }
    }
    nloc = mine > 0u ? mine : 1u; nx = cnt > 0u ? cnt : 1u;
}

__device__ __forceinline__ void xcd_barrier(const XcdBarrier& b) {
    asm volatile("s_waitcnt vmcnt(0)" ::: "memory");
    __syncthreads();
    if (threadIdx.x == 0) {
        unsigned* bar = b.bar;
        __builtin_amdgcn_s_waitcnt(0);
        unsigned nloc = b.st[0], nx = b.st[1];
        if (nloc == 0u) { xcd_barrier_complete(bar, b.x, nloc, nx); b.st[0] = nloc; b.st[1] = nx; }
        const unsigned old = xb_add(&bar[XB_XSUB(b.x)], 1u);
        const unsigned gen = old / nloc;
        if (old + 1u == (gen + 1u) * nloc) {
            __builtin_amdgcn_fence(__ATOMIC_RELEASE, "agent");
            asm volatile("s_waitcnt vmcnt(0)" ::: "memory");
            const unsigned og = xb_add(&bar[XB_TOP], 1u);
            const unsigned tg = og / nx;
            if (og + 1u == (tg + 1u) * nx) xb_add(&bar[XB_TOPGEN], 1u);
            else XB_SPIN(xb_ld(&bar[XB_TOPGEN]) == tg, bar);
            __builtin_amdgcn_fence(__ATOMIC_ACQUIRE, "agent");
            xb_add(&bar[XB_XGEN(b.x)], 1u);
            asm volatile("s_waitcnt vmcnt(0)" ::: "memory");
        } else {
            XB_SPIN(xb_ld(&bar[XB_XGEN(b.x)]) == gen, bar);
            __builtin_amdgcn_fence(__ATOMIC_ACQUIRE, "agent");
            asm volatile("s_waitcnt vmcnt(0)" ::: "memory");
        }
    }
    __syncthreads();
}
#ifndef PROBE_DUP
#define PROBE_DUP (-1)
#endif
constexpr int NWAVES = 8, NTHR = 512;
constexpr int BATCH = 2, SEQ = 8192, DM = 1024, MTOK = BATCH * SEQ;
constexpr int NIN = 3584;
constexpr int AW = 512;
constexpr int NEXP = 16, DFF = 1024, CAP = 1024, NROWS = BATCH * NEXP * CAP;
constexpr int NSC = 32, SCLEN = 256;
constexpr int NHEAD = 16, HD = 64, NQKV = 3072;
constexpr float EPS = 1e-6f;
constexpr int NPHASE = 21;

constexpr size_t MiB = 1u << 20;
constexpr size_t WS_CTL = 0, CTL_ZERO_BYTES = 1 * MiB;
constexpr size_t WS_AFF = 1 * MiB;
constexpr size_t WS_POS = 2 * MiB;
constexpr size_t WS_IDX = 3 * MiB;
constexpr size_t WS_GATE = 3 * MiB + 256 * 1024;
constexpr size_t WS_DEC = 3 * MiB + 512 * 1024;
constexpr size_t WS_LB = 4 * MiB;
constexpr size_t WS_BT = 4 * MiB + 64 * 1024;
constexpr size_t WS_WIN = 8 * MiB;
constexpr size_t WS_WOUT = 15 * MiB;
constexpr size_t WS_WQKV = 17 * MiB;
constexpr size_t WS_WO = 23 * MiB;
constexpr size_t WS_WSB = 25 * MiB;
constexpr size_t WS_WGU = 32 * MiB;
constexpr size_t WS_WDN = 96 * MiB;
constexpr size_t WS_H = 128 * MiB;
constexpr size_t WS_R1 = 160 * MiB;
constexpr size_t WS_U = WS_R1, WS_GV = WS_R1 + 16 * MiB, WS_Q = WS_R1 + 32 * MiB, WS_V = WS_R1 + 48 * MiB, WS_G = WS_R1 + 64 * MiB;
constexpr size_t WS_LFF = WS_R1 + 80 * MiB, WS_LFB = WS_R1 + 112 * MiB;
constexpr size_t WS_CAT = WS_R1 + 144 * MiB;
constexpr size_t WS_ST = WS_R1 + 176 * MiB;
constexpr size_t WS_ODIR = WS_R1 + 208 * MiB;
constexpr size_t WS_XE = WS_R1, WS_Y = WS_R1;
constexpr size_t WS_HMID = WS_R1 + 64 * MiB;
constexpr size_t WS_QKV = WS_R1;
constexpr size_t WS_ATT = WS_R1 + 96 * MiB;
constexpr size_t WS_KF = WS_R1 + 128 * MiB;
constexpr size_t WS_VF = WS_R1 + 224 * MiB;
constexpr size_t WS_XR = WS_R1 + 320 * MiB;
constexpr size_t WS_END = WS_R1 + 352 * MiB;
constexpr int CW_BAR = 4096;
constexpr int MAX_BAR_REGIONS = 24;

constexpr int RING_BYTES = 131072;
constexpr int LDS_BYTES = 147456;
constexpr int LDSCTL_OFF = LDS_BYTES - 512, MISC_OFF = LDSCTL_OFF + 320;

struct Args { const float* in[19]; float* out; unsigned char* ws; int ph_lo, ph_hi, li, pad; };

struct Frame {
    LAS unsigned char* lds;
    volatile LAS unsigned* MISC;
    int tid, lane, wave, G, bid, gw, NGW;
    unsigned char* ws;
};

template <int NPN_> struct GroupedOrder {
    int G, c;
    DI bool next(int i, pg8::Unit& u) const {
        if (G == 256) {
            const int x = c & 7, k = c >> 3;
            if (i >= NPN_ / 2) return false;
            const int e = (NPN_ == 8) ? 4 * i + (x >> 1) : 8 * i + x;
            u.pm = e * 8 + (k & 7); u.pn = e * NPN_ + ((NPN_ == 8) ? 4 * (x & 1) + (k >> 3) : (k >> 3)); return true;
        }
        const int L = i * G + c; if (L >= 16 * 8 * NPN_) return false;
        const int e = L / (8 * NPN_), w = L % (8 * NPN_);
        u.pm = e * 8 + (w & 7); u.pn = e * NPN_ + (w >> 3); return true;
    }
    DI void a_ready(const pg8::Unit&) const {}
    DI void done(const pg8::Unit&) const {}
};

typedef _Float16 h16x8 __attribute__((ext_vector_type(8)));
struct EpiInProj {
    static constexpr bool PERM = true, AFTER_DRAIN = false;
    bf16 *U, *GV, *Q, *V, *G; _Float16 *LFf, *LFb; const float* LB;
    DI void operator()(const pg8::f32x4 (&acc)[2][2][4][2], const pg8::Unit& u, int wr, int wc, int fr, int fq) const {
        const int seg = u.pn >> 1;
        const int row0 = u.pm * 256 + wr * 64 + fr, lc0 = (u.pn & 1) * 256 + wc * 32 + 8 * fq;
#pragma unroll
        for (int bj = 0; bj < 2; ++bj) {
            const int lc = lc0 + bj * 128;
            float lb[8];
            if (seg == 3 || seg == 4) {
#pragma unroll
                for (int j = 0; j < 8; ++j) lb[j] = LB[(seg - 3) * 512 + lc + j];
            }
#pragma unroll
            for (int ai = 0; ai < 2; ++ai)
#pragma unroll
                for (int m = 0; m < 4; ++m) {
                    const size_t off = (size_t)(row0 + ai * 128 + m * 16) * 512 + lc;
                    float v[8];
#pragma unroll
                    for (int j = 0; j < 8; ++j) v[j] = acc[ai][bj][m][j >> 2][j & 3];
                    if (seg == 3 || seg == 4) {
#pragma unroll
                        for (int j = 0; j < 8; ++j) v[j] = flog(lb[j] + (1.f - lb[j]) * sigmoidf_(v[j]));
                        _Float16* o = (seg == 3 ? LFf : LFb) + off;
                        h16x8 hv;
#pragma unroll
                        for (int j = 0; j < 8; ++j) hv[j] = (_Float16)v[j];
                        *(h16x8*)o = hv;
                    } else {
                        bf16* o;
                        if (seg == 0) { o = U;
#pragma unroll
                            for (int j = 0; j < 8; ++j) v[j] = gelu_tanh(v[j]);
                        } else if (seg == 1) { o = GV;
#pragma unroll
                            for (int j = 0; j < 8; ++j) v[j] = gelu_tanh(v[j]);
                        } else if (seg == 2) { o = Q;
#pragma unroll
                            for (int j = 0; j < 8; ++j) v[j] = siluf_(v[j]);
                        } else if (seg == 5) { o = V;
                        } else { o = G;
#pragma unroll
                            for (int j = 0; j < 8; ++j) v[j] = sigmoidf_(v[j]);
                        }
                        v4u w; w.x = pk2(v[0], v[1]); w.y = pk2(v[2], v[3]); w.z = pk2(v[4], v[5]); w.w = pk2(v[6], v[7]);
                        *(v4u*)(o + off) = w;
                    }
                }
        }
    }
};
template <bool BASE_F32> struct EpiResid {
    static constexpr bool PERM = true, AFTER_DRAIN = false;
    const float* basef; bf16* XR;
    DI void operator()(const pg8::f32x4 (&acc)[2][2][4][2], const pg8::Unit& u, int wr, int wc, int fr, int fq) const {
        const int row0 = u.pm * 256 + wr * 64 + fr, col0 = u.pn * 256 + wc * 32 + 8 * fq;
#pragma unroll
        for (int ai = 0; ai < 2; ++ai)
#pragma unroll
            for (int m = 0; m < 4; ++m) { const size_t ro = (size_t)(row0 + ai * 128 + m * 16) * DM + col0;
#pragma unroll
                for (int bj = 0; bj < 2; ++bj) { const size_t o = ro + bj * 128;
                    float v[8];
                    if (BASE_F32) { const f32x4 b0 = *(const f32x4*)(basef + o), b1 = *(const f32x4*)(basef + o + 4);
                        v[0] = b0.x; v[1] = b0.y; v[2] = b0.z; v[3] = b0.w; v[4] = b1.x; v[5] = b1.y; v[6] = b1.z; v[7] = b1.w; }
                    else { const v4u w = *(const v4u*)(XR + o); v[0] = bflo(w.x); v[1] = bfhi(w.x); v[2] = bflo(w.y); v[3] = bfhi(w.y); v[4] = bflo(w.z); v[5] = bfhi(w.z); v[6] = bflo(w.w); v[7] = bfhi(w.w); }
#pragma unroll
                    for (int j = 0; j < 8; ++j) v[j] += acc[ai][bj][m][j >> 2][j & 3];
                    v4u w; w.x = pk2(v[0], v[1]); w.y = pk2(v[2], v[3]); w.z = pk2(v[4], v[5]); w.w = pk2(v[6], v[7]);
                    *(v4u*)(XR + o) = w; } }
    }
};
struct EpiGateUp {
    static constexpr bool PERM = true, AFTER_DRAIN = false;
    bf16* H;
    DI void operator()(const pg8::f32x4 (&acc)[2][2][4][2], const pg8::Unit& u, int wr, int wc, int fr, int fq) const {
        const int pnl = u.pn & 7;
        const int row0 = u.pm * 256 + wr * 64 + fr, col0 = pnl * 128 + wc * 32 + 8 * fq;
#pragma unroll
        for (int ai = 0; ai < 2; ++ai)
#pragma unroll
            for (int m = 0; m < 4; ++m) {
                float v[8];
#pragma unroll
                for (int j = 0; j < 8; ++j) v[j] = siluf_(acc[ai][0][m][j >> 2][j & 3]) * acc[ai][1][m][j >> 2][j & 3];
                v4u w; w.x = pk2(v[0], v[1]); w.y = pk2(v[2], v[3]); w.z = pk2(v[4], v[5]); w.w = pk2(v[6], v[7]);
                *(v4u*)(H + (size_t)(row0 + ai * 128 + m * 16) * DFF + col0) = w;
            }
    }
};
struct EpiDown {
    static constexpr bool PERM = true, AFTER_DRAIN = false;
    bf16* Y; const float* gate;
    DI void operator()(const pg8::f32x4 (&acc)[2][2][4][2], const pg8::Unit& u, int wr, int wc, int fr, int fq) const {
        const int pnl = u.pn & 3;
        const int row0 = u.pm * 256 + wr * 64 + fr, col0 = pnl * 256 + wc * 32 + 8 * fq;
#pragma unroll
        for (int ai = 0; ai < 2; ++ai)
#pragma unroll
            for (int m = 0; m < 4; ++m) { const int row = row0 + ai * 128 + m * 16; const float g = gate[row];
#pragma unroll
                for (int bj = 0; bj < 2; ++bj) {
                    float v[8];
#pragma unroll
                    for (int j = 0; j < 8; ++j) v[j] = acc[ai][bj][m][j >> 2][j & 3] * g;
                    v4u w; w.x = pk2(v[0], v[1]); w.y = pk2(v[2], v[3]); w.z = pk2(v[4], v[5]); w.w = pk2(v[6], v[7]);
                    *(v4u*)(Y + (size_t)row * DM + col0 + bj * 128) = w; } }
    }
};
struct EpiQKV {
    static constexpr bool PERM = true, AFTER_DRAIN = false;
    bf16* O;
    DI void operator()(const pg8::f32x4 (&acc)[2][2][4][2], const pg8::Unit& u, int wr, int wc, int fr, int fq) const {
        const float sc = (u.pn < 4) ? 0.125f : 1.f;
        const int row0 = u.pm * 256 + wr * 64 + fr, col0 = u.pn * 256 + wc * 32 + 8 * fq;
#pragma unroll
        for (int ai = 0; ai < 2; ++ai)
#pragma unroll
            for (int m = 0; m < 4; ++m)
#pragma unroll
                for (int bj = 0; bj < 2; ++bj) {
                    float v[8];
#pragma unroll
                    for (int j = 0; j < 8; ++j) v[j] = acc[ai][bj][m][j >> 2][j & 3] * sc;
                    v4u w; w.x = pk2(v[0], v[1]); w.y = pk2(v[2], v[3]); w.z = pk2(v[4], v[5]); w.w = pk2(v[6], v[7]);
                    *(v4u*)(O + (size_t)(row0 + ai * 128 + m * 16) * NQKV + col0 + bj * 128) = w; }
    }
};

DI void transpose_item(const float* W, int K, int N, bf16* WT, LAS float* scr, int k0, int n0, int drow0, int lane) {
#pragma unroll 8
    for (int i = 0; i < 32; ++i) { const int kk = 2 * i + (lane >> 5); scr[kk * 33 + (lane & 31)] = W[(size_t)(k0 + kk) * N + n0 + (lane & 31)]; }
    LDS_WAIT(); asm volatile("" ::: "memory");
    const int c = lane & 7;
#pragma unroll
    for (int j = 0; j < 4; ++j) { const int n = (lane >> 3) + 8 * j; const LAS float* s = scr + (8 * c) * 33 + n;
        v4u o; o.x = pk2(s[0 * 33], s[1 * 33]); o.y = pk2(s[2 * 33], s[3 * 33]); o.z = pk2(s[4 * 33], s[5 * 33]); o.w = pk2(s[6 * 33], s[7 * 33]);
        *(v4u*)(WT + (size_t)(drow0 + n) * K + k0 + 8 * c) = o; }
    LDS_WAIT(); asm volatile("" ::: "memory");
}
DI void transpose_matrix(Frame& F, const float* W, int K, int N, bf16* WT) {
    LAS float* scr = (LAS float*)(F.lds + F.wave * 16384);
    const int nblk = N / 32, nitems = (K / 64) * nblk;
    for (int it = F.gw; it < nitems; it += F.NGW) { const int kb = it / nblk, nb = it % nblk; transpose_item(W, K, N, WT, scr, 64 * kb, 32 * nb, 32 * nb, F.lane); }
}
DI void convert_moe_weights(Frame& F, const float* wg, const float* wu, const float* wd, int layer, int nskip = 0) {
    LAS float* scr = (LAS float*)(F.lds + F.wave * 16384);
    bf16* WGU = (bf16*)(F.ws + WS_WGU); bf16* WDN = (bf16*)(F.ws + WS_WDN);
    if (F.bid < nskip) return;
    for (int it = F.gw - nskip * NWAVES; it < 3 * 16 * 512; it += F.NGW - nskip * NWAVES) {
        const int mat = it / 8192, rem = it % 8192, e = rem / 512, r = rem % 512, kb = r / 32, nb = r % 32, n0 = 32 * nb;
        const size_t so = ((size_t)layer * 16 + e) * 1024 * 1024;
        if (mat == 0) transpose_item(wg + so, 1024, 1024, WGU + (size_t)e * 2048 * 1024, scr, 64 * kb, n0, (n0 >> 7) * 256 + (n0 & 127), F.lane);
        else if (mat == 1) transpose_item(wu + so, 1024, 1024, WGU + (size_t)e * 2048 * 1024, scr, 64 * kb, n0, (n0 >> 7) * 256 + 128 + (n0 & 127), F.lane);
        else transpose_item(wd + so, 1024, 1024, WDN + (size_t)e * 1024 * 1024, scr, 64 * kb, n0, n0, F.lane);
    }
}
DI void rms_row(const float* xrow, const float* g, f32x4 (&v)[4], int lane) {
    const f32x4* xr = (const f32x4*)xrow + lane; float s = 0.f;
#pragma unroll
    for (int j = 0; j < 4; ++j) { v[j] = xr[64 * j]; s += (v[j].x * v[j].x + v[j].y * v[j].y) + (v[j].z * v[j].z + v[j].w * v[j].w); }
    const float rstd = 1.f / sqrtf(wave_sum(s) * (1.f / DM) + EPS);
    const f32x4* gr = (const f32x4*)g + lane;
#pragma unroll
    for (int j = 0; j < 4; ++j) v[j] = v[j] * rstd * gr[64 * j];
}
DI void store_row_bf16(bf16* orow, const f32x4 (&v)[4], int lane) {
    v2u* o8 = (v2u*)orow + lane;
#pragma unroll
    for (int j = 0; j < 4; ++j) { v2u w; w.x = pk2(v[j].x, v[j].y); w.y = pk2(v[j].z, v[j].w); o8[64 * j] = w; }
}
DI int t5_bucket(int rel) {
    const int n = rel < 0 ? -rel : rel;
    int val;
    if (n < 8) val = n;
    else { const float sc = logf((float)n / 8.f) / 4.852030263919617f; int lg = 8 + (int)(sc * 8.f); val = lg < 15 ? lg : 15; }
    return (rel > 0 ? 16 : 0) + val;
}

typedef float f32x16 __attribute__((ext_vector_type(16)));
#define MFMA32(a, b, c) __builtin_amdgcn_mfma_f32_32x32x16_bf16((a), (b), (c), 0, 0, 0)
DI int crow32(int j, int hh) { return (j & 3) + 8 * (j >> 2) + 4 * hh; }
DI void phase_prologue(Frame& F, const Args& a) {
    unsigned char* ws = F.ws;
    transpose_matrix(F, a.in[4], 1024, NIN, (bf16*)(ws + WS_WIN));
    transpose_matrix(F, a.in[5], 1024, 1024, (bf16*)(ws + WS_WOUT));
    transpose_matrix(F, a.in[12], 1024, NQKV, (bf16*)(ws + WS_WQKV));
    transpose_matrix(F, a.in[13], 1024, 1024, (bf16*)(ws + WS_WO));
    { bf16* WSB = (bf16*)(ws + WS_WSB); for (int i = F.bid * NTHR + F.tid; i < 4 * 128 * 128; i += F.G * NTHR) WSB[i] = (bf16)f2bf(a.in[8][i]); }
    { float* LB = (float*)(ws + WS_LB); const float* t = a.in[10];
      for (int i = F.bid * NTHR + F.tid; i < 2 * 512; i += F.G * NTHR) { const int d = i / 512, k = i % 512;
          const float a0 = t[(d * 3 + 0) * 512 + k], a1 = t[(d * 3 + 1) * 512 + k], a2 = t[(d * 3 + 2) * 512 + k];
          const float mx = fmaxf(a0, fmaxf(a1, a2)); const float e0 = expf(a0 - mx), e1 = expf(a1 - mx), e2 = expf(a2 - mx);
          LB[i] = e0 / (e0 + e1 + e2); } }
    { float* BT = (float*)(ws + WS_BT); const float* rb = a.in[14];
      for (int i = F.bid * NTHR + F.tid; i < 3 * 16 * 129; i += F.G * NTHR) { const int p = i / (16 * 129), h = (i / 129) % 16, j = i % 129;
          const int dil = (p == 0) ? 1 : (p == 1 ? 4 : 16);
          BT[i] = rb[t5_bucket((j - 64) * dil) * 16 + h]; } }
    { bf16* H = (bf16*)(ws + WS_H); const float* x = a.in[0];
      for (int m = F.gw; m < MTOK; m += F.NGW) { f32x4 v[4]; rms_row(x + (size_t)m * DM, a.in[1], v, F.lane); store_row_bf16(H + (size_t)m * DM, v, F.lane); } }
}

DI void phase_a_mix(Frame& F, const Args& a) {
    const bf16* GV = (const bf16*)(F.ws + WS_GV); const bf16* U = (const bf16*)(F.ws + WS_U); bf16* CAT = (bf16*)(F.ws + WS_CAT); const bf16* WSB = (const bf16*)(F.ws + WS_WSB);
    LAS float* st = (LAS float*)F.lds;
    LAS unsigned char* tl = F.lds + 1024;
    const int r32 = F.lane & 31, hh = F.lane >> 5, ci = F.wave & 3, tp = F.wave >> 2;
    for (int u = F.bid; u < 512; u += F.G) {
        const int g = u & 3, ch = u >> 2; const int row0 = ch * 128;
        v4u tw[4];
#pragma unroll
        for (int i = 0; i < 4; ++i) { const int p = F.tid + 512 * i; tw[i] = *(const v4u*)(GV + (size_t)(row0 + (p >> 4)) * AW + g * 128 + 8 * (p & 15)); }
        float p1[16], p2[16];
#pragma unroll
        for (int r = 0; r < 16; ++r) { const v4u w = *((const v4u*)(GV + (size_t)(row0 + 16 * F.wave + r) * AW) + F.lane);
            const float x0 = bflo(w.x), x1 = bfhi(w.x), x2 = bflo(w.y), x3 = bfhi(w.y), x4 = bflo(w.z), x5 = bfhi(w.z), x6 = bflo(w.w), x7 = bfhi(w.w);
            p1[r] = ((x0 + x1) + (x2 + x3)) + ((x4 + x5) + (x6 + x7)); p2[r] = ((x0 * x0 + x1 * x1) + (x2 * x2 + x3 * x3)) + ((x4 * x4 + x5 * x5) + (x6 * x6 + x7 * x7)); }
        const float s1 = red16(p1, F.lane), s2 = red16(p2, F.lane);
        __syncthreads();
        if ((F.lane & 3) == 0) { const float mu = s1 * (1.f / AW); const float var = fmaxf(s2 * (1.f / AW) - mu * mu, 0.f); const int r = 16 * F.wave + red16_idx(F.lane);
            st[2 * r] = mu; st[2 * r + 1] = 1.f / sqrtf(var + EPS); }
#pragma unroll
        for (int i = 0; i < 4; ++i) { const int p = F.tid + 512 * i; *(LAS v4u*)(tl + (p >> 4) * 272 + 16 * (p & 15)) = tw[i]; }
        __syncthreads();
        f32x16 acc[2];
#pragma unroll
        for (int j = 0; j < 16; ++j) { acc[0][j] = 0.f; acc[1][j] = 0.f; }
        const int cl = 32 * ci + r32;
        const float lg = a.in[6][g * 128 + cl], lb = a.in[7][g * 128 + cl];
        const bf16* w0 = WSB + (size_t)g * 16384 + (size_t)(64 * tp + r32) * 128 + 8 * hh;
#pragma unroll
        for (int s = 0; s < 8; ++s) {
            float e[8];
#pragma unroll
            for (int j = 0; j < 8; ++j) { const int tk = 16 * s + 8 * hh + j; e[j] = (bf2f(*(const LAS unsigned short*)(tl + tk * 272 + 2 * cl)) - st[2 * tk]) * st[2 * tk + 1] * lg + lb; }
            v4u bw; bw.x = pk2(e[0], e[1]); bw.y = pk2(e[2], e[3]); bw.z = pk2(e[4], e[5]); bw.w = pk2(e[6], e[7]);
            const bf16x8 at = __builtin_bit_cast(bf16x8, bw);
            acc[0] = MFMA32(at, *(const bf16x8*)(w0 + 16 * s), acc[0]);
            acc[1] = MFMA32(at, *(const bf16x8*)(w0 + 32 * 128 + 16 * s), acc[1]);
        }
#pragma unroll
        for (int q = 0; q < 2; ++q) { const int t = 64 * tp + 32 * q + r32; const float bs = a.in[9][g * 128 + t];
            const size_t ub = (size_t)(row0 + t) * AW + g * 128 + 32 * ci + 4 * hh, cb = (size_t)(row0 + t) * DM + g * 128 + 32 * ci + 4 * hh;
#pragma unroll
            for (int gq = 0; gq < 4; ++gq) { const v2u uw = *(const v2u*)(U + ub + 8 * gq); v2u o;
                o.x = pk2(bflo(uw.x) * (acc[q][4 * gq] + bs), bfhi(uw.x) * (acc[q][4 * gq + 1] + bs)); o.y = pk2(bflo(uw.y) * (acc[q][4 * gq + 2] + bs), bfhi(uw.y) * (acc[q][4 * gq + 3] + bs));
                *(v2u*)(CAT + cb + 8 * gq) = o; } }
    }
}

DI void phase_gla_scan(Frame& F) {
    float* ST = (float*)(F.ws + WS_ST); const float* DEC = (const float*)(F.ws + WS_DEC);
    for (int idx = F.bid * NTHR + F.tid; idx < 16 * 4096; idx += F.G * NTHR) {
        const int chain = idx >> 12, kv = (idx & 4095) * 4, k = kv >> 7;
        f32x4 d[16]; float dc[NSC];
#pragma unroll
        for (int sc = 0; sc < NSC; ++sc) dc[sc] = DEC[(chain * NSC + sc) * 128 + k];
#pragma unroll
        for (int sc = 0; sc < 16; ++sc) d[sc] = *(const f32x4*)(ST + (size_t)(chain * NSC + sc) * 16384 + kv);
        f32x4 S = (f32x4){0.f, 0.f, 0.f, 0.f};
#pragma unroll
        for (int sc = 0; sc < NSC; ++sc) { const f32x4 cur = d[sc & 15];
            if (sc + 16 < NSC) d[sc & 15] = *(const f32x4*)(ST + (size_t)(chain * NSC + sc + 16) * 16384 + kv);
            *(f32x4*)(ST + (size_t)(chain * NSC + sc) * 16384 + kv) = S; S = S * dc[sc] + cur; }
    }
}
DI void row16_load(const bf16* row, float (&v)[16], int lane) {
#pragma unroll
    for (int j = 0; j < 2; ++j) { const v4u w = *((const v4u*)row + 64 * j + lane);
        v[8 * j] = bflo(w.x); v[8 * j + 1] = bfhi(w.x); v[8 * j + 2] = bflo(w.y); v[8 * j + 3] = bfhi(w.y); v[8 * j + 4] = bflo(w.z); v[8 * j + 5] = bfhi(w.z); v[8 * j + 6] = bflo(w.w); v[8 * j + 7] = bfhi(w.w); }
}
DI void row16_add(const v4u (&w)[2], float sc, float (&v)[16]) {
#pragma unroll
    for (int j = 0; j < 2; ++j) { v[8 * j] += sc * bflo(w[j].x); v[8 * j + 1] += sc * bfhi(w[j].x); v[8 * j + 2] += sc * bflo(w[j].y); v[8 * j + 3] += sc * bfhi(w[j].y);
        v[8 * j + 4] += sc * bflo(w[j].z); v[8 * j + 5] += sc * bfhi(w[j].z); v[8 * j + 6] += sc * bflo(w[j].w); v[8 * j + 7] += sc * bfhi(w[j].w); }
}
DI void row16_store(bf16* row, const float (&v)[16], int lane) {
#pragma unroll
    for (int j = 0; j < 2; ++j) { v4u w; w.x = pk2(v[8 * j], v[8 * j + 1]); w.y = pk2(v[8 * j + 2], v[8 * j + 3]); w.z = pk2(v[8 * j + 4], v[8 * j + 5]); w.w = pk2(v[8 * j + 6], v[8 * j + 7]); *((v4u*)row + 64 * j + lane) = w; }
}
DI void row16_gain(const float* g, float (&gv)[16], int lane) {
#pragma unroll
    for (int j = 0; j < 2; ++j)
#pragma unroll
        for (int hq = 0; hq < 2; ++hq) { const f32x4 t = *(const f32x4*)(g + 512 * j + 8 * lane + 4 * hq); gv[8 * j + 4 * hq] = t.x; gv[8 * j + 4 * hq + 1] = t.y; gv[8 * j + 4 * hq + 2] = t.z; gv[8 * j + 4 * hq + 3] = t.w; }
}
DI float row16_sumsq(const float (&v)[16]) { float s = 0.f;
#pragma unroll
    for (int i = 0; i < 16; i += 4) s += (v[i] * v[i] + v[i + 1] * v[i + 1]) + (v[i + 2] * v[i + 2] + v[i + 3] * v[i + 3]);
    return s; }
DI void phase_router(Frame& F, const bf16* XR, const float* gn, const float* wr) {
    LAS float* wl = (LAS float*)F.lds;
    __syncthreads();
    for (int i = F.tid; i < 1024 * 16 / 4; i += NTHR) { const f32x4 w4 = *(const f32x4*)(wr + 4 * i); const int d = i >> 2, e0 = 4 * (i & 3);
        const int pos = (d & 512) + 256 * ((d >> 2) & 1) + 4 * ((d >> 3) & 63) + (d & 3);
        wl[(e0 + 0) * 1024 + pos] = w4.x; wl[(e0 + 1) * 1024 + pos] = w4.y; wl[(e0 + 2) * 1024 + pos] = w4.z; wl[(e0 + 3) * 1024 + pos] = w4.w; }
    __syncthreads();
    bf16* H = (bf16*)(F.ws + WS_H); float* AFF = (float*)(F.ws + WS_AFF);
    float gv[16]; row16_gain(gn, gv, F.lane);
    v4u ra_[2], rb_[2];
    { const int mp = F.gw; if (mp < MTOK / 2) { const v4u* xa = (const v4u*)(XR + (size_t)(2 * mp) * DM) + F.lane; ra_[0] = xa[0]; ra_[1] = xa[64]; rb_[0] = xa[128]; rb_[1] = xa[192]; } }
    for (int mp = F.gw; mp < MTOK / 2; mp += F.NGW) {
        asm volatile("" ::: "memory");
        const int m0 = 2 * mp;
        float va[16], vb[16];
#pragma unroll
        for (int j = 0; j < 2; ++j) { const v4u w = ra_[j], x = rb_[j];
            va[8 * j] = bflo(w.x); va[8 * j + 1] = bfhi(w.x); va[8 * j + 2] = bflo(w.y); va[8 * j + 3] = bfhi(w.y); va[8 * j + 4] = bflo(w.z); va[8 * j + 5] = bfhi(w.z); va[8 * j + 6] = bflo(w.w); va[8 * j + 7] = bfhi(w.w);
            vb[8 * j] = bflo(x.x); vb[8 * j + 1] = bfhi(x.x); vb[8 * j + 2] = bflo(x.y); vb[8 * j + 3] = bfhi(x.y); vb[8 * j + 4] = bflo(x.z); vb[8 * j + 5] = bfhi(x.z); vb[8 * j + 6] = bflo(x.w); vb[8 * j + 7] = bfhi(x.w); }
        { const int mn = mp + F.NGW; if (mn < MTOK / 2) { const v4u* xa = (const v4u*)(XR + (size_t)(2 * mn) * DM) + F.lane; ra_[0] = xa[0]; ra_[1] = xa[64]; rb_[0] = xa[128]; rb_[1] = xa[192]; } }
        const float ra = 1.f / sqrtf(wave_sum(row16_sumsq(va)) * (1.f / DM) + EPS), rb = 1.f / sqrtf(wave_sum(row16_sumsq(vb)) * (1.f / DM) + EPS);
#pragma unroll
        for (int i = 0; i < 16; ++i) { va[i] = va[i] * ra * gv[i]; vb[i] = vb[i] * rb * gv[i]; }
        row16_store(H + (size_t)m0 * DM, va, F.lane); row16_store(H + (size_t)(m0 + 1) * DM, vb, F.lane);
        float pa[16], pb[16];
#pragma unroll
        for (int e = 0; e < 16; ++e) { float a = 0.f, c = 0.f;
#pragma unroll
            for (int j = 0; j < 2; ++j)
#pragma unroll
                for (int hq = 0; hq < 2; ++hq) { const f32x4 w4 = *(const LAS f32x4*)(wl + e * 1024 + 512 * j + 256 * hq + 4 * F.lane); const int o = 8 * j + 4 * hq;
                    a += (va[o] * w4.x + va[o + 1] * w4.y) + (va[o + 2] * w4.z + va[o + 3] * w4.w); c += (vb[o] * w4.x + vb[o + 1] * w4.y) + (vb[o + 2] * w4.z + vb[o + 3] * w4.w); }
            pa[e] = a; pb[e] = c; }
        const float la = red16(pa, F.lane), lb = red16(pb, F.lane);
        const float ma = wave_max(la), mb = wave_max(lb); const float ea = expf(la - ma), eb = expf(lb - mb); const float za = wave_sum(ea) * 0.25f, zb = wave_sum(eb) * 0.25f;
        if ((F.lane & 3) == 0) { const int b = m0 / SEQ, sq = m0 % SEQ; float* ap = AFF + (size_t)(b * 16 + red16_idx(F.lane)) * SEQ + sq; ap[0] = ea / za; ap[1] = eb / zb; }
    }
}

DI int block_excl_scan(int v, LAS int* scratch, int tid, int lane, int wave, int* tot) {
    int inc = v;
#pragma unroll
    for (int o = 1; o < 64; o <<= 1) { const int t = __shfl_up(inc, o); if (lane >= o) inc += t; }
    __syncthreads();
    if (lane == 63) scratch[wave] = inc;
    __syncthreads();
    int base = 0, total = 0;
#pragma unroll
    for (int w = 0; w < NWAVES; ++w) { const int s = scratch[w]; if (w < wave) base += s; total += s; }
    *tot = total;
    return base + inc - v;
}
DI void phase_topk(Frame& F) {
    const float* AFF = (const float*)(F.ws + WS_AFF); int* IDX = (int*)(F.ws + WS_IDX); float* GATE = (float*)(F.ws + WS_GATE); int* POS = (int*)(F.ws + WS_POS);
    LAS unsigned* hist = (LAS unsigned*)F.lds; LAS int* sc = (LAS int*)(F.lds + 16384); LAS unsigned* shv = (LAS unsigned*)(F.lds + 16384 + 256);
    for (int u = F.bid; u < BATCH * NEXP; u += F.G) {
        const int b = u / NEXP, e = u % NEXP;
        unsigned vals[16];
        { const v4u* src = (const v4u*)(AFF + (size_t)u * SEQ + 16 * F.tid);
#pragma unroll
          for (int j = 0; j < 4; ++j) { const v4u t = src[j]; vals[4 * j] = t.x; vals[4 * j + 1] = t.y; vals[4 * j + 2] = t.z; vals[4 * j + 3] = t.w; } }
        unsigned prefix = 0; int krem = CAP;
#pragma unroll
        for (int pass = 0; pass < 3; ++pass) {
            const int shift = (pass == 0) ? 20 : (pass == 1 ? 8 : 0); const unsigned mask = (pass == 2) ? 255u : 4095u; const int pshift = (pass == 2) ? 8 : 20;
            __syncthreads();
#pragma unroll
            for (int j = 0; j < 8; ++j) hist[F.tid + 512 * j] = 0u;
            __syncthreads();
#pragma unroll
            for (int j = 0; j < 16; ++j) { const unsigned v = vals[j]; if (pass == 0 || (v >> pshift) == prefix) __hip_atomic_fetch_add(&hist[(v >> shift) & mask], 1u, __ATOMIC_RELAXED, __HIP_MEMORY_SCOPE_WORKGROUP); }
            __syncthreads();
            const int hi = 4095 - 8 * F.tid; int ls = 0; unsigned hb[8];
#pragma unroll
            for (int j = 0; j < 8; ++j) { hb[j] = hist[hi - j]; ls += (int)hb[j]; }
            int tot; const int above = block_excl_scan(ls, sc, F.tid, F.lane, F.wave, &tot);
            if (above < krem && krem <= above + ls) { int cum = above, sel = hi, found = 0;
#pragma unroll
                for (int j = 0; j < 8; ++j) { if (!found) { if (cum + (int)hb[j] >= krem) { sel = hi - j; found = 1; } else cum += (int)hb[j]; } }
                shv[0] = (unsigned)sel; shv[1] = (unsigned)(krem - cum); }
            __syncthreads();
            prefix = (pass == 2) ? ((prefix << 8) | shv[0]) : ((prefix << 12) | shv[0]); krem = (int)shv[1];
        }
        const unsigned T = prefix;
        int ce = 0;
#pragma unroll
        for (int j = 0; j < 16; ++j) ce += (vals[j] == T) ? 1 : 0;
        int tot; int pe = block_excl_scan(ce, sc, F.tid, F.lane, F.wave, &tot);
        unsigned selmask = 0; int cs = 0;
#pragma unroll
        for (int j = 0; j < 16; ++j) { bool s = vals[j] > T; if (vals[j] == T) { s = pe < krem; ++pe; } if (s) { selmask |= 1u << j; ++cs; } }
        int slot = block_excl_scan(cs, sc, F.tid, F.lane, F.wave, &tot);
#pragma unroll
        for (int j = 0; j < 16; ++j) { const int s = 16 * F.tid + j; const int tokrow = b * SEQ + s;
            if (selmask & (1u << j)) { const int row = (e * 2 + b) * CAP + slot; ++slot; IDX[row] = tokrow; GATE[row] = __builtin_bit_cast(float, vals[j]); POS[tokrow * 16 + e] = row; }
            else POS[tokrow * 16 + e] = -1; }
    }
}
DI void phase_gather(Frame& F) {
    const bf16* H = (const bf16*)(F.ws + WS_H); bf16* XE = (bf16*)(F.ws + WS_XE); const int* IDX = (const int*)(F.ws + WS_IDX);
    for (int r = F.gw; r < NROWS; r += F.NGW) { const int src = IDX[r];
        const v4u* s = (const v4u*)(H + (size_t)src * DM) + F.lane; v4u* d = (v4u*)(XE + (size_t)r * DM) + F.lane;
        d[0] = s[0]; d[64] = s[64]; }
}
struct CombRow { float v[16]; v4u y[4][2]; float sc[4]; unsigned rest; int pm; };
DI void comb_load(CombRow& c, const bf16* XR, const bf16* Y, const int* POS, int m, int lane) {
    row16_load(XR + (size_t)m * DM, c.v, lane);
    c.pm = POS[m * 16 + (lane & 15)];
    unsigned mk = (unsigned)__builtin_amdgcn_readfirstlane((int)(unsigned)(__ballot(lane < 16 && c.pm >= 0)));
#pragma unroll
    for (int q = 0; q < 4; ++q) {
        int p = -1;
        if (mk) { const int e = __builtin_ctz(mk); mk &= mk - 1u; p = __builtin_amdgcn_readlane(c.pm, e); }
        c.sc[q] = (p >= 0) ? 1.f : 0.f;
        const v4u* yr = (const v4u*)(Y + (size_t)(p >= 0 ? p : 0) * DM) + lane;
        c.y[q][0] = yr[0]; c.y[q][1] = yr[64];
    }
    c.rest = mk;
}
DI void comb_finish(CombRow& c, bf16* XR, float* out, bf16* H, const bf16* Y, const float* gnext, bool final_out, int m, int lane) {
#pragma unroll
    for (int q = 0; q < 4; ++q) row16_add(c.y[q], c.sc[q], c.v);
    unsigned mk = c.rest;
    while (mk) { const int e = __builtin_ctz(mk); mk &= mk - 1u; const int p = __builtin_amdgcn_readlane(c.pm, e);
        const v4u* yr = (const v4u*)(Y + (size_t)p * DM) + lane; v4u w[2]; w[0] = yr[0]; w[1] = yr[64]; row16_add(w, 1.f, c.v); }
    const float rstd = 1.f / sqrtf(wave_sum(row16_sumsq(c.v)) * (1.f / DM) + EPS);
    float gv[16]; row16_gain(gnext, gv, lane);
    if (final_out) {
        float* xo = out + (size_t)m * DM;
#pragma unroll
        for (int j = 0; j < 2; ++j)
#pragma unroll
            for (int hq = 0; hq < 2; ++hq) { const int o = 8 * j + 4 * hq;
                *(f32x4*)(xo + 512 * j + 8 * lane + 4 * hq) = (f32x4){c.v[o] * rstd * gv[o], c.v[o + 1] * rstd * gv[o + 1], c.v[o + 2] * rstd * gv[o + 2], c.v[o + 3] * rstd * gv[o + 3]}; }
    } else {
        row16_store(XR + (size_t)m * DM, c.v, lane);
        float nv[16];
#pragma unroll
        for (int i = 0; i < 16; ++i) nv[i] = c.v[i] * rstd * gv[i];
        row16_store(H + (size_t)m * DM, nv, lane);
    }
}
DI void phase_moe_combine(Frame& F, bf16* XR, float* out, const float* gnext, bool final_out) {
    const bf16* Y = (const bf16*)(F.ws + WS_Y); const int* POS = (const int*)(F.ws + WS_POS); bf16* H = (bf16*)(F.ws + WS_H);
    for (int m = F.gw; m < MTOK; m += 2 * F.NGW) {
        CombRow ca, cb; const int m2 = m + F.NGW;
        comb_load(ca, XR, Y, POS, m, F.lane);
        if (m2 < MTOK) comb_load(cb, XR, Y, POS, m2, F.lane);
        comb_finish(ca, XR, out, H, Y, gnext, final_out, m, F.lane);
        if (m2 < MTOK) comb_finish(cb, XR, out, H, Y, gnext, final_out, m2, F.lane);
    }
}

DI int kperm(int r) { return (r & ~12) | ((r & 4) << 1) | ((r & 8) >> 1); }
DI unsigned fp8x4(float a, float b, float c, float d) { int w = __builtin_amdgcn_cvt_pk_fp8_f32(a, b, 0, false); w = __builtin_amdgcn_cvt_pk_fp8_f32(c, d, w, true); return (unsigned)w; }
DI void phase_kvf(Frame& F) {
    const bf16* QKV = (const bf16*)(F.ws + WS_QKV); unsigned char* KF = F.ws + WS_KF; unsigned char* VF = F.ws + WS_VF;
    LAS unsigned char* kl = F.lds; LAS unsigned char* vl = F.lds + 69632;
    for (int u = F.bid; u < 512; u += F.G) {
        const int c = u & 15, h = (u >> 4) & 15, b = u >> 8, t0 = c * 512;
        __syncthreads();
        { const v4u* ks = (const v4u*)(QKV + (size_t)(b * SEQ + t0 + F.tid) * NQKV + 1024 + h * 64); const v4u* vs = (const v4u*)(QKV + (size_t)(b * SEQ + t0 + F.tid) * NQKV + 2048 + h * 64);
#pragma unroll
          for (int j = 0; j < 8; ++j) { const v4u w = ks[j]; LAS v2u* d = (LAS v2u*)(kl + F.tid * 136 + 16 * j); d[0] = (v2u){w.x, w.y}; d[1] = (v2u){w.z, w.w}; }
#pragma unroll
          for (int j = 0; j < 8; ++j) { const v4u w = vs[j]; LAS v2u* d = (LAS v2u*)(vl + F.tid * 136 + 16 * j); d[0] = (v2u){w.x, w.y}; d[1] = (v2u){w.z, w.w}; } }
        __syncthreads();
#pragma unroll
        for (int p = 0; p < 3; ++p) {
            const int dl = (p == 0) ? 1 : (p == 1 ? 4 : 16), tpr = 16 / dl, ntile = SEQ / dl / 32;
            unsigned char* kd = KF + (size_t)p * 16 * MiB; unsigned char* vd = VF + (size_t)p * 16 * MiB;
#pragma unroll 2
            for (int i = 0; i < 4; ++i) { const int q = F.tid + 512 * i, tl = q >> 7, sel = (q >> 6) & 1, ln = q & 63, hh = ln >> 5, rho = ln & 31, r = tl / tpr, tt = tl % tpr;
                const size_t tg = ((size_t)((b * 16 + h) * dl + r) * ntile + c * tpr + tt) * 2048;
                { const int tokl = dl * (32 * tt + kperm(rho)) + r;
                  const LAS v2u* sp = (const LAS v2u*)(kl + tokl * 136 + 64 * hh + 32 * sel); v4u o;
                  { const v2u a0 = sp[0], a1 = sp[1]; o.x = fp8x4(bflo(a0.x), bfhi(a0.x), bflo(a0.y), bfhi(a0.y)); o.y = fp8x4(bflo(a1.x), bfhi(a1.x), bflo(a1.y), bfhi(a1.y)); }
                  { const v2u a2 = sp[2], a3 = sp[3]; o.z = fp8x4(bflo(a2.x), bfhi(a2.x), bflo(a2.y), bfhi(a2.y)); o.w = fp8x4(bflo(a3.x), bfhi(a3.x), bflo(a3.y), bfhi(a3.y)); }
                  *(v4u*)(kd + tg + sel * 1024 + ln * 16) = o; }
                { const int dim = 32 * sel + rho; float e[16];
#pragma unroll
                  for (int k = 0; k < 16; ++k) e[k] = bf2f(*(const LAS unsigned short*)(vl + (dl * (32 * tt + 16 * (k >> 3) + 8 * hh + (k & 7)) + r) * 136 + dim * 2));
                  v4u o; o.x = fp8x4(e[0], e[1], e[2], e[3]); o.y = fp8x4(e[4], e[5], e[6], e[7]); o.z = fp8x4(e[8], e[9], e[10], e[11]); o.w = fp8x4(e[12], e[13], e[14], e[15]);
                  *(v4u*)(vd + tg + sel * 1024 + ln * 16) = o; }
            }
        }
    }
}

DI int osw(int tok, int chunk) { return tok * 256 + (((chunk ^ tok ^ (tok >> 4)) & 15) << 4); }
struct AttnK { v4u w[2]; }; struct AttnV { v4u w[2]; };
typedef __bf16 bf16x2v __attribute__((ext_vector_type(2)));
DI bf16x8 fp8x8_to_bf16(unsigned lo, unsigned hi) {
    v4u r; r.x = __builtin_bit_cast(unsigned, __builtin_amdgcn_cvt_scalef32_pk_bf16_fp8((int)lo, 1.0f, false)); r.y = __builtin_bit_cast(unsigned, __builtin_amdgcn_cvt_scalef32_pk_bf16_fp8((int)lo, 1.0f, true));
    r.z = __builtin_bit_cast(unsigned, __builtin_amdgcn_cvt_scalef32_pk_bf16_fp8((int)hi, 1.0f, false)); r.w = __builtin_bit_cast(unsigned, __builtin_amdgcn_cvt_scalef32_pk_bf16_fp8((int)hi, 1.0f, true));
    return __builtin_bit_cast(bf16x8, r);
}
DI void attn_load_k(AttnK& t, const unsigned char* kt) { t.w[0] = *(const v4u*)kt; t.w[1] = *(const v4u*)(kt + 1024); }
DI void attn_load_v(AttnV& t, const unsigned char* vt) { t.w[0] = *(const v4u*)vt; t.w[1] = *(const v4u*)(vt + 1024); }
template <bool MASK> DI void attn_step(const AttnK& tk, const AttnV& tv, const bf16x8 (&qf)[4], f32x16& o0, f32x16& o1, float& m, float& l, const LAS float* bl, int rel0, int hh) {
    f32x16 sa;
#pragma unroll
    for (int i = 0; i < 16; ++i) sa[i] = 0.f;
#pragma unroll
    for (int s = 0; s < 4; ++s) { const v4u kw = tk.w[s >> 1]; sa = MFMA32((s & 1) ? fp8x8_to_bf16(kw.z, kw.w) : fp8x8_to_bf16(kw.x, kw.y), qf[s], sa); }
    float sc[16]; float tmax = -1e30f;
#pragma unroll
    for (int i = 0; i < 16; ++i) { const int rel = rel0 + 16 * (i >> 3) + (i & 7);
        const bool valid = !MASK || ((rel >= -64) && (rel <= 64)); const int idx = valid ? rel + 64 : 0;
        const float v = sa[i] + bl[idx]; sc[i] = valid ? v : -1e30f; tmax = fmaxf(tmax, sc[i]); }
    tmax = fmaxf(tmax, __shfl_xor(tmax, 32));
    const float mnew = fmaxf(m, tmax), alpha = fexp(m - mnew);
    float ps = 0.f; float p[16];
#pragma unroll
    for (int i = 0; i < 16; ++i) { p[i] = (!MASK || sc[i] > -1e29f) ? fexp(sc[i] - mnew) : 0.f; ps += p[i]; }
    l = l * alpha + ps; m = mnew;
#pragma unroll
    for (int i = 0; i < 16; ++i) { o0[i] *= alpha; o1[i] *= alpha; }
#pragma unroll
    for (int s = 0; s < 2; ++s) {
        v4u w; w.x = pk2(p[8 * s], p[8 * s + 1]); w.y = pk2(p[8 * s + 2], p[8 * s + 3]); w.z = pk2(p[8 * s + 4], p[8 * s + 5]); w.w = pk2(p[8 * s + 6], p[8 * s + 7]);
        const bf16x8 pf = __builtin_bit_cast(bf16x8, w);
        o0 = MFMA32(s ? fp8x8_to_bf16(tv.w[0].z, tv.w[0].w) : fp8x8_to_bf16(tv.w[0].x, tv.w[0].y), pf, o0); o1 = MFMA32(s ? fp8x8_to_bf16(tv.w[1].z, tv.w[1].w) : fp8x8_to_bf16(tv.w[1].x, tv.w[1].y), pf, o1);
    }
}
DI void attn_stage(Frame& F, int b, int h, int t0, const int P) {
    const int dsh = 2 * P, DL = 1 << dsh, NT = (SEQ / 32) >> dsh;
    const bf16* QKV = (const bf16*)(F.ws + WS_QKV); const unsigned char* KF = F.ws + WS_KF + (size_t)P * 16 * MiB; const unsigned char* VF = F.ws + WS_VF + (size_t)P * 16 * MiB; bf16* ATT = (bf16*)(F.ws + WS_ATT);
    LAS unsigned char* ol = F.lds; LAS float* ml = (LAS float*)(F.lds + 131072); LAS float* ll = ml + 512; const LAS float* bl = (const LAS float*)(F.lds + 135168) + P * 132;
    int lane = F.lane; asm volatile("" : "+v"(lane));
    const int r32 = lane & 31, hh = lane >> 5, w = F.wave;
    asm volatile("" ::: "memory");
    int rr[2], mq[2], tq[2]; const unsigned char* kb[2]; const unsigned char* vb[2];
#pragma unroll
    for (int task = 0; task < 2; ++task) {
        int r, i0;
        if (P == 0) { r = 0; i0 = 64 * w + 32 * task; } else if (P == 1) { r = w & 3; i0 = 64 * (w >> 2) + 32 * task; } else { r = 2 * w + task; i0 = 0; }
        rr[task] = r; mq[task] = (t0 >> dsh) + i0; tq[task] = r + ((i0 + r32) << dsh);
        const size_t tb0 = ((size_t)((b * 16 + h) * DL + r) * NT) * 2048 + lane * 16;
        kb[task] = KF + tb0; vb[task] = VF + tb0;
    }
    int relb = 8 * hh - 64 - r32;
    asm volatile("" : "+v"(relb));
    AttnK ka, kb_, kc; AttnV va, vb_; bf16x8 qf[4], qn[4]; f32x16 o0, o1; float m, l;
#define ATT_T(task, kt) (mq[task] / 32 - 2 + (kt))
#define ATT_OK(task, kt) (ATT_T(task, kt) >= 0 && ATT_T(task, kt) < NT)
#define ATT_TC(task, kt) (ATT_T(task, kt) < 0 ? 0 : (ATT_T(task, kt) >= NT ? NT - 1 : ATT_T(task, kt)))
#define ATT_LDK(t, task, kt) attn_load_k(t, kb[task] + (size_t)ATT_TC(task, kt) * 2048)
#define ATT_LDV(t, task, kt) attn_load_v(t, vb[task] + (size_t)ATT_TC(task, kt) * 2048)
#define ATT_ST(tk, tv, task, kt, MSK) do { if (ATT_OK(task, kt)) attn_step<MSK>(tk, tv, qf, o0, o1, m, l, bl, relb + 32 * (kt), hh); } while (0)
#define ATT_Q(dst, task) do { const bf16* qp = QKV + (size_t)(b * SEQ + t0 + tq[task]) * NQKV + h * 64 + 32 * hh; _Pragma("unroll") for (int s = 0; s < 4; ++s) dst[s] = *(const bf16x8*)(qp + 8 * s); } while (0)
#define ATT_INIT(task) do { if (P == 0) { _Pragma("unroll") for (int i = 0; i < 16; ++i) { o0[i] = 0.f; o1[i] = 0.f; } m = -1e30f; l = 0.f; } else { \
        _Pragma("unroll") for (int g = 0; g < 4; ++g) { const f32x4 a = *(const LAS f32x4*)(ol + osw(tq[task], 2 * g + hh)), c = *(const LAS f32x4*)(ol + osw(tq[task], 8 + 2 * g + hh)); \
            o0[4 * g] = a.x; o0[4 * g + 1] = a.y; o0[4 * g + 2] = a.z; o0[4 * g + 3] = a.w; o1[4 * g] = c.x; o1[4 * g + 1] = c.y; o1[4 * g + 2] = c.z; o1[4 * g + 3] = c.w; } \
        m = ml[tq[task]]; l = hh ? 0.f : ll[tq[task]]; } } while (0)
#define ATT_WB(task) do { const float lt = l + __shfl_xor(l, 32); int tw = tq[task]; asm volatile("" : "+v"(tw));     \
        if (P < 2) { _Pragma("unroll") for (int g = 0; g < 4; ++g) { *(LAS f32x4*)(ol + osw(tw, 2 * g + hh)) = (f32x4){o0[4 * g], o0[4 * g + 1], o0[4 * g + 2], o0[4 * g + 3]}; \
                *(LAS f32x4*)(ol + osw(tw, 8 + 2 * g + hh)) = (f32x4){o1[4 * g], o1[4 * g + 1], o1[4 * g + 2], o1[4 * g + 3]}; } \
            if (hh == 0) { ml[tw] = m; ll[tw] = lt; } } \
        else { const float inv = 1.f / lt; bf16* op = ATT + (size_t)(b * SEQ + t0 + tw) * DM + h * 64 + 4 * hh; \
            _Pragma("unroll") for (int g = 0; g < 4; ++g) { v2u a, c; a.x = pk2(o0[4 * g] * inv, o0[4 * g + 1] * inv); a.y = pk2(o0[4 * g + 2] * inv, o0[4 * g + 3] * inv); \
                c.x = pk2(o1[4 * g] * inv, o1[4 * g + 1] * inv); c.y = pk2(o1[4 * g + 2] * inv, o1[4 * g + 3] * inv); *(v2u*)(op + 8 * g) = a; *(v2u*)(op + 32 + 8 * g) = c; } } } while (0)
    ATT_LDK(ka, 0, 0); ATT_LDK(kb_, 0, 1); ATT_LDV(va, 0, 0);
    ATT_Q(qf, 0); ATT_INIT(0);
    ATT_LDK(kc, 0, 2); ATT_LDV(vb_, 0, 1); ATT_ST(ka, va, 0, 0, true);
    ATT_LDK(ka, 0, 3); ATT_LDV(va, 0, 2); ATT_ST(kb_, vb_, 0, 1, false);
    ATT_LDK(kb_, 0, 4); ATT_LDV(vb_, 0, 3); ATT_ST(kc, va, 0, 2, false);
    ATT_Q(qn, 1);
    ATT_LDK(kc, 1, 0); ATT_LDV(va, 0, 4); ATT_ST(ka, vb_, 0, 3, false);
    ATT_LDK(ka, 1, 1); ATT_LDV(vb_, 1, 0); ATT_ST(kb_, va, 0, 4, true);
    ATT_WB(0);
    _Pragma("unroll") for (int s = 0; s < 4; ++s) qf[s] = qn[s];
    ATT_INIT(1);
    ATT_LDK(kb_, 1, 2); ATT_LDV(va, 1, 1); ATT_ST(kc, vb_, 1, 0, true);
    ATT_LDK(kc, 1, 3); ATT_LDV(vb_, 1, 2); ATT_ST(ka, va, 1, 1, false);
    ATT_LDK(ka, 1, 4); ATT_LDV(va, 1, 3); ATT_ST(kb_, vb_, 1, 2, false);
    ATT_LDV(vb_, 1, 4); ATT_ST(kc, va, 1, 3, false);
    ATT_ST(ka, vb_, 1, 4, true);
    ATT_WB(1);
#undef ATT_T
#undef ATT_OK
#undef ATT_TC
#undef ATT_LDK
#undef ATT_LDV
#undef ATT_ST
#undef ATT_Q
#undef ATT_INIT
#undef ATT_WB
}
DI void phase_attn(Frame& F) {
    const float* BT = (const float*)(F.ws + WS_BT);
    LAS float* bl = (LAS float*)(F.lds + 135168);
    const int vb_ = (F.G % 8 == 0) ? (F.bid % 8) * (F.G / 8) + F.bid / 8 : F.bid;
    for (int u = vb_; u < 512; u += F.G) {
        const int c = u & 15, h = (u >> 4) & 15, b = u >> 8, t0 = c * 512;
        __syncthreads();
        { int i0 = F.tid; asm volatile("" : "+v"(i0)); for (int i = i0; i < 3 * 129; i += NTHR) bl[(i / 129) * 132 + i % 129] = BT[((i / 129) * 16 + h) * 129 + i % 129]; }
        __syncthreads();
#pragma unroll 1
        for (int P = 0; P < 3; ++P) { if (P) __syncthreads(); attn_stage(F, b, h, t0, P); }
    }
}

constexpr int GL_QT = 0, GL_KT = 17408, GL_QB = 34816, GL_KHT = 52224, GL_VT = 70656, GL_P = 89088, GL_ST = 98304, GL_DEC = 133120, GL_TOT = 133632;
struct GlaRaw { v4u q[2], lf[2], v[2]; };
DI void gla_load_raw(GlaRaw& R, const _Float16* LF, const bf16* Q, const bf16* V, int b, int h, int dir, int pos0, int tid) {
#pragma unroll
    for (int i = 0; i < 2; ++i) { const int p = tid + 512 * i, ii = pos0 + (p >> 4); const int tok = dir ? (SEQ - 1 - ii) : ii; const size_t off = (size_t)(b * SEQ + tok) * AW + h * 128 + 8 * (p & 15);
        R.q[i] = *(const v4u*)(Q + off); R.lf[i] = *(const v4u*)(LF + off); R.v[i] = *(const v4u*)(V + off); }
}
DI void gla_prep(Frame& F, const GlaRaw& R) {
    LAS unsigned char* L = F.lds; LAS float* tot = (LAS float*)(L + GL_TOT);
    const int ch = F.tid & 127, qtr = F.tid >> 7;
#pragma unroll
    for (int i = 0; i < 2; ++i) { const int p = F.tid + 512 * i; const int so = (p >> 4) * 272 + 16 * (p & 15);
        *(LAS v4u*)(L + GL_QT + so) = R.q[i]; *(LAS v4u*)(L + GL_KT + so) = R.lf[i]; *(LAS v4u*)(L + GL_QB + so) = R.v[i]; }
    __syncthreads();
    float lf[16]; unsigned short qr[16], vr[16];
#pragma unroll
    for (int i = 0; i < 16; ++i) { const int so = (16 * qtr + i) * 272 + 2 * ch;
        qr[i] = *(const LAS unsigned short*)(L + GL_QT + so); lf[i] = (float)*(const LAS _Float16*)(L + GL_KT + so); vr[i] = *(const LAS unsigned short*)(L + GL_QB + so); }
    float c[16]; float run = 0.f;
#pragma unroll
    for (int i = 0; i < 16; ++i) { run += lf[i]; c[i] = run; }
    tot[qtr * 128 + ch] = run;
    __syncthreads();
    const float t0 = tot[ch], t1 = tot[128 + ch], t2 = tot[256 + ch], t3 = tot[384 + ch];
    const float off = (qtr > 0 ? t0 : 0.f) + (qtr > 1 ? t1 : 0.f) + (qtr > 2 ? t2 : 0.f), rr = t0 + t1, bend = (t0 + t1) + (t2 + t3);
    const float er = fexp(rr), ebr = fexp(bend - rr);
    unsigned kh[8], vv[8];
#pragma unroll
    for (int i = 0; i < 16; i += 2) {
        const float E0 = fexp(off + c[i] - rr), E1 = fexp(off + c[i + 1] - rr), I0 = frcp(E0), I1 = frcp(E1);
        const float k0 = 1.f - fexp(lf[i]), k1 = 1.f - fexp(lf[i + 1]);
        const float ki0 = k0 * I0, ki1 = k1 * I1;
        kh[i >> 1] = pk2(ki0 * ebr, ki1 * ebr);
        vv[i >> 1] = (unsigned)vr[i] | ((unsigned)vr[i + 1] << 16);
        const float q0 = bf2f(qr[i]) * E0, q1 = bf2f(qr[i + 1]) * E1;
        const int ta = 16 * qtr + i;
        *(LAS unsigned short*)(L + GL_QT + ta * 272 + 2 * ch) = (unsigned short)f2bf(q0);
        *(LAS unsigned short*)(L + GL_QT + (ta + 1) * 272 + 2 * ch) = (unsigned short)f2bf(q1);
        *(LAS unsigned short*)(L + GL_KT + ta * 272 + 2 * ch) = (unsigned short)f2bf(ki0);
        *(LAS unsigned short*)(L + GL_KT + (ta + 1) * 272 + 2 * ch) = (unsigned short)f2bf(ki1);
        *(LAS unsigned short*)(L + GL_QB + ta * 272 + 2 * ch) = (unsigned short)f2bf(q0 * er);
        *(LAS unsigned short*)(L + GL_QB + (ta + 1) * 272 + 2 * ch) = (unsigned short)f2bf(q1 * er);
    }
    *(LAS v4u*)(L + GL_KHT + ch * 144 + 32 * qtr) = (v4u){kh[0], kh[1], kh[2], kh[3]}; *(LAS v4u*)(L + GL_KHT + ch * 144 + 32 * qtr + 16) = (v4u){kh[4], kh[5], kh[6], kh[7]};
    *(LAS v4u*)(L + GL_VT + ch * 144 + 32 * qtr) = (v4u){vv[0], vv[1], vv[2], vv[3]}; *(LAS v4u*)(L + GL_VT + ch * 144 + 32 * qtr + 16) = (v4u){vv[4], vv[5], vv[6], vv[7]};
    if (qtr == 0) *(LAS float*)(L + GL_DEC + 4 * ch) = fexp(bend);
}
DI bf16x8 gfrag(const LAS unsigned char* base, int row, int stride, int kel) { return *(const LAS bf16x8*)(base + row * stride + kel * 2); }
DI void gla_state_update(Frame& F, f32x16 (&S)[2]) {
    const LAS unsigned char* L = F.lds; const int r32 = F.lane & 31, hh = F.lane >> 5, vi = F.wave & 3, ki0 = 2 * (F.wave >> 2);
    bf16x8 a[4];
#pragma unroll
    for (int s = 0; s < 4; ++s) a[s] = gfrag(L + GL_VT, 32 * vi + r32, 144, 16 * s + 8 * hh);
#pragma unroll
    for (int q = 0; q < 2; ++q) { const int kr = 32 * (ki0 + q) + r32; const float d = *(const LAS float*)(L + GL_DEC + 4 * kr);
#pragma unroll
        for (int j = 0; j < 16; ++j) S[q][j] *= d;
#pragma unroll
        for (int s = 0; s < 4; ++s) S[q] = MFMA32(a[s], gfrag(L + GL_KHT, kr, 144, 16 * s + 8 * hh), S[q]); }
}
DI void gla_state_to_lds(Frame& F, const f32x16 (&S)[2]) {
    LAS unsigned char* L = F.lds; const int r32 = F.lane & 31, hh = F.lane >> 5, vi = F.wave & 3, ki0 = 2 * (F.wave >> 2);
#pragma unroll
    for (int q = 0; q < 2; ++q)
#pragma unroll
        for (int j = 0; j < 16; ++j) *(LAS unsigned short*)(L + GL_ST + (32 * vi + crow32(j, hh)) * 272 + 2 * (32 * (ki0 + q) + r32)) = (unsigned short)f2bf(S[q][j]);
}
constexpr int G1_KHT = 0, G1_VT = 69632, G1_TOT = 139264;
DI void gla_unit_state(Frame& F, int u) {
    const int sc = u & 31, dir = (u >> 5) & 1, h = (u >> 6) & 3, b = u >> 8;
    const bf16* V = (const bf16*)(F.ws + WS_V); const _Float16* LF = (const _Float16*)(F.ws + (dir ? WS_LFB : WS_LFF));
    float* ST = (float*)(F.ws + WS_ST) + (size_t)u * 16384; float* DEC = (float*)(F.ws + WS_DEC) + u * 128;
    LAS unsigned char* L = F.lds; LAS float* tot = (LAS float*)(L + G1_TOT);
    const int ch = F.tid & 127, qtr = F.tid >> 7, r32 = F.lane & 31, hh = F.lane >> 5, vi = F.wave & 3, ki0 = 2 * (F.wave >> 2);
    { v4u rl[8], rv[8];
#pragma unroll
      for (int i = 0; i < 8; ++i) { const int p = F.tid + 512 * i, ii = sc * 256 + (p >> 4); const int tok = dir ? (SEQ - 1 - ii) : ii; const size_t off = (size_t)(b * SEQ + tok) * AW + h * 128 + 8 * (p & 15);
          rl[i] = *(const v4u*)(LF + off); rv[i] = *(const v4u*)(V + off); }
      __syncthreads();
#pragma unroll
      for (int i = 0; i < 8; ++i) { const int p = F.tid + 512 * i; const int so = (p >> 4) * 272 + 16 * (p & 15); *(LAS v4u*)(L + G1_KHT + so) = rl[i]; *(LAS v4u*)(L + G1_VT + so) = rv[i]; } }
    __syncthreads();
    float lf[64]; unsigned vv[32];
#pragma unroll
    for (int i = 0; i < 64; ++i) { const int so = (64 * qtr + i) * 272 + 2 * ch;
        lf[i] = (float)*(const LAS _Float16*)(L + G1_KHT + so); const unsigned x = *(const LAS unsigned short*)(L + G1_VT + so); if (i & 1) vv[i >> 1] |= x << 16; else vv[i >> 1] = x; }
    float run = 0.f;
#pragma unroll
    for (int i = 0; i < 64; ++i) run += lf[i];
    __syncthreads();
    tot[qtr * 128 + ch] = run;
#pragma unroll
    for (int i = 0; i < 32; i += 4) *(LAS v4u*)(L + G1_VT + ch * 528 + 128 * qtr + 4 * i) = (v4u){vv[i], vv[i + 1], vv[i + 2], vv[i + 3]};
    __syncthreads();
    const float t0 = tot[ch], t1 = tot[128 + ch], t2 = tot[256 + ch], t3 = tot[384 + ch];
    const float bend = (t0 + t1) + (t2 + t3);
    run = (qtr > 0 ? t0 : 0.f) + (qtr > 1 ? t1 : 0.f) + (qtr > 2 ? t2 : 0.f);
#pragma unroll
    for (int i = 0; i < 64; i += 2) { const float b0 = run + lf[i], b1 = b0 + lf[i + 1]; run = b1;
        vv[i >> 1] = pk2((1.f - fexp(lf[i])) * fexp(bend - b0), (1.f - fexp(lf[i + 1])) * fexp(bend - b1)); }
#pragma unroll
    for (int i = 0; i < 32; i += 4) *(LAS v4u*)(L + G1_KHT + ch * 528 + 128 * qtr + 4 * i) = (v4u){vv[i], vv[i + 1], vv[i + 2], vv[i + 3]};
    if (qtr == 0) DEC[ch] = fexp(bend);
    __syncthreads();
    f32x16 S[2];
#pragma unroll
    for (int j = 0; j < 16; ++j) { S[0][j] = 0.f; S[1][j] = 0.f; }
#pragma unroll 4
    for (int s = 0; s < 16; ++s) { const bf16x8 av = gfrag(L + G1_VT, 32 * vi + r32, 528, 16 * s + 8 * hh);
        S[0] = MFMA32(av, gfrag(L + G1_KHT, 32 * ki0 + r32, 528, 16 * s + 8 * hh), S[0]);
        S[1] = MFMA32(av, gfrag(L + G1_KHT, 32 * (ki0 + 1) + r32, 528, 16 * s + 8 * hh), S[1]); }
#pragma unroll
    for (int q = 0; q < 2; ++q)
#pragma unroll
        for (int g = 0; g < 4; ++g) *(f32x4*)(ST + (size_t)(32 * (ki0 + q) + r32) * 128 + 32 * vi + 8 * g + 4 * hh) = (f32x4){S[q][4 * g], S[q][4 * g + 1], S[q][4 * g + 2], S[q][4 * g + 3]};
}
DI int red16h_idx(int lane) { return 8 * ((lane >> 4) & 1) + 4 * ((lane >> 3) & 1) + 2 * ((lane >> 2) & 1) + ((lane >> 1) & 1); }
DI float red16h(const float (&o)[16], int lane) {
    const bool b16 = lane & 16, b8 = lane & 8, b4 = lane & 4, b2 = lane & 2;
    float a8[8], a4[4], a2[2], a1;
#pragma unroll
    for (int j = 0; j < 8; ++j) { const float send = b16 ? o[j] : o[j + 8], keep = b16 ? o[j + 8] : o[j]; a8[j] = keep + __shfl_xor(send, 16); }
#pragma unroll
    for (int j = 0; j < 4; ++j) { const float send = b8 ? a8[j] : a8[j + 4], keep = b8 ? a8[j + 4] : a8[j]; a4[j] = keep + __shfl_xor(send, 8); }
#pragma unroll
    for (int j = 0; j < 2; ++j) { const float send = b4 ? a4[j] : a4[j + 2], keep = b4 ? a4[j + 2] : a4[j]; a2[j] = keep + __shfl_xor(send, 4); }
    { const float send = b2 ? a2[0] : a2[1], keep = b2 ? a2[1] : a2[0]; a1 = keep + __shfl_xor(send, 2); }
    a1 += __shfl_xor(a1, 1);
    return a1;
}
constexpr int GL_RS = 135680;
template <bool FUSE> DI void gla_unit_out(Frame& F, const Args& a, int u) {
    const int sc = u & 31, dir = (u >> 5) & 1, h = (u >> 6) & 3, b = u >> 8;
    const bf16* Q = (const bf16*)(F.ws + WS_Q); const bf16* V = (const bf16*)(F.ws + WS_V); const _Float16* LF = (const _Float16*)(F.ws + (dir ? WS_LFB : WS_LFF));
    const float* ST = (const float*)(F.ws + WS_ST) + (size_t)u * 16384; float* OF = (float*)(F.ws + WS_ODIR);
    const bf16* G = (const bf16*)(F.ws + WS_G); bf16* CAT = (bf16*)(F.ws + WS_CAT);
    const LAS unsigned char* L = F.lds;
    const int ch = F.tid & 127, qtr = F.tid >> 7, r32 = F.lane & 31, hh = F.lane >> 5, w = F.wave, vi = w & 3, ki0 = 2 * (w >> 2), ti = w >> 2;
    f32x16 S[2];
#pragma unroll
    for (int q = 0; q < 2; ++q)
#pragma unroll
        for (int g = 0; g < 4; ++g) { const f32x4 t = *(const f32x4*)(ST + (size_t)(32 * (ki0 + q) + r32) * 128 + 32 * vi + 8 * g + 4 * hh); S[q][4 * g] = t.x; S[q][4 * g + 1] = t.y; S[q][4 * g + 2] = t.z; S[q][4 * g + 3] = t.w; }
    GlaRaw cur, nxt;
    gla_load_raw(cur, LF, Q, V, b, h, dir, sc * 256, F.tid);
    __syncthreads();
    gla_state_to_lds(F, S);
    f32x4 ngv[4];
    if (FUSE) {
#pragma unroll
        for (int g = 0; g < 4; ++g) ngv[g] = *(const f32x4*)(a.in[11] + h * 128 + 32 * vi + 8 * g + 4 * hh);
    }
#pragma unroll 1
    for (int c = 0; c < 4; ++c) {
        gla_prep(F, cur);
        if (c < 3) gla_load_raw(nxt, LF, Q, V, b, h, dir, sc * 256 + (c + 1) * 64, F.tid);
        const int ii = sc * 256 + c * 64 + 32 * ti + r32; const int tok = dir ? (SEQ - 1 - ii) : ii;
        const size_t orow = (size_t)(b * SEQ + tok) * AW + h * 128 + 32 * vi + 4 * hh;
        f32x4 of[4]; v2u gg[4];
        if (FUSE) {
#pragma unroll
            for (int g = 0; g < 4; ++g) { of[g] = *(const f32x4*)(OF + orow + 8 * g); gg[g] = *(const v2u*)(G + orow + 8 * g); }
        }
        __syncthreads();
        f32x16 o;
#pragma unroll
        for (int j = 0; j < 16; ++j) o[j] = 0.f;
#pragma unroll
        for (int s = 0; s < 8; ++s) o = MFMA32(gfrag(L + GL_ST, 32 * vi + r32, 272, 16 * s + 8 * hh), gfrag(L + GL_QB, 32 * ti + r32, 272, 16 * s + 8 * hh), o);
        if (w < 3) {
            const int tp = (w + 1) >> 1, sp = (w == 2) ? 1 : 0;
            f32x16 p;
#pragma unroll
            for (int j = 0; j < 16; ++j) p[j] = 0.f;
#pragma unroll
            for (int s = 0; s < 8; ++s) p = MFMA32(gfrag(L + GL_QT, 32 * tp + r32, 272, 16 * s + 8 * hh), gfrag(L + GL_KT, 32 * sp + r32, 272, 16 * s + 8 * hh), p);
#pragma unroll
            for (int j = 0; j < 16; ++j) { const int t = 32 * tp + crow32(j, hh), s2 = 32 * sp + r32;
                *(LAS unsigned short*)(F.lds + GL_P + t * 144 + 2 * s2) = (s2 <= t) ? (unsigned short)f2bf(p[j]) : (unsigned short)0; }
        }
        __syncthreads();
        { const int ns = ti ? 4 : 2;
#pragma unroll
          for (int s = 0; s < 4; ++s) if (s < ns) o = MFMA32(gfrag(L + GL_VT, 32 * vi + r32, 144, 16 * s + 8 * hh), gfrag(L + GL_P, 32 * ti + r32, 144, 16 * s + 8 * hh), o); }
        if (!FUSE) {
#pragma unroll
            for (int g = 0; g < 4; ++g) *(f32x4*)(OF + orow + 8 * g) = (f32x4){o[4 * g], o[4 * g + 1], o[4 * g + 2], o[4 * g + 3]};
        } else {
            float part = 0.f;
#pragma unroll
            for (int g = 0; g < 4; ++g) { o[4 * g] += of[g].x; o[4 * g + 1] += of[g].y; o[4 * g + 2] += of[g].z; o[4 * g + 3] += of[g].w; }
#pragma unroll
            for (int j = 0; j < 16; ++j) part += o[j] * o[j];
            part += __shfl_xor(part, 32);
            if (hh == 0) *(LAS float*)(F.lds + GL_RS + ((ti * 32 + r32) * 4 + vi) * 4) = part;
        }
        if (c < 3) { gla_state_update(F, S); gla_state_to_lds(F, S); }
        cur = nxt;
        __syncthreads();
        if (FUSE) {
            const f32x4 ps = *(const LAS f32x4*)(L + GL_RS + (ti * 32 + r32) * 16);
            const float rstd = 1.f / sqrtf(((ps.x + ps.y) + (ps.z + ps.w)) * (1.f / 128.f) + EPS);
            bf16* crow_ = CAT + (size_t)(b * SEQ + tok) * DM + 512 + h * 128 + 32 * vi + 4 * hh;
#pragma unroll
            for (int g = 0; g < 4; ++g) { v2u wv; wv.x = pk2(o[4 * g] * rstd * ngv[g].x * bflo(gg[g].x), o[4 * g + 1] * rstd * ngv[g].y * bfhi(gg[g].x));
                wv.y = pk2(o[4 * g + 2] * rstd * ngv[g].z * bflo(gg[g].y), o[4 * g + 3] * rstd * ngv[g].w * bfhi(gg[g].y));
                *(v2u*)(crow_ + 8 * g) = wv; }
        }
    }
}

__global__ void __launch_bounds__(NTHR, 2) fwd_kernel(Args args) {
    extern __shared__ __attribute__((aligned(16))) unsigned char lds[];
    Frame F;
    F.lds = (LAS unsigned char*)lds;
    F.MISC = (volatile LAS unsigned*)(F.lds + MISC_OFF);
    F.tid = threadIdx.x; F.lane = F.tid & 63; F.wave = __builtin_amdgcn_readfirstlane(F.tid >> 6);
    F.G = gridDim.x; F.bid = blockIdx.x; F.gw = F.bid * NWAVES + F.wave; F.NGW = F.G * NWAVES;
    F.ws = args.ws;
    unsigned* ctl = (unsigned*)(args.ws + WS_CTL);
    for (int u = F.tid; u < (LDS_BYTES - LDSCTL_OFF) / 4; u += NTHR) ((LAS unsigned*)(F.lds + LDSCTL_OFF))[u] = 0u;
    __syncthreads();
    const int lo = args.ph_lo, hi = args.ph_hi;
    XcdBarrier bar; bar.bar = ctl + CW_BAR + args.li * XCD_BAR_WORDS; bar.x = 0; bar.st = nullptr;
    if (hi - lo > 1) bar = xcd_barrier_post(ctl + CW_BAR + args.li * XCD_BAR_WORDS, F.MISC + 8);
#define IN(k) (lo <= (k) && (k) < hi)
#ifndef PROBE_DUP
#define PROBE_DUP (-1)
#endif
#define REP(k) for (int rep_ = 0; rep_ < (((PROBE_DUP) == (k)) ? 2 : 1); ++rep_)
#define SEAM(k) do { if (IN(k) && IN((k) + 1)) { xcd_barrier(bar); if (PROBE_DUP == 99) xcd_barrier(bar); } } while (0)
    unsigned char* ws = args.ws;
    bf16* XR = (bf16*)(ws + WS_XR);

    if (IN(0)) REP(0) { phase_prologue(F, args); } SEAM(0);
    if (IN(1)) {
        pg8::Gemm g{(const bf16*)(ws + WS_H), (const bf16*)(ws + WS_WIN), MTOK, NIN, DM}; pg8::StaticOrder S; S.init(MTOK, NIN, F.G, F.bid);
        EpiInProj E{(bf16*)(ws + WS_U), (bf16*)(ws + WS_GV), (bf16*)(ws + WS_Q), (bf16*)(ws + WS_V), (bf16*)(ws + WS_G), (_Float16*)(ws + WS_LFF), (_Float16*)(ws + WS_LFB), (const float*)(ws + WS_LB)};
        pg8::gemm_phase<EpiInProj, pg8::StaticOrder, true, true>(F.lds, g, S, E);
        if (PROBE_DUP == 1) pg8::gemm_phase<EpiInProj, pg8::StaticOrder, true, true>(F.lds, g, S, E);
    } SEAM(1);
    if (IN(2)) { phase_a_mix(F, args); REP(2) for (int u = F.bid; u < 512; u += F.G) gla_unit_state(F, u); } SEAM(2);
    if (IN(3)) { phase_gla_scan(F); } SEAM(3);
    if (IN(4)) { for (int i = F.bid; i < 256; i += F.G) gla_unit_out<false>(F, args, ((i >> 5) << 6) | (i & 31)); } SEAM(4);
    if (IN(5)) { for (int i = F.bid; i < 256; i += F.G) gla_unit_out<true>(F, args, ((i >> 5) << 6) | 32 | (i & 31)); } SEAM(5);
    if (IN(6)) REP(6) {
        pg8::Gemm g{(const bf16*)(ws + WS_CAT), (const bf16*)(ws + WS_WOUT), MTOK, DM, DM}; pg8::StaticOrder S; S.init(MTOK, DM, F.G, F.bid);
        EpiResid<true> E{args.in[0], XR};
        pg8::gemm_phase<EpiResid<true>, pg8::StaticOrder, true, true>(F.lds, g, S, E);
    } SEAM(6);
#define MOE_BLOCK(L, pb) do { \
        if (IN(pb)) REP(pb) { phase_router(F, XR, args.in[2] + (L) * DM, args.in[15] + (L) * DM * NEXP); } SEAM(pb); \
        if (IN((pb) + 1)) { REP((pb) + 1) phase_topk(F); convert_moe_weights(F, args.in[16], args.in[17], args.in[18], (L), (F.G > 64) ? 32 : 0); } SEAM((pb) + 1);     \
        if (IN((pb) + 2)) {     \
            pg8::Gemm g{(const bf16*)(ws + WS_H), (const bf16*)(ws + WS_WGU), NROWS, 16 * 2048, DM}; GroupedOrder<8> S{F.G, F.bid}; \
            EpiGateUp E{(bf16*)(ws + WS_HMID)}; \
            LAS int* rowtab = (LAS int*)(F.lds + RING_BYTES); const int* IDX = (const int*)(ws + WS_IDX); \
            for (int i = 0; i < 4; ++i) { pg8::Unit uu; if (!S.next(i, uu)) break; if (F.tid < 256) rowtab[i * 256 + F.tid] = IDX[uu.pm * 256 + F.tid]; } \
            __syncthreads(); \
            pg8::gemm_phase<EpiGateUp, GroupedOrder<8>, true, true, true>(F.lds, g, S, E, rowtab); \
            if (PROBE_DUP == (pb) + 2) pg8::gemm_phase<EpiGateUp, GroupedOrder<8>, true, true, true>(F.lds, g, S, E, rowtab); \
        } SEAM((pb) + 2); \
        if (IN((pb) + 3)) { \
            pg8::Gemm g{(const bf16*)(ws + WS_HMID), (const bf16*)(ws + WS_WDN), NROWS, 16 * 1024, DFF}; GroupedOrder<4> S{F.G, F.bid}; \
            EpiDown E{(bf16*)(ws + WS_Y), (const float*)(ws + WS_GATE)}; \
            pg8::gemm_phase<EpiDown, GroupedOrder<4>, true, true>(F.lds, g, S, E); \
            if (PROBE_DUP == (pb) + 3) pg8::gemm_phase<EpiDown, GroupedOrder<4>, true, true>(F.lds, g, S, E); \
        } SEAM((pb) + 3); \
    } while (0)

    MOE_BLOCK(0, 7);
    if (IN(11)) { phase_moe_combine(F, XR, args.out, args.in[1] + DM, false); } SEAM(11);
    if (IN(12)) REP(12) {
        pg8::Gemm g{(const bf16*)(ws + WS_H), (const bf16*)(ws + WS_WQKV), MTOK, NQKV, DM}; pg8::StaticOrder S; S.init(MTOK, NQKV, F.G, F.bid);
        EpiQKV E{(bf16*)(ws + WS_QKV)};
        pg8::gemm_phase<EpiQKV, pg8::StaticOrder, true, true>(F.lds, g, S, E);
    } SEAM(12);
    if (IN(13)) REP(13) { phase_kvf(F); } SEAM(13);
    if (IN(14)) REP(14) { phase_attn(F); } SEAM(14);
    if (IN(15)) {
        pg8::Gemm g{(const bf16*)(ws + WS_ATT), (const bf16*)(ws + WS_WO), MTOK, DM, DM}; pg8::StaticOrder S; S.init(MTOK, DM, F.G, F.bid);
        EpiResid<false> E{nullptr, XR};
        pg8::gemm_phase<EpiResid<false>, pg8::StaticOrder, true, true>(F.lds, g, S, E);
    } SEAM(15);
    MOE_BLOCK(1, 16);
    if (IN(20)) { phase_moe_combine(F, XR, args.out, args.in[3], true); }
#undef MOE_BLOCK
#undef IN
#undef SEAM
}

#ifndef MK_N_LAUNCHES
#define MK_N_LAUNCHES 1
#endif
extern "C" void kernel_launch(void* const* d_in, const int* in_sizes, int n_in, void* d_out, int out_size, void* d_ws, size_t ws_size, hipStream_t stream) {
    static int grid = 0;
    if (grid == 0) {
        if (n_in != 19 || in_sizes[0] != MTOK * DM || out_size != MTOK * DM || ws_size < WS_END) { fprintf(stderr, "kernel_launch: unexpected shapes (n_in %d, in0 %d, out %d, ws %zu < %zu); nothing launched\n", n_in, n_in > 0 ? in_sizes[0] : -1, out_size, ws_size, (size_t)WS_END); grid = -1; return; }
        int dev = 0, cus = 0, per_cu = 0;
        if (hipGetDevice(&dev) != hipSuccess || hipDeviceGetAttribute(&cus, hipDeviceAttributeMultiprocessorCount, dev) != hipSuccess) { grid = -1; return; }
        if (hipFuncSetAttribute((const void*)fwd_kernel, hipFuncAttributeMaxDynamicSharedMemorySize, LDS_BYTES) != hipSuccess) { fprintf(stderr, "kernel_launch: hipFuncSetAttribute failed\n"); grid = -1; return; }
        if (hipOccupancyMaxActiveBlocksPerMultiprocessor(&per_cu, (const void*)fwd_kernel, NTHR, LDS_BYTES) != hipSuccess || per_cu < 1) { fprintf(stderr, "kernel_launch: occupancy query reports %d workgroups per CU\n", per_cu); }
        (void)hipGetLastError();
        grid = cus;
    }
    if (grid < 0) return;
    if (hipMemsetAsync((char*)d_ws + WS_CTL, 0, CTL_ZERO_BYTES, stream) != hipSuccess) return;
    Args a{};
    for (int i = 0; i < 19; ++i) a.in[i] = (const float*)d_in[i];
    a.out = (float*)d_out; a.ws = (unsigned char*)d_ws; a.pad = 0;
    static_assert(CW_BAR + MAX_BAR_REGIONS * XCD_BAR_WORDS <= (int)(CTL_ZERO_BYTES / 4), "barrier regions inside the memset region");
#ifdef PROBE_PREFIX
    const int nl = 2;
    for (int li = 0; li < nl; ++li) {
        a.ph_lo = 0; a.ph_hi = (li == 0) ? PROBE_PREFIX : NPHASE; a.li = li;
#else
    const int nl = MK_N_LAUNCHES;
    for (int li = 0; li < nl; ++li) {
        a.ph_lo = (int)((long)NPHASE * li / nl); a.ph_hi = (int)((long)NPHASE * (li + 1) / nl); a.li = li;
#endif
        hipLaunchKernelGGL(fwd_kernel, dim3(grid), dim3(NTHR), LDS_BYTES, stream, a);
        const hipError_t le = hipPeekAtLastError();
        if (le != hipSuccess) { fprintf(stderr, "kernel_launch: launch %d failed: %s\n", li, hipGetErrorName(le)); break; }
    }
}
```

```cpp
#include <hip/hip_runtime.h>
#include <cstdio>
#include <cstdint>
namespace pg8 {
#define PG8_LAS __attribute__((address_space(3)))
typedef unsigned short bf16_t;
typedef short bf16x8 __attribute__((ext_vector_type(8)));
typedef float f32x4 __attribute__((ext_vector_type(4)));
typedef unsigned u32x4 __attribute__((ext_vector_type(4)));
constexpr int BM = 256, BK = 64, HALF = 128, HTB = HALF * BK * 2  , STAGE_BYTES = 8 * HTB, NXCD = 8, WGM = 8;

__host__ __device__ __forceinline__ int lds_byte(int r, int c) { const int st = (r >> 4) * 2 + (c >> 5), rr = r & 15, cc = c & 31, ob = rr * 64 + cc * 2; return st * 1024 + (ob ^ (((ob >> 9) & 1) << 5)); }
__host__ __device__ __forceinline__ void stage_rc(int b, int& R, int& C) { const int st = b / 1024, sb = b % 1024, swz = sb ^ (((sb >> 9) & 1) << 5); R = (st >> 1) * 16 + swz / 64; C = (st & 1) * 32 + (swz % 64) / 2; }
__host__ __device__ __forceinline__ int perm32(int rho) { const int n = rho >> 4, i = rho & 15; return 8 * (i >> 2) + 4 * n + (i & 3); }

struct Unit { int pm, pn; };
struct Gemm { const bf16_t* A; const bf16_t* Bt; int M, N, K; };

struct StaticOrder {
    int nM, nN, nwg, G, c;
    __host__ __device__ void init(int M, int N, int G_, int c_) { nM = M / BM; nN = N / BM; nwg = nM * nN; G = G_; c = c_; }
    __host__ __device__ bool next(int i, Unit& u) const {
        const long L = (long)i * G + c; if (L >= nwg) return false;
        int wgid = (int)L; { const int q = nwg / NXCD, r = nwg % NXCD, xcd = wgid % NXCD, off = wgid / NXCD; wgid = (xcd < r ? xcd * (q + 1) : r * (q + 1) + (xcd - r) * q) + off; }
        const int nig = WGM * nN, gid = wgid / nig, fm = gid * WGM, gsz = (nM - fm) < WGM ? (nM - fm) : WGM;
        u.pm = fm + ((wgid % nig) % gsz); u.pn = (wgid % nig) / gsz; return true;
    }
    __device__ __forceinline__ void a_ready(const Unit&) const {}
    __device__ __forceinline__ void done(const Unit&) const {}
};

__device__ __forceinline__ unsigned cvt_pk_bf16(float lo, float hi) { unsigned r; asm volatile("v_cvt_pk_bf16_f32 %0, %1, %2" : "=v"(r) : "v"(lo), "v"(hi)); return r; }
typedef float f32x2 __attribute__((ext_vector_type(2)));
__device__ __forceinline__ f32x2 gelu_pk(f32x2 v) {
    const f32x2 av = __builtin_elementwise_abs(v), d = av * 0.2316418882f + 1.0f;
    f32x2 t; t.x = __builtin_amdgcn_rcpf(d.x); t.y = __builtin_amdgcn_rcpf(d.y);
    f32x2 q = t * 0.5307027145f + (-0.7265760135f); q = q * t + 0.7107068705f; q = q * t + (-0.142248368f); q = q * t + 0.127414796f; q = q * t;
    const f32x2 s = (v * v) * (-0.72134752044f);
    f32x2 e; e.x = __builtin_amdgcn_exp2f(s.x); e.y = __builtin_amdgcn_exp2f(s.y);
    const f32x2 m = v * (q * e), r = v - m;
    f32x2 o; o.x = v.x < 0.f ? m.x : r.x; o.y = v.y < 0.f ? m.y : r.y; return o;
}

template <int ACT  > struct EpiBf16 {
    static constexpr bool PERM = true, AFTER_DRAIN = false; static_assert(ACT == 0 || ACT == 1, "EpiBf16: ACT is 0 (none) or 1 (gelu_pk)");
    bf16_t* O; int ldc; const float* bias; int split_cols; size_t split_stride; float scale0;
    __device__ __forceinline__ void operator()(const f32x4 (&acc)[2][2][4][2], const Unit& u, int wr, int wc, int fr, int fq) const {
        const int row0 = u.pm * BM + wr * 64 + fr; int colt = u.pn * BM; bf16_t* base = O;
        float sc = 1.f; if (split_cols) { const int t = colt / split_cols; base += (size_t)t * split_stride; colt -= t * split_cols; if (t == 0) sc = scale0; }
        const int col0 = colt + wc * 32 + 8 * fq, bcol0 = u.pn * BM + wc * 32 + 8 * fq;
        f32x4 bv[2][2];
#pragma unroll
        for (int bj = 0; bj < 2; ++bj)
#pragma unroll
            for (int n = 0; n < 2; ++n) bv[bj][n] = bias ? *(const f32x4*)(bias + bcol0 + bj * HALF + 4 * n) : (f32x4){0.f, 0.f, 0.f, 0.f};
#pragma unroll
        for (int ai = 0; ai < 2; ++ai)
#pragma unroll
            for (int m = 0; m < 4; ++m) { bf16_t* rowp = base + (size_t)(row0 + ai * HALF + m * 16) * ldc + col0;
#pragma unroll
                for (int bj = 0; bj < 2; ++bj) { f32x4 v0 = acc[ai][bj][m][0] + bv[bj][0], v1 = acc[ai][bj][m][1] + bv[bj][1];
                    if (ACT == 1) { f32x2 a = gelu_pk((f32x2){v0[0], v0[1]}), b = gelu_pk((f32x2){v0[2], v0[3]}), c = gelu_pk((f32x2){v1[0], v1[1]}), d = gelu_pk((f32x2){v1[2], v1[3]});
                        v0 = (f32x4){a.x, a.y, b.x, b.y}; v1 = (f32x4){c.x, c.y, d.x, d.y}; }
                    v0 = v0 * sc; v1 = v1 * sc; u32x4 w; w.x = cvt_pk_bf16(v0[0], v0[1]); w.y = cvt_pk_bf16(v0[2], v0[3]); w.z = cvt_pk_bf16(v1[0], v1[1]); w.w = cvt_pk_bf16(v1[2], v1[3]);
                    *(u32x4*)(rowp + bj * HALF) = w; } }
    }
};
template <class Epi, class Sched, bool ALIGN_EPI = false, bool SP2 = false, bool GATHER = false>
__device__ __forceinline__ void gemm_phase(PG8_LAS unsigned char* lds, const Gemm g, const Sched& S, const Epi& E, const PG8_LAS int* rowtab = nullptr) {
    const int tid = threadIdx.x, wid = __builtin_amdgcn_readfirstlane(tid >> 6), lane = tid & 63, wr = wid >> 2, wc = wid & 3, fr = lane & 15, fq = lane >> 4;
    const int K = g.K, nt = K / BK;
    unsigned voffA[2], voffB[2]; int gR[2], gC[2];
#pragma unroll
    for (int i = 0; i < 2; ++i) { int R, C; stage_rc(tid * 16 + i * 8192, R, C); const int Rb = Epi::PERM ? ((R & ~31) + perm32(R & 31)) : R;
        voffA[i] = (unsigned)(R * K + C) * 2u; voffB[i] = (unsigned)(Rb * K + C) * 2u; gR[i] = R; gC[i] = C; }
    unsigned vC[2][2] = {{0u, 0u}, {0u, 0u}}, vN[2][2] = {{0u, 0u}, {0u, 0u}};
#define PG8_ROWS(dst, ui_) do { _Pragma("unroll") for (int _h = 0; _h < 2; ++_h) _Pragma("unroll") for (int _i = 0; _i < 2; ++_i) \
        dst[_h][_i] = (unsigned)(rowtab[(ui_) * 256 + _h * 128 + gR[_i]] * K + gC[_i]) * 2u; } while (0)
    const size_t kstep = (size_t)(BK * 2);
    const size_t hstep = (size_t)HALF * K * 2;
    const size_t tstep = 2 * hstep;
    const unsigned ldsw = (unsigned)wid * 1024u;
    const int aoff = lds_byte(wr * 64 + fr, fq * 8), boff = lds_byte(wc * 32 + fr, fq * 8);
#define PG8_SA(b, h) (((b) * 2 + (h)) * HTB)
#define PG8_SB(b, h) ((4 + (b) * 2 + (h)) * HTB)
#define PG8_STAGE(bufoff, gbase, voff) do { _Pragma("unroll") for (int _i = 0; _i < 2; ++_i) \
        __builtin_amdgcn_global_load_lds((const unsigned*)((const char*)(gbase) + (voff)[_i]), (PG8_LAS unsigned*)(lds + (bufoff) + ldsw + _i * 8192), 16, 0, 0); } while (0)
#define PG8_STGA(bufoff, abase, half, V) do { _Pragma("unroll") for (int _i = 0; _i < 2; ++_i) \
        __builtin_amdgcn_global_load_lds((const unsigned*)((const char*)(abase) + (GATHER ? (size_t)V[half][_i] : (size_t)((half) ? hstep : 0) + voffA[_i])), (PG8_LAS unsigned*)(lds + (bufoff) + ldsw + _i * 8192), 16, 0, 0); } while (0)
#define PG8_LDA(dst, b, h) do { _Pragma("unroll") for (int m = 0; m < 4; ++m) _Pragma("unroll") for (int k = 0; k < 2; ++k) dst[m][k] = *(const PG8_LAS bf16x8*)(lds + PG8_SA(b, h) + aoff + m * 2048 + k * 1024); } while (0)
#define PG8_LDB(dst, b, h) do { _Pragma("unroll") for (int n = 0; n < 2; ++n) _Pragma("unroll") for (int k = 0; k < 2; ++k) dst[n][k] = *(const PG8_LAS bf16x8*)(lds + PG8_SB(b, h) + boff + n * 2048 + k * 1024); } while (0)
#define PG8_MMA(ai, bj, At, Bt) do { __builtin_amdgcn_s_setprio(1); _Pragma("unroll") for (int m = 0; m < 4; ++m) _Pragma("unroll") for (int n = 0; n < 2; ++n) _Pragma("unroll") for (int k = 0; k < 2; ++k) \
        acc[ai][bj][m][n] = __builtin_amdgcn_mfma_f32_16x16x32_bf16(Bt[n][k], At[m][k], acc[ai][bj][m][n], 0, 0, 0); __builtin_amdgcn_s_setprio(0); } while (0)
#define PG8_WAIT_V(n) asm volatile("s_waitcnt vmcnt(" #n ")" ::: "memory")
#define PG8_WAIT_L(n) asm volatile("s_waitcnt lgkmcnt(" #n ")" ::: "memory")
#define PG8_BAR __builtin_amdgcn_s_barrier()
#define PG8_SCHED __builtin_amdgcn_sched_barrier(0)
    Unit cur, nxt; int ui = 0;
    if (!S.next(0, cur)) return;
    f32x4 acc[2][2][4][2];
#pragma unroll
    for (int a = 0; a < 2; ++a)
#pragma unroll
        for (int b = 0; b < 2; ++b)
#pragma unroll
            for (int m = 0; m < 4; ++m)
#pragma unroll
                for (int n = 0; n < 2; ++n) acc[a][b][m][n] = (f32x4){0.f, 0.f, 0.f, 0.f};
    bf16x8 At[4][2], B0[2][2], B1[2][2];
    const char* cA = (const char*)g.A + (GATHER ? (size_t)0 : (size_t)cur.pm * tstep); if constexpr (GATHER) PG8_ROWS(vC, 0);
    const char* cB = (const char*)g.Bt + (size_t)cur.pn * tstep;
    S.a_ready(cur);
    if constexpr (SP2) {
        PG8_STAGE(PG8_SB(0, 0), cB, voffB); PG8_STAGE(PG8_SB(0, 1), cB + hstep, voffB); PG8_STGA(PG8_SA(0, 0), cA, 0, vC); PG8_STGA(PG8_SA(0, 1), cA, 1, vC);
        if (wr == 1) PG8_BAR;
        PG8_WAIT_V(2); PG8_BAR;
        PG8_STAGE(PG8_SB(1, 0), cB + kstep, voffB); PG8_STGA(PG8_SA(1, 0), cA + kstep, 0, vC); PG8_STAGE(PG8_SB(1, 1), cB + hstep + kstep, voffB);
        PG8_WAIT_V(6); PG8_BAR;
    } else {
        PG8_STAGE(PG8_SB(0, 0), cB, voffB); PG8_STGA(PG8_SA(0, 0), cA, 0, vC); PG8_STAGE(PG8_SB(0, 1), cB + hstep, voffB); PG8_STGA(PG8_SA(0, 1), cA, 1, vC);
        if (wr == 1) PG8_BAR;
        PG8_WAIT_V(4); PG8_BAR;
        PG8_STAGE(PG8_SB(1, 0), cB + kstep, voffB); PG8_STGA(PG8_SA(1, 0), cA + kstep, 0, vC); PG8_STAGE(PG8_SB(1, 1), cB + hstep + kstep, voffB);
        PG8_WAIT_V(6); PG8_BAR;
    }
    for (;;) {
        const bool has_next = S.next(ui + 1, nxt);
        const char* nA = (has_next && !GATHER) ? (const char*)g.A + (size_t)nxt.pm * tstep : cA;
        if constexpr (GATHER) { if (has_next) PG8_ROWS(vN, ui + 1); else { _Pragma("unroll") for (int _h = 0; _h < 2; ++_h) _Pragma("unroll") for (int _i = 0; _i < 2; ++_i) vN[_h][_i] = vC[_h][_i]; } }
        const char* nB = has_next ? (const char*)g.Bt + (size_t)nxt.pn * tstep : cB;
        for (int t = 0; t < nt; t += 2) {
            const bool last = (t == nt - 2);
            unsigned vX[2][2];
            _Pragma("unroll") for (int _h = 0; _h < 2; ++_h) _Pragma("unroll") for (int _i = 0; _i < 2; ++_i) vX[_h][_i] = last ? vN[_h][_i] : vC[_h][_i];
            const char* a1 = cA + (size_t)(t + 1) * kstep;
            const char* a2 = last ? nA : cA + (size_t)(t + 2) * kstep; const char* b2 = last ? nB : cB + (size_t)(t + 2) * kstep;
            const char* a3 = a2 + kstep; const char* b3 = b2 + kstep;
            if (last && has_next) S.a_ready(nxt);
            if constexpr (SP2) {
            PG8_LDB(B0, 0, 0); PG8_LDB(B1, 0, 1); PG8_SCHED; PG8_LDA(At, 0, 0); PG8_STGA(PG8_SA(1, 1), a1, 1, vC);
            PG8_WAIT_V(8); PG8_WAIT_L(0); PG8_BAR; PG8_MMA(0, 0, At, B0); PG8_MMA(0, 1, At, B1); PG8_BAR; PG8_SCHED;
            PG8_LDA(At, 0, 1); PG8_STAGE(PG8_SB(0, 0), b2, voffB); PG8_STAGE(PG8_SB(0, 1), b2 + hstep, voffB); PG8_STGA(PG8_SA(0, 0), a2, 0, vX);
            PG8_WAIT_V(8); PG8_WAIT_L(0); PG8_BAR; PG8_MMA(1, 0, At, B0); PG8_MMA(1, 1, At, B1); PG8_BAR; PG8_SCHED;
            PG8_LDB(B0, 1, 0); PG8_LDB(B1, 1, 1); PG8_SCHED; PG8_LDA(At, 1, 0); PG8_STGA(PG8_SA(0, 1), a2, 1, vX);
            PG8_WAIT_V(8); PG8_WAIT_L(0); PG8_BAR; PG8_MMA(0, 0, At, B0); PG8_MMA(0, 1, At, B1); PG8_BAR; PG8_SCHED;
            PG8_LDA(At, 1, 1); PG8_STAGE(PG8_SB(1, 0), b3, voffB); PG8_STAGE(PG8_SB(1, 1), b3 + hstep, voffB); PG8_STGA(PG8_SA(1, 0), a3, 0, vX);
            PG8_WAIT_V(8); PG8_WAIT_L(0); PG8_BAR; PG8_MMA(1, 0, At, B0); PG8_MMA(1, 1, At, B1); PG8_BAR; PG8_SCHED;
            } else {
            PG8_LDB(B0, 0, 0); PG8_SCHED; PG8_LDA(At, 0, 0); PG8_STGA(PG8_SA(1, 1), a1, 1, vC);
            PG8_WAIT_L(8); PG8_BAR; PG8_WAIT_L(0); PG8_MMA(0, 0, At, B0); PG8_BAR; PG8_SCHED;
            PG8_LDB(B1, 0, 1); PG8_STAGE(PG8_SB(0, 0), b2, voffB);
            PG8_BAR; PG8_WAIT_L(0); PG8_MMA(0, 1, At, B1); PG8_BAR;
            PG8_LDA(At, 0, 1); PG8_STGA(PG8_SA(0, 0), a2, 0, vX);
            PG8_BAR; PG8_WAIT_L(0); PG8_MMA(1, 0, At, B0); PG8_BAR; PG8_SCHED;
            PG8_STAGE(PG8_SB(0, 1), b2 + hstep, voffB);
            PG8_WAIT_V(6); PG8_BAR; PG8_MMA(1, 1, At, B1); PG8_BAR;
            PG8_LDB(B0, 1, 0); PG8_SCHED; PG8_LDA(At, 1, 0); PG8_STGA(PG8_SA(0, 1), a2, 1, vX);
            PG8_WAIT_L(8); PG8_BAR; PG8_WAIT_L(0); PG8_MMA(0, 0, At, B0); PG8_BAR; PG8_SCHED;
            PG8_LDB(B1, 1, 1); PG8_STAGE(PG8_SB(1, 0), b3, voffB);
            PG8_BAR; PG8_WAIT_L(0); PG8_MMA(0, 1, At, B1); PG8_BAR;
            PG8_LDA(At, 1, 1); PG8_STGA(PG8_SA(1, 0), a3, 0, vX);
            PG8_BAR; PG8_WAIT_L(0); PG8_MMA(1, 0, At, B0); PG8_BAR; PG8_SCHED;
            PG8_STAGE(PG8_SB(1, 1), b3 + hstep, voffB);
            PG8_WAIT_V(6); PG8_BAR; PG8_MMA(1, 1, At, B1); PG8_BAR;
            }
        }
        if constexpr (ALIGN_EPI) { if (wr == 0) PG8_BAR; }
        if constexpr (!Epi::AFTER_DRAIN) { E(acc, cur, wr, wc, fr, fq); S.done(cur); }
        if (!has_next) break;
#pragma unroll
        for (int a = 0; a < 2; ++a)
#pragma unroll
            for (int b = 0; b < 2; ++b)
#pragma unroll
                for (int m = 0; m < 4; ++m)
#pragma unroll
                    for (int n = 0; n < 2; ++n) acc[a][b][m][n] = (f32x4){0.f, 0.f, 0.f, 0.f};
        cur = nxt; cA = nA; cB = nB; ++ui;
        if constexpr (GATHER) { _Pragma("unroll") for (int _h = 0; _h < 2; ++_h) _Pragma("unroll") for (int _i = 0; _i < 2; ++_i) vC[_h][_i] = vN[_h][_i]; }
        if constexpr (ALIGN_EPI) { if (wr == 1) PG8_BAR; }
    }
    PG8_WAIT_V(0);
    if constexpr (!ALIGN_EPI) { if (wr == 0) PG8_BAR; }
    PG8_BAR;
    if constexpr (Epi::AFTER_DRAIN) { E.fused(acc, cur, wr, wc, fr, fq, lds, wid, lane); S.done(cur); }
#undef PG8_SA
#undef PG8_SB
#undef PG8_STAGE
#undef PG8_STGA
#undef PG8_ROWS
#undef PG8_LDA
#undef PG8_LDB
#undef PG8_MMA
#undef PG8_WAIT_V
#undef PG8_WAIT_L
#undef PG8_BAR
#undef PG8_SCHED
}
}
#define LAS __attribute__((address_space(3)))
#define DI __device__ __forceinline__
typedef unsigned short bf16;
typedef unsigned v4u __attribute__((ext_vector_type(4)));
typedef unsigned v2u __attribute__((ext_vector_type(2)));
typedef float f32x4 __attribute__((ext_vector_type(4)));
typedef short bf16x8 __attribute__((ext_vector_type(8)));
#define LDS_WAIT() asm volatile("s_waitcnt lgkmcnt(0)" ::: "memory")
#define VM_WAIT() asm volatile("s_waitcnt vmcnt(0)" ::: "memory")
DI unsigned f2bf(float f) { unsigned u = __builtin_bit_cast(unsigned, f); return (u + 0x7fffu + ((u >> 16) & 1u)) >> 16; }
typedef float f32x2_t __attribute__((ext_vector_type(2))); typedef __bf16 bf16x2_t __attribute__((ext_vector_type(2)));
DI unsigned pk2(float lo, float hi) { f32x2_t v = {lo, hi}; bf16x2_t b = __builtin_convertvector(v, bf16x2_t); return __builtin_bit_cast(unsigned, b); }
DI float bf2f(unsigned b) { return __builtin_bit_cast(float, b << 16); }
DI float bflo(unsigned w) { return __builtin_bit_cast(float, w << 16); }
DI float bfhi(unsigned w) { return __builtin_bit_cast(float, w & 0xffff0000u); }
DI float fexp(float x) { return __builtin_amdgcn_exp2f(x * 1.4426950408889634f); }
DI float flog(float x) { return __builtin_amdgcn_logf(x) * 0.6931471805599453f; }
DI float frcp(float x) { return __builtin_amdgcn_rcpf(x); }
DI float sigmoidf_(float x) { return frcp(1.f + fexp(-x)); }
DI float siluf_(float x) { return x * sigmoidf_(x); }
DI float gelu_tanh(float x) { const float u = 0.7978845608028654f * (x + 0.044715f * x * x * x); return x * sigmoidf_(2.f * u); }
DI float wave_sum(float v) {
#pragma unroll
    for (int o = 1; o < 64; o <<= 1) v += __shfl_xor(v, o);
    return v;
}
DI float wave_max(float v) {
#pragma unroll
    for (int o = 1; o < 64; o <<= 1) v = fmaxf(v, __shfl_xor(v, o));
    return v;
}
DI int red16_idx(int lane) { return 8 * ((lane >> 5) & 1) + 4 * ((lane >> 4) & 1) + 2 * ((lane >> 3) & 1) + ((lane >> 2) & 1); }
DI float red16(const float (&o)[16], int lane) {
    const bool b32 = lane & 32, b16 = lane & 16, b8 = lane & 8, b4 = lane & 4;
    float a8[8], a4[4], a2[2], a1;
#pragma unroll
    for (int j = 0; j < 8; ++j) { const float send = b32 ? o[j] : o[j + 8], keep = b32 ? o[j + 8] : o[j]; a8[j] = keep + __shfl_xor(send, 32); }
#pragma unroll
    for (int j = 0; j < 4; ++j) { const float send = b16 ? a8[j] : a8[j + 4], keep = b16 ? a8[j + 4] : a8[j]; a4[j] = keep + __shfl_xor(send, 16); }
#pragma unroll
    for (int j = 0; j < 2; ++j) { const float send = b8 ? a4[j] : a4[j + 2], keep = b8 ? a4[j + 2] : a4[j]; a2[j] = keep + __shfl_xor(send, 8); }
    { const float send = b4 ? a2[0] : a2[1], keep = b4 ? a2[1] : a2[0]; a1 = keep + __shfl_xor(send, 4); }
    a1 += __shfl_xor(a1, 2); a1 += __shfl_xor(a1, 1);
    return a1;
}
#define XB_TMO      128
#define XB_XCNT(j)  (256  + 64 * (j))
#define XB_XSUB(j)  (1280 + 64 * (j))
#define XB_XGEN(j)  (2304 + 64 * (j))
#define XB_TOP      3328
#define XB_TOPGEN   3392
#define XCD_BAR_WORDS 3456
#define XB_SPIN_CAP (1u << 18)

__device__ __forceinline__ unsigned xb_ld(unsigned* p)              { return __hip_atomic_load(p, __ATOMIC_RELAXED, __HIP_MEMORY_SCOPE_AGENT); }
__device__ __forceinline__ unsigned xb_add(unsigned* p, unsigned v) { return __hip_atomic_fetch_add(p, v, __ATOMIC_RELAXED, __HIP_MEMORY_SCOPE_AGENT); }
__device__ __forceinline__ unsigned xb_xcc_id() { return (unsigned)__builtin_amdgcn_s_getreg((3 << 11) | 20) & 0xFu; }
#define XB_SPIN(cond, bar) do { unsigned _sp = 0; while (cond) { __builtin_amdgcn_s_sleep(1); \
    if ((++_sp & 255u) == 0u) { if (xb_ld(&(bar)[XB_TMO])) break; if (_sp > XB_SPIN_CAP) { atomicAdd(&(bar)[XB_TMO], 1u); break; } } } } while (0)

struct XcdBarrier {
    unsigned* bar; unsigned x;
    volatile LAS unsigned* st;
};

__device__ __forceinline__ XcdBarrier xcd_barrier_post(unsigned* bar, volatile LAS unsigned* st) {
    XcdBarrier b; b.bar = bar; b.x = xb_xcc_id(); b.st = st;
    if (threadIdx.x == 0) (void)xb_add(&bar[XB_XCNT(b.x)], 1u);
    return b;
}
__device__ __forceinline__ void xcd_barrier_complete(unsigned* bar, unsigned x, unsigned& nloc, unsigned& nx) {
    const unsigned G = gridDim.x * gridDim.y * gridDim.z;
    unsigned sum, cnt, mine, sp = 0u;
    for (;;) {
        sum = 0u; cnt = 0u; mine = 0u;
#pragma unroll
        for (unsigned j = 0; j < 16; ++j) { const unsigned c = xb_ld(&bar[XB_XCNT(j)]); sum += c; cnt += (c > 0u) ? 1u : 0u; mine = (j == x) ? c : mine; }
        if (sum == G) break;
        __builtin_amdgcn_s_sleep(1);
        if ((++sp & 255u) == 0u) { if (xb_ld(&bar[XB_TMO])) break; if (sp > XB_SPIN_CAP) { atomicAdd(&bar[XB_TMO], 1u); break; } }
    }
    nloc = mine > 0u ? mine : 1u; nx = cnt > 0u ? cnt : 1u;
}

__device__ __forceinline__ void xcd_barrier(const XcdBarrier& b) {
    asm volatile("s_waitcnt vmcnt(0)" ::: "memory");
    __syncthreads();
    if (threadIdx.x == 0) {
        unsigned* bar = b.bar;
        __builtin_amdgcn_s_waitcnt(0);
        unsigned nloc = b.st[0], nx = b.st[1];
        if (nloc == 0u) { xcd_barrier_complete(bar, b.x, nloc, nx); b.st[0] = nloc; b.st[1] = nx; }
        const unsigned old = xb_add(&bar[XB_XSUB(b.x)], 1u);
        const unsigned gen = old / nloc;
        if (old + 1u == (gen + 1u) * nloc) {
            __builtin_amdgcn_fence(__ATOMIC_RELEASE, "agent");
            asm volatile("s_waitcnt vmcnt(0)" ::: "memory");
            const unsigned og = xb_add(&bar[XB_TOP], 1u);
            const unsigned tg = og / nx;
            if (og + 1u == (tg + 1u) * nx) xb_add(&bar[XB_TOPGEN], 1u);
            else XB_SPIN(xb_ld(&bar[XB_TOPGEN]) == tg, bar);
            __builtin_amdgcn_fence(__ATOMIC_ACQUIRE, "agent");
            xb_add(&bar[XB_XGEN(b.x)], 1u);
            asm volatile("s_waitcnt vmcnt(0)" ::: "memory");
        } else {
            XB_SPIN(xb_ld(&bar[XB_XGEN(b.x)]) == gen, bar);
            __builtin_amdgcn_fence(__ATOMIC_ACQUIRE, "agent");
            asm volatile("s_waitcnt vmcnt(0)" ::: "memory");
        }
    }
    __syncthreads();
}
#ifndef PROBE_DUP
#define PROBE_DUP (-1)
#endif
constexpr int NWAVES = 8, NTHR = 512;
constexpr int BATCH = 2, SEQ = 8192, DM = 1024, MTOK = BATCH * SEQ;
constexpr int NIN = 3584;
constexpr int AW = 512;
constexpr int NEXP = 16, DFF = 1024, CAP = 1024, NROWS = BATCH * NEXP * CAP;
constexpr int NSC = 32, SCLEN = 256;
constexpr int NHEAD = 16, HD = 64, NQKV = 3072;
constexpr float EPS = 1e-6f;
constexpr int NPHASE = 21;

constexpr size_t MiB = 1u << 20;
constexpr size_t WS_CTL = 0, CTL_ZERO_BYTES = 1 * MiB;
constexpr size_t WS_AFF = 1 * MiB;
constexpr size_t WS_POS = 2 * MiB;
constexpr size_t WS_IDX = 3 * MiB;
constexpr size_t WS_GATE = 3 * MiB + 256 * 1024;
constexpr size_t WS_DEC = 3 * MiB + 512 * 1024;
constexpr size_t WS_LB = 4 * MiB;
constexpr size_t WS_BT = 4 * MiB + 64 * 1024;
constexpr size_t WS_WIN = 8 * MiB;
constexpr size_t WS_WOUT = 15 * MiB;
constexpr size_t WS_WQKV = 17 * MiB;
constexpr size_t WS_WO = 23 * MiB;
constexpr size_t WS_WSB = 25 * MiB;
constexpr size_t WS_WGU = 32 * MiB;
constexpr size_t WS_WDN = 96 * MiB;
constexpr size_t WS_H = 128 * MiB;
constexpr size_t WS_R1 = 160 * MiB;
constexpr size_t WS_U = WS_R1, WS_GV = WS_R1 + 16 * MiB, WS_Q = WS_R1 + 32 * MiB, WS_V = WS_R1 + 48 * MiB, WS_G = WS_R1 + 64 * MiB;
constexpr size_t WS_LFF = WS_R1 + 80 * MiB, WS_LFB = WS_R1 + 112 * MiB;
constexpr size_t WS_CAT = WS_R1 + 144 * MiB;
constexpr size_t WS_ST = WS_R1 + 176 * MiB;
constexpr size_t WS_ODIR = WS_R1 + 208 * MiB;
constexpr size_t WS_XE = WS_R1, WS_Y = WS_R1;
constexpr size_t WS_HMID = WS_R1 + 64 * MiB;
constexpr size_t WS_QKV = WS_R1;
constexpr size_t WS_ATT = WS_R1 + 96 * MiB;
constexpr size_t WS_KF = WS_R1 + 128 * MiB;
constexpr size_t WS_VF = WS_R1 + 224 * MiB;
constexpr size_t WS_XR = WS_R1 + 320 * MiB;
constexpr size_t WS_END = WS_R1 + 352 * MiB;
constexpr int CW_BAR = 4096;
constexpr int MAX_BAR_REGIONS = 24;

constexpr int RING_BYTES = 131072;
constexpr int LDS_BYTES = 147456;
constexpr int LDSCTL_OFF = LDS_BYTES - 512, MISC_OFF = LDSCTL_OFF + 320;

struct Args { const float* in[19]; float* out; unsigned char* ws; int ph_lo, ph_hi, li, pad; };

struct Frame {
    LAS unsigned char* lds;
    volatile LAS unsigned* MISC;
    int tid, lane, wave, G, bid, gw, NGW;
    unsigned char* ws;
};

template <int NPN_> struct GroupedOrder {
    int G, c;
    DI bool next(int i, pg8::Unit& u) const {
        if (G == 256) {
            const int x = c & 7, k = c >> 3;
            if (i >= NPN_ / 2) return false;
            const int e = (NPN_ == 8) ? 4 * i + (x >> 1) : 8 * i + x;
            u.pm = e * 8 + (k & 7); u.pn = e * NPN_ + ((NPN_ == 8) ? 4 * (x & 1) + (k >> 3) : (k >> 3)); return true;
        }
        const int L = i * G + c; if (L >= 16 * 8 * NPN_) return false;
        const int e = L / (8 * NPN_), w = L % (8 * NPN_);
        u.pm = e * 8 + (w & 7); u.pn = e * NPN_ + (w >> 3); return true;
    }
    DI void a_ready(const pg8::Unit&) const {}
    DI void done(const pg8::Unit&) const {}
};

typedef _Float16 h16x8 __attribute__((ext_vector_type(8)));
struct EpiInProj {
    static constexpr bool PERM = true, AFTER_DRAIN = false;
    bf16 *U, *GV, *Q, *V, *G; _Float16 *LFf, *LFb; const float* LB;
    DI void operator()(const pg8::f32x4 (&acc)[2][2][4][2], const pg8::Unit& u, int wr, int wc, int fr, int fq) const {
        const int seg = u.pn >> 1;
        const int row0 = u.pm * 256 + wr * 64 + fr, lc0 = (u.pn & 1) * 256 + wc * 32 + 8 * fq;
#pragma unroll
        for (int bj = 0; bj < 2; ++bj) {
            const int lc = lc0 + bj * 128;
            float lb[8];
            if (seg == 3 || seg == 4) {
#pragma unroll
                for (int j = 0; j < 8; ++j) lb[j] = LB[(seg - 3) * 512 + lc + j];
            }
#pragma unroll
            for (int ai = 0; ai < 2; ++ai)
#pragma unroll
                for (int m = 0; m < 4; ++m) {
                    const size_t off = (size_t)(row0 + ai * 128 + m * 16) * 512 + lc;
                    float v[8];
#pragma unroll
                    for (int j = 0; j < 8; ++j) v[j] = acc[ai][bj][m][j >> 2][j & 3];
                    if (seg == 3 || seg == 4) {
#pragma unroll
                        for (int j = 0; j < 8; ++j) v[j] = flog(lb[j] + (1.f - lb[j]) * sigmoidf_(v[j]));
                        _Float16* o = (seg == 3 ? LFf : LFb) + off;
                        h16x8 hv;
#pragma unroll
                        for (int j = 0; j < 8; ++j) hv[j] = (_Float16)v[j];
                        *(h16x8*)o = hv;
                    } else {
                        bf16* o;
                        if (seg == 0) { o = U;
#pragma unroll
                            for (int j = 0; j < 8; ++j) v[j] = gelu_tanh(v[j]);
                        } else if (seg == 1) { o = GV;
#pragma unroll
                            for (int j = 0; j < 8; ++j) v[j] = gelu_tanh(v[j]);
                        } else if (seg == 2) { o = Q;
#pragma unroll
                            for (int j = 0; j < 8; ++j) v[j] = siluf_(v[j]);
                        } else if (seg == 5) { o = V;
                        } else { o = G;
#pragma unroll
                            for (int j = 0; j < 8; ++j) v[j] = sigmoidf_(v[j]);
                        }
                        v4u w; w.x = pk2(v[0], v[1]); w.y = pk2(v[2], v[3]); w.z = pk2(v[4], v[5]); w.w = pk2(v[6], v[7]);
                        *(v4u*)(o + off) = w;
                    }
                }
        }
    }
};
template <bool BASE_F32> struct EpiResid {
    static constexpr bool PERM = true, AFTER_DRAIN = false;
    const float* basef; bf16* XR;
    DI void operator()(const pg8::f32x4 (&acc)[2][2][4][2], const pg8::Unit& u, int wr, int wc, int fr, int fq) const {
        const int row0 = u.pm * 256 + wr * 64 + fr, col0 = u.pn * 256 + wc * 32 + 8 * fq;
#pragma unroll
        for (int ai = 0; ai < 2; ++ai)
#pragma unroll
            for (int m = 0; m < 4; ++m) { const size_t ro = (size_t)(row0 + ai * 128 + m * 16) * DM + col0;
#pragma unroll
                for (int bj = 0; bj < 2; ++bj) { const size_t o = ro + bj * 128;
                    float v[8];
                    if (BASE_F32) { const f32x4 b0 = *(const f32x4*)(basef + o), b1 = *(const f32x4*)(basef + o + 4);
                        v[0] = b0.x; v[1] = b0.y; v[2] = b0.z; v[3] = b0.w; v[4] = b1.x; v[5] = b1.y; v[6] = b1.z; v[7] = b1.w; }
                    else { const v4u w = *(const v4u*)(XR + o); v[0] = bflo(w.x); v[1] = bfhi(w.x); v[2] = bflo(w.y); v[3] = bfhi(w.y); v[4] = bflo(w.z); v[5] = bfhi(w.z); v[6] = bflo(w.w); v[7] = bfhi(w.w); }
#pragma unroll
                    for (int j = 0; j < 8; ++j) v[j] += acc[ai][bj][m][j >> 2][j & 3];
                    v4u w; w.x = pk2(v[0], v[1]); w.y = pk2(v[2], v[3]); w.z = pk2(v[4], v[5]); w.w = pk2(v[6], v[7]);
                    *(v4u*)(XR + o) = w; } }
    }
};
struct EpiGateUp {
    static constexpr bool PERM = true, AFTER_DRAIN = false;
    bf16* H;
    DI void operator()(const pg8::f32x4 (&acc)[2][2][4][2], const pg8::Unit& u, int wr, int wc, int fr, int fq) const {
        const int pnl = u.pn & 7;
        const int row0 = u.pm * 256 + wr * 64 + fr, col0 = pnl * 128 + wc * 32 + 8 * fq;
#pragma unroll
        for (int ai = 0; ai < 2; ++ai)
#pragma unroll
            for (int m = 0; m < 4; ++m) {
                float v[8];
#pragma unroll
                for (int j = 0; j < 8; ++j) v[j] = siluf_(acc[ai][0][m][j >> 2][j & 3]) * acc[ai][1][m][j >> 2][j & 3];
                v4u w; w.x = pk2(v[0], v[1]); w.y = pk2(v[2], v[3]); w.z = pk2(v[4], v[5]); w.w = pk2(v[6], v[7]);
                *(v4u*)(H + (size_t)(row0 + ai * 128 + m * 16) * DFF + col0) = w;
            }
    }
};
struct EpiDown {
    static constexpr bool PERM = true, AFTER_DRAIN = false;
    bf16* Y; const float* gate;
    DI void operator()(const pg8::f32x4 (&acc)[2][2][4][2], const pg8::Unit& u, int wr, int wc, int fr, int fq) const {
        const int pnl = u.pn & 3;
        const int row0 = u.pm * 256 + wr * 64 + fr, col0 = pnl * 256 + wc * 32 + 8 * fq;
#pragma unroll
        for (int ai = 0; ai < 2; ++ai)
#pragma unroll
            for (int m = 0; m < 4; ++m) { const int row = row0 + ai * 128 + m * 16; const float g = gate[row];
#pragma unroll
                for (int bj = 0; bj < 2; ++bj) {
                    float v[8];
#pragma unroll
                    for (int j = 0; j < 8; ++j) v[j] = acc[ai][bj][m][j >> 2][j & 3] * g;
                    v4u w; w.x = pk2(v[0], v[1]); w.y = pk2(v[2], v[3]); w.z = pk2(v[4], v[5]); w.w = pk2(v[6], v[7]);
                    *(v4u*)(Y + (size_t)row * DM + col0 + bj * 128) = w; } }
    }
};
struct EpiQKV {
    static constexpr bool PERM = true, AFTER_DRAIN = false;
    bf16* O;
    DI void operator()(const pg8::f32x4 (&acc)[2][2][4][2], const pg8::Unit& u, int wr, int wc, int fr, int fq) const {
        const float sc = (u.pn < 4) ? 0.125f * 1.4426950408889634f : 1.f;
        const int row0 = u.pm * 256 + wr * 64 + fr, col0 = u.pn * 256 + wc * 32 + 8 * fq;
#pragma unroll
        for (int ai = 0; ai < 2; ++ai)
#pragma unroll
            for (int m = 0; m < 4; ++m)
#pragma unroll
                for (int bj = 0; bj < 2; ++bj) {
                    float v[8];
#pragma unroll
                    for (int j = 0; j < 8; ++j) v[j] = acc[ai][bj][m][j >> 2][j & 3] * sc;
                    v4u w; w.x = pk2(v[0], v[1]); w.y = pk2(v[2], v[3]); w.z = pk2(v[4], v[5]); w.w = pk2(v[6], v[7]);
                    *(v4u*)(O + (size_t)(row0 + ai * 128 + m * 16) * NQKV + col0 + bj * 128) = w; }
    }
};

constexpr int TSCR_BYTES = (64 * 68 + 32) * 4;
DI void transpose_item(const float* W, int K, int N, bf16* WT, LAS float* scr, int k0, int n0, int drow0, int lane) {
    const int kr = lane >> 4, c4 = (lane & 15) * 4;
    f32x4 t[16];
#pragma unroll
    for (int i = 0; i < 16; ++i) t[i] = *(const f32x4*)(W + (size_t)(k0 + 4 * i + kr) * N + n0 + c4);
#pragma unroll
    for (int i = 0; i < 16; ++i) { const int k = 4 * i + kr; *(LAS f32x4*)(scr + k * 68 + 4 * (k >> 3) + c4) = t[i]; }
    LDS_WAIT(); asm volatile("" ::: "memory");
    const int c = lane & 7;
#pragma unroll
    for (int j = 0; j < 8; ++j) { const int n = (lane >> 3) + 8 * j; const LAS float* s = scr + (8 * c) * 68 + 4 * c + n;
        v4u o; o.x = pk2(s[0 * 68], s[1 * 68]); o.y = pk2(s[2 * 68], s[3 * 68]); o.z = pk2(s[4 * 68], s[5 * 68]); o.w = pk2(s[6 * 68], s[7 * 68]);
        *(v4u*)(WT + (size_t)(drow0 + n) * K + k0 + 8 * c) = o; }
    LDS_WAIT(); asm volatile("" ::: "memory");
}
DI void transpose_matrix(Frame& F, const float* W, int K, int N, bf16* WT) {
    LAS float* scr = (LAS float*)(F.lds + F.wave * TSCR_BYTES);
    const int nblk = N / 64, nitems = (K / 64) * nblk;
    for (int it = F.gw; it < nitems; it += F.NGW) { const int kb = it / nblk, nb = it % nblk; transpose_item(W, K, N, WT, scr, 64 * kb, 64 * nb, 64 * nb, F.lane); }
}
DI void convert_moe_weights(Frame& F, const float* wg, const float* wu, const float* wd, int layer, int nskip = 0) {
    LAS float* scr = (LAS float*)(F.lds + F.wave * TSCR_BYTES);
    bf16* WGU = (bf16*)(F.ws + WS_WGU); bf16* WDN = (bf16*)(F.ws + WS_WDN);
    if (F.bid < nskip) return;
    for (int it = F.gw - nskip * NWAVES; it < 3 * 16 * 256; it += F.NGW - nskip * NWAVES) {
        const int mat = it / 4096, rem = it % 4096, e = rem / 256, r = rem % 256, kb = r / 16, nb = r % 16, n0 = 64 * nb;
        const size_t so = ((size_t)layer * 16 + e) * 1024 * 1024;
        if (mat == 0) transpose_item(wg + so, 1024, 1024, WGU + (size_t)e * 2048 * 1024, scr, 64 * kb, n0, (n0 >> 7) * 256 + (n0 & 127), F.lane);
        else if (mat == 1) transpose_item(wu + so, 1024, 1024, WGU + (size_t)e * 2048 * 1024, scr, 64 * kb, n0, (n0 >> 7) * 256 + 128 + (n0 & 127), F.lane);
        else transpose_item(wd + so, 1024, 1024, WDN + (size_t)e * 1024 * 1024, scr, 64 * kb, n0, n0, F.lane);
    }
}
DI void rms_row(const float* xrow, const float* g, f32x4 (&v)[4], int lane) {
    const f32x4* xr = (const f32x4*)xrow + lane; float s = 0.f;
#pragma unroll
    for (int j = 0; j < 4; ++j) { v[j] = xr[64 * j]; s += (v[j].x * v[j].x + v[j].y * v[j].y) + (v[j].z * v[j].z + v[j].w * v[j].w); }
    const float rstd = 1.f / sqrtf(wave_sum(s) * (1.f / DM) + EPS);
    const f32x4* gr = (const f32x4*)g + lane;
#pragma unroll
    for (int j = 0; j < 4; ++j) v[j] = v[j] * rstd * gr[64 * j];
}
DI void store_row_bf16(bf16* orow, const f32x4 (&v)[4], int lane) {
    v2u* o8 = (v2u*)orow + lane;
#pragma unroll
    for (int j = 0; j < 4; ++j) { v2u w; w.x = pk2(v[j].x, v[j].y); w.y = pk2(v[j].z, v[j].w); o8[64 * j] = w; }
}
DI int t5_bucket(int rel) {
    const int n = rel < 0 ? -rel : rel;
    int val;
    if (n < 8) val = n;
    else { const float sc = logf((float)n / 8.f) / 4.852030263919617f; int lg = 8 + (int)(sc * 8.f); val = lg < 15 ? lg : 15; }
    return (rel > 0 ? 16 : 0) + val;
}

typedef float f32x16 __attribute__((ext_vector_type(16)));
#define MFMA32(a, b, c) __builtin_amdgcn_mfma_f32_32x32x16_bf16((a), (b), (c), 0, 0, 0)
DI int crow32(int j, int hh) { return (j & 3) + 8 * (j >> 2) + 4 * hh; }
DI void phase_prologue(Frame& F, const Args& a) {
    unsigned char* ws = F.ws;
    transpose_matrix(F, a.in[4], 1024, NIN, (bf16*)(ws + WS_WIN));
    transpose_matrix(F, a.in[5], 1024, 1024, (bf16*)(ws + WS_WOUT));
    transpose_matrix(F, a.in[12], 1024, NQKV, (bf16*)(ws + WS_WQKV));
    transpose_matrix(F, a.in[13], 1024, 1024, (bf16*)(ws + WS_WO));
    { bf16* WSB = (bf16*)(ws + WS_WSB); for (int i = F.bid * NTHR + F.tid; i < 4 * 128 * 128; i += F.G * NTHR) WSB[i] = (bf16)f2bf(a.in[8][i]); }
    { float* LB = (float*)(ws + WS_LB); const float* t = a.in[10];
      for (int i = F.bid * NTHR + F.tid; i < 2 * 512; i += F.G * NTHR) { const int d = i / 512, k = i % 512;
          const float a0 = t[(d * 3 + 0) * 512 + k], a1 = t[(d * 3 + 1) * 512 + k], a2 = t[(d * 3 + 2) * 512 + k];
          const float mx = fmaxf(a0, fmaxf(a1, a2)); const float e0 = expf(a0 - mx), e1 = expf(a1 - mx), e2 = expf(a2 - mx);
          LB[i] = e0 / (e0 + e1 + e2); } }
    { float* BT = (float*)(ws + WS_BT); const float* rb = a.in[14];
      for (int i = F.bid * NTHR + F.tid; i < 3 * 16 * 129; i += F.G * NTHR) { const int p = i / (16 * 129), h = (i / 129) % 16, j = i % 129;
          const int dil = (p == 0) ? 1 : (p == 1 ? 4 : 16);
          BT[i] = rb[t5_bucket((j - 64) * dil) * 16 + h] * 1.4426950408889634f; } }
    { bf16* H = (bf16*)(ws + WS_H); const float* x = a.in[0];
      for (int m = F.gw; m < MTOK; m += F.NGW) { f32x4 v[4]; rms_row(x + (size_t)m * DM, a.in[1], v, F.lane); store_row_bf16(H + (size_t)m * DM, v, F.lane); } }
}

DI void phase_a_mix(Frame& F, const Args& a) {
    const bf16* GV = (const bf16*)(F.ws + WS_GV); const bf16* U = (const bf16*)(F.ws + WS_U); bf16* CAT = (bf16*)(F.ws + WS_CAT); const bf16* WSB = (const bf16*)(F.ws + WS_WSB);
    LAS float* st = (LAS float*)F.lds;
    LAS unsigned char* tl = F.lds + 1024;
    const int r32 = F.lane & 31, hh = F.lane >> 5, ci = F.wave & 3, tp = F.wave >> 2;
    for (int u = F.bid; u < 512; u += F.G) {
        const int g = u & 3, ch = u >> 2; const int row0 = ch * 128;
        v4u tw[4];
#pragma unroll
        for (int i = 0; i < 4; ++i) { const int p = F.tid + 512 * i; tw[i] = *(const v4u*)(GV + (size_t)(row0 + (p >> 4)) * AW + g * 128 + 8 * (p & 15)); }
        float p1[16], p2[16];
#pragma unroll
        for (int r = 0; r < 16; ++r) { const v4u w = *((const v4u*)(GV + (size_t)(row0 + 16 * F.wave + r) * AW) + F.lane);
            const float x0 = bflo(w.x), x1 = bfhi(w.x), x2 = bflo(w.y), x3 = bfhi(w.y), x4 = bflo(w.z), x5 = bfhi(w.z), x6 = bflo(w.w), x7 = bfhi(w.w);
            p1[r] = ((x0 + x1) + (x2 + x3)) + ((x4 + x5) + (x6 + x7)); p2[r] = ((x0 * x0 + x1 * x1) + (x2 * x2 + x3 * x3)) + ((x4 * x4 + x5 * x5) + (x6 * x6 + x7 * x7)); }
        const float s1 = red16(p1, F.lane), s2 = red16(p2, F.lane);
        __syncthreads();
        if ((F.lane & 3) == 0) { const float mu = s1 * (1.f / AW); const float var = fmaxf(s2 * (1.f / AW) - mu * mu, 0.f); const int r = 16 * F.wave + red16_idx(F.lane);
            st[2 * r] = mu; st[2 * r + 1] = 1.f / sqrtf(var + EPS); }
#pragma unroll
        for (int i = 0; i < 4; ++i) { const int p = F.tid + 512 * i; *(LAS v4u*)(tl + (p >> 4) * 272 + 16 * (p & 15)) = tw[i]; }
        __syncthreads();
        f32x16 acc[2];
#pragma unroll
        for (int j = 0; j < 16; ++j) { acc[0][j] = 0.f; acc[1][j] = 0.f; }
        const int cl = 32 * ci + r32;
        const float lg = a.in[6][g * 128 + cl], lb = a.in[7][g * 128 + cl];
        const bf16* w0 = WSB + (size_t)g * 16384 + (size_t)(64 * tp + r32) * 128 + 8 * hh;
#pragma unroll
        for (int s = 0; s < 8; ++s) {
            float e[8];
#pragma unroll
            for (int j = 0; j < 8; ++j) { const int tk = 16 * s + 8 * hh + j; e[j] = (bf2f(*(const LAS unsigned short*)(tl + tk * 272 + 2 * cl)) - st[2 * tk]) * st[2 * tk + 1] * lg + lb; }
            v4u bw; bw.x = pk2(e[0], e[1]); bw.y = pk2(e[2], e[3]); bw.z = pk2(e[4], e[5]); bw.w = pk2(e[6], e[7]);
            const bf16x8 at = __builtin_bit_cast(bf16x8, bw);
            acc[0] = MFMA32(at, *(const bf16x8*)(w0 + 16 * s), acc[0]);
            acc[1] = MFMA32(at, *(const bf16x8*)(w0 + 32 * 128 + 16 * s), acc[1]);
        }
#pragma unroll
        for (int q = 0; q < 2; ++q) { const int t = 64 * tp + 32 * q + r32; const float bs = a.in[9][g * 128 + t];
            const size_t ub = (size_t)(row0 + t) * AW + g * 128 + 32 * ci + 4 * hh, cb = (size_t)(row0 + t) * DM + g * 128 + 32 * ci + 4 * hh;
#pragma unroll
            for (int gq = 0; gq < 4; ++gq) { const v2u uw = *(const v2u*)(U + ub + 8 * gq); v2u o;
                o.x = pk2(bflo(uw.x) * (acc[q][4 * gq] + bs), bfhi(uw.x) * (acc[q][4 * gq + 1] + bs)); o.y = pk2(bflo(uw.y) * (acc[q][4 * gq + 2] + bs), bfhi(uw.y) * (acc[q][4 * gq + 3] + bs));
                *(v2u*)(CAT + cb + 8 * gq) = o; } }
    }
}

DI void phase_gla_scan(Frame& F) {
    float* ST = (float*)(F.ws + WS_ST); const float* DEC = (const float*)(F.ws + WS_DEC);
    for (int idx = F.bid * NTHR + F.tid; idx < 16 * 4096; idx += F.G * NTHR) {
        const int chain = idx >> 12, kv = (idx & 4095) * 4, k = kv >> 7;
        f32x4 d[16]; float dc[NSC];
#pragma unroll
        for (int sc = 0; sc < NSC; ++sc) dc[sc] = DEC[(chain * NSC + sc) * 128 + k];
#pragma unroll
        for (int sc = 0; sc < 16; ++sc) d[sc] = *(const f32x4*)(ST + (size_t)(chain * NSC + sc) * 16384 + kv);
        f32x4 S = (f32x4){0.f, 0.f, 0.f, 0.f};
#pragma unroll
        for (int sc = 0; sc < NSC; ++sc) { const f32x4 cur = d[sc & 15];
            if (sc + 16 < NSC) d[sc & 15] = *(const f32x4*)(ST + (size_t)(chain * NSC + sc + 16) * 16384 + kv);
            *(f32x4*)(ST + (size_t)(chain * NSC + sc) * 16384 + kv) = S; S = S * dc[sc] + cur; }
    }
}
DI void row16_load(const bf16* row, float (&v)[16], int lane) {
#pragma unroll
    for (int j = 0; j < 2; ++j) { const v4u w = *((const v4u*)row + 64 * j + lane);
        v[8 * j] = bflo(w.x); v[8 * j + 1] = bfhi(w.x); v[8 * j + 2] = bflo(w.y); v[8 * j + 3] = bfhi(w.y); v[8 * j + 4] = bflo(w.z); v[8 * j + 5] = bfhi(w.z); v[8 * j + 6] = bflo(w.w); v[8 * j + 7] = bfhi(w.w); }
}
DI void row16_add(const v4u (&w)[2], float sc, float (&v)[16]) {
#pragma unroll
    for (int j = 0; j < 2; ++j) { v[8 * j] += sc * bflo(w[j].x); v[8 * j + 1] += sc * bfhi(w[j].x); v[8 * j + 2] += sc * bflo(w[j].y); v[8 * j + 3] += sc * bfhi(w[j].y);
        v[8 * j + 4] += sc * bflo(w[j].z); v[8 * j + 5] += sc * bfhi(w[j].z); v[8 * j + 6] += sc * bflo(w[j].w); v[8 * j + 7] += sc * bfhi(w[j].w); }
}
DI void row16_store(bf16* row, const float (&v)[16], int lane) {
#pragma unroll
    for (int j = 0; j < 2; ++j) { v4u w; w.x = pk2(v[8 * j], v[8 * j + 1]); w.y = pk2(v[8 * j + 2], v[8 * j + 3]); w.z = pk2(v[8 * j + 4], v[8 * j + 5]); w.w = pk2(v[8 * j + 6], v[8 * j + 7]); *((v4u*)row + 64 * j + lane) = w; }
}
DI void row16_gain(const float* g, float (&gv)[16], int lane) {
#pragma unroll
    for (int j = 0; j < 2; ++j)
#pragma unroll
        for (int hq = 0; hq < 2; ++hq) { const f32x4 t = *(const f32x4*)(g + 512 * j + 8 * lane + 4 * hq); gv[8 * j + 4 * hq] = t.x; gv[8 * j + 4 * hq + 1] = t.y; gv[8 * j + 4 * hq + 2] = t.z; gv[8 * j + 4 * hq + 3] = t.w; }
}
DI float row16_sumsq(const float (&v)[16]) { float s = 0.f;
#pragma unroll
    for (int i = 0; i < 16; i += 4) s += (v[i] * v[i] + v[i + 1] * v[i + 1]) + (v[i + 2] * v[i + 2] + v[i + 3] * v[i + 3]);
    return s; }
DI void phase_router(Frame& F, const bf16* XR, const float* gn, const float* wr) {
    LAS float* wl = (LAS float*)F.lds;
    __syncthreads();
    for (int i = F.tid; i < 1024 * 16 / 4; i += NTHR) { const f32x4 w4 = *(const f32x4*)(wr + 4 * i); const int d = i >> 2, e0 = 4 * (i & 3);
        const int pos = (d & 512) + 256 * ((d >> 2) & 1) + 4 * ((d >> 3) & 63) + (d & 3);
        wl[(e0 + 0) * 1024 + pos] = w4.x; wl[(e0 + 1) * 1024 + pos] = w4.y; wl[(e0 + 2) * 1024 + pos] = w4.z; wl[(e0 + 3) * 1024 + pos] = w4.w; }
    __syncthreads();
    bf16* H = (bf16*)(F.ws + WS_H); float* AFF = (float*)(F.ws + WS_AFF);
    float gv[16]; row16_gain(gn, gv, F.lane);
    v4u ra_[2], rb_[2];
    { const int mp = F.gw; if (mp < MTOK / 2) { const v4u* xa = (const v4u*)(XR + (size_t)(2 * mp) * DM) + F.lane; ra_[0] = xa[0]; ra_[1] = xa[64]; rb_[0] = xa[128]; rb_[1] = xa[192]; } }
    for (int mp = F.gw; mp < MTOK / 2; mp += F.NGW) {
        asm volatile("" ::: "memory");
        const int m0 = 2 * mp;
        float va[16], vb[16];
#pragma unroll
        for (int j = 0; j < 2; ++j) { const v4u w = ra_[j], x = rb_[j];
            va[8 * j] = bflo(w.x); va[8 * j + 1] = bfhi(w.x); va[8 * j + 2] = bflo(w.y); va[8 * j + 3] = bfhi(w.y); va[8 * j + 4] = bflo(w.z); va[8 * j + 5] = bfhi(w.z); va[8 * j + 6] = bflo(w.w); va[8 * j + 7] = bfhi(w.w);
            vb[8 * j] = bflo(x.x); vb[8 * j + 1] = bfhi(x.x); vb[8 * j + 2] = bflo(x.y); vb[8 * j + 3] = bfhi(x.y); vb[8 * j + 4] = bflo(x.z); vb[8 * j + 5] = bfhi(x.z); vb[8 * j + 6] = bflo(x.w); vb[8 * j + 7] = bfhi(x.w); }
        { const int mn = mp + F.NGW; if (mn < MTOK / 2) { const v4u* xa = (const v4u*)(XR + (size_t)(2 * mn) * DM) + F.lane; ra_[0] = xa[0]; ra_[1] = xa[64]; rb_[0] = xa[128]; rb_[1] = xa[192]; } }
        const float ra = 1.f / sqrtf(wave_sum(row16_sumsq(va)) * (1.f / DM) + EPS), rb = 1.f / sqrtf(wave_sum(row16_sumsq(vb)) * (1.f / DM) + EPS);
#pragma unroll
        for (int i = 0; i < 16; ++i) { va[i] = va[i] * ra * gv[i]; vb[i] = vb[i] * rb * gv[i]; }
        row16_store(H + (size_t)m0 * DM, va, F.lane); row16_store(H + (size_t)(m0 + 1) * DM, vb, F.lane);
        float pa[16], pb[16];
#pragma unroll
        for (int e = 0; e < 16; ++e) { float a = 0.f, c = 0.f;
#pragma unroll
            for (int j = 0; j < 2; ++j)
#pragma unroll
                for (int hq = 0; hq < 2; ++hq) { const f32x4 w4 = *(const LAS f32x4*)(wl + e * 1024 + 512 * j + 256 * hq + 4 * F.lane); const int o = 8 * j + 4 * hq;
                    a += (va[o] * w4.x + va[o + 1] * w4.y) + (va[o + 2] * w4.z + va[o + 3] * w4.w); c += (vb[o] * w4.x + vb[o + 1] * w4.y) + (vb[o + 2] * w4.z + vb[o + 3] * w4.w); }
            pa[e] = a; pb[e] = c; }
        const float la = red16(pa, F.lane), lb = red16(pb, F.lane);
        const float ma = wave_max(la), mb = wave_max(lb); const float ea = expf(la - ma), eb = expf(lb - mb); const float za = wave_sum(ea) * 0.25f, zb = wave_sum(eb) * 0.25f;
        if ((F.lane & 3) == 0) { const int b = m0 / SEQ, sq = m0 % SEQ; float* ap = AFF + (size_t)(b * 16 + red16_idx(F.lane)) * SEQ + sq; ap[0] = ea / za; ap[1] = eb / zb; }
    }
}

DI int block_excl_scan(int v, LAS int* scratch, int tid, int lane, int wave, int* tot) {
    int inc = v;
#pragma unroll
    for (int o = 1; o < 64; o <<= 1) { const int t = __shfl_up(inc, o); if (lane >= o) inc += t; }
    __syncthreads();
    if (lane == 63) scratch[wave] = inc;
    __syncthreads();
    int base = 0, total = 0;
#pragma unroll
    for (int w = 0; w < NWAVES; ++w) { const int s = scratch[w]; if (w < wave) base += s; total += s; }
    *tot = total;
    return base + inc - v;
}
DI void phase_topk(Frame& F) {
    const float* AFF = (const float*)(F.ws + WS_AFF); int* IDX = (int*)(F.ws + WS_IDX); float* GATE = (float*)(F.ws + WS_GATE); int* POS = (int*)(F.ws + WS_POS);
    LAS unsigned* hist = (LAS unsigned*)F.lds; LAS int* sc = (LAS int*)(F.lds + 16384); LAS unsigned* shv = (LAS unsigned*)(F.lds + 16384 + 256);
    for (int u = F.bid; u < BATCH * NEXP; u += F.G) {
        const int b = u / NEXP, e = u % NEXP;
        unsigned vals[16];
        { const v4u* src = (const v4u*)(AFF + (size_t)u * SEQ + 16 * F.tid);
#pragma unroll
          for (int j = 0; j < 4; ++j) { const v4u t = src[j]; vals[4 * j] = t.x; vals[4 * j + 1] = t.y; vals[4 * j + 2] = t.z; vals[4 * j + 3] = t.w; } }
        unsigned prefix = 0; int krem = CAP;
#pragma unroll
        for (int pass = 0; pass < 3; ++pass) {
            const int shift = (pass == 0) ? 20 : (pass == 1 ? 8 : 0); const unsigned mask = (pass == 2) ? 255u : 4095u; const int pshift = (pass == 2) ? 8 : 20;
            __syncthreads();
#pragma unroll
            for (int j = 0; j < 8; ++j) hist[F.tid + 512 * j] = 0u;
            __syncthreads();
#pragma unroll
            for (int j = 0; j < 16; ++j) { const unsigned v = vals[j]; if (pass == 0 || (v >> pshift) == prefix) __hip_atomic_fetch_add(&hist[(v >> shift) & mask], 1u, __ATOMIC_RELAXED, __HIP_MEMORY_SCOPE_WORKGROUP); }
            __syncthreads();
            const int hi = 4095 - 8 * F.tid; int ls = 0; unsigned hb[8];
#pragma unroll
            for (int j = 0; j < 8; ++j) { hb[j] = hist[hi - j]; ls += (int)hb[j]; }
            int tot; const int above = block_excl_scan(ls, sc, F.tid, F.lane, F.wave, &tot);
            if (above < krem && krem <= above + ls) { int cum = above, sel = hi, found = 0;
#pragma unroll
                for (int j = 0; j < 8; ++j) { if (!found) { if (cum + (int)hb[j] >= krem) { sel = hi - j; found = 1; } else cum += (int)hb[j]; } }
                shv[0] = (unsigned)sel; shv[1] = (unsigned)(krem - cum); }
            __syncthreads();
            prefix = (pass == 2) ? ((prefix << 8) | shv[0]) : ((prefix << 12) | shv[0]); krem = (int)shv[1];
        }
        const unsigned T = prefix;
        int ce = 0;
#pragma unroll
        for (int j = 0; j < 16; ++j) ce += (vals[j] == T) ? 1 : 0;
        int tot; int pe = block_excl_scan(ce, sc, F.tid, F.lane, F.wave, &tot);
        unsigned selmask = 0; int cs = 0;
#pragma unroll
        for (int j = 0; j < 16; ++j) { bool s = vals[j] > T; if (vals[j] == T) { s = pe < krem; ++pe; } if (s) { selmask |= 1u << j; ++cs; } }
        int slot = block_excl_scan(cs, sc, F.tid, F.lane, F.wave, &tot);
#pragma unroll
        for (int j = 0; j < 16; ++j) { const int s = 16 * F.tid + j; const int tokrow = b * SEQ + s;
            if (selmask & (1u << j)) { const int row = (e * 2 + b) * CAP + slot; ++slot; IDX[row] = tokrow; GATE[row] = __builtin_bit_cast(float, vals[j]); POS[tokrow * 16 + e] = row; }
            else POS[tokrow * 16 + e] = -1; }
    }
}
DI void phase_gather(Frame& F) {
    const bf16* H = (const bf16*)(F.ws + WS_H); bf16* XE = (bf16*)(F.ws + WS_XE); const int* IDX = (const int*)(F.ws + WS_IDX);
    for (int r = F.gw; r < NROWS; r += F.NGW) { const int src = IDX[r];
        const v4u* s = (const v4u*)(H + (size_t)src * DM) + F.lane; v4u* d = (v4u*)(XE + (size_t)r * DM) + F.lane;
        d[0] = s[0]; d[64] = s[64]; }
}
struct CombRow { float v[16]; v4u y[4][2]; float sc[4]; unsigned rest; int pm; };
DI void comb_load(CombRow& c, const bf16* XR, const bf16* Y, const int* POS, int m, int lane) {
    row16_load(XR + (size_t)m * DM, c.v, lane);
    c.pm = POS[m * 16 + (lane & 15)];
    unsigned mk = (unsigned)__builtin_amdgcn_readfirstlane((int)(unsigned)(__ballot(lane < 16 && c.pm >= 0)));
#pragma unroll
    for (int q = 0; q < 4; ++q) {
        int p = -1;
        if (mk) { const int e = __builtin_ctz(mk); mk &= mk - 1u; p = __builtin_amdgcn_readlane(c.pm, e); }
        c.sc[q] = (p >= 0) ? 1.f : 0.f;
        const v4u* yr = (const v4u*)(Y + (size_t)(p >= 0 ? p : 0) * DM) + lane;
        c.y[q][0] = yr[0]; c.y[q][1] = yr[64];
    }
    c.rest = mk;
}
DI void comb_finish(CombRow& c, bf16* XR, float* out, bf16* H, const bf16* Y, const float* gnext, bool final_out, int m, int lane) {
#pragma unroll
    for (int q = 0; q < 4; ++q) row16_add(c.y[q], c.sc[q], c.v);
    unsigned mk = c.rest;
    while (mk) { const int e = __builtin_ctz(mk); mk &= mk - 1u; const int p = __builtin_amdgcn_readlane(c.pm, e);
        const v4u* yr = (const v4u*)(Y + (size_t)p * DM) + lane; v4u w[2]; w[0] = yr[0]; w[1] = yr[64]; row16_add(w, 1.f, c.v); }
    const float rstd = 1.f / sqrtf(wave_sum(row16_sumsq(c.v)) * (1.f / DM) + EPS);
    float gv[16]; row16_gain(gnext, gv, lane);
    if (final_out) {
        float* xo = out + (size_t)m * DM;
#pragma unroll
        for (int j = 0; j < 2; ++j)
#pragma unroll
            for (int hq = 0; hq < 2; ++hq) { const int o = 8 * j + 4 * hq;
                *(f32x4*)(xo + 512 * j + 8 * lane + 4 * hq) = (f32x4){c.v[o] * rstd * gv[o], c.v[o + 1] * rstd * gv[o + 1], c.v[o + 2] * rstd * gv[o + 2], c.v[o + 3] * rstd * gv[o + 3]}; }
    } else {
        row16_store(XR + (size_t)m * DM, c.v, lane);
        float nv[16];
#pragma unroll
        for (int i = 0; i < 16; ++i) nv[i] = c.v[i] * rstd * gv[i];
        row16_store(H + (size_t)m * DM, nv, lane);
    }
}
DI void phase_moe_combine(Frame& F, bf16* XR, float* out, const float* gnext, bool final_out) {
    const bf16* Y = (const bf16*)(F.ws + WS_Y); const int* POS = (const int*)(F.ws + WS_POS); bf16* H = (bf16*)(F.ws + WS_H);
    for (int m = F.gw; m < MTOK; m += 2 * F.NGW) {
        CombRow ca, cb; const int m2 = m + F.NGW;
        comb_load(ca, XR, Y, POS, m, F.lane);
        if (m2 < MTOK) comb_load(cb, XR, Y, POS, m2, F.lane);
        comb_finish(ca, XR, out, H, Y, gnext, final_out, m, F.lane);
        if (m2 < MTOK) comb_finish(cb, XR, out, H, Y, gnext, final_out, m2, F.lane);
    }
}

DI int kperm(int r) { return (r & ~12) | ((r & 4) << 1) | ((r & 8) >> 1); }
DI unsigned fp8x4(float a, float b, float c, float d) { int w = __builtin_amdgcn_cvt_pk_fp8_f32(a, b, 0, false); w = __builtin_amdgcn_cvt_pk_fp8_f32(c, d, w, true); return (unsigned)w; }
DI void phase_kvf(Frame& F) {
    const bf16* QKV = (const bf16*)(F.ws + WS_QKV); unsigned char* KF = F.ws + WS_KF; unsigned char* VF = F.ws + WS_VF;
    LAS unsigned char* kl = F.lds; LAS unsigned char* vl = F.lds + 69632;
    for (int u = F.bid; u < 512; u += F.G) {
        const int c = u & 15, h = (u >> 4) & 15, b = u >> 8, t0 = c * 512;
        __syncthreads();
        { const v4u* ks = (const v4u*)(QKV + (size_t)(b * SEQ + t0 + F.tid) * NQKV + 1024 + h * 64); const v4u* vs = (const v4u*)(QKV + (size_t)(b * SEQ + t0 + F.tid) * NQKV + 2048 + h * 64);
#pragma unroll
          for (int j = 0; j < 8; ++j) { const v4u w = ks[j]; LAS v2u* d = (LAS v2u*)(kl + F.tid * 136 + 16 * j); d[0] = (v2u){w.x, w.y}; d[1] = (v2u){w.z, w.w}; }
#pragma unroll
          for (int j = 0; j < 8; ++j) { const v4u w = vs[j]; LAS v2u* d = (LAS v2u*)(vl + F.tid * 136 + 16 * j); d[0] = (v2u){w.x, w.y}; d[1] = (v2u){w.z, w.w}; } }
        __syncthreads();
#pragma unroll
        for (int p = 0; p < 3; ++p) {
            const int dl = (p == 0) ? 1 : (p == 1 ? 4 : 16), tpr = 16 / dl, ntile = SEQ / dl / 32;
            unsigned char* kd = KF + (size_t)p * 16 * MiB; unsigned char* vd = VF + (size_t)p * 16 * MiB;
#pragma unroll 2
            for (int i = 0; i < 4; ++i) { const int q = F.tid + 512 * i, tl = q >> 7, sel = (q >> 6) & 1, ln = q & 63, hh = ln >> 5, rho = ln & 31, r = tl / tpr, tt = tl % tpr;
                const size_t tg = ((size_t)((b * 16 + h) * dl + r) * ntile + c * tpr + tt) * 2048;
                { const int tokl = dl * (32 * tt + kperm(rho)) + r;
                  const LAS v2u* sp = (const LAS v2u*)(kl + tokl * 136 + 64 * hh + 32 * sel); v4u o;
                  { const v2u a0 = sp[0], a1 = sp[1]; o.x = fp8x4(bflo(a0.x), bfhi(a0.x), bflo(a0.y), bfhi(a0.y)); o.y = fp8x4(bflo(a1.x), bfhi(a1.x), bflo(a1.y), bfhi(a1.y)); }
                  { const v2u a2 = sp[2], a3 = sp[3]; o.z = fp8x4(bflo(a2.x), bfhi(a2.x), bflo(a2.y), bfhi(a2.y)); o.w = fp8x4(bflo(a3.x), bfhi(a3.x), bflo(a3.y), bfhi(a3.y)); }
                  *(v4u*)(kd + tg + sel * 1024 + ln * 16) = o; }
                { const int dim = 32 * sel + rho; float e[16];
#pragma unroll
                  for (int k = 0; k < 16; ++k) e[k] = bf2f(*(const LAS unsigned short*)(vl + (dl * (32 * tt + 16 * (k >> 3) + 8 * hh + (k & 7)) + r) * 136 + dim * 2));
                  v4u o; o.x = fp8x4(e[0], e[1], e[2], e[3]); o.y = fp8x4(e[4], e[5], e[6], e[7]); o.z = fp8x4(e[8], e[9], e[10], e[11]); o.w = fp8x4(e[12], e[13], e[14], e[15]);
                  *(v4u*)(vd + tg + sel * 1024 + ln * 16) = o; }
            }
        }
    }
}

DI int osw(int tok, int chunk) { return tok * 256 + (((chunk ^ tok ^ (tok >> 4)) & 15) << 4); }
struct AttnK { v4u w[2]; }; struct AttnV { v4u w[2]; };
typedef __bf16 bf16x2v __attribute__((ext_vector_type(2)));
DI bf16x8 fp8x8_to_bf16(unsigned lo, unsigned hi) {
    v4u r; r.x = __builtin_bit_cast(unsigned, __builtin_amdgcn_cvt_scalef32_pk_bf16_fp8((int)lo, 1.0f, false)); r.y = __builtin_bit_cast(unsigned, __builtin_amdgcn_cvt_scalef32_pk_bf16_fp8((int)lo, 1.0f, true));
    r.z = __builtin_bit_cast(unsigned, __builtin_amdgcn_cvt_scalef32_pk_bf16_fp8((int)hi, 1.0f, false)); r.w = __builtin_bit_cast(unsigned, __builtin_amdgcn_cvt_scalef32_pk_bf16_fp8((int)hi, 1.0f, true));
    return __builtin_bit_cast(bf16x8, r);
}
DI void attn_load_k(AttnK& t, const unsigned char* kt) { t.w[0] = *(const v4u*)kt; t.w[1] = *(const v4u*)(kt + 1024); }
DI void attn_load_v(AttnV& t, const unsigned char* vt) { t.w[0] = *(const v4u*)vt; t.w[1] = *(const v4u*)(vt + 1024); }
template <bool MASK> DI void attn_step(const AttnK& tk, const AttnV& tv, const bf16x8 (&qf)[4], f32x16& o0, f32x16& o1, float& m, float& l, const LAS float* bl, int rel0, int hh) {
    f32x16 sa; bool vld[16];
#pragma unroll
    for (int i = 0; i < 16; ++i) { const int rel = rel0 + 16 * (i >> 3) + (i & 7);
        vld[i] = !MASK || ((rel >= -64) && (rel <= 64)); sa[i] = bl[vld[i] ? rel + 64 : 0]; }
#pragma unroll
    for (int s = 0; s < 4; ++s) { const v4u kw = tk.w[s >> 1]; sa = MFMA32((s & 1) ? fp8x8_to_bf16(kw.z, kw.w) : fp8x8_to_bf16(kw.x, kw.y), qf[s], sa); }
    float tmax = -1e30f;
#pragma unroll
    for (int i = 0; i < 16; ++i) { if (MASK) sa[i] = vld[i] ? sa[i] : -1e30f; tmax = fmaxf(tmax, sa[i]); }
    tmax = fmaxf(tmax, __shfl_xor(tmax, 32));
    if (__any(tmax > m + 8.f)) {
        const float mnew = fmaxf(m, tmax), alpha = __builtin_amdgcn_exp2f(m - mnew);
        l *= alpha; m = mnew;
#pragma unroll
        for (int i = 0; i < 16; ++i) { o0[i] *= alpha; o1[i] *= alpha; }
    }
    float ps = 0.f; float p[16];
#pragma unroll
    for (int i = 0; i < 16; ++i) { p[i] = (!MASK || vld[i]) ? __builtin_amdgcn_exp2f(sa[i] - m) : 0.f; ps += p[i]; }
    l += ps;
#pragma unroll
    for (int s = 0; s < 2; ++s) {
        v4u w; w.x = pk2(p[8 * s], p[8 * s + 1]); w.y = pk2(p[8 * s + 2], p[8 * s + 3]); w.z = pk2(p[8 * s + 4], p[8 * s + 5]); w.w = pk2(p[8 * s + 6], p[8 * s + 7]);
        const bf16x8 pf = __builtin_bit_cast(bf16x8, w);
        o0 = MFMA32(s ? fp8x8_to_bf16(tv.w[0].z, tv.w[0].w) : fp8x8_to_bf16(tv.w[0].x, tv.w[0].y), pf, o0); o1 = MFMA32(s ? fp8x8_to_bf16(tv.w[1].z, tv.w[1].w) : fp8x8_to_bf16(tv.w[1].x, tv.w[1].y), pf, o1);
    }
}
DI void attn_stage(Frame& F, int b, int h, int t0, const int P) {
    const int dsh = 2 * P, DL = 1 << dsh, NT = (SEQ / 32) >> dsh;
    const bf16* QKV = (const bf16*)(F.ws + WS_QKV); const unsigned char* KF = F.ws + WS_KF + (size_t)P * 16 * MiB; const unsigned char* VF = F.ws + WS_VF + (size_t)P * 16 * MiB; bf16* ATT = (bf16*)(F.ws + WS_ATT);
    LAS unsigned char* ol = F.lds; LAS float* ml = (LAS float*)(F.lds + 131072); LAS float* ll = ml + 512; const LAS float* bl = (const LAS float*)(F.lds + 135168) + P * 132;
    int lane = F.lane; asm volatile("" : "+v"(lane));
    const int r32 = lane & 31, hh = lane >> 5, w = F.wave;
    asm volatile("" ::: "memory");
    int rr[2], mq[2], tq[2]; const unsigned char* kb[2]; const unsigned char* vb[2];
#pragma unroll
    for (int task = 0; task < 2; ++task) {
        int r, i0;
        if (P == 0) { r = 0; i0 = 64 * w + 32 * task; } else if (P == 1) { r = w & 3; i0 = 64 * (w >> 2) + 32 * task; } else { r = 2 * w + task; i0 = 0; }
        rr[task] = r; mq[task] = (t0 >> dsh) + i0; tq[task] = r + ((i0 + r32) << dsh);
        const size_t tb0 = ((size_t)((b * 16 + h) * DL + r) * NT) * 2048 + lane * 16;
        kb[task] = KF + tb0; vb[task] = VF + tb0;
    }
    int relb = 8 * hh - 64 - r32;
    asm volatile("" : "+v"(relb));
    AttnK ka, kb_, kc; AttnV va, vb_, vc; bf16x8 qf[4], qn[4]; f32x16 o0, o1; float m, l;
#define ATT_T(task, kt) (mq[task] / 32 - 2 + (kt))
#define ATT_OK(task, kt) (ATT_T(task, kt) >= 0 && ATT_T(task, kt) < NT)
#define ATT_TC(task, kt) (ATT_T(task, kt) < 0 ? 0 : (ATT_T(task, kt) >= NT ? NT - 1 : ATT_T(task, kt)))
#define ATT_LDK(t, task, kt) attn_load_k(t, kb[task] + (size_t)ATT_TC(task, kt) * 2048)
#define ATT_LDV(t, task, kt) attn_load_v(t, vb[task] + (size_t)ATT_TC(task, kt) * 2048)
#define ATT_ST(tk, tv, task, kt, MSK) do { if (ATT_OK(task, kt)) attn_step<MSK>(tk, tv, qf, o0, o1, m, l, bl, relb + 32 * (kt), hh); } while (0)
#define ATT_Q(dst, task) do { const bf16* qp = QKV + (size_t)(b * SEQ + t0 + tq[task]) * NQKV + h * 64 + 32 * hh; _Pragma("unroll") for (int s = 0; s < 4; ++s) dst[s] = *(const bf16x8*)(qp + 8 * s); } while (0)
#define ATT_INIT(task) do { if (P == 0) { _Pragma("unroll") for (int i = 0; i < 16; ++i) { o0[i] = 0.f; o1[i] = 0.f; } m = -1e30f; l = 0.f; } else { \
        _Pragma("unroll") for (int g = 0; g < 4; ++g) { const f32x4 a = *(const LAS f32x4*)(ol + osw(tq[task], 2 * g + hh)), c = *(const LAS f32x4*)(ol + osw(tq[task], 8 + 2 * g + hh)); \
            o0[4 * g] = a.x; o0[4 * g + 1] = a.y; o0[4 * g + 2] = a.z; o0[4 * g + 3] = a.w; o1[4 * g] = c.x; o1[4 * g + 1] = c.y; o1[4 * g + 2] = c.z; o1[4 * g + 3] = c.w; } \
        m = ml[tq[task]]; l = hh ? 0.f : ll[tq[task]]; } } while (0)
#define ATT_WB(task) do { const float lt = l + __shfl_xor(l, 32); int tw = tq[task]; asm volatile("" : "+v"(tw));     \
        if (P < 2) { _Pragma("unroll") for (int g = 0; g < 4; ++g) { *(LAS f32x4*)(ol + osw(tw, 2 * g + hh)) = (f32x4){o0[4 * g], o0[4 * g + 1], o0[4 * g + 2], o0[4 * g + 3]}; \
                *(LAS f32x4*)(ol + osw(tw, 8 + 2 * g + hh)) = (f32x4){o1[4 * g], o1[4 * g + 1], o1[4 * g + 2], o1[4 * g + 3]}; } \
            if (hh == 0) { ml[tw] = m; ll[tw] = lt; } } \
        else { const float inv = 1.f / lt; bf16* op = ATT + (size_t)(b * SEQ + t0 + tw) * DM + h * 64 + 4 * hh; \
            _Pragma("unroll") for (int g = 0; g < 4; ++g) { v2u a, c; a.x = pk2(o0[4 * g] * inv, o0[4 * g + 1] * inv); a.y = pk2(o0[4 * g + 2] * inv, o0[4 * g + 3] * inv); \
                c.x = pk2(o1[4 * g] * inv, o1[4 * g + 1] * inv); c.y = pk2(o1[4 * g + 2] * inv, o1[4 * g + 3] * inv); *(v2u*)(op + 8 * g) = a; *(v2u*)(op + 32 + 8 * g) = c; } } } while (0)
    ATT_LDK(ka, 0, 0); ATT_LDV(va, 0, 0); ATT_LDK(kb_, 0, 1); ATT_LDV(vb_, 0, 1);
    ATT_Q(qf, 0);
    __syncthreads();
    ATT_INIT(0);
    ATT_LDK(kc, 0, 2); ATT_LDV(vc, 0, 2); ATT_ST(ka, va, 0, 0, true);
    ATT_LDK(ka, 0, 3); ATT_LDV(va, 0, 3); ATT_ST(kb_, vb_, 0, 1, false);
    ATT_LDK(kb_, 0, 4); ATT_LDV(vb_, 0, 4); ATT_ST(kc, vc, 0, 2, false);
    ATT_Q(qn, 1);
    ATT_LDK(kc, 1, 0); ATT_LDV(vc, 1, 0); ATT_ST(ka, va, 0, 3, false);
    ATT_LDK(ka, 1, 1); ATT_LDV(va, 1, 1); ATT_ST(kb_, vb_, 0, 4, true);
    ATT_WB(0);
    _Pragma("unroll") for (int s = 0; s < 4; ++s) qf[s] = qn[s];
    ATT_INIT(1);
    __builtin_amdgcn_sched_barrier(0);
    ATT_LDK(kb_, 1, 2); ATT_LDV(vb_, 1, 2); ATT_ST(kc, vc, 1, 0, true);
    ATT_LDK(kc, 1, 3); ATT_LDV(vc, 1, 3); ATT_ST(ka, va, 1, 1, false);
    ATT_LDK(ka, 1, 4); ATT_LDV(va, 1, 4); ATT_ST(kb_, vb_, 1, 2, false);
    ATT_ST(kc, vc, 1, 3, false);
    ATT_ST(ka, va, 1, 4, true);
    ATT_WB(1);
#undef ATT_T
#undef ATT_OK
#undef ATT_TC
#undef ATT_LDK
#undef ATT_LDV
#undef ATT_ST
#undef ATT_Q
#undef ATT_INIT
#undef ATT_WB
}
DI void phase_attn(Frame& F) {
    const float* BT = (const float*)(F.ws + WS_BT);
    LAS float* bl = (LAS float*)(F.lds + 135168);
    const int vb_ = (F.G % 8 == 0) ? (F.bid % 8) * (F.G / 8) + F.bid / 8 : F.bid;
    for (int u = vb_; u < 512; u += F.G) {
        const int c = u & 15, h = (u >> 4) & 15, b = u >> 8, t0 = c * 512;
        __syncthreads();
        { int i0 = F.tid; asm volatile("" : "+v"(i0)); for (int i = i0; i < 3 * 129; i += NTHR) bl[(i / 129) * 132 + i % 129] = BT[((i / 129) * 16 + h) * 129 + i % 129]; }
#pragma unroll 1
        for (int P = 0; P < 3; ++P) attn_stage(F, b, h, t0, P);
        if (PROBE_DUP == 55) attn_stage(F, b, h, t0, 2);
    }
}

constexpr int GL_QT = 0, GL_KT = 17408, GL_QB = 34816, GL_KHT = 52224, GL_VT = 70656, GL_P = 89088, GL_ST = 98304, GL_DEC = 133120, GL_TOT = 133632;
struct GlaRaw { v4u q[2], lf[2], v[2]; };
DI void gla_load_raw(GlaRaw& R, const _Float16* LF, const bf16* Q, const bf16* V, int b, int h, int dir, int pos0, int tid) {
#pragma unroll
    for (int i = 0; i < 2; ++i) { const int p = tid + 512 * i, ii = pos0 + (p >> 4); const int tok = dir ? (SEQ - 1 - ii) : ii; const size_t off = (size_t)(b * SEQ + tok) * AW + h * 128 + 8 * (p & 15);
        R.q[i] = *(const v4u*)(Q + off); R.lf[i] = *(const v4u*)(LF + off); R.v[i] = *(const v4u*)(V + off); }
}
DI void gla_prep(Frame& F, const GlaRaw& R) {
    LAS unsigned char* L = F.lds; LAS float* tot = (LAS float*)(L + GL_TOT);
    const int ch = F.tid & 127, qtr = F.tid >> 7;
#pragma unroll
    for (int i = 0; i < 2; ++i) { const int p = F.tid + 512 * i; const int so = (p >> 4) * 272 + 16 * (p & 15);
        *(LAS v4u*)(L + GL_QT + so) = R.q[i]; *(LAS v4u*)(L + GL_KT + so) = R.lf[i]; *(LAS v4u*)(L + GL_QB + so) = R.v[i]; }
    __syncthreads();
    float lf[16]; unsigned short qr[16], vr[16];
#pragma unroll
    for (int i = 0; i < 16; ++i) { const int so = (16 * qtr + i) * 272 + 2 * ch;
        qr[i] = *(const LAS unsigned short*)(L + GL_QT + so); lf[i] = (float)*(const LAS _Float16*)(L + GL_KT + so); vr[i] = *(const LAS unsigned short*)(L + GL_QB + so); }
    float c[16]; float run = 0.f;
#pragma unroll
    for (int i = 0; i < 16; ++i) { run += lf[i]; c[i] = run; }
    tot[qtr * 128 + ch] = run;
    __syncthreads();
    const float t0 = tot[ch], t1 = tot[128 + ch], t2 = tot[256 + ch], t3 = tot[384 + ch];
    const float off = (qtr > 0 ? t0 : 0.f) + (qtr > 1 ? t1 : 0.f) + (qtr > 2 ? t2 : 0.f), rr = t0 + t1, bend = (t0 + t1) + (t2 + t3);
    const float er = fexp(rr), ebr = fexp(bend - rr);
    unsigned kh[8], vv[8];
#pragma unroll
    for (int i = 0; i < 16; i += 2) {
        const float E0 = fexp(off + c[i] - rr), E1 = fexp(off + c[i + 1] - rr), I0 = frcp(E0), I1 = frcp(E1);
        const float k0 = 1.f - fexp(lf[i]), k1 = 1.f - fexp(lf[i + 1]);
        const float ki0 = k0 * I0, ki1 = k1 * I1;
        kh[i >> 1] = pk2(ki0 * ebr, ki1 * ebr);
        vv[i >> 1] = (unsigned)vr[i] | ((unsigned)vr[i + 1] << 16);
        const float q0 = bf2f(qr[i]) * E0, q1 = bf2f(qr[i + 1]) * E1;
        const int ta = 16 * qtr + i;
        *(LAS unsigned short*)(L + GL_QT + ta * 272 + 2 * ch) = (unsigned short)f2bf(q0);
        *(LAS unsigned short*)(L + GL_QT + (ta + 1) * 272 + 2 * ch) = (unsigned short)f2bf(q1);
        *(LAS unsigned short*)(L + GL_KT + ta * 272 + 2 * ch) = (unsigned short)f2bf(ki0);
        *(LAS unsigned short*)(L + GL_KT + (ta + 1) * 272 + 2 * ch) = (unsigned short)f2bf(ki1);
        *(LAS unsigned short*)(L + GL_QB + ta * 272 + 2 * ch) = (unsigned short)f2bf(q0 * er);
        *(LAS unsigned short*)(L + GL_QB + (ta + 1) * 272 + 2 * ch) = (unsigned short)f2bf(q1 * er);
    }
    *(LAS v4u*)(L + GL_KHT + ch * 144 + 32 * qtr) = (v4u){kh[0], kh[1], kh[2], kh[3]}; *(LAS v4u*)(L + GL_KHT + ch * 144 + 32 * qtr + 16) = (v4u){kh[4], kh[5], kh[6], kh[7]};
    *(LAS v4u*)(L + GL_VT + ch * 144 + 32 * qtr) = (v4u){vv[0], vv[1], vv[2], vv[3]}; *(LAS v4u*)(L + GL_VT + ch * 144 + 32 * qtr + 16) = (v4u){vv[4], vv[5], vv[6], vv[7]};
    if (qtr == 0) *(LAS float*)(L + GL_DEC + 4 * ch) = fexp(bend);
}
DI bf16x8 gfrag(const LAS unsigned char* base, int row, int stride, int kel) { return *(const LAS bf16x8*)(base + row * stride + kel * 2); }
DI void gla_state_update(Frame& F, f32x16 (&S)[2]) {
    const LAS unsigned char* L = F.lds; const int r32 = F.lane & 31, hh = F.lane >> 5, vi = F.wave & 3, ki0 = 2 * (F.wave >> 2);
    bf16x8 a[4];
#pragma unroll
    for (int s = 0; s < 4; ++s) a[s] = gfrag(L + GL_VT, 32 * vi + r32, 144, 16 * s + 8 * hh);
#pragma unroll
    for (int q = 0; q < 2; ++q) { const int kr = 32 * (ki0 + q) + r32; const float d = *(const LAS float*)(L + GL_DEC + 4 * kr);
#pragma unroll
        for (int j = 0; j < 16; ++j) S[q][j] *= d;
#pragma unroll
        for (int s = 0; s < 4; ++s) S[q] = MFMA32(a[s], gfrag(L + GL_KHT, kr, 144, 16 * s + 8 * hh), S[q]); }
}
DI void gla_state_to_lds(Frame& F, const f32x16 (&S)[2]) {
    LAS unsigned char* L = F.lds; const int r32 = F.lane & 31, hh = F.lane >> 5, vi = F.wave & 3, ki0 = 2 * (F.wave >> 2);
#pragma unroll
    for (int q = 0; q < 2; ++q)
#pragma unroll
        for (int j = 0; j < 16; ++j) *(LAS unsigned short*)(L + GL_ST + (32 * vi + crow32(j, hh)) * 272 + 2 * (32 * (ki0 + q) + r32)) = (unsigned short)f2bf(S[q][j]);
}
constexpr int G1_KHT = 0, G1_VT = 69632, G1_TOT = 139264;
DI void gla_unit_state(Frame& F, int u) {
    const int sc = u & 31, dir = (u >> 5) & 1, h = (u >> 6) & 3, b = u >> 8;
    const bf16* V = (const bf16*)(F.ws + WS_V); const _Float16* LF = (const _Float16*)(F.ws + (dir ? WS_LFB : WS_LFF));
    float* ST = (float*)(F.ws + WS_ST) + (size_t)u * 16384; float* DEC = (float*)(F.ws + WS_DEC) + u * 128;
    LAS unsigned char* L = F.lds; LAS float* tot = (LAS float*)(L + G1_TOT);
    const int ch = F.tid & 127, qtr = F.tid >> 7, r32 = F.lane & 31, hh = F.lane >> 5, vi = F.wave & 3, ki0 = 2 * (F.wave >> 2);
    { v4u rl[8], rv[8];
#pragma unroll
      for (int i = 0; i < 8; ++i) { const int p = F.tid + 512 * i, ii = sc * 256 + (p >> 4); const int tok = dir ? (SEQ - 1 - ii) : ii; const size_t off = (size_t)(b * SEQ + tok) * AW + h * 128 + 8 * (p & 15);
          rl[i] = *(const v4u*)(LF + off); rv[i] = *(const v4u*)(V + off); }
      __syncthreads();
#pragma unroll
      for (int i = 0; i < 8; ++i) { const int p = F.tid + 512 * i; const int so = (p >> 4) * 272 + 16 * (p & 15); *(LAS v4u*)(L + G1_KHT + so) = rl[i]; *(LAS v4u*)(L + G1_VT + so) = rv[i]; } }
    __syncthreads();
    float lf[64]; unsigned vv[32];
#pragma unroll
    for (int i = 0; i < 64; ++i) { const int so = (64 * qtr + i) * 272 + 2 * ch;
        lf[i] = (float)*(const LAS _Float16*)(L + G1_KHT + so); const unsigned x = *(const LAS unsigned short*)(L + G1_VT + so); if (i & 1) vv[i >> 1] |= x << 16; else vv[i >> 1] = x; }
    float run = 0.f;
#pragma unroll
    for (int i = 0; i < 64; ++i) run += lf[i];
    __syncthreads();
    tot[qtr * 128 + ch] = run;
#pragma unroll
    for (int i = 0; i < 32; i += 4) *(LAS v4u*)(L + G1_VT + ch * 528 + 128 * qtr + 4 * i) = (v4u){vv[i], vv[i + 1], vv[i + 2], vv[i + 3]};
    __syncthreads();
    const float t0 = tot[ch], t1 = tot[128 + ch], t2 = tot[256 + ch], t3 = tot[384 + ch];
    const float bend = (t0 + t1) + (t2 + t3);
    run = (qtr > 0 ? t0 : 0.f) + (qtr > 1 ? t1 : 0.f) + (qtr > 2 ? t2 : 0.f);
#pragma unroll
    for (int i = 0; i < 64; i += 2) { const float b0 = run + lf[i], b1 = b0 + lf[i + 1]; run = b1;
        vv[i >> 1] = pk2((1.f - fexp(lf[i])) * fexp(bend - b0), (1.f - fexp(lf[i + 1])) * fexp(bend - b1)); }
#pragma unroll
    for (int i = 0; i < 32; i += 4) *(LAS v4u*)(L + G1_KHT + ch * 528 + 128 * qtr + 4 * i) = (v4u){vv[i], vv[i + 1], vv[i + 2], vv[i + 3]};
    if (qtr == 0) DEC[ch] = fexp(bend);
    __syncthreads();
    f32x16 S[2];
#pragma unroll
    for (int j = 0; j < 16; ++j) { S[0][j] = 0.f; S[1][j] = 0.f; }
#pragma unroll 4
    for (int s = 0; s < 16; ++s) { const bf16x8 av = gfrag(L + G1_VT, 32 * vi + r32, 528, 16 * s + 8 * hh);
        S[0] = MFMA32(av, gfrag(L + G1_KHT, 32 * ki0 + r32, 528, 16 * s + 8 * hh), S[0]);
        S[1] = MFMA32(av, gfrag(L + G1_KHT, 32 * (ki0 + 1) + r32, 528, 16 * s + 8 * hh), S[1]); }
#pragma unroll
    for (int q = 0; q < 2; ++q)
#pragma unroll
        for (int g = 0; g < 4; ++g) *(f32x4*)(ST + (size_t)(32 * (ki0 + q) + r32) * 128 + 32 * vi + 8 * g + 4 * hh) = (f32x4){S[q][4 * g], S[q][4 * g + 1], S[q][4 * g + 2], S[q][4 * g + 3]};
}
DI int red16h_idx(int lane) { return 8 * ((lane >> 4) & 1) + 4 * ((lane >> 3) & 1) + 2 * ((lane >> 2) & 1) + ((lane >> 1) & 1); }
DI float red16h(const float (&o)[16], int lane) {
    const bool b16 = lane & 16, b8 = lane & 8, b4 = lane & 4, b2 = lane & 2;
    float a8[8], a4[4], a2[2], a1;
#pragma unroll
    for (int j = 0; j < 8; ++j) { const float send = b16 ? o[j] : o[j + 8], keep = b16 ? o[j + 8] : o[j]; a8[j] = keep + __shfl_xor(send, 16); }
#pragma unroll
    for (int j = 0; j < 4; ++j) { const float send = b8 ? a8[j] : a8[j + 4], keep = b8 ? a8[j + 4] : a8[j]; a4[j] = keep + __shfl_xor(send, 8); }
#pragma unroll
    for (int j = 0; j < 2; ++j) { const float send = b4 ? a4[j] : a4[j + 2], keep = b4 ? a4[j + 2] : a4[j]; a2[j] = keep + __shfl_xor(send, 4); }
    { const float send = b2 ? a2[0] : a2[1], keep = b2 ? a2[1] : a2[0]; a1 = keep + __shfl_xor(send, 2); }
    a1 += __shfl_xor(a1, 1);
    return a1;
}
constexpr int GL_RS = 135680;
template <bool FUSE> DI void gla_unit_out(Frame& F, const Args& a, int u) {
    const int sc = u & 31, dir = (u >> 5) & 1, h = (u >> 6) & 3, b = u >> 8;
    const bf16* Q = (const bf16*)(F.ws + WS_Q); const bf16* V = (const bf16*)(F.ws + WS_V); const _Float16* LF = (const _Float16*)(F.ws + (dir ? WS_LFB : WS_LFF));
    const float* ST = (const float*)(F.ws + WS_ST) + (size_t)u * 16384; float* OF = (float*)(F.ws + WS_ODIR);
    const bf16* G = (const bf16*)(F.ws + WS_G); bf16* CAT = (bf16*)(F.ws + WS_CAT);
    const LAS unsigned char* L = F.lds;
    const int ch = F.tid & 127, qtr = F.tid >> 7, r32 = F.lane & 31, hh = F.lane >> 5, w = F.wave, vi = w & 3, ki0 = 2 * (w >> 2), ti = w >> 2;
    f32x16 S[2];
#pragma unroll
    for (int q = 0; q < 2; ++q)
#pragma unroll
        for (int g = 0; g < 4; ++g) { const f32x4 t = *(const f32x4*)(ST + (size_t)(32 * (ki0 + q) + r32) * 128 + 32 * vi + 8 * g + 4 * hh); S[q][4 * g] = t.x; S[q][4 * g + 1] = t.y; S[q][4 * g + 2] = t.z; S[q][4 * g + 3] = t.w; }
    GlaRaw cur, nxt;
    gla_load_raw(cur, LF, Q, V, b, h, dir, sc * 256, F.tid);
    __syncthreads();
    gla_state_to_lds(F, S);
    f32x4 ngv[4];
    if (FUSE) {
#pragma unroll
        for (int g = 0; g < 4; ++g) ngv[g] = *(const f32x4*)(a.in[11] + h * 128 + 32 * vi + 8 * g + 4 * hh);
    }
#pragma unroll 1
    for (int c = 0; c < 4; ++c) {
        gla_prep(F, cur);
        if (c < 3) gla_load_raw(nxt, LF, Q, V, b, h, dir, sc * 256 + (c + 1) * 64, F.tid);
        const int ii = sc * 256 + c * 64 + 32 * ti + r32; const int tok = dir ? (SEQ - 1 - ii) : ii;
        const size_t orow = (size_t)(b * SEQ + tok) * AW + h * 128 + 32 * vi + 4 * hh;
        f32x4 of[4]; v2u gg[4];
        if (FUSE) {
#pragma unroll
            for (int g = 0; g < 4; ++g) { of[g] = *(const f32x4*)(OF + orow + 8 * g); gg[g] = *(const v2u*)(G + orow + 8 * g); }
        }
        __syncthreads();
        f32x16 o;
#pragma unroll
        for (int j = 0; j < 16; ++j) o[j] = 0.f;
#pragma unroll
        for (int s = 0; s < 8; ++s) o = MFMA32(gfrag(L + GL_ST, 32 * vi + r32, 272, 16 * s + 8 * hh), gfrag(L + GL_QB, 32 * ti + r32, 272, 16 * s + 8 * hh), o);
        if (w < 3) {
            const int tp = (w + 1) >> 1, sp = (w == 2) ? 1 : 0;
            f32x16 p;
#pragma unroll
            for (int j = 0; j < 16; ++j) p[j] = 0.f;
#pragma unroll
            for (int s = 0; s < 8; ++s) p = MFMA32(gfrag(L + GL_QT, 32 * tp + r32, 272, 16 * s + 8 * hh), gfrag(L + GL_KT, 32 * sp + r32, 272, 16 * s + 8 * hh), p);
#pragma unroll
            for (int j = 0; j < 16; ++j) { const int t = 32 * tp + crow32(j, hh), s2 = 32 * sp + r32;
                *(LAS unsigned short*)(F.lds + GL_P + t * 144 + 2 * s2) = (s2 <= t) ? (unsigned short)f2bf(p[j]) : (unsigned short)0; }
        }
        __syncthreads();
        { const int ns = ti ? 4 : 2;
#pragma unroll
          for (int s = 0; s < 4; ++s) if (s < ns) o = MFMA32(gfrag(L + GL_VT, 32 * vi + r32, 144, 16 * s + 8 * hh), gfrag(L + GL_P, 32 * ti + r32, 144, 16 * s + 8 * hh), o); }
        if (!FUSE) {
#pragma unroll
            for (int g = 0; g < 4; ++g) *(f32x4*)(OF + orow + 8 * g) = (f32x4){o[4 * g], o[4 * g + 1], o[4 * g + 2], o[4 * g + 3]};
        } else {
            float part = 0.f;
#pragma unroll
            for (int g = 0; g < 4; ++g) { o[4 * g] += of[g].x; o[4 * g + 1] += of[g].y; o[4 * g + 2] += of[g].z; o[4 * g + 3] += of[g].w; }
#pragma unroll
            for (int j = 0; j < 16; ++j) part += o[j] * o[j];
            part += __shfl_xor(part, 32);
            if (hh == 0) *(LAS float*)(F.lds + GL_RS + ((ti * 32 + r32) * 4 + vi) * 4) = part;
        }
        if (c < 3) { gla_state_update(F, S); gla_state_to_lds(F, S); }
        cur = nxt;
        __syncthreads();
        if (FUSE) {
            const f32x4 ps = *(const LAS f32x4*)(L + GL_RS + (ti * 32 + r32) * 16);
            const float rstd = 1.f / sqrtf(((ps.x + ps.y) + (ps.z + ps.w)) * (1.f / 128.f) + EPS);
            bf16* crow_ = CAT + (size_t)(b * SEQ + tok) * DM + 512 + h * 128 + 32 * vi + 4 * hh;
#pragma unroll
            for (int g = 0; g < 4; ++g) { v2u wv; wv.x = pk2(o[4 * g] * rstd * ngv[g].x * bflo(gg[g].x), o[4 * g + 1] * rstd * ngv[g].y * bfhi(gg[g].x));
                wv.y = pk2(o[4 * g + 2] * rstd * ngv[g].z * bflo(gg[g].y), o[4 * g + 3] * rstd * ngv[g].w * bfhi(gg[g].y));
                *(v2u*)(crow_ + 8 * g) = wv; }
        }
    }
}

__global__ void __launch_bounds__(NTHR, 2) fwd_kernel(Args args) {
    extern __shared__ __attribute__((aligned(16))) unsigned char lds[];
    Frame F;
    F.lds = (LAS unsigned char*)lds;
    F.MISC = (volatile LAS unsigned*)(F.lds + MISC_OFF);
    F.tid = threadIdx.x; F.lane = F.tid & 63; F.wave = __builtin_amdgcn_readfirstlane(F.tid >> 6);
    F.G = gridDim.x; F.bid = blockIdx.x; F.gw = F.bid * NWAVES + F.wave; F.NGW = F.G * NWAVES;
    F.ws = args.ws;
    unsigned* ctl = (unsigned*)(args.ws + WS_CTL);
    for (int u = F.tid; u < (LDS_BYTES - LDSCTL_OFF) / 4; u += NTHR) ((LAS unsigned*)(F.lds + LDSCTL_OFF))[u] = 0u;
    __syncthreads();
    const int lo = args.ph_lo, hi = args.ph_hi;
    XcdBarrier bar; bar.bar = ctl + CW_BAR + args.li * XCD_BAR_WORDS; bar.x = 0; bar.st = nullptr;
    if (hi - lo > 1) bar = xcd_barrier_post(ctl + CW_BAR + args.li * XCD_BAR_WORDS, F.MISC + 8);
#define IN(k) (lo <= (k) && (k) < hi)
#ifndef PROBE_DUP
#define PROBE_DUP (-1)
#endif
#define REP(k) for (int rep_ = 0; rep_ < (((PROBE_DUP) == (k)) ? 2 : 1); ++rep_)
#define SEAM(k) do { if (IN(k) && IN((k) + 1)) { xcd_barrier(bar); if (PROBE_DUP == 99) xcd_barrier(bar); } } while (0)
    unsigned char* ws = args.ws;
    bf16* XR = (bf16*)(ws + WS_XR);

    if (IN(0)) REP(0) { phase_prologue(F, args); } SEAM(0);
    if (IN(1)) {
        pg8::Gemm g{(const bf16*)(ws + WS_H), (const bf16*)(ws + WS_WIN), MTOK, NIN, DM}; pg8::StaticOrder S; S.init(MTOK, NIN, F.G, F.bid);
        EpiInProj E{(bf16*)(ws + WS_U), (bf16*)(ws + WS_GV), (bf16*)(ws + WS_Q), (bf16*)(ws + WS_V), (bf16*)(ws + WS_G), (_Float16*)(ws + WS_LFF), (_Float16*)(ws + WS_LFB), (const float*)(ws + WS_LB)};
        pg8::gemm_phase<EpiInProj, pg8::StaticOrder, true, true>(F.lds, g, S, E);
        if (PROBE_DUP == 1) pg8::gemm_phase<EpiInProj, pg8::StaticOrder, true, true>(F.lds, g, S, E);
    } SEAM(1);
    if (IN(2)) { phase_a_mix(F, args); REP(2) for (int u = F.bid; u < 512; u += F.G) gla_unit_state(F, u); } SEAM(2);
    if (IN(3)) { phase_gla_scan(F); } SEAM(3);
    if (IN(4)) { for (int i = F.bid; i < 256; i += F.G) gla_unit_out<false>(F, args, ((i >> 5) << 6) | (i & 31)); } SEAM(4);
    if (IN(5)) { for (int i = F.bid; i < 256; i += F.G) gla_unit_out<true>(F, args, ((i >> 5) << 6) | 32 | (i & 31)); } SEAM(5);
    if (IN(6)) REP(6) {
        pg8::Gemm g{(const bf16*)(ws + WS_CAT), (const bf16*)(ws + WS_WOUT), MTOK, DM, DM}; pg8::StaticOrder S; S.init(MTOK, DM, F.G, F.bid);
        EpiResid<true> E{args.in[0], XR};
        pg8::gemm_phase<EpiResid<true>, pg8::StaticOrder, true, true>(F.lds, g, S, E);
    } SEAM(6);
#define MOE_BLOCK(L, pb) do { \
        if (IN(pb)) REP(pb) { phase_router(F, XR, args.in[2] + (L) * DM, args.in[15] + (L) * DM * NEXP); } SEAM(pb); \
        if (IN((pb) + 1)) { REP((pb) + 1) phase_topk(F); convert_moe_weights(F, args.in[16], args.in[17], args.in[18], (L), (F.G > 64) ? 32 : 0); } SEAM((pb) + 1);     \
        if (IN((pb) + 2)) {     \
            pg8::Gemm g{(const bf16*)(ws + WS_H), (const bf16*)(ws + WS_WGU), NROWS, 16 * 2048, DM}; GroupedOrder<8> S{F.G, F.bid}; \
            EpiGateUp E{(bf16*)(ws + WS_HMID)}; \
            LAS int* rowtab = (LAS int*)(F.lds + RING_BYTES); const int* IDX = (const int*)(ws + WS_IDX); \
            for (int i = 0; i < 4; ++i) { pg8::Unit uu; if (!S.next(i, uu)) break; if (F.tid < 256) rowtab[i * 256 + F.tid] = IDX[uu.pm * 256 + F.tid]; } \
            __syncthreads(); \
            pg8::gemm_phase<EpiGateUp, GroupedOrder<8>, true, true, true>(F.lds, g, S, E, rowtab); \
            if (PROBE_DUP == (pb) + 2) pg8::gemm_phase<EpiGateUp, GroupedOrder<8>, true, true, true>(F.lds, g, S, E, rowtab); \
        } SEAM((pb) + 2); \
        if (IN((pb) + 3)) { \
            pg8::Gemm g{(const bf16*)(ws + WS_HMID), (const bf16*)(ws + WS_WDN), NROWS, 16 * 1024, DFF}; GroupedOrder<4> S{F.G, F.bid}; \
            EpiDown E{(bf16*)(ws + WS_Y), (const float*)(ws + WS_GATE)}; \
            pg8::gemm_phase<EpiDown, GroupedOrder<4>, true, true>(F.lds, g, S, E); \
            if (PROBE_DUP == (pb) + 3) pg8::gemm_phase<EpiDown, GroupedOrder<4>, true, true>(F.lds, g, S, E); \
        } SEAM((pb) + 3); \
    } while (0)

    MOE_BLOCK(0, 7);
    if (IN(11)) { phase_moe_combine(F, XR, args.out, args.in[1] + DM, false); } SEAM(11);
    if (IN(12)) REP(12) {
        pg8::Gemm g{(const bf16*)(ws + WS_H), (const bf16*)(ws + WS_WQKV), MTOK, NQKV, DM}; pg8::StaticOrder S; S.init(MTOK, NQKV, F.G, F.bid);
        EpiQKV E{(bf16*)(ws + WS_QKV)};
        pg8::gemm_phase<EpiQKV, pg8::StaticOrder, true, true>(F.lds, g, S, E);
    } SEAM(12);
    if (IN(13)) REP(13) { phase_kvf(F); } SEAM(13);
    if (IN(14)) REP(14) { phase_attn(F); } SEAM(14);
    if (IN(15)) {
        pg8::Gemm g{(const bf16*)(ws + WS_ATT), (const bf16*)(ws + WS_WO), MTOK, DM, DM}; pg8::StaticOrder S; S.init(MTOK, DM, F.G, F.bid);
        EpiResid<false> E{nullptr, XR};
        pg8::gemm_phase<EpiResid<false>, pg8::StaticOrder, true, true>(F.lds, g, S, E);
    } SEAM(15);
    MOE_BLOCK(1, 16);
    if (IN(20)) { phase_moe_combine(F, XR, args.out, args.in[3], true); }
#undef MOE_BLOCK
#undef IN
#undef SEAM
}

#ifndef MK_N_LAUNCHES
#define MK_N_LAUNCHES 1
#endif
extern "C" void kernel_launch(void* const* d_in, const int* in_sizes, int n_in, void* d_out, int out_size, void* d_ws, size_t ws_size, hipStream_t stream) {
    static int grid = 0;
    if (grid == 0) {
        if (n_in != 19 || in_sizes[0] != MTOK * DM || out_size != MTOK * DM || ws_size < WS_END) { fprintf(stderr, "kernel_launch: unexpected shapes (n_in %d, in0 %d, out %d, ws %zu < %zu); nothing launched\n", n_in, n_in > 0 ? in_sizes[0] : -1, out_size, ws_size, (size_t)WS_END); grid = -1; return; }
        int dev = 0, cus = 0, per_cu = 0;
        if (hipGetDevice(&dev) != hipSuccess || hipDeviceGetAttribute(&cus, hipDeviceAttributeMultiprocessorCount, dev) != hipSuccess) { grid = -1; return; }
        if (hipFuncSetAttribute((const void*)fwd_kernel, hipFuncAttributeMaxDynamicSharedMemorySize, LDS_BYTES) != hipSuccess) { fprintf(stderr, "kernel_launch: hipFuncSetAttribute failed\n"); grid = -1; return; }
        if (hipOccupancyMaxActiveBlocksPerMultiprocessor(&per_cu, (const void*)fwd_kernel, NTHR, LDS_BYTES) != hipSuccess || per_cu < 1) { fprintf(stderr, "kernel_launch: occupancy query reports %d workgroups per CU\n", per_cu); }
        (void)hipGetLastError();
        grid = cus;
    }
    if (grid < 0) return;
    if (hipMemsetAsync((char*)d_ws + WS_CTL, 0, CTL_ZERO_BYTES, stream) != hipSuccess) return;
    Args a{};
    for (int i = 0; i < 19; ++i) a.in[i] = (const float*)d_in[i];
    a.out = (float*)d_out; a.ws = (unsigned char*)d_ws; a.pad = 0;
    static_assert(CW_BAR + MAX_BAR_REGIONS * XCD_BAR_WORDS <= (int)(CTL_ZERO_BYTES / 4), "barrier regions inside the memset region");
#ifdef PROBE_PREFIX
    const int nl = 2;
    for (int li = 0; li < nl; ++li) {
        a.ph_lo = 0; a.ph_hi = (li == 0) ? PROBE_PREFIX : NPHASE; a.li = li;
#else
    const int nl = MK_N_LAUNCHES;
    for (int li = 0; li < nl; ++li) {
        a.ph_lo = (int)((long)NPHASE * li / nl); a.ph_hi = (int)((long)NPHASE * (li + 1) / nl); a.li = li;
#endif
        hipLaunchKernelGGL(fwd_kernel, dim3(grid), dim3(NTHR), LDS_BYTES, stream, a);
        const hipError_t le = hipPeekAtLastError();
        if (le != hipSuccess) { fprintf(stderr, "kernel_launch: launch %d failed: %s\n", li, hipGetErrorName(le)); break; }
    }
}
```
